# Optimizing an MI355X kernel written in HIP

```python
import jax, jax.numpy as jnp
from jax import lax
import numpy as np

D_MODEL = 1024
BATCH = 4
SEQ = 8192
DEPTH = 1

CHUNK = 64
Q_BLOCK = 128
SB_HEADS = 16
SB_HEAD_DIM = 64
SB_WIDTH = SB_HEADS * SB_HEAD_DIM
RET_HEADS = 4
RET_QK_DIM = 256
RET_V_DIM = 512
RET_QK_WIDTH = RET_HEADS * RET_QK_DIM
RET_V_WIDTH = RET_HEADS * RET_V_DIM
ROPE_BASE = 10000.0
N_EXPERTS = 32
TOP_K = 4
D_FF = 1024
SWIGLU_LIMIT = 7.0
SWIGLU_ALPHA = 1.702
EXPERT_BLOCK = 256
LN_EPS = 1e-5
DEEPNORM_ALPHA = (2.0 * DEPTH) ** 0.25
DEEPNORM_BETA = (8.0 * DEPTH) ** -0.25
IN_SIZES = (SB_WIDTH, SB_WIDTH, SB_WIDTH, RET_QK_WIDTH, RET_QK_WIDTH, RET_V_WIDTH, RET_V_WIDTH, D_MODEL, D_MODEL)
IN_WIDTH = 3 * SB_WIDTH + 2 * RET_QK_WIDTH + 2 * RET_V_WIDTH + 2 * D_MODEL

kernel_name = 'hybrid_stickbreak_retention_moe_deepnorm'


def layer_norm(x, g, b):
    xf = x.astype(jnp.float32)
    mu = jnp.mean(xf, axis=-1, keepdims=True)
    var = jnp.mean(jnp.square(xf - mu), axis=-1, keepdims=True)
    return ((xf - mu) * lax.rsqrt(var + LN_EPS)).astype(x.dtype) * g + b


def group_norm_heads(y):
    yf = y.astype(jnp.float32)
    mu = jnp.mean(yf, axis=-1, keepdims=True)
    var = jnp.mean(jnp.square(yf - mu), axis=-1, keepdims=True)
    return ((yf - mu) * lax.rsqrt(var + LN_EPS)).astype(y.dtype)


def split_heads(t, h):
    b, s, w = t.shape
    return t.reshape(b, s, h, w // h).transpose(0, 2, 1, 3)


def merge_heads(t):
    b, h, s, d = t.shape
    return t.transpose(0, 2, 1, 3).reshape(b, s, h * d)


def rotary(x, pos):
    half = x.shape[-1] // 2
    inv_freq = ROPE_BASE ** (-jnp.arange(half, dtype=jnp.float32) / half)
    ang = pos[:, None] * inv_freq[None, :]
    cos = jnp.cos(ang).astype(x.dtype)
    sin = jnp.sin(ang).astype(x.dtype)
    x1, x2 = x[..., :half], x[..., half:]
    return jnp.concatenate([x1 * cos - x2 * sin, x1 * sin + x2 * cos], axis=-1)


def stick_breaking_attention(q, k, v):
    s_len, d = q.shape[2], q.shape[3]
    scale = d ** -0.5
    outs = []
    for blk in range(s_len // Q_BLOCK):
        q0 = blk * Q_BLOCK
        q1 = q0 + Q_BLOCK
        qb = q[:, :, q0:q1]
        kb = k[:, :, :q1]
        vb = v[:, :, :q1]
        z = jnp.einsum('bhqd,bhkd->bhqk', qb, kb).astype(jnp.float32) * scale
        t_idx = q0 + jnp.arange(Q_BLOCK)[:, None]
        s_idx = jnp.arange(q1)[None, :]
        strict = s_idx < t_idx
        log_one_minus_beta = jnp.where(strict, jax.nn.log_sigmoid(-z), 0.0)
        later = lax.cumsum(log_one_minus_beta, axis=3, reverse=True) - log_one_minus_beta
        a = jnp.where(strict, jnp.exp(jax.nn.log_sigmoid(z) + later), 0.0)
        outs.append(jnp.einsum('bhqk,bhkd->bhqd', a.astype(v.dtype), vb))
    return jnp.concatenate(outs, axis=2)


def retention_chunkwise(q, k, v):
    b, h, s_len, dk = q.shape
    dv = v.shape[-1]
    n_chunks = s_len // CHUNK
    log_gamma = jnp.log(1.0 - 2.0 ** (-5.0 - jnp.arange(h, dtype=jnp.float32)))
    i = jnp.arange(CHUNK, dtype=jnp.float32)
    intra = jnp.exp(log_gamma[:, None, None] * jnp.abs(i[:, None] - i[None, :]))
    q_decay = jnp.exp(log_gamma[:, None] * (i + 1.0))
    k_decay = jnp.exp(log_gamma[:, None] * (CHUNK - 1.0 - i))
    chunk_decay = jnp.exp(log_gamma * CHUNK)
    q = q * (dk ** -0.5)

    def to_chunks(t):
        return t.reshape(b, h, n_chunks, CHUNK, t.shape[-1]).transpose(2, 0, 1, 3, 4)

    def step(state, qkv):
        qc, kc, vc = qkv
        scores = jnp.einsum('bhid,bhjd->bhij', qc, kc) * intra.astype(qc.dtype)
        y_intra = jnp.einsum('bhij,bhjv->bhiv', scores, vc).astype(jnp.float32)
        y_inter = jnp.einsum('bhid,bhdv->bhiv',
                             qc.astype(jnp.float32) * q_decay[None, :, :, None], state)
        new_state = state * chunk_decay[None, :, None, None] + jnp.einsum(
            'bhjd,bhjv->bhdv', kc.astype(jnp.float32) * k_decay[None, :, :, None],
            vc.astype(jnp.float32))
        return new_state, (y_intra + y_inter).astype(vc.dtype)

    state0 = jnp.zeros((b, h, dk, dv), jnp.float32)
    _, ys = lax.scan(step, state0, (to_chunks(q), to_chunks(k), to_chunks(v)))
    return ys.transpose(1, 2, 0, 3, 4).reshape(b, h, s_len, dv)


def hybrid_mixer(x, w_in, w_branch_sb, w_branch_ret, w_out):
    s_len = x.shape[1]
    points = [int(c) for c in np.cumsum(IN_SIZES)[:-1]]
    q_sb, k_sb, v_sb, q_r, k_r, v_r, g_r, gate_sb, gate_ret = jnp.split(x @ w_in, points, axis=-1)
    y_sb = stick_breaking_attention(split_heads(q_sb, SB_HEADS), split_heads(k_sb, SB_HEADS),
                                    split_heads(v_sb, SB_HEADS))
    branch_sb = merge_heads(y_sb) @ w_branch_sb
    pos = jnp.arange(s_len, dtype=jnp.float32)
    y_r = retention_chunkwise(rotary(split_heads(q_r, RET_HEADS), pos),
                              rotary(split_heads(k_r, RET_HEADS), pos),
                              split_heads(v_r, RET_HEADS))
    branch_ret = (jax.nn.silu(g_r) * merge_heads(group_norm_heads(y_r))) @ w_branch_ret
    merged = jax.nn.sigmoid(gate_sb) * branch_sb + jax.nn.sigmoid(gate_ret) * branch_ret
    return merged @ w_out


def moe_ffn(x, w_router, b_router, w_gate_up, b_gate_up, w_down, b_down):
    b, s_len, d = x.shape
    xf = x.reshape(-1, d)
    n_tok = xf.shape[0]
    logits = (xf @ w_router + b_router).astype(jnp.float32)
    top_val, top_idx = lax.top_k(logits, TOP_K)
    top_w = jax.nn.softmax(top_val, axis=-1).astype(x.dtype)
    n_assign = n_tok * TOP_K
    expert_flat = top_idx.reshape(-1)
    token_flat = jnp.arange(n_assign, dtype=jnp.int32) // TOP_K
    weight_flat = top_w.reshape(-1)
    order = jnp.argsort(expert_flat)
    sorted_e = expert_flat[order]
    counts = jnp.bincount(expert_flat, length=N_EXPERTS)
    starts = jnp.cumsum(counts) - counts
    padded = (counts + EXPERT_BLOCK - 1) // EXPERT_BLOCK * EXPERT_BLOCK
    padded_ends = jnp.cumsum(padded)
    padded_starts = padded_ends - padded
    dest = padded_starts[sorted_e] + jnp.arange(n_assign) - starts[sorted_e]
    n_rows = -(-n_assign // EXPERT_BLOCK) * EXPERT_BLOCK + N_EXPERTS * EXPERT_BLOCK
    n_blocks = n_rows // EXPERT_BLOCK
    row_token = jnp.zeros((n_rows,), jnp.int32).at[dest].set(token_flat[order])
    row_weight = jnp.zeros((n_rows,), x.dtype).at[dest].set(weight_flat[order])
    block_expert = jnp.minimum(
        jnp.searchsorted(padded_ends, jnp.arange(n_blocks) * EXPERT_BLOCK, side='right'),
        N_EXPERTS - 1)

    def run_block(args):
        e, tok, w = args
        hgu = xf[tok] @ w_gate_up[e] + b_gate_up[e]
        gate = jnp.minimum(hgu[:, :D_FF], SWIGLU_LIMIT)
        up = jnp.clip(hgu[:, D_FF:], -SWIGLU_LIMIT, SWIGLU_LIMIT)
        glu = gate * jax.nn.sigmoid(gate * SWIGLU_ALPHA)
        out = ((up + 1.0) * glu) @ w_down[e] + b_down[e]
        return out * w[:, None]

    rows = lax.map(run_block, (block_expert, row_token.reshape(n_blocks, EXPERT_BLOCK),
                               row_weight.reshape(n_blocks, EXPERT_BLOCK)))
    y = jax.ops.segment_sum(rows.reshape(n_rows, d), row_token, num_segments=n_tok)
    return y.reshape(b, s_len, d)


def setup_inputs(seed: int = 0) -> dict:
    key = jax.random.key(seed)
    ks = jax.random.split(key, 20)
    f32 = jnp.float32

    def nrm(k, shape, scale):
        return jax.random.normal(k, shape, f32) * scale

    x = jax.random.normal(ks[0], (BATCH, SEQ, D_MODEL), f32)
    col_scale = jnp.concatenate([
        jnp.full((sz,), DEEPNORM_BETA if idx in (2, 5) else 1.0, f32)
        for idx, sz in enumerate(IN_SIZES)])
    w_in = nrm(ks[1], (DEPTH, D_MODEL, IN_WIDTH), D_MODEL ** -0.5) * col_scale
    w_branch_sb = nrm(ks[2], (DEPTH, SB_WIDTH, D_MODEL), SB_WIDTH ** -0.5 * DEEPNORM_BETA)
    w_branch_ret = nrm(ks[3], (DEPTH, RET_V_WIDTH, D_MODEL), RET_V_WIDTH ** -0.5 * DEEPNORM_BETA)
    w_out = nrm(ks[4], (DEPTH, D_MODEL, D_MODEL), D_MODEL ** -0.5 * DEEPNORM_BETA)
    ln1_g = 1.0 + nrm(ks[5], (DEPTH, D_MODEL), 0.02)
    ln1_b = nrm(ks[6], (DEPTH, D_MODEL), 0.02)
    w_router = nrm(ks[7], (DEPTH, D_MODEL, N_EXPERTS), D_MODEL ** -0.5)
    b_router = nrm(ks[8], (DEPTH, N_EXPERTS), 0.01)
    w_gate_up = nrm(ks[9], (DEPTH, N_EXPERTS, D_MODEL, 2 * D_FF), D_MODEL ** -0.5 * DEEPNORM_BETA)
    b_gate_up = nrm(ks[10], (DEPTH, N_EXPERTS, 2 * D_FF), 0.01)
    w_down = nrm(ks[11], (DEPTH, N_EXPERTS, D_FF, D_MODEL), D_FF ** -0.5 * DEEPNORM_BETA)
    b_down = nrm(ks[12], (DEPTH, N_EXPERTS, D_MODEL), 0.01)
    ln2_g = 1.0 + nrm(ks[13], (DEPTH, D_MODEL), 0.02)
    ln2_b = nrm(ks[14], (DEPTH, D_MODEL), 0.02)
    return {'x': x, 'w_in': w_in, 'w_branch_sb': w_branch_sb, 'w_branch_ret': w_branch_ret,
            'w_out': w_out, 'ln1_g': ln1_g, 'ln1_b': ln1_b, 'w_router': w_router,
            'b_router': b_router, 'w_gate_up': w_gate_up, 'b_gate_up': b_gate_up,
            'w_down': w_down, 'b_down': b_down, 'ln2_g': ln2_g, 'ln2_b': ln2_b}


def reference(x, w_in, w_branch_sb, w_branch_ret, w_out, ln1_g, ln1_b, w_router, b_router,
              w_gate_up, b_gate_up, w_down, b_down, ln2_g, ln2_b):
    for l in range(DEPTH):
        mix = hybrid_mixer(x, w_in[l], w_branch_sb[l], w_branch_ret[l], w_out[l])
        x = layer_norm(DEEPNORM_ALPHA * x + mix, ln1_g[l], ln1_b[l])
        ffn = moe_ffn(x, w_router[l], b_router[l], w_gate_up[l], b_gate_up[l], w_down[l], b_down[l])
        x = layer_norm(DEEPNORM_ALPHA * x + ffn, ln2_g[l], ln2_b[l])
    return x
```

```cpp
#include <hip/hip_runtime.h>
#include <cstdio>
#include <cstdint>
#include <cstring>

constexpr int BATCH = 4, SEQ = 8192, DM = 1024, NTOK = BATCH * SEQ;
constexpr int SBH = 16, SBD = 64;
constexpr int RH = 4, RDK = 256, RDV = 512, RQK = RH * RDK  , RV = RH * RDV  ;
constexpr int CHUNK = 64, NCHUNK = SEQ / CHUNK;
constexpr int INW = 11264;
constexpr int NEXP = 32, TOPK = 4, DFF = 1024;
constexpr int CAP = NTOK;
constexpr int MAXROWS = NTOK * TOPK + NEXP * 256;
constexpr float LN_EPS = 1e-5f;
constexpr float DN_ALPHA = 1.18920711500272106672f;
constexpr float LOG2E = 1.4426950408889634f;
constexpr float SB_C2 = 0.125f * LOG2E;

typedef unsigned short bf16;
typedef float f32x4 __attribute__((ext_vector_type(4)));
typedef float f32x16 __attribute__((ext_vector_type(16)));
typedef short bf16x8 __attribute__((ext_vector_type(8)));
typedef short bf16x4 __attribute__((ext_vector_type(4)));
typedef unsigned u32x4 __attribute__((ext_vector_type(4)));
typedef unsigned u32x2 __attribute__((ext_vector_type(2)));

__host__ __device__ __forceinline__ float bf2f(bf16 v) { unsigned u = (unsigned)v << 16; return __builtin_bit_cast(float, u); }
__host__ __device__ __forceinline__ bf16 f2bf(float f) { unsigned u = __builtin_bit_cast(unsigned, f); return (bf16)((u + 0x7fffu + ((u >> 16) & 1u)) >> 16); }
__device__ __forceinline__ unsigned pk2(float lo, float hi) { return (unsigned)f2bf(lo) | ((unsigned)f2bf(hi) << 16); }

constexpr size_t MiB = 1u << 20;
constexpr size_t WS_CTL = 0, CTL_ZERO_BYTES = 1 * MiB;
constexpr size_t WS_COS = 1 * MiB, WS_SIN = 5 * MiB;
constexpr size_t WS_WRT = 9 * MiB;
constexpr size_t WS_TSTART = 9 * MiB + 512 * 1024;
constexpr size_t WS_WINT = 10 * MiB;
constexpr size_t WS_WVT = 26 * MiB;
constexpr size_t WS_WBSBT = 32 * MiB, WS_WBRETT = 34 * MiB, WS_WOUTT = 38 * MiB;
constexpr size_t WS_WGUT = 40 * MiB;
constexpr size_t WS_WDT = 168 * MiB;
constexpr size_t WS_QSB = 232 * MiB;
constexpr size_t WS_KSB = 296 * MiB;
constexpr size_t WS_VSBT = 360 * MiB;
constexpr size_t WS_YINT = 296 * MiB;
constexpr size_t WS_QR = 424 * MiB, WS_KR = 488 * MiB;
constexpr size_t WS_VRT = 552 * MiB;
constexpr size_t WS_SG = 680 * MiB;
constexpr size_t WS_GSB = 808 * MiB, WS_GRET = 872 * MiB;
constexpr size_t WS_SELE = 936 * MiB, WS_SELW = 937 * MiB;
constexpr size_t WS_ROWTK = 940 * MiB, WS_ROWW = 944 * MiB;
constexpr size_t WS_RINFO = 948 * MiB;
constexpr size_t WS_M1 = 424 * MiB, WS_MG = 488 * MiB;
constexpr size_t WS_X1B = 552 * MiB;
constexpr size_t WS_ACT = 616 * MiB;
constexpr size_t WS_OUTR = 232 * MiB;
constexpr size_t WS_END = 1024 * MiB;
static_assert(WS_ACT + (size_t)MAXROWS * 1024 * 2 <= WS_SELE, "ACT fits");
static_assert(WS_OUTR + (size_t)NTOK * 4 * 1024 * 2 <= WS_MG, "OUTR fits below MG");
constexpr size_t DO_XB = 0, DO_KRT = 64 * MiB;

constexpr int CW_TMO = 0, CW_CODE = 1;
constexpr int CW_BAR = 4096;
constexpr int CW_CNT = 16384;

struct Bufs {
    const float *x, *w_in, *w_bsb, *w_bret, *w_out, *ln1_g, *ln1_b, *w_router, *b_router, *w_gu, *b_gu, *w_dn, *b_dn, *ln2_g, *ln2_b;
    float* out; unsigned char* ws;
};
#define WSP(T, off) ((T*)(B.ws + (off)))
#define DOP(T, off) ((T*)((unsigned char*)B.out + (off)))

__global__ void n_xb(Bufs B) {
    const size_t n = (size_t)NTOK * DM; bf16* xb = DOP(bf16, DO_XB);
    for (size_t i = (size_t)blockIdx.x * blockDim.x + threadIdx.x; i < n; i += (size_t)gridDim.x * blockDim.x) xb[i] = f2bf(B.x[i]);
}
struct TrArgs { const float* src; bf16* dst; int lds, c0, width, K, r0, pad; };
__global__ void n_tr(TrArgs a) {
    const float* src = a.src; bf16* dst = a.dst; const int lds = a.lds, c0 = a.c0, width = a.width, K = a.K, r0 = a.r0;
    const size_t n = (size_t)width * K;
    for (size_t i = (size_t)blockIdx.x * blockDim.x + threadIdx.x; i < n; i += (size_t)gridDim.x * blockDim.x) {
        const int k = (int)(i % K), c = (int)(i / K); dst[(size_t)(r0 + c) * K + k] = f2bf(src[(size_t)k * lds + c0 + c]); }
}
struct Tr2Args { const float* src; bf16* dst; };
__global__ void n_tr_gu(Tr2Args a) { const float* src = a.src; bf16* dst = a.dst;
    const size_t n = (size_t)NEXP * 2048 * 1024;
    for (size_t i = (size_t)blockIdx.x * blockDim.x + threadIdx.x; i < n; i += (size_t)gridDim.x * blockDim.x) {
        const int k = (int)(i % 1024); const int r = (int)((i / 1024) % 2048); const int e = (int)(i / (1024 * 2048));
        const int ct = r >> 8, bj = (r >> 7) & 1, ii = r & 127; const int c = bj * 1024 + 128 * ct + ii;
        dst[i] = f2bf(src[((size_t)e * 1024 + k) * 2048 + c]); }
}
__global__ void n_tr_dn(Tr2Args a) { const float* src = a.src; bf16* dst = a.dst;
    const size_t n = (size_t)NEXP * 1024 * 1024;
    for (size_t i = (size_t)blockIdx.x * blockDim.x + threadIdx.x; i < n; i += (size_t)gridDim.x * blockDim.x) {
        const int ff = (int)(i % 1024); const int d = (int)((i / 1024) % 1024); const int e = (int)(i / (1024 * 1024));
        dst[i] = f2bf(src[((size_t)e * 1024 + ff) * 1024 + d]); }
}
__device__ __forceinline__ float rope_inv_freq(int j) { return powf(10000.0f, -(float)j / 128.0f); }
__global__ void n_rope(Bufs B) {
    float* c = WSP(float, WS_COS); float* s = WSP(float, WS_SIN);
    for (int i = blockIdx.x * blockDim.x + threadIdx.x; i < SEQ * 128; i += gridDim.x * blockDim.x) {
        const int pos = i >> 7, j = i & 127; const float ang = (float)pos * rope_inv_freq(j);
        c[i] = (float)cos((double)ang); s[i] = (float)sin((double)ang); }
}

template <class AF, class BF, class EF> struct GArgs { AF af; BF bf; EF ef; int M, N, K, pad; };
template <int NB, class AF, class BF, class EF>
__global__ void __launch_bounds__(256) ngemm(GArgs<AF, BF, EF> ga) {
    const AF& af = ga.af; const BF& bf = ga.bf; const EF& ef = ga.ef; const int K = ga.K;
    __shared__ float As[16][65], Bs[NB][16][65];
    const int tx = threadIdx.x & 15, ty = threadIdx.x >> 4;
    const int m0 = blockIdx.y * 64, n0 = blockIdx.x * 64;
    if (!af.active(m0)) return;
    float acc[NB][4][4];
#pragma unroll
    for (int b = 0; b < NB; ++b)
#pragma unroll
        for (int i = 0; i < 4; ++i)
#pragma unroll
            for (int j = 0; j < 4; ++j) acc[b][i][j] = 0.f;
    for (int k0 = 0; k0 < K; k0 += 16) {
#pragma unroll
        for (int i = 0; i < 4; ++i) { const int idx = threadIdx.x + 256 * i; const int kk = idx & 15, mm = idx >> 4; As[kk][mm] = af(m0 + mm, k0 + kk); }
#pragma unroll
        for (int b = 0; b < NB; ++b)
#pragma unroll
            for (int i = 0; i < 4; ++i) { const int idx = threadIdx.x + 256 * i; const int kk = idx & 15, nn = idx >> 4; Bs[b][kk][nn] = bf(m0, k0 + kk, n0 + nn, b); }
        __syncthreads();
#pragma unroll
        for (int kk = 0; kk < 16; ++kk) {
            float a[4];
#pragma unroll
            for (int i = 0; i < 4; ++i) a[i] = As[kk][ty * 4 + i];
#pragma unroll
            for (int b = 0; b < NB; ++b) {
                float bb[4];
#pragma unroll
                for (int j = 0; j < 4; ++j) bb[j] = Bs[b][kk][tx * 4 + j];
#pragma unroll
                for (int i = 0; i < 4; ++i)
#pragma unroll
                    for (int j = 0; j < 4; ++j) acc[b][i][j] += a[i] * bb[j];
            }
        }
        __syncthreads();
    }
#pragma unroll
    for (int i = 0; i < 4; ++i)
#pragma unroll
        for (int j = 0; j < 4; ++j) {
            float v[NB];
#pragma unroll
            for (int b = 0; b < NB; ++b) v[b] = acc[b][i][j];
            ef(m0 + ty * 4 + i, n0 + tx * 4 + j, v);
        }
}

__device__ __forceinline__ float sigmoidf_(float x) { return 1.0f / (1.0f + __expf(-x)); }
__device__ __forceinline__ float ret_log2gamma(int h) { return log2f(1.0f - exp2f(-5.0f - (float)h)); }

struct AF_rows { const bf16* A; int ld, pad; __device__ bool active(int) const { return true; } __device__ float operator()(int m, int k) const { return bf2f(A[(size_t)m * ld + k]); } };
struct BF_inproj { const bf16 *wint, *wvt;
    __device__ float operator()(int, int k, int n, int) const {
        const bf16* row;
        if (n < 2048) row = wint + (size_t)n * 1024;
        else if (n < 3072) row = wvt + (size_t)(n - 2048) * 1024;
        else if (n < 5120) row = wint + (size_t)(2048 + n - 3072) * 1024;
        else if (n < 7168) row = wvt + (size_t)(1024 + n - 5120) * 1024;
        else row = wint + (size_t)(4096 + n - 7168) * 1024;
        return bf2f(row[k]); } };
struct EF_inproj { Bufs B;
    __device__ void operator()(int m, int n, const float (&v)[1]) const {
        const float a = v[0];
        if (n < 1024) WSP(bf16, WS_QSB)[(size_t)m * 1024 + n] = f2bf(a * SB_C2);
        else if (n < 2048) WSP(bf16, WS_KSB)[(size_t)m * 1024 + n - 1024] = f2bf(a);
        else if (n < 3072) WSP(bf16, WS_VSBT)[(size_t)(n - 2048) * NTOK + m] = f2bf(a);
        else if (n < 4096) WSP(bf16, WS_QR)[(size_t)m * 1024 + n - 3072] = f2bf(a);
        else if (n < 5120) WSP(bf16, WS_KR)[(size_t)m * 1024 + n - 4096] = f2bf(a);
        else if (n < 7168) { const int f = n - 5120, h = f >> 9; const float dec = exp2f((float)(63 - (m & 63)) * ret_log2gamma(h));
            WSP(bf16, WS_VRT)[(size_t)f * NTOK + m] = f2bf(a * dec); }
        else if (n < 9216) WSP(bf16, WS_SG)[(size_t)m * 2048 + n - 7168] = f2bf(a * sigmoidf_(a));
        else if (n < 10240) WSP(bf16, WS_GSB)[(size_t)m * 1024 + n - 9216] = f2bf(sigmoidf_(a));
        else WSP(bf16, WS_GRET)[(size_t)m * 1024 + n - 10240] = f2bf(sigmoidf_(a)); } };
__global__ void n_rotary(Bufs B) {
    bf16* qr = WSP(bf16, WS_QR); bf16* kr = WSP(bf16, WS_KR); bf16* krt = DOP(bf16, DO_KRT);
    const float* ct = WSP(float, WS_COS); const float* st = WSP(float, WS_SIN);
    const size_t n = (size_t)NTOK * RH * 128;
    for (size_t i = (size_t)blockIdx.x * blockDim.x + threadIdx.x; i < n; i += (size_t)gridDim.x * blockDim.x) {
        const int j = (int)(i & 127), h = (int)((i >> 7) & 3); const int m = (int)(i >> 9); const int pos = m & (SEQ - 1);
        const float c = ct[pos * 128 + j], s = st[pos * 128 + j];
        const size_t o1 = (size_t)m * 1024 + h * 256 + j, o2 = o1 + 128;
        { const float x1 = bf2f(qr[o1]), x2 = bf2f(qr[o2]); qr[o1] = f2bf((x1 * c - x2 * s) * 0.0625f); qr[o2] = f2bf((x1 * s + x2 * c) * 0.0625f); }
        { const float x1 = bf2f(kr[o1]), x2 = bf2f(kr[o2]); const bf16 r1 = f2bf(x1 * c - x2 * s), r2 = f2bf(x1 * s + x2 * c); kr[o1] = r1; kr[o2] = r2;
          krt[(size_t)(h * 256 + j) * NTOK + m] = r1; krt[(size_t)(h * 256 + j + 128) * NTOK + m] = r2; }
    }
}

__global__ void __launch_bounds__(64) n_attn(Bufs B) {
    const int gid = blockIdx.x * 64 + threadIdx.x;
    const int t = gid & (SEQ - 1), bh = gid >> 13, h = bh & 15, b = bh >> 4;
    bf16* q = WSP(bf16, WS_QSB); const bf16* k = WSP(bf16, WS_KSB); const bf16* vt = WSP(bf16, WS_VSBT);
    const size_t rb = (size_t)b * SEQ;
    float qv[64], o[64];
#pragma unroll
    for (int d = 0; d < 64; ++d) { qv[d] = bf2f(q[(rb + t) * 1024 + h * 64 + d]); o[d] = 0.f; }
    float later = 0.f;
    for (int s = t - 1; s >= 0; --s) {
        const bf16* kp = k + (rb + s) * 1024 + h * 64; float z2 = 0.f;
#pragma unroll
        for (int d = 0; d < 64; ++d) z2 += qv[d] * bf2f(kp[d]);
        const float z = z2 * 0.6931471805599453f;
        const float sp = fmaxf(z, 0.f) + log1pf(__expf(-fabsf(z)));
        const float a = __expf((z - sp) + later);
        later -= sp;
        if (a > 0.f) {
#pragma unroll
            for (int d = 0; d < 64; ++d) o[d] += a * bf2f(vt[(size_t)(h * 64 + d) * NTOK + rb + s]);
        }
    }
#pragma unroll
    for (int d = 0; d < 64; ++d) q[(rb + t) * 1024 + h * 64 + d] = f2bf(o[d]);
}

__global__ void __launch_bounds__(64) n_scan(Bufs B) {
    const int gid = blockIdx.x, v = gid & 511, h = (gid >> 9) & 3, b = gid >> 11, lane = threadIdx.x;
    const bf16* qr = WSP(bf16, WS_QR); const bf16* krt = DOP(bf16, DO_KRT); const bf16* vrt = WSP(bf16, WS_VRT); bf16* yint = WSP(bf16, WS_YINT);
    const float l2g = ret_log2gamma(h), cd = exp2f(64.f * l2g);
    float st[4] = {0.f, 0.f, 0.f, 0.f};
    for (int c = 0; c < NCHUNK; ++c) {
        const size_t tok0 = (size_t)b * SEQ + c * 64;
        for (int i = 0; i < 64; ++i) {
            const bf16* qp = qr + (tok0 + i) * 1024 + h * 256 + 4 * lane;
            float p = bf2f(qp[0]) * st[0] + bf2f(qp[1]) * st[1] + bf2f(qp[2]) * st[2] + bf2f(qp[3]) * st[3];
#pragma unroll
            for (int o = 1; o < 64; o <<= 1) p += __shfl_xor(p, o);
            if (lane == 0) yint[(tok0 + i) * 2048 + h * 512 + v] = f2bf(p * exp2f((float)(i + 1) * l2g));
        }
        float ns[4] = {st[0] * cd, st[1] * cd, st[2] * cd, st[3] * cd};
        for (int j = 0; j < 64; ++j) {
            const float vv = bf2f(vrt[(size_t)(h * 512 + v) * NTOK + tok0 + j]);
#pragma unroll
            for (int e = 0; e < 4; ++e) ns[e] += bf2f(krt[(size_t)(h * 256 + 4 * lane + e) * NTOK + tok0 + j]) * vv;
        }
#pragma unroll
        for (int e = 0; e < 4; ++e) st[e] = ns[e];
    }
}

__global__ void __launch_bounds__(256) n_intra(Bufs B) {
    __shared__ float P[64][65]; __shared__ float Y[8][512]; __shared__ float stat[8][2];
    const int gid = blockIdx.x, c = gid & 127, h = (gid >> 7) & 3, b = gid >> 9, tid = threadIdx.x;
    const bf16* qr = WSP(bf16, WS_QR); const bf16* kr = WSP(bf16, WS_KR); const bf16* vrt = WSP(bf16, WS_VRT); const bf16* sg = WSP(bf16, WS_SG); bf16* yr = WSP(bf16, WS_YINT);
    const size_t tok0 = (size_t)b * SEQ + c * 64; const float l2g = ret_log2gamma(h);
    for (int e = tid; e < 4096; e += 256) { const int i = e >> 6, j = e & 63; float s = 0.f;
        const bf16* qp = qr + (tok0 + i) * 1024 + h * 256; const bf16* kp = kr + (tok0 + j) * 1024 + h * 256;
        for (int d = 0; d < 256; ++d) s += bf2f(qp[d]) * bf2f(kp[d]);
        const int ad = i > j ? i - j : j - i; P[i][j] = s * exp2f((float)(ad - 63 + j) * l2g); }
    __syncthreads();
    for (int i0 = 0; i0 < 64; i0 += 8) {
        for (int vv = tid; vv < 512; vv += 256) {
            const bf16* vp = vrt + (size_t)(h * 512 + vv) * NTOK + tok0;
            float acc[8] = {0.f, 0.f, 0.f, 0.f, 0.f, 0.f, 0.f, 0.f};
            for (int j = 0; j < 64; ++j) { const float x = bf2f(vp[j]);
#pragma unroll
                for (int r = 0; r < 8; ++r) acc[r] += P[i0 + r][j] * x; }
#pragma unroll
            for (int r = 0; r < 8; ++r) Y[r][vv] = acc[r] + bf2f(yr[(tok0 + i0 + r) * 2048 + h * 512 + vv]);
        }
        __syncthreads();
        { const int w = tid >> 6, lane = tid & 63;
          for (int r = w; r < 8; r += 4) { float s = 0.f, s2 = 0.f;
              for (int vv = lane; vv < 512; vv += 64) { const float x = Y[r][vv]; s += x; }
#pragma unroll
              for (int o = 1; o < 64; o <<= 1) s += __shfl_xor(s, o);
              const float mean = s * (1.f / 512.f);
              for (int vv = lane; vv < 512; vv += 64) { const float x = Y[r][vv] - mean; s2 += x * x; }
#pragma unroll
              for (int o = 1; o < 64; o <<= 1) s2 += __shfl_xor(s2, o);
              if (lane == 0) { stat[r][0] = mean; stat[r][1] = rsqrtf(s2 * (1.f / 512.f) + LN_EPS); } } }
        __syncthreads();
        for (int e = tid; e < 8 * 512; e += 256) { const int r = e >> 9, vv = e & 511; const size_t o = (tok0 + i0 + r) * 2048 + h * 512 + vv;
            yr[o] = f2bf(bf2f(sg[o]) * (Y[r][vv] - stat[r][0]) * stat[r][1]); }
        __syncthreads();
    }
}

struct BF_wt { const bf16* W; int K, pad; __device__ float operator()(int, int k, int n, int) const { return bf2f(W[(size_t)n * K + k]); } };
struct EF_m1 { Bufs B; __device__ void operator()(int m, int n, const float (&v)[1]) const { const size_t o = (size_t)m * 1024 + n; WSP(bf16, WS_M1)[o] = f2bf(bf2f(WSP(bf16, WS_GSB)[o]) * v[0]); } };
struct EF_mg { Bufs B; __device__ void operator()(int m, int n, const float (&v)[1]) const { const size_t o = (size_t)m * 1024 + n; WSP(bf16, WS_MG)[o] = f2bf(bf2f(WSP(bf16, WS_M1)[o]) + bf2f(WSP(bf16, WS_GRET)[o]) * v[0]); } };
struct EF_pre { Bufs B; __device__ void operator()(int m, int n, const float (&v)[1]) const { const size_t o = (size_t)m * 1024 + n; B.out[o] = DN_ALPHA * B.x[o] + v[0]; } };

__device__ __forceinline__ float wave_sum(float v) {
#pragma unroll
    for (int o = 1; o < 64; o <<= 1) v += __shfl_xor(v, o);
    return v;
}
__global__ void __launch_bounds__(256) n_ln1(Bufs B) {
    const int row = blockIdx.x * 4 + (threadIdx.x >> 6), lane = threadIdx.x & 63;
    float* p = B.out + (size_t)row * 1024; bf16* xb = WSP(bf16, WS_X1B) + (size_t)row * 1024;
    float v[16]; float s = 0.f;
#pragma unroll
    for (int j = 0; j < 16; ++j) { v[j] = p[lane + 64 * j]; s += v[j]; }
    const float mean = wave_sum(s) * (1.f / 1024.f); float s2 = 0.f;
#pragma unroll
    for (int j = 0; j < 16; ++j) { v[j] -= mean; s2 += v[j] * v[j]; }
    const float rstd = rsqrtf(wave_sum(s2) * (1.f / 1024.f) + LN_EPS);
#pragma unroll
    for (int j = 0; j < 16; ++j) { const int c = lane + 64 * j; const float y = v[j] * rstd * B.ln1_g[c] + B.ln1_b[c]; p[c] = y; xb[c] = f2bf(y); }
}
__global__ void __launch_bounds__(64) n_router(Bufs B) {
    const int tok = blockIdx.x * 64 + threadIdx.x;
    const bf16* xb = WSP(bf16, WS_X1B) + (size_t)tok * 1024; const bf16* wr = WSP(bf16, WS_WRT);
    float lg[32];
#pragma unroll
    for (int e = 0; e < 32; ++e) lg[e] = 0.f;
    for (int k = 0; k < 1024; ++k) { const float xv = bf2f(xb[k]);
#pragma unroll
        for (int e = 0; e < 32; ++e) lg[e] += xv * bf2f(wr[e * 1024 + k]); }
#pragma unroll
    for (int e = 0; e < 32; ++e) lg[e] += B.b_router[e];
    int se[4]; float sv[4];
#pragma unroll
    for (int kk = 0; kk < 4; ++kk) { float best = -INFINITY; int bi = 0;
#pragma unroll
        for (int e = 0; e < 32; ++e) { if (lg[e] > best) { best = lg[e]; bi = e; } }
        se[kk] = bi; sv[kk] = best;
#pragma unroll
        for (int e = 0; e < 32; ++e) if (e == bi) lg[e] = -INFINITY; }
    const float e1 = __expf(sv[1] - sv[0]), e2 = __expf(sv[2] - sv[0]), e3 = __expf(sv[3] - sv[0]); const float inv = 1.f / (1.f + e1 + e2 + e3);
    const float w[4] = {inv, e1 * inv, e2 * inv, e3 * inv};
    unsigned* cnt = WSP(unsigned, WS_CTL) + CW_CNT;
#pragma unroll
    for (int kk = 0; kk < 4; ++kk) { WSP(int, WS_SELE)[tok * 4 + kk] = se[kk]; WSP(float, WS_SELW)[tok * 4 + kk] = w[kk];
        const unsigned pos = atomicAdd(cnt + 64 * se[kk], 1u);
        WSP(int, WS_ROWTK)[(size_t)se[kk] * CAP + pos] = tok * 4 + kk; WSP(float, WS_ROWW)[(size_t)se[kk] * CAP + pos] = w[kk]; }
}
__global__ void n_tstart(Bufs B) {
    if (threadIdx.x == 0 && blockIdx.x == 0) { int* ts = WSP(int, WS_TSTART); const unsigned* cnt = WSP(unsigned, WS_CTL) + CW_CNT; int acc = 0;
        for (int e = 0; e < NEXP; ++e) { ts[e] = acc; acc += (int)((cnt[64 * e] + 255u) >> 8); } ts[NEXP] = acc; }
}
struct MoeRow { int e, valid, tk; float w; };
__global__ void n_rowinfo(Bufs B) {
    const int* ts = WSP(int, WS_TSTART); const unsigned* cnt = WSP(unsigned, WS_CTL) + CW_CNT; MoeRow* ri = WSP(MoeRow, WS_RINFO);
    for (int m = blockIdx.x * blockDim.x + threadIdx.x; m < MAXROWS; m += gridDim.x * blockDim.x) {
        MoeRow r; const int rt = m >> 8; int e = 0;
        while (e < NEXP - 1 && rt >= ts[e + 1]) ++e;
        const int pos = m - 256 * ts[e];
        r.e = e; r.valid = (rt < ts[NEXP]) && (pos < (int)cnt[64 * e]);
        r.tk = r.valid ? WSP(int, WS_ROWTK)[(size_t)e * CAP + pos] : 0; r.w = r.valid ? WSP(float, WS_ROWW)[(size_t)e * CAP + pos] : 0.f; ri[m] = r; }
}
struct AF_gather { Bufs B; __device__ bool active(int m0) const { return (m0 >> 8) < WSP(int, WS_TSTART)[NEXP]; }
    __device__ float operator()(int m, int k) const { const int tk = WSP(MoeRow, WS_RINFO)[m].tk; return bf2f(WSP(bf16, WS_X1B)[(size_t)(tk >> 2) * 1024 + k]); } };
struct BF_gu { Bufs B; __device__ float operator()(int m0, int k, int n, int which) const { const int e = WSP(MoeRow, WS_RINFO)[m0].e;
        const int ct = n >> 7, i = n & 127; return bf2f(WSP(bf16, WS_WGUT)[((size_t)e * 2048 + 256 * ct + 128 * which + i) * 1024 + k]); } };
__device__ __forceinline__ float moe_act(float g, float u) {
    g = fminf(g, 7.0f); u = fminf(fmaxf(u, -7.0f), 7.0f); const float glu = g * (1.0f / (1.0f + __expf(-1.702f * g))); return (u + 1.0f) * glu; }
struct EF_gu { Bufs B; __device__ void operator()(int m, int n, const float (&v)[2]) const { const MoeRow r = WSP(MoeRow, WS_RINFO)[m]; if (!r.valid) return;
        const float g = v[0] + B.b_gu[r.e * 2048 + n], u = v[1] + B.b_gu[r.e * 2048 + 1024 + n]; WSP(bf16, WS_ACT)[(size_t)m * 1024 + n] = f2bf(moe_act(g, u)); } };
struct AF_act { Bufs B; __device__ bool active(int m0) const { return (m0 >> 8) < WSP(int, WS_TSTART)[NEXP]; }
    __device__ float operator()(int m, int k) const { return WSP(MoeRow, WS_RINFO)[m].valid ? bf2f(WSP(bf16, WS_ACT)[(size_t)m * 1024 + k]) : 0.f; } };
struct BF_dn { Bufs B; __device__ float operator()(int m0, int k, int n, int) const { const int e = WSP(MoeRow, WS_RINFO)[m0].e; return bf2f(WSP(bf16, WS_WDT)[((size_t)e * 1024 + n) * 1024 + k]); } };
struct EF_dn { Bufs B; __device__ void operator()(int m, int n, const float (&v)[1]) const { const MoeRow r = WSP(MoeRow, WS_RINFO)[m]; if (!r.valid) return;
        WSP(bf16, WS_OUTR)[(size_t)r.tk * 1024 + n] = f2bf((v[0] + B.b_dn[r.e * 1024 + n]) * r.w); } };
__global__ void __launch_bounds__(256) n_final(Bufs B) {
    const int row = blockIdx.x * 4 + (threadIdx.x >> 6), lane = threadIdx.x & 63;
    float* p = B.out + (size_t)row * 1024; const bf16* orow = WSP(bf16, WS_OUTR) + (size_t)row * 4 * 1024;
    float v[16]; float s = 0.f;
#pragma unroll
    for (int j = 0; j < 16; ++j) { const int c = lane + 64 * j; float a = DN_ALPHA * p[c];
#pragma unroll
        for (int kk = 0; kk < 4; ++kk) a += bf2f(orow[kk * 1024 + c]);
        v[j] = a; s += a; }
    const float mean = wave_sum(s) * (1.f / 1024.f); float s2 = 0.f;
#pragma unroll
    for (int j = 0; j < 16; ++j) { v[j] -= mean; s2 += v[j] * v[j]; }
    const float rstd = rsqrtf(wave_sum(s2) * (1.f / 1024.f) + LN_EPS);
#pragma unroll
    for (int j = 0; j < 16; ++j) { const int c = lane + 64 * j; p[c] = v[j] * rstd * B.ln2_g[c] + B.ln2_b[c]; }
}

__device__ __forceinline__ int lane_id() { return (int)__builtin_amdgcn_mbcnt_hi(~0u, __builtin_amdgcn_mbcnt_lo(~0u, 0u)); }
namespace pg8 {
#define PG8_LAS __attribute__((address_space(3)))
constexpr int BM = 256, BK = 64, HALF = 128, HTB = HALF * BK * 2  , STAGE_BYTES = 8 * HTB, NXCD = 8, WGM = 8;
__host__ __device__ __forceinline__ int lds_byte(int r, int c) { const int st = (r >> 4) * 2 + (c >> 5), rr = r & 15, cc = c & 31, ob = rr * 64 + cc * 2; return st * 1024 + (ob ^ (((ob >> 9) & 1) << 5)); }
__host__ __device__ __forceinline__ void stage_rc(int b, int& R, int& C) { const int st = b / 1024, sb = b % 1024, swz = sb ^ (((sb >> 9) & 1) << 5); R = (st >> 1) * 16 + swz / 64; C = (st & 1) * 32 + (swz % 64) / 2; }
__host__ __device__ __forceinline__ int perm32(int rho) { const int n = rho >> 4, i = rho & 15; return 8 * (i >> 2) + 4 * n + (i & 3); }

struct Unit { int pm, pn, e, idx, rbase, nrows; };

struct StaticOrder {
    const char* A; const char* Bt; int nM, nN, nwg, G, c, K;
    __device__ void init(const void* A_, const void* Bt_, int M, int N, int K_, int G_, int c_) { A = (const char*)A_; Bt = (const char*)Bt_; nM = M / BM; nN = N / BM; nwg = nM * nN; G = G_; c = c_; K = K_; }
    __device__ bool next(int i, Unit& u) const {
        const long L = (long)i * G + c; if (L >= nwg) return false;
        int wgid = (int)L; { const int q = nwg / NXCD, r = nwg % NXCD, xcd = wgid % NXCD, off = wgid / NXCD; wgid = (xcd < r ? xcd * (q + 1) : r * (q + 1) + (xcd - r) * q) + off; }
        const int nig = WGM * nN, gid = wgid / nig, fm = gid * WGM, gsz = (nM - fm) < WGM ? (nM - fm) : WGM;
        u.pm = fm + ((wgid % nig) % gsz); u.pn = (wgid % nig) / gsz; u.e = 0; u.idx = i; u.rbase = u.pm * BM; u.nrows = BM; return true;
    }
    __device__ __forceinline__ const char* a_ptr(const Unit& u) const { return A + (size_t)u.pm * BM * K * 2; }
    __device__ __forceinline__ const char* b_ptr(const Unit& u) const { return Bt + (size_t)u.pn * BM * K * 2; }
    __device__ __forceinline__ unsigned a_off(const Unit&, int) const { return 0u; }
    __device__ __forceinline__ void a_ready(const Unit&) const {}
    __device__ __forceinline__ void done(const Unit&) const {}
};

__device__ __forceinline__ unsigned cvt_pk_bf16(float lo, float hi) { unsigned r; asm volatile("v_cvt_pk_bf16_f32 %0, %1, %2" : "=v"(r) : "v"(lo), "v"(hi)); return r; }

template <class Epi, class Sched, bool ALIGN_EPI, bool GATHER>
__device__ __forceinline__ void gemm_phase(PG8_LAS unsigned char* lds, const int K, const Sched& S, const Epi& E, const int wid) {
    int lane_ = lane_id(); asm volatile("" : "+v"(lane_));
    const int lane = lane_, tid = wid * 64 + lane, wr = wid >> 2, wc = wid & 3, fr = lane & 15, fq = lane >> 4;
    const int nt = K / BK;
    unsigned voffB[2]; int RA[2], CA[2];
#pragma unroll
    for (int i = 0; i < 2; ++i) { int R, C; stage_rc(tid * 16 + i * 8192, R, C); const int Rb = Epi::PERM ? ((R & ~31) + perm32(R & 31)) : R;
        RA[i] = R; CA[i] = C; voffB[i] = (unsigned)(Rb * K + C) * 2u; }
    const size_t kstep = (size_t)(BK * 2);
    const size_t hstep = (size_t)HALF * K * 2;
    const unsigned ldsw = (unsigned)wid * 1024u;
    const int aoff = lds_byte(wr * 64 + fr, fq * 8), boff = lds_byte(wc * 32 + fr, fq * 8);
#define PG8_SA(b, h) (((b) * 2 + (h)) * HTB)
#define PG8_SB(b, h) ((4 + (b) * 2 + (h)) * HTB)
#define PG8_STAGE(bufoff, gbase, voff) do { _Pragma("unroll") for (int _i = 0; _i < 2; ++_i) \
        __builtin_amdgcn_global_load_lds((const unsigned*)((const char*)(gbase) + (voff)[_i]), (PG8_LAS unsigned*)(lds + (bufoff) + ldsw + _i * 8192), 16, 0, 0); } while (0)
#define PG8_LDA(dst, b, h) do { _Pragma("unroll") for (int m = 0; m < 4; ++m) _Pragma("unroll") for (int k = 0; k < 2; ++k) dst[m][k] = *(const PG8_LAS bf16x8*)(lds + PG8_SA(b, h) + aoff + m * 2048 + k * 1024); } while (0)
#define PG8_LDB(dst, b, h) do { _Pragma("unroll") for (int n = 0; n < 2; ++n) _Pragma("unroll") for (int k = 0; k < 2; ++k) dst[n][k] = *(const PG8_LAS bf16x8*)(lds + PG8_SB(b, h) + boff + n * 2048 + k * 1024); } while (0)
#define PG8_MMA(ai, bj, At, Bt) do { __builtin_amdgcn_s_setprio(1); _Pragma("unroll") for (int m = 0; m < 4; ++m) _Pragma("unroll") for (int n = 0; n < 2; ++n) _Pragma("unroll") for (int k = 0; k < 2; ++k) \
        acc[ai][bj][m][n] = __builtin_amdgcn_mfma_f32_16x16x32_bf16(Bt[n][k], At[m][k], acc[ai][bj][m][n], 0, 0, 0); __builtin_amdgcn_s_setprio(0); } while (0)
#define PG8_WAIT_V(n) asm volatile("s_waitcnt vmcnt(" #n ")" ::: "memory")
#define PG8_WAIT_L(n) asm volatile("s_waitcnt lgkmcnt(" #n ")" ::: "memory")
#define PG8_BAR __builtin_amdgcn_s_barrier()
#define PG8_SCHED __builtin_amdgcn_sched_barrier(0)
#define PG8_OFFS(dst, u) do { _Pragma("unroll") for (int _h = 0; _h < 2; ++_h) _Pragma("unroll") for (int _i = 0; _i < 2; ++_i) \
        dst[_h][_i] = GATHER ? (S.a_off(u, _h * HALF + RA[_i]) + (unsigned)CA[_i] * 2u) : (unsigned)(((_h * HALF + RA[_i]) * K + CA[_i]) * 2); } while (0)
    Unit cur, nxt; int ui = 0;
    if (!S.next(0, cur)) return;
    f32x4 acc[2][2][4][2];
#pragma unroll
    for (int a = 0; a < 2; ++a)
#pragma unroll
        for (int b = 0; b < 2; ++b)
#pragma unroll
            for (int m = 0; m < 4; ++m)
#pragma unroll
                for (int n = 0; n < 2; ++n) acc[a][b][m][n] = (f32x4){0.f, 0.f, 0.f, 0.f};
    bf16x8 At[4][2], B0[2][2], B1[2][2];
    unsigned offA[2][2], offAn[2][2];
    PG8_OFFS(offA, cur);
    const char* cA = S.a_ptr(cur); const char* cB = S.b_ptr(cur);
    S.a_ready(cur);
    PG8_STAGE(PG8_SB(0, 0), cB, voffB); PG8_STAGE(PG8_SB(0, 1), cB + hstep, voffB); PG8_STAGE(PG8_SA(0, 0), cA, offA[0]); PG8_STAGE(PG8_SA(0, 1), cA, offA[1]);
    if (wr == 1) PG8_BAR;
    PG8_WAIT_V(2); PG8_BAR;
    PG8_STAGE(PG8_SB(1, 0), cB + kstep, voffB); PG8_STAGE(PG8_SA(1, 0), cA + kstep, offA[0]); PG8_STAGE(PG8_SB(1, 1), cB + hstep + kstep, voffB);
    PG8_WAIT_V(6); PG8_BAR;
    for (;;) {
        const bool has_next = S.next(ui + 1, nxt);
        const char* nA = has_next ? S.a_ptr(nxt) : cA; const char* nB = has_next ? S.b_ptr(nxt) : cB;
        if (GATHER && has_next) { PG8_OFFS(offAn, nxt); }
        else {
#pragma unroll
            for (int h = 0; h < 2; ++h)
#pragma unroll
                for (int i = 0; i < 2; ++i) offAn[h][i] = offA[h][i]; }
        for (int t = 0; t < nt; t += 2) {
            const bool last = (t == nt - 2);
            const char* a1 = cA + (size_t)(t + 1) * kstep;
            const char* a2 = last ? nA : cA + (size_t)(t + 2) * kstep; const char* b2 = last ? nB : cB + (size_t)(t + 2) * kstep;
            const char* a3 = a2 + kstep; const char* b3 = b2 + kstep;
            unsigned o2[2][2];
#pragma unroll
            for (int h = 0; h < 2; ++h)
#pragma unroll
                for (int i = 0; i < 2; ++i) o2[h][i] = (GATHER && last) ? offAn[h][i] : offA[h][i];
            if (last && has_next) S.a_ready(nxt);
            PG8_LDB(B0, 0, 0); PG8_LDB(B1, 0, 1); PG8_SCHED; PG8_LDA(At, 0, 0); PG8_STAGE(PG8_SA(1, 1), a1, offA[1]);
            PG8_WAIT_V(8); PG8_WAIT_L(0); PG8_BAR; PG8_MMA(0, 0, At, B0); PG8_MMA(0, 1, At, B1); PG8_BAR; PG8_SCHED;
            PG8_LDA(At, 0, 1); PG8_STAGE(PG8_SB(0, 0), b2, voffB); PG8_STAGE(PG8_SB(0, 1), b2 + hstep, voffB); PG8_STAGE(PG8_SA(0, 0), a2, o2[0]);
            PG8_WAIT_V(8); PG8_WAIT_L(0); PG8_BAR; PG8_MMA(1, 0, At, B0); PG8_MMA(1, 1, At, B1); PG8_BAR; PG8_SCHED;
            PG8_LDB(B0, 1, 0); PG8_LDB(B1, 1, 1); PG8_SCHED; PG8_LDA(At, 1, 0); PG8_STAGE(PG8_SA(0, 1), a2, o2[1]);
            PG8_WAIT_V(8); PG8_WAIT_L(0); PG8_BAR; PG8_MMA(0, 0, At, B0); PG8_MMA(0, 1, At, B1); PG8_BAR; PG8_SCHED;
            PG8_LDA(At, 1, 1); PG8_STAGE(PG8_SB(1, 0), b3, voffB); PG8_STAGE(PG8_SB(1, 1), b3 + hstep, voffB); PG8_STAGE(PG8_SA(1, 0), a3, o2[0]);
            PG8_WAIT_V(8); PG8_WAIT_L(0); PG8_BAR; PG8_MMA(1, 0, At, B0); PG8_MMA(1, 1, At, B1); PG8_BAR; PG8_SCHED;
        }
        if constexpr (ALIGN_EPI) { if (wr == 0) PG8_BAR; }
        { int fr2 = fr, fq2 = fq; asm volatile("" : "+v"(fr2), "+v"(fq2));
          E(acc, cur, wr, wc, fr2, fq2); } S.done(cur);
        if (!has_next) break;
#pragma unroll
        for (int a = 0; a < 2; ++a)
#pragma unroll
            for (int b = 0; b < 2; ++b)
#pragma unroll
                for (int m = 0; m < 4; ++m)
#pragma unroll
                    for (int n = 0; n < 2; ++n) acc[a][b][m][n] = (f32x4){0.f, 0.f, 0.f, 0.f};
        cur = nxt; cA = nA; cB = nB; ++ui;
#pragma unroll
        for (int h = 0; h < 2; ++h)
#pragma unroll
            for (int i = 0; i < 2; ++i) offA[h][i] = offAn[h][i];
        if constexpr (ALIGN_EPI) { if (wr == 1) PG8_BAR; }
    }
    PG8_WAIT_V(0);
    if constexpr (!ALIGN_EPI) { if (wr == 0) PG8_BAR; }
    PG8_BAR;
#undef PG8_SA
#undef PG8_SB
#undef PG8_STAGE
#undef PG8_LDA
#undef PG8_LDB
#undef PG8_MMA
#undef PG8_WAIT_V
#undef PG8_WAIT_L
#undef PG8_BAR
#undef PG8_SCHED
#undef PG8_OFFS
}
}
namespace pg8 {
__device__ __forceinline__ float fsigmoid(float x) { return __builtin_amdgcn_rcpf(1.0f + __builtin_amdgcn_exp2f(-LOG2E * x)); }
__device__ __forceinline__ u32x4 pack8(const f32x4 a, const f32x4 b) { u32x4 w; w.x = cvt_pk_bf16(a[0], a[1]); w.y = cvt_pk_bf16(a[2], a[3]); w.z = cvt_pk_bf16(b[0], b[1]); w.w = cvt_pk_bf16(b[2], b[3]); return w; }
__device__ __forceinline__ void unpack8(const u32x4 w, f32x4& a, f32x4& b) {
    a[0] = __uint_as_float(w.x << 16); a[1] = __uint_as_float(w.x & 0xffff0000u); a[2] = __uint_as_float(w.y << 16); a[3] = __uint_as_float(w.y & 0xffff0000u);
    b[0] = __uint_as_float(w.z << 16); b[1] = __uint_as_float(w.z & 0xffff0000u); b[2] = __uint_as_float(w.w << 16); b[3] = __uint_as_float(w.w & 0xffff0000u); }

struct EpiQK {
    static constexpr bool PERM = true;
    bf16 *qsb, *ksb;
    __device__ __forceinline__ void operator()(const f32x4 (&acc)[2][2][4][2], const Unit& u, int wr, int wc, int fr, int fq) const {
        const int pn = u.pn; const int row0 = u.pm * BM + wr * 64 + fr; const int cin = wc * 32 + 8 * fq;
        bf16* O = pn < 4 ? qsb : ksb; const float sc = pn < 4 ? SB_C2 : 1.0f; const int colt = (pn & 3) * 256;
#pragma unroll
        for (int ai = 0; ai < 2; ++ai)
#pragma unroll
            for (int m = 0; m < 4; ++m) { bf16* rowp = O + (size_t)(row0 + ai * HALF + m * 16) * 1024 + colt + cin;
#pragma unroll
                for (int bj = 0; bj < 2; ++bj) *(u32x4*)(rowp + bj * HALF) = pack8(acc[ai][bj][m][0] * sc, acc[ai][bj][m][1] * sc); }
    }
};
struct EpiRot {
    static constexpr bool PERM = true;
    bf16 *qr, *kr, *krt; const float *cosT, *sinT;
    __device__ __forceinline__ void operator()(const f32x4 (&acc)[2][2][4][2], const Unit& u, int wr, int wc, int fr, int fq) const {
        const int pn = u.pn; const int row0 = u.pm * BM + wr * 64 + fr; const int cin = wc * 32 + 8 * fq;
        const bool isK = pn >= 4; const int head = pn & 3; bf16* O = isK ? kr : qr; const float sc = isK ? 1.0f : 0.0625f;
#pragma unroll
        for (int ai = 0; ai < 2; ++ai)
#pragma unroll
            for (int m = 0; m < 4; ++m) { const int row = row0 + ai * HALF + m * 16; const int pos = row & (SEQ - 1);
                f32x4 o1[2], o2[2];
#pragma unroll
                for (int n = 0; n < 2; ++n) { const f32x4 c = *(const f32x4*)(cosT + pos * 128 + cin + 4 * n), s = *(const f32x4*)(sinT + pos * 128 + cin + 4 * n);
                    const f32x4 x1 = acc[ai][0][m][n], x2 = acc[ai][1][m][n]; o1[n] = (x1 * c - x2 * s) * sc; o2[n] = (x1 * s + x2 * c) * sc; }
                bf16* rowp = O + (size_t)row * 1024 + head * 256 + cin;
                const u32x4 w1 = pack8(o1[0], o1[1]), w2 = pack8(o2[0], o2[1]);
                *(u32x4*)(rowp) = w1; *(u32x4*)(rowp + HALF) = w2;
                if (isK) {
                    bf16* tp = krt + (size_t)(head * 256 + cin) * NTOK + row;
#pragma unroll
                    for (int q = 0; q < 4; ++q) { tp[(size_t)(2 * q) * NTOK] = (bf16)(w1[q] & 0xffffu); tp[(size_t)(2 * q + 1) * NTOK] = (bf16)(w1[q] >> 16);
                        tp[(size_t)(HALF + 2 * q) * NTOK] = (bf16)(w2[q] & 0xffffu); tp[(size_t)(HALF + 2 * q + 1) * NTOK] = (bf16)(w2[q] >> 16); }
                }
                asm volatile("" ::: "memory"); }
    }
};
struct EpiGate {
    static constexpr bool PERM = true;
    unsigned char* ws;
    __device__ __forceinline__ void operator()(const f32x4 (&acc)[2][2][4][2], const Unit& u, int wr, int wc, int fr, int fq) const {
        const int pn = u.pn; const int row0 = u.pm * BM + wr * 64 + fr; const int cin = wc * 32 + 8 * fq;
        const bool silu = pn < 8; bf16* O = (bf16*)(ws + WS_SG + (size_t)(silu ? 0 : 1) * (WS_GSB - WS_SG) + (size_t)(pn >= 12 ? 1 : 0) * (WS_GRET - WS_GSB));
        const int ld = silu ? 2048 : 1024; const int colt = (silu ? pn : (pn & 3)) * 256;
#pragma unroll
        for (int ai = 0; ai < 2; ++ai)
#pragma unroll
            for (int m = 0; m < 4; ++m) { bf16* rowp = O + (size_t)(row0 + ai * HALF + m * 16) * ld + colt + cin;
#pragma unroll
                for (int bj = 0; bj < 2; ++bj) { f32x4 a = acc[ai][bj][m][0], b = acc[ai][bj][m][1];
#pragma unroll
                    for (int e = 0; e < 4; ++e) { const float sa = fsigmoid(a[e]), sb = fsigmoid(b[e]); a[e] = silu ? a[e] * sa : sa; b[e] = silu ? b[e] * sb : sb; }
                    *(u32x4*)(rowp + bj * HALF) = pack8(a, b); }
                asm volatile("" ::: "memory"); }
    }
};
struct EpiVT {
    static constexpr bool PERM = true;
    bf16 *vsbt, *vrt;
    __device__ __forceinline__ void operator()(const f32x4 (&acc)[2][2][4][2], const Unit& u, int wr, int wc, int fr, int fq) const {
        const int f0 = u.pm * BM + wr * 64 + fr; const int tcol = u.pn * BM + wc * 32 + 8 * fq;
        float dec[8];
        if (u.pm < 4) {
#pragma unroll
            for (int q = 0; q < 8; ++q) dec[q] = 1.0f;
        } else { const int h = (u.pm - 4) >> 1; const float l2g = __builtin_amdgcn_logf(1.0f - __builtin_amdgcn_exp2f(-5.0f - (float)h));
#pragma unroll
            for (int q = 0; q < 8; ++q) dec[q] = __builtin_amdgcn_exp2f((float)(63 - (((wc & 1) * 32 + 8 * fq + q) & 63)) * l2g); }
        bf16* O = u.pm < 4 ? vsbt : (vrt - (size_t)1024 * NTOK);
#pragma unroll
        for (int ai = 0; ai < 2; ++ai)
#pragma unroll
            for (int m = 0; m < 4; ++m) { bf16* rowp = O + (size_t)(f0 + ai * HALF + m * 16) * NTOK + tcol;
#pragma unroll
                for (int bj = 0; bj < 2; ++bj) { f32x4 a = acc[ai][bj][m][0], b = acc[ai][bj][m][1];
#pragma unroll
                    for (int e = 0; e < 4; ++e) { a[e] *= dec[e]; b[e] *= dec[4 + e]; }
                    *(u32x4*)(rowp + bj * HALF) = pack8(a, b); } }
    }
};
template <int MODE> struct EpiBranch {
    static constexpr bool PERM = true;
    const bf16* gate; const bf16* m1in; bf16* out;
    __device__ __forceinline__ void operator()(const f32x4 (&acc)[2][2][4][2], const Unit& u, int wr, int wc, int fr, int fq) const {
        const int row0 = u.pm * BM + wr * 64 + fr; const int col0 = u.pn * BM + wc * 32 + 8 * fq;
#pragma unroll
        for (int ai = 0; ai < 2; ++ai)
#pragma unroll
            for (int m = 0; m < 4; ++m) { const size_t ro = (size_t)(row0 + ai * HALF + m * 16) * 1024 + col0;
#pragma unroll
                for (int bj = 0; bj < 2; ++bj) { f32x4 ga, gb; unpack8(*(const u32x4*)(gate + ro + bj * HALF), ga, gb);
                    f32x4 a = acc[ai][bj][m][0] * ga, b = acc[ai][bj][m][1] * gb;
                    if (MODE == 1) { f32x4 pa, pb; unpack8(*(const u32x4*)(m1in + ro + bj * HALF), pa, pb); a += pa; b += pb; }
                    *(u32x4*)(out + ro + bj * HALF) = pack8(a, b); }
                asm volatile("" ::: "memory"); }
    }
};
struct EpiPre {
    static constexpr bool PERM = false;
    const float* x; float* pre;
    __device__ __forceinline__ void operator()(const f32x4 (&acc)[2][2][4][2], const Unit& u, int wr, int wc, int fr, int fq) const {
        const int row0 = u.pm * BM + wr * 64 + fr, col0 = u.pn * BM + wc * 32 + 4 * fq;
#pragma unroll
        for (int ai = 0; ai < 2; ++ai)
#pragma unroll
            for (int m = 0; m < 4; ++m) { const size_t ro = (size_t)(row0 + ai * HALF + m * 16) * 1024 + col0;
#pragma unroll
                for (int bj = 0; bj < 2; ++bj)
#pragma unroll
                    for (int n = 0; n < 2; ++n) { const size_t o = ro + bj * HALF + n * 16; *(f32x4*)(pre + o) = *(const f32x4*)(x + o) * DN_ALPHA + acc[ai][bj][m][n]; }
                asm volatile("" ::: "memory"); }
    }
};
struct EpiGateUp {
    static constexpr bool PERM = true;
    const float* bgu; bf16* act;
    __device__ __forceinline__ void operator()(const f32x4 (&acc)[2][2][4][2], const Unit& u, int wr, int wc, int fr, int fq) const {
        const int ff0 = u.pn * 128 + wc * 32 + 8 * fq; const float* bp = bgu + (size_t)u.e * 2048 + ff0;
#pragma unroll
        for (int ai = 0; ai < 2; ++ai)
#pragma unroll
            for (int m = 0; m < 4; ++m) { const int rr = ai * HALF + wr * 64 + m * 16 + fr;
                f32x4 bg[2], bu[2];
#pragma unroll
                for (int n = 0; n < 2; ++n) { bg[n] = *(const f32x4*)(bp + 4 * n); bu[n] = *(const f32x4*)(bp + 1024 + 4 * n); }
                f32x4 o[2];
#pragma unroll
                for (int n = 0; n < 2; ++n) { const f32x4 g = acc[ai][0][m][n] + bg[n], up = acc[ai][1][m][n] + bu[n];
#pragma unroll
                    for (int e = 0; e < 4; ++e) { const float gg = fminf(g[e], 7.0f), uu = fminf(fmaxf(up[e], -7.0f), 7.0f); o[n][e] = (uu + 1.0f) * gg * fsigmoid(1.702f * gg); } }
                if (rr < u.nrows) *(u32x4*)(act + (size_t)(u.rbase + rr) * 1024 + ff0) = pack8(o[0], o[1]);
                asm volatile("" ::: "memory"); }
    }
};
struct EpiDown {
    static constexpr bool PERM = true;
    const float* bdn; const int* rowtk; const float* roww; bf16* outr;
    __device__ __forceinline__ void operator()(const f32x4 (&acc)[2][2][4][2], const Unit& u, int wr, int wc, int fr, int fq) const {
        const int col0 = u.pn * BM + wc * 32 + 8 * fq; const float* bp = bdn + (size_t)u.e * 1024 + col0;
        const size_t lbase = (size_t)u.e * CAP + u.pm;
#pragma unroll
        for (int ai = 0; ai < 2; ++ai)
#pragma unroll
            for (int m = 0; m < 4; ++m) { const int rr = ai * HALF + wr * 64 + m * 16 + fr;
                if (rr < u.nrows) { const int tk = rowtk[lbase + rr]; const float w = roww[lbase + rr]; bf16* rowp = outr + (size_t)tk * 1024 + col0;
#pragma unroll
                    for (int bj = 0; bj < 2; ++bj) { const f32x4 b0 = *(const f32x4*)(bp + bj * HALF), b1 = *(const f32x4*)(bp + bj * HALF + 4);
                        *(u32x4*)(rowp + bj * HALF) = pack8((acc[ai][bj][m][0] + b0) * w, (acc[ai][bj][m][1] + b1) * w); } }
                asm volatile("" ::: "memory"); }
    }
};
}
#define GAS __attribute__((address_space(1)))
#define LAS __attribute__((address_space(3)))
typedef GAS unsigned gu32;
#define RLX_AGENT __ATOMIC_RELAXED, __HIP_MEMORY_SCOPE_AGENT
constexpr int NWAVES = 8;
constexpr int RING_OFF = 0, RING_BYTES = 131072;
constexpr int LDSCTL_OFF = RING_BYTES;
constexpr int LDS_TAB_OFF = RING_BYTES + 1024;
constexpr int LDS_BYTES = LDS_TAB_OFF + 24 * 256 * 4;
static_assert(LDS_BYTES <= 163840, "LDS");

#define XB_TMO      128
#define XB_XCNT(j)  (256  + 64 * (j))
#define XB_XSUB(j)  (1280 + 64 * (j))
#define XB_XGEN(j)  (2304 + 64 * (j))
#define XB_TOP      3328
#define XB_TOPGEN   3392
#define XCD_BAR_WORDS 3456
#define XB_SPIN_CAP (1u << 18)
__device__ __forceinline__ unsigned xb_ld(unsigned* p)              { return __hip_atomic_load(p, __ATOMIC_RELAXED, __HIP_MEMORY_SCOPE_AGENT); }
__device__ __forceinline__ unsigned xb_add(unsigned* p, unsigned v) { return __hip_atomic_fetch_add(p, v, __ATOMIC_RELAXED, __HIP_MEMORY_SCOPE_AGENT); }
__device__ __forceinline__ unsigned xb_xcc_id() { return (unsigned)__builtin_amdgcn_s_getreg((3 << 11) | 20) & 0xFu; }
#define XB_SPIN(cond, bar) do { unsigned _sp = 0; while (cond) { __builtin_amdgcn_s_sleep(1); \
    if ((++_sp & 255u) == 0u) { if (xb_ld(&(bar)[XB_TMO])) break; if (_sp > XB_SPIN_CAP) { atomicAdd(&(bar)[XB_TMO], 1u); break; } } } } while (0)
struct XcdBarrier { unsigned* bar; unsigned x; volatile LAS unsigned* st; };
__device__ __forceinline__ XcdBarrier xcd_barrier_post(unsigned* bar, volatile LAS unsigned* st) {
    XcdBarrier b; b.bar = bar; b.x = xb_xcc_id(); b.st = st;
    if (threadIdx.x == 0) (void)xb_add(&bar[XB_XCNT(b.x)], 1u);
    return b;
}
__device__ __forceinline__ void xcd_barrier_complete(unsigned* bar, unsigned x, unsigned& nloc, unsigned& nx) {
    const unsigned G = gridDim.x * gridDim.y * gridDim.z;
    unsigned sum, cnt, mine, sp = 0u;
    for (;;) {
        sum = 0u; cnt = 0u; mine = 0u;
#pragma unroll
        for (unsigned j = 0; j < 16; ++j) { const unsigned c = xb_ld(&bar[XB_XCNT(j)]); sum += c; cnt += (c > 0u) ? 1u : 0u; mine = (j == x) ? c : mine; }
        if (sum == G) break;
        __builtin_amdgcn_s_sleep(1);
        if ((++sp & 255u) == 0u) { if (xb_ld(&bar[XB_TMO])) break; if (sp > XB_SPIN_CAP) { atomicAdd(&bar[XB_TMO], 1u); break; } }
    }
    nloc = mine > 0u ? mine : 1u; nx = cnt > 0u ? cnt : 1u;
}
__device__ __forceinline__ void xcd_barrier(const XcdBarrier& b) {
    asm volatile("s_waitcnt vmcnt(0)" ::: "memory");
    __syncthreads();
    if (threadIdx.x == 0) {
        unsigned* bar = b.bar;
        __builtin_amdgcn_s_waitcnt(0);
        unsigned nloc = b.st[0], nx = b.st[1];
        if (nloc == 0u) { xcd_barrier_complete(bar, b.x, nloc, nx); b.st[0] = nloc; b.st[1] = nx; }
        const unsigned old = xb_add(&bar[XB_XSUB(b.x)], 1u);
        const unsigned gen = old / nloc;
        if (old + 1u == (gen + 1u) * nloc) {
            __builtin_amdgcn_fence(__ATOMIC_RELEASE, "agent");
            asm volatile("s_waitcnt vmcnt(0)" ::: "memory");
            const unsigned og = xb_add(&bar[XB_TOP], 1u);
            const unsigned tg = og / nx;
            if (og + 1u == (tg + 1u) * nx) xb_add(&bar[XB_TOPGEN], 1u);
            else XB_SPIN(xb_ld(&bar[XB_TOPGEN]) == tg, bar);
            __builtin_amdgcn_fence(__ATOMIC_ACQUIRE, "agent");
            xb_add(&bar[XB_XGEN(b.x)], 1u);
            asm volatile("s_waitcnt vmcnt(0)" ::: "memory");
        } else {
            XB_SPIN(xb_ld(&bar[XB_XGEN(b.x)]) == gen, bar);
            __builtin_amdgcn_fence(__ATOMIC_ACQUIRE, "agent");
            asm volatile("s_waitcnt vmcnt(0)" ::: "memory");
        }
    }
    __syncthreads();
}

struct Frame {
    LAS unsigned char* lds; volatile LAS unsigned* LC;
    unsigned* ctl;
    int wave, vcu, G;
    Bufs B;
};
#define FWS(T, off) ((T*)(F.B.ws + (off)))
#define FDO(T, off) ((T*)((unsigned char*)F.B.out + (off)))
#define LDS_WAIT() asm volatile("s_waitcnt lgkmcnt(0)" ::: "memory")
#define VM_WAIT() asm volatile("s_waitcnt vmcnt(0)" ::: "memory")

__device__ __forceinline__ f32x16 mfma32(bf16x8 a, bf16x8 b, f32x16 c) { return __builtin_amdgcn_mfma_f32_32x32x16_bf16(a, b, c, 0, 0, 0); }
__device__ __forceinline__ int crow(int r, int hi) { return (r & 3) + 8 * (r >> 2) + 4 * hi; }
__device__ __forceinline__ float swap_lo(float x, float& hi_out) { auto rr = __builtin_amdgcn_permlane32_swap(__float_as_uint(x), __float_as_uint(x), false, false); hi_out = __uint_as_float(rr[1]); return __uint_as_float(rr[0]); }
__device__ __forceinline__ bf16x8 pack_frag(const f32x16& v, int base) {
    u32x4 w; w.x = pg8::cvt_pk_bf16(v[base + 0], v[base + 1]); w.y = pg8::cvt_pk_bf16(v[base + 2], v[base + 3]); w.z = pg8::cvt_pk_bf16(v[base + 4], v[base + 5]); w.w = pg8::cvt_pk_bf16(v[base + 6], v[base + 7]);
    return __builtin_bit_cast(bf16x8, w); }
__device__ __forceinline__ bf16x8 join8(u32x2 a, u32x2 b) { u32x4 w; w.x = a.x; w.y = a.y; w.z = b.x; w.w = b.y; return __builtin_bit_cast(bf16x8, w); }
__device__ __forceinline__ float ret_l2g(int h) { return __builtin_amdgcn_logf(1.0f - __builtin_amdgcn_exp2f(-5.0f - (float)h)); }

__device__ __forceinline__ void tr_item(const float* src, int lds_, int k0, int c0, bf16* dst, int K, int r0, LAS unsigned char* scr, int lane) {
    const int kr = lane >> 4, nq = lane & 15;
    f32x4 v[4][4];
#pragma unroll
    for (int gI = 0; gI < 4; ++gI)
#pragma unroll
        for (int i = 0; i < 4; ++i) v[gI][i] = *(const f32x4*)(src + (size_t)(k0 + 16 * gI + 4 * kr + i) * lds_ + c0 + 4 * nq);
#pragma unroll
    for (int gI = 0; gI < 4; ++gI)
#pragma unroll
        for (int e = 0; e < 4; ++e) { u32x2 w; w.x = pk2(v[gI][0][e], v[gI][1][e]); w.y = pk2(v[gI][2][e], v[gI][3][e]);
            *(LAS u32x2*)(scr + (4 * nq + e) * 144 + 32 * gI + 8 * kr) = w; }
    LDS_WAIT(); asm volatile("" ::: "memory");
#pragma unroll
    for (int it = 0; it < 8; ++it) { const int n = it * 8 + (lane >> 3), ch = lane & 7;
        const u32x4 w = *(const LAS u32x4*)(scr + n * 144 + ch * 16);
        *(u32x4*)(dst + (size_t)(r0 + n) * K + k0 + 8 * ch) = w; }
    LDS_WAIT(); asm volatile("" ::: "memory");
}
__device__ __forceinline__ void p0_prologue(Frame& F) {
    const Bufs& B = F.B; const int lane_ = lane_id(), tid_ = F.wave * 64 + lane_;
    const int gw = F.vcu * NWAVES + F.wave, NGW = F.G * NWAVES;
    { const f32x4* xs = (const f32x4*)B.x; u32x4* xd = FDO(u32x4, DO_XB); const size_t n8 = (size_t)NTOK * DM / 8;
      for (size_t i = (size_t)blockIdx.x * 512 + tid_; i < n8; i += (size_t)F.G * 512) { const f32x4 a = xs[2 * i], b = xs[2 * i + 1];
          u32x4 w; w.x = pk2(a[0], a[1]); w.y = pk2(a[2], a[3]); w.z = pk2(b[0], b[1]); w.w = pk2(b[2], b[3]); xd[i] = w; } }
    LAS unsigned char* scr = F.lds + RING_OFF + F.wave * 9216;
    constexpr int I_IN = 16 * (INW / 64)  , I_BSB = 256, I_BRET = 32 * 16, I_OUT = 256, I_GU = 32 * 16 * 32, I_DN = 32 * 16 * 16;
    constexpr int NITEMS = I_IN + I_BSB + I_BRET + I_OUT + I_GU + I_DN;
    for (int it = gw; it < NITEMS; it += NGW) {
        int r = it;
        if (r < I_IN) { const int kb = r / (INW / 64), nb = r % (INW / 64); const int c0 = nb * 64; bf16* dst; int r0;
            if (c0 < 2048) { dst = FWS(bf16, WS_WINT); r0 = c0; } else if (c0 < 3072) { dst = FWS(bf16, WS_WVT); r0 = c0 - 2048; }
            else if (c0 < 5120) { dst = FWS(bf16, WS_WINT); r0 = 2048 + c0 - 3072; } else if (c0 < 7168) { dst = FWS(bf16, WS_WVT); r0 = 1024 + c0 - 5120; }
            else { dst = FWS(bf16, WS_WINT); r0 = 4096 + c0 - 7168; }
            tr_item(B.w_in, INW, kb * 64, c0, dst, 1024, r0, scr, lane_); continue; } r -= I_IN;
        if (r < I_BSB) { tr_item(B.w_bsb, 1024, (r >> 4) * 64, (r & 15) * 64, FWS(bf16, WS_WBSBT), 1024, (r & 15) * 64, scr, lane_); continue; } r -= I_BSB;
        if (r < I_BRET) { tr_item(B.w_bret, 1024, (r >> 4) * 64, (r & 15) * 64, FWS(bf16, WS_WBRETT), 2048, (r & 15) * 64, scr, lane_); continue; } r -= I_BRET;
        if (r < I_OUT) { tr_item(B.w_out, 1024, (r >> 4) * 64, (r & 15) * 64, FWS(bf16, WS_WOUTT), 1024, (r & 15) * 64, scr, lane_); continue; } r -= I_OUT;
        if (r < I_GU) { const int e = r >> 9, q = r & 511, kb = q >> 5, nb = q & 31; const int c0 = nb * 64; const int bj = c0 >> 10, rem = c0 & 1023, ct = rem >> 7, i0 = rem & 127;
            tr_item(B.w_gu + (size_t)e * 1024 * 2048, 2048, kb * 64, c0, FWS(bf16, WS_WGUT) + (size_t)e * 2048 * 1024, 1024, 256 * ct + 128 * bj + i0, scr, lane_); continue; } r -= I_GU;
        { const int e = r >> 8, q = r & 255, kb = q >> 4, nb = q & 15;
          tr_item(B.w_dn + (size_t)e * 1024 * 1024, 1024, kb * 64, nb * 64, FWS(bf16, WS_WDT) + (size_t)e * 1024 * 1024, 1024, nb * 64, scr, lane_); }
    }
    { float* ct = FWS(float, WS_COS); float* st = FWS(float, WS_SIN);
      for (int i = blockIdx.x * 512 + tid_; i < SEQ * 128; i += F.G * 512) { const int pos = i >> 7, j = i & 127; const float ang = (float)pos * rope_inv_freq(j);
          ct[i] = (float)cos((double)ang); st[i] = (float)sin((double)ang); } }
    { bf16* wrt = FWS(bf16, WS_WRT);
      for (int i = blockIdx.x * 512 + tid_; i < 32 * 1024; i += F.G * 512) { const int k = i & 1023, e = i >> 10; wrt[i] = f2bf(B.w_router[k * 32 + e]); } }
}
__device__ __forceinline__ void attn_wave_unit(const bf16* __restrict__ KSB, const bf16* __restrict__ VSBT, bf16* QY, int b, int h, int qb, int lane) {
    const int r32 = lane & 31, hi = lane >> 5;
    const int t0 = qb * 32; const size_t rb = (size_t)b * SEQ; const int tq = t0 + r32;
    bf16x8 qf[4];
    { const bf16* qp = QY + (rb + t0 + r32) * 1024 + h * 64 + 8 * hi;
#pragma unroll
      for (int d0 = 0; d0 < 4; ++d0) qf[d0] = *(const bf16x8*)(qp + 16 * d0); }
    f32x16 o0 = {}, o1 = {};
    float carry = 1.0f;
    const bf16* vrow0 = VSBT + (size_t)(h * 64 + r32) * NTOK + rb;
    for (int tile = 0;; ++tile) {
        const int ks = t0 + 32 - 64 * (tile + 1);
        const int kc0 = max(ks + r32, 0), kc1 = max(ks + 32 + r32, 0);
        const bf16* kp0 = KSB + (rb + kc0) * 1024 + h * 64 + 8 * hi; const bf16* kp1 = KSB + (rb + kc1) * 1024 + h * 64 + 8 * hi;
        f32x16 p0 = {}, p1 = {};
#pragma unroll
        for (int d0 = 0; d0 < 4; ++d0) { const bf16x8 a0 = *(const bf16x8*)(kp0 + 16 * d0), a1 = *(const bf16x8*)(kp1 + 16 * d0);
            p0 = mfma32(a0, qf[d0], p0); p1 = mfma32(a1, qf[d0], p1); }
        bf16x8 vf[2][4];
#pragma unroll
        for (int s = 0; s < 4; ++s) { const int ta = max(ks + 16 * s + 4 * hi, 0), tb = max(ks + 16 * s + 8 + 4 * hi, 0);
#pragma unroll
            for (int db = 0; db < 2; ++db) { const bf16* vp = vrow0 + (size_t)db * 32 * NTOK; vf[db][s] = join8(*(const u32x2*)(vp + ta), *(const u32x2*)(vp + tb)); } }
        f32x16 u0, u1;
        const bool need_mask = (tile == 0) || (ks < 0);
#pragma unroll
        for (int r = 0; r < 16; ++r) { const float e0 = __builtin_amdgcn_exp2f(fminf(p0[r], 100.0f)), e1 = __builtin_amdgcn_exp2f(fminf(p1[r], 100.0f));
            u0[r] = __builtin_amdgcn_rcpf(1.0f + e0); u1[r] = __builtin_amdgcn_rcpf(1.0f + e1); p0[r] = e0 * u0[r]; p1[r] = e1 * u1[r]; }
        if (need_mask) {
#pragma unroll
            for (int r = 0; r < 16; ++r) { const int s0 = ks + crow(r, hi), s1 = s0 + 32;
                const bool v0 = (s0 >= 0) && (s0 < tq), v1 = (s1 >= 0) && (s1 < tq);
                u0[r] = v0 ? u0[r] : 1.0f; p0[r] = v0 ? p0[r] : 0.0f; u1[r] = v1 ? u1[r] : 1.0f; p1[r] = v1 ? p1[r] : 0.0f; }
        }
        float R[8], Rhi[8], T[8];
#pragma unroll
        for (int g = 0; g < 4; ++g) { R[g] = (u0[4 * g] * u0[4 * g + 1]) * (u0[4 * g + 2] * u0[4 * g + 3]); R[4 + g] = (u1[4 * g] * u1[4 * g + 1]) * (u1[4 * g + 2] * u1[4 * g + 3]); }
#pragma unroll
        for (int a = 0; a < 8; ++a) { float rh; const float rl = swap_lo(R[a], rh); Rhi[a] = rh; T[a] = rl * rh; }
        float X[8]; X[7] = 1.0f;
#pragma unroll
        for (int a = 6; a >= 0; --a) X[a] = X[a + 1] * T[a + 1];
        const float total = X[0] * T[0];
#pragma unroll
        for (int a = 0; a < 8; ++a) { const float ec = X[a] * (hi == 0 ? Rhi[a] : 1.0f) * carry; const int g = a & 3;
            if (a < 4) { const float w2 = u0[4 * g + 3], w1 = w2 * u0[4 * g + 2], w0 = w1 * u0[4 * g + 1];
                p0[4 * g + 3] *= ec; p0[4 * g + 2] *= w2 * ec; p0[4 * g + 1] *= w1 * ec; p0[4 * g] *= w0 * ec; }
            else { const float w2 = u1[4 * g + 3], w1 = w2 * u1[4 * g + 2], w0 = w1 * u1[4 * g + 1];
                p1[4 * g + 3] *= ec; p1[4 * g + 2] *= w2 * ec; p1[4 * g + 1] *= w1 * ec; p1[4 * g] *= w0 * ec; } }
        carry *= total;
#pragma unroll
        for (int s = 0; s < 4; ++s) { const bf16x8 pf = (s < 2) ? pack_frag(p0, 8 * (s & 1)) : pack_frag(p1, 8 * (s & 1));
            o0 = mfma32(vf[0][s], pf, o0); o1 = mfma32(vf[1][s], pf, o1); }
        if (ks <= 0) break;
        if (__all(carry < 1.0e-37f)) break;
    }
    bf16* op = QY + (rb + t0 + r32) * 1024 + h * 64 + 4 * hi;
#pragma unroll
    for (int g = 0; g < 4; ++g) { u32x2 w; w.x = pg8::cvt_pk_bf16(o0[4 * g], o0[4 * g + 1]); w.y = pg8::cvt_pk_bf16(o0[4 * g + 2], o0[4 * g + 3]); *(u32x2*)(op + 8 * g) = w;
        u32x2 w2; w2.x = pg8::cvt_pk_bf16(o1[4 * g], o1[4 * g + 1]); w2.y = pg8::cvt_pk_bf16(o1[4 * g + 2], o1[4 * g + 3]); *(u32x2*)(op + 32 + 8 * g) = w2; }
}
__device__ __forceinline__ void attn_phase(Frame& F) {
    const int gw = F.vcu * NWAVES + F.wave, NGW = F.G * NWAVES;
    for (int wu = gw; wu < BATCH * SBH * (SEQ / 32); wu += NGW) { const int qb = wu & 255, bh = wu >> 8;
        attn_wave_unit(FWS(bf16, WS_KSB), FWS(bf16, WS_VSBT), FWS(bf16, WS_QSB), bh >> 4, bh & 15, qb, lane_id()); }
}

__device__ __forceinline__ int swap23(int m) { return (m & ~12) | ((m & 4) << 1) | ((m & 8) >> 1); }
__device__ __forceinline__ void scan_phase(Frame& F) {
    if (F.vcu >= BATCH * RH * 16) return;
    const int lane = lane_id(), w = F.wave, r32 = lane & 31, hi = lane >> 5;
    const int bh = F.vcu >> 4, vs = F.vcu & 15, b = bh >> 2, h = bh & 3;
    const float l2g = ret_l2g(h), cd = __builtin_amdgcn_exp2f(64.0f * l2g);
    const bf16* ktp = FDO(bf16, DO_KRT) + (size_t)(h * 256 + 32 * w + swap23(r32)) * NTOK + (size_t)b * SEQ + 8 * hi;
    const bf16* vtp = FWS(bf16, WS_VRT) + (size_t)(h * 512 + 32 * vs + r32) * NTOK + (size_t)b * SEQ + 8 * hi;
    const bf16* qp = FWS(bf16, WS_QR) + ((size_t)b * SEQ + r32) * 1024 + h * 256 + 32 * w + 8 * hi;
    bf16* yp = FWS(bf16, WS_YINT) + (size_t)b * SEQ * 2048 + h * 512 + 32 * vs + r32;
    LAS float* part = (LAS float*)(F.lds + RING_OFF);
    f32x16 S = {};
    bf16x8 kf[4], vf[4], qf[2][2];
#define SCAN_LOAD(c) do { _Pragma("unroll") for (int s = 0; s < 4; ++s) { kf[s] = *(const bf16x8*)(ktp + (c) * 64 + 16 * s); vf[s] = *(const bf16x8*)(vtp + (c) * 64 + 16 * s); } \
        _Pragma("unroll") for (int ib = 0; ib < 2; ++ib) _Pragma("unroll") for (int s = 0; s < 2; ++s) qf[ib][s] = *(const bf16x8*)(qp + (size_t)((c) * 64 + 32 * ib) * 1024 + 16 * s); } while (0)
    SCAN_LOAD(0);
    for (int c = 0; c < NCHUNK; ++c) {
        const bf16x8 sb0 = pack_frag(S, 0), sb1 = pack_frag(S, 8);
        f32x16 y0 = {}, y1 = {};
        y0 = mfma32(qf[0][0], sb0, y0); y0 = mfma32(qf[0][1], sb1, y0);
        y1 = mfma32(qf[1][0], sb0, y1); y1 = mfma32(qf[1][1], sb1, y1);
        LAS float* pb = part + (c & 1) * 16384 + (w * 32) * 64 + lane;
#pragma unroll
        for (int r = 0; r < 16; ++r) { pb[r * 64] = y0[r]; pb[(16 + r) * 64] = y1[r]; }
#pragma unroll
        for (int r = 0; r < 16; ++r) S[r] *= cd;
#pragma unroll
        for (int s = 0; s < 4; ++s) S = mfma32(kf[s], vf[s], S);
        if (c + 1 < NCHUNK) SCAN_LOAD(c + 1);
        LDS_WAIT(); __builtin_amdgcn_s_barrier(); asm volatile("" ::: "memory");
        const LAS float* rbp = part + (c & 1) * 16384 + lane;
#pragma unroll
        for (int k = 0; k < 4; ++k) { const int idx = 4 * w + k, ib = idx >> 4, r = idx & 15; float acc = 0.f;
#pragma unroll
            for (int w2 = 0; w2 < 8; ++w2) acc += rbp[(w2 * 32 + idx) * 64];
            const int i = 32 * ib + crow(r, hi);
            yp[(size_t)(c * 64 + i) * 2048] = f2bf(acc * __builtin_amdgcn_exp2f((float)(i + 1) * l2g)); }
    }
#undef SCAN_LOAD
    LDS_WAIT(); __syncthreads();
}

__device__ __forceinline__ void intra_phase(Frame& F) {
    const int lane = lane_id(), w = F.wave, r32 = lane & 31, hi = lane >> 5;
    LAS float* red = (LAS float*)(F.lds + RING_OFF);
    int parity = 0;
    for (int un = F.vcu * 8; un < F.vcu * 8 + 8 && un < BATCH * RH * NCHUNK; ++un, parity ^= 1) {
        const int c = un & 127, h = (un >> 7) & 3, b = un >> 9;
        const size_t tok0 = (size_t)b * SEQ + c * 64; const float l2g = ret_l2g(h);
        f32x16 X00 = {}, X01 = {}, X10 = {}, X11 = {};
        { const bf16* kp = FWS(bf16, WS_KR) + (tok0 + r32) * 1024 + h * 256 + 8 * hi; const bf16* qp = FWS(bf16, WS_QR) + (tok0 + r32) * 1024 + h * 256 + 8 * hi;
#pragma unroll 4
          for (int s = 0; s < 16; ++s) { const bf16x8 k0 = *(const bf16x8*)(kp + 16 * s), k1 = *(const bf16x8*)(kp + 32 * 1024 + 16 * s), q0 = *(const bf16x8*)(qp + 16 * s), q1 = *(const bf16x8*)(qp + 32 * 1024 + 16 * s);
              X00 = mfma32(k0, q0, X00); X01 = mfma32(k0, q1, X01); X10 = mfma32(k1, q0, X10); X11 = mfma32(k1, q1, X11); } }
#pragma unroll
        for (int r = 0; r < 16; ++r) { const int j0 = crow(r, hi), j1 = 32 + j0, i0 = r32, i1 = 32 + r32;
            X00[r] *= __builtin_amdgcn_exp2f((float)((j0 <= i0 ? i0 - j0 : j0 - i0) - 63 + j0) * l2g);
            X01[r] *= __builtin_amdgcn_exp2f((float)((j0 <= i1 ? i1 - j0 : j0 - i1) - 63 + j0) * l2g);
            X10[r] *= __builtin_amdgcn_exp2f((float)((j1 <= i0 ? i0 - j1 : j1 - i0) - 63 + j1) * l2g);
            X11[r] *= __builtin_amdgcn_exp2f((float)((j1 <= i1 ? i1 - j1 : j1 - i1) - 63 + j1) * l2g); }
        bf16x8 pf[2][4];
        pf[0][0] = pack_frag(X00, 0); pf[0][1] = pack_frag(X00, 8); pf[0][2] = pack_frag(X10, 0); pf[0][3] = pack_frag(X10, 8);
        pf[1][0] = pack_frag(X01, 0); pf[1][1] = pack_frag(X01, 8); pf[1][2] = pack_frag(X11, 0); pf[1][3] = pack_frag(X11, 8);
        f32x16 Y[2][2] = {};
        { const bf16* vp = FWS(bf16, WS_VRT) + (size_t)(h * 512 + 64 * w + r32) * NTOK + tok0 + 4 * hi;
#pragma unroll
          for (int vb = 0; vb < 2; ++vb)
#pragma unroll
              for (int ks = 0; ks < 4; ++ks) { const bf16* p = vp + (size_t)vb * 32 * NTOK + 16 * ks; const bf16x8 vfr = join8(*(const u32x2*)(p), *(const u32x2*)(p + 8));
                  Y[vb][0] = mfma32(vfr, pf[0][ks], Y[vb][0]); Y[vb][1] = mfma32(vfr, pf[1][ks], Y[vb][1]); } }
        bf16* yrow = FWS(bf16, WS_YINT) + (tok0 + r32) * 2048 + h * 512 + 64 * w + 4 * hi;
        const bf16* srow = FWS(bf16, WS_SG) + (tok0 + r32) * 2048 + h * 512 + 64 * w + 4 * hi;
        float s1[2] = {0.f, 0.f}, s2[2] = {0.f, 0.f};
#pragma unroll
        for (int ib = 0; ib < 2; ++ib)
#pragma unroll
            for (int vb = 0; vb < 2; ++vb)
#pragma unroll
                for (int g = 0; g < 4; ++g) { const u32x2 wv = *(const u32x2*)(yrow + (size_t)ib * 32 * 2048 + 32 * vb + 8 * g);
                    const float a0 = __uint_as_float(wv.x << 16), a1 = __uint_as_float(wv.x & 0xffff0000u), a2 = __uint_as_float(wv.y << 16), a3 = __uint_as_float(wv.y & 0xffff0000u);
                    Y[vb][ib][4 * g] += a0; Y[vb][ib][4 * g + 1] += a1; Y[vb][ib][4 * g + 2] += a2; Y[vb][ib][4 * g + 3] += a3;
#pragma unroll
                    for (int e = 0; e < 4; ++e) { const float y = Y[vb][ib][4 * g + e]; s1[ib] += y; s2[ib] += y * y; } }
        LAS float* rp = red + parity * 1024;
#pragma unroll
        for (int ib = 0; ib < 2; ++ib) { float h1, h2; const float l1 = swap_lo(s1[ib], h1), l2 = swap_lo(s2[ib], h2);
            if (hi == 0) { rp[(w * 64 + 32 * ib + r32) * 2] = l1 + h1; rp[(w * 64 + 32 * ib + r32) * 2 + 1] = l2 + h2; } }
        LDS_WAIT(); __builtin_amdgcn_s_barrier(); asm volatile("" ::: "memory");
#pragma unroll
        for (int ib = 0; ib < 2; ++ib) { float t1 = 0.f, t2 = 0.f;
#pragma unroll
            for (int w2 = 0; w2 < 8; ++w2) { t1 += rp[(w2 * 64 + 32 * ib + r32) * 2]; t2 += rp[(w2 * 64 + 32 * ib + r32) * 2 + 1]; }
            const float mean = t1 * (1.0f / 512.0f), var = fmaxf(t2 * (1.0f / 512.0f) - mean * mean, 0.0f), rstd = __builtin_amdgcn_rsqf(var + LN_EPS);
#pragma unroll
            for (int vb = 0; vb < 2; ++vb)
#pragma unroll
                for (int g = 0; g < 4; ++g) { const size_t o = (size_t)ib * 32 * 2048 + 32 * vb + 8 * g; const u32x2 sv = *(const u32x2*)(srow + o);
                    const float g0 = __uint_as_float(sv.x << 16), g1 = __uint_as_float(sv.x & 0xffff0000u), g2 = __uint_as_float(sv.y << 16), g3 = __uint_as_float(sv.y & 0xffff0000u);
                    u32x2 ov; ov.x = pg8::cvt_pk_bf16(g0 * (Y[vb][ib][4 * g] - mean) * rstd, g1 * (Y[vb][ib][4 * g + 1] - mean) * rstd);
                    ov.y = pg8::cvt_pk_bf16(g2 * (Y[vb][ib][4 * g + 2] - mean) * rstd, g3 * (Y[vb][ib][4 * g + 3] - mean) * rstd);
                    *(u32x2*)(yrow + o) = ov; } }
    }
    LDS_WAIT(); __syncthreads();
}
__device__ __forceinline__ void ln1_router_phase(Frame& F) {
    const Bufs& B = F.B;
    if (F.vcu >= NTOK / 256) return;
    const int lane = lane_id(), w = F.wave, r32 = lane & 31, hi = lane >> 5; const int tid_ = w * 64 + lane;
    const int rowbase = F.vcu * 256 + 32 * w;
    volatile LAS unsigned* hist = F.LC + 96; volatile LAS unsigned* basew = F.LC + 128;
    if (tid_ < 32) hist[tid_] = 0u;
    __syncthreads();
    { f32x4 gv[4], bv[4];
#pragma unroll
      for (int j = 0; j < 4; ++j) { gv[j] = *(const f32x4*)(B.ln1_g + 4 * lane + 256 * j); bv[j] = *(const f32x4*)(B.ln1_b + 4 * lane + 256 * j); }
      for (int rr = 0; rr < 32; ++rr) { float* p = B.out + (size_t)(rowbase + rr) * 1024 + 4 * lane; bf16* xb = FWS(bf16, WS_X1B) + (size_t)(rowbase + rr) * 1024 + 4 * lane;
          f32x4 v[4]; float s = 0.f;
#pragma unroll
          for (int j = 0; j < 4; ++j) { v[j] = *(const f32x4*)(p + 256 * j); s += (v[j][0] + v[j][1]) + (v[j][2] + v[j][3]); }
          const float mean = wave_sum(s) * (1.f / 1024.f); float s2 = 0.f;
#pragma unroll
          for (int j = 0; j < 4; ++j) { v[j] = v[j] - mean; s2 += (v[j][0] * v[j][0] + v[j][1] * v[j][1]) + (v[j][2] * v[j][2] + v[j][3] * v[j][3]); }
          const float rstd = rsqrtf(wave_sum(s2) * (1.f / 1024.f) + LN_EPS);
#pragma unroll
          for (int j = 0; j < 4; ++j) { const f32x4 y = v[j] * rstd * gv[j] + bv[j]; *(f32x4*)(p + 256 * j) = y;
              u32x2 o; o.x = pg8::cvt_pk_bf16(y[0], y[1]); o.y = pg8::cvt_pk_bf16(y[2], y[3]); *(u32x2*)(xb + 256 * j) = o; } } }
    VM_WAIT();
    f32x16 acc[4] = {};
    { const bf16* ap = FWS(bf16, WS_WRT) + (size_t)r32 * 1024 + 8 * hi; const bf16* bp = FWS(bf16, WS_X1B) + (size_t)(rowbase + r32) * 1024 + 8 * hi;
#pragma unroll 4
      for (int s = 0; s < 64; s += 4) {
#pragma unroll
          for (int q = 0; q < 4; ++q) acc[q] = mfma32(*(const bf16x8*)(ap + 16 * (s + q)), *(const bf16x8*)(bp + 16 * (s + q)), acc[q]); } }
    float lo[16], hv[16];
#pragma unroll
    for (int r = 0; r < 16; ++r) { const float x = (acc[0][r] + acc[1][r]) + (acc[2][r] + acc[3][r]) + B.b_router[crow(r, hi)]; float h_; lo[r] = swap_lo(x, h_); hv[r] = h_; }
    int se[4]; float sv[4];
#pragma unroll
    for (int kk = 0; kk < 4; ++kk) { float best = -INFINITY; int bi = 0;
#pragma unroll
        for (int g = 0; g < 4; ++g) {
#pragma unroll
            for (int e = 0; e < 4; ++e) { if (lo[4 * g + e] > best) { best = lo[4 * g + e]; bi = 8 * g + e; } }
#pragma unroll
            for (int e = 0; e < 4; ++e) { if (hv[4 * g + e] > best) { best = hv[4 * g + e]; bi = 8 * g + 4 + e; } } }
        se[kk] = bi; sv[kk] = best;
#pragma unroll
        for (int r = 0; r < 16; ++r) { if (bi == crow(r, 0)) lo[r] = -INFINITY; if (bi == crow(r, 1)) hv[r] = -INFINITY; } }
    const float e1 = __expf(sv[1] - sv[0]), e2 = __expf(sv[2] - sv[0]), e3 = __expf(sv[3] - sv[0]); const float inv = 1.f / (1.f + e1 + e2 + e3);
    const float wts[4] = {inv, e1 * inv, e2 * inv, e3 * inv};
    const int tok = rowbase + r32;
    const int ea = hi ? se[2] : se[0], eb = hi ? se[3] : se[1]; const float wa = hi ? wts[2] : wts[0], wb = hi ? wts[3] : wts[1]; const int ka = hi ? 2 : 0, kb = ka + 1;
    FWS(int, WS_SELE)[tok * 4 + ka] = ea; FWS(int, WS_SELE)[tok * 4 + kb] = eb; FWS(float, WS_SELW)[tok * 4 + ka] = wa; FWS(float, WS_SELW)[tok * 4 + kb] = wb;
    const unsigned ra = __hip_atomic_fetch_add((LAS unsigned*)hist + ea, 1u, __ATOMIC_RELAXED, __HIP_MEMORY_SCOPE_WORKGROUP);
    const unsigned rb_ = __hip_atomic_fetch_add((LAS unsigned*)hist + eb, 1u, __ATOMIC_RELAXED, __HIP_MEMORY_SCOPE_WORKGROUP);
    LDS_WAIT(); __syncthreads();
    if (tid_ < 32) basew[tid_] = __hip_atomic_fetch_add(F.ctl + CW_CNT + 64 * tid_, hist[tid_], RLX_AGENT);
    LDS_WAIT(); __syncthreads();
    { const unsigned pa = basew[ea] + ra, pb = basew[eb] + rb_;
      FWS(int, WS_ROWTK)[(size_t)ea * CAP + pa] = tok * 4 + ka; FWS(float, WS_ROWW)[(size_t)ea * CAP + pa] = wa;
      FWS(int, WS_ROWTK)[(size_t)eb * CAP + pb] = tok * 4 + kb; FWS(float, WS_ROWW)[(size_t)eb * CAP + pb] = wb; }
}

template <bool GU> struct MoeOrder {
    const char* A; const char* W; volatile LAS int* ts; volatile LAS unsigned* cntl; const LAS unsigned* tab; int c;
    __device__ bool next(int i, pg8::Unit& u) const {
        const int x = c & 7, k = c >> 3, q = 8 * i + x;
        const int rt = GU ? (4 * q + (k >> 3)) : (8 * q + (k >> 2));
        if (rt >= ts[NEXP]) return false;
        int e = 0;
        for (int j = 1; j < NEXP; ++j) e += (rt >= ts[j]) ? 1 : 0;
        u.pn = GU ? (k & 7) : (k & 3); u.e = e; u.idx = i; u.rbase = rt * 256; u.pm = (rt - ts[e]) * 256;
        const int left = (int)cntl[e] - u.pm; u.nrows = left < 256 ? left : 256; return true;
    }
    __device__ __forceinline__ const char* a_ptr(const pg8::Unit& u) const { return GU ? A : A + (size_t)u.rbase * 1024 * 2; }
    __device__ __forceinline__ const char* b_ptr(const pg8::Unit& u) const { return W + ((size_t)u.e * (GU ? 2048 : 1024) + (size_t)u.pn * 256) * 1024 * 2; }
    __device__ __forceinline__ unsigned a_off(const pg8::Unit& u, int row) const { return tab[u.idx * 256 + row]; }
    __device__ __forceinline__ void a_ready(const pg8::Unit&) const {}
    __device__ __forceinline__ void done(const pg8::Unit&) const {}
};
__device__ __forceinline__ void moe_setup(Frame& F) {
    const int tid_ = F.wave * 64 + lane_id();
    volatile LAS int* ts = (volatile LAS int*)(F.LC + 16); volatile LAS unsigned* cntl = F.LC + 64;
    if (tid_ < 32) cntl[tid_] = __hip_atomic_load(F.ctl + CW_CNT + 64 * tid_, RLX_AGENT);
    LDS_WAIT(); __syncthreads();
    if (tid_ == 0) { int acc = 0; for (int e = 0; e < NEXP; ++e) { ts[e] = acc; acc += (int)((cntl[e] + 255u) >> 8); } ts[NEXP] = acc; }
    LDS_WAIT(); __syncthreads();
}

__device__ __forceinline__ void final_phase(Frame& F) {
    const Bufs& B = F.B; const int lane = lane_id();
    const int gw = F.vcu * NWAVES + F.wave, NGW = F.G * NWAVES;
    f32x4 gv[4], bv[4];
#pragma unroll
    for (int j = 0; j < 4; ++j) { gv[j] = *(const f32x4*)(B.ln2_g + 4 * lane + 256 * j); bv[j] = *(const f32x4*)(B.ln2_b + 4 * lane + 256 * j); }
    for (int row = gw; row < NTOK; row += NGW) { float* p = B.out + (size_t)row * 1024 + 4 * lane; const bf16* orow = FWS(bf16, WS_OUTR) + (size_t)row * 4096 + 4 * lane;
        f32x4 v[4]; float s = 0.f;
#pragma unroll
        for (int j = 0; j < 4; ++j) { v[j] = *(const f32x4*)(p + 256 * j) * DN_ALPHA;
#pragma unroll
            for (int kk = 0; kk < 4; ++kk) { const u32x2 wv = *(const u32x2*)(orow + kk * 1024 + 256 * j);
                v[j][0] += __uint_as_float(wv.x << 16); v[j][1] += __uint_as_float(wv.x & 0xffff0000u); v[j][2] += __uint_as_float(wv.y << 16); v[j][3] += __uint_as_float(wv.y & 0xffff0000u); }
            s += (v[j][0] + v[j][1]) + (v[j][2] + v[j][3]); }
        const float mean = wave_sum(s) * (1.f / 1024.f); float s2 = 0.f;
#pragma unroll
        for (int j = 0; j < 4; ++j) { v[j] = v[j] - mean; s2 += (v[j][0] * v[j][0] + v[j][1] * v[j][1]) + (v[j][2] * v[j][2] + v[j][3] * v[j][3]); }
        const float rstd = rsqrtf(wave_sum(s2) * (1.f / 1024.f) + LN_EPS);
#pragma unroll
        for (int j = 0; j < 4; ++j) *(f32x4*)(p + 256 * j) = v[j] * rstd * gv[j] + bv[j]; }
}

constexpr int NPHASE = 11;
struct MArgs { Bufs B; int ph_lo, ph_hi; };
__global__ void __launch_bounds__(NWAVES * 64, 2) mega_fwd(MArgs args) {
    extern __shared__ __attribute__((aligned(16))) unsigned char lds[];
    Frame F;
    F.lds = (LAS unsigned char*)lds; F.LC = (volatile LAS unsigned*)(F.lds + LDSCTL_OFF);
    F.wave = __builtin_amdgcn_readfirstlane((int)threadIdx.x >> 6);
    F.G = gridDim.x; { const int bx = blockIdx.x; F.vcu = (F.G % 8 == 0) ? (bx % 8) * (F.G / 8) + bx / 8 : bx; }
    F.B = args.B; F.ctl = (unsigned*)(args.B.ws + WS_CTL);
    for (int u = threadIdx.x; u < 256; u += NWAVES * 64) F.LC[u] = 0u;
    __syncthreads();
    const int lo = args.ph_lo, hi = args.ph_hi;
    const bool multi = (hi - lo) > 1;
    XcdBarrier bar; bar.bar = F.ctl + CW_BAR; bar.x = 0; bar.st = nullptr;
    if (multi) bar = xcd_barrier_post(F.ctl + CW_BAR, F.LC);
#ifndef PH_COMPILE
#define PH_COMPILE 0x7FF
#endif
#define IN(k) ((((PH_COMPILE) >> (k)) & 1) && lo <= (k) && (k) < hi)
#define SEAM(k) do { if (IN(k) && IN((k) + 1)) xcd_barrier(bar); } while (0)
    LAS unsigned char* ring = F.lds + RING_OFF;
    const int c = (int)blockIdx.x;
    if (IN(0)) { p0_prologue(F); } SEAM(0);
    if (IN(1)) {
        { pg8::StaticOrder S; S.init(FDO(bf16, DO_XB), FWS(bf16, WS_WINT), NTOK, 2048, 1024, F.G, c);
          pg8::EpiQK E{FWS(bf16, WS_QSB), FWS(bf16, WS_KSB)};
          pg8::gemm_phase<pg8::EpiQK, pg8::StaticOrder, true, false>(ring, 1024, S, E, F.wave); }
        { pg8::StaticOrder S; S.init(FDO(bf16, DO_XB), FWS(bf16, WS_WINT) + (size_t)2048 * 1024, NTOK, 2048, 1024, F.G, c);
          pg8::EpiRot E{FWS(bf16, WS_QR), FWS(bf16, WS_KR), FDO(bf16, DO_KRT), FWS(float, WS_COS), FWS(float, WS_SIN)};
          pg8::gemm_phase<pg8::EpiRot, pg8::StaticOrder, true, false>(ring, 1024, S, E, F.wave); }
        { pg8::StaticOrder S; S.init(FDO(bf16, DO_XB), FWS(bf16, WS_WINT) + (size_t)4096 * 1024, NTOK, 4096, 1024, F.G, c);
          pg8::EpiGate E{F.B.ws};
          pg8::gemm_phase<pg8::EpiGate, pg8::StaticOrder, true, false>(ring, 1024, S, E, F.wave); }
        { pg8::StaticOrder S; S.init(FWS(bf16, WS_WVT), FDO(bf16, DO_XB), 3072, NTOK, 1024, F.G, c);
          pg8::EpiVT E{FWS(bf16, WS_VSBT), FWS(bf16, WS_VRT)};
          pg8::gemm_phase<pg8::EpiVT, pg8::StaticOrder, true, false>(ring, 1024, S, E, F.wave); }
    } SEAM(1);
    if (IN(2)) { attn_phase(F); } SEAM(2);
    if (IN(3)) { scan_phase(F); } SEAM(3);
    if (IN(4)) { intra_phase(F); } SEAM(4);
    if (IN(5)) {
        { pg8::StaticOrder S; S.init(FWS(bf16, WS_QSB), FWS(bf16, WS_WBSBT), NTOK, 1024, 1024, F.G, c);
          pg8::EpiBranch<0> E{FWS(bf16, WS_GSB), nullptr, FWS(bf16, WS_M1)};
          pg8::gemm_phase<pg8::EpiBranch<0>, pg8::StaticOrder, true, false>(ring, 1024, S, E, F.wave); }
        { pg8::StaticOrder S; S.init(FWS(bf16, WS_YINT), FWS(bf16, WS_WBRETT), NTOK, 1024, 2048, F.G, c);
          pg8::EpiBranch<1> E{FWS(bf16, WS_GRET), FWS(bf16, WS_M1), FWS(bf16, WS_MG)};
          pg8::gemm_phase<pg8::EpiBranch<1>, pg8::StaticOrder, true, false>(ring, 2048, S, E, F.wave); }
    } SEAM(5);
    if (IN(6)) { pg8::StaticOrder S; S.init(FWS(bf16, WS_MG), FWS(bf16, WS_WOUTT), NTOK, 1024, 1024, F.G, c);
        pg8::EpiPre E{F.B.x, F.B.out};
        pg8::gemm_phase<pg8::EpiPre, pg8::StaticOrder, true, false>(ring, 1024, S, E, F.wave); } SEAM(6);
    if (IN(7)) { ln1_router_phase(F); } SEAM(7);
    if (IN(8)) { moe_setup(F);
        MoeOrder<true> S{(const char*)FWS(bf16, WS_X1B), (const char*)FWS(bf16, WS_WGUT), (volatile LAS int*)(F.LC + 16), F.LC + 64, (const LAS unsigned*)(F.lds + LDS_TAB_OFF), c};
        { pg8::Unit u; LAS unsigned* tab = (LAS unsigned*)(F.lds + LDS_TAB_OFF);
          const int tid_ = F.wave * 64 + lane_id();
          for (int i = 0; i < 24 && S.next(i, u); ++i) { if (tid_ < 256) { const int rr = tid_; unsigned off = 0u;
                  if (rr < u.nrows) off = (unsigned)(FWS(int, WS_ROWTK)[(size_t)u.e * CAP + u.pm + rr] >> 2) * 2048u;
                  tab[i * 256 + rr] = off; } }
          LDS_WAIT(); __syncthreads(); }
        pg8::EpiGateUp E{F.B.b_gu, FWS(bf16, WS_ACT)};
        pg8::gemm_phase<pg8::EpiGateUp, MoeOrder<true>, true, true>(ring, 1024, S, E, F.wave); } SEAM(8);
    if (IN(9)) { moe_setup(F);
        MoeOrder<false> S{(const char*)FWS(bf16, WS_ACT), (const char*)FWS(bf16, WS_WDT), (volatile LAS int*)(F.LC + 16), F.LC + 64, (const LAS unsigned*)(F.lds + LDS_TAB_OFF), c};
        pg8::EpiDown E{F.B.b_dn, FWS(int, WS_ROWTK), FWS(float, WS_ROWW), FWS(bf16, WS_OUTR)};
        pg8::gemm_phase<pg8::EpiDown, MoeOrder<false>, true, false>(ring, 1024, S, E, F.wave); } SEAM(9);
    if (IN(10)) { final_phase(F); }
#undef IN
#undef SEAM
}
#ifndef OPT_MASK
#define OPT_MASK 0x7FF
#endif
#ifndef ONE_LAUNCH
#define ONE_LAUNCH 1
#endif
template <int NB, class AF, class BF, class EF> static void launch_ngemm(hipStream_t s, int M, int N, int K, const AF& af, const BF& bf, const EF& ef) {
    GArgs<AF, BF, EF> ga; memset(&ga, 0, sizeof(ga)); ga.af = af; ga.bf = bf; ga.ef = ef; ga.M = M; ga.N = N; ga.K = K; ga.pad = 0;
    ngemm<NB, AF, BF, EF><<<dim3(N / 64, M / 64), 256, 0, s>>>(ga);
}
static void launch_tr(hipStream_t s, int grid, const float* src, int lds, int c0, int width, int K, bf16* dst, int r0) {
    TrArgs a; memset(&a, 0, sizeof(a)); a.src = src; a.dst = dst; a.lds = lds; a.c0 = c0; a.width = width; a.K = K; a.r0 = r0; a.pad = 0;
    n_tr<<<grid, 256, 0, s>>>(a);
}
static AF_rows mk_rows(const void* p, int ld) { AF_rows a; memset(&a, 0, sizeof(a)); a.A = (const bf16*)p; a.ld = ld; a.pad = 0; return a; }
static BF_wt mk_wt(const void* p, int K) { BF_wt a; memset(&a, 0, sizeof(a)); a.W = (const bf16*)p; a.K = K; a.pad = 0; return a; }
static void run_naive(const Bufs& B, hipStream_t s, int stage) {
    unsigned char* ws = B.ws;
    switch (stage) {
    case 0: {
        n_xb<<<2048, 256, 0, s>>>(B);
        bf16* wint = (bf16*)(ws + WS_WINT); bf16* wvt = (bf16*)(ws + WS_WVT);
        launch_tr(s, 1024, B.w_in, INW, 0, 2048, 1024, wint, 0);
        launch_tr(s, 1024, B.w_in, INW, 2048, 1024, 1024, wvt, 0);
        launch_tr(s, 1024, B.w_in, INW, 3072, 2048, 1024, wint, 2048);
        launch_tr(s, 1024, B.w_in, INW, 5120, 2048, 1024, wvt, 1024);
        launch_tr(s, 1024, B.w_in, INW, 7168, 4096, 1024, wint, 4096);
        launch_tr(s, 1024, B.w_bsb, 1024, 0, 1024, 1024, (bf16*)(ws + WS_WBSBT), 0);
        launch_tr(s, 1024, B.w_bret, 1024, 0, 1024, 2048, (bf16*)(ws + WS_WBRETT), 0);
        launch_tr(s, 1024, B.w_out, 1024, 0, 1024, 1024, (bf16*)(ws + WS_WOUTT), 0);
        launch_tr(s, 64, B.w_router, 32, 0, 32, 1024, (bf16*)(ws + WS_WRT), 0);
        { Tr2Args a; memset(&a, 0, sizeof(a)); a.src = B.w_gu; a.dst = (bf16*)(ws + WS_WGUT); n_tr_gu<<<4096, 256, 0, s>>>(a); }
        { Tr2Args a; memset(&a, 0, sizeof(a)); a.src = B.w_dn; a.dst = (bf16*)(ws + WS_WDT); n_tr_dn<<<4096, 256, 0, s>>>(a); }
        n_rope<<<1024, 256, 0, s>>>(B);
    } break;
    case 1: {
        BF_inproj bf; memset(&bf, 0, sizeof(bf)); bf.wint = (const bf16*)(ws + WS_WINT); bf.wvt = (const bf16*)(ws + WS_WVT); EF_inproj ef{B};
        launch_ngemm<1>(s, NTOK, INW, 1024, mk_rows((unsigned char*)B.out + DO_XB, 1024), bf, ef);
        n_rotary<<<4096, 256, 0, s>>>(B);
    } break;
    case 2: n_attn<<<BATCH * SBH * SEQ / 64, 64, 0, s>>>(B); break;
    case 3: n_scan<<<BATCH * RH * RDV, 64, 0, s>>>(B); break;
    case 4: n_intra<<<BATCH * RH * NCHUNK, 256, 0, s>>>(B); break;
    case 5: {
        { EF_m1 ef{B}; launch_ngemm<1>(s, NTOK, 1024, 1024, mk_rows(ws + WS_QSB, 1024), mk_wt(ws + WS_WBSBT, 1024), ef); }
        { EF_mg ef{B}; launch_ngemm<1>(s, NTOK, 1024, 2048, mk_rows(ws + WS_YINT, 2048), mk_wt(ws + WS_WBRETT, 2048), ef); }
    } break;
    case 6: { EF_pre ef{B}; launch_ngemm<1>(s, NTOK, 1024, 1024, mk_rows(ws + WS_MG, 1024), mk_wt(ws + WS_WOUTT, 1024), ef); } break;
    case 7: n_ln1<<<NTOK / 4, 256, 0, s>>>(B); n_router<<<NTOK / 64, 64, 0, s>>>(B); break;
    case 8: { n_tstart<<<1, 64, 0, s>>>(B); n_rowinfo<<<544, 256, 0, s>>>(B); AF_gather af{B}; BF_gu bf{B}; EF_gu ef{B}; launch_ngemm<2>(s, MAXROWS, 1024, 1024, af, bf, ef); } break;
    case 9: { n_tstart<<<1, 64, 0, s>>>(B); n_rowinfo<<<544, 256, 0, s>>>(B); AF_act af{B}; BF_dn bf{B}; EF_dn ef{B}; launch_ngemm<1>(s, MAXROWS, 1024, 1024, af, bf, ef); } break;
    case 10: n_final<<<NTOK / 4, 256, 0, s>>>(B); break;
    }
}
static void run_mega(const Bufs& B, hipStream_t s, int lo, int hi) {
    MArgs a; memset(&a, 0, sizeof(a)); a.B = B; a.ph_lo = lo; a.ph_hi = hi;
    hipLaunchKernelGGL(mega_fwd, dim3(256), dim3(NWAVES * 64), LDS_BYTES, s, a);
}

extern "C" void kernel_launch(void* const* d_in, const int* in_sizes, int n_in, void* d_out, int out_size, void* d_ws, size_t ws_size, hipStream_t stream) {
    if (n_in != 15 || out_size != NTOK * DM || ws_size < WS_END) { fprintf(stderr, "kernel_launch: unexpected shapes (n_in %d out %d ws %zu)\n", n_in, out_size, ws_size); return; }
    static int inited = 0;
    if (!inited) { inited = 1;
        if (hipFuncSetAttribute((const void*)mega_fwd, hipFuncAttributeMaxDynamicSharedMemorySize, LDS_BYTES) != hipSuccess) fprintf(stderr, "kernel_launch: hipFuncSetAttribute failed\n");
        int dev = 0, cus = 0; (void)hipGetDevice(&dev); (void)hipDeviceGetAttribute(&cus, hipDeviceAttributeMultiprocessorCount, dev);
        if (cus != 256) fprintf(stderr, "kernel_launch: built for 256 CUs, device has %d\n", cus);
        (void)hipGetLastError(); }
    Bufs B; memset(&B, 0, sizeof(B));
    B.x = (const float*)d_in[0]; B.w_in = (const float*)d_in[1]; B.w_bsb = (const float*)d_in[2]; B.w_bret = (const float*)d_in[3]; B.w_out = (const float*)d_in[4];
    B.ln1_g = (const float*)d_in[5]; B.ln1_b = (const float*)d_in[6]; B.w_router = (const float*)d_in[7]; B.b_router = (const float*)d_in[8];
    B.w_gu = (const float*)d_in[9]; B.b_gu = (const float*)d_in[10]; B.w_dn = (const float*)d_in[11]; B.b_dn = (const float*)d_in[12]; B.ln2_g = (const float*)d_in[13]; B.ln2_b = (const float*)d_in[14];
    B.out = (float*)d_out; B.ws = (unsigned char*)d_ws;
    (void)hipMemsetAsync((char*)d_ws + WS_CTL, 0, CTL_ZERO_BYTES, stream);
    if ((OPT_MASK & 0x7FF) == 0x7FF && ONE_LAUNCH) { run_mega(B, stream, 0, NPHASE); return; }
    for (int st = 0; st < NPHASE; ++st) { if ((OPT_MASK >> st) & 1) run_mega(B, stream, st, st + 1); else run_naive(B, stream, st); }
}
```

```cpp
#include <hip/hip_runtime.h>
#include <cstdio>
#include <cstdint>
#include <cstring>

constexpr int BATCH = 4, SEQ = 8192, DM = 1024, NTOK = BATCH * SEQ;
constexpr int SBH = 16, SBD = 64;
constexpr int RH = 4, RDK = 256, RDV = 512, RQK = RH * RDK  , RV = RH * RDV  ;
constexpr int CHUNK = 64, NCHUNK = SEQ / CHUNK;
constexpr int INW = 11264;
constexpr int NEXP = 32, TOPK = 4, DFF = 1024;
constexpr int CAP = NTOK;
constexpr int MAXROWS = NTOK * TOPK + NEXP * 256;
constexpr float LN_EPS = 1e-5f;
constexpr float DN_ALPHA = 1.18920711500272106672f;
constexpr float LOG2E = 1.4426950408889634f;
constexpr float SB_C2 = 0.125f * LOG2E;

typedef unsigned short bf16;
typedef float f32x4 __attribute__((ext_vector_type(4)));
typedef float f32x16 __attribute__((ext_vector_type(16)));
typedef short bf16x8 __attribute__((ext_vector_type(8)));
typedef short bf16x4 __attribute__((ext_vector_type(4)));
typedef unsigned u32x4 __attribute__((ext_vector_type(4)));
typedef unsigned u32x2 __attribute__((ext_vector_type(2)));

__host__ __device__ __forceinline__ float bf2f(bf16 v) { unsigned u = (unsigned)v << 16; return __builtin_bit_cast(float, u); }
__host__ __device__ __forceinline__ bf16 f2bf(float f) { unsigned u = __builtin_bit_cast(unsigned, f); return (bf16)((u + 0x7fffu + ((u >> 16) & 1u)) >> 16); }
__device__ __forceinline__ unsigned pk2(float lo, float hi) { return (unsigned)f2bf(lo) | ((unsigned)f2bf(hi) << 16); }

constexpr size_t MiB = 1u << 20;
constexpr size_t WS_CTL = 0, CTL_ZERO_BYTES = 1 * MiB;
constexpr size_t WS_COS = 1 * MiB, WS_SIN = 5 * MiB;
constexpr size_t WS_WRT = 9 * MiB;
constexpr size_t WS_TSTART = 9 * MiB + 512 * 1024;
constexpr size_t WS_WINT = 10 * MiB;
constexpr size_t WS_WVT = 26 * MiB;
constexpr size_t WS_WBSBT = 32 * MiB, WS_WBRETT = 34 * MiB, WS_WOUTT = 38 * MiB;
constexpr size_t WS_WGUT = 40 * MiB;
constexpr size_t WS_WDT = 168 * MiB;
constexpr size_t WS_QSB = 232 * MiB;
constexpr size_t WS_KSB = 296 * MiB;
constexpr size_t WS_VSBT = 360 * MiB;
constexpr size_t WS_YINT = 296 * MiB;
constexpr size_t WS_QR = 424 * MiB, WS_KR = 488 * MiB;
constexpr size_t WS_VRT = 552 * MiB;
constexpr size_t WS_SG = 680 * MiB;
constexpr size_t WS_GSB = 808 * MiB, WS_GRET = 872 * MiB;
constexpr size_t WS_SELE = 936 * MiB, WS_SELW = 937 * MiB;
constexpr size_t WS_ROWTK = 940 * MiB, WS_ROWW = 944 * MiB;
constexpr size_t WS_RINFO = 948 * MiB;
constexpr size_t WS_M1 = 424 * MiB, WS_MG = 488 * MiB;
constexpr size_t WS_X1B = 552 * MiB;
constexpr size_t WS_ACT = 616 * MiB;
constexpr size_t WS_OUTR = 232 * MiB;
constexpr size_t WS_END = 1024 * MiB;
static_assert(WS_ACT + (size_t)MAXROWS * 1024 * 2 <= WS_SELE, "ACT fits");
static_assert(WS_OUTR + (size_t)NTOK * 4 * 1024 * 2 <= WS_MG, "OUTR fits below MG");
constexpr size_t DO_XB = 0, DO_KRT = 64 * MiB;

__host__ __device__ __forceinline__ size_t krt_idx(int bh, int t, int d) { return ((((size_t)bh * 128 + (t >> 6)) * 4 + ((t >> 4) & 3)) * 256 + d) * 16 + (t & 15); }
__host__ __device__ __forceinline__ size_t vrt_idx(int bh, int t, int v) { return ((((size_t)bh * 128 + (t >> 6)) * 4 + ((t >> 4) & 3)) * 512 + v) * 16 + (t & 15); }
__host__ __device__ __forceinline__ size_t qrs_idx(int bh, int t, int d) { return ((((size_t)bh * 128 + (t >> 6)) * 16 + (d >> 4)) * 64 + (t & 63)) * 16 + (d & 15); }
__host__ __device__ __forceinline__ size_t yt_idx(int bh, int t, int v) { return ((((size_t)bh * 128 + (t >> 6)) * 64 + (v >> 3)) * 64 + (t & 63)) * 8 + (v & 7); }
constexpr size_t WS_QRS = 952 * MiB;
constexpr size_t DO_R = 0;
static_assert(WS_QRS + 64 * MiB <= WS_END, "QRS fits");

constexpr int CW_TMO = 0, CW_CODE = 1;
constexpr int CW_BAR = 4096;
constexpr int CW_CNT = 16384;

struct Bufs {
    const float *x, *w_in, *w_bsb, *w_bret, *w_out, *ln1_g, *ln1_b, *w_router, *b_router, *w_gu, *b_gu, *w_dn, *b_dn, *ln2_g, *ln2_b;
    float* out; unsigned char* ws;
};
#define WSP(T, off) ((T*)(B.ws + (off)))
#define DOP(T, off) ((T*)((unsigned char*)B.out + (off)))

__global__ void n_xb(Bufs B) {
    const size_t n = (size_t)NTOK * DM; bf16* xb = DOP(bf16, DO_XB);
    for (size_t i = (size_t)blockIdx.x * blockDim.x + threadIdx.x; i < n; i += (size_t)gridDim.x * blockDim.x) xb[i] = f2bf(B.x[i]);
}
struct TrArgs { const float* src; bf16* dst; int lds, c0, width, K, r0, pad; };
__global__ void n_tr(TrArgs a) {
    const float* src = a.src; bf16* dst = a.dst; const int lds = a.lds, c0 = a.c0, width = a.width, K = a.K, r0 = a.r0;
    const size_t n = (size_t)width * K;
    for (size_t i = (size_t)blockIdx.x * blockDim.x + threadIdx.x; i < n; i += (size_t)gridDim.x * blockDim.x) {
        const int k = (int)(i % K), c = (int)(i / K); dst[(size_t)(r0 + c) * K + k] = f2bf(src[(size_t)k * lds + c0 + c]); }
}
struct Tr2Args { const float* src; bf16* dst; };
__global__ void n_tr_gu(Tr2Args a) { const float* src = a.src; bf16* dst = a.dst;
    const size_t n = (size_t)NEXP * 2048 * 1024;
    for (size_t i = (size_t)blockIdx.x * blockDim.x + threadIdx.x; i < n; i += (size_t)gridDim.x * blockDim.x) {
        const int k = (int)(i % 1024); const int r = (int)((i / 1024) % 2048); const int e = (int)(i / (1024 * 2048));
        const int ct = r >> 8, bj = (r >> 7) & 1, ii = r & 127; const int c = bj * 1024 + 128 * ct + ii;
        dst[i] = f2bf(src[((size_t)e * 1024 + k) * 2048 + c]); }
}
__global__ void n_tr_dn(Tr2Args a) { const float* src = a.src; bf16* dst = a.dst;
    const size_t n = (size_t)NEXP * 1024 * 1024;
    for (size_t i = (size_t)blockIdx.x * blockDim.x + threadIdx.x; i < n; i += (size_t)gridDim.x * blockDim.x) {
        const int ff = (int)(i % 1024); const int d = (int)((i / 1024) % 1024); const int e = (int)(i / (1024 * 1024));
        dst[i] = f2bf(src[((size_t)e * 1024 + ff) * 1024 + d]); }
}
__device__ __forceinline__ float rope_inv_freq(int j) { return powf(10000.0f, -(float)j / 128.0f); }
__global__ void n_rope(Bufs B) {
    float* c = WSP(float, WS_COS); float* s = WSP(float, WS_SIN);
    for (int i = blockIdx.x * blockDim.x + threadIdx.x; i < SEQ * 128; i += gridDim.x * blockDim.x) {
        const int pos = i >> 7, j = i & 127; const float ang = (float)pos * rope_inv_freq(j);
        c[i] = (float)cos((double)ang); s[i] = (float)sin((double)ang); }
}

template <class AF, class BF, class EF> struct GArgs { AF af; BF bf; EF ef; int M, N, K, pad; };
template <int NB, class AF, class BF, class EF>
__global__ void __launch_bounds__(256) ngemm(GArgs<AF, BF, EF> ga) {
    const AF& af = ga.af; const BF& bf = ga.bf; const EF& ef = ga.ef; const int K = ga.K;
    __shared__ float As[16][65], Bs[NB][16][65];
    const int tx = threadIdx.x & 15, ty = threadIdx.x >> 4;
    const int m0 = blockIdx.y * 64, n0 = blockIdx.x * 64;
    if (!af.active(m0)) return;
    float acc[NB][4][4];
#pragma unroll
    for (int b = 0; b < NB; ++b)
#pragma unroll
        for (int i = 0; i < 4; ++i)
#pragma unroll
            for (int j = 0; j < 4; ++j) acc[b][i][j] = 0.f;
    for (int k0 = 0; k0 < K; k0 += 16) {
#pragma unroll
        for (int i = 0; i < 4; ++i) { const int idx = threadIdx.x + 256 * i; const int kk = idx & 15, mm = idx >> 4; As[kk][mm] = af(m0 + mm, k0 + kk); }
#pragma unroll
        for (int b = 0; b < NB; ++b)
#pragma unroll
            for (int i = 0; i < 4; ++i) { const int idx = threadIdx.x + 256 * i; const int kk = idx & 15, nn = idx >> 4; Bs[b][kk][nn] = bf(m0, k0 + kk, n0 + nn, b); }
        __syncthreads();
#pragma unroll
        for (int kk = 0; kk < 16; ++kk) {
            float a[4];
#pragma unroll
            for (int i = 0; i < 4; ++i) a[i] = As[kk][ty * 4 + i];
#pragma unroll
            for (int b = 0; b < NB; ++b) {
                float bb[4];
#pragma unroll
                for (int j = 0; j < 4; ++j) bb[j] = Bs[b][kk][tx * 4 + j];
#pragma unroll
                for (int i = 0; i < 4; ++i)
#pragma unroll
                    for (int j = 0; j < 4; ++j) acc[b][i][j] += a[i] * bb[j];
            }
        }
        __syncthreads();
    }
#pragma unroll
    for (int i = 0; i < 4; ++i)
#pragma unroll
        for (int j = 0; j < 4; ++j) {
            float v[NB];
#pragma unroll
            for (int b = 0; b < NB; ++b) v[b] = acc[b][i][j];
            ef(m0 + ty * 4 + i, n0 + tx * 4 + j, v);
        }
}

__device__ __forceinline__ float sigmoidf_(float x) { return 1.0f / (1.0f + __expf(-x)); }
__device__ __forceinline__ float ret_log2gamma(int h) { return log2f(1.0f - exp2f(-5.0f - (float)h)); }

struct AF_rows { const bf16* A; int ld, pad; __device__ bool active(int) const { return true; } __device__ float operator()(int m, int k) const { return bf2f(A[(size_t)m * ld + k]); } };
struct BF_inproj { const bf16 *wint, *wvt;
    __device__ float operator()(int, int k, int n, int) const {
        const bf16* row;
        if (n < 2048) row = wint + (size_t)n * 1024;
        else if (n < 3072) row = wvt + (size_t)(n - 2048) * 1024;
        else if (n < 5120) row = wint + (size_t)(2048 + n - 3072) * 1024;
        else if (n < 7168) row = wvt + (size_t)(1024 + n - 5120) * 1024;
        else row = wint + (size_t)(4096 + n - 7168) * 1024;
        return bf2f(row[k]); } };
struct EF_inproj { Bufs B;
    __device__ void operator()(int m, int n, const float (&v)[1]) const {
        const float a = v[0];
        if (n < 1024) WSP(bf16, WS_QSB)[(size_t)m * 1024 + n] = f2bf(a * SB_C2);
        else if (n < 2048) WSP(bf16, WS_KSB)[(size_t)m * 1024 + n - 1024] = f2bf(a);
        else if (n < 3072) WSP(bf16, WS_VSBT)[(size_t)(n - 2048) * NTOK + m] = f2bf(a);
        else if (n < 4096) WSP(bf16, WS_QR)[(size_t)m * 1024 + n - 3072] = f2bf(a);
        else if (n < 5120) WSP(bf16, WS_KR)[(size_t)m * 1024 + n - 4096] = f2bf(a);
        else if (n < 7168) { const int f = n - 5120, h = f >> 9; const float dec = exp2f((float)(63 - (m & 63)) * ret_log2gamma(h));
            WSP(bf16, WS_VRT)[vrt_idx((m >> 13) * 4 + h, m & (SEQ - 1), f & 511)] = f2bf(a * dec); }
        else if (n < 9216) { const int f = n - 7168; WSP(bf16, WS_SG)[yt_idx((m >> 13) * 4 + (f >> 9), m & (SEQ - 1), f & 511)] = f2bf(a * sigmoidf_(a)); }
        else if (n < 10240) WSP(bf16, WS_GSB)[(size_t)m * 1024 + n - 9216] = f2bf(sigmoidf_(a));
        else WSP(bf16, WS_GRET)[(size_t)m * 1024 + n - 10240] = f2bf(sigmoidf_(a)); } };
__global__ void n_rotary(Bufs B) {
    bf16* qr = WSP(bf16, WS_QR); bf16* kr = WSP(bf16, WS_KR); bf16* krt = DOP(bf16, DO_KRT);
    const float* ct = WSP(float, WS_COS); const float* st = WSP(float, WS_SIN);
    const size_t n = (size_t)NTOK * RH * 128;
    for (size_t i = (size_t)blockIdx.x * blockDim.x + threadIdx.x; i < n; i += (size_t)gridDim.x * blockDim.x) {
        const int j = (int)(i & 127), h = (int)((i >> 7) & 3); const int m = (int)(i >> 9); const int pos = m & (SEQ - 1);
        const float c = ct[pos * 128 + j], s = st[pos * 128 + j];
        const size_t o1 = (size_t)m * 1024 + h * 256 + j, o2 = o1 + 128;
        const int bh = (m >> 13) * 4 + h;
        { const float x1 = bf2f(qr[o1]), x2 = bf2f(qr[o2]); const bf16 r1 = f2bf((x1 * c - x2 * s) * 0.0625f), r2 = f2bf((x1 * s + x2 * c) * 0.0625f); qr[o1] = r1; qr[o2] = r2;
          WSP(bf16, WS_QRS)[qrs_idx(bh, pos, j)] = r1; WSP(bf16, WS_QRS)[qrs_idx(bh, pos, j + 128)] = r2; }
        { const float x1 = bf2f(kr[o1]), x2 = bf2f(kr[o2]); const bf16 r1 = f2bf(x1 * c - x2 * s), r2 = f2bf(x1 * s + x2 * c); kr[o1] = r1; kr[o2] = r2;
          krt[krt_idx(bh, pos, j)] = r1; krt[krt_idx(bh, pos, j + 128)] = r2; }
    }
}

__global__ void __launch_bounds__(64) n_attn(Bufs B) {
    const int gid = blockIdx.x * 64 + threadIdx.x;
    const int t = gid & (SEQ - 1), bh = gid >> 13, h = bh & 15, b = bh >> 4;
    bf16* q = WSP(bf16, WS_QSB); const bf16* k = WSP(bf16, WS_KSB); const bf16* vt = WSP(bf16, WS_VSBT);
    const size_t rb = (size_t)b * SEQ;
    float qv[64], o[64];
#pragma unroll
    for (int d = 0; d < 64; ++d) { qv[d] = bf2f(q[(rb + t) * 1024 + h * 64 + d]); o[d] = 0.f; }
    float later = 0.f;
    for (int s = t - 1; s >= 0; --s) {
        const bf16* kp = k + (rb + s) * 1024 + h * 64; float z2 = 0.f;
#pragma unroll
        for (int d = 0; d < 64; ++d) z2 += qv[d] * bf2f(kp[d]);
        const float z = z2 * 0.6931471805599453f;
        const float sp = fmaxf(z, 0.f) + log1pf(__expf(-fabsf(z)));
        const float a = __expf((z - sp) + later);
        later -= sp;
        if (a > 0.f) {
#pragma unroll
            for (int d = 0; d < 64; ++d) o[d] += a * bf2f(vt[(size_t)(h * 64 + d) * NTOK + rb + s]);
        }
    }
#pragma unroll
    for (int d = 0; d < 64; ++d) q[(rb + t) * 1024 + h * 64 + d] = f2bf(o[d]);
}

__global__ void __launch_bounds__(64) n_scan(Bufs B) {
    const int gid = blockIdx.x, v = gid & 511, h = (gid >> 9) & 3, b = gid >> 11, lane = threadIdx.x;
    const bf16* qr = WSP(bf16, WS_QR); const bf16* krt = DOP(bf16, DO_KRT); const bf16* vrt = WSP(bf16, WS_VRT); bf16* yint = WSP(bf16, WS_YINT);
    const float l2g = ret_log2gamma(h), cd = exp2f(64.f * l2g);
    float st[4] = {0.f, 0.f, 0.f, 0.f};
    for (int c = 0; c < NCHUNK; ++c) {
        const size_t tok0 = (size_t)b * SEQ + c * 64;
        for (int i = 0; i < 64; ++i) {
            const bf16* qp = qr + (tok0 + i) * 1024 + h * 256 + 4 * lane;
            float p = bf2f(qp[0]) * st[0] + bf2f(qp[1]) * st[1] + bf2f(qp[2]) * st[2] + bf2f(qp[3]) * st[3];
#pragma unroll
            for (int o = 1; o < 64; o <<= 1) p += __shfl_xor(p, o);
            if (lane == 0) yint[yt_idx(b * 4 + h, c * 64 + i, v)] = f2bf(p * exp2f((float)(i + 1) * l2g));
        }
        float ns[4] = {st[0] * cd, st[1] * cd, st[2] * cd, st[3] * cd};
        for (int j = 0; j < 64; ++j) {
            const float vv = bf2f(vrt[vrt_idx(b * 4 + h, c * 64 + j, v)]);
#pragma unroll
            for (int e = 0; e < 4; ++e) ns[e] += bf2f(krt[krt_idx(b * 4 + h, c * 64 + j, 4 * lane + e)]) * vv;
        }
#pragma unroll
        for (int e = 0; e < 4; ++e) st[e] = ns[e];
    }
}

__global__ void __launch_bounds__(256) n_intra(Bufs B) {
    __shared__ float P[64][65]; __shared__ float Y[8][512]; __shared__ float stat[8][2];
    const int gid = blockIdx.x, c = gid & 127, h = (gid >> 7) & 3, b = gid >> 9, tid = threadIdx.x;
    const bf16* qr = WSP(bf16, WS_QR); const bf16* kr = WSP(bf16, WS_KR); const bf16* vrt = WSP(bf16, WS_VRT); const bf16* sg = WSP(bf16, WS_SG); const bf16* yr = WSP(bf16, WS_YINT); bf16* rout = DOP(bf16, DO_R);
    const size_t tok0 = (size_t)b * SEQ + c * 64; const float l2g = ret_log2gamma(h);
    for (int e = tid; e < 4096; e += 256) { const int i = e >> 6, j = e & 63; float s = 0.f;
        const bf16* qp = qr + (tok0 + i) * 1024 + h * 256; const bf16* kp = kr + (tok0 + j) * 1024 + h * 256;
        for (int d = 0; d < 256; ++d) s += bf2f(qp[d]) * bf2f(kp[d]);
        const int ad = i > j ? i - j : j - i; P[i][j] = s * exp2f((float)(ad - 63 + j) * l2g); }
    __syncthreads();
    for (int i0 = 0; i0 < 64; i0 += 8) {
        for (int vv = tid; vv < 512; vv += 256) {
            float acc[8] = {0.f, 0.f, 0.f, 0.f, 0.f, 0.f, 0.f, 0.f};
            for (int j = 0; j < 64; ++j) { const float x = bf2f(vrt[vrt_idx(b * 4 + h, c * 64 + j, vv)]);
#pragma unroll
                for (int r = 0; r < 8; ++r) acc[r] += P[i0 + r][j] * x; }
#pragma unroll
            for (int r = 0; r < 8; ++r) Y[r][vv] = acc[r] + bf2f(yr[yt_idx(b * 4 + h, c * 64 + i0 + r, vv)]);
        }
        __syncthreads();
        { const int w = tid >> 6, lane = tid & 63;
          for (int r = w; r < 8; r += 4) { float s = 0.f, s2 = 0.f;
              for (int vv = lane; vv < 512; vv += 64) { const float x = Y[r][vv]; s += x; }
#pragma unroll
              for (int o = 1; o < 64; o <<= 1) s += __shfl_xor(s, o);
              const float mean = s * (1.f / 512.f);
              for (int vv = lane; vv < 512; vv += 64) { const float x = Y[r][vv] - mean; s2 += x * x; }
#pragma unroll
              for (int o = 1; o < 64; o <<= 1) s2 += __shfl_xor(s2, o);
              if (lane == 0) { stat[r][0] = mean; stat[r][1] = rsqrtf(s2 * (1.f / 512.f) + LN_EPS); } } }
        __syncthreads();
        for (int e = tid; e < 8 * 512; e += 256) { const int r = e >> 9, vv = e & 511; const size_t o = (tok0 + i0 + r) * 2048 + h * 512 + vv;
            rout[o] = f2bf(bf2f(sg[yt_idx(b * 4 + h, c * 64 + i0 + r, vv)]) * (Y[r][vv] - stat[r][0]) * stat[r][1]); }
        __syncthreads();
    }
}

struct BF_wt { const bf16* W; int K, pad; __device__ float operator()(int, int k, int n, int) const { return bf2f(W[(size_t)n * K + k]); } };
struct EF_m1 { Bufs B; __device__ void operator()(int m, int n, const float (&v)[1]) const { const size_t o = (size_t)m * 1024 + n; WSP(bf16, WS_M1)[o] = f2bf(bf2f(WSP(bf16, WS_GSB)[o]) * v[0]); } };
struct EF_mg { Bufs B; __device__ void operator()(int m, int n, const float (&v)[1]) const { const size_t o = (size_t)m * 1024 + n; WSP(bf16, WS_MG)[o] = f2bf(bf2f(WSP(bf16, WS_M1)[o]) + bf2f(WSP(bf16, WS_GRET)[o]) * v[0]); } };
struct EF_pre { Bufs B; __device__ void operator()(int m, int n, const float (&v)[1]) const { const size_t o = (size_t)m * 1024 + n; B.out[o] = DN_ALPHA * B.x[o] + v[0]; } };

__device__ __forceinline__ float wave_sum(float v) {
#pragma unroll
    for (int o = 1; o < 64; o <<= 1) v += __shfl_xor(v, o);
    return v;
}
__global__ void __launch_bounds__(256) n_ln1(Bufs B) {
    const int row = blockIdx.x * 4 + (threadIdx.x >> 6), lane = threadIdx.x & 63;
    float* p = B.out + (size_t)row * 1024; bf16* xb = WSP(bf16, WS_X1B) + (size_t)row * 1024;
    float v[16]; float s = 0.f;
#pragma unroll
    for (int j = 0; j < 16; ++j) { v[j] = p[lane + 64 * j]; s += v[j]; }
    const float mean = wave_sum(s) * (1.f / 1024.f); float s2 = 0.f;
#pragma unroll
    for (int j = 0; j < 16; ++j) { v[j] -= mean; s2 += v[j] * v[j]; }
    const float rstd = rsqrtf(wave_sum(s2) * (1.f / 1024.f) + LN_EPS);
#pragma unroll
    for (int j = 0; j < 16; ++j) { const int c = lane + 64 * j; const float y = v[j] * rstd * B.ln1_g[c] + B.ln1_b[c]; p[c] = y; xb[c] = f2bf(y); }
}
__global__ void __launch_bounds__(64) n_router(Bufs B) {
    const int tok = blockIdx.x * 64 + threadIdx.x;
    const bf16* xb = WSP(bf16, WS_X1B) + (size_t)tok * 1024; const bf16* wr = WSP(bf16, WS_WRT);
    float lg[32];
#pragma unroll
    for (int e = 0; e < 32; ++e) lg[e] = 0.f;
    for (int k = 0; k < 1024; ++k) { const float xv = bf2f(xb[k]);
#pragma unroll
        for (int e = 0; e < 32; ++e) lg[e] += xv * bf2f(wr[e * 1024 + k]); }
#pragma unroll
    for (int e = 0; e < 32; ++e) lg[e] += B.b_router[e];
    int se[4]; float sv[4];
#pragma unroll
    for (int kk = 0; kk < 4; ++kk) { float best = -INFINITY; int bi = 0;
#pragma unroll
        for (int e = 0; e < 32; ++e) { if (lg[e] > best) { best = lg[e]; bi = e; } }
        se[kk] = bi; sv[kk] = best;
#pragma unroll
        for (int e = 0; e < 32; ++e) if (e == bi) lg[e] = -INFINITY; }
    const float e1 = __expf(sv[1] - sv[0]), e2 = __expf(sv[2] - sv[0]), e3 = __expf(sv[3] - sv[0]); const float inv = 1.f / (1.f + e1 + e2 + e3);
    const float w[4] = {inv, e1 * inv, e2 * inv, e3 * inv};
    unsigned* cnt = WSP(unsigned, WS_CTL) + CW_CNT;
#pragma unroll
    for (int kk = 0; kk < 4; ++kk) { WSP(int, WS_SELE)[tok * 4 + kk] = se[kk]; WSP(float, WS_SELW)[tok * 4 + kk] = w[kk];
        const unsigned pos = atomicAdd(cnt + 64 * se[kk], 1u);
        WSP(int, WS_ROWTK)[(size_t)se[kk] * CAP + pos] = tok * 4 + kk; WSP(float, WS_ROWW)[(size_t)se[kk] * CAP + pos] = w[kk]; }
}
__global__ void n_tstart(Bufs B) {
    if (threadIdx.x == 0 && blockIdx.x == 0) { int* ts = WSP(int, WS_TSTART); const unsigned* cnt = WSP(unsigned, WS_CTL) + CW_CNT; int acc = 0;
        for (int e = 0; e < NEXP; ++e) { ts[e] = acc; acc += (int)((cnt[64 * e] + 255u) >> 8); } ts[NEXP] = acc; }
}
struct MoeRow { int e, valid, tk; float w; };
__global__ void n_rowinfo(Bufs B) {
    const int* ts = WSP(int, WS_TSTART); const unsigned* cnt = WSP(unsigned, WS_CTL) + CW_CNT; MoeRow* ri = WSP(MoeRow, WS_RINFO);
    for (int m = blockIdx.x * blockDim.x + threadIdx.x; m < MAXROWS; m += gridDim.x * blockDim.x) {
        MoeRow r; const int rt = m >> 8; int e = 0;
        while (e < NEXP - 1 && rt >= ts[e + 1]) ++e;
        const int pos = m - 256 * ts[e];
        r.e = e; r.valid = (rt < ts[NEXP]) && (pos < (int)cnt[64 * e]);
        r.tk = r.valid ? WSP(int, WS_ROWTK)[(size_t)e * CAP + pos] : 0; r.w = r.valid ? WSP(float, WS_ROWW)[(size_t)e * CAP + pos] : 0.f; ri[m] = r; }
}
struct AF_gather { Bufs B; __device__ bool active(int m0) const { return (m0 >> 8) < WSP(int, WS_TSTART)[NEXP]; }
    __device__ float operator()(int m, int k) const { const int tk = WSP(MoeRow, WS_RINFO)[m].tk; return bf2f(WSP(bf16, WS_X1B)[(size_t)(tk >> 2) * 1024 + k]); } };
struct BF_gu { Bufs B; __device__ float operator()(int m0, int k, int n, int which) const { const int e = WSP(MoeRow, WS_RINFO)[m0].e;
        const int ct = n >> 7, i = n & 127; return bf2f(WSP(bf16, WS_WGUT)[((size_t)e * 2048 + 256 * ct + 128 * which + i) * 1024 + k]); } };
__device__ __forceinline__ float moe_act(float g, float u) {
    g = fminf(g, 7.0f); u = fminf(fmaxf(u, -7.0f), 7.0f); const float glu = g * (1.0f / (1.0f + __expf(-1.702f * g))); return (u + 1.0f) * glu; }
struct EF_gu { Bufs B; __device__ void operator()(int m, int n, const float (&v)[2]) const { const MoeRow r = WSP(MoeRow, WS_RINFO)[m]; if (!r.valid) return;
        const float g = v[0] + B.b_gu[r.e * 2048 + n], u = v[1] + B.b_gu[r.e * 2048 + 1024 + n]; WSP(bf16, WS_ACT)[(size_t)m * 1024 + n] = f2bf(moe_act(g, u)); } };
struct AF_act { Bufs B; __device__ bool active(int m0) const { return (m0 >> 8) < WSP(int, WS_TSTART)[NEXP]; }
    __device__ float operator()(int m, int k) const { return WSP(MoeRow, WS_RINFO)[m].valid ? bf2f(WSP(bf16, WS_ACT)[(size_t)m * 1024 + k]) : 0.f; } };
struct BF_dn { Bufs B; __device__ float operator()(int m0, int k, int n, int) const { const int e = WSP(MoeRow, WS_RINFO)[m0].e; return bf2f(WSP(bf16, WS_WDT)[((size_t)e * 1024 + n) * 1024 + k]); } };
struct EF_dn { Bufs B; __device__ void operator()(int m, int n, const float (&v)[1]) const { const MoeRow r = WSP(MoeRow, WS_RINFO)[m]; if (!r.valid) return;
        WSP(bf16, WS_OUTR)[(size_t)r.tk * 1024 + n] = f2bf((v[0] + B.b_dn[r.e * 1024 + n]) * r.w); } };
__global__ void __launch_bounds__(256) n_final(Bufs B) {
    const int row = blockIdx.x * 4 + (threadIdx.x >> 6), lane = threadIdx.x & 63;
    float* p = B.out + (size_t)row * 1024; const bf16* orow = WSP(bf16, WS_OUTR) + (size_t)row * 4 * 1024;
    float v[16]; float s = 0.f;
#pragma unroll
    for (int j = 0; j < 16; ++j) { const int c = lane + 64 * j; float a = DN_ALPHA * p[c];
#pragma unroll
        for (int kk = 0; kk < 4; ++kk) a += bf2f(orow[kk * 1024 + c]);
        v[j] = a; s += a; }
    const float mean = wave_sum(s) * (1.f / 1024.f); float s2 = 0.f;
#pragma unroll
    for (int j = 0; j < 16; ++j) { v[j] -= mean; s2 += v[j] * v[j]; }
    const float rstd = rsqrtf(wave_sum(s2) * (1.f / 1024.f) + LN_EPS);
#pragma unroll
    for (int j = 0; j < 16; ++j) { const int c = lane + 64 * j; p[c] = v[j] * rstd * B.ln2_g[c] + B.ln2_b[c]; }
}

__device__ __forceinline__ int lane_id() { return (int)__builtin_amdgcn_mbcnt_hi(~0u, __builtin_amdgcn_mbcnt_lo(~0u, 0u)); }
namespace pg8 {
#define PG8_LAS __attribute__((address_space(3)))
constexpr int BM = 256, BK = 64, HALF = 128, HTB = HALF * BK * 2  , STAGE_BYTES = 8 * HTB, NXCD = 8, WGM = 8;
__host__ __device__ __forceinline__ int lds_byte(int r, int c) { const int st = (r >> 4) * 2 + (c >> 5), rr = r & 15, cc = c & 31, ob = rr * 64 + cc * 2; return st * 1024 + (ob ^ (((ob >> 9) & 1) << 5)); }
__host__ __device__ __forceinline__ void stage_rc(int b, int& R, int& C) { const int st = b / 1024, sb = b % 1024, swz = sb ^ (((sb >> 9) & 1) << 5); R = (st >> 1) * 16 + swz / 64; C = (st & 1) * 32 + (swz % 64) / 2; }
__host__ __device__ __forceinline__ int perm32(int rho) { const int n = rho >> 4, i = rho & 15; return 8 * (i >> 2) + 4 * n + (i & 3); }

struct Unit { int pm, pn, e, idx, rbase, nrows; };

struct StaticOrder {
    const char* A; const char* Bt; int nM, nN, nwg, G, c, K;
    __device__ void init(const void* A_, const void* Bt_, int M, int N, int K_, int G_, int c_) { A = (const char*)A_; Bt = (const char*)Bt_; nM = M / BM; nN = N / BM; nwg = nM * nN; G = G_; c = c_; K = K_; }
    __device__ bool next(int i, Unit& u) const {
        const long L = (long)i * G + c; if (L >= nwg) return false;
        int wgid = (int)L; { const int q = nwg / NXCD, r = nwg % NXCD, xcd = wgid % NXCD, off = wgid / NXCD; wgid = (xcd < r ? xcd * (q + 1) : r * (q + 1) + (xcd - r) * q) + off; }
        const int nig = WGM * nN, gid = wgid / nig, fm = gid * WGM, gsz = (nM - fm) < WGM ? (nM - fm) : WGM;
        u.pm = fm + ((wgid % nig) % gsz); u.pn = (wgid % nig) / gsz; u.e = 0; u.idx = i; u.rbase = u.pm * BM; u.nrows = BM; return true;
    }
    __device__ __forceinline__ const char* a_ptr(const Unit& u) const { return A + (size_t)u.pm * BM * K * 2; }
    __device__ __forceinline__ const char* b_ptr(const Unit& u) const { return Bt + (size_t)u.pn * BM * K * 2; }
    __device__ __forceinline__ unsigned a_off(const Unit&, int) const { return 0u; }
    __device__ __forceinline__ void a_ready(const Unit&) const {}
    __device__ __forceinline__ void done(const Unit&) const {}
};

__device__ __forceinline__ unsigned cvt_pk_bf16(float lo, float hi) { unsigned r; asm volatile("v_cvt_pk_bf16_f32 %0, %1, %2" : "=v"(r) : "v"(lo), "v"(hi)); return r; }

template <class Epi, class Sched, bool ALIGN_EPI, bool GATHER>
__device__ __forceinline__ void gemm_phase(PG8_LAS unsigned char* lds, const int K, const Sched& S, const Epi& E, const int wid) {
    int lane_ = lane_id(); asm volatile("" : "+v"(lane_));
    const int lane = lane_, tid = wid * 64 + lane, wr = wid >> 2, wc = wid & 3, fr = lane & 15, fq = lane >> 4;
    const int nt = K / BK;
    unsigned voffB[2]; int RA[2], CA[2];
#pragma unroll
    for (int i = 0; i < 2; ++i) { int R, C; stage_rc(tid * 16 + i * 8192, R, C); const int Rb = Epi::PERM ? ((R & ~31) + perm32(R & 31)) : R;
        RA[i] = R; CA[i] = C; voffB[i] = (unsigned)(Rb * K + C) * 2u; }
    const size_t kstep = (size_t)(BK * 2);
    const size_t hstep = (size_t)HALF * K * 2;
    const unsigned ldsw = (unsigned)wid * 1024u;
    const int aoff = lds_byte(wr * 64 + fr, fq * 8), boff = lds_byte(wc * 32 + fr, fq * 8);
#define PG8_SA(b, h) (((b) * 2 + (h)) * HTB)
#define PG8_SB(b, h) ((4 + (b) * 2 + (h)) * HTB)
#define PG8_STAGE(bufoff, gbase, voff) do { _Pragma("unroll") for (int _i = 0; _i < 2; ++_i) \
        __builtin_amdgcn_global_load_lds((const unsigned*)((const char*)(gbase) + (voff)[_i]), (PG8_LAS unsigned*)(lds + (bufoff) + ldsw + _i * 8192), 16, 0, 0); } while (0)
#define PG8_LDA(dst, b, h) do { _Pragma("unroll") for (int m = 0; m < 4; ++m) _Pragma("unroll") for (int k = 0; k < 2; ++k) dst[m][k] = *(const PG8_LAS bf16x8*)(lds + PG8_SA(b, h) + aoff + m * 2048 + k * 1024); } while (0)
#define PG8_LDB(dst, b, h) do { _Pragma("unroll") for (int n = 0; n < 2; ++n) _Pragma("unroll") for (int k = 0; k < 2; ++k) dst[n][k] = *(const PG8_LAS bf16x8*)(lds + PG8_SB(b, h) + boff + n * 2048 + k * 1024); } while (0)
#define PG8_MMA(ai, bj, At, Bt) do { __builtin_amdgcn_s_setprio(1); _Pragma("unroll") for (int m = 0; m < 4; ++m) _Pragma("unroll") for (int n = 0; n < 2; ++n) _Pragma("unroll") for (int k = 0; k < 2; ++k) \
        acc[ai][bj][m][n] = __builtin_amdgcn_mfma_f32_16x16x32_bf16(Bt[n][k], At[m][k], acc[ai][bj][m][n], 0, 0, 0); __builtin_amdgcn_s_setprio(0); } while (0)
#define PG8_WAIT_V(n) asm volatile("s_waitcnt vmcnt(" #n ")" ::: "memory")
#define PG8_WAIT_L(n) asm volatile("s_waitcnt lgkmcnt(" #n ")" ::: "memory")
#define PG8_BAR __builtin_amdgcn_s_barrier()
#define PG8_SCHED __builtin_amdgcn_sched_barrier(0)
#define PG8_OFFS(dst, u) do { _Pragma("unroll") for (int _h = 0; _h < 2; ++_h) _Pragma("unroll") for (int _i = 0; _i < 2; ++_i) \
        dst[_h][_i] = GATHER ? (S.a_off(u, _h * HALF + RA[_i]) + (unsigned)CA[_i] * 2u) : (unsigned)(((_h * HALF + RA[_i]) * K + CA[_i]) * 2); } while (0)
    Unit cur, nxt; int ui = 0;
    if (!S.next(0, cur)) return;
    f32x4 acc[2][2][4][2];
#pragma unroll
    for (int a = 0; a < 2; ++a)
#pragma unroll
        for (int b = 0; b < 2; ++b)
#pragma unroll
            for (int m = 0; m < 4; ++m)
#pragma unroll
                for (int n = 0; n < 2; ++n) acc[a][b][m][n] = (f32x4){0.f, 0.f, 0.f, 0.f};
    bf16x8 At[4][2], B0[2][2], B1[2][2];
    unsigned offA[2][2], offAn[2][2];
    PG8_OFFS(offA, cur);
    const char* cA = S.a_ptr(cur); const char* cB = S.b_ptr(cur);
    S.a_ready(cur);
    PG8_STAGE(PG8_SB(0, 0), cB, voffB); PG8_STAGE(PG8_SB(0, 1), cB + hstep, voffB); PG8_STAGE(PG8_SA(0, 0), cA, offA[0]); PG8_STAGE(PG8_SA(0, 1), cA, offA[1]);
    if (wr == 1) PG8_BAR;
    PG8_WAIT_V(2); PG8_BAR;
    PG8_STAGE(PG8_SB(1, 0), cB + kstep, voffB); PG8_STAGE(PG8_SA(1, 0), cA + kstep, offA[0]); PG8_STAGE(PG8_SB(1, 1), cB + hstep + kstep, voffB);
    PG8_WAIT_V(6); PG8_BAR;
    for (;;) {
        const bool has_next = S.next(ui + 1, nxt);
        const char* nA = has_next ? S.a_ptr(nxt) : cA; const char* nB = has_next ? S.b_ptr(nxt) : cB;
        if (GATHER && has_next) { PG8_OFFS(offAn, nxt); }
        else {
#pragma unroll
            for (int h = 0; h < 2; ++h)
#pragma unroll
                for (int i = 0; i < 2; ++i) offAn[h][i] = offA[h][i]; }
        for (int t = 0; t < nt; t += 2) {
            const bool last = (t == nt - 2);
            const char* a1 = cA + (size_t)(t + 1) * kstep;
            const char* a2 = last ? nA : cA + (size_t)(t + 2) * kstep; const char* b2 = last ? nB : cB + (size_t)(t + 2) * kstep;
            const char* a3 = a2 + kstep; const char* b3 = b2 + kstep;
            unsigned o2[2][2];
#pragma unroll
            for (int h = 0; h < 2; ++h)
#pragma unroll
                for (int i = 0; i < 2; ++i) o2[h][i] = (GATHER && last) ? offAn[h][i] : offA[h][i];
            if (last && has_next) S.a_ready(nxt);
            PG8_LDB(B0, 0, 0); PG8_LDB(B1, 0, 1); PG8_SCHED; PG8_LDA(At, 0, 0); PG8_STAGE(PG8_SA(1, 1), a1, offA[1]);
            PG8_WAIT_V(8); PG8_WAIT_L(0); PG8_BAR; PG8_MMA(0, 0, At, B0); PG8_MMA(0, 1, At, B1); PG8_BAR; PG8_SCHED;
            PG8_LDA(At, 0, 1); PG8_STAGE(PG8_SB(0, 0), b2, voffB); PG8_STAGE(PG8_SB(0, 1), b2 + hstep, voffB); PG8_STAGE(PG8_SA(0, 0), a2, o2[0]);
            PG8_WAIT_V(8); PG8_WAIT_L(0); PG8_BAR; PG8_MMA(1, 0, At, B0); PG8_MMA(1, 1, At, B1); PG8_BAR; PG8_SCHED;
            PG8_LDB(B0, 1, 0); PG8_LDB(B1, 1, 1); PG8_SCHED; PG8_LDA(At, 1, 0); PG8_STAGE(PG8_SA(0, 1), a2, o2[1]);
            PG8_WAIT_V(8); PG8_WAIT_L(0); PG8_BAR; PG8_MMA(0, 0, At, B0); PG8_MMA(0, 1, At, B1); PG8_BAR; PG8_SCHED;
            PG8_LDA(At, 1, 1); PG8_STAGE(PG8_SB(1, 0), b3, voffB); PG8_STAGE(PG8_SB(1, 1), b3 + hstep, voffB); PG8_STAGE(PG8_SA(1, 0), a3, o2[0]);
            PG8_WAIT_V(8); PG8_WAIT_L(0); PG8_BAR; PG8_MMA(1, 0, At, B0); PG8_MMA(1, 1, At, B1); PG8_BAR; PG8_SCHED;
        }
        if constexpr (ALIGN_EPI) { if (wr == 0) PG8_BAR; }
        { int fr2 = fr, fq2 = fq; asm volatile("" : "+v"(fr2), "+v"(fq2));
          E(acc, cur, wr, wc, fr2, fq2); } S.done(cur);
        if (!has_next) break;
#pragma unroll
        for (int a = 0; a < 2; ++a)
#pragma unroll
            for (int b = 0; b < 2; ++b)
#pragma unroll
                for (int m = 0; m < 4; ++m)
#pragma unroll
                    for (int n = 0; n < 2; ++n) acc[a][b][m][n] = (f32x4){0.f, 0.f, 0.f, 0.f};
        cur = nxt; cA = nA; cB = nB; ++ui;
#pragma unroll
        for (int h = 0; h < 2; ++h)
#pragma unroll
            for (int i = 0; i < 2; ++i) offA[h][i] = offAn[h][i];
        if constexpr (ALIGN_EPI) { if (wr == 1) PG8_BAR; }
    }
    PG8_WAIT_V(0);
    if constexpr (!ALIGN_EPI) { if (wr == 0) PG8_BAR; }
    PG8_BAR;
#undef PG8_SA
#undef PG8_SB
#undef PG8_STAGE
#undef PG8_LDA
#undef PG8_LDB
#undef PG8_MMA
#undef PG8_WAIT_V
#undef PG8_WAIT_L
#undef PG8_BAR
#undef PG8_SCHED
#undef PG8_OFFS
}
}
namespace pg8 {
__device__ __forceinline__ float fsigmoid(float x) { return __builtin_amdgcn_rcpf(1.0f + __builtin_amdgcn_exp2f(-LOG2E * x)); }
__device__ __forceinline__ u32x4 pack8(const f32x4 a, const f32x4 b) { u32x4 w; w.x = cvt_pk_bf16(a[0], a[1]); w.y = cvt_pk_bf16(a[2], a[3]); w.z = cvt_pk_bf16(b[0], b[1]); w.w = cvt_pk_bf16(b[2], b[3]); return w; }
__device__ __forceinline__ void unpack8(const u32x4 w, f32x4& a, f32x4& b) {
    a[0] = __uint_as_float(w.x << 16); a[1] = __uint_as_float(w.x & 0xffff0000u); a[2] = __uint_as_float(w.y << 16); a[3] = __uint_as_float(w.y & 0xffff0000u);
    b[0] = __uint_as_float(w.z << 16); b[1] = __uint_as_float(w.z & 0xffff0000u); b[2] = __uint_as_float(w.w << 16); b[3] = __uint_as_float(w.w & 0xffff0000u); }

struct EpiQK {
    static constexpr bool PERM = true;
    bf16 *qsb, *ksb;
    __device__ __forceinline__ void operator()(const f32x4 (&acc)[2][2][4][2], const Unit& u, int wr, int wc, int fr, int fq) const {
        const int pn = u.pn; const int row0 = u.pm * BM + wr * 64 + fr; const int cin = wc * 32 + 8 * fq;
        bf16* O = pn < 4 ? qsb : ksb; const float sc = pn < 4 ? SB_C2 : 1.0f; const int colt = (pn & 3) * 256;
#pragma unroll
        for (int ai = 0; ai < 2; ++ai)
#pragma unroll
            for (int m = 0; m < 4; ++m) { bf16* rowp = O + (size_t)(row0 + ai * HALF + m * 16) * 1024 + colt + cin;
#pragma unroll
                for (int bj = 0; bj < 2; ++bj) *(u32x4*)(rowp + bj * HALF) = pack8(acc[ai][bj][m][0] * sc, acc[ai][bj][m][1] * sc); }
    }
};
struct EpiRot {
    static constexpr bool PERM = true;
    bf16 *qr, *kr, *krt, *qrs; const float *cosT, *sinT;
    __device__ __forceinline__ void operator()(const f32x4 (&acc)[2][2][4][2], const Unit& u, int wr, int wc, int fr, int fq) const {
        const int pn = u.pn; const int row0 = u.pm * BM + wr * 64 + fr; const int cin = wc * 32 + 8 * fq;
        const bool isK = pn >= 4; const int head = pn & 3; bf16* O = isK ? kr : qr; const float sc = isK ? 1.0f : 0.0625f;
#pragma unroll
        for (int ai = 0; ai < 2; ++ai)
#pragma unroll
            for (int m = 0; m < 4; ++m) { const int row = row0 + ai * HALF + m * 16; const int pos = row & (SEQ - 1); const int bh = (row >> 13) * 4 + head;
                f32x4 o1[2], o2[2];
#pragma unroll
                for (int n = 0; n < 2; ++n) { const f32x4 c = *(const f32x4*)(cosT + pos * 128 + cin + 4 * n), s = *(const f32x4*)(sinT + pos * 128 + cin + 4 * n);
                    const f32x4 x1 = acc[ai][0][m][n], x2 = acc[ai][1][m][n]; o1[n] = (x1 * c - x2 * s) * sc; o2[n] = (x1 * s + x2 * c) * sc; }
                bf16* rowp = O + (size_t)row * 1024 + head * 256 + cin;
                const u32x4 w1 = pack8(o1[0], o1[1]), w2 = pack8(o2[0], o2[1]);
                *(u32x4*)(rowp) = w1; *(u32x4*)(rowp + HALF) = w2;
                if (isK) {
                    bf16* tp = krt + krt_idx(bh, pos, cin);
#pragma unroll
                    for (int q = 0; q < 4; ++q) { tp[(2 * q) * 16] = (bf16)(w1[q] & 0xffffu); tp[(2 * q + 1) * 16] = (bf16)(w1[q] >> 16);
                        tp[(HALF + 2 * q) * 16] = (bf16)(w2[q] & 0xffffu); tp[(HALF + 2 * q + 1) * 16] = (bf16)(w2[q] >> 16); }
                } else {
                    *(u32x4*)(qrs + qrs_idx(bh, pos, cin)) = w1; *(u32x4*)(qrs + qrs_idx(bh, pos, cin + HALF)) = w2; }
                asm volatile("" ::: "memory"); }
    }
};
struct EpiGate {
    static constexpr bool PERM = true;
    unsigned char* ws;
    __device__ __forceinline__ void operator()(const f32x4 (&acc)[2][2][4][2], const Unit& u, int wr, int wc, int fr, int fq) const {
        const int pn = u.pn; const int row0 = u.pm * BM + wr * 64 + fr; const int cin = wc * 32 + 8 * fq;
        const bool silu = pn < 8; bf16* O = (bf16*)(ws + WS_SG + (size_t)(silu ? 0 : 1) * (WS_GSB - WS_SG) + (size_t)(pn >= 12 ? 1 : 0) * (WS_GRET - WS_GSB));
        const int colt = (silu ? pn : (pn & 3)) * 256;
#pragma unroll
        for (int ai = 0; ai < 2; ++ai)
#pragma unroll
            for (int m = 0; m < 4; ++m) { const int row = row0 + ai * HALF + m * 16;
#pragma unroll
                for (int bj = 0; bj < 2; ++bj) { f32x4 a = acc[ai][bj][m][0], b = acc[ai][bj][m][1];
#pragma unroll
                    for (int e = 0; e < 4; ++e) { const float sa = fsigmoid(a[e]), sb = fsigmoid(b[e]); a[e] = silu ? a[e] * sa : sa; b[e] = silu ? b[e] * sb : sb; }
                    const int col = colt + cin + bj * HALF;
                    bf16* dst = silu ? O + yt_idx((row >> 13) * 4 + (col >> 9), row & (SEQ - 1), col & 511) : O + (size_t)row * 1024 + col;
                    *(u32x4*)dst = pack8(a, b); }
                asm volatile("" ::: "memory"); }
    }
};
struct EpiVT {
    static constexpr bool PERM = true;
    bf16 *vsbt, *vrt;
    __device__ __forceinline__ void operator()(const f32x4 (&acc)[2][2][4][2], const Unit& u, int wr, int wc, int fr, int fq) const {
        const int f0 = u.pm * BM + wr * 64 + fr; const int tcol = u.pn * BM + wc * 32 + 8 * fq;
        float dec[8];
        if (u.pm < 4) {
#pragma unroll
            for (int q = 0; q < 8; ++q) dec[q] = 1.0f;
        } else { const int h = (u.pm - 4) >> 1; const float l2g = __builtin_amdgcn_logf(1.0f - __builtin_amdgcn_exp2f(-5.0f - (float)h));
#pragma unroll
            for (int q = 0; q < 8; ++q) dec[q] = __builtin_amdgcn_exp2f((float)(63 - (((wc & 1) * 32 + 8 * fq + q) & 63)) * l2g); }
#pragma unroll
        for (int ai = 0; ai < 2; ++ai)
#pragma unroll
            for (int m = 0; m < 4; ++m) { const int f = f0 + ai * HALF + m * 16;
#pragma unroll
                for (int bj = 0; bj < 2; ++bj) { f32x4 a = acc[ai][bj][m][0], b = acc[ai][bj][m][1];
#pragma unroll
                    for (int e = 0; e < 4; ++e) { a[e] *= dec[e]; b[e] *= dec[4 + e]; }
                    const int tok = tcol + bj * HALF;
                    bf16* dst = u.pm < 4 ? vsbt + (size_t)f * NTOK + tok : vrt + vrt_idx((tok >> 13) * 4 + ((f - 1024) >> 9), tok & (SEQ - 1), (f - 1024) & 511);
                    *(u32x4*)dst = pack8(a, b); } }
    }
};
template <int MODE> struct EpiBranch {
    static constexpr bool PERM = true;
    const bf16* gate; const bf16* m1in; bf16* out;
    __device__ __forceinline__ void operator()(const f32x4 (&acc)[2][2][4][2], const Unit& u, int wr, int wc, int fr, int fq) const {
        const int row0 = u.pm * BM + wr * 64 + fr; const int col0 = u.pn * BM + wc * 32 + 8 * fq;
#pragma unroll
        for (int ai = 0; ai < 2; ++ai)
#pragma unroll
            for (int m = 0; m < 4; ++m) { const size_t ro = (size_t)(row0 + ai * HALF + m * 16) * 1024 + col0;
#pragma unroll
                for (int bj = 0; bj < 2; ++bj) { f32x4 ga, gb; unpack8(*(const u32x4*)(gate + ro + bj * HALF), ga, gb);
                    f32x4 a = acc[ai][bj][m][0] * ga, b = acc[ai][bj][m][1] * gb;
                    if (MODE == 1) { f32x4 pa, pb; unpack8(*(const u32x4*)(m1in + ro + bj * HALF), pa, pb); a += pa; b += pb; }
                    *(u32x4*)(out + ro + bj * HALF) = pack8(a, b); }
                asm volatile("" ::: "memory"); }
    }
};
struct EpiPre {
    static constexpr bool PERM = false;
    const float* x; float* pre;
    __device__ __forceinline__ void operator()(const f32x4 (&acc)[2][2][4][2], const Unit& u, int wr, int wc, int fr, int fq) const {
        const int row0 = u.pm * BM + wr * 64 + fr, col0 = u.pn * BM + wc * 32 + 4 * fq;
#pragma unroll
        for (int ai = 0; ai < 2; ++ai)
#pragma unroll
            for (int m = 0; m < 4; ++m) { const size_t ro = (size_t)(row0 + ai * HALF + m * 16) * 1024 + col0;
#pragma unroll
                for (int bj = 0; bj < 2; ++bj)
#pragma unroll
                    for (int n = 0; n < 2; ++n) { const size_t o = ro + bj * HALF + n * 16; *(f32x4*)(pre + o) = *(const f32x4*)(x + o) * DN_ALPHA + acc[ai][bj][m][n]; }
                asm volatile("" ::: "memory"); }
    }
};
struct EpiGateUp {
    static constexpr bool PERM = true;
    const float* bgu; bf16* act;
    __device__ __forceinline__ void operator()(const f32x4 (&acc)[2][2][4][2], const Unit& u, int wr, int wc, int fr, int fq) const {
        const int ff0 = u.pn * 128 + wc * 32 + 8 * fq; const float* bp = bgu + (size_t)u.e * 2048 + ff0;
#pragma unroll
        for (int ai = 0; ai < 2; ++ai)
#pragma unroll
            for (int m = 0; m < 4; ++m) { const int rr = ai * HALF + wr * 64 + m * 16 + fr;
                f32x4 bg[2], bu[2];
#pragma unroll
                for (int n = 0; n < 2; ++n) { bg[n] = *(const f32x4*)(bp + 4 * n); bu[n] = *(const f32x4*)(bp + 1024 + 4 * n); }
                f32x4 o[2];
#pragma unroll
                for (int n = 0; n < 2; ++n) { const f32x4 g = acc[ai][0][m][n] + bg[n], up = acc[ai][1][m][n] + bu[n];
#pragma unroll
                    for (int e = 0; e < 4; ++e) { const float gg = fminf(g[e], 7.0f), uu = fminf(fmaxf(up[e], -7.0f), 7.0f); o[n][e] = (uu + 1.0f) * gg * fsigmoid(1.702f * gg); } }
                if (rr < u.nrows) *(u32x4*)(act + (size_t)(u.rbase + rr) * 1024 + ff0) = pack8(o[0], o[1]);
                asm volatile("" ::: "memory"); }
    }
};
struct EpiDown {
    static constexpr bool PERM = true;
    const float* bdn; const int* rowtk; const float* roww; bf16* outr;
    __device__ __forceinline__ void operator()(const f32x4 (&acc)[2][2][4][2], const Unit& u, int wr, int wc, int fr, int fq) const {
        const int col0 = u.pn * BM + wc * 32 + 8 * fq; const float* bp = bdn + (size_t)u.e * 1024 + col0;
        const size_t lbase = (size_t)u.e * CAP + u.pm;
#pragma unroll
        for (int ai = 0; ai < 2; ++ai)
#pragma unroll
            for (int m = 0; m < 4; ++m) { const int rr = ai * HALF + wr * 64 + m * 16 + fr;
                if (rr < u.nrows) { const int tk = rowtk[lbase + rr]; const float w = roww[lbase + rr]; bf16* rowp = outr + (size_t)tk * 1024 + col0;
#pragma unroll
                    for (int bj = 0; bj < 2; ++bj) { const f32x4 b0 = *(const f32x4*)(bp + bj * HALF), b1 = *(const f32x4*)(bp + bj * HALF + 4);
                        *(u32x4*)(rowp + bj * HALF) = pack8((acc[ai][bj][m][0] + b0) * w, (acc[ai][bj][m][1] + b1) * w); } }
                asm volatile("" ::: "memory"); }
    }
};
}
#define GAS __attribute__((address_space(1)))
#define LAS __attribute__((address_space(3)))
typedef GAS unsigned gu32;
#define RLX_AGENT __ATOMIC_RELAXED, __HIP_MEMORY_SCOPE_AGENT
constexpr int NWAVES = 8;
constexpr int RING_OFF = 0, RING_BYTES = 131072;
constexpr int LDSCTL_OFF = RING_BYTES;
constexpr int LDS_TAB_OFF = RING_BYTES + 1024;
constexpr int LDS_BYTES = LDS_TAB_OFF + 24 * 256 * 4;
static_assert(LDS_BYTES <= 163840, "LDS");

#define XB_TMO      128
#define XB_XCNT(j)  (256  + 64 * (j))
#define XB_XSUB(j)  (1280 + 64 * (j))
#define XB_XGEN(j)  (2304 + 64 * (j))
#define XB_TOP      3328
#define XB_TOPGEN   3392
#define XCD_BAR_WORDS 3456
#define XB_SPIN_CAP (1u << 18)
__device__ __forceinline__ unsigned xb_ld(unsigned* p)              { return __hip_atomic_load(p, __ATOMIC_RELAXED, __HIP_MEMORY_SCOPE_AGENT); }
__device__ __forceinline__ unsigned xb_add(unsigned* p, unsigned v) { return __hip_atomic_fetch_add(p, v, __ATOMIC_RELAXED, __HIP_MEMORY_SCOPE_AGENT); }
__device__ __forceinline__ unsigned xb_xcc_id() { return (unsigned)__builtin_amdgcn_s_getreg((3 << 11) | 20) & 0xFu; }
#define XB_SPIN(cond, bar) do { unsigned _sp = 0; while (cond) { __builtin_amdgcn_s_sleep(1); \
    if ((++_sp & 255u) == 0u) { if (xb_ld(&(bar)[XB_TMO])) break; if (_sp > XB_SPIN_CAP) { atomicAdd(&(bar)[XB_TMO], 1u); break; } } } } while (0)
struct XcdBarrier { unsigned* bar; unsigned x; volatile LAS unsigned* st; };
__device__ __forceinline__ XcdBarrier xcd_barrier_post(unsigned* bar, volatile LAS unsigned* st) {
    XcdBarrier b; b.bar = bar; b.x = xb_xcc_id(); b.st = st;
    if (threadIdx.x == 0) (void)xb_add(&bar[XB_XCNT(b.x)], 1u);
    return b;
}
__device__ __forceinline__ void xcd_barrier_complete(unsigned* bar, unsigned x, unsigned& nloc, unsigned& nx) {
    const unsigned G = gridDim.x * gridDim.y * gridDim.z;
    unsigned sum, cnt, mine, sp = 0u;
    for (;;) {
        sum = 0u; cnt = 0u; mine = 0u;
#pragma unroll
        for (unsigned j = 0; j < 16; ++j) { const unsigned c = xb_ld(&bar[XB_XCNT(j)]); sum += c; cnt += (c > 0u) ? 1u : 0u; mine = (j == x) ? c : mine; }
        if (sum == G) break;
        __builtin_amdgcn_s_sleep(1);
        if ((++sp & 255u) == 0u) { if (xb_ld(&bar[XB_TMO])) break; if (sp > XB_SPIN_CAP) { atomicAdd(&bar[XB_TMO], 1u); break; } }
    }
    nloc = mine > 0u ? mine : 1u; nx = cnt > 0u ? cnt : 1u;
}
__device__ __forceinline__ void xcd_barrier(const XcdBarrier& b) {
    asm volatile("s_waitcnt vmcnt(0)" ::: "memory");
    __syncthreads();
    if (threadIdx.x == 0) {
        unsigned* bar = b.bar;
        __builtin_amdgcn_s_waitcnt(0);
        unsigned nloc = b.st[0], nx = b.st[1];
        if (nloc == 0u) { xcd_barrier_complete(bar, b.x, nloc, nx); b.st[0] = nloc; b.st[1] = nx; }
        const unsigned old = xb_add(&bar[XB_XSUB(b.x)], 1u);
        const unsigned gen = old / nloc;
        if (old + 1u == (gen + 1u) * nloc) {
            __builtin_amdgcn_fence(__ATOMIC_RELEASE, "agent");
            asm volatile("s_waitcnt vmcnt(0)" ::: "memory");
            const unsigned og = xb_add(&bar[XB_TOP], 1u);
            const unsigned tg = og / nx;
            if (og + 1u == (tg + 1u) * nx) xb_add(&bar[XB_TOPGEN], 1u);
            else XB_SPIN(xb_ld(&bar[XB_TOPGEN]) == tg, bar);
            __builtin_amdgcn_fence(__ATOMIC_ACQUIRE, "agent");
            xb_add(&bar[XB_XGEN(b.x)], 1u);
            asm volatile("s_waitcnt vmcnt(0)" ::: "memory");
        } else {
            XB_SPIN(xb_ld(&bar[XB_XGEN(b.x)]) == gen, bar);
            __builtin_amdgcn_fence(__ATOMIC_ACQUIRE, "agent");
            asm volatile("s_waitcnt vmcnt(0)" ::: "memory");
        }
    }
    __syncthreads();
}

struct Frame {
    LAS unsigned char* lds; volatile LAS unsigned* LC;
    unsigned* ctl;
    int wave, vcu, G;
    Bufs B;
};
#define FWS(T, off) ((T*)(F.B.ws + (off)))
#define FDO(T, off) ((T*)((unsigned char*)F.B.out + (off)))
#define LDS_WAIT() asm volatile("s_waitcnt lgkmcnt(0)" ::: "memory")
#define VM_WAIT() asm volatile("s_waitcnt vmcnt(0)" ::: "memory")

__device__ __forceinline__ f32x16 mfma32(bf16x8 a, bf16x8 b, f32x16 c) { return __builtin_amdgcn_mfma_f32_32x32x16_bf16(a, b, c, 0, 0, 0); }
__device__ __forceinline__ int crow(int r, int hi) { return (r & 3) + 8 * (r >> 2) + 4 * hi; }
__device__ __forceinline__ float swap_lo(float x, float& hi_out) { auto rr = __builtin_amdgcn_permlane32_swap(__float_as_uint(x), __float_as_uint(x), false, false); hi_out = __uint_as_float(rr[1]); return __uint_as_float(rr[0]); }
__device__ __forceinline__ bf16x8 pack_frag(const f32x16& v, int base) {
    u32x4 w; w.x = pg8::cvt_pk_bf16(v[base + 0], v[base + 1]); w.y = pg8::cvt_pk_bf16(v[base + 2], v[base + 3]); w.z = pg8::cvt_pk_bf16(v[base + 4], v[base + 5]); w.w = pg8::cvt_pk_bf16(v[base + 6], v[base + 7]);
    return __builtin_bit_cast(bf16x8, w); }
__device__ __forceinline__ bf16x8 join8(u32x2 a, u32x2 b) { u32x4 w; w.x = a.x; w.y = a.y; w.z = b.x; w.w = b.y; return __builtin_bit_cast(bf16x8, w); }
__device__ __forceinline__ float ret_l2g(int h) { return __builtin_amdgcn_logf(1.0f - __builtin_amdgcn_exp2f(-5.0f - (float)h)); }

__device__ __forceinline__ void tr_item(const float* src, int lds_, int k0, int c0, bf16* dst, int K, int r0, LAS unsigned char* scr, int lane) {
    const int kr = lane >> 4, nq = lane & 15;
    f32x4 v[4][4];
#pragma unroll
    for (int gI = 0; gI < 4; ++gI)
#pragma unroll
        for (int i = 0; i < 4; ++i) v[gI][i] = *(const f32x4*)(src + (size_t)(k0 + 16 * gI + 4 * kr + i) * lds_ + c0 + 4 * nq);
#pragma unroll
    for (int gI = 0; gI < 4; ++gI)
#pragma unroll
        for (int e = 0; e < 4; ++e) { u32x2 w; w.x = pk2(v[gI][0][e], v[gI][1][e]); w.y = pk2(v[gI][2][e], v[gI][3][e]);
            *(LAS u32x2*)(scr + (4 * nq + e) * 144 + 32 * gI + 8 * kr) = w; }
    LDS_WAIT(); asm volatile("" ::: "memory");
#pragma unroll
    for (int it = 0; it < 8; ++it) { const int n = it * 8 + (lane >> 3), ch = lane & 7;
        const u32x4 w = *(const LAS u32x4*)(scr + n * 144 + ch * 16);
        *(u32x4*)(dst + (size_t)(r0 + n) * K + k0 + 8 * ch) = w; }
    LDS_WAIT(); asm volatile("" ::: "memory");
}
__device__ __forceinline__ void p0_prologue(Frame& F) {
    const Bufs& B = F.B; const int lane_ = lane_id(), tid_ = F.wave * 64 + lane_;
    const int gw = F.vcu * NWAVES + F.wave, NGW = F.G * NWAVES;
    { const f32x4* xs = (const f32x4*)B.x; u32x4* xd = FDO(u32x4, DO_XB); const size_t n8 = (size_t)NTOK * DM / 8;
      for (size_t i = (size_t)blockIdx.x * 512 + tid_; i < n8; i += (size_t)F.G * 512) { const f32x4 a = xs[2 * i], b = xs[2 * i + 1];
          u32x4 w; w.x = pk2(a[0], a[1]); w.y = pk2(a[2], a[3]); w.z = pk2(b[0], b[1]); w.w = pk2(b[2], b[3]); xd[i] = w; } }
    LAS unsigned char* scr = F.lds + RING_OFF + F.wave * 9216;
    constexpr int I_IN = 16 * (INW / 64)  , I_BSB = 256, I_BRET = 32 * 16, I_OUT = 256, I_GU = 32 * 16 * 32, I_DN = 32 * 16 * 16;
    constexpr int NITEMS = I_IN + I_BSB + I_BRET + I_OUT + I_GU + I_DN;
    for (int it = gw; it < NITEMS; it += NGW) {
        int r = it;
        if (r < I_IN) { const int kb = r / (INW / 64), nb = r % (INW / 64); const int c0 = nb * 64; bf16* dst; int r0;
            if (c0 < 2048) { dst = FWS(bf16, WS_WINT); r0 = c0; } else if (c0 < 3072) { dst = FWS(bf16, WS_WVT); r0 = c0 - 2048; }
            else if (c0 < 5120) { dst = FWS(bf16, WS_WINT); r0 = 2048 + c0 - 3072; } else if (c0 < 7168) { dst = FWS(bf16, WS_WVT); r0 = 1024 + c0 - 5120; }
            else { dst = FWS(bf16, WS_WINT); r0 = 4096 + c0 - 7168; }
            tr_item(B.w_in, INW, kb * 64, c0, dst, 1024, r0, scr, lane_); continue; } r -= I_IN;
        if (r < I_BSB) { tr_item(B.w_bsb, 1024, (r >> 4) * 64, (r & 15) * 64, FWS(bf16, WS_WBSBT), 1024, (r & 15) * 64, scr, lane_); continue; } r -= I_BSB;
        if (r < I_BRET) { tr_item(B.w_bret, 1024, (r >> 4) * 64, (r & 15) * 64, FWS(bf16, WS_WBRETT), 2048, (r & 15) * 64, scr, lane_); continue; } r -= I_BRET;
        if (r < I_OUT) { tr_item(B.w_out, 1024, (r >> 4) * 64, (r & 15) * 64, FWS(bf16, WS_WOUTT), 1024, (r & 15) * 64, scr, lane_); continue; } r -= I_OUT;
        if (r < I_GU) { const int e = r >> 9, q = r & 511, kb = q >> 5, nb = q & 31; const int c0 = nb * 64; const int bj = c0 >> 10, rem = c0 & 1023, ct = rem >> 7, i0 = rem & 127;
            tr_item(B.w_gu + (size_t)e * 1024 * 2048, 2048, kb * 64, c0, FWS(bf16, WS_WGUT) + (size_t)e * 2048 * 1024, 1024, 256 * ct + 128 * bj + i0, scr, lane_); continue; } r -= I_GU;
        { const int e = r >> 8, q = r & 255, kb = q >> 4, nb = q & 15;
          tr_item(B.w_dn + (size_t)e * 1024 * 1024, 1024, kb * 64, nb * 64, FWS(bf16, WS_WDT) + (size_t)e * 1024 * 1024, 1024, nb * 64, scr, lane_); }
    }
    { float* ct = FWS(float, WS_COS); float* st = FWS(float, WS_SIN);
      for (int i = blockIdx.x * 512 + tid_; i < SEQ * 128; i += F.G * 512) { const int pos = i >> 7, j = i & 127; const float ang = (float)pos * rope_inv_freq(j);
          ct[i] = (float)cos((double)ang); st[i] = (float)sin((double)ang); } }
    { bf16* wrt = FWS(bf16, WS_WRT);
      for (int i = blockIdx.x * 512 + tid_; i < 32 * 1024; i += F.G * 512) { const int k = i & 1023, e = i >> 10; wrt[i] = f2bf(B.w_router[k * 32 + e]); } }
}
__device__ __forceinline__ void attn_wave_unit(const bf16* __restrict__ KSB, const bf16* __restrict__ VSBT, bf16* QY, int b, int h, int qb, int lane) {
    const int r32 = lane & 31, hi = lane >> 5;
    const int t0 = qb * 32; const size_t rb = (size_t)b * SEQ; const int tq = t0 + r32;
    bf16x8 qf[4];
    { const bf16* qp = QY + (rb + t0 + r32) * 1024 + h * 64 + 8 * hi;
#pragma unroll
      for (int d0 = 0; d0 < 4; ++d0) qf[d0] = *(const bf16x8*)(qp + 16 * d0); }
    f32x16 o0 = {}, o1 = {};
    float carry = 1.0f;
    const bf16* vrow0 = VSBT + (size_t)(h * 64 + r32) * NTOK + rb;
    for (int tile = 0;; ++tile) {
        const int ks = t0 + 32 - 64 * (tile + 1);
        const int kc0 = max(ks + r32, 0), kc1 = max(ks + 32 + r32, 0);
        const bf16* kp0 = KSB + (rb + kc0) * 1024 + h * 64 + 8 * hi; const bf16* kp1 = KSB + (rb + kc1) * 1024 + h * 64 + 8 * hi;
        f32x16 p0 = {}, p1 = {};
#pragma unroll
        for (int d0 = 0; d0 < 4; ++d0) { const bf16x8 a0 = *(const bf16x8*)(kp0 + 16 * d0), a1 = *(const bf16x8*)(kp1 + 16 * d0);
            p0 = mfma32(a0, qf[d0], p0); p1 = mfma32(a1, qf[d0], p1); }
        bf16x8 vf[2][4];
#pragma unroll
        for (int s = 0; s < 4; ++s) { const int ta = max(ks + 16 * s + 4 * hi, 0), tb = max(ks + 16 * s + 8 + 4 * hi, 0);
#pragma unroll
            for (int db = 0; db < 2; ++db) { const bf16* vp = vrow0 + (size_t)db * 32 * NTOK; vf[db][s] = join8(*(const u32x2*)(vp + ta), *(const u32x2*)(vp + tb)); } }
        f32x16 u0, u1;
        const bool need_mask = (tile == 0) || (ks < 0);
#pragma unroll
        for (int r = 0; r < 16; ++r) { const float e0 = __builtin_amdgcn_exp2f(fminf(p0[r], 100.0f)), e1 = __builtin_amdgcn_exp2f(fminf(p1[r], 100.0f));
            u0[r] = __builtin_amdgcn_rcpf(1.0f + e0); u1[r] = __builtin_amdgcn_rcpf(1.0f + e1); p0[r] = e0 * u0[r]; p1[r] = e1 * u1[r]; }
        if (need_mask) {
#pragma unroll
            for (int r = 0; r < 16; ++r) { const int s0 = ks + crow(r, hi), s1 = s0 + 32;
                const bool v0 = (s0 >= 0) && (s0 < tq), v1 = (s1 >= 0) && (s1 < tq);
                u0[r] = v0 ? u0[r] : 1.0f; p0[r] = v0 ? p0[r] : 0.0f; u1[r] = v1 ? u1[r] : 1.0f; p1[r] = v1 ? p1[r] : 0.0f; }
        }
        float R[8], Rhi[8], T[8];
#pragma unroll
        for (int g = 0; g < 4; ++g) { R[g] = (u0[4 * g] * u0[4 * g + 1]) * (u0[4 * g + 2] * u0[4 * g + 3]); R[4 + g] = (u1[4 * g] * u1[4 * g + 1]) * (u1[4 * g + 2] * u1[4 * g + 3]); }
#pragma unroll
        for (int a = 0; a < 8; ++a) { float rh; const float rl = swap_lo(R[a], rh); Rhi[a] = rh; T[a] = rl * rh; }
        float X[8]; X[7] = 1.0f;
#pragma unroll
        for (int a = 6; a >= 0; --a) X[a] = X[a + 1] * T[a + 1];
        const float total = X[0] * T[0];
#pragma unroll
        for (int a = 0; a < 8; ++a) { const float ec = X[a] * (hi == 0 ? Rhi[a] : 1.0f) * carry; const int g = a & 3;
            if (a < 4) { const float w2 = u0[4 * g + 3], w1 = w2 * u0[4 * g + 2], w0 = w1 * u0[4 * g + 1];
                p0[4 * g + 3] *= ec; p0[4 * g + 2] *= w2 * ec; p0[4 * g + 1] *= w1 * ec; p0[4 * g] *= w0 * ec; }
            else { const float w2 = u1[4 * g + 3], w1 = w2 * u1[4 * g + 2], w0 = w1 * u1[4 * g + 1];
                p1[4 * g + 3] *= ec; p1[4 * g + 2] *= w2 * ec; p1[4 * g + 1] *= w1 * ec; p1[4 * g] *= w0 * ec; } }
        carry *= total;
#pragma unroll
        for (int s = 0; s < 4; ++s) { const bf16x8 pf = (s < 2) ? pack_frag(p0, 8 * (s & 1)) : pack_frag(p1, 8 * (s & 1));
            o0 = mfma32(vf[0][s], pf, o0); o1 = mfma32(vf[1][s], pf, o1); }
        if (ks <= 0) break;
        if (__all(carry < 1.0e-37f)) break;
    }
    bf16* op = QY + (rb + t0 + r32) * 1024 + h * 64 + 4 * hi;
#pragma unroll
    for (int g = 0; g < 4; ++g) { u32x2 w; w.x = pg8::cvt_pk_bf16(o0[4 * g], o0[4 * g + 1]); w.y = pg8::cvt_pk_bf16(o0[4 * g + 2], o0[4 * g + 3]); *(u32x2*)(op + 8 * g) = w;
        u32x2 w2; w2.x = pg8::cvt_pk_bf16(o1[4 * g], o1[4 * g + 1]); w2.y = pg8::cvt_pk_bf16(o1[4 * g + 2], o1[4 * g + 3]); *(u32x2*)(op + 32 + 8 * g) = w2; }
}
__device__ __forceinline__ void attn_phase(Frame& F) {
    const int gw = F.vcu * NWAVES + F.wave, NGW = F.G * NWAVES;
    for (int wu = gw; wu < BATCH * SBH * (SEQ / 32); wu += NGW) { const int qb = wu & 255, bh = wu >> 8;
        attn_wave_unit(FWS(bf16, WS_KSB), FWS(bf16, WS_VSBT), FWS(bf16, WS_QSB), bh >> 4, bh & 15, qb, lane_id()); }
}

__device__ __forceinline__ int swap23(int m) { return (m & ~12) | ((m & 4) << 1) | ((m & 8) >> 1); }
__device__ __forceinline__ void scan_phase(Frame& F) {
    if (F.vcu >= BATCH * RH * 16) return;
    const int lane = lane_id(), w = F.wave, r32 = lane & 31, hi = lane >> 5;
    const int bh = F.vcu >> 4, vs = F.vcu & 15, h = bh & 3;
    const float l2g = ret_l2g(h), cd = __builtin_amdgcn_exp2f(64.0f * l2g);
    const bf16* ktp = FDO(bf16, DO_KRT) + ((size_t)bh * 128 * 4 * 256 + (32 * w + swap23(r32))) * 16 + 8 * hi;
    const bf16* vtp = FWS(bf16, WS_VRT) + ((size_t)bh * 128 * 4 * 512 + (32 * vs + r32)) * 16 + 8 * hi;
    const bf16* qp = FWS(bf16, WS_QRS) + ((size_t)bh * 128 * 16 * 64 + (size_t)(2 * w) * 64 + r32) * 16 + 8 * hi;
    bf16* yp = FWS(bf16, WS_YINT) + ((size_t)bh * 128 * 64 + (size_t)(4 * vs + (r32 >> 3))) * 512 + (r32 & 7);
    LAS f32x4* part = (LAS f32x4*)(F.lds + RING_OFF);
    f32x16 S = {};
    bf16x8 kfA[4], vfA[4], qfA[2][2], kfB[4], vfB[4], qfB[2][2];
#define SCAN_LOAD(kf, vf, qf, c) do { _Pragma("unroll") for (int s = 0; s < 4; ++s) { kf[s] = *(const bf16x8*)(ktp + (size_t)((c) * 4 + s) * 4096); vf[s] = *(const bf16x8*)(vtp + (size_t)((c) * 4 + s) * 8192); } \
        _Pragma("unroll") for (int ib = 0; ib < 2; ++ib) _Pragma("unroll") for (int s = 0; s < 2; ++s) qf[ib][s] = *(const bf16x8*)(qp + (size_t)(c) * 16384 + s * 1024 + ib * 512); } while (0)
#define SCAN_STEP(kf, vf, qf, c) do { \
        const bf16x8 sb0 = pack_frag(S, 0), sb1 = pack_frag(S, 8); \
        f32x16 y0 = {}, y1 = {}; \
        y0 = mfma32(qf[0][0], sb0, y0); y0 = mfma32(qf[0][1], sb1, y0); \
        y1 = mfma32(qf[1][0], sb0, y1); y1 = mfma32(qf[1][1], sb1, y1); \
        LAS f32x4* pb = part + ((c) & 1) * 4096 + (w * 8) * 64 + lane; \
        _Pragma("unroll") for (int q = 0; q < 4; ++q) { pb[q * 64] = (f32x4){y0[4 * q], y0[4 * q + 1], y0[4 * q + 2], y0[4 * q + 3]}; pb[(4 + q) * 64] = (f32x4){y1[4 * q], y1[4 * q + 1], y1[4 * q + 2], y1[4 * q + 3]}; } \
        _Pragma("unroll") for (int r = 0; r < 16; ++r) S[r] *= cd; \
        _Pragma("unroll") for (int s = 0; s < 4; ++s) S = mfma32(kf[s], vf[s], S); \
        if ((c) + 2 < NCHUNK) SCAN_LOAD(kf, vf, qf, (c) + 2); \
        LDS_WAIT(); __builtin_amdgcn_s_barrier(); asm volatile("" ::: "memory"); \
        const LAS f32x4* rbp = part + ((c) & 1) * 4096 + w * 64 + lane;         \
        f32x4 acc = rbp[0]; \
        _Pragma("unroll") for (int w2 = 1; w2 < 8; ++w2) acc += rbp[w2 * 8 * 64]; \
        _Pragma("unroll") for (int k = 0; k < 4; ++k) { const int idx = 4 * w + k, ib = idx >> 4, r = idx & 15; const int i = 32 * ib + crow(r, hi); \
            yp[(size_t)(c) * 32768 + i * 8] = f2bf(acc[k] * __builtin_amdgcn_exp2f((float)(i + 1) * l2g)); } } while (0)
    SCAN_LOAD(kfA, vfA, qfA, 0); SCAN_LOAD(kfB, vfB, qfB, 1);
    for (int c = 0; c < NCHUNK; c += 2) { SCAN_STEP(kfA, vfA, qfA, c); SCAN_STEP(kfB, vfB, qfB, c + 1); }
#undef SCAN_STEP
#undef SCAN_LOAD
    LDS_WAIT(); __syncthreads();
}

__device__ __forceinline__ void intra_phase(Frame& F) {
    const int lane = lane_id(), w = F.wave, r32 = lane & 31, hi = lane >> 5;
    LAS float* part = (LAS float*)(F.lds + RING_OFF);
    LAS u32x4* pfl = (LAS u32x4*)(F.lds + RING_OFF + 16384);
    LAS float* red = (LAS float*)(F.lds + RING_OFF + 24576);
    LAS unsigned char* stg = F.lds + RING_OFF + 32768 + w * 9216;
    const int tl = w & 3, jb = tl >> 1, ibt = tl & 1, kh = w >> 2;
    for (int un = F.vcu * 8; un < F.vcu * 8 + 8 && un < BATCH * RH * NCHUNK; ++un) {
        const int c = un & 127, h = (un >> 7) & 3, b = un >> 9, bh = b * 4 + h;
        const size_t tok0 = (size_t)b * SEQ + c * 64; const float l2g = ret_l2g(h);
        bf16x8 kfr[8], qfr[8];
        { const bf16* kp = FWS(bf16, WS_KR) + (tok0 + 32 * jb + r32) * 1024 + h * 256 + 128 * kh + 8 * hi;
          const bf16* qp = FWS(bf16, WS_QRS) + (((size_t)bh * 128 + c) * 16 + 8 * kh) * 1024 + (32 * ibt + r32) * 16 + 8 * hi;
#pragma unroll
          for (int s = 0; s < 8; ++s) { kfr[s] = *(const bf16x8*)(kp + 16 * s); qfr[s] = *(const bf16x8*)(qp + s * 1024); } }
        bf16x8 vfr[2][4];
        { const bf16* vp = FWS(bf16, WS_VRT) + (((size_t)bh * 128 + c) * 4 * 512 + 64 * w + r32) * 16 + 4 * hi;
#pragma unroll
          for (int vb = 0; vb < 2; ++vb)
#pragma unroll
              for (int ks = 0; ks < 4; ++ks) { const bf16* p = vp + (size_t)ks * 8192 + vb * 512; vfr[vb][ks] = join8(*(const u32x2*)(p), *(const u32x2*)(p + 8)); } }
        const size_t tbase = ((((size_t)bh * 128 + c) * 64 + 8 * w) * 64 + r32) * 8 + 4 * hi;
        const bf16* yrow = FWS(bf16, WS_YINT) + tbase; const bf16* srow = FWS(bf16, WS_SG) + tbase;
        u32x2 yv[2][2][4];
#pragma unroll
        for (int ib = 0; ib < 2; ++ib)
#pragma unroll
            for (int vb = 0; vb < 2; ++vb)
#pragma unroll
                for (int g = 0; g < 4; ++g) yv[ib][vb][g] = *(const u32x2*)(yrow + (size_t)(4 * vb + g) * 512 + ib * 256);
        f32x16 X = {};
#pragma unroll
        for (int s = 0; s < 8; ++s) X = mfma32(kfr[s], qfr[s], X);
        u32x2 sv[2][2][4];
#pragma unroll
        for (int ib = 0; ib < 2; ++ib)
#pragma unroll
            for (int vb = 0; vb < 2; ++vb)
#pragma unroll
                for (int g = 0; g < 4; ++g) sv[ib][vb][g] = *(const u32x2*)(srow + (size_t)(4 * vb + g) * 512 + ib * 256);
        if (kh == 1) {
#pragma unroll
            for (int r = 0; r < 16; ++r) part[(tl * 16 + r) * 64 + lane] = X[r]; }
        LDS_WAIT(); __builtin_amdgcn_s_barrier(); asm volatile("" ::: "memory");
        if (kh == 0) {
#pragma unroll
            for (int r = 0; r < 16; ++r) { const int j = 32 * jb + crow(r, hi), i = 32 * ibt + r32;
                X[r] = (X[r] + part[(tl * 16 + r) * 64 + lane]) * __builtin_amdgcn_exp2f((float)((j <= i ? i - j : j - i) - 63 + j) * l2g); }
            pfl[(ibt * 4 + 2 * jb) * 64 + lane] = __builtin_bit_cast(u32x4, pack_frag(X, 0)); pfl[(ibt * 4 + 2 * jb + 1) * 64 + lane] = __builtin_bit_cast(u32x4, pack_frag(X, 8)); }
        LDS_WAIT(); __builtin_amdgcn_s_barrier(); asm volatile("" ::: "memory");
        f32x16 Y[2][2] = {};
#pragma unroll
        for (int ks = 0; ks < 4; ++ks) { const bf16x8 p0 = __builtin_bit_cast(bf16x8, pfl[(0 * 4 + ks) * 64 + lane]), p1 = __builtin_bit_cast(bf16x8, pfl[(1 * 4 + ks) * 64 + lane]);
#pragma unroll
            for (int vb = 0; vb < 2; ++vb) { Y[vb][0] = mfma32(vfr[vb][ks], p0, Y[vb][0]); Y[vb][1] = mfma32(vfr[vb][ks], p1, Y[vb][1]); } }
        float s1[2] = {0.f, 0.f}, s2[2] = {0.f, 0.f};
#pragma unroll
        for (int ib = 0; ib < 2; ++ib)
#pragma unroll
            for (int vb = 0; vb < 2; ++vb)
#pragma unroll
                for (int g = 0; g < 4; ++g) { const u32x2 wv = yv[ib][vb][g];
                    Y[vb][ib][4 * g] += __uint_as_float(wv.x << 16); Y[vb][ib][4 * g + 1] += __uint_as_float(wv.x & 0xffff0000u); Y[vb][ib][4 * g + 2] += __uint_as_float(wv.y << 16); Y[vb][ib][4 * g + 3] += __uint_as_float(wv.y & 0xffff0000u);
#pragma unroll
                    for (int e = 0; e < 4; ++e) { const float y = Y[vb][ib][4 * g + e]; s1[ib] += y; s2[ib] += y * y; } }
#pragma unroll
        for (int ib = 0; ib < 2; ++ib) { float h1, h2; const float l1 = swap_lo(s1[ib], h1), l2 = swap_lo(s2[ib], h2);
            if (hi == 0) { red[(w * 64 + 32 * ib + r32) * 2] = l1 + h1; red[(w * 64 + 32 * ib + r32) * 2 + 1] = l2 + h2; } }
        LDS_WAIT(); __builtin_amdgcn_s_barrier(); asm volatile("" ::: "memory");
#pragma unroll
        for (int ib = 0; ib < 2; ++ib) { float t1 = 0.f, t2 = 0.f;
#pragma unroll
            for (int w2 = 0; w2 < 8; ++w2) { t1 += red[(w2 * 64 + 32 * ib + r32) * 2]; t2 += red[(w2 * 64 + 32 * ib + r32) * 2 + 1]; }
            const float mean = t1 * (1.0f / 512.0f), var = fmaxf(t2 * (1.0f / 512.0f) - mean * mean, 0.0f), rstd = __builtin_amdgcn_rsqf(var + LN_EPS);
#pragma unroll
            for (int vb = 0; vb < 2; ++vb)
#pragma unroll
                for (int g = 0; g < 4; ++g) { const u32x2 sw = sv[ib][vb][g];
                    const float g0 = __uint_as_float(sw.x << 16), g1 = __uint_as_float(sw.x & 0xffff0000u), g2 = __uint_as_float(sw.y << 16), g3 = __uint_as_float(sw.y & 0xffff0000u);
                    u32x2 ov; ov.x = pg8::cvt_pk_bf16(g0 * (Y[vb][ib][4 * g] - mean) * rstd, g1 * (Y[vb][ib][4 * g + 1] - mean) * rstd);
                    ov.y = pg8::cvt_pk_bf16(g2 * (Y[vb][ib][4 * g + 2] - mean) * rstd, g3 * (Y[vb][ib][4 * g + 3] - mean) * rstd);
                    *(LAS u32x2*)(stg + (32 * ib + r32) * 144 + (32 * vb + 8 * g + 4 * hi) * 2) = ov; } }
        LDS_WAIT(); asm volatile("" ::: "memory");
        { bf16* rp = FDO(bf16, DO_R) + (tok0 + (lane >> 3)) * 2048 + h * 512 + 64 * w + 8 * (lane & 7);
#pragma unroll
          for (int k = 0; k < 8; ++k) { const u32x4 v = *(const LAS u32x4*)(stg + (8 * k + (lane >> 3)) * 144 + (lane & 7) * 16); *(u32x4*)(rp + (size_t)(8 * k) * 2048) = v; } }
        LDS_WAIT(); asm volatile("" ::: "memory");
    }
    LDS_WAIT(); __syncthreads();
}

__device__ __forceinline__ void ln1_router_phase(Frame& F) {
    const Bufs& B = F.B;
    if (F.vcu >= NTOK / 256) return;
    const int lane = lane_id(), w = F.wave, r32 = lane & 31, hi = lane >> 5; const int tid_ = w * 64 + lane;
    const int rowbase = F.vcu * 256 + 32 * w;
    volatile LAS unsigned* hist = F.LC + 96; volatile LAS unsigned* basew = F.LC + 128;
    if (tid_ < 32) hist[tid_] = 0u;
    __syncthreads();
    { f32x4 gv[4], bv[4];
#pragma unroll
      for (int j = 0; j < 4; ++j) { gv[j] = *(const f32x4*)(B.ln1_g + 4 * lane + 256 * j); bv[j] = *(const f32x4*)(B.ln1_b + 4 * lane + 256 * j); }
      for (int rr = 0; rr < 32; ++rr) { float* p = B.out + (size_t)(rowbase + rr) * 1024 + 4 * lane; bf16* xb = FWS(bf16, WS_X1B) + (size_t)(rowbase + rr) * 1024 + 4 * lane;
          f32x4 v[4]; float s = 0.f;
#pragma unroll
          for (int j = 0; j < 4; ++j) { v[j] = *(const f32x4*)(p + 256 * j); s += (v[j][0] + v[j][1]) + (v[j][2] + v[j][3]); }
          const float mean = wave_sum(s) * (1.f / 1024.f); float s2 = 0.f;
#pragma unroll
          for (int j = 0; j < 4; ++j) { v[j] = v[j] - mean; s2 += (v[j][0] * v[j][0] + v[j][1] * v[j][1]) + (v[j][2] * v[j][2] + v[j][3] * v[j][3]); }
          const float rstd = rsqrtf(wave_sum(s2) * (1.f / 1024.f) + LN_EPS);
#pragma unroll
          for (int j = 0; j < 4; ++j) { const f32x4 y = v[j] * rstd * gv[j] + bv[j]; *(f32x4*)(p + 256 * j) = y;
              u32x2 o; o.x = pg8::cvt_pk_bf16(y[0], y[1]); o.y = pg8::cvt_pk_bf16(y[2], y[3]); *(u32x2*)(xb + 256 * j) = o; } } }
    VM_WAIT();
    f32x16 acc[4] = {};
    { const bf16* ap = FWS(bf16, WS_WRT) + (size_t)r32 * 1024 + 8 * hi; const bf16* bp = FWS(bf16, WS_X1B) + (size_t)(rowbase + r32) * 1024 + 8 * hi;
#pragma unroll 4
      for (int s = 0; s < 64; s += 4) {
#pragma unroll
          for (int q = 0; q < 4; ++q) acc[q] = mfma32(*(const bf16x8*)(ap + 16 * (s + q)), *(const bf16x8*)(bp + 16 * (s + q)), acc[q]); } }
    float lo[16], hv[16];
#pragma unroll
    for (int r = 0; r < 16; ++r) { const float x = (acc[0][r] + acc[1][r]) + (acc[2][r] + acc[3][r]) + B.b_router[crow(r, hi)]; float h_; lo[r] = swap_lo(x, h_); hv[r] = h_; }
    int se[4]; float sv[4];
#pragma unroll
    for (int kk = 0; kk < 4; ++kk) { float best = -INFINITY; int bi = 0;
#pragma unroll
        for (int g = 0; g < 4; ++g) {
#pragma unroll
            for (int e = 0; e < 4; ++e) { if (lo[4 * g + e] > best) { best = lo[4 * g + e]; bi = 8 * g + e; } }
#pragma unroll
            for (int e = 0; e < 4; ++e) { if (hv[4 * g + e] > best) { best = hv[4 * g + e]; bi = 8 * g + 4 + e; } } }
        se[kk] = bi; sv[kk] = best;
#pragma unroll
        for (int r = 0; r < 16; ++r) { if (bi == crow(r, 0)) lo[r] = -INFINITY; if (bi == crow(r, 1)) hv[r] = -INFINITY; } }
    const float e1 = __expf(sv[1] - sv[0]), e2 = __expf(sv[2] - sv[0]), e3 = __expf(sv[3] - sv[0]); const float inv = 1.f / (1.f + e1 + e2 + e3);
    const float wts[4] = {inv, e1 * inv, e2 * inv, e3 * inv};
    const int tok = rowbase + r32;
    const int ea = hi ? se[2] : se[0], eb = hi ? se[3] : se[1]; const float wa = hi ? wts[2] : wts[0], wb = hi ? wts[3] : wts[1]; const int ka = hi ? 2 : 0, kb = ka + 1;
    FWS(int, WS_SELE)[tok * 4 + ka] = ea; FWS(int, WS_SELE)[tok * 4 + kb] = eb; FWS(float, WS_SELW)[tok * 4 + ka] = wa; FWS(float, WS_SELW)[tok * 4 + kb] = wb;
    const unsigned ra = __hip_atomic_fetch_add((LAS unsigned*)hist + ea, 1u, __ATOMIC_RELAXED, __HIP_MEMORY_SCOPE_WORKGROUP);
    const unsigned rb_ = __hip_atomic_fetch_add((LAS unsigned*)hist + eb, 1u, __ATOMIC_RELAXED, __HIP_MEMORY_SCOPE_WORKGROUP);
    LDS_WAIT(); __syncthreads();
    if (tid_ < 32) basew[tid_] = __hip_atomic_fetch_add(F.ctl + CW_CNT + 64 * tid_, hist[tid_], RLX_AGENT);
    LDS_WAIT(); __syncthreads();
    { const unsigned pa = basew[ea] + ra, pb = basew[eb] + rb_;
      FWS(int, WS_ROWTK)[(size_t)ea * CAP + pa] = tok * 4 + ka; FWS(float, WS_ROWW)[(size_t)ea * CAP + pa] = wa;
      FWS(int, WS_ROWTK)[(size_t)eb * CAP + pb] = tok * 4 + kb; FWS(float, WS_ROWW)[(size_t)eb * CAP + pb] = wb; }
}

template <bool GU> struct MoeOrder {
    const char* A; const char* W; volatile LAS int* ts; volatile LAS unsigned* cntl; const LAS unsigned* tab; int c;
    __device__ bool next(int i, pg8::Unit& u) const {
        const int x = c & 7, k = c >> 3, q = 8 * i + x;
        const int rt = GU ? (4 * q + (k >> 3)) : (8 * q + (k >> 2));
        if (rt >= ts[NEXP]) return false;
        int e = 0;
        for (int j = 1; j < NEXP; ++j) e += (rt >= ts[j]) ? 1 : 0;
        u.pn = GU ? (k & 7) : (k & 3); u.e = e; u.idx = i; u.rbase = rt * 256; u.pm = (rt - ts[e]) * 256;
        const int left = (int)cntl[e] - u.pm; u.nrows = left < 256 ? left : 256; return true;
    }
    __device__ __forceinline__ const char* a_ptr(const pg8::Unit& u) const { return GU ? A : A + (size_t)u.rbase * 1024 * 2; }
    __device__ __forceinline__ const char* b_ptr(const pg8::Unit& u) const { return W + ((size_t)u.e * (GU ? 2048 : 1024) + (size_t)u.pn * 256) * 1024 * 2; }
    __device__ __forceinline__ unsigned a_off(const pg8::Unit& u, int row) const { return tab[u.idx * 256 + row]; }
    __device__ __forceinline__ void a_ready(const pg8::Unit&) const {}
    __device__ __forceinline__ void done(const pg8::Unit&) const {}
};
__device__ __forceinline__ void moe_setup(Frame& F) {
    const int tid_ = F.wave * 64 + lane_id();
    volatile LAS int* ts = (volatile LAS int*)(F.LC + 16); volatile LAS unsigned* cntl = F.LC + 64;
    if (tid_ < 32) cntl[tid_] = __hip_atomic_load(F.ctl + CW_CNT + 64 * tid_, RLX_AGENT);
    LDS_WAIT(); __syncthreads();
    if (tid_ == 0) { int acc = 0; for (int e = 0; e < NEXP; ++e) { ts[e] = acc; acc += (int)((cntl[e] + 255u) >> 8); } ts[NEXP] = acc; }
    LDS_WAIT(); __syncthreads();
}

__device__ __forceinline__ void final_phase(Frame& F) {
    const Bufs& B = F.B; const int lane = lane_id();
    const int gw = F.vcu * NWAVES + F.wave, NGW = F.G * NWAVES;
    f32x4 gv[4], bv[4];
#pragma unroll
    for (int j = 0; j < 4; ++j) { gv[j] = *(const f32x4*)(B.ln2_g + 4 * lane + 256 * j); bv[j] = *(const f32x4*)(B.ln2_b + 4 * lane + 256 * j); }
    for (int row = gw; row < NTOK; row += NGW) { float* p = B.out + (size_t)row * 1024 + 4 * lane; const bf16* orow = FWS(bf16, WS_OUTR) + (size_t)row * 4096 + 4 * lane;
        f32x4 v[4]; float s = 0.f;
#pragma unroll
        for (int j = 0; j < 4; ++j) { v[j] = *(const f32x4*)(p + 256 * j) * DN_ALPHA;
#pragma unroll
            for (int kk = 0; kk < 4; ++kk) { const u32x2 wv = *(const u32x2*)(orow + kk * 1024 + 256 * j);
                v[j][0] += __uint_as_float(wv.x << 16); v[j][1] += __uint_as_float(wv.x & 0xffff0000u); v[j][2] += __uint_as_float(wv.y << 16); v[j][3] += __uint_as_float(wv.y & 0xffff0000u); }
            s += (v[j][0] + v[j][1]) + (v[j][2] + v[j][3]); }
        const float mean = wave_sum(s) * (1.f / 1024.f); float s2 = 0.f;
#pragma unroll
        for (int j = 0; j < 4; ++j) { v[j] = v[j] - mean; s2 += (v[j][0] * v[j][0] + v[j][1] * v[j][1]) + (v[j][2] * v[j][2] + v[j][3] * v[j][3]); }
        const float rstd = rsqrtf(wave_sum(s2) * (1.f / 1024.f) + LN_EPS);
#pragma unroll
        for (int j = 0; j < 4; ++j) *(f32x4*)(p + 256 * j) = v[j] * rstd * gv[j] + bv[j]; }
}

constexpr int NPHASE = 11;
struct MArgs { Bufs B; int ph_lo, ph_hi; };
__global__ void __launch_bounds__(NWAVES * 64, 2) mega_fwd(MArgs args) {
    extern __shared__ __attribute__((aligned(16))) unsigned char lds[];
    Frame F;
    F.lds = (LAS unsigned char*)lds; F.LC = (volatile LAS unsigned*)(F.lds + LDSCTL_OFF);
    F.wave = __builtin_amdgcn_readfirstlane((int)threadIdx.x >> 6);
    F.G = gridDim.x; { const int bx = blockIdx.x; F.vcu = (F.G % 8 == 0) ? (bx % 8) * (F.G / 8) + bx / 8 : bx; }
    F.B = args.B; F.ctl = (unsigned*)(args.B.ws + WS_CTL);
    for (int u = threadIdx.x; u < 256; u += NWAVES * 64) F.LC[u] = 0u;
    __syncthreads();
    const int lo = args.ph_lo, hi = args.ph_hi;
    const bool multi = (hi - lo) > 1;
    XcdBarrier bar; bar.bar = F.ctl + CW_BAR; bar.x = 0; bar.st = nullptr;
    if (multi) bar = xcd_barrier_post(F.ctl + CW_BAR, F.LC);
#ifndef PH_COMPILE
#define PH_COMPILE 0x7FF
#endif
#define IN(k) ((((PH_COMPILE) >> (k)) & 1) && lo <= (k) && (k) < hi)
#define SEAM(k) do { if (IN(k) && IN((k) + 1)) xcd_barrier(bar); } while (0)
    LAS unsigned char* ring = F.lds + RING_OFF;
    const int c = (int)blockIdx.x;
    if (IN(0)) { p0_prologue(F); } SEAM(0);
    if (IN(1)) {
        { pg8::StaticOrder S; S.init(FDO(bf16, DO_XB), FWS(bf16, WS_WINT), NTOK, 2048, 1024, F.G, c);
          pg8::EpiQK E{FWS(bf16, WS_QSB), FWS(bf16, WS_KSB)};
          pg8::gemm_phase<pg8::EpiQK, pg8::StaticOrder, true, false>(ring, 1024, S, E, F.wave); }
        { pg8::StaticOrder S; S.init(FDO(bf16, DO_XB), FWS(bf16, WS_WINT) + (size_t)2048 * 1024, NTOK, 2048, 1024, F.G, c);
          pg8::EpiRot E{FWS(bf16, WS_QR), FWS(bf16, WS_KR), FDO(bf16, DO_KRT), FWS(bf16, WS_QRS), FWS(float, WS_COS), FWS(float, WS_SIN)};
          pg8::gemm_phase<pg8::EpiRot, pg8::StaticOrder, true, false>(ring, 1024, S, E, F.wave); }
        { pg8::StaticOrder S; S.init(FDO(bf16, DO_XB), FWS(bf16, WS_WINT) + (size_t)4096 * 1024, NTOK, 4096, 1024, F.G, c);
          pg8::EpiGate E{F.B.ws};
          pg8::gemm_phase<pg8::EpiGate, pg8::StaticOrder, true, false>(ring, 1024, S, E, F.wave); }
        { pg8::StaticOrder S; S.init(FWS(bf16, WS_WVT), FDO(bf16, DO_XB), 3072, NTOK, 1024, F.G, c);
          pg8::EpiVT E{FWS(bf16, WS_VSBT), FWS(bf16, WS_VRT)};
          pg8::gemm_phase<pg8::EpiVT, pg8::StaticOrder, true, false>(ring, 1024, S, E, F.wave); }
    } SEAM(1);
    if (IN(2)) { attn_phase(F); } SEAM(2);
    if (IN(3)) { scan_phase(F); } SEAM(3);
    if (IN(4)) { intra_phase(F); } SEAM(4);
    if (IN(5)) {
        { pg8::StaticOrder S; S.init(FWS(bf16, WS_QSB), FWS(bf16, WS_WBSBT), NTOK, 1024, 1024, F.G, c);
          pg8::EpiBranch<0> E{FWS(bf16, WS_GSB), nullptr, FWS(bf16, WS_M1)};
          pg8::gemm_phase<pg8::EpiBranch<0>, pg8::StaticOrder, true, false>(ring, 1024, S, E, F.wave); }
        { pg8::StaticOrder S; S.init(FDO(bf16, DO_R), FWS(bf16, WS_WBRETT), NTOK, 1024, 2048, F.G, c);
          pg8::EpiBranch<1> E{FWS(bf16, WS_GRET), FWS(bf16, WS_M1), FWS(bf16, WS_MG)};
          pg8::gemm_phase<pg8::EpiBranch<1>, pg8::StaticOrder, true, false>(ring, 2048, S, E, F.wave); }
    } SEAM(5);
    if (IN(6)) { pg8::StaticOrder S; S.init(FWS(bf16, WS_MG), FWS(bf16, WS_WOUTT), NTOK, 1024, 1024, F.G, c);
        pg8::EpiPre E{F.B.x, F.B.out};
        pg8::gemm_phase<pg8::EpiPre, pg8::StaticOrder, true, false>(ring, 1024, S, E, F.wave); } SEAM(6);
    if (IN(7)) { ln1_router_phase(F); } SEAM(7);
    if (IN(8)) { moe_setup(F);
        MoeOrder<true> S{(const char*)FWS(bf16, WS_X1B), (const char*)FWS(bf16, WS_WGUT), (volatile LAS int*)(F.LC + 16), F.LC + 64, (const LAS unsigned*)(F.lds + LDS_TAB_OFF), c};
        { pg8::Unit u; LAS unsigned* tab = (LAS unsigned*)(F.lds + LDS_TAB_OFF);
          const int tid_ = F.wave * 64 + lane_id();
          for (int i = 0; i < 24 && S.next(i, u); ++i) { if (tid_ < 256) { const int rr = tid_; unsigned off = 0u;
                  if (rr < u.nrows) off = (unsigned)(FWS(int, WS_ROWTK)[(size_t)u.e * CAP + u.pm + rr] >> 2) * 2048u;
                  tab[i * 256 + rr] = off; } }
          LDS_WAIT(); __syncthreads(); }
        pg8::EpiGateUp E{F.B.b_gu, FWS(bf16, WS_ACT)};
        pg8::gemm_phase<pg8::EpiGateUp, MoeOrder<true>, true, true>(ring, 1024, S, E, F.wave); } SEAM(8);
    if (IN(9)) { moe_setup(F);
        MoeOrder<false> S{(const char*)FWS(bf16, WS_ACT), (const char*)FWS(bf16, WS_WDT), (volatile LAS int*)(F.LC + 16), F.LC + 64, (const LAS unsigned*)(F.lds + LDS_TAB_OFF), c};
        pg8::EpiDown E{F.B.b_dn, FWS(int, WS_ROWTK), FWS(float, WS_ROWW), FWS(bf16, WS_OUTR)};
        pg8::gemm_phase<pg8::EpiDown, MoeOrder<false>, true, false>(ring, 1024, S, E, F.wave); } SEAM(9);
    if (IN(10)) { final_phase(F); }
#undef IN
#undef SEAM
}
#ifndef OPT_MASK
#define OPT_MASK 0x7FF
#endif
#ifndef ONE_LAUNCH
#define ONE_LAUNCH 1
#endif
template <int NB, class AF, class BF, class EF> static void launch_ngemm(hipStream_t s, int M, int N, int K, const AF& af, const BF& bf, const EF& ef) {
    GArgs<AF, BF, EF> ga; memset(&ga, 0, sizeof(ga)); ga.af = af; ga.bf = bf; ga.ef = ef; ga.M = M; ga.N = N; ga.K = K; ga.pad = 0;
    ngemm<NB, AF, BF, EF><<<dim3(N / 64, M / 64), 256, 0, s>>>(ga);
}
static void launch_tr(hipStream_t s, int grid, const float* src, int lds, int c0, int width, int K, bf16* dst, int r0) {
    TrArgs a; memset(&a, 0, sizeof(a)); a.src = src; a.dst = dst; a.lds = lds; a.c0 = c0; a.width = width; a.K = K; a.r0 = r0; a.pad = 0;
    n_tr<<<grid, 256, 0, s>>>(a);
}
static AF_rows mk_rows(const void* p, int ld) { AF_rows a; memset(&a, 0, sizeof(a)); a.A = (const bf16*)p; a.ld = ld; a.pad = 0; return a; }
static BF_wt mk_wt(const void* p, int K) { BF_wt a; memset(&a, 0, sizeof(a)); a.W = (const bf16*)p; a.K = K; a.pad = 0; return a; }
static void run_naive(const Bufs& B, hipStream_t s, int stage) {
    unsigned char* ws = B.ws;
    switch (stage) {
    case 0: {
        n_xb<<<2048, 256, 0, s>>>(B);
        bf16* wint = (bf16*)(ws + WS_WINT); bf16* wvt = (bf16*)(ws + WS_WVT);
        launch_tr(s, 1024, B.w_in, INW, 0, 2048, 1024, wint, 0);
        launch_tr(s, 1024, B.w_in, INW, 2048, 1024, 1024, wvt, 0);
        launch_tr(s, 1024, B.w_in, INW, 3072, 2048, 1024, wint, 2048);
        launch_tr(s, 1024, B.w_in, INW, 5120, 2048, 1024, wvt, 1024);
        launch_tr(s, 1024, B.w_in, INW, 7168, 4096, 1024, wint, 4096);
        launch_tr(s, 1024, B.w_bsb, 1024, 0, 1024, 1024, (bf16*)(ws + WS_WBSBT), 0);
        launch_tr(s, 1024, B.w_bret, 1024, 0, 1024, 2048, (bf16*)(ws + WS_WBRETT), 0);
        launch_tr(s, 1024, B.w_out, 1024, 0, 1024, 1024, (bf16*)(ws + WS_WOUTT), 0);
        launch_tr(s, 64, B.w_router, 32, 0, 32, 1024, (bf16*)(ws + WS_WRT), 0);
        { Tr2Args a; memset(&a, 0, sizeof(a)); a.src = B.w_gu; a.dst = (bf16*)(ws + WS_WGUT); n_tr_gu<<<4096, 256, 0, s>>>(a); }
        { Tr2Args a; memset(&a, 0, sizeof(a)); a.src = B.w_dn; a.dst = (bf16*)(ws + WS_WDT); n_tr_dn<<<4096, 256, 0, s>>>(a); }
        n_rope<<<1024, 256, 0, s>>>(B);
    } break;
    case 1: {
        BF_inproj bf; memset(&bf, 0, sizeof(bf)); bf.wint = (const bf16*)(ws + WS_WINT); bf.wvt = (const bf16*)(ws + WS_WVT); EF_inproj ef{B};
        launch_ngemm<1>(s, NTOK, INW, 1024, mk_rows((unsigned char*)B.out + DO_XB, 1024), bf, ef);
        n_rotary<<<4096, 256, 0, s>>>(B);
    } break;
    case 2: n_attn<<<BATCH * SBH * SEQ / 64, 64, 0, s>>>(B); break;
    case 3: n_scan<<<BATCH * RH * RDV, 64, 0, s>>>(B); break;
    case 4: n_intra<<<BATCH * RH * NCHUNK, 256, 0, s>>>(B); break;
    case 5: {
        { EF_m1 ef{B}; launch_ngemm<1>(s, NTOK, 1024, 1024, mk_rows(ws + WS_QSB, 1024), mk_wt(ws + WS_WBSBT, 1024), ef); }
        { EF_mg ef{B}; launch_ngemm<1>(s, NTOK, 1024, 2048, mk_rows((unsigned char*)B.out + DO_R, 2048), mk_wt(ws + WS_WBRETT, 2048), ef); }
    } break;
    case 6: { EF_pre ef{B}; launch_ngemm<1>(s, NTOK, 1024, 1024, mk_rows(ws + WS_MG, 1024), mk_wt(ws + WS_WOUTT, 1024), ef); } break;
    case 7: n_ln1<<<NTOK / 4, 256, 0, s>>>(B); n_router<<<NTOK / 64, 64, 0, s>>>(B); break;
    case 8: { n_tstart<<<1, 64, 0, s>>>(B); n_rowinfo<<<544, 256, 0, s>>>(B); AF_gather af{B}; BF_gu bf{B}; EF_gu ef{B}; launch_ngemm<2>(s, MAXROWS, 1024, 1024, af, bf, ef); } break;
    case 9: { n_tstart<<<1, 64, 0, s>>>(B); n_rowinfo<<<544, 256, 0, s>>>(B); AF_act af{B}; BF_dn bf{B}; EF_dn ef{B}; launch_ngemm<1>(s, MAXROWS, 1024, 1024, af, bf, ef); } break;
    case 10: n_final<<<NTOK / 4, 256, 0, s>>>(B); break;
    }
}
static void run_mega(const Bufs& B, hipStream_t s, int lo, int hi) {
    MArgs a; memset(&a, 0, sizeof(a)); a.B = B; a.ph_lo = lo; a.ph_hi = hi;
    hipLaunchKernelGGL(mega_fwd, dim3(256), dim3(NWAVES * 64), LDS_BYTES, s, a);
}

extern "C" void kernel_launch(void* const* d_in, const int* in_sizes, int n_in, void* d_out, int out_size, void* d_ws, size_t ws_size, hipStream_t stream) {
    if (n_in != 15 || out_size != NTOK * DM || ws_size < WS_END) { fprintf(stderr, "kernel_launch: unexpected shapes (n_in %d out %d ws %zu)\n", n_in, out_size, ws_size); return; }
    static int inited = 0;
    if (!inited) { inited = 1;
        if (hipFuncSetAttribute((const void*)mega_fwd, hipFuncAttributeMaxDynamicSharedMemorySize, LDS_BYTES) != hipSuccess) fprintf(stderr, "kernel_launch: hipFuncSetAttribute failed\n");
        int dev = 0, cus = 0; (void)hipGetDevice(&dev); (void)hipDeviceGetAttribute(&cus, hipDeviceAttributeMultiprocessorCount, dev);
        if (cus != 256) fprintf(stderr, "kernel_launch: built for 256 CUs, device has %d\n", cus);
        (void)hipGetLastError(); }
    Bufs B; memset(&B, 0, sizeof(B));
    B.x = (const float*)d_in[0]; B.w_in = (const float*)d_in[1]; B.w_bsb = (const float*)d_in[2]; B.w_bret = (const float*)d_in[3]; B.w_out = (const float*)d_in[4];
    B.ln1_g = (const float*)d_in[5]; B.ln1_b = (const float*)d_in[6]; B.w_router = (const float*)d_in[7]; B.b_router = (const float*)d_in[8];
    B.w_gu = (const float*)d_in[9]; B.b_gu = (const float*)d_in[10]; B.w_dn = (const float*)d_in[11]; B.b_dn = (const float*)d_in[12]; B.ln2_g = (const float*)d_in[13]; B.ln2_b = (const float*)d_in[14];
    B.out = (float*)d_out; B.ws = (unsigned char*)d_ws;
    (void)hipMemsetAsync((char*)d_ws + WS_CTL, 0, CTL_ZERO_BYTES, stream);
    if ((OPT_MASK & 0x7FF) == 0x7FF && ONE_LAUNCH) { run_mega(B, stream, 0, NPHASE); return; }
    for (int st = 0; st < NPHASE; ++st) { if ((OPT_MASK >> st) & 1) run_mega(B, stream, st, st + 1); else run_naive(B, stream, st);
#ifdef PROBE_DUP
        if (st == PROBE_DUP) {
            if (st == 2) { run_mega(B, stream, 1, 2); run_mega(B, stream, 2, 3); }
            else if (st == 4) { run_mega(B, stream, 3, 4); run_mega(B, stream, 4, 5); }
            else if (st == 7) { (void)hipMemsetAsync((char*)d_ws + WS_CTL, 0, CTL_ZERO_BYTES, stream); run_mega(B, stream, 6, 7); run_mega(B, stream, 7, 8); }
            else if (st == 10) { (void)hipMemsetAsync((char*)d_ws + WS_CTL, 0, CTL_ZERO_BYTES, stream); run_mega(B, stream, 6, 7); run_mega(B, stream, 7, 8); run_mega(B, stream, 10, 11); }
            else run_mega(B, stream, st, st + 1);
        }
#endif
    }
}
```

```cpp
#include <hip/hip_runtime.h>
#include <cstdio>
#include <cstdint>
#include <cstring>

constexpr int BATCH = 4, SEQ = 8192, DM = 1024, NTOK = BATCH * SEQ;
constexpr int SBH = 16, SBD = 64;
constexpr int RH = 4, RDK = 256, RDV = 512, RQK = RH * RDK  , RV = RH * RDV  ;
constexpr int CHUNK = 64, NCHUNK = SEQ / CHUNK;
constexpr int INW = 11264;
constexpr int NEXP = 32, TOPK = 4, DFF = 1024;
constexpr int CAP = NTOK;
constexpr int MAXROWS = NTOK * TOPK + NEXP * 256;
constexpr float LN_EPS = 1e-5f;
constexpr float DN_ALPHA = 1.18920711500272106672f;
constexpr float LOG2E = 1.4426950408889634f;
constexpr float SB_C2 = 0.125f * LOG2E;

typedef unsigned short bf16;
typedef float f32x4 __attribute__((ext_vector_type(4)));
typedef float f32x16 __attribute__((ext_vector_type(16)));
typedef short bf16x8 __attribute__((ext_vector_type(8)));
typedef short bf16x4 __attribute__((ext_vector_type(4)));
typedef unsigned u32x4 __attribute__((ext_vector_type(4)));
typedef unsigned u32x2 __attribute__((ext_vector_type(2)));

__host__ __device__ __forceinline__ float bf2f(bf16 v) { unsigned u = (unsigned)v << 16; return __builtin_bit_cast(float, u); }
__host__ __device__ __forceinline__ bf16 f2bf(float f) { unsigned u = __builtin_bit_cast(unsigned, f); return (bf16)((u + 0x7fffu + ((u >> 16) & 1u)) >> 16); }
__device__ __forceinline__ unsigned pk2(float lo, float hi) { return (unsigned)f2bf(lo) | ((unsigned)f2bf(hi) << 16); }

constexpr size_t MiB = 1u << 20;
constexpr size_t WS_CTL = 0, CTL_ZERO_BYTES = 1 * MiB;
constexpr size_t WS_COS = 1 * MiB, WS_SIN = 5 * MiB;
constexpr size_t WS_WRT = 9 * MiB;
constexpr size_t WS_TSTART = 9 * MiB + 512 * 1024;
constexpr size_t WS_WINT = 10 * MiB;
constexpr size_t WS_WVT = 26 * MiB;
constexpr size_t WS_WBSBT = 32 * MiB, WS_WBRETT = 34 * MiB, WS_WOUTT = 38 * MiB;
constexpr size_t WS_WGUT = 40 * MiB;
constexpr size_t WS_WDT = 168 * MiB;
constexpr size_t WS_QSB = 232 * MiB;
constexpr size_t WS_KSB = 296 * MiB;
constexpr size_t WS_VSBT = 360 * MiB;
constexpr size_t WS_YINT = 296 * MiB;
constexpr size_t WS_QR = 424 * MiB, WS_KR = 488 * MiB;
constexpr size_t WS_VRT = 552 * MiB;
constexpr size_t WS_SG = 680 * MiB;
constexpr size_t WS_GSB = 808 * MiB, WS_GRET = 872 * MiB;
constexpr size_t WS_SELE = 936 * MiB, WS_SELW = 937 * MiB;
constexpr size_t WS_ROWTK = 940 * MiB, WS_ROWW = 944 * MiB;
constexpr size_t WS_RINFO = 948 * MiB;
constexpr size_t WS_M1 = 424 * MiB, WS_MG = 488 * MiB;
constexpr size_t WS_X1B = 552 * MiB;
constexpr size_t WS_ACT = 616 * MiB;
constexpr size_t WS_OUTR = 232 * MiB;
constexpr size_t WS_END = 1024 * MiB;
static_assert(WS_ACT + (size_t)MAXROWS * 1024 * 2 <= WS_SELE, "ACT fits");
static_assert(WS_OUTR + (size_t)NTOK * 4 * 1024 * 2 <= WS_MG, "OUTR fits below MG");
constexpr size_t DO_XB = 0, DO_KRT = 64 * MiB;

__host__ __device__ __forceinline__ size_t krt_idx(int bh, int t, int d) { return ((((size_t)bh * 128 + (t >> 6)) * 4 + ((t >> 4) & 3)) * 256 + d) * 16 + (t & 15); }
__host__ __device__ __forceinline__ size_t vrt_idx(int bh, int t, int v) { return ((((size_t)bh * 128 + (t >> 6)) * 4 + ((t >> 4) & 3)) * 512 + v) * 16 + (t & 15); }
__host__ __device__ __forceinline__ size_t qrs_idx(int bh, int t, int d) { return ((((size_t)bh * 128 + (t >> 6)) * 16 + (d >> 4)) * 64 + (t & 63)) * 16 + (d & 15); }
__host__ __device__ __forceinline__ size_t yt_idx(int bh, int t, int v) { return ((((size_t)bh * 128 + (t >> 6)) * 64 + (v >> 3)) * 64 + (t & 63)) * 8 + (v & 7); }
constexpr size_t WS_QRS = 952 * MiB;
constexpr size_t DO_R = 0;
static_assert(WS_QRS + 64 * MiB <= WS_END, "QRS fits");

constexpr int CW_TMO = 0, CW_CODE = 1;
constexpr int CW_BAR = 4096;
constexpr int CW_CNT = 16384;

struct Bufs {
    const float *x, *w_in, *w_bsb, *w_bret, *w_out, *ln1_g, *ln1_b, *w_router, *b_router, *w_gu, *b_gu, *w_dn, *b_dn, *ln2_g, *ln2_b;
    float* out; unsigned char* ws;
};
#define WSP(T, off) ((T*)(B.ws + (off)))
#define DOP(T, off) ((T*)((unsigned char*)B.out + (off)))

__global__ void n_xb(Bufs B) {
    const size_t n = (size_t)NTOK * DM; bf16* xb = DOP(bf16, DO_XB);
    for (size_t i = (size_t)blockIdx.x * blockDim.x + threadIdx.x; i < n; i += (size_t)gridDim.x * blockDim.x) xb[i] = f2bf(B.x[i]);
}
struct TrArgs { const float* src; bf16* dst; int lds, c0, width, K, r0, pad; };
__global__ void n_tr(TrArgs a) {
    const float* src = a.src; bf16* dst = a.dst; const int lds = a.lds, c0 = a.c0, width = a.width, K = a.K, r0 = a.r0;
    const size_t n = (size_t)width * K;
    for (size_t i = (size_t)blockIdx.x * blockDim.x + threadIdx.x; i < n; i += (size_t)gridDim.x * blockDim.x) {
        const int k = (int)(i % K), c = (int)(i / K); dst[(size_t)(r0 + c) * K + k] = f2bf(src[(size_t)k * lds + c0 + c]); }
}
struct Tr2Args { const float* src; bf16* dst; };
__global__ void n_tr_gu(Tr2Args a) { const float* src = a.src; bf16* dst = a.dst;
    const size_t n = (size_t)NEXP * 2048 * 1024;
    for (size_t i = (size_t)blockIdx.x * blockDim.x + threadIdx.x; i < n; i += (size_t)gridDim.x * blockDim.x) {
        const int k = (int)(i % 1024); const int r = (int)((i / 1024) % 2048); const int e = (int)(i / (1024 * 2048));
        const int ct = r >> 8, bj = (r >> 7) & 1, ii = r & 127; const int c = bj * 1024 + 128 * ct + ii;
        dst[i] = f2bf(src[((size_t)e * 1024 + k) * 2048 + c]); }
}
__global__ void n_tr_dn(Tr2Args a) { const float* src = a.src; bf16* dst = a.dst;
    const size_t n = (size_t)NEXP * 1024 * 1024;
    for (size_t i = (size_t)blockIdx.x * blockDim.x + threadIdx.x; i < n; i += (size_t)gridDim.x * blockDim.x) {
        const int ff = (int)(i % 1024); const int d = (int)((i / 1024) % 1024); const int e = (int)(i / (1024 * 1024));
        dst[i] = f2bf(src[((size_t)e * 1024 + ff) * 1024 + d]); }
}
__device__ __forceinline__ float rope_inv_freq(int j) { return powf(10000.0f, -(float)j / 128.0f); }
__global__ void n_rope(Bufs B) {
    float* c = WSP(float, WS_COS); float* s = WSP(float, WS_SIN);
    for (int i = blockIdx.x * blockDim.x + threadIdx.x; i < SEQ * 128; i += gridDim.x * blockDim.x) {
        const int pos = i >> 7, j = i & 127; const float ang = (float)pos * rope_inv_freq(j);
        c[i] = (float)cos((double)ang); s[i] = (float)sin((double)ang); }
}

template <class AF, class BF, class EF> struct GArgs { AF af; BF bf; EF ef; int M, N, K, pad; };
template <int NB, class AF, class BF, class EF>
__global__ void __launch_bounds__(256) ngemm(GArgs<AF, BF, EF> ga) {
    const AF& af = ga.af; const BF& bf = ga.bf; const EF& ef = ga.ef; const int K = ga.K;
    __shared__ float As[16][65], Bs[NB][16][65];
    const int tx = threadIdx.x & 15, ty = threadIdx.x >> 4;
    const int m0 = blockIdx.y * 64, n0 = blockIdx.x * 64;
    if (!af.active(m0)) return;
    float acc[NB][4][4];
#pragma unroll
    for (int b = 0; b < NB; ++b)
#pragma unroll
        for (int i = 0; i < 4; ++i)
#pragma unroll
            for (int j = 0; j < 4; ++j) acc[b][i][j] = 0.f;
    for (int k0 = 0; k0 < K; k0 += 16) {
#pragma unroll
        for (int i = 0; i < 4; ++i) { const int idx = threadIdx.x + 256 * i; const int kk = idx & 15, mm = idx >> 4; As[kk][mm] = af(m0 + mm, k0 + kk); }
#pragma unroll
        for (int b = 0; b < NB; ++b)
#pragma unroll
            for (int i = 0; i < 4; ++i) { const int idx = threadIdx.x + 256 * i; const int kk = idx & 15, nn = idx >> 4; Bs[b][kk][nn] = bf(m0, k0 + kk, n0 + nn, b); }
        __syncthreads();
#pragma unroll
        for (int kk = 0; kk < 16; ++kk) {
            float a[4];
#pragma unroll
            for (int i = 0; i < 4; ++i) a[i] = As[kk][ty * 4 + i];
#pragma unroll
            for (int b = 0; b < NB; ++b) {
                float bb[4];
#pragma unroll
                for (int j = 0; j < 4; ++j) bb[j] = Bs[b][kk][tx * 4 + j];
#pragma unroll
                for (int i = 0; i < 4; ++i)
#pragma unroll
                    for (int j = 0; j < 4; ++j) acc[b][i][j] += a[i] * bb[j];
            }
        }
        __syncthreads();
    }
#pragma unroll
    for (int i = 0; i < 4; ++i)
#pragma unroll
        for (int j = 0; j < 4; ++j) {
            float v[NB];
#pragma unroll
            for (int b = 0; b < NB; ++b) v[b] = acc[b][i][j];
            ef(m0 + ty * 4 + i, n0 + tx * 4 + j, v);
        }
}

__device__ __forceinline__ float sigmoidf_(float x) { return 1.0f / (1.0f + __expf(-x)); }
__device__ __forceinline__ float ret_log2gamma(int h) { return log2f(1.0f - exp2f(-5.0f - (float)h)); }

struct AF_rows { const bf16* A; int ld, pad; __device__ bool active(int) const { return true; } __device__ float operator()(int m, int k) const { return bf2f(A[(size_t)m * ld + k]); } };
struct BF_inproj { const bf16 *wint, *wvt;
    __device__ float operator()(int, int k, int n, int) const {
        const bf16* row;
        if (n < 2048) row = wint + (size_t)n * 1024;
        else if (n < 3072) row = wvt + (size_t)(n - 2048) * 1024;
        else if (n < 5120) row = wint + (size_t)(2048 + n - 3072) * 1024;
        else if (n < 7168) row = wvt + (size_t)(1024 + n - 5120) * 1024;
        else row = wint + (size_t)(4096 + n - 7168) * 1024;
        return bf2f(row[k]); } };
struct EF_inproj { Bufs B;
    __device__ void operator()(int m, int n, const float (&v)[1]) const {
        const float a = v[0];
        if (n < 1024) WSP(bf16, WS_QSB)[(size_t)m * 1024 + n] = f2bf(a * SB_C2);
        else if (n < 2048) WSP(bf16, WS_KSB)[(size_t)m * 1024 + n - 1024] = f2bf(a);
        else if (n < 3072) WSP(bf16, WS_VSBT)[(size_t)(n - 2048) * NTOK + m] = f2bf(a);
        else if (n < 4096) WSP(bf16, WS_QR)[(size_t)m * 1024 + n - 3072] = f2bf(a);
        else if (n < 5120) WSP(bf16, WS_KR)[(size_t)m * 1024 + n - 4096] = f2bf(a);
        else if (n < 7168) { const int f = n - 5120, h = f >> 9; const float dec = exp2f((float)(63 - (m & 63)) * ret_log2gamma(h));
            WSP(bf16, WS_VRT)[vrt_idx((m >> 13) * 4 + h, m & (SEQ - 1), f & 511)] = f2bf(a * dec); }
        else if (n < 9216) { const int f = n - 7168; WSP(bf16, WS_SG)[yt_idx((m >> 13) * 4 + (f >> 9), m & (SEQ - 1), f & 511)] = f2bf(a * sigmoidf_(a)); }
        else if (n < 10240) WSP(bf16, WS_GSB)[(size_t)m * 1024 + n - 9216] = f2bf(sigmoidf_(a));
        else WSP(bf16, WS_GRET)[(size_t)m * 1024 + n - 10240] = f2bf(sigmoidf_(a)); } };
__global__ void n_rotary(Bufs B) {
    bf16* qr = WSP(bf16, WS_QR); bf16* kr = WSP(bf16, WS_KR); bf16* krt = DOP(bf16, DO_KRT);
    const float* ct = WSP(float, WS_COS); const float* st = WSP(float, WS_SIN);
    const size_t n = (size_t)NTOK * RH * 128;
    for (size_t i = (size_t)blockIdx.x * blockDim.x + threadIdx.x; i < n; i += (size_t)gridDim.x * blockDim.x) {
        const int j = (int)(i & 127), h = (int)((i >> 7) & 3); const int m = (int)(i >> 9); const int pos = m & (SEQ - 1);
        const float c = ct[pos * 128 + j], s = st[pos * 128 + j];
        const size_t o1 = (size_t)m * 1024 + h * 256 + j, o2 = o1 + 128;
        const int bh = (m >> 13) * 4 + h;
        { const float x1 = bf2f(qr[o1]), x2 = bf2f(qr[o2]); const bf16 r1 = f2bf((x1 * c - x2 * s) * 0.0625f), r2 = f2bf((x1 * s + x2 * c) * 0.0625f); qr[o1] = r1; qr[o2] = r2;
          WSP(bf16, WS_QRS)[qrs_idx(bh, pos, j)] = r1; WSP(bf16, WS_QRS)[qrs_idx(bh, pos, j + 128)] = r2; }
        { const float x1 = bf2f(kr[o1]), x2 = bf2f(kr[o2]); const bf16 r1 = f2bf(x1 * c - x2 * s), r2 = f2bf(x1 * s + x2 * c); kr[o1] = r1; kr[o2] = r2;
          krt[krt_idx(bh, pos, j)] = r1; krt[krt_idx(bh, pos, j + 128)] = r2; }
    }
}

__global__ void __launch_bounds__(64) n_attn(Bufs B) {
    const int gid = blockIdx.x * 64 + threadIdx.x;
    const int t = gid & (SEQ - 1), bh = gid >> 13, h = bh & 15, b = bh >> 4;
    bf16* q = WSP(bf16, WS_QSB); const bf16* k = WSP(bf16, WS_KSB); const bf16* vt = WSP(bf16, WS_VSBT);
    const size_t rb = (size_t)b * SEQ;
    float qv[64], o[64];
#pragma unroll
    for (int d = 0; d < 64; ++d) { qv[d] = bf2f(q[(rb + t) * 1024 + h * 64 + d]); o[d] = 0.f; }
    float later = 0.f;
    for (int s = t - 1; s >= 0; --s) {
        const bf16* kp = k + (rb + s) * 1024 + h * 64; float z2 = 0.f;
#pragma unroll
        for (int d = 0; d < 64; ++d) z2 += qv[d] * bf2f(kp[d]);
        const float z = z2 * 0.6931471805599453f;
        const float sp = fmaxf(z, 0.f) + log1pf(__expf(-fabsf(z)));
        const float a = __expf((z - sp) + later);
        later -= sp;
        if (a > 0.f) {
#pragma unroll
            for (int d = 0; d < 64; ++d) o[d] += a * bf2f(vt[(size_t)(h * 64 + d) * NTOK + rb + s]);
        }
    }
#pragma unroll
    for (int d = 0; d < 64; ++d) q[(rb + t) * 1024 + h * 64 + d] = f2bf(o[d]);
}

__global__ void __launch_bounds__(64) n_scan(Bufs B) {
    const int gid = blockIdx.x, v = gid & 511, h = (gid >> 9) & 3, b = gid >> 11, lane = threadIdx.x;
    const bf16* qr = WSP(bf16, WS_QR); const bf16* krt = DOP(bf16, DO_KRT); const bf16* vrt = WSP(bf16, WS_VRT); bf16* yint = WSP(bf16, WS_YINT);
    const float l2g = ret_log2gamma(h), cd = exp2f(64.f * l2g);
    float st[4] = {0.f, 0.f, 0.f, 0.f};
    for (int c = 0; c < NCHUNK; ++c) {
        const size_t tok0 = (size_t)b * SEQ + c * 64;
        for (int i = 0; i < 64; ++i) {
            const bf16* qp = qr + (tok0 + i) * 1024 + h * 256 + 4 * lane;
            float p = bf2f(qp[0]) * st[0] + bf2f(qp[1]) * st[1] + bf2f(qp[2]) * st[2] + bf2f(qp[3]) * st[3];
#pragma unroll
            for (int o = 1; o < 64; o <<= 1) p += __shfl_xor(p, o);
            if (lane == 0) yint[yt_idx(b * 4 + h, c * 64 + i, v)] = f2bf(p * exp2f((float)(i + 1) * l2g));
        }
        float ns[4] = {st[0] * cd, st[1] * cd, st[2] * cd, st[3] * cd};
        for (int j = 0; j < 64; ++j) {
            const float vv = bf2f(vrt[vrt_idx(b * 4 + h, c * 64 + j, v)]);
#pragma unroll
            for (int e = 0; e < 4; ++e) ns[e] += bf2f(krt[krt_idx(b * 4 + h, c * 64 + j, 4 * lane + e)]) * vv;
        }
#pragma unroll
        for (int e = 0; e < 4; ++e) st[e] = ns[e];
    }
}

__global__ void __launch_bounds__(256) n_intra(Bufs B) {
    __shared__ float P[64][65]; __shared__ float Y[8][512]; __shared__ float stat[8][2];
    const int gid = blockIdx.x, c = gid & 127, h = (gid >> 7) & 3, b = gid >> 9, tid = threadIdx.x;
    const bf16* qr = WSP(bf16, WS_QR); const bf16* kr = WSP(bf16, WS_KR); const bf16* vrt = WSP(bf16, WS_VRT); const bf16* sg = WSP(bf16, WS_SG); const bf16* yr = WSP(bf16, WS_YINT); bf16* rout = DOP(bf16, DO_R);
    const size_t tok0 = (size_t)b * SEQ + c * 64; const float l2g = ret_log2gamma(h);
    for (int e = tid; e < 4096; e += 256) { const int i = e >> 6, j = e & 63; float s = 0.f;
        const bf16* qp = qr + (tok0 + i) * 1024 + h * 256; const bf16* kp = kr + (tok0 + j) * 1024 + h * 256;
        for (int d = 0; d < 256; ++d) s += bf2f(qp[d]) * bf2f(kp[d]);
        const int ad = i > j ? i - j : j - i; P[i][j] = s * exp2f((float)(ad - 63 + j) * l2g); }
    __syncthreads();
    for (int i0 = 0; i0 < 64; i0 += 8) {
        for (int vv = tid; vv < 512; vv += 256) {
            float acc[8] = {0.f, 0.f, 0.f, 0.f, 0.f, 0.f, 0.f, 0.f};
            for (int j = 0; j < 64; ++j) { const float x = bf2f(vrt[vrt_idx(b * 4 + h, c * 64 + j, vv)]);
#pragma unroll
                for (int r = 0; r < 8; ++r) acc[r] += P[i0 + r][j] * x; }
#pragma unroll
            for (int r = 0; r < 8; ++r) Y[r][vv] = acc[r] + bf2f(yr[yt_idx(b * 4 + h, c * 64 + i0 + r, vv)]);
        }
        __syncthreads();
        { const int w = tid >> 6, lane = tid & 63;
          for (int r = w; r < 8; r += 4) { float s = 0.f, s2 = 0.f;
              for (int vv = lane; vv < 512; vv += 64) { const float x = Y[r][vv]; s += x; }
#pragma unroll
              for (int o = 1; o < 64; o <<= 1) s += __shfl_xor(s, o);
              const float mean = s * (1.f / 512.f);
              for (int vv = lane; vv < 512; vv += 64) { const float x = Y[r][vv] - mean; s2 += x * x; }
#pragma unroll
              for (int o = 1; o < 64; o <<= 1) s2 += __shfl_xor(s2, o);
              if (lane == 0) { stat[r][0] = mean; stat[r][1] = rsqrtf(s2 * (1.f / 512.f) + LN_EPS); } } }
        __syncthreads();
        for (int e = tid; e < 8 * 512; e += 256) { const int r = e >> 9, vv = e & 511; const size_t o = (tok0 + i0 + r) * 2048 + h * 512 + vv;
            rout[o] = f2bf(bf2f(sg[yt_idx(b * 4 + h, c * 64 + i0 + r, vv)]) * (Y[r][vv] - stat[r][0]) * stat[r][1]); }
        __syncthreads();
    }
}

struct BF_wt { const bf16* W; int K, pad; __device__ float operator()(int, int k, int n, int) const { return bf2f(W[(size_t)n * K + k]); } };
struct EF_m1 { Bufs B; __device__ void operator()(int m, int n, const float (&v)[1]) const { const size_t o = (size_t)m * 1024 + n; WSP(bf16, WS_M1)[o] = f2bf(bf2f(WSP(bf16, WS_GSB)[o]) * v[0]); } };
struct EF_mg { Bufs B; __device__ void operator()(int m, int n, const float (&v)[1]) const { const size_t o = (size_t)m * 1024 + n; WSP(bf16, WS_MG)[o] = f2bf(bf2f(WSP(bf16, WS_M1)[o]) + bf2f(WSP(bf16, WS_GRET)[o]) * v[0]); } };
struct EF_pre { Bufs B; __device__ void operator()(int m, int n, const float (&v)[1]) const { const size_t o = (size_t)m * 1024 + n; B.out[o] = DN_ALPHA * B.x[o] + v[0]; } };

__device__ __forceinline__ float wave_sum(float v) {
#pragma unroll
    for (int o = 1; o < 64; o <<= 1) v += __shfl_xor(v, o);
    return v;
}
__global__ void __launch_bounds__(256) n_ln1(Bufs B) {
    const int row = blockIdx.x * 4 + (threadIdx.x >> 6), lane = threadIdx.x & 63;
    float* p = B.out + (size_t)row * 1024; bf16* xb = WSP(bf16, WS_X1B) + (size_t)row * 1024;
    float v[16]; float s = 0.f;
#pragma unroll
    for (int j = 0; j < 16; ++j) { v[j] = p[lane + 64 * j]; s += v[j]; }
    const float mean = wave_sum(s) * (1.f / 1024.f); float s2 = 0.f;
#pragma unroll
    for (int j = 0; j < 16; ++j) { v[j] -= mean; s2 += v[j] * v[j]; }
    const float rstd = rsqrtf(wave_sum(s2) * (1.f / 1024.f) + LN_EPS);
#pragma unroll
    for (int j = 0; j < 16; ++j) { const int c = lane + 64 * j; const float y = v[j] * rstd * B.ln1_g[c] + B.ln1_b[c]; p[c] = y; xb[c] = f2bf(y); }
}
__global__ void __launch_bounds__(64) n_router(Bufs B) {
    const int tok = blockIdx.x * 64 + threadIdx.x;
    const bf16* xb = WSP(bf16, WS_X1B) + (size_t)tok * 1024; const bf16* wr = WSP(bf16, WS_WRT);
    float lg[32];
#pragma unroll
    for (int e = 0; e < 32; ++e) lg[e] = 0.f;
    for (int k = 0; k < 1024; ++k) { const float xv = bf2f(xb[k]);
#pragma unroll
        for (int e = 0; e < 32; ++e) lg[e] += xv * bf2f(wr[e * 1024 + k]); }
#pragma unroll
    for (int e = 0; e < 32; ++e) lg[e] += B.b_router[e];
    int se[4]; float sv[4];
#pragma unroll
    for (int kk = 0; kk < 4; ++kk) { float best = -INFINITY; int bi = 0;
#pragma unroll
        for (int e = 0; e < 32; ++e) { if (lg[e] > best) { best = lg[e]; bi = e; } }
        se[kk] = bi; sv[kk] = best;
#pragma unroll
        for (int e = 0; e < 32; ++e) if (e == bi) lg[e] = -INFINITY; }
    const float e1 = __expf(sv[1] - sv[0]), e2 = __expf(sv[2] - sv[0]), e3 = __expf(sv[3] - sv[0]); const float inv = 1.f / (1.f + e1 + e2 + e3);
    const float w[4] = {inv, e1 * inv, e2 * inv, e3 * inv};
    unsigned* cnt = WSP(unsigned, WS_CTL) + CW_CNT;
#pragma unroll
    for (int kk = 0; kk < 4; ++kk) { WSP(int, WS_SELE)[tok * 4 + kk] = se[kk]; WSP(float, WS_SELW)[tok * 4 + kk] = w[kk];
        const unsigned pos = atomicAdd(cnt + 64 * se[kk], 1u);
        WSP(int, WS_ROWTK)[(size_t)se[kk] * CAP + pos] = tok * 4 + kk; WSP(float, WS_ROWW)[(size_t)se[kk] * CAP + pos] = w[kk]; }
}
__global__ void n_tstart(Bufs B) {
    if (threadIdx.x == 0 && blockIdx.x == 0) { int* ts = WSP(int, WS_TSTART); const unsigned* cnt = WSP(unsigned, WS_CTL) + CW_CNT; int acc = 0;
        for (int e = 0; e < NEXP; ++e) { ts[e] = acc; acc += (int)((cnt[64 * e] + 255u) >> 8); } ts[NEXP] = acc; }
}
struct MoeRow { int e, valid, tk; float w; };
__global__ void n_rowinfo(Bufs B) {
    const int* ts = WSP(int, WS_TSTART); const unsigned* cnt = WSP(unsigned, WS_CTL) + CW_CNT; MoeRow* ri = WSP(MoeRow, WS_RINFO);
    for (int m = blockIdx.x * blockDim.x + threadIdx.x; m < MAXROWS; m += gridDim.x * blockDim.x) {
        MoeRow r; const int rt = m >> 8; int e = 0;
        while (e < NEXP - 1 && rt >= ts[e + 1]) ++e;
        const int pos = m - 256 * ts[e];
        r.e = e; r.valid = (rt < ts[NEXP]) && (pos < (int)cnt[64 * e]);
        r.tk = r.valid ? WSP(int, WS_ROWTK)[(size_t)e * CAP + pos] : 0; r.w = r.valid ? WSP(float, WS_ROWW)[(size_t)e * CAP + pos] : 0.f; ri[m] = r; }
}
struct AF_gather { Bufs B; __device__ bool active(int m0) const { return (m0 >> 8) < WSP(int, WS_TSTART)[NEXP]; }
    __device__ float operator()(int m, int k) const { const int tk = WSP(MoeRow, WS_RINFO)[m].tk; return bf2f(WSP(bf16, WS_X1B)[(size_t)(tk >> 2) * 1024 + k]); } };
struct BF_gu { Bufs B; __device__ float operator()(int m0, int k, int n, int which) const { const int e = WSP(MoeRow, WS_RINFO)[m0].e;
        const int ct = n >> 7, i = n & 127; return bf2f(WSP(bf16, WS_WGUT)[((size_t)e * 2048 + 256 * ct + 128 * which + i) * 1024 + k]); } };
__device__ __forceinline__ float moe_act(float g, float u) {
    g = fminf(g, 7.0f); u = fminf(fmaxf(u, -7.0f), 7.0f); const float glu = g * (1.0f / (1.0f + __expf(-1.702f * g))); return (u + 1.0f) * glu; }
struct EF_gu { Bufs B; __device__ void operator()(int m, int n, const float (&v)[2]) const { const MoeRow r = WSP(MoeRow, WS_RINFO)[m]; if (!r.valid) return;
        const float g = v[0] + B.b_gu[r.e * 2048 + n], u = v[1] + B.b_gu[r.e * 2048 + 1024 + n]; WSP(bf16, WS_ACT)[(size_t)m * 1024 + n] = f2bf(moe_act(g, u)); } };
struct AF_act { Bufs B; __device__ bool active(int m0) const { return (m0 >> 8) < WSP(int, WS_TSTART)[NEXP]; }
    __device__ float operator()(int m, int k) const { return WSP(MoeRow, WS_RINFO)[m].valid ? bf2f(WSP(bf16, WS_ACT)[(size_t)m * 1024 + k]) : 0.f; } };
struct BF_dn { Bufs B; __device__ float operator()(int m0, int k, int n, int) const { const int e = WSP(MoeRow, WS_RINFO)[m0].e; return bf2f(WSP(bf16, WS_WDT)[((size_t)e * 1024 + n) * 1024 + k]); } };
struct EF_dn { Bufs B; __device__ void operator()(int m, int n, const float (&v)[1]) const { const MoeRow r = WSP(MoeRow, WS_RINFO)[m]; if (!r.valid) return;
        WSP(bf16, WS_OUTR)[(size_t)r.tk * 1024 + n] = f2bf((v[0] + B.b_dn[r.e * 1024 + n]) * r.w); } };
__global__ void __launch_bounds__(256) n_final(Bufs B) {
    const int row = blockIdx.x * 4 + (threadIdx.x >> 6), lane = threadIdx.x & 63;
    float* p = B.out + (size_t)row * 1024; const bf16* orow = WSP(bf16, WS_OUTR) + (size_t)row * 4 * 1024;
    float v[16]; float s = 0.f;
#pragma unroll
    for (int j = 0; j < 16; ++j) { const int c = lane + 64 * j; float a = DN_ALPHA * bf2f(WSP(bf16, WS_X1B)[(size_t)row * 1024 + c]);
#pragma unroll
        for (int kk = 0; kk < 4; ++kk) a += bf2f(orow[kk * 1024 + c]);
        v[j] = a; s += a; }
    const float mean = wave_sum(s) * (1.f / 1024.f); float s2 = 0.f;
#pragma unroll
    for (int j = 0; j < 16; ++j) { v[j] -= mean; s2 += v[j] * v[j]; }
    const float rstd = rsqrtf(wave_sum(s2) * (1.f / 1024.f) + LN_EPS);
#pragma unroll
    for (int j = 0; j < 16; ++j) { const int c = lane + 64 * j; p[c] = v[j] * rstd * B.ln2_g[c] + B.ln2_b[c]; }
}

__device__ __forceinline__ int lane_id() { return (int)__builtin_amdgcn_mbcnt_hi(~0u, __builtin_amdgcn_mbcnt_lo(~0u, 0u)); }
namespace pg8 {
#define PG8_LAS __attribute__((address_space(3)))
constexpr int BM = 256, BK = 64, HALF = 128, HTB = HALF * BK * 2  , STAGE_BYTES = 8 * HTB, NXCD = 8, WGM = 8;
__host__ __device__ __forceinline__ int lds_byte(int r, int c) { const int st = (r >> 4) * 2 + (c >> 5), rr = r & 15, cc = c & 31, ob = rr * 64 + cc * 2; return st * 1024 + (ob ^ (((ob >> 9) & 1) << 5)); }
__host__ __device__ __forceinline__ void stage_rc(int b, int& R, int& C) { const int st = b / 1024, sb = b % 1024, swz = sb ^ (((sb >> 9) & 1) << 5); R = (st >> 1) * 16 + swz / 64; C = (st & 1) * 32 + (swz % 64) / 2; }
__host__ __device__ __forceinline__ int perm32(int rho) { const int n = rho >> 4, i = rho & 15; return 8 * (i >> 2) + 4 * n + (i & 3); }

struct Unit { int pm, pn, e, idx, rbase, nrows; };

struct StaticOrder {
    const char* A; const char* Bt; int nM, nN, nwg, G, c, K;
    __device__ void init(const void* A_, const void* Bt_, int M, int N, int K_, int G_, int c_) { A = (const char*)A_; Bt = (const char*)Bt_; nM = M / BM; nN = N / BM; nwg = nM * nN; G = G_; c = c_; K = K_; }
    __device__ bool next(int i, Unit& u) const {
        const long L = (long)i * G + c; if (L >= nwg) return false;
        int wgid = (int)L; { const int q = nwg / NXCD, r = nwg % NXCD, xcd = wgid % NXCD, off = wgid / NXCD; wgid = (xcd < r ? xcd * (q + 1) : r * (q + 1) + (xcd - r) * q) + off; }
        const int nig = WGM * nN, gid = wgid / nig, fm = gid * WGM, gsz = (nM - fm) < WGM ? (nM - fm) : WGM;
        u.pm = fm + ((wgid % nig) % gsz); u.pn = (wgid % nig) / gsz; u.e = 0; u.idx = i; u.rbase = u.pm * BM; u.nrows = BM; return true;
    }
    __device__ __forceinline__ const char* a_ptr(const Unit& u) const { return A + (size_t)u.pm * BM * K * 2; }
    __device__ __forceinline__ const char* b_ptr(const Unit& u) const { return Bt + (size_t)u.pn * BM * K * 2; }
    __device__ __forceinline__ unsigned a_off(const Unit&, int) const { return 0u; }
    __device__ __forceinline__ void a_ready(const Unit&) const {}
    __device__ __forceinline__ void done(const Unit&) const {}
};

__device__ __forceinline__ unsigned cvt_pk_bf16(float lo, float hi) { unsigned r; asm volatile("v_cvt_pk_bf16_f32 %0, %1, %2" : "=v"(r) : "v"(lo), "v"(hi)); return r; }

template <class Epi, class Sched, bool ALIGN_EPI, bool GATHER>
__device__ __forceinline__ void gemm_phase(PG8_LAS unsigned char* lds, const int K, const Sched& S, const Epi& E, const int wid) {
    int lane_ = lane_id(); asm volatile("" : "+v"(lane_));
    const int lane = lane_, tid = wid * 64 + lane, wr = wid >> 2, wc = wid & 3, fr = lane & 15, fq = lane >> 4;
    const int nt = K / BK;
    unsigned voffB[2]; int RA[2], CA[2];
#pragma unroll
    for (int i = 0; i < 2; ++i) { int R, C; stage_rc(tid * 16 + i * 8192, R, C); const int Rb = Epi::PERM ? ((R & ~31) + perm32(R & 31)) : R;
        RA[i] = R; CA[i] = C; voffB[i] = (unsigned)(Rb * K + C) * 2u; }
    const size_t kstep = (size_t)(BK * 2);
    const size_t hstep = (size_t)HALF * K * 2;
    const unsigned ldsw = (unsigned)wid * 1024u;
    const int aoff = lds_byte(wr * 64 + fr, fq * 8), boff = lds_byte(wc * 32 + fr, fq * 8);
#define PG8_SA(b, h) (((b) * 2 + (h)) * HTB)
#define PG8_SB(b, h) ((4 + (b) * 2 + (h)) * HTB)
#define PG8_STAGE(bufoff, gbase, voff) do { _Pragma("unroll") for (int _i = 0; _i < 2; ++_i) \
        __builtin_amdgcn_global_load_lds((const unsigned*)((const char*)(gbase) + (voff)[_i]), (PG8_LAS unsigned*)(lds + (bufoff) + ldsw + _i * 8192), 16, 0, 0); } while (0)
#define PG8_LDA(dst, b, h) do { _Pragma("unroll") for (int m = 0; m < 4; ++m) _Pragma("unroll") for (int k = 0; k < 2; ++k) dst[m][k] = *(const PG8_LAS bf16x8*)(lds + PG8_SA(b, h) + aoff + m * 2048 + k * 1024); } while (0)
#define PG8_LDB(dst, b, h) do { _Pragma("unroll") for (int n = 0; n < 2; ++n) _Pragma("unroll") for (int k = 0; k < 2; ++k) dst[n][k] = *(const PG8_LAS bf16x8*)(lds + PG8_SB(b, h) + boff + n * 2048 + k * 1024); } while (0)
#define PG8_MMA(ai, bj, At, Bt) do { __builtin_amdgcn_s_setprio(1); _Pragma("unroll") for (int m = 0; m < 4; ++m) _Pragma("unroll") for (int n = 0; n < 2; ++n) _Pragma("unroll") for (int k = 0; k < 2; ++k) \
        acc[ai][bj][m][n] = __builtin_amdgcn_mfma_f32_16x16x32_bf16(Bt[n][k], At[m][k], acc[ai][bj][m][n], 0, 0, 0); __builtin_amdgcn_s_setprio(0); } while (0)
#define PG8_WAIT_V(n) asm volatile("s_waitcnt vmcnt(" #n ")" ::: "memory")
#define PG8_WAIT_L(n) asm volatile("s_waitcnt lgkmcnt(" #n ")" ::: "memory")
#define PG8_BAR __builtin_amdgcn_s_barrier()
#define PG8_SCHED __builtin_amdgcn_sched_barrier(0)
#define PG8_OFFS(dst, u) do { _Pragma("unroll") for (int _h = 0; _h < 2; ++_h) _Pragma("unroll") for (int _i = 0; _i < 2; ++_i) \
        dst[_h][_i] = GATHER ? (S.a_off(u, _h * HALF + RA[_i]) + (unsigned)CA[_i] * 2u) : (unsigned)(((_h * HALF + RA[_i]) * K + CA[_i]) * 2); } while (0)
    Unit cur, nxt; int ui = 0;
    if (!S.next(0, cur)) return;
    f32x4 acc[2][2][4][2];
#pragma unroll
    for (int a = 0; a < 2; ++a)
#pragma unroll
        for (int b = 0; b < 2; ++b)
#pragma unroll
            for (int m = 0; m < 4; ++m)
#pragma unroll
                for (int n = 0; n < 2; ++n) acc[a][b][m][n] = (f32x4){0.f, 0.f, 0.f, 0.f};
    bf16x8 At[4][2], B0[2][2], B1[2][2];
    unsigned offA[2][2], offAn[2][2];
    PG8_OFFS(offA, cur);
    const char* cA = S.a_ptr(cur); const char* cB = S.b_ptr(cur);
    S.a_ready(cur);
    PG8_STAGE(PG8_SB(0, 0), cB, voffB); PG8_STAGE(PG8_SB(0, 1), cB + hstep, voffB); PG8_STAGE(PG8_SA(0, 0), cA, offA[0]); PG8_STAGE(PG8_SA(0, 1), cA, offA[1]);
    if (wr == 1) PG8_BAR;
    PG8_WAIT_V(2); PG8_BAR;
    PG8_STAGE(PG8_SB(1, 0), cB + kstep, voffB); PG8_STAGE(PG8_SA(1, 0), cA + kstep, offA[0]); PG8_STAGE(PG8_SB(1, 1), cB + hstep + kstep, voffB);
    PG8_WAIT_V(6); PG8_BAR;
    for (;;) {
        const bool has_next = S.next(ui + 1, nxt);
        const char* nA = has_next ? S.a_ptr(nxt) : cA; const char* nB = has_next ? S.b_ptr(nxt) : cB;
        if (GATHER && has_next) { PG8_OFFS(offAn, nxt); }
        else {
#pragma unroll
            for (int h = 0; h < 2; ++h)
#pragma unroll
                for (int i = 0; i < 2; ++i) offAn[h][i] = offA[h][i]; }
        for (int t = 0; t < nt; t += 2) {
            const bool last = (t == nt - 2);
            const char* a1 = cA + (size_t)(t + 1) * kstep;
            const char* a2 = last ? nA : cA + (size_t)(t + 2) * kstep; const char* b2 = last ? nB : cB + (size_t)(t + 2) * kstep;
            const char* a3 = a2 + kstep; const char* b3 = b2 + kstep;
            unsigned o2[2][2];
#pragma unroll
            for (int h = 0; h < 2; ++h)
#pragma unroll
                for (int i = 0; i < 2; ++i) o2[h][i] = (GATHER && last) ? offAn[h][i] : offA[h][i];
            if (last && has_next) S.a_ready(nxt);
            PG8_LDB(B0, 0, 0); PG8_LDB(B1, 0, 1); PG8_SCHED; PG8_LDA(At, 0, 0); PG8_STAGE(PG8_SA(1, 1), a1, offA[1]);
            PG8_WAIT_V(8); PG8_WAIT_L(0); PG8_BAR; PG8_MMA(0, 0, At, B0); PG8_MMA(0, 1, At, B1); PG8_BAR; PG8_SCHED;
            PG8_LDA(At, 0, 1); PG8_STAGE(PG8_SB(0, 0), b2, voffB); PG8_STAGE(PG8_SB(0, 1), b2 + hstep, voffB); PG8_STAGE(PG8_SA(0, 0), a2, o2[0]);
            PG8_WAIT_V(8); PG8_WAIT_L(0); PG8_BAR; PG8_MMA(1, 0, At, B0); PG8_MMA(1, 1, At, B1); PG8_BAR; PG8_SCHED;
            PG8_LDB(B0, 1, 0); PG8_LDB(B1, 1, 1); PG8_SCHED; PG8_LDA(At, 1, 0); PG8_STAGE(PG8_SA(0, 1), a2, o2[1]);
            PG8_WAIT_V(8); PG8_WAIT_L(0); PG8_BAR; PG8_MMA(0, 0, At, B0); PG8_MMA(0, 1, At, B1); PG8_BAR; PG8_SCHED;
            PG8_LDA(At, 1, 1); PG8_STAGE(PG8_SB(1, 0), b3, voffB); PG8_STAGE(PG8_SB(1, 1), b3 + hstep, voffB); PG8_STAGE(PG8_SA(1, 0), a3, o2[0]);
            PG8_WAIT_V(8); PG8_WAIT_L(0); PG8_BAR; PG8_MMA(1, 0, At, B0); PG8_MMA(1, 1, At, B1); PG8_BAR; PG8_SCHED;
        }
        if constexpr (ALIGN_EPI) { if (wr == 0) PG8_BAR; }
        { int fr2 = fr, fq2 = fq; asm volatile("" : "+v"(fr2), "+v"(fq2));
          E(acc, cur, wr, wc, fr2, fq2); } S.done(cur);
        if (!has_next) break;
#pragma unroll
        for (int a = 0; a < 2; ++a)
#pragma unroll
            for (int b = 0; b < 2; ++b)
#pragma unroll
                for (int m = 0; m < 4; ++m)
#pragma unroll
                    for (int n = 0; n < 2; ++n) acc[a][b][m][n] = (f32x4){0.f, 0.f, 0.f, 0.f};
        cur = nxt; cA = nA; cB = nB; ++ui;
#pragma unroll
        for (int h = 0; h < 2; ++h)
#pragma unroll
            for (int i = 0; i < 2; ++i) offA[h][i] = offAn[h][i];
        if constexpr (ALIGN_EPI) { if (wr == 1) PG8_BAR; }
    }
    PG8_WAIT_V(0);
    if constexpr (!ALIGN_EPI) { if (wr == 0) PG8_BAR; }
    PG8_BAR;
#undef PG8_SA
#undef PG8_SB
#undef PG8_STAGE
#undef PG8_LDA
#undef PG8_LDB
#undef PG8_MMA
#undef PG8_WAIT_V
#undef PG8_WAIT_L
#undef PG8_BAR
#undef PG8_SCHED
#undef PG8_OFFS
}
}
namespace pg8 {
__device__ __forceinline__ float fsigmoid(float x) { return __builtin_amdgcn_rcpf(1.0f + __builtin_amdgcn_exp2f(-LOG2E * x)); }
__device__ __forceinline__ u32x4 pack8(const f32x4 a, const f32x4 b) { u32x4 w; w.x = cvt_pk_bf16(a[0], a[1]); w.y = cvt_pk_bf16(a[2], a[3]); w.z = cvt_pk_bf16(b[0], b[1]); w.w = cvt_pk_bf16(b[2], b[3]); return w; }
__device__ __forceinline__ void unpack8(const u32x4 w, f32x4& a, f32x4& b) {
    a[0] = __uint_as_float(w.x << 16); a[1] = __uint_as_float(w.x & 0xffff0000u); a[2] = __uint_as_float(w.y << 16); a[3] = __uint_as_float(w.y & 0xffff0000u);
    b[0] = __uint_as_float(w.z << 16); b[1] = __uint_as_float(w.z & 0xffff0000u); b[2] = __uint_as_float(w.w << 16); b[3] = __uint_as_float(w.w & 0xffff0000u); }

struct EpiQK {
    static constexpr bool PERM = true;
    bf16 *qsb, *ksb;
    __device__ __forceinline__ void operator()(const f32x4 (&acc)[2][2][4][2], const Unit& u, int wr, int wc, int fr, int fq) const {
        const int pn = u.pn; const int row0 = u.pm * BM + wr * 64 + fr; const int cin = wc * 32 + 8 * fq;
        bf16* O = pn < 4 ? qsb : ksb; const float sc = pn < 4 ? SB_C2 : 1.0f; const int colt = (pn & 3) * 256;
#pragma unroll
        for (int ai = 0; ai < 2; ++ai)
#pragma unroll
            for (int m = 0; m < 4; ++m) { bf16* rowp = O + (size_t)(row0 + ai * HALF + m * 16) * 1024 + colt + cin;
#pragma unroll
                for (int bj = 0; bj < 2; ++bj) *(u32x4*)(rowp + bj * HALF) = pack8(acc[ai][bj][m][0] * sc, acc[ai][bj][m][1] * sc); }
    }
};
struct EpiRot {
    static constexpr bool PERM = true;
    bf16 *qr, *kr, *krt, *qrs; const float *cosT, *sinT;
    __device__ __forceinline__ void operator()(const f32x4 (&acc)[2][2][4][2], const Unit& u, int wr, int wc, int fr, int fq) const {
        const int pn = u.pn; const int row0 = u.pm * BM + wr * 64 + fr; const int cin = wc * 32 + 8 * fq;
        const bool isK = pn >= 4; const int head = pn & 3; bf16* O = isK ? kr : qr; const float sc = isK ? 1.0f : 0.0625f;
        const int pos0 = row0 & (SEQ - 1);
        f32x4 c[2], sn[2], dc[2], ds[2], ec[2], es[2];
#pragma unroll
        for (int n = 0; n < 2; ++n) { c[n] = *(const f32x4*)(cosT + pos0 * 128 + cin + 4 * n); sn[n] = *(const f32x4*)(sinT + pos0 * 128 + cin + 4 * n);
            dc[n] = *(const f32x4*)(cosT + 16 * 128 + cin + 4 * n); ds[n] = *(const f32x4*)(sinT + 16 * 128 + cin + 4 * n);
            ec[n] = *(const f32x4*)(cosT + 80 * 128 + cin + 4 * n); es[n] = *(const f32x4*)(sinT + 80 * 128 + cin + 4 * n); }
#pragma unroll
        for (int ai = 0; ai < 2; ++ai)
#pragma unroll
            for (int m = 0; m < 4; ++m) { const int row = row0 + ai * HALF + m * 16; const int pos = row & (SEQ - 1); const int bh = (row >> 13) * 4 + head;
                f32x4 o1[2], o2[2];
#pragma unroll
                for (int n = 0; n < 2; ++n) { const f32x4 x1 = acc[ai][0][m][n], x2 = acc[ai][1][m][n]; o1[n] = (x1 * c[n] - x2 * sn[n]) * sc; o2[n] = (x1 * sn[n] + x2 * c[n]) * sc; }
                if (m < 3) {
#pragma unroll
                    for (int n = 0; n < 2; ++n) { const f32x4 cc = c[n] * dc[n] - sn[n] * ds[n]; sn[n] = sn[n] * dc[n] + c[n] * ds[n]; c[n] = cc; } }
                else if (ai == 0) {
#pragma unroll
                    for (int n = 0; n < 2; ++n) { const f32x4 cc = c[n] * ec[n] - sn[n] * es[n]; sn[n] = sn[n] * ec[n] + c[n] * es[n]; c[n] = cc; } }
                bf16* rowp = O + (size_t)row * 1024 + head * 256 + cin;
                const u32x4 w1 = pack8(o1[0], o1[1]), w2 = pack8(o2[0], o2[1]);
                *(u32x4*)(rowp) = w1; *(u32x4*)(rowp + HALF) = w2;
                if (isK) {
                    bf16* tp = krt + krt_idx(bh, pos, cin);
#pragma unroll
                    for (int q = 0; q < 4; ++q) { tp[(2 * q) * 16] = (bf16)(w1[q] & 0xffffu); tp[(2 * q + 1) * 16] = (bf16)(w1[q] >> 16);
                        tp[(HALF + 2 * q) * 16] = (bf16)(w2[q] & 0xffffu); tp[(HALF + 2 * q + 1) * 16] = (bf16)(w2[q] >> 16); }
                } else {
                    *(u32x4*)(qrs + qrs_idx(bh, pos, cin)) = w1; *(u32x4*)(qrs + qrs_idx(bh, pos, cin + HALF)) = w2; }
            }
    }
};
struct EpiGate {
    static constexpr bool PERM = true;
    unsigned char* ws;
    __device__ __forceinline__ void operator()(const f32x4 (&acc)[2][2][4][2], const Unit& u, int wr, int wc, int fr, int fq) const {
        const int pn = u.pn; const int row0 = u.pm * BM + wr * 64 + fr; const int cin = wc * 32 + 8 * fq;
        const bool silu = pn < 8; bf16* O = (bf16*)(ws + WS_SG + (size_t)(silu ? 0 : 1) * (WS_GSB - WS_SG) + (size_t)(pn >= 12 ? 1 : 0) * (WS_GRET - WS_GSB));
        const int colt = (silu ? pn : (pn & 3)) * 256;
#pragma unroll
        for (int ai = 0; ai < 2; ++ai)
#pragma unroll
            for (int m = 0; m < 4; ++m) { const int row = row0 + ai * HALF + m * 16;
#pragma unroll
                for (int bj = 0; bj < 2; ++bj) { f32x4 a = acc[ai][bj][m][0], b = acc[ai][bj][m][1];
#pragma unroll
                    for (int e = 0; e < 4; ++e) { const float sa = fsigmoid(a[e]), sb = fsigmoid(b[e]); a[e] = silu ? a[e] * sa : sa; b[e] = silu ? b[e] * sb : sb; }
                    const int col = colt + cin + bj * HALF;
                    bf16* dst = silu ? O + yt_idx((row >> 13) * 4 + (col >> 9), row & (SEQ - 1), col & 511) : O + (size_t)row * 1024 + col;
                    *(u32x4*)dst = pack8(a, b); }
                asm volatile("" ::: "memory"); }
    }
};
struct EpiVT {
    static constexpr bool PERM = true;
    bf16 *vsbt, *vrt;
    __device__ __forceinline__ void operator()(const f32x4 (&acc)[2][2][4][2], const Unit& u, int wr, int wc, int fr, int fq) const {
        const int f0 = u.pm * BM + wr * 64 + fr; const int tcol = u.pn * BM + wc * 32 + 8 * fq;
        float dec[8];
        if (u.pm < 4) {
#pragma unroll
            for (int q = 0; q < 8; ++q) dec[q] = 1.0f;
        } else { const int h = (u.pm - 4) >> 1; const float l2g = __builtin_amdgcn_logf(1.0f - __builtin_amdgcn_exp2f(-5.0f - (float)h));
#pragma unroll
            for (int q = 0; q < 8; ++q) dec[q] = __builtin_amdgcn_exp2f((float)(63 - (((wc & 1) * 32 + 8 * fq + q) & 63)) * l2g); }
#pragma unroll
        for (int ai = 0; ai < 2; ++ai)
#pragma unroll
            for (int m = 0; m < 4; ++m) { const int f = f0 + ai * HALF + m * 16;
#pragma unroll
                for (int bj = 0; bj < 2; ++bj) { f32x4 a = acc[ai][bj][m][0], b = acc[ai][bj][m][1];
#pragma unroll
                    for (int e = 0; e < 4; ++e) { a[e] *= dec[e]; b[e] *= dec[4 + e]; }
                    const int tok = tcol + bj * HALF;
                    bf16* dst = u.pm < 4 ? vsbt + (size_t)f * NTOK + tok : vrt + vrt_idx((tok >> 13) * 4 + ((f - 1024) >> 9), tok & (SEQ - 1), (f - 1024) & 511);
                    *(u32x4*)dst = pack8(a, b); } }
    }
};
template <int MODE> struct EpiBranch {
    static constexpr bool PERM = true;
    const bf16* gate; const bf16* m1in; bf16* out;
    __device__ __forceinline__ void operator()(const f32x4 (&acc)[2][2][4][2], const Unit& u, int wr, int wc, int fr, int fq) const {
        const int row0 = u.pm * BM + wr * 64 + fr; const int col0 = u.pn * BM + wc * 32 + 8 * fq;
#pragma unroll
        for (int ai = 0; ai < 2; ++ai)
#pragma unroll
            for (int m = 0; m < 4; ++m) { const size_t ro = (size_t)(row0 + ai * HALF + m * 16) * 1024 + col0;
#pragma unroll
                for (int bj = 0; bj < 2; ++bj) { f32x4 ga, gb; unpack8(*(const u32x4*)(gate + ro + bj * HALF), ga, gb);
                    f32x4 a = acc[ai][bj][m][0] * ga, b = acc[ai][bj][m][1] * gb;
                    if (MODE == 1) { f32x4 pa, pb; unpack8(*(const u32x4*)(m1in + ro + bj * HALF), pa, pb); a += pa; b += pb; }
                    *(u32x4*)(out + ro + bj * HALF) = pack8(a, b); }
                asm volatile("" ::: "memory"); }
    }
};
struct EpiPre {
    static constexpr bool PERM = false;
    const float* x; float* pre;
    __device__ __forceinline__ void operator()(const f32x4 (&acc)[2][2][4][2], const Unit& u, int wr, int wc, int fr, int fq) const {
        const int row0 = u.pm * BM + wr * 64 + fr, col0 = u.pn * BM + wc * 32 + 4 * fq;
#pragma unroll
        for (int ai = 0; ai < 2; ++ai)
#pragma unroll
            for (int m = 0; m < 4; ++m) { const size_t ro = (size_t)(row0 + ai * HALF + m * 16) * 1024 + col0;
#pragma unroll
                for (int bj = 0; bj < 2; ++bj)
#pragma unroll
                    for (int n = 0; n < 2; ++n) { const size_t o = ro + bj * HALF + n * 16; *(f32x4*)(pre + o) = *(const f32x4*)(x + o) * DN_ALPHA + acc[ai][bj][m][n]; }
                asm volatile("" ::: "memory"); }
    }
};
struct EpiGateUp {
    static constexpr bool PERM = true;
    const float* bgu; bf16* act;
    __device__ __forceinline__ void operator()(const f32x4 (&acc)[2][2][4][2], const Unit& u, int wr, int wc, int fr, int fq) const {
        const int ff0 = u.pn * 128 + wc * 32 + 8 * fq; const float* bp = bgu + (size_t)u.e * 2048 + ff0;
#pragma unroll
        for (int ai = 0; ai < 2; ++ai)
#pragma unroll
            for (int m = 0; m < 4; ++m) { const int rr = ai * HALF + wr * 64 + m * 16 + fr;
                f32x4 bg[2], bu[2];
#pragma unroll
                for (int n = 0; n < 2; ++n) { bg[n] = *(const f32x4*)(bp + 4 * n); bu[n] = *(const f32x4*)(bp + 1024 + 4 * n); }
                f32x4 o[2];
#pragma unroll
                for (int n = 0; n < 2; ++n) { const f32x4 g = acc[ai][0][m][n] + bg[n], up = acc[ai][1][m][n] + bu[n];
#pragma unroll
                    for (int e = 0; e < 4; ++e) { const float gg = fminf(g[e], 7.0f), uu = fminf(fmaxf(up[e], -7.0f), 7.0f); o[n][e] = (uu + 1.0f) * gg * fsigmoid(1.702f * gg); } }
                if (rr < u.nrows) *(u32x4*)(act + (size_t)(u.rbase + rr) * 1024 + ff0) = pack8(o[0], o[1]);
                asm volatile("" ::: "memory"); }
    }
};
struct EpiDown {
    static constexpr bool PERM = true;
    const float* bdn; const int* rowtk; const float* roww; bf16* outr;
    __device__ __forceinline__ void operator()(const f32x4 (&acc)[2][2][4][2], const Unit& u, int wr, int wc, int fr, int fq) const {
        const int col0 = u.pn * BM + wc * 32 + 8 * fq; const float* bp = bdn + (size_t)u.e * 1024 + col0;
        const size_t lbase = (size_t)u.e * CAP + u.pm;
#pragma unroll
        for (int ai = 0; ai < 2; ++ai)
#pragma unroll
            for (int m = 0; m < 4; ++m) { const int rr = ai * HALF + wr * 64 + m * 16 + fr;
                if (rr < u.nrows) { const int tk = rowtk[lbase + rr]; const float w = roww[lbase + rr]; bf16* rowp = outr + (size_t)tk * 1024 + col0;
#pragma unroll
                    for (int bj = 0; bj < 2; ++bj) { const f32x4 b0 = *(const f32x4*)(bp + bj * HALF), b1 = *(const f32x4*)(bp + bj * HALF + 4);
                        *(u32x4*)(rowp + bj * HALF) = pack8((acc[ai][bj][m][0] + b0) * w, (acc[ai][bj][m][1] + b1) * w); } }
                asm volatile("" ::: "memory"); }
    }
};
}
#define GAS __attribute__((address_space(1)))
#define LAS __attribute__((address_space(3)))
typedef GAS unsigned gu32;
#define RLX_AGENT __ATOMIC_RELAXED, __HIP_MEMORY_SCOPE_AGENT
constexpr int NWAVES = 8;
constexpr int RING_OFF = 0, RING_BYTES = 131072;
constexpr int LDSCTL_OFF = RING_BYTES;
constexpr int LDS_TAB_OFF = RING_BYTES + 1024;
constexpr int LDS_BYTES = LDS_TAB_OFF + 24 * 256 * 4;
static_assert(LDS_BYTES <= 163840, "LDS");

#define XB_TMO      128
#define XB_XCNT(j)  (256  + 64 * (j))
#define XB_XSUB(j)  (1280 + 64 * (j))
#define XB_XGEN(j)  (2304 + 64 * (j))
#define XB_TOP      3328
#define XB_TOPGEN   3392
#define XCD_BAR_WORDS 3456
#define XB_SPIN_CAP (1u << 18)
__device__ __forceinline__ unsigned xb_ld(unsigned* p)              { return __hip_atomic_load(p, __ATOMIC_RELAXED, __HIP_MEMORY_SCOPE_AGENT); }
__device__ __forceinline__ unsigned xb_add(unsigned* p, unsigned v) { return __hip_atomic_fetch_add(p, v, __ATOMIC_RELAXED, __HIP_MEMORY_SCOPE_AGENT); }
__device__ __forceinline__ unsigned xb_xcc_id() { return (unsigned)__builtin_amdgcn_s_getreg((3 << 11) | 20) & 0xFu; }
#define XB_SPIN(cond, bar) do { unsigned _sp = 0; while (cond) { __builtin_amdgcn_s_sleep(1); \
    if ((++_sp & 255u) == 0u) { if (xb_ld(&(bar)[XB_TMO])) break; if (_sp > XB_SPIN_CAP) { atomicAdd(&(bar)[XB_TMO], 1u); break; } } } } while (0)
struct XcdBarrier { unsigned* bar; unsigned x; volatile LAS unsigned* st; };
__device__ __forceinline__ XcdBarrier xcd_barrier_post(unsigned* bar, volatile LAS unsigned* st) {
    XcdBarrier b; b.bar = bar; b.x = xb_xcc_id(); b.st = st;
    if (threadIdx.x == 0) (void)xb_add(&bar[XB_XCNT(b.x)], 1u);
    return b;
}
__device__ __forceinline__ void xcd_barrier_complete(unsigned* bar, unsigned x, unsigned& nloc, unsigned& nx) {
    const unsigned G = gridDim.x * gridDim.y * gridDim.z;
    unsigned sum, cnt, mine, sp = 0u;
    for (;;) {
        sum = 0u; cnt = 0u; mine = 0u;
#pragma unroll
        for (unsigned j = 0; j < 16; ++j) { const unsigned c = xb_ld(&bar[XB_XCNT(j)]); sum += c; cnt += (c > 0u) ? 1u : 0u; mine = (j == x) ? c : mine; }
        if (sum == G) break;
        __builtin_amdgcn_s_sleep(1);
        if ((++sp & 255u) == 0u) { if (xb_ld(&bar[XB_TMO])) break; if (sp > XB_SPIN_CAP) { atomicAdd(&bar[XB_TMO], 1u); break; } }
    }
    nloc = mine > 0u ? mine : 1u; nx = cnt > 0u ? cnt : 1u;
}
__device__ __forceinline__ void xcd_barrier(const XcdBarrier& b) {
    asm volatile("s_waitcnt vmcnt(0)" ::: "memory");
    __syncthreads();
    if (threadIdx.x == 0) {
        unsigned* bar = b.bar;
        __builtin_amdgcn_s_waitcnt(0);
        unsigned nloc = b.st[0], nx = b.st[1];
        if (nloc == 0u) { xcd_barrier_complete(bar, b.x, nloc, nx); b.st[0] = nloc; b.st[1] = nx; }
        const unsigned old = xb_add(&bar[XB_XSUB(b.x)], 1u);
        const unsigned gen = old / nloc;
        if (old + 1u == (gen + 1u) * nloc) {
            __builtin_amdgcn_fence(__ATOMIC_RELEASE, "agent");
            asm volatile("s_waitcnt vmcnt(0)" ::: "memory");
            const unsigned og = xb_add(&bar[XB_TOP], 1u);
            const unsigned tg = og / nx;
            if (og + 1u == (tg + 1u) * nx) xb_add(&bar[XB_TOPGEN], 1u);
            else XB_SPIN(xb_ld(&bar[XB_TOPGEN]) == tg, bar);
            __builtin_amdgcn_fence(__ATOMIC_ACQUIRE, "agent");
            xb_add(&bar[XB_XGEN(b.x)], 1u);
            asm volatile("s_waitcnt vmcnt(0)" ::: "memory");
        } else {
            XB_SPIN(xb_ld(&bar[XB_XGEN(b.x)]) == gen, bar);
            __builtin_amdgcn_fence(__ATOMIC_ACQUIRE, "agent");
            asm volatile("s_waitcnt vmcnt(0)" ::: "memory");
        }
    }
    __syncthreads();
}

struct Frame {
    LAS unsigned char* lds; volatile LAS unsigned* LC;
    unsigned* ctl;
    int wave, vcu, G;
    Bufs B;
};
#define FWS(T, off) ((T*)(F.B.ws + (off)))
#define FDO(T, off) ((T*)((unsigned char*)F.B.out + (off)))
#define LDS_WAIT() asm volatile("s_waitcnt lgkmcnt(0)" ::: "memory")
#define VM_WAIT() asm volatile("s_waitcnt vmcnt(0)" ::: "memory")

__device__ __forceinline__ f32x16 mfma32(bf16x8 a, bf16x8 b, f32x16 c) { return __builtin_amdgcn_mfma_f32_32x32x16_bf16(a, b, c, 0, 0, 0); }
__device__ __forceinline__ int crow(int r, int hi) { return (r & 3) + 8 * (r >> 2) + 4 * hi; }
__device__ __forceinline__ float swap_lo(float x, float& hi_out) { auto rr = __builtin_amdgcn_permlane32_swap(__float_as_uint(x), __float_as_uint(x), false, false); hi_out = __uint_as_float(rr[1]); return __uint_as_float(rr[0]); }
__device__ __forceinline__ bf16x8 pack_frag(const f32x16& v, int base) {
    u32x4 w; w.x = pg8::cvt_pk_bf16(v[base + 0], v[base + 1]); w.y = pg8::cvt_pk_bf16(v[base + 2], v[base + 3]); w.z = pg8::cvt_pk_bf16(v[base + 4], v[base + 5]); w.w = pg8::cvt_pk_bf16(v[base + 6], v[base + 7]);
    return __builtin_bit_cast(bf16x8, w); }
__device__ __forceinline__ bf16x8 join8(u32x2 a, u32x2 b) { u32x4 w; w.x = a.x; w.y = a.y; w.z = b.x; w.w = b.y; return __builtin_bit_cast(bf16x8, w); }
__device__ __forceinline__ float ret_l2g(int h) { return __builtin_amdgcn_logf(1.0f - __builtin_amdgcn_exp2f(-5.0f - (float)h)); }

__device__ __forceinline__ void tr_item(const float* src, int lds_, int k0, int c0, bf16* dst, int K, int r0, LAS unsigned char* scr, int lane) {
    const int kr = lane >> 4, nq = lane & 15;
    f32x4 v[4][4];
#pragma unroll
    for (int gI = 0; gI < 4; ++gI)
#pragma unroll
        for (int i = 0; i < 4; ++i) v[gI][i] = *(const f32x4*)(src + (size_t)(k0 + 16 * gI + 4 * kr + i) * lds_ + c0 + 4 * nq);
#pragma unroll
    for (int gI = 0; gI < 4; ++gI)
#pragma unroll
        for (int e = 0; e < 4; ++e) { u32x2 w; w.x = pk2(v[gI][0][e], v[gI][1][e]); w.y = pk2(v[gI][2][e], v[gI][3][e]);
            *(LAS u32x2*)(scr + (4 * nq + e) * 144 + 32 * gI + 8 * kr) = w; }
    LDS_WAIT(); asm volatile("" ::: "memory");
#pragma unroll
    for (int it = 0; it < 8; ++it) { const int n = it * 8 + (lane >> 3), ch = lane & 7;
        const u32x4 w = *(const LAS u32x4*)(scr + n * 144 + ch * 16);
        *(u32x4*)(dst + (size_t)(r0 + n) * K + k0 + 8 * ch) = w; }
    LDS_WAIT(); asm volatile("" ::: "memory");
}
__device__ __forceinline__ void p0_prologue(Frame& F) {
    const Bufs& B = F.B; const int lane_ = lane_id(), tid_ = F.wave * 64 + lane_;
    const int gw = F.vcu * NWAVES + F.wave, NGW = F.G * NWAVES;
    { const f32x4* xs = (const f32x4*)B.x; u32x4* xd = FDO(u32x4, DO_XB); const size_t n8 = (size_t)NTOK * DM / 8;
      for (size_t i = (size_t)blockIdx.x * 512 + tid_; i < n8; i += (size_t)F.G * 512) { const f32x4 a = xs[2 * i], b = xs[2 * i + 1];
          u32x4 w; w.x = pk2(a[0], a[1]); w.y = pk2(a[2], a[3]); w.z = pk2(b[0], b[1]); w.w = pk2(b[2], b[3]); xd[i] = w; } }
    LAS unsigned char* scr = F.lds + RING_OFF + F.wave * 9216;
    constexpr int I_IN = 16 * (INW / 64)  , I_BSB = 256, I_BRET = 32 * 16, I_OUT = 256;
    constexpr int NITEMS = I_IN + I_BSB + I_BRET + I_OUT;
    for (int it = gw; it < NITEMS; it += NGW) {
        int r = it;
        if (r < I_IN) { const int kb = r / (INW / 64), nb = r % (INW / 64); const int c0 = nb * 64; bf16* dst; int r0;
            if (c0 < 2048) { dst = FWS(bf16, WS_WINT); r0 = c0; } else if (c0 < 3072) { dst = FWS(bf16, WS_WVT); r0 = c0 - 2048; }
            else if (c0 < 5120) { dst = FWS(bf16, WS_WINT); r0 = 2048 + c0 - 3072; } else if (c0 < 7168) { dst = FWS(bf16, WS_WVT); r0 = 1024 + c0 - 5120; }
            else { dst = FWS(bf16, WS_WINT); r0 = 4096 + c0 - 7168; }
            tr_item(B.w_in, INW, kb * 64, c0, dst, 1024, r0, scr, lane_); continue; } r -= I_IN;
        if (r < I_BSB) { tr_item(B.w_bsb, 1024, (r >> 4) * 64, (r & 15) * 64, FWS(bf16, WS_WBSBT), 1024, (r & 15) * 64, scr, lane_); continue; } r -= I_BSB;
        if (r < I_BRET) { tr_item(B.w_bret, 1024, (r >> 4) * 64, (r & 15) * 64, FWS(bf16, WS_WBRETT), 2048, (r & 15) * 64, scr, lane_); continue; } r -= I_BRET;
        tr_item(B.w_out, 1024, (r >> 4) * 64, (r & 15) * 64, FWS(bf16, WS_WOUTT), 1024, (r & 15) * 64, scr, lane_);
    }
    { float* ct = FWS(float, WS_COS); float* st = FWS(float, WS_SIN);
      for (int i = blockIdx.x * 512 + tid_; i < SEQ * 128; i += F.G * 512) { const int pos = i >> 7, j = i & 127; const float ang = (float)pos * rope_inv_freq(j);
          ct[i] = (float)cos((double)ang); st[i] = (float)sin((double)ang); } }
    { bf16* wrt = FWS(bf16, WS_WRT);
      for (int i = blockIdx.x * 512 + tid_; i < 32 * 1024; i += F.G * 512) { const int k = i & 1023, e = i >> 10; wrt[i] = f2bf(B.w_router[k * 32 + e]); } }
}
__device__ __forceinline__ void attn_wave_unit(const bf16* __restrict__ KSB, const bf16* __restrict__ VSBT, bf16* QY, int b, int h, int qb, int lane) {
    const int r32 = lane & 31, hi = lane >> 5;
    const int t0 = qb * 32; const size_t rb = (size_t)b * SEQ; const int tq = t0 + r32;
    bf16x8 qf[4];
    { const bf16* qp = QY + (rb + t0 + r32) * 1024 + h * 64 + 8 * hi;
#pragma unroll
      for (int d0 = 0; d0 < 4; ++d0) qf[d0] = *(const bf16x8*)(qp + 16 * d0); }
    f32x16 o0 = {}, o1 = {};
    float carry = 1.0f;
    const bf16* vrow0 = VSBT + (size_t)(h * 64 + r32) * NTOK + rb;
    for (int tile = 0;; ++tile) {
        const int ks = t0 + 32 - 64 * (tile + 1);
        const int kc0 = max(ks + r32, 0), kc1 = max(ks + 32 + r32, 0);
        const bf16* kp0 = KSB + (rb + kc0) * 1024 + h * 64 + 8 * hi; const bf16* kp1 = KSB + (rb + kc1) * 1024 + h * 64 + 8 * hi;
        f32x16 p0 = {}, p1 = {};
#pragma unroll
        for (int d0 = 0; d0 < 4; ++d0) { const bf16x8 a0 = *(const bf16x8*)(kp0 + 16 * d0), a1 = *(const bf16x8*)(kp1 + 16 * d0);
            p0 = mfma32(a0, qf[d0], p0); p1 = mfma32(a1, qf[d0], p1); }
        bf16x8 vf[2][4];
#pragma unroll
        for (int s = 0; s < 4; ++s) { const int ta = max(ks + 16 * s + 4 * hi, 0), tb = max(ks + 16 * s + 8 + 4 * hi, 0);
#pragma unroll
            for (int db = 0; db < 2; ++db) { const bf16* vp = vrow0 + (size_t)db * 32 * NTOK; vf[db][s] = join8(*(const u32x2*)(vp + ta), *(const u32x2*)(vp + tb)); } }
        f32x16 u0, u1;
        const bool need_mask = (tile == 0) || (ks < 0);
#pragma unroll
        for (int r = 0; r < 16; ++r) { const float e0 = __builtin_amdgcn_exp2f(fminf(p0[r], 100.0f)), e1 = __builtin_amdgcn_exp2f(fminf(p1[r], 100.0f));
            u0[r] = __builtin_amdgcn_rcpf(1.0f + e0); u1[r] = __builtin_amdgcn_rcpf(1.0f + e1); p0[r] = e0 * u0[r]; p1[r] = e1 * u1[r]; }
        if (need_mask) {
#pragma unroll
            for (int r = 0; r < 16; ++r) { const int s0 = ks + crow(r, hi), s1 = s0 + 32;
                const bool v0 = (s0 >= 0) && (s0 < tq), v1 = (s1 >= 0) && (s1 < tq);
                u0[r] = v0 ? u0[r] : 1.0f; p0[r] = v0 ? p0[r] : 0.0f; u1[r] = v1 ? u1[r] : 1.0f; p1[r] = v1 ? p1[r] : 0.0f; }
        }
        float R[8], Rhi[8], T[8];
#pragma unroll
        for (int g = 0; g < 4; ++g) { R[g] = (u0[4 * g] * u0[4 * g + 1]) * (u0[4 * g + 2] * u0[4 * g + 3]); R[4 + g] = (u1[4 * g] * u1[4 * g + 1]) * (u1[4 * g + 2] * u1[4 * g + 3]); }
#pragma unroll
        for (int a = 0; a < 8; ++a) { float rh; const float rl = swap_lo(R[a], rh); Rhi[a] = rh; T[a] = rl * rh; }
        float X[8]; X[7] = 1.0f;
#pragma unroll
        for (int a = 6; a >= 0; --a) X[a] = X[a + 1] * T[a + 1];
        const float total = X[0] * T[0];
#pragma unroll
        for (int a = 0; a < 8; ++a) { const float ec = X[a] * (hi == 0 ? Rhi[a] : 1.0f) * carry; const int g = a & 3;
            if (a < 4) { const float w2 = u0[4 * g + 3], w1 = w2 * u0[4 * g + 2], w0 = w1 * u0[4 * g + 1];
                p0[4 * g + 3] *= ec; p0[4 * g + 2] *= w2 * ec; p0[4 * g + 1] *= w1 * ec; p0[4 * g] *= w0 * ec; }
            else { const float w2 = u1[4 * g + 3], w1 = w2 * u1[4 * g + 2], w0 = w1 * u1[4 * g + 1];
                p1[4 * g + 3] *= ec; p1[4 * g + 2] *= w2 * ec; p1[4 * g + 1] *= w1 * ec; p1[4 * g] *= w0 * ec; } }
        carry *= total;
#pragma unroll
        for (int s = 0; s < 4; ++s) { const bf16x8 pf = (s < 2) ? pack_frag(p0, 8 * (s & 1)) : pack_frag(p1, 8 * (s & 1));
            o0 = mfma32(vf[0][s], pf, o0); o1 = mfma32(vf[1][s], pf, o1); }
        if (ks <= 0) break;
        if (__all(carry < 1.0e-37f)) break;
    }
    bf16* op = QY + (rb + t0 + r32) * 1024 + h * 64 + 4 * hi;
#pragma unroll
    for (int g = 0; g < 4; ++g) { u32x2 w; w.x = pg8::cvt_pk_bf16(o0[4 * g], o0[4 * g + 1]); w.y = pg8::cvt_pk_bf16(o0[4 * g + 2], o0[4 * g + 3]); *(u32x2*)(op + 8 * g) = w;
        u32x2 w2; w2.x = pg8::cvt_pk_bf16(o1[4 * g], o1[4 * g + 1]); w2.y = pg8::cvt_pk_bf16(o1[4 * g + 2], o1[4 * g + 3]); *(u32x2*)(op + 32 + 8 * g) = w2; }
}
constexpr int I_GU = 32 * 16 * 32, I_DN = 32 * 16 * 16, I_MOE = I_GU + I_DN;
__device__ __forceinline__ void moe_tr_item(Frame& F, int r, LAS unsigned char* scr, int lane) {
    const Bufs& B = F.B;
    if (r < I_GU) { const int e = r >> 9, q = r & 511, kb = q >> 5, nb = q & 31; const int c0 = nb * 64; const int bj = c0 >> 10, rem = c0 & 1023, ct = rem >> 7, i0 = rem & 127;
        tr_item(B.w_gu + (size_t)e * 1024 * 2048, 2048, kb * 64, c0, FWS(bf16, WS_WGUT) + (size_t)e * 2048 * 1024, 1024, 256 * ct + 128 * bj + i0, scr, lane); return; }
    r -= I_GU;
    { const int e = r >> 8, q = r & 255, kb = q >> 4, nb = q & 15;
      tr_item(B.w_dn + (size_t)e * 1024 * 1024, 1024, kb * 64, nb * 64, FWS(bf16, WS_WDT) + (size_t)e * 1024 * 1024, 1024, nb * 64, scr, lane); }
}
__device__ __forceinline__ void attn_phase(Frame& F) {
    const int gw = F.vcu * NWAVES + F.wave, NGW = F.G * NWAVES; const int lane = lane_id();
    LAS unsigned char* scr = F.lds + RING_OFF + F.wave * 9216;
    int it = gw;
    for (int wu = gw; wu < BATCH * SBH * (SEQ / 32); wu += NGW) { const int qb = wu & 255, bh = wu >> 8;
        attn_wave_unit(FWS(bf16, WS_KSB), FWS(bf16, WS_VSBT), FWS(bf16, WS_QSB), bh >> 4, bh & 15, qb, lane);
        for (int z = 0; z < 2 && it < I_MOE; ++z, it += NGW) moe_tr_item(F, it, scr, lane); }
    for (; it < I_MOE; it += NGW) moe_tr_item(F, it, scr, lane);
}

__device__ __forceinline__ int swap23(int m) { return (m & ~12) | ((m & 4) << 1) | ((m & 8) >> 1); }
__device__ __forceinline__ void scan_phase(Frame& F) {
    if (F.vcu >= BATCH * RH * 16) return;
    const int lane = lane_id(), w = F.wave, r32 = lane & 31, hi = lane >> 5;
    const int bh = F.vcu >> 4, vs = F.vcu & 15, h = bh & 3;
    const float l2g = ret_l2g(h), cd = __builtin_amdgcn_exp2f(64.0f * l2g);
    const bf16* ktp = FDO(bf16, DO_KRT) + ((size_t)bh * 128 * 4 * 256 + (32 * w + swap23(r32))) * 16 + 8 * hi;
    const bf16* vtp = FWS(bf16, WS_VRT) + ((size_t)bh * 128 * 4 * 512 + (32 * vs + r32)) * 16 + 8 * hi;
    const bf16* qp = FWS(bf16, WS_QRS) + ((size_t)bh * 128 * 16 * 64 + (size_t)(2 * w) * 64 + r32) * 16 + 8 * hi;
    bf16* yp = FWS(bf16, WS_YINT) + ((size_t)bh * 128 * 64 + (size_t)(4 * vs + (r32 >> 3))) * 512 + (r32 & 7);
    LAS f32x4* part = (LAS f32x4*)(F.lds + RING_OFF);
    f32x16 S = {};
    bf16x8 kfA[4], vfA[4], qfA[2][2], kfB[4], vfB[4], qfB[2][2];
#define SCAN_LOAD(kf, vf, qf, c) do { _Pragma("unroll") for (int s = 0; s < 4; ++s) { kf[s] = *(const bf16x8*)(ktp + (size_t)((c) * 4 + s) * 4096); vf[s] = *(const bf16x8*)(vtp + (size_t)((c) * 4 + s) * 8192); } \
        _Pragma("unroll") for (int ib = 0; ib < 2; ++ib) _Pragma("unroll") for (int s = 0; s < 2; ++s) qf[ib][s] = *(const bf16x8*)(qp + (size_t)(c) * 16384 + s * 1024 + ib * 512); } while (0)
#define SCAN_STEP(kf, vf, qf, c) do { \
        const bf16x8 sb0 = pack_frag(S, 0), sb1 = pack_frag(S, 8); \
        f32x16 y0 = {}, y1 = {}; \
        y0 = mfma32(qf[0][0], sb0, y0); y0 = mfma32(qf[0][1], sb1, y0); \
        y1 = mfma32(qf[1][0], sb0, y1); y1 = mfma32(qf[1][1], sb1, y1); \
        LAS f32x4* pb = part + ((c) & 1) * 4096 + (w * 8) * 64 + lane; \
        _Pragma("unroll") for (int q = 0; q < 4; ++q) { pb[q * 64] = (f32x4){y0[4 * q], y0[4 * q + 1], y0[4 * q + 2], y0[4 * q + 3]}; pb[(4 + q) * 64] = (f32x4){y1[4 * q], y1[4 * q + 1], y1[4 * q + 2], y1[4 * q + 3]}; } \
        _Pragma("unroll") for (int r = 0; r < 16; ++r) S[r] *= cd; \
        _Pragma("unroll") for (int s = 0; s < 4; ++s) S = mfma32(kf[s], vf[s], S); \
        if ((c) + 2 < NCHUNK) SCAN_LOAD(kf, vf, qf, (c) + 2); \
        LDS_WAIT(); __builtin_amdgcn_s_barrier(); asm volatile("" ::: "memory"); \
        const LAS f32x4* rbp = part + ((c) & 1) * 4096 + w * 64 + lane;         \
        f32x4 acc = rbp[0]; \
        _Pragma("unroll") for (int w2 = 1; w2 < 8; ++w2) acc += rbp[w2 * 8 * 64]; \
        _Pragma("unroll") for (int k = 0; k < 4; ++k) { const int idx = 4 * w + k, ib = idx >> 4, r = idx & 15; const int i = 32 * ib + crow(r, hi); \
            yp[(size_t)(c) * 32768 + i * 8] = f2bf(acc[k] * __builtin_amdgcn_exp2f((float)(i + 1) * l2g)); } } while (0)
    SCAN_LOAD(kfA, vfA, qfA, 0); SCAN_LOAD(kfB, vfB, qfB, 1);
    for (int c = 0; c < NCHUNK; c += 2) { SCAN_STEP(kfA, vfA, qfA, c); SCAN_STEP(kfB, vfB, qfB, c + 1); }
#undef SCAN_STEP
#undef SCAN_LOAD
    LDS_WAIT(); __syncthreads();
}

__device__ __forceinline__ void intra_phase(Frame& F) {
    const int lane = lane_id(), w = F.wave, r32 = lane & 31, hi = lane >> 5;
    LAS float* part = (LAS float*)(F.lds + RING_OFF);
    LAS u32x4* pfl = (LAS u32x4*)(F.lds + RING_OFF + 16384);
    LAS float* red = (LAS float*)(F.lds + RING_OFF + 24576);
    LAS unsigned char* stg = F.lds + RING_OFF + 32768 + w * 9216;
    const int tl = w & 3, jb = tl >> 1, ibt = tl & 1, kh = w >> 2;
    for (int un = F.vcu * 8; un < F.vcu * 8 + 8 && un < BATCH * RH * NCHUNK; ++un) {
        const int c = un & 127, h = (un >> 7) & 3, b = un >> 9, bh = b * 4 + h;
        const size_t tok0 = (size_t)b * SEQ + c * 64; const float l2g = ret_l2g(h);
        bf16x8 kfr[8], qfr[8];
        { const bf16* kp = FWS(bf16, WS_KR) + (tok0 + 32 * jb + r32) * 1024 + h * 256 + 128 * kh + 8 * hi;
          const bf16* qp = FWS(bf16, WS_QRS) + (((size_t)bh * 128 + c) * 16 + 8 * kh) * 1024 + (32 * ibt + r32) * 16 + 8 * hi;
#pragma unroll
          for (int s = 0; s < 8; ++s) { kfr[s] = *(const bf16x8*)(kp + 16 * s); qfr[s] = *(const bf16x8*)(qp + s * 1024); } }
        bf16x8 vfr[2][4];
        { const bf16* vp = FWS(bf16, WS_VRT) + (((size_t)bh * 128 + c) * 4 * 512 + 64 * w + r32) * 16 + 4 * hi;
#pragma unroll
          for (int vb = 0; vb < 2; ++vb)
#pragma unroll
              for (int ks = 0; ks < 4; ++ks) { const bf16* p = vp + (size_t)ks * 8192 + vb * 512; vfr[vb][ks] = join8(*(const u32x2*)(p), *(const u32x2*)(p + 8)); } }
        const size_t tbase = ((((size_t)bh * 128 + c) * 64 + 8 * w) * 64 + r32) * 8 + 4 * hi;
        const bf16* yrow = FWS(bf16, WS_YINT) + tbase; const bf16* srow = FWS(bf16, WS_SG) + tbase;
        u32x2 yv[2][2][4];
#pragma unroll
        for (int ib = 0; ib < 2; ++ib)
#pragma unroll
            for (int vb = 0; vb < 2; ++vb)
#pragma unroll
                for (int g = 0; g < 4; ++g) yv[ib][vb][g] = *(const u32x2*)(yrow + (size_t)(4 * vb + g) * 512 + ib * 256);
        f32x16 X = {};
#pragma unroll
        for (int s = 0; s < 8; ++s) X = mfma32(kfr[s], qfr[s], X);
        u32x2 sv[2][2][4];
#pragma unroll
        for (int ib = 0; ib < 2; ++ib)
#pragma unroll
            for (int vb = 0; vb < 2; ++vb)
#pragma unroll
                for (int g = 0; g < 4; ++g) sv[ib][vb][g] = *(const u32x2*)(srow + (size_t)(4 * vb + g) * 512 + ib * 256);
        if (kh == 1) {
#pragma unroll
            for (int r = 0; r < 16; ++r) part[(tl * 16 + r) * 64 + lane] = X[r]; }
        LDS_WAIT(); __builtin_amdgcn_s_barrier(); asm volatile("" ::: "memory");
        if (kh == 0) {
#pragma unroll
            for (int r = 0; r < 16; ++r) { const int j = 32 * jb + crow(r, hi), i = 32 * ibt + r32;
                X[r] = (X[r] + part[(tl * 16 + r) * 64 + lane]) * __builtin_amdgcn_exp2f((float)((j <= i ? i - j : j - i) - 63 + j) * l2g); }
            pfl[(ibt * 4 + 2 * jb) * 64 + lane] = __builtin_bit_cast(u32x4, pack_frag(X, 0)); pfl[(ibt * 4 + 2 * jb + 1) * 64 + lane] = __builtin_bit_cast(u32x4, pack_frag(X, 8)); }
        LDS_WAIT(); __builtin_amdgcn_s_barrier(); asm volatile("" ::: "memory");
        f32x16 Y[2][2] = {};
#pragma unroll
        for (int ks = 0; ks < 4; ++ks) { const bf16x8 p0 = __builtin_bit_cast(bf16x8, pfl[(0 * 4 + ks) * 64 + lane]), p1 = __builtin_bit_cast(bf16x8, pfl[(1 * 4 + ks) * 64 + lane]);
#pragma unroll
            for (int vb = 0; vb < 2; ++vb) { Y[vb][0] = mfma32(vfr[vb][ks], p0, Y[vb][0]); Y[vb][1] = mfma32(vfr[vb][ks], p1, Y[vb][1]); } }
        float s1[2] = {0.f, 0.f}, s2[2] = {0.f, 0.f};
#pragma unroll
        for (int ib = 0; ib < 2; ++ib)
#pragma unroll
            for (int vb = 0; vb < 2; ++vb)
#pragma unroll
                for (int g = 0; g < 4; ++g) { const u32x2 wv = yv[ib][vb][g];
                    Y[vb][ib][4 * g] += __uint_as_float(wv.x << 16); Y[vb][ib][4 * g + 1] += __uint_as_float(wv.x & 0xffff0000u); Y[vb][ib][4 * g + 2] += __uint_as_float(wv.y << 16); Y[vb][ib][4 * g + 3] += __uint_as_float(wv.y & 0xffff0000u);
#pragma unroll
                    for (int e = 0; e < 4; ++e) { const float y = Y[vb][ib][4 * g + e]; s1[ib] += y; s2[ib] += y * y; } }
#pragma unroll
        for (int ib = 0; ib < 2; ++ib) { float h1, h2; const float l1 = swap_lo(s1[ib], h1), l2 = swap_lo(s2[ib], h2);
            if (hi == 0) { red[(w * 64 + 32 * ib + r32) * 2] = l1 + h1; red[(w * 64 + 32 * ib + r32) * 2 + 1] = l2 + h2; } }
        LDS_WAIT(); __builtin_amdgcn_s_barrier(); asm volatile("" ::: "memory");
#pragma unroll
        for (int ib = 0; ib < 2; ++ib) { float t1 = 0.f, t2 = 0.f;
#pragma unroll
            for (int w2 = 0; w2 < 8; ++w2) { t1 += red[(w2 * 64 + 32 * ib + r32) * 2]; t2 += red[(w2 * 64 + 32 * ib + r32) * 2 + 1]; }
            const float mean = t1 * (1.0f / 512.0f), var = fmaxf(t2 * (1.0f / 512.0f) - mean * mean, 0.0f), rstd = __builtin_amdgcn_rsqf(var + LN_EPS);
#pragma unroll
            for (int vb = 0; vb < 2; ++vb)
#pragma unroll
                for (int g = 0; g < 4; ++g) { const u32x2 sw = sv[ib][vb][g];
                    const float g0 = __uint_as_float(sw.x << 16), g1 = __uint_as_float(sw.x & 0xffff0000u), g2 = __uint_as_float(sw.y << 16), g3 = __uint_as_float(sw.y & 0xffff0000u);
                    u32x2 ov; ov.x = pg8::cvt_pk_bf16(g0 * (Y[vb][ib][4 * g] - mean) * rstd, g1 * (Y[vb][ib][4 * g + 1] - mean) * rstd);
                    ov.y = pg8::cvt_pk_bf16(g2 * (Y[vb][ib][4 * g + 2] - mean) * rstd, g3 * (Y[vb][ib][4 * g + 3] - mean) * rstd);
                    *(LAS u32x2*)(stg + (32 * ib + r32) * 144 + (32 * vb + 8 * g + 4 * hi) * 2) = ov; } }
        LDS_WAIT(); asm volatile("" ::: "memory");
        { bf16* rp = FDO(bf16, DO_R) + (tok0 + (lane >> 3)) * 2048 + h * 512 + 64 * w + 8 * (lane & 7);
#pragma unroll
          for (int k = 0; k < 8; ++k) { const u32x4 v = *(const LAS u32x4*)(stg + (8 * k + (lane >> 3)) * 144 + (lane & 7) * 16); *(u32x4*)(rp + (size_t)(8 * k) * 2048) = v; } }
        LDS_WAIT(); asm volatile("" ::: "memory");
    }
    LDS_WAIT(); __syncthreads();
}

__device__ __forceinline__ void ln1_router_phase(Frame& F) {
    const Bufs& B = F.B;
    const int lane = lane_id(), w = F.wave, r32 = lane & 31, hi = lane >> 5; const int tid_ = w * 64 + lane;
    LAS unsigned char* xt = F.lds + RING_OFF;
    LAS f32x4* pl = (LAS f32x4*)(F.lds + RING_OFF + 66048);
    LAS int* selE = (LAS int*)(F.lds + RING_OFF + 98816);
    LAS float* selW = (LAS float*)(F.lds + RING_OFF + 98816 + 2048);
    volatile LAS unsigned* hist = F.LC + 96; volatile LAS unsigned* basew = F.LC + 128;
    if (tid_ < 32) hist[tid_] = 0u;
    f32x4 gv[4], bv[4];
#pragma unroll
    for (int j = 0; j < 4; ++j) { gv[j] = *(const f32x4*)(B.ln1_g + 4 * lane + 256 * j); bv[j] = *(const f32x4*)(B.ln1_b + 4 * lane + 256 * j); }
    const int wgrow0 = F.vcu * 128;
    for (int blk = 0; blk < 4; ++blk) {
        const int row0 = wgrow0 + 32 * blk;
#pragma unroll
        for (int rr = 0; rr < 4; ++rr) { const int lr = 4 * w + rr; const float* p = B.out + (size_t)(row0 + lr) * 1024 + 4 * lane; bf16* xb = FWS(bf16, WS_X1B) + (size_t)(row0 + lr) * 1024 + 4 * lane;
            f32x4 v[4]; float s = 0.f;
#pragma unroll
            for (int j = 0; j < 4; ++j) { v[j] = *(const f32x4*)(p + 256 * j); s += (v[j][0] + v[j][1]) + (v[j][2] + v[j][3]); }
            const float mean = wave_sum(s) * (1.f / 1024.f); float s2 = 0.f;
#pragma unroll
            for (int j = 0; j < 4; ++j) { v[j] = v[j] - mean; s2 += (v[j][0] * v[j][0] + v[j][1] * v[j][1]) + (v[j][2] * v[j][2] + v[j][3] * v[j][3]); }
            const float rstd = rsqrtf(wave_sum(s2) * (1.f / 1024.f) + LN_EPS);
#pragma unroll
            for (int j = 0; j < 4; ++j) { const f32x4 y = v[j] * rstd * gv[j] + bv[j];
                u32x2 o; o.x = pg8::cvt_pk_bf16(y[0], y[1]); o.y = pg8::cvt_pk_bf16(y[2], y[3]); *(u32x2*)(xb + 256 * j) = o;
                *(LAS u32x2*)(xt + lr * 2064 + (4 * lane + 256 * j) * 2) = o; } }
        LDS_WAIT(); __builtin_amdgcn_s_barrier(); asm volatile("" ::: "memory");
        f32x16 acc = {};
        { const bf16* ap = FWS(bf16, WS_WRT) + (size_t)r32 * 1024 + 128 * w + 8 * hi; const LAS unsigned char* bp = xt + r32 * 2064 + (128 * w + 8 * hi) * 2;
#pragma unroll
          for (int s = 0; s < 8; ++s) acc = mfma32(*(const bf16x8*)(ap + 16 * s), *(const LAS bf16x8*)(bp + 32 * s), acc); }
#pragma unroll
        for (int q = 0; q < 4; ++q) pl[(w * 4 + q) * 64 + lane] = (f32x4){acc[4 * q], acc[4 * q + 1], acc[4 * q + 2], acc[4 * q + 3]};
        LDS_WAIT(); __builtin_amdgcn_s_barrier(); asm volatile("" ::: "memory");
        const bool fin = (w == (blk & 7));
        f32x4 t[4];
        if (fin) {
#pragma unroll
            for (int q = 0; q < 4; ++q) { t[q] = pl[q * 64 + lane];
#pragma unroll
                for (int w2 = 1; w2 < 8; ++w2) t[q] += pl[(w2 * 4 + q) * 64 + lane]; } }
        LDS_WAIT(); __builtin_amdgcn_s_barrier(); asm volatile("" ::: "memory");
        if (fin) {
            float lo[16], hv[16];
#pragma unroll
            for (int r = 0; r < 16; ++r) { const float x = t[r >> 2][r & 3] + B.b_router[crow(r, hi)]; float h_; lo[r] = swap_lo(x, h_); hv[r] = h_; }
            int se[4]; float sv[4];
#pragma unroll
            for (int kk = 0; kk < 4; ++kk) { float best = -INFINITY; int bi = 0;
#pragma unroll
                for (int g = 0; g < 4; ++g) {
#pragma unroll
                    for (int e = 0; e < 4; ++e) { if (lo[4 * g + e] > best) { best = lo[4 * g + e]; bi = 8 * g + e; } }
#pragma unroll
                    for (int e = 0; e < 4; ++e) { if (hv[4 * g + e] > best) { best = hv[4 * g + e]; bi = 8 * g + 4 + e; } } }
                se[kk] = bi; sv[kk] = best;
#pragma unroll
                for (int r = 0; r < 16; ++r) { if (bi == crow(r, 0)) lo[r] = -INFINITY; if (bi == crow(r, 1)) hv[r] = -INFINITY; } }
            const float e1 = __expf(sv[1] - sv[0]), e2 = __expf(sv[2] - sv[0]), e3 = __expf(sv[3] - sv[0]); const float inv = 1.f / (1.f + e1 + e2 + e3);
            if (hi == 0) { const int tl = 32 * blk + r32;
                selE[tl * 4 + 0] = se[0]; selE[tl * 4 + 1] = se[1]; selE[tl * 4 + 2] = se[2]; selE[tl * 4 + 3] = se[3];
                selW[tl * 4 + 0] = inv; selW[tl * 4 + 1] = e1 * inv; selW[tl * 4 + 2] = e2 * inv; selW[tl * 4 + 3] = e3 * inv; } }
    }
    LDS_WAIT(); __syncthreads();
    const int myE = selE[tid_]; const float myW = selW[tid_];
    const unsigned rk = __hip_atomic_fetch_add((LAS unsigned*)hist + myE, 1u, __ATOMIC_RELAXED, __HIP_MEMORY_SCOPE_WORKGROUP);
    LDS_WAIT(); __syncthreads();
    if (tid_ < 32) basew[tid_] = __hip_atomic_fetch_add(F.ctl + CW_CNT + 64 * tid_, hist[tid_], RLX_AGENT);
    LDS_WAIT(); __syncthreads();
    { const unsigned pos = basew[myE] + rk; const int tk = (wgrow0 + (tid_ >> 2)) * 4 + (tid_ & 3);
      FWS(int, WS_ROWTK)[(size_t)myE * CAP + pos] = tk; FWS(float, WS_ROWW)[(size_t)myE * CAP + pos] = myW; }
}

template <bool GU> struct MoeOrder {
    const char* A; const char* W; volatile LAS int* ts; volatile LAS unsigned* cntl; const LAS unsigned* tab; int c;
    __device__ bool next(int i, pg8::Unit& u) const {
        const int x = c & 7, k = c >> 3, q = 8 * i + x;
        const int rt = GU ? (4 * q + (k >> 3)) : (8 * q + (k >> 2));
        if (rt >= ts[NEXP]) return false;
        int e = 0;
        for (int j = 1; j < NEXP; ++j) e += (rt >= ts[j]) ? 1 : 0;
        u.pn = GU ? (k & 7) : (k & 3); u.e = e; u.idx = i; u.rbase = rt * 256; u.pm = (rt - ts[e]) * 256;
        const int left = (int)cntl[e] - u.pm; u.nrows = left < 256 ? left : 256; return true;
    }
    __device__ __forceinline__ const char* a_ptr(const pg8::Unit& u) const { return GU ? A : A + (size_t)u.rbase * 1024 * 2; }
    __device__ __forceinline__ const char* b_ptr(const pg8::Unit& u) const { return W + ((size_t)u.e * (GU ? 2048 : 1024) + (size_t)u.pn * 256) * 1024 * 2; }
    __device__ __forceinline__ unsigned a_off(const pg8::Unit& u, int row) const { return tab[u.idx * 256 + row]; }
    __device__ __forceinline__ void a_ready(const pg8::Unit&) const {}
    __device__ __forceinline__ void done(const pg8::Unit&) const {}
};
__device__ __forceinline__ void moe_setup(Frame& F) {
    const int tid_ = F.wave * 64 + lane_id();
    volatile LAS int* ts = (volatile LAS int*)(F.LC + 16); volatile LAS unsigned* cntl = F.LC + 64;
    if (tid_ < 32) cntl[tid_] = __hip_atomic_load(F.ctl + CW_CNT + 64 * tid_, RLX_AGENT);
    LDS_WAIT(); __syncthreads();
    if (tid_ == 0) { int acc = 0; for (int e = 0; e < NEXP; ++e) { ts[e] = acc; acc += (int)((cntl[e] + 255u) >> 8); } ts[NEXP] = acc; }
    LDS_WAIT(); __syncthreads();
}

__device__ __forceinline__ void final_phase(Frame& F) {
    const Bufs& B = F.B; const int lane = lane_id();
    const int gw = F.vcu * NWAVES + F.wave, NGW = F.G * NWAVES;
    f32x4 gv[4], bv[4];
#pragma unroll
    for (int j = 0; j < 4; ++j) { gv[j] = *(const f32x4*)(B.ln2_g + 4 * lane + 256 * j); bv[j] = *(const f32x4*)(B.ln2_b + 4 * lane + 256 * j); }
    for (int row = gw; row < NTOK; row += NGW) { float* p = B.out + (size_t)row * 1024 + 4 * lane; const bf16* orow = FWS(bf16, WS_OUTR) + (size_t)row * 4096 + 4 * lane;
        const bf16* xrow = FWS(bf16, WS_X1B) + (size_t)row * 1024 + 4 * lane;
        f32x4 v[4]; float s = 0.f;
#pragma unroll
        for (int j = 0; j < 4; ++j) { { const u32x2 xv = *(const u32x2*)(xrow + 256 * j);
                v[j] = (f32x4){__uint_as_float(xv.x << 16), __uint_as_float(xv.x & 0xffff0000u), __uint_as_float(xv.y << 16), __uint_as_float(xv.y & 0xffff0000u)} * DN_ALPHA; }
#pragma unroll
            for (int kk = 0; kk < 4; ++kk) { const u32x2 wv = *(const u32x2*)(orow + kk * 1024 + 256 * j);
                v[j][0] += __uint_as_float(wv.x << 16); v[j][1] += __uint_as_float(wv.x & 0xffff0000u); v[j][2] += __uint_as_float(wv.y << 16); v[j][3] += __uint_as_float(wv.y & 0xffff0000u); }
            s += (v[j][0] + v[j][1]) + (v[j][2] + v[j][3]); }
        const float mean = wave_sum(s) * (1.f / 1024.f); float s2 = 0.f;
#pragma unroll
        for (int j = 0; j < 4; ++j) { v[j] = v[j] - mean; s2 += (v[j][0] * v[j][0] + v[j][1] * v[j][1]) + (v[j][2] * v[j][2] + v[j][3] * v[j][3]); }
        const float rstd = rsqrtf(wave_sum(s2) * (1.f / 1024.f) + LN_EPS);
#pragma unroll
        for (int j = 0; j < 4; ++j) *(f32x4*)(p + 256 * j) = v[j] * rstd * gv[j] + bv[j]; }
}

constexpr int NPHASE = 11;
struct MArgs { Bufs B; int ph_lo, ph_hi; };
__global__ void __launch_bounds__(NWAVES * 64, 2) mega_fwd(MArgs args) {
    extern __shared__ __attribute__((aligned(16))) unsigned char lds[];
    Frame F;
    F.lds = (LAS unsigned char*)lds; F.LC = (volatile LAS unsigned*)(F.lds + LDSCTL_OFF);
    F.wave = __builtin_amdgcn_readfirstlane((int)threadIdx.x >> 6);
    F.G = gridDim.x; { const int bx = blockIdx.x; F.vcu = (F.G % 8 == 0) ? (bx % 8) * (F.G / 8) + bx / 8 : bx; }
    F.B = args.B; F.ctl = (unsigned*)(args.B.ws + WS_CTL);
    for (int u = threadIdx.x; u < 256; u += NWAVES * 64) F.LC[u] = 0u;
    __syncthreads();
    const int lo = args.ph_lo, hi = args.ph_hi;
    const bool multi = (hi - lo) > 1;
    XcdBarrier bar; bar.bar = F.ctl + CW_BAR; bar.x = 0; bar.st = nullptr;
    if (multi) bar = xcd_barrier_post(F.ctl + CW_BAR, F.LC);
#ifndef PH_COMPILE
#define PH_COMPILE 0x7FF
#endif
#define IN(k) ((((PH_COMPILE) >> (k)) & 1) && lo <= (k) && (k) < hi)
#define SEAM(k) do { if (IN(k) && IN((k) + 1)) xcd_barrier(bar); } while (0)
    LAS unsigned char* ring = F.lds + RING_OFF;
    const int c = (int)blockIdx.x;
    if (IN(0)) { p0_prologue(F); } SEAM(0);
    if (IN(1)) {
        { pg8::StaticOrder S; S.init(FDO(bf16, DO_XB), FWS(bf16, WS_WINT), NTOK, 2048, 1024, F.G, c);
          pg8::EpiQK E{FWS(bf16, WS_QSB), FWS(bf16, WS_KSB)};
          pg8::gemm_phase<pg8::EpiQK, pg8::StaticOrder, true, false>(ring, 1024, S, E, F.wave); }
        { pg8::StaticOrder S; S.init(FDO(bf16, DO_XB), FWS(bf16, WS_WINT) + (size_t)2048 * 1024, NTOK, 2048, 1024, F.G, c);
          pg8::EpiRot E{FWS(bf16, WS_QR), FWS(bf16, WS_KR), FDO(bf16, DO_KRT), FWS(bf16, WS_QRS), FWS(float, WS_COS), FWS(float, WS_SIN)};
          pg8::gemm_phase<pg8::EpiRot, pg8::StaticOrder, true, false>(ring, 1024, S, E, F.wave); }
        { pg8::StaticOrder S; S.init(FDO(bf16, DO_XB), FWS(bf16, WS_WINT) + (size_t)4096 * 1024, NTOK, 4096, 1024, F.G, c);
          pg8::EpiGate E{F.B.ws};
          pg8::gemm_phase<pg8::EpiGate, pg8::StaticOrder, true, false>(ring, 1024, S, E, F.wave); }
        { pg8::StaticOrder S; S.init(FWS(bf16, WS_WVT), FDO(bf16, DO_XB), 3072, NTOK, 1024, F.G, c);
          pg8::EpiVT E{FWS(bf16, WS_VSBT), FWS(bf16, WS_VRT)};
          pg8::gemm_phase<pg8::EpiVT, pg8::StaticOrder, true, false>(ring, 1024, S, E, F.wave); }
    } SEAM(1);
    if (IN(2)) { attn_phase(F); } SEAM(2);
    if (IN(3)) { scan_phase(F); } SEAM(3);
    if (IN(4)) { intra_phase(F); } SEAM(4);
    if (IN(5)) {
        { pg8::StaticOrder S; S.init(FWS(bf16, WS_QSB), FWS(bf16, WS_WBSBT), NTOK, 1024, 1024, F.G, c);
          pg8::EpiBranch<0> E{FWS(bf16, WS_GSB), nullptr, FWS(bf16, WS_M1)};
          pg8::gemm_phase<pg8::EpiBranch<0>, pg8::StaticOrder, true, false>(ring, 1024, S, E, F.wave); }
        { pg8::StaticOrder S; S.init(FDO(bf16, DO_R), FWS(bf16, WS_WBRETT), NTOK, 1024, 2048, F.G, c);
          pg8::EpiBranch<1> E{FWS(bf16, WS_GRET), FWS(bf16, WS_M1), FWS(bf16, WS_MG)};
          pg8::gemm_phase<pg8::EpiBranch<1>, pg8::StaticOrder, true, false>(ring, 2048, S, E, F.wave); }
    } SEAM(5);
    if (IN(6)) { pg8::StaticOrder S; S.init(FWS(bf16, WS_MG), FWS(bf16, WS_WOUTT), NTOK, 1024, 1024, F.G, c);
        pg8::EpiPre E{F.B.x, F.B.out};
        pg8::gemm_phase<pg8::EpiPre, pg8::StaticOrder, true, false>(ring, 1024, S, E, F.wave); } SEAM(6);
    if (IN(7)) { ln1_router_phase(F); } SEAM(7);
    if (IN(8)) { moe_setup(F);
        MoeOrder<true> S{(const char*)FWS(bf16, WS_X1B), (const char*)FWS(bf16, WS_WGUT), (volatile LAS int*)(F.LC + 16), F.LC + 64, (const LAS unsigned*)(F.lds + LDS_TAB_OFF), c};
        { pg8::Unit u; LAS unsigned* tab = (LAS unsigned*)(F.lds + LDS_TAB_OFF);
          const int tid_ = F.wave * 64 + lane_id();
          for (int i = 0; i < 24 && S.next(i, u); ++i) { if (tid_ < 256) { const int rr = tid_; unsigned off = 0u;
                  if (rr < u.nrows) off = (unsigned)(FWS(int, WS_ROWTK)[(size_t)u.e * CAP + u.pm + rr] >> 2) * 2048u;
                  tab[i * 256 + rr] = off; } }
          LDS_WAIT(); __syncthreads(); }
        pg8::EpiGateUp E{F.B.b_gu, FWS(bf16, WS_ACT)};
        pg8::gemm_phase<pg8::EpiGateUp, MoeOrder<true>, true, true>(ring, 1024, S, E, F.wave); } SEAM(8);
    if (IN(9)) { moe_setup(F);
        MoeOrder<false> S{(const char*)FWS(bf16, WS_ACT), (const char*)FWS(bf16, WS_WDT), (volatile LAS int*)(F.LC + 16), F.LC + 64, (const LAS unsigned*)(F.lds + LDS_TAB_OFF), c};
        pg8::EpiDown E{F.B.b_dn, FWS(int, WS_ROWTK), FWS(float, WS_ROWW), FWS(bf16, WS_OUTR)};
        pg8::gemm_phase<pg8::EpiDown, MoeOrder<false>, true, false>(ring, 1024, S, E, F.wave); } SEAM(9);
    if (IN(10)) { final_phase(F); }
#undef IN
#undef SEAM
}
#ifndef OPT_MASK
#define OPT_MASK 0x7FF
#endif
#ifndef ONE_LAUNCH
#define ONE_LAUNCH 1
#endif
template <int NB, class AF, class BF, class EF> static void launch_ngemm(hipStream_t s, int M, int N, int K, const AF& af, const BF& bf, const EF& ef) {
    GArgs<AF, BF, EF> ga; memset(&ga, 0, sizeof(ga)); ga.af = af; ga.bf = bf; ga.ef = ef; ga.M = M; ga.N = N; ga.K = K; ga.pad = 0;
    ngemm<NB, AF, BF, EF><<<dim3(N / 64, M / 64), 256, 0, s>>>(ga);
}
static void launch_tr(hipStream_t s, int grid, const float* src, int lds, int c0, int width, int K, bf16* dst, int r0) {
    TrArgs a; memset(&a, 0, sizeof(a)); a.src = src; a.dst = dst; a.lds = lds; a.c0 = c0; a.width = width; a.K = K; a.r0 = r0; a.pad = 0;
    n_tr<<<grid, 256, 0, s>>>(a);
}
static AF_rows mk_rows(const void* p, int ld) { AF_rows a; memset(&a, 0, sizeof(a)); a.A = (const bf16*)p; a.ld = ld; a.pad = 0; return a; }
static BF_wt mk_wt(const void* p, int K) { BF_wt a; memset(&a, 0, sizeof(a)); a.W = (const bf16*)p; a.K = K; a.pad = 0; return a; }
static void run_naive(const Bufs& B, hipStream_t s, int stage) {
    unsigned char* ws = B.ws;
    switch (stage) {
    case 0: {
        n_xb<<<2048, 256, 0, s>>>(B);
        bf16* wint = (bf16*)(ws + WS_WINT); bf16* wvt = (bf16*)(ws + WS_WVT);
        launch_tr(s, 1024, B.w_in, INW, 0, 2048, 1024, wint, 0);
        launch_tr(s, 1024, B.w_in, INW, 2048, 1024, 1024, wvt, 0);
        launch_tr(s, 1024, B.w_in, INW, 3072, 2048, 1024, wint, 2048);
        launch_tr(s, 1024, B.w_in, INW, 5120, 2048, 1024, wvt, 1024);
        launch_tr(s, 1024, B.w_in, INW, 7168, 4096, 1024, wint, 4096);
        launch_tr(s, 1024, B.w_bsb, 1024, 0, 1024, 1024, (bf16*)(ws + WS_WBSBT), 0);
        launch_tr(s, 1024, B.w_bret, 1024, 0, 1024, 2048, (bf16*)(ws + WS_WBRETT), 0);
        launch_tr(s, 1024, B.w_out, 1024, 0, 1024, 1024, (bf16*)(ws + WS_WOUTT), 0);
        launch_tr(s, 64, B.w_router, 32, 0, 32, 1024, (bf16*)(ws + WS_WRT), 0);
        { Tr2Args a; memset(&a, 0, sizeof(a)); a.src = B.w_gu; a.dst = (bf16*)(ws + WS_WGUT); n_tr_gu<<<4096, 256, 0, s>>>(a); }
        { Tr2Args a; memset(&a, 0, sizeof(a)); a.src = B.w_dn; a.dst = (bf16*)(ws + WS_WDT); n_tr_dn<<<4096, 256, 0, s>>>(a); }
        n_rope<<<1024, 256, 0, s>>>(B);
    } break;
    case 1: {
        BF_inproj bf; memset(&bf, 0, sizeof(bf)); bf.wint = (const bf16*)(ws + WS_WINT); bf.wvt = (const bf16*)(ws + WS_WVT); EF_inproj ef{B};
        launch_ngemm<1>(s, NTOK, INW, 1024, mk_rows((unsigned char*)B.out + DO_XB, 1024), bf, ef);
        n_rotary<<<4096, 256, 0, s>>>(B);
    } break;
    case 2: n_attn<<<BATCH * SBH * SEQ / 64, 64, 0, s>>>(B);
        if (OPT_MASK & 1) { { Tr2Args a; memset(&a, 0, sizeof(a)); a.src = B.w_gu; a.dst = (bf16*)(ws + WS_WGUT); n_tr_gu<<<4096, 256, 0, s>>>(a); }
                            { Tr2Args a; memset(&a, 0, sizeof(a)); a.src = B.w_dn; a.dst = (bf16*)(ws + WS_WDT); n_tr_dn<<<4096, 256, 0, s>>>(a); } }
        break;
    case 3: n_scan<<<BATCH * RH * RDV, 64, 0, s>>>(B); break;
    case 4: n_intra<<<BATCH * RH * NCHUNK, 256, 0, s>>>(B); break;
    case 5: {
        { EF_m1 ef{B}; launch_ngemm<1>(s, NTOK, 1024, 1024, mk_rows(ws + WS_QSB, 1024), mk_wt(ws + WS_WBSBT, 1024), ef); }
        { EF_mg ef{B}; launch_ngemm<1>(s, NTOK, 1024, 2048, mk_rows((unsigned char*)B.out + DO_R, 2048), mk_wt(ws + WS_WBRETT, 2048), ef); }
    } break;
    case 6: { EF_pre ef{B}; launch_ngemm<1>(s, NTOK, 1024, 1024, mk_rows(ws + WS_MG, 1024), mk_wt(ws + WS_WOUTT, 1024), ef); } break;
    case 7: n_ln1<<<NTOK / 4, 256, 0, s>>>(B); n_router<<<NTOK / 64, 64, 0, s>>>(B); break;
    case 8: { n_tstart<<<1, 64, 0, s>>>(B); n_rowinfo<<<544, 256, 0, s>>>(B); AF_gather af{B}; BF_gu bf{B}; EF_gu ef{B}; launch_ngemm<2>(s, MAXROWS, 1024, 1024, af, bf, ef); } break;
    case 9: { n_tstart<<<1, 64, 0, s>>>(B); n_rowinfo<<<544, 256, 0, s>>>(B); AF_act af{B}; BF_dn bf{B}; EF_dn ef{B}; launch_ngemm<1>(s, MAXROWS, 1024, 1024, af, bf, ef); } break;
    case 10: n_final<<<NTOK / 4, 256, 0, s>>>(B); break;
    }
}
static void run_mega(const Bufs& B, hipStream_t s, int lo, int hi) {
    MArgs a; memset(&a, 0, sizeof(a)); a.B = B; a.ph_lo = lo; a.ph_hi = hi;
    hipLaunchKernelGGL(mega_fwd, dim3(256), dim3(NWAVES * 64), LDS_BYTES, s, a);
}

extern "C" void kernel_launch(void* const* d_in, const int* in_sizes, int n_in, void* d_out, int out_size, void* d_ws, size_t ws_size, hipStream_t stream) {
    if (n_in != 15 || out_size != NTOK * DM || ws_size < WS_END) { fprintf(stderr, "kernel_launch: unexpected shapes (n_in %d out %d ws %zu)\n", n_in, out_size, ws_size); return; }
    static int inited = 0;
    if (!inited) { inited = 1;
        if (hipFuncSetAttribute((const void*)mega_fwd, hipFuncAttributeMaxDynamicSharedMemorySize, LDS_BYTES) != hipSuccess) fprintf(stderr, "kernel_launch: hipFuncSetAttribute failed\n");
        int dev = 0, cus = 0; (void)hipGetDevice(&dev); (void)hipDeviceGetAttribute(&cus, hipDeviceAttributeMultiprocessorCount, dev);
        if (cus != 256) fprintf(stderr, "kernel_launch: built for 256 CUs, device has %d\n", cus);
        (void)hipGetLastError(); }
    Bufs B; memset(&B, 0, sizeof(B));
    B.x = (const float*)d_in[0]; B.w_in = (const float*)d_in[1]; B.w_bsb = (const float*)d_in[2]; B.w_bret = (const float*)d_in[3]; B.w_out = (const float*)d_in[4];
    B.ln1_g = (const float*)d_in[5]; B.ln1_b = (const float*)d_in[6]; B.w_router = (const float*)d_in[7]; B.b_router = (const float*)d_in[8];
    B.w_gu = (const float*)d_in[9]; B.b_gu = (const float*)d_in[10]; B.w_dn = (const float*)d_in[11]; B.b_dn = (const float*)d_in[12]; B.ln2_g = (const float*)d_in[13]; B.ln2_b = (const float*)d_in[14];
    B.out = (float*)d_out; B.ws = (unsigned char*)d_ws;
    (void)hipMemsetAsync((char*)d_ws + WS_CTL, 0, CTL_ZERO_BYTES, stream);
    if ((OPT_MASK & 0x7FF) == 0x7FF && ONE_LAUNCH) { run_mega(B, stream, 0, NPHASE); return; }
    for (int st = 0; st < NPHASE; ++st) { if ((OPT_MASK >> st) & 1) run_mega(B, stream, st, st + 1); else run_naive(B, stream, st);
#ifdef PROBE_DUP
        if (st == PROBE_DUP) {
            if (st == 2) { run_mega(B, stream, 1, 2); run_mega(B, stream, 2, 3); }
            else if (st == 4) { run_mega(B, stream, 3, 4); run_mega(B, stream, 4, 5); }
            else if (st == 7) { (void)hipMemsetAsync((char*)d_ws + WS_CTL, 0, CTL_ZERO_BYTES, stream); run_mega(B, stream, 6, 7); run_mega(B, stream, 7, 8); }
            else if (st == 10) { (void)hipMemsetAsync((char*)d_ws + WS_CTL, 0, CTL_ZERO_BYTES, stream); run_mega(B, stream, 6, 7); run_mega(B, stream, 7, 8); run_mega(B, stream, 10, 11); }
            else run_mega(B, stream, st, st + 1);
        }
#endif
    }
}
```

```cpp
#include <hip/hip_runtime.h>
#include <cstdio>
#include <cstdint>
#include <cstring>

constexpr int BATCH = 4, SEQ = 8192, DM = 1024, NTOK = BATCH * SEQ;
constexpr int SBH = 16, SBD = 64;
constexpr int RH = 4, RDK = 256, RDV = 512, RQK = RH * RDK  , RV = RH * RDV  ;
constexpr int CHUNK = 64, NCHUNK = SEQ / CHUNK;
constexpr int INW = 11264;
constexpr int NEXP = 32, TOPK = 4, DFF = 1024;
constexpr int CAP = NTOK;
constexpr int MAXROWS = NTOK * TOPK + NEXP * 256;
constexpr float LN_EPS = 1e-5f;
constexpr float DN_ALPHA = 1.18920711500272106672f;
constexpr float LOG2E = 1.4426950408889634f;
constexpr float SB_C2 = 0.125f * LOG2E;

typedef unsigned short bf16;
typedef float f32x4 __attribute__((ext_vector_type(4)));
typedef float f32x16 __attribute__((ext_vector_type(16)));
typedef short bf16x8 __attribute__((ext_vector_type(8)));
typedef short bf16x4 __attribute__((ext_vector_type(4)));
typedef unsigned u32x4 __attribute__((ext_vector_type(4)));
typedef unsigned u32x2 __attribute__((ext_vector_type(2)));

__host__ __device__ __forceinline__ float bf2f(bf16 v) { unsigned u = (unsigned)v << 16; return __builtin_bit_cast(float, u); }
__host__ __device__ __forceinline__ bf16 f2bf(float f) { unsigned u = __builtin_bit_cast(unsigned, f); return (bf16)((u + 0x7fffu + ((u >> 16) & 1u)) >> 16); }
__device__ __forceinline__ unsigned pk2(float lo, float hi) { return (unsigned)f2bf(lo) | ((unsigned)f2bf(hi) << 16); }

constexpr size_t MiB = 1u << 20;
constexpr size_t WS_CTL = 0, CTL_ZERO_BYTES = 1 * MiB;
constexpr size_t WS_COS = 1 * MiB, WS_SIN = 5 * MiB;
constexpr size_t WS_WRT = 9 * MiB;
constexpr size_t WS_TSTART = 9 * MiB + 512 * 1024;
constexpr size_t WS_WINT = 10 * MiB;
constexpr size_t WS_WVT = 26 * MiB;
constexpr size_t WS_WBSBT = 32 * MiB, WS_WBRETT = 34 * MiB, WS_WOUTT = 38 * MiB;
constexpr size_t WS_WGUT = 40 * MiB;
constexpr size_t WS_WDT = 168 * MiB;
constexpr size_t WS_QSB = 232 * MiB;
constexpr size_t WS_KSB = 296 * MiB;
constexpr size_t WS_VSBT = 360 * MiB;
constexpr size_t WS_YINT = 296 * MiB;
constexpr size_t WS_QR = 424 * MiB, WS_KR = 488 * MiB;
constexpr size_t WS_VRT = 552 * MiB;
constexpr size_t WS_SG = 680 * MiB;
constexpr size_t WS_GSB = 808 * MiB, WS_GRET = 872 * MiB;
constexpr size_t WS_SELE = 936 * MiB, WS_SELW = 937 * MiB;
constexpr size_t WS_ROWTK = 940 * MiB, WS_ROWW = 944 * MiB;
constexpr size_t WS_RINFO = 948 * MiB;
constexpr size_t WS_M1 = 424 * MiB, WS_MG = 488 * MiB;
constexpr size_t WS_X1B = 552 * MiB;
constexpr size_t WS_ACT = 616 * MiB;
constexpr size_t WS_OUTR = 232 * MiB;
constexpr size_t WS_END = 1024 * MiB;
static_assert(WS_ACT + (size_t)MAXROWS * 1024 * 2 <= WS_SELE, "ACT fits");
static_assert(WS_OUTR + (size_t)NTOK * 4 * 1024 * 2 <= WS_MG, "OUTR fits below MG");
constexpr size_t DO_XB = 0, DO_KRT = 64 * MiB;

__host__ __device__ __forceinline__ size_t krt_idx(int bh, int t, int d) { return ((((size_t)bh * 128 + (t >> 6)) * 4 + ((t >> 4) & 3)) * 256 + d) * 16 + (t & 15); }
__host__ __device__ __forceinline__ size_t vrt_idx(int bh, int t, int v) { return ((((size_t)bh * 128 + (t >> 6)) * 4 + ((t >> 4) & 3)) * 512 + v) * 16 + (t & 15); }
__host__ __device__ __forceinline__ size_t qrs_idx(int bh, int t, int d) { return ((((size_t)bh * 128 + (t >> 6)) * 16 + (d >> 4)) * 64 + (t & 63)) * 16 + (d & 15); }
__host__ __device__ __forceinline__ size_t yt_idx(int bh, int t, int v) { return ((((size_t)bh * 128 + (t >> 6)) * 64 + (v >> 3)) * 64 + (t & 63)) * 8 + (v & 7); }
__host__ __device__ __forceinline__ size_t ksb_idx(int bh, int t, int d) { return ((((size_t)bh * 256 + (t >> 5)) * 4 + (d >> 4)) * 32 + (t & 31)) * 16 + (d & 15); }
__host__ __device__ __forceinline__ size_t vsb_idx(int bh, int t, int d) { return (((size_t)bh * 512 + (t >> 4)) * 64 + d) * 16 + (t & 15); }
constexpr size_t WS_QRS = 952 * MiB;
constexpr size_t DO_R = 0;
static_assert(WS_QRS + 64 * MiB <= WS_END, "QRS fits");

constexpr int CW_TMO = 0, CW_CODE = 1;
constexpr int CW_BAR = 4096;
constexpr int CW_CNT = 16384;

struct Bufs {
    const float *x, *w_in, *w_bsb, *w_bret, *w_out, *ln1_g, *ln1_b, *w_router, *b_router, *w_gu, *b_gu, *w_dn, *b_dn, *ln2_g, *ln2_b;
    float* out; unsigned char* ws;
};
#define WSP(T, off) ((T*)(B.ws + (off)))
#define DOP(T, off) ((T*)((unsigned char*)B.out + (off)))

__global__ void n_xb(Bufs B) {
    const size_t n = (size_t)NTOK * DM; bf16* xb = DOP(bf16, DO_XB);
    for (size_t i = (size_t)blockIdx.x * blockDim.x + threadIdx.x; i < n; i += (size_t)gridDim.x * blockDim.x) xb[i] = f2bf(B.x[i]);
}
struct TrArgs { const float* src; bf16* dst; int lds, c0, width, K, r0, pad; };
__global__ void n_tr(TrArgs a) {
    const float* src = a.src; bf16* dst = a.dst; const int lds = a.lds, c0 = a.c0, width = a.width, K = a.K, r0 = a.r0;
    const size_t n = (size_t)width * K;
    for (size_t i = (size_t)blockIdx.x * blockDim.x + threadIdx.x; i < n; i += (size_t)gridDim.x * blockDim.x) {
        const int k = (int)(i % K), c = (int)(i / K); dst[(size_t)(r0 + c) * K + k] = f2bf(src[(size_t)k * lds + c0 + c]); }
}
struct Tr2Args { const float* src; bf16* dst; };
__global__ void n_tr_gu(Tr2Args a) { const float* src = a.src; bf16* dst = a.dst;
    const size_t n = (size_t)NEXP * 2048 * 1024;
    for (size_t i = (size_t)blockIdx.x * blockDim.x + threadIdx.x; i < n; i += (size_t)gridDim.x * blockDim.x) {
        const int k = (int)(i % 1024); const int r = (int)((i / 1024) % 2048); const int e = (int)(i / (1024 * 2048));
        const int ct = r >> 8, bj = (r >> 7) & 1, ii = r & 127; const int c = bj * 1024 + 128 * ct + ii;
        dst[i] = f2bf(src[((size_t)e * 1024 + k) * 2048 + c]); }
}
__global__ void n_tr_dn(Tr2Args a) { const float* src = a.src; bf16* dst = a.dst;
    const size_t n = (size_t)NEXP * 1024 * 1024;
    for (size_t i = (size_t)blockIdx.x * blockDim.x + threadIdx.x; i < n; i += (size_t)gridDim.x * blockDim.x) {
        const int ff = (int)(i % 1024); const int d = (int)((i / 1024) % 1024); const int e = (int)(i / (1024 * 1024));
        dst[i] = f2bf(src[((size_t)e * 1024 + ff) * 1024 + d]); }
}
__device__ __forceinline__ float rope_inv_freq(int j) { return powf(10000.0f, -(float)j / 128.0f); }
__global__ void n_rope(Bufs B) {
    float* c = WSP(float, WS_COS); float* s = WSP(float, WS_SIN);
    for (int i = blockIdx.x * blockDim.x + threadIdx.x; i < SEQ * 128; i += gridDim.x * blockDim.x) {
        const int pos = i >> 7, j = i & 127; const float ang = (float)pos * rope_inv_freq(j);
        c[i] = (float)cos((double)ang); s[i] = (float)sin((double)ang); }
}

template <class AF, class BF, class EF> struct GArgs { AF af; BF bf; EF ef; int M, N, K, pad; };
template <int NB, class AF, class BF, class EF>
__global__ void __launch_bounds__(256) ngemm(GArgs<AF, BF, EF> ga) {
    const AF& af = ga.af; const BF& bf = ga.bf; const EF& ef = ga.ef; const int K = ga.K;
    __shared__ float As[16][65], Bs[NB][16][65];
    const int tx = threadIdx.x & 15, ty = threadIdx.x >> 4;
    const int m0 = blockIdx.y * 64, n0 = blockIdx.x * 64;
    if (!af.active(m0)) return;
    float acc[NB][4][4];
#pragma unroll
    for (int b = 0; b < NB; ++b)
#pragma unroll
        for (int i = 0; i < 4; ++i)
#pragma unroll
            for (int j = 0; j < 4; ++j) acc[b][i][j] = 0.f;
    for (int k0 = 0; k0 < K; k0 += 16) {
#pragma unroll
        for (int i = 0; i < 4; ++i) { const int idx = threadIdx.x + 256 * i; const int kk = idx & 15, mm = idx >> 4; As[kk][mm] = af(m0 + mm, k0 + kk); }
#pragma unroll
        for (int b = 0; b < NB; ++b)
#pragma unroll
            for (int i = 0; i < 4; ++i) { const int idx = threadIdx.x + 256 * i; const int kk = idx & 15, nn = idx >> 4; Bs[b][kk][nn] = bf(m0, k0 + kk, n0 + nn, b); }
        __syncthreads();
#pragma unroll
        for (int kk = 0; kk < 16; ++kk) {
            float a[4];
#pragma unroll
            for (int i = 0; i < 4; ++i) a[i] = As[kk][ty * 4 + i];
#pragma unroll
            for (int b = 0; b < NB; ++b) {
                float bb[4];
#pragma unroll
                for (int j = 0; j < 4; ++j) bb[j] = Bs[b][kk][tx * 4 + j];
#pragma unroll
                for (int i = 0; i < 4; ++i)
#pragma unroll
                    for (int j = 0; j < 4; ++j) acc[b][i][j] += a[i] * bb[j];
            }
        }
        __syncthreads();
    }
#pragma unroll
    for (int i = 0; i < 4; ++i)
#pragma unroll
        for (int j = 0; j < 4; ++j) {
            float v[NB];
#pragma unroll
            for (int b = 0; b < NB; ++b) v[b] = acc[b][i][j];
            ef(m0 + ty * 4 + i, n0 + tx * 4 + j, v);
        }
}

__device__ __forceinline__ float sigmoidf_(float x) { return 1.0f / (1.0f + __expf(-x)); }
__device__ __forceinline__ float ret_log2gamma(int h) { return log2f(1.0f - exp2f(-5.0f - (float)h)); }

struct AF_rows { const bf16* A; int ld, pad; __device__ bool active(int) const { return true; } __device__ float operator()(int m, int k) const { return bf2f(A[(size_t)m * ld + k]); } };
struct BF_inproj { const bf16 *wint, *wvt;
    __device__ float operator()(int, int k, int n, int) const {
        const bf16* row;
        if (n < 2048) row = wint + (size_t)n * 1024;
        else if (n < 3072) row = wvt + (size_t)(n - 2048) * 1024;
        else if (n < 5120) row = wint + (size_t)(2048 + n - 3072) * 1024;
        else if (n < 7168) row = wvt + (size_t)(1024 + n - 5120) * 1024;
        else row = wint + (size_t)(4096 + n - 7168) * 1024;
        return bf2f(row[k]); } };
struct EF_inproj { Bufs B;
    __device__ void operator()(int m, int n, const float (&v)[1]) const {
        const float a = v[0];
        if (n < 1024) WSP(bf16, WS_QSB)[(size_t)m * 1024 + n] = f2bf(a * SB_C2);
        else if (n < 2048) { const int f = n - 1024; WSP(bf16, WS_KSB)[ksb_idx((m >> 13) * 16 + (f >> 6), m & (SEQ - 1), f & 63)] = f2bf(a); }
        else if (n < 3072) { const int f = n - 2048; WSP(bf16, WS_VSBT)[vsb_idx((m >> 13) * 16 + (f >> 6), m & (SEQ - 1), f & 63)] = f2bf(a); }
        else if (n < 4096) WSP(bf16, WS_QR)[(size_t)m * 1024 + n - 3072] = f2bf(a);
        else if (n < 5120) WSP(bf16, WS_KR)[(size_t)m * 1024 + n - 4096] = f2bf(a);
        else if (n < 7168) { const int f = n - 5120, h = f >> 9; const float dec = exp2f((float)(63 - (m & 63)) * ret_log2gamma(h));
            WSP(bf16, WS_VRT)[vrt_idx((m >> 13) * 4 + h, m & (SEQ - 1), f & 511)] = f2bf(a * dec); }
        else if (n < 9216) { const int f = n - 7168; WSP(bf16, WS_SG)[yt_idx((m >> 13) * 4 + (f >> 9), m & (SEQ - 1), f & 511)] = f2bf(a * sigmoidf_(a)); }
        else if (n < 10240) WSP(bf16, WS_GSB)[(size_t)m * 1024 + n - 9216] = f2bf(sigmoidf_(a));
        else WSP(bf16, WS_GRET)[(size_t)m * 1024 + n - 10240] = f2bf(sigmoidf_(a)); } };
__global__ void n_rotary(Bufs B) {
    bf16* qr = WSP(bf16, WS_QR); bf16* kr = WSP(bf16, WS_KR); bf16* krt = DOP(bf16, DO_KRT);
    const float* ct = WSP(float, WS_COS); const float* st = WSP(float, WS_SIN);
    const size_t n = (size_t)NTOK * RH * 128;
    for (size_t i = (size_t)blockIdx.x * blockDim.x + threadIdx.x; i < n; i += (size_t)gridDim.x * blockDim.x) {
        const int j = (int)(i & 127), h = (int)((i >> 7) & 3); const int m = (int)(i >> 9); const int pos = m & (SEQ - 1);
        const float c = ct[pos * 128 + j], s = st[pos * 128 + j];
        const size_t o1 = (size_t)m * 1024 + h * 256 + j, o2 = o1 + 128;
        const int bh = (m >> 13) * 4 + h;
        { const float x1 = bf2f(qr[o1]), x2 = bf2f(qr[o2]); const bf16 r1 = f2bf((x1 * c - x2 * s) * 0.0625f), r2 = f2bf((x1 * s + x2 * c) * 0.0625f); qr[o1] = r1; qr[o2] = r2;
          WSP(bf16, WS_QRS)[qrs_idx(bh, pos, j)] = r1; WSP(bf16, WS_QRS)[qrs_idx(bh, pos, j + 128)] = r2; }
        { const float x1 = bf2f(kr[o1]), x2 = bf2f(kr[o2]); const bf16 r1 = f2bf(x1 * c - x2 * s), r2 = f2bf(x1 * s + x2 * c); kr[o1] = r1; kr[o2] = r2;
          krt[krt_idx(bh, pos, j)] = r1; krt[krt_idx(bh, pos, j + 128)] = r2; }
    }
}

__global__ void __launch_bounds__(64) n_attn(Bufs B) {
    const int gid = blockIdx.x * 64 + threadIdx.x;
    const int t = gid & (SEQ - 1), bh = gid >> 13, h = bh & 15, b = bh >> 4;
    bf16* q = WSP(bf16, WS_QSB); const bf16* k = WSP(bf16, WS_KSB); const bf16* vt = WSP(bf16, WS_VSBT);
    const size_t rb = (size_t)b * SEQ;
    float qv[64], o[64];
#pragma unroll
    for (int d = 0; d < 64; ++d) { qv[d] = bf2f(q[(rb + t) * 1024 + h * 64 + d]); o[d] = 0.f; }
    float later = 0.f;
    for (int s = t - 1; s >= 0; --s) {
        float z2 = 0.f;
#pragma unroll
        for (int d = 0; d < 64; ++d) z2 += qv[d] * bf2f(k[ksb_idx(bh, s, d)]);
        const float z = z2 * 0.6931471805599453f;
        const float sp = fmaxf(z, 0.f) + log1pf(__expf(-fabsf(z)));
        const float a = __expf((z - sp) + later);
        later -= sp;
        if (a > 0.f) {
#pragma unroll
            for (int d = 0; d < 64; ++d) o[d] += a * bf2f(vt[vsb_idx(bh, s, d)]);
        }
    }
#pragma unroll
    for (int d = 0; d < 64; ++d) q[(rb + t) * 1024 + h * 64 + d] = f2bf(o[d]);
}

__global__ void __launch_bounds__(64) n_scan(Bufs B) {
    const int gid = blockIdx.x, v = gid & 511, h = (gid >> 9) & 3, b = gid >> 11, lane = threadIdx.x;
    const bf16* qr = WSP(bf16, WS_QR); const bf16* krt = DOP(bf16, DO_KRT); const bf16* vrt = WSP(bf16, WS_VRT); bf16* yint = WSP(bf16, WS_YINT);
    const float l2g = ret_log2gamma(h), cd = exp2f(64.f * l2g);
    float st[4] = {0.f, 0.f, 0.f, 0.f};
    for (int c = 0; c < NCHUNK; ++c) {
        const size_t tok0 = (size_t)b * SEQ + c * 64;
        for (int i = 0; i < 64; ++i) {
            const bf16* qp = qr + (tok0 + i) * 1024 + h * 256 + 4 * lane;
            float p = bf2f(qp[0]) * st[0] + bf2f(qp[1]) * st[1] + bf2f(qp[2]) * st[2] + bf2f(qp[3]) * st[3];
#pragma unroll
            for (int o = 1; o < 64; o <<= 1) p += __shfl_xor(p, o);
            if (lane == 0) yint[yt_idx(b * 4 + h, c * 64 + i, v)] = f2bf(p * exp2f((float)(i + 1) * l2g));
        }
        float ns[4] = {st[0] * cd, st[1] * cd, st[2] * cd, st[3] * cd};
        for (int j = 0; j < 64; ++j) {
            const float vv = bf2f(vrt[vrt_idx(b * 4 + h, c * 64 + j, v)]);
#pragma unroll
            for (int e = 0; e < 4; ++e) ns[e] += bf2f(krt[krt_idx(b * 4 + h, c * 64 + j, 4 * lane + e)]) * vv;
        }
#pragma unroll
        for (int e = 0; e < 4; ++e) st[e] = ns[e];
    }
}

__global__ void __launch_bounds__(256) n_intra(Bufs B) {
    __shared__ float P[64][65]; __shared__ float Y[8][512]; __shared__ float stat[8][2];
    const int gid = blockIdx.x, c = gid & 127, h = (gid >> 7) & 3, b = gid >> 9, tid = threadIdx.x;
    const bf16* qr = WSP(bf16, WS_QR); const bf16* kr = WSP(bf16, WS_KR); const bf16* vrt = WSP(bf16, WS_VRT); const bf16* sg = WSP(bf16, WS_SG); const bf16* yr = WSP(bf16, WS_YINT); bf16* rout = DOP(bf16, DO_R);
    const size_t tok0 = (size_t)b * SEQ + c * 64; const float l2g = ret_log2gamma(h);
    for (int e = tid; e < 4096; e += 256) { const int i = e >> 6, j = e & 63; float s = 0.f;
        const bf16* qp = qr + (tok0 + i) * 1024 + h * 256; const bf16* kp = kr + (tok0 + j) * 1024 + h * 256;
        for (int d = 0; d < 256; ++d) s += bf2f(qp[d]) * bf2f(kp[d]);
        const int ad = i > j ? i - j : j - i; P[i][j] = s * exp2f((float)(ad - 63 + j) * l2g); }
    __syncthreads();
    for (int i0 = 0; i0 < 64; i0 += 8) {
        for (int vv = tid; vv < 512; vv += 256) {
            float acc[8] = {0.f, 0.f, 0.f, 0.f, 0.f, 0.f, 0.f, 0.f};
            for (int j = 0; j < 64; ++j) { const float x = bf2f(vrt[vrt_idx(b * 4 + h, c * 64 + j, vv)]);
#pragma unroll
                for (int r = 0; r < 8; ++r) acc[r] += P[i0 + r][j] * x; }
#pragma unroll
            for (int r = 0; r < 8; ++r) Y[r][vv] = acc[r] + bf2f(yr[yt_idx(b * 4 + h, c * 64 + i0 + r, vv)]);
        }
        __syncthreads();
        { const int w = tid >> 6, lane = tid & 63;
          for (int r = w; r < 8; r += 4) { float s = 0.f, s2 = 0.f;
              for (int vv = lane; vv < 512; vv += 64) { const float x = Y[r][vv]; s += x; }
#pragma unroll
              for (int o = 1; o < 64; o <<= 1) s += __shfl_xor(s, o);
              const float mean = s * (1.f / 512.f);
              for (int vv = lane; vv < 512; vv += 64) { const float x = Y[r][vv] - mean; s2 += x * x; }
#pragma unroll
              for (int o = 1; o < 64; o <<= 1) s2 += __shfl_xor(s2, o);
              if (lane == 0) { stat[r][0] = mean; stat[r][1] = rsqrtf(s2 * (1.f / 512.f) + LN_EPS); } } }
        __syncthreads();
        for (int e = tid; e < 8 * 512; e += 256) { const int r = e >> 9, vv = e & 511; const size_t o = (tok0 + i0 + r) * 2048 + h * 512 + vv;
            rout[o] = f2bf(bf2f(sg[yt_idx(b * 4 + h, c * 64 + i0 + r, vv)]) * (Y[r][vv] - stat[r][0]) * stat[r][1]); }
        __syncthreads();
    }
}

struct BF_wt { const bf16* W; int K, pad; __device__ float operator()(int, int k, int n, int) const { return bf2f(W[(size_t)n * K + k]); } };
struct EF_m1 { Bufs B; __device__ void operator()(int m, int n, const float (&v)[1]) const { const size_t o = (size_t)m * 1024 + n; WSP(bf16, WS_M1)[o] = f2bf(bf2f(WSP(bf16, WS_GSB)[o]) * v[0]); } };
struct EF_mg { Bufs B; __device__ void operator()(int m, int n, const float (&v)[1]) const { const size_t o = (size_t)m * 1024 + n; WSP(bf16, WS_MG)[o] = f2bf(bf2f(WSP(bf16, WS_M1)[o]) + bf2f(WSP(bf16, WS_GRET)[o]) * v[0]); } };
struct EF_pre { Bufs B; __device__ void operator()(int m, int n, const float (&v)[1]) const { const size_t o = (size_t)m * 1024 + n; B.out[o] = DN_ALPHA * B.x[o] + v[0]; } };

__device__ __forceinline__ float wave_sum(float v) {
#pragma unroll
    for (int o = 1; o < 64; o <<= 1) v += __shfl_xor(v, o);
    return v;
}
__global__ void __launch_bounds__(256) n_ln1(Bufs B) {
    const int row = blockIdx.x * 4 + (threadIdx.x >> 6), lane = threadIdx.x & 63;
    float* p = B.out + (size_t)row * 1024; bf16* xb = WSP(bf16, WS_X1B) + (size_t)row * 1024;
    float v[16]; float s = 0.f;
#pragma unroll
    for (int j = 0; j < 16; ++j) { v[j] = p[lane + 64 * j]; s += v[j]; }
    const float mean = wave_sum(s) * (1.f / 1024.f); float s2 = 0.f;
#pragma unroll
    for (int j = 0; j < 16; ++j) { v[j] -= mean; s2 += v[j] * v[j]; }
    const float rstd = rsqrtf(wave_sum(s2) * (1.f / 1024.f) + LN_EPS);
#pragma unroll
    for (int j = 0; j < 16; ++j) { const int c = lane + 64 * j; const float y = v[j] * rstd * B.ln1_g[c] + B.ln1_b[c]; p[c] = y; xb[c] = f2bf(y); }
}
__global__ void __launch_bounds__(64) n_router(Bufs B) {
    const int tok = blockIdx.x * 64 + threadIdx.x;
    const bf16* xb = WSP(bf16, WS_X1B) + (size_t)tok * 1024; const bf16* wr = WSP(bf16, WS_WRT);
    float lg[32];
#pragma unroll
    for (int e = 0; e < 32; ++e) lg[e] = 0.f;
    for (int k = 0; k < 1024; ++k) { const float xv = bf2f(xb[k]);
#pragma unroll
        for (int e = 0; e < 32; ++e) lg[e] += xv * bf2f(wr[e * 1024 + k]); }
#pragma unroll
    for (int e = 0; e < 32; ++e) lg[e] += B.b_router[e];
    int se[4]; float sv[4];
#pragma unroll
    for (int kk = 0; kk < 4; ++kk) { float best = -INFINITY; int bi = 0;
#pragma unroll
        for (int e = 0; e < 32; ++e) { if (lg[e] > best) { best = lg[e]; bi = e; } }
        se[kk] = bi; sv[kk] = best;
#pragma unroll
        for (int e = 0; e < 32; ++e) if (e == bi) lg[e] = -INFINITY; }
    const float e1 = __expf(sv[1] - sv[0]), e2 = __expf(sv[2] - sv[0]), e3 = __expf(sv[3] - sv[0]); const float inv = 1.f / (1.f + e1 + e2 + e3);
    const float w[4] = {inv, e1 * inv, e2 * inv, e3 * inv};
    unsigned* cnt = WSP(unsigned, WS_CTL) + CW_CNT;
#pragma unroll
    for (int kk = 0; kk < 4; ++kk) { WSP(int, WS_SELE)[tok * 4 + kk] = se[kk]; WSP(float, WS_SELW)[tok * 4 + kk] = w[kk];
        const unsigned pos = atomicAdd(cnt + 64 * se[kk], 1u);
        WSP(int, WS_ROWTK)[(size_t)se[kk] * CAP + pos] = tok * 4 + kk; WSP(float, WS_ROWW)[(size_t)se[kk] * CAP + pos] = w[kk]; }
}
__global__ void n_tstart(Bufs B) {
    if (threadIdx.x == 0 && blockIdx.x == 0) { int* ts = WSP(int, WS_TSTART); const unsigned* cnt = WSP(unsigned, WS_CTL) + CW_CNT; int acc = 0;
        for (int e = 0; e < NEXP; ++e) { ts[e] = acc; acc += (int)((cnt[64 * e] + 255u) >> 8); } ts[NEXP] = acc; }
}
struct MoeRow { int e, valid, tk; float w; };
__global__ void n_rowinfo(Bufs B) {
    const int* ts = WSP(int, WS_TSTART); const unsigned* cnt = WSP(unsigned, WS_CTL) + CW_CNT; MoeRow* ri = WSP(MoeRow, WS_RINFO);
    for (int m = blockIdx.x * blockDim.x + threadIdx.x; m < MAXROWS; m += gridDim.x * blockDim.x) {
        MoeRow r; const int rt = m >> 8; int e = 0;
        while (e < NEXP - 1 && rt >= ts[e + 1]) ++e;
        const int pos = m - 256 * ts[e];
        r.e = e; r.valid = (rt < ts[NEXP]) && (pos < (int)cnt[64 * e]);
        r.tk = r.valid ? WSP(int, WS_ROWTK)[(size_t)e * CAP + pos] : 0; r.w = r.valid ? WSP(float, WS_ROWW)[(size_t)e * CAP + pos] : 0.f; ri[m] = r; }
}
struct AF_gather { Bufs B; __device__ bool active(int m0) const { return (m0 >> 8) < WSP(int, WS_TSTART)[NEXP]; }
    __device__ float operator()(int m, int k) const { const int tk = WSP(MoeRow, WS_RINFO)[m].tk; return bf2f(WSP(bf16, WS_X1B)[(size_t)(tk >> 2) * 1024 + k]); } };
struct BF_gu { Bufs B; __device__ float operator()(int m0, int k, int n, int which) const { const int e = WSP(MoeRow, WS_RINFO)[m0].e;
        const int ct = n >> 7, i = n & 127; return bf2f(WSP(bf16, WS_WGUT)[((size_t)e * 2048 + 256 * ct + 128 * which + i) * 1024 + k]); } };
__device__ __forceinline__ float moe_act(float g, float u) {
    g = fminf(g, 7.0f); u = fminf(fmaxf(u, -7.0f), 7.0f); const float glu = g * (1.0f / (1.0f + __expf(-1.702f * g))); return (u + 1.0f) * glu; }
struct EF_gu { Bufs B; __device__ void operator()(int m, int n, const float (&v)[2]) const { const MoeRow r = WSP(MoeRow, WS_RINFO)[m]; if (!r.valid) return;
        const float g = v[0] + B.b_gu[r.e * 2048 + n], u = v[1] + B.b_gu[r.e * 2048 + 1024 + n]; WSP(bf16, WS_ACT)[(size_t)m * 1024 + n] = f2bf(moe_act(g, u)); } };
struct AF_act { Bufs B; __device__ bool active(int m0) const { return (m0 >> 8) < WSP(int, WS_TSTART)[NEXP]; }
    __device__ float operator()(int m, int k) const { return WSP(MoeRow, WS_RINFO)[m].valid ? bf2f(WSP(bf16, WS_ACT)[(size_t)m * 1024 + k]) : 0.f; } };
struct BF_dn { Bufs B; __device__ float operator()(int m0, int k, int n, int) const { const int e = WSP(MoeRow, WS_RINFO)[m0].e; return bf2f(WSP(bf16, WS_WDT)[((size_t)e * 1024 + n) * 1024 + k]); } };
struct EF_dn { Bufs B; __device__ void operator()(int m, int n, const float (&v)[1]) const { const MoeRow r = WSP(MoeRow, WS_RINFO)[m]; if (!r.valid) return;
        WSP(bf16, WS_OUTR)[(size_t)r.tk * 1024 + n] = f2bf((v[0] + B.b_dn[r.e * 1024 + n]) * r.w); } };
__global__ void __launch_bounds__(256) n_final(Bufs B) {
    const int row = blockIdx.x * 4 + (threadIdx.x >> 6), lane = threadIdx.x & 63;
    float* p = B.out + (size_t)row * 1024; const bf16* orow = WSP(bf16, WS_OUTR) + (size_t)row * 4 * 1024;
    float v[16]; float s = 0.f;
#pragma unroll
    for (int j = 0; j < 16; ++j) { const int c = lane + 64 * j; float a = DN_ALPHA * bf2f(WSP(bf16, WS_X1B)[(size_t)row * 1024 + c]);
#pragma unroll
        for (int kk = 0; kk < 4; ++kk) a += bf2f(orow[kk * 1024 + c]);
        v[j] = a; s += a; }
    const float mean = wave_sum(s) * (1.f / 1024.f); float s2 = 0.f;
#pragma unroll
    for (int j = 0; j < 16; ++j) { v[j] -= mean; s2 += v[j] * v[j]; }
    const float rstd = rsqrtf(wave_sum(s2) * (1.f / 1024.f) + LN_EPS);
#pragma unroll
    for (int j = 0; j < 16; ++j) { const int c = lane + 64 * j; p[c] = v[j] * rstd * B.ln2_g[c] + B.ln2_b[c]; }
}

__device__ __forceinline__ int lane_id() { return (int)__builtin_amdgcn_mbcnt_hi(~0u, __builtin_amdgcn_mbcnt_lo(~0u, 0u)); }
namespace pg8 {
#define PG8_LAS __attribute__((address_space(3)))
constexpr int BM = 256, BK = 64, HALF = 128, HTB = HALF * BK * 2  , STAGE_BYTES = 8 * HTB, NXCD = 8, WGM = 8;
__host__ __device__ __forceinline__ int lds_byte(int r, int c) { const int st = (r >> 4) * 2 + (c >> 5), rr = r & 15, cc = c & 31, ob = rr * 64 + cc * 2; return st * 1024 + (ob ^ (((ob >> 9) & 1) << 5)); }
__host__ __device__ __forceinline__ void stage_rc(int b, int& R, int& C) { const int st = b / 1024, sb = b % 1024, swz = sb ^ (((sb >> 9) & 1) << 5); R = (st >> 1) * 16 + swz / 64; C = (st & 1) * 32 + (swz % 64) / 2; }
__host__ __device__ __forceinline__ int perm32(int rho) { const int n = rho >> 4, i = rho & 15; return 8 * (i >> 2) + 4 * n + (i & 3); }

struct Unit { int pm, pn, e, idx, rbase, nrows; };

struct StaticOrder {
    const char* A; const char* Bt; int nM, nN, nwg, G, c, K;
    __device__ void init(const void* A_, const void* Bt_, int M, int N, int K_, int G_, int c_) { A = (const char*)A_; Bt = (const char*)Bt_; nM = M / BM; nN = N / BM; nwg = nM * nN; G = G_; c = c_; K = K_; }
    __device__ bool next(int i, Unit& u) const {
        const long L = (long)i * G + c; if (L >= nwg) return false;
        int wgid = (int)L; { const int q = nwg / NXCD, r = nwg % NXCD, xcd = wgid % NXCD, off = wgid / NXCD; wgid = (xcd < r ? xcd * (q + 1) : r * (q + 1) + (xcd - r) * q) + off; }
        const int nig = WGM * nN, gid = wgid / nig, fm = gid * WGM, gsz = (nM - fm) < WGM ? (nM - fm) : WGM;
        u.pm = fm + ((wgid % nig) % gsz); u.pn = (wgid % nig) / gsz; u.e = 0; u.idx = i; u.rbase = u.pm * BM; u.nrows = BM; return true;
    }
    __device__ __forceinline__ const char* a_ptr(const Unit& u) const { return A + (size_t)u.pm * BM * K * 2; }
    __device__ __forceinline__ const char* b_ptr(const Unit& u) const { return Bt + (size_t)u.pn * BM * K * 2; }
    __device__ __forceinline__ unsigned a_off(const Unit&, int) const { return 0u; }
    __device__ __forceinline__ void a_ready(const Unit&) const {}
    __device__ __forceinline__ void done(const Unit&) const {}
};

__device__ __forceinline__ unsigned cvt_pk_bf16(float lo, float hi) { unsigned r; asm volatile("v_cvt_pk_bf16_f32 %0, %1, %2" : "=v"(r) : "v"(lo), "v"(hi)); return r; }

template <class Epi, class Sched, bool ALIGN_EPI, bool GATHER>
__device__ __forceinline__ void gemm_phase(PG8_LAS unsigned char* lds, const int K, const Sched& S, const Epi& E, const int wid) {
    int lane_ = lane_id(); asm volatile("" : "+v"(lane_));
    const int lane = lane_, tid = wid * 64 + lane, wr = wid >> 2, wc = wid & 3, fr = lane & 15, fq = lane >> 4;
    const int nt = K / BK;
    unsigned voffB[2]; int RA[2], CA[2];
#pragma unroll
    for (int i = 0; i < 2; ++i) { int R, C; stage_rc(tid * 16 + i * 8192, R, C); const int Rb = Epi::PERM ? ((R & ~31) + perm32(R & 31)) : R;
        RA[i] = R; CA[i] = C; voffB[i] = (unsigned)(Rb * K + C) * 2u; }
    const size_t kstep = (size_t)(BK * 2);
    const size_t hstep = (size_t)HALF * K * 2;
    const unsigned ldsw = (unsigned)wid * 1024u;
    const int aoff = lds_byte(wr * 64 + fr, fq * 8), boff = lds_byte(wc * 32 + fr, fq * 8);
#define PG8_SA(b, h) (((b) * 2 + (h)) * HTB)
#define PG8_SB(b, h) ((4 + (b) * 2 + (h)) * HTB)
#define PG8_STAGE(bufoff, gbase, voff) do { _Pragma("unroll") for (int _i = 0; _i < 2; ++_i) \
        __builtin_amdgcn_global_load_lds((const unsigned*)((const char*)(gbase) + (voff)[_i]), (PG8_LAS unsigned*)(lds + (bufoff) + ldsw + _i * 8192), 16, 0, 0); } while (0)
#define PG8_LDA(dst, b, h) do { _Pragma("unroll") for (int m = 0; m < 4; ++m) _Pragma("unroll") for (int k = 0; k < 2; ++k) dst[m][k] = *(const PG8_LAS bf16x8*)(lds + PG8_SA(b, h) + aoff + m * 2048 + k * 1024); } while (0)
#define PG8_LDB(dst, b, h) do { _Pragma("unroll") for (int n = 0; n < 2; ++n) _Pragma("unroll") for (int k = 0; k < 2; ++k) dst[n][k] = *(const PG8_LAS bf16x8*)(lds + PG8_SB(b, h) + boff + n * 2048 + k * 1024); } while (0)
#define PG8_MMA(ai, bj, At, Bt) do { __builtin_amdgcn_s_setprio(1); _Pragma("unroll") for (int m = 0; m < 4; ++m) _Pragma("unroll") for (int n = 0; n < 2; ++n) _Pragma("unroll") for (int k = 0; k < 2; ++k) \
        acc[ai][bj][m][n] = __builtin_amdgcn_mfma_f32_16x16x32_bf16(Bt[n][k], At[m][k], acc[ai][bj][m][n], 0, 0, 0); __builtin_amdgcn_s_setprio(0); } while (0)
#define PG8_WAIT_V(n) asm volatile("s_waitcnt vmcnt(" #n ")" ::: "memory")
#define PG8_WAIT_L(n) asm volatile("s_waitcnt lgkmcnt(" #n ")" ::: "memory")
#define PG8_BAR __builtin_amdgcn_s_barrier()
#define PG8_SCHED __builtin_amdgcn_sched_barrier(0)
#define PG8_OFFS(dst, u) do { _Pragma("unroll") for (int _h = 0; _h < 2; ++_h) _Pragma("unroll") for (int _i = 0; _i < 2; ++_i) \
        dst[_h][_i] = GATHER ? (S.a_off(u, _h * HALF + RA[_i]) + (unsigned)CA[_i] * 2u) : (unsigned)(((_h * HALF + RA[_i]) * K + CA[_i]) * 2); } while (0)
    Unit cur, nxt; int ui = 0;
    if (!S.next(0, cur)) return;
    f32x4 acc[2][2][4][2];
#pragma unroll
    for (int a = 0; a < 2; ++a)
#pragma unroll
        for (int b = 0; b < 2; ++b)
#pragma unroll
            for (int m = 0; m < 4; ++m)
#pragma unroll
                for (int n = 0; n < 2; ++n) acc[a][b][m][n] = (f32x4){0.f, 0.f, 0.f, 0.f};
    bf16x8 At[4][2], B0[2][2], B1[2][2];
    unsigned offA[2][2], offAn[2][2];
    PG8_OFFS(offA, cur);
    const char* cA = S.a_ptr(cur); const char* cB = S.b_ptr(cur);
    S.a_ready(cur);
    PG8_STAGE(PG8_SB(0, 0), cB, voffB); PG8_STAGE(PG8_SB(0, 1), cB + hstep, voffB); PG8_STAGE(PG8_SA(0, 0), cA, offA[0]); PG8_STAGE(PG8_SA(0, 1), cA, offA[1]);
    if (wr == 1) PG8_BAR;
    PG8_WAIT_V(2); PG8_BAR;
    PG8_STAGE(PG8_SB(1, 0), cB + kstep, voffB); PG8_STAGE(PG8_SA(1, 0), cA + kstep, offA[0]); PG8_STAGE(PG8_SB(1, 1), cB + hstep + kstep, voffB);
    PG8_WAIT_V(6); PG8_BAR;
    for (;;) {
        const bool has_next = S.next(ui + 1, nxt);
        const char* nA = has_next ? S.a_ptr(nxt) : cA; const char* nB = has_next ? S.b_ptr(nxt) : cB;
        if (GATHER && has_next) { PG8_OFFS(offAn, nxt); }
        else {
#pragma unroll
            for (int h = 0; h < 2; ++h)
#pragma unroll
                for (int i = 0; i < 2; ++i) offAn[h][i] = offA[h][i]; }
        for (int t = 0; t < nt; t += 2) {
            const bool last = (t == nt - 2);
            const char* a1 = cA + (size_t)(t + 1) * kstep;
            const char* a2 = last ? nA : cA + (size_t)(t + 2) * kstep; const char* b2 = last ? nB : cB + (size_t)(t + 2) * kstep;
            const char* a3 = a2 + kstep; const char* b3 = b2 + kstep;
            unsigned o2[2][2];
#pragma unroll
            for (int h = 0; h < 2; ++h)
#pragma unroll
                for (int i = 0; i < 2; ++i) o2[h][i] = (GATHER && last) ? offAn[h][i] : offA[h][i];
            if (last && has_next) S.a_ready(nxt);
            PG8_LDB(B0, 0, 0); PG8_LDB(B1, 0, 1); PG8_SCHED; PG8_LDA(At, 0, 0); PG8_STAGE(PG8_SA(1, 1), a1, offA[1]);
            PG8_WAIT_V(8); PG8_WAIT_L(0); PG8_BAR; PG8_MMA(0, 0, At, B0); PG8_MMA(0, 1, At, B1); PG8_BAR; PG8_SCHED;
            PG8_LDA(At, 0, 1); PG8_STAGE(PG8_SB(0, 0), b2, voffB); PG8_STAGE(PG8_SB(0, 1), b2 + hstep, voffB); PG8_STAGE(PG8_SA(0, 0), a2, o2[0]);
            PG8_WAIT_V(8); PG8_WAIT_L(0); PG8_BAR; PG8_MMA(1, 0, At, B0); PG8_MMA(1, 1, At, B1); PG8_BAR; PG8_SCHED;
            PG8_LDB(B0, 1, 0); PG8_LDB(B1, 1, 1); PG8_SCHED; PG8_LDA(At, 1, 0); PG8_STAGE(PG8_SA(0, 1), a2, o2[1]);
            PG8_WAIT_V(8); PG8_WAIT_L(0); PG8_BAR; PG8_MMA(0, 0, At, B0); PG8_MMA(0, 1, At, B1); PG8_BAR; PG8_SCHED;
            PG8_LDA(At, 1, 1); PG8_STAGE(PG8_SB(1, 0), b3, voffB); PG8_STAGE(PG8_SB(1, 1), b3 + hstep, voffB); PG8_STAGE(PG8_SA(1, 0), a3, o2[0]);
            PG8_WAIT_V(8); PG8_WAIT_L(0); PG8_BAR; PG8_MMA(1, 0, At, B0); PG8_MMA(1, 1, At, B1); PG8_BAR; PG8_SCHED;
        }
        if constexpr (ALIGN_EPI) { if (wr == 0) PG8_BAR; }
        { int fr2 = fr, fq2 = fq; asm volatile("" : "+v"(fr2), "+v"(fq2));
          E(acc, cur, wr, wc, fr2, fq2); } S.done(cur);
        if (!has_next) break;
#pragma unroll
        for (int a = 0; a < 2; ++a)
#pragma unroll
            for (int b = 0; b < 2; ++b)
#pragma unroll
                for (int m = 0; m < 4; ++m)
#pragma unroll
                    for (int n = 0; n < 2; ++n) acc[a][b][m][n] = (f32x4){0.f, 0.f, 0.f, 0.f};
        cur = nxt; cA = nA; cB = nB; ++ui;
#pragma unroll
        for (int h = 0; h < 2; ++h)
#pragma unroll
            for (int i = 0; i < 2; ++i) offA[h][i] = offAn[h][i];
        if constexpr (ALIGN_EPI) { if (wr == 1) PG8_BAR; }
    }
    PG8_WAIT_V(0);
    if constexpr (!ALIGN_EPI) { if (wr == 0) PG8_BAR; }
    PG8_BAR;
#undef PG8_SA
#undef PG8_SB
#undef PG8_STAGE
#undef PG8_LDA
#undef PG8_LDB
#undef PG8_MMA
#undef PG8_WAIT_V
#undef PG8_WAIT_L
#undef PG8_BAR
#undef PG8_SCHED
#undef PG8_OFFS
}
}
namespace pg8 {
__device__ __forceinline__ float fsigmoid(float x) { return __builtin_amdgcn_rcpf(1.0f + __builtin_amdgcn_exp2f(-LOG2E * x)); }
__device__ __forceinline__ u32x4 pack8(const f32x4 a, const f32x4 b) { u32x4 w; w.x = cvt_pk_bf16(a[0], a[1]); w.y = cvt_pk_bf16(a[2], a[3]); w.z = cvt_pk_bf16(b[0], b[1]); w.w = cvt_pk_bf16(b[2], b[3]); return w; }
__device__ __forceinline__ void unpack8(const u32x4 w, f32x4& a, f32x4& b) {
    a[0] = __uint_as_float(w.x << 16); a[1] = __uint_as_float(w.x & 0xffff0000u); a[2] = __uint_as_float(w.y << 16); a[3] = __uint_as_float(w.y & 0xffff0000u);
    b[0] = __uint_as_float(w.z << 16); b[1] = __uint_as_float(w.z & 0xffff0000u); b[2] = __uint_as_float(w.w << 16); b[3] = __uint_as_float(w.w & 0xffff0000u); }

struct EpiQK {
    static constexpr bool PERM = true;
    bf16 *qsb, *ksb;
    __device__ __forceinline__ void operator()(const f32x4 (&acc)[2][2][4][2], const Unit& u, int wr, int wc, int fr, int fq) const {
        const int pn = u.pn; const int row0 = u.pm * BM + wr * 64 + fr; const int cin = wc * 32 + 8 * fq;
        const bool isQ = pn < 4; const float sc = isQ ? SB_C2 : 1.0f; const int colt = (pn & 3) * 256;
#pragma unroll
        for (int ai = 0; ai < 2; ++ai)
#pragma unroll
            for (int m = 0; m < 4; ++m) { const int row = row0 + ai * HALF + m * 16;
#pragma unroll
                for (int bj = 0; bj < 2; ++bj) { const int col = colt + cin + bj * HALF;
                    bf16* dst = isQ ? qsb + (size_t)row * 1024 + col : ksb + ksb_idx((row >> 13) * 16 + (col >> 6), row & (SEQ - 1), col & 63);
                    *(u32x4*)dst = pack8(acc[ai][bj][m][0] * sc, acc[ai][bj][m][1] * sc); } }
    }
};
struct EpiRot {
    static constexpr bool PERM = true;
    bf16 *qr, *kr, *krt, *qrs; const float *cosT, *sinT;
    __device__ __forceinline__ void operator()(const f32x4 (&acc)[2][2][4][2], const Unit& u, int wr, int wc, int fr, int fq) const {
        const int pn = u.pn; const int row0 = u.pm * BM + wr * 64 + fr; const int cin = wc * 32 + 8 * fq;
        const bool isK = pn >= 4; const int head = pn & 3; bf16* O = isK ? kr : qr; const float sc = isK ? 1.0f : 0.0625f;
        const int pos0 = row0 & (SEQ - 1);
        f32x4 c[2], sn[2], dc[2], ds[2], ec[2], es[2];
#pragma unroll
        for (int n = 0; n < 2; ++n) { c[n] = *(const f32x4*)(cosT + pos0 * 128 + cin + 4 * n); sn[n] = *(const f32x4*)(sinT + pos0 * 128 + cin + 4 * n);
            dc[n] = *(const f32x4*)(cosT + 16 * 128 + cin + 4 * n); ds[n] = *(const f32x4*)(sinT + 16 * 128 + cin + 4 * n);
            ec[n] = *(const f32x4*)(cosT + 80 * 128 + cin + 4 * n); es[n] = *(const f32x4*)(sinT + 80 * 128 + cin + 4 * n); }
#pragma unroll
        for (int ai = 0; ai < 2; ++ai)
#pragma unroll
            for (int m = 0; m < 4; ++m) { const int row = row0 + ai * HALF + m * 16; const int pos = row & (SEQ - 1); const int bh = (row >> 13) * 4 + head;
                f32x4 o1[2], o2[2];
#pragma unroll
                for (int n = 0; n < 2; ++n) { const f32x4 x1 = acc[ai][0][m][n], x2 = acc[ai][1][m][n]; o1[n] = (x1 * c[n] - x2 * sn[n]) * sc; o2[n] = (x1 * sn[n] + x2 * c[n]) * sc; }
                if (m < 3) {
#pragma unroll
                    for (int n = 0; n < 2; ++n) { const f32x4 cc = c[n] * dc[n] - sn[n] * ds[n]; sn[n] = sn[n] * dc[n] + c[n] * ds[n]; c[n] = cc; } }
                else if (ai == 0) {
#pragma unroll
                    for (int n = 0; n < 2; ++n) { const f32x4 cc = c[n] * ec[n] - sn[n] * es[n]; sn[n] = sn[n] * ec[n] + c[n] * es[n]; c[n] = cc; } }
                bf16* rowp = O + (size_t)row * 1024 + head * 256 + cin;
                const u32x4 w1 = pack8(o1[0], o1[1]), w2 = pack8(o2[0], o2[1]);
                *(u32x4*)(rowp) = w1; *(u32x4*)(rowp + HALF) = w2;
                if (isK) {
                    bf16* tp = krt + krt_idx(bh, pos, cin);
#pragma unroll
                    for (int q = 0; q < 4; ++q) { tp[(2 * q) * 16] = (bf16)(w1[q] & 0xffffu); tp[(2 * q + 1) * 16] = (bf16)(w1[q] >> 16);
                        tp[(HALF + 2 * q) * 16] = (bf16)(w2[q] & 0xffffu); tp[(HALF + 2 * q + 1) * 16] = (bf16)(w2[q] >> 16); }
                } else {
                    *(u32x4*)(qrs + qrs_idx(bh, pos, cin)) = w1; *(u32x4*)(qrs + qrs_idx(bh, pos, cin + HALF)) = w2; }
            }
    }
};
struct EpiGate {
    static constexpr bool PERM = true;
    unsigned char* ws;
    __device__ __forceinline__ void operator()(const f32x4 (&acc)[2][2][4][2], const Unit& u, int wr, int wc, int fr, int fq) const {
        const int pn = u.pn; const int row0 = u.pm * BM + wr * 64 + fr; const int cin = wc * 32 + 8 * fq;
        const bool silu = pn < 8; bf16* O = (bf16*)(ws + WS_SG + (size_t)(silu ? 0 : 1) * (WS_GSB - WS_SG) + (size_t)(pn >= 12 ? 1 : 0) * (WS_GRET - WS_GSB));
        const int colt = (silu ? pn : (pn & 3)) * 256;
#pragma unroll
        for (int ai = 0; ai < 2; ++ai)
#pragma unroll
            for (int m = 0; m < 4; ++m) { const int row = row0 + ai * HALF + m * 16;
#pragma unroll
                for (int bj = 0; bj < 2; ++bj) { f32x4 a = acc[ai][bj][m][0], b = acc[ai][bj][m][1];
#pragma unroll
                    for (int e = 0; e < 4; ++e) { const float sa = fsigmoid(a[e]), sb = fsigmoid(b[e]); a[e] = silu ? a[e] * sa : sa; b[e] = silu ? b[e] * sb : sb; }
                    const int col = colt + cin + bj * HALF;
                    bf16* dst = silu ? O + yt_idx((row >> 13) * 4 + (col >> 9), row & (SEQ - 1), col & 511) : O + (size_t)row * 1024 + col;
                    *(u32x4*)dst = pack8(a, b); }
                asm volatile("" ::: "memory"); }
    }
};
struct EpiVT {
    static constexpr bool PERM = true;
    bf16 *vsbt, *vrt;
    __device__ __forceinline__ void operator()(const f32x4 (&acc)[2][2][4][2], const Unit& u, int wr, int wc, int fr, int fq) const {
        const int f0 = u.pm * BM + wr * 64 + fr; const int tcol = u.pn * BM + wc * 32 + 8 * fq;
        float dec[8];
        if (u.pm < 4) {
#pragma unroll
            for (int q = 0; q < 8; ++q) dec[q] = 1.0f;
        } else { const int h = (u.pm - 4) >> 1; const float l2g = __builtin_amdgcn_logf(1.0f - __builtin_amdgcn_exp2f(-5.0f - (float)h));
#pragma unroll
            for (int q = 0; q < 8; ++q) dec[q] = __builtin_amdgcn_exp2f((float)(63 - (((wc & 1) * 32 + 8 * fq + q) & 63)) * l2g); }
#pragma unroll
        for (int ai = 0; ai < 2; ++ai)
#pragma unroll
            for (int m = 0; m < 4; ++m) { const int f = f0 + ai * HALF + m * 16;
#pragma unroll
                for (int bj = 0; bj < 2; ++bj) { f32x4 a = acc[ai][bj][m][0], b = acc[ai][bj][m][1];
#pragma unroll
                    for (int e = 0; e < 4; ++e) { a[e] *= dec[e]; b[e] *= dec[4 + e]; }
                    const int tok = tcol + bj * HALF;
                    bf16* dst = u.pm < 4 ? vsbt + vsb_idx((tok >> 13) * 16 + (f >> 6), tok & (SEQ - 1), f & 63) : vrt + vrt_idx((tok >> 13) * 4 + ((f - 1024) >> 9), tok & (SEQ - 1), (f - 1024) & 511);
                    *(u32x4*)dst = pack8(a, b); } }
    }
};
template <int MODE> struct EpiBranch {
    static constexpr bool PERM = true;
    const bf16* gate; const bf16* m1in; bf16* out;
    __device__ __forceinline__ void operator()(const f32x4 (&acc)[2][2][4][2], const Unit& u, int wr, int wc, int fr, int fq) const {
        const int row0 = u.pm * BM + wr * 64 + fr; const int col0 = u.pn * BM + wc * 32 + 8 * fq;
#pragma unroll
        for (int ai = 0; ai < 2; ++ai)
#pragma unroll
            for (int m = 0; m < 4; ++m) { const size_t ro = (size_t)(row0 + ai * HALF + m * 16) * 1024 + col0;
#pragma unroll
                for (int bj = 0; bj < 2; ++bj) { f32x4 ga, gb; unpack8(*(const u32x4*)(gate + ro + bj * HALF), ga, gb);
                    f32x4 a = acc[ai][bj][m][0] * ga, b = acc[ai][bj][m][1] * gb;
                    if (MODE == 1) { f32x4 pa, pb; unpack8(*(const u32x4*)(m1in + ro + bj * HALF), pa, pb); a += pa; b += pb; }
                    *(u32x4*)(out + ro + bj * HALF) = pack8(a, b); }
                asm volatile("" ::: "memory"); }
    }
};
struct EpiPre {
    static constexpr bool PERM = false;
    const float* x; float* pre;
    __device__ __forceinline__ void operator()(const f32x4 (&acc)[2][2][4][2], const Unit& u, int wr, int wc, int fr, int fq) const {
        const int row0 = u.pm * BM + wr * 64 + fr, col0 = u.pn * BM + wc * 32 + 4 * fq;
#pragma unroll
        for (int ai = 0; ai < 2; ++ai)
#pragma unroll
            for (int m = 0; m < 4; ++m) { const size_t ro = (size_t)(row0 + ai * HALF + m * 16) * 1024 + col0;
#pragma unroll
                for (int bj = 0; bj < 2; ++bj)
#pragma unroll
                    for (int n = 0; n < 2; ++n) { const size_t o = ro + bj * HALF + n * 16; *(f32x4*)(pre + o) = *(const f32x4*)(x + o) * DN_ALPHA + acc[ai][bj][m][n]; }
                asm volatile("" ::: "memory"); }
    }
};
struct EpiGateUp {
    static constexpr bool PERM = true;
    const float* bgu; bf16* act;
    __device__ __forceinline__ void operator()(const f32x4 (&acc)[2][2][4][2], const Unit& u, int wr, int wc, int fr, int fq) const {
        const int ff0 = u.pn * 128 + wc * 32 + 8 * fq; const float* bp = bgu + (size_t)u.e * 2048 + ff0;
#pragma unroll
        for (int ai = 0; ai < 2; ++ai)
#pragma unroll
            for (int m = 0; m < 4; ++m) { const int rr = ai * HALF + wr * 64 + m * 16 + fr;
                f32x4 bg[2], bu[2];
#pragma unroll
                for (int n = 0; n < 2; ++n) { bg[n] = *(const f32x4*)(bp + 4 * n); bu[n] = *(const f32x4*)(bp + 1024 + 4 * n); }
                f32x4 o[2];
#pragma unroll
                for (int n = 0; n < 2; ++n) { const f32x4 g = acc[ai][0][m][n] + bg[n], up = acc[ai][1][m][n] + bu[n];
#pragma unroll
                    for (int e = 0; e < 4; ++e) { const float gg = fminf(g[e], 7.0f), uu = fminf(fmaxf(up[e], -7.0f), 7.0f); o[n][e] = (uu + 1.0f) * gg * fsigmoid(1.702f * gg); } }
                if (rr < u.nrows) *(u32x4*)(act + (size_t)(u.rbase + rr) * 1024 + ff0) = pack8(o[0], o[1]);
                asm volatile("" ::: "memory"); }
    }
};
struct EpiDown {
    static constexpr bool PERM = true;
    const float* bdn; const int* rowtk; const float* roww; bf16* outr;
    __device__ __forceinline__ void operator()(const f32x4 (&acc)[2][2][4][2], const Unit& u, int wr, int wc, int fr, int fq) const {
        const int col0 = u.pn * BM + wc * 32 + 8 * fq; const float* bp = bdn + (size_t)u.e * 1024 + col0;
        const size_t lbase = (size_t)u.e * CAP + u.pm;
#pragma unroll
        for (int ai = 0; ai < 2; ++ai)
#pragma unroll
            for (int m = 0; m < 4; ++m) { const int rr = ai * HALF + wr * 64 + m * 16 + fr;
                if (rr < u.nrows) { const int tk = rowtk[lbase + rr]; const float w = roww[lbase + rr]; bf16* rowp = outr + (size_t)tk * 1024 + col0;
#pragma unroll
                    for (int bj = 0; bj < 2; ++bj) { const f32x4 b0 = *(const f32x4*)(bp + bj * HALF), b1 = *(const f32x4*)(bp + bj * HALF + 4);
                        *(u32x4*)(rowp + bj * HALF) = pack8((acc[ai][bj][m][0] + b0) * w, (acc[ai][bj][m][1] + b1) * w); } }
                asm volatile("" ::: "memory"); }
    }
};
}
#define GAS __attribute__((address_space(1)))
#define LAS __attribute__((address_space(3)))
typedef GAS unsigned gu32;
#define RLX_AGENT __ATOMIC_RELAXED, __HIP_MEMORY_SCOPE_AGENT
constexpr int NWAVES = 8;
constexpr int RING_OFF = 0, RING_BYTES = 131072;
constexpr int LDSCTL_OFF = RING_BYTES;
constexpr int LDS_TAB_OFF = RING_BYTES + 1024;
constexpr int LDS_BYTES = LDS_TAB_OFF + 24 * 256 * 4;
static_assert(LDS_BYTES <= 163840, "LDS");

#define XB_TMO      128
#define XB_XCNT(j)  (256  + 64 * (j))
#define XB_XSUB(j)  (1280 + 64 * (j))
#define XB_XGEN(j)  (2304 + 64 * (j))
#define XB_TOP      3328
#define XB_TOPGEN   3392
#define XCD_BAR_WORDS 3456
#define XB_SPIN_CAP (1u << 18)
__device__ __forceinline__ unsigned xb_ld(unsigned* p)              { return __hip_atomic_load(p, __ATOMIC_RELAXED, __HIP_MEMORY_SCOPE_AGENT); }
__device__ __forceinline__ unsigned xb_add(unsigned* p, unsigned v) { return __hip_atomic_fetch_add(p, v, __ATOMIC_RELAXED, __HIP_MEMORY_SCOPE_AGENT); }
__device__ __forceinline__ unsigned xb_xcc_id() { return (unsigned)__builtin_amdgcn_s_getreg((3 << 11) | 20) & 0xFu; }
#define XB_SPIN(cond, bar) do { unsigned _sp = 0; while (cond) { __builtin_amdgcn_s_sleep(1); \
    if ((++_sp & 255u) == 0u) { if (xb_ld(&(bar)[XB_TMO])) break; if (_sp > XB_SPIN_CAP) { atomicAdd(&(bar)[XB_TMO], 1u); break; } } } } while (0)
struct XcdBarrier { unsigned* bar; unsigned x; volatile LAS unsigned* st; };
__device__ __forceinline__ XcdBarrier xcd_barrier_post(unsigned* bar, volatile LAS unsigned* st) {
    XcdBarrier b; b.bar = bar; b.x = xb_xcc_id(); b.st = st;
    if (threadIdx.x == 0) (void)xb_add(&bar[XB_XCNT(b.x)], 1u);
    return b;
}
__device__ __forceinline__ void xcd_barrier_complete(unsigned* bar, unsigned x, unsigned& nloc, unsigned& nx) {
    const unsigned G = gridDim.x * gridDim.y * gridDim.z;
    unsigned sum, cnt, mine, sp = 0u;
    for (;;) {
        sum = 0u; cnt = 0u; mine = 0u;
#pragma unroll
        for (unsigned j = 0; j < 16; ++j) { const unsigned c = xb_ld(&bar[XB_XCNT(j)]); sum += c; cnt += (c > 0u) ? 1u : 0u; mine = (j == x) ? c : mine; }
        if (sum == G) break;
        __builtin_amdgcn_s_sleep(1);
        if ((++sp & 255u) == 0u) { if (xb_ld(&bar[XB_TMO])) break; if (sp > XB_SPIN_CAP) { atomicAdd(&bar[XB_TMO], 1u); break; } }
    }
    nloc = mine > 0u ? mine : 1u; nx = cnt > 0u ? cnt : 1u;
}
__device__ __forceinline__ void xcd_barrier(const XcdBarrier& b) {
    asm volatile("s_waitcnt vmcnt(0)" ::: "memory");
    __syncthreads();
    if (threadIdx.x == 0) {
        unsigned* bar = b.bar;
        __builtin_amdgcn_s_waitcnt(0);
        unsigned nloc = b.st[0], nx = b.st[1];
        if (nloc == 0u) { xcd_barrier_complete(bar, b.x, nloc, nx); b.st[0] = nloc; b.st[1] = nx; }
        const unsigned old = xb_add(&bar[XB_XSUB(b.x)], 1u);
        const unsigned gen = old / nloc;
        if (old + 1u == (gen + 1u) * nloc) {
            __builtin_amdgcn_fence(__ATOMIC_RELEASE, "agent");
            asm volatile("s_waitcnt vmcnt(0)" ::: "memory");
            const unsigned og = xb_add(&bar[XB_TOP], 1u);
            const unsigned tg = og / nx;
            if (og + 1u == (tg + 1u) * nx) xb_add(&bar[XB_TOPGEN], 1u);
            else XB_SPIN(xb_ld(&bar[XB_TOPGEN]) == tg, bar);
            __builtin_amdgcn_fence(__ATOMIC_ACQUIRE, "agent");
            xb_add(&bar[XB_XGEN(b.x)], 1u);
            asm volatile("s_waitcnt vmcnt(0)" ::: "memory");
        } else {
            XB_SPIN(xb_ld(&bar[XB_XGEN(b.x)]) == gen, bar);
            __builtin_amdgcn_fence(__ATOMIC_ACQUIRE, "agent");
            asm volatile("s_waitcnt vmcnt(0)" ::: "memory");
        }
    }
    __syncthreads();
}

struct Frame {
    LAS unsigned char* lds; volatile LAS unsigned* LC;
    unsigned* ctl;
    int wave, vcu, G;
    Bufs B;
};
#define FWS(T, off) ((T*)(F.B.ws + (off)))
#define FDO(T, off) ((T*)((unsigned char*)F.B.out + (off)))
#define LDS_WAIT() asm volatile("s_waitcnt lgkmcnt(0)" ::: "memory")
#define VM_WAIT() asm volatile("s_waitcnt vmcnt(0)" ::: "memory")

__device__ __forceinline__ f32x16 mfma32(bf16x8 a, bf16x8 b, f32x16 c) { return __builtin_amdgcn_mfma_f32_32x32x16_bf16(a, b, c, 0, 0, 0); }
__device__ __forceinline__ int crow(int r, int hi) { return (r & 3) + 8 * (r >> 2) + 4 * hi; }
__device__ __forceinline__ float swap_lo(float x, float& hi_out) { auto rr = __builtin_amdgcn_permlane32_swap(__float_as_uint(x), __float_as_uint(x), false, false); hi_out = __uint_as_float(rr[1]); return __uint_as_float(rr[0]); }
__device__ __forceinline__ bf16x8 pack_frag(const f32x16& v, int base) {
    u32x4 w; w.x = pg8::cvt_pk_bf16(v[base + 0], v[base + 1]); w.y = pg8::cvt_pk_bf16(v[base + 2], v[base + 3]); w.z = pg8::cvt_pk_bf16(v[base + 4], v[base + 5]); w.w = pg8::cvt_pk_bf16(v[base + 6], v[base + 7]);
    return __builtin_bit_cast(bf16x8, w); }
__device__ __forceinline__ bf16x8 join8(u32x2 a, u32x2 b) { u32x4 w; w.x = a.x; w.y = a.y; w.z = b.x; w.w = b.y; return __builtin_bit_cast(bf16x8, w); }
__device__ __forceinline__ float ret_l2g(int h) { return __builtin_amdgcn_logf(1.0f - __builtin_amdgcn_exp2f(-5.0f - (float)h)); }

__device__ __forceinline__ void tr_item(const float* src, int lds_, int k0, int c0, bf16* dst, int K, int r0, LAS unsigned char* scr, int lane) {
    const int kr = lane >> 4, nq = lane & 15;
    f32x4 v[4][4];
#pragma unroll
    for (int gI = 0; gI < 4; ++gI)
#pragma unroll
        for (int i = 0; i < 4; ++i) v[gI][i] = *(const f32x4*)(src + (size_t)(k0 + 16 * gI + 4 * kr + i) * lds_ + c0 + 4 * nq);
#pragma unroll
    for (int gI = 0; gI < 4; ++gI)
#pragma unroll
        for (int e = 0; e < 4; ++e) { u32x2 w; w.x = pk2(v[gI][0][e], v[gI][1][e]); w.y = pk2(v[gI][2][e], v[gI][3][e]);
            *(LAS u32x2*)(scr + (4 * nq + e) * 144 + 32 * gI + 8 * kr) = w; }
    LDS_WAIT(); asm volatile("" ::: "memory");
#pragma unroll
    for (int it = 0; it < 8; ++it) { const int n = it * 8 + (lane >> 3), ch = lane & 7;
        const u32x4 w = *(const LAS u32x4*)(scr + n * 144 + ch * 16);
        *(u32x4*)(dst + (size_t)(r0 + n) * K + k0 + 8 * ch) = w; }
    LDS_WAIT(); asm volatile("" ::: "memory");
}
__device__ __forceinline__ void p0_prologue(Frame& F) {
    const Bufs& B = F.B; const int lane_ = lane_id(), tid_ = F.wave * 64 + lane_;
    const int gw = F.vcu * NWAVES + F.wave, NGW = F.G * NWAVES;
    { const f32x4* xs = (const f32x4*)B.x; u32x4* xd = FDO(u32x4, DO_XB); const size_t n8 = (size_t)NTOK * DM / 8;
      for (size_t i = (size_t)blockIdx.x * 512 + tid_; i < n8; i += (size_t)F.G * 512) { const f32x4 a = xs[2 * i], b = xs[2 * i + 1];
          u32x4 w; w.x = pk2(a[0], a[1]); w.y = pk2(a[2], a[3]); w.z = pk2(b[0], b[1]); w.w = pk2(b[2], b[3]); xd[i] = w; } }
    LAS unsigned char* scr = F.lds + RING_OFF + F.wave * 9216;
    constexpr int I_IN = 16 * (INW / 64)  , I_BSB = 256, I_BRET = 32 * 16, I_OUT = 256;
    constexpr int NITEMS = I_IN + I_BSB + I_BRET + I_OUT;
    for (int it = gw; it < NITEMS; it += NGW) {
        int r = it;
        if (r < I_IN) { const int kb = r / (INW / 64), nb = r % (INW / 64); const int c0 = nb * 64; bf16* dst; int r0;
            if (c0 < 2048) { dst = FWS(bf16, WS_WINT); r0 = c0; } else if (c0 < 3072) { dst = FWS(bf16, WS_WVT); r0 = c0 - 2048; }
            else if (c0 < 5120) { dst = FWS(bf16, WS_WINT); r0 = 2048 + c0 - 3072; } else if (c0 < 7168) { dst = FWS(bf16, WS_WVT); r0 = 1024 + c0 - 5120; }
            else { dst = FWS(bf16, WS_WINT); r0 = 4096 + c0 - 7168; }
            tr_item(B.w_in, INW, kb * 64, c0, dst, 1024, r0, scr, lane_); continue; } r -= I_IN;
        if (r < I_BSB) { tr_item(B.w_bsb, 1024, (r >> 4) * 64, (r & 15) * 64, FWS(bf16, WS_WBSBT), 1024, (r & 15) * 64, scr, lane_); continue; } r -= I_BSB;
        if (r < I_BRET) { tr_item(B.w_bret, 1024, (r >> 4) * 64, (r & 15) * 64, FWS(bf16, WS_WBRETT), 2048, (r & 15) * 64, scr, lane_); continue; } r -= I_BRET;
        tr_item(B.w_out, 1024, (r >> 4) * 64, (r & 15) * 64, FWS(bf16, WS_WOUTT), 1024, (r & 15) * 64, scr, lane_);
    }
    { float* ct = FWS(float, WS_COS); float* st = FWS(float, WS_SIN);
      for (int i = blockIdx.x * 512 + tid_; i < SEQ * 128; i += F.G * 512) { const int pos = i >> 7, j = i & 127; const float ang = (float)pos * rope_inv_freq(j);
          ct[i] = (float)cos((double)ang); st[i] = (float)sin((double)ang); } }
    { bf16* wrt = FWS(bf16, WS_WRT);
      for (int i = blockIdx.x * 512 + tid_; i < 32 * 1024; i += F.G * 512) { const int k = i & 1023, e = i >> 10; wrt[i] = f2bf(B.w_router[k * 32 + e]); } }
}
__device__ __forceinline__ float sb_half(f32x16& p, int kbase, int tq, int hi, bool need_mask, float cin, bf16x8& f0, bf16x8& f1) {
    f32x16 u;
#pragma unroll
    for (int r = 0; r < 16; ++r) { const float e = __builtin_amdgcn_exp2f(fminf(p[r], 100.0f)); u[r] = __builtin_amdgcn_rcpf(1.0f + e); p[r] = e * u[r]; }
    if (need_mask) {
#pragma unroll
        for (int r = 0; r < 16; ++r) { const int s_ = kbase + crow(r, hi); const bool v = (s_ >= 0) && (s_ < tq); u[r] = v ? u[r] : 1.0f; p[r] = v ? p[r] : 0.0f; } }
    float T[4], Rh[4];
#pragma unroll
    for (int g = 0; g < 4; ++g) { const float R = (u[4 * g] * u[4 * g + 1]) * (u[4 * g + 2] * u[4 * g + 3]); float rh; const float rl = swap_lo(R, rh); Rh[g] = rh; T[g] = rl * rh; }
    float X[4]; X[3] = 1.0f;
#pragma unroll
    for (int g = 2; g >= 0; --g) X[g] = X[g + 1] * T[g + 1];
#pragma unroll
    for (int g = 0; g < 4; ++g) { const float ec = X[g] * (hi == 0 ? Rh[g] : 1.0f) * cin;
        const float w2 = u[4 * g + 3], w1 = w2 * u[4 * g + 2], w0 = w1 * u[4 * g + 1];
        p[4 * g + 3] *= ec; p[4 * g + 2] *= w2 * ec; p[4 * g + 1] *= w1 * ec; p[4 * g] *= w0 * ec; }
    f0 = pack_frag(p, 0); f1 = pack_frag(p, 8);
    return X[0] * T[0];
}
__device__ __forceinline__ void attn_wave_unit(const bf16* __restrict__ KSB, const bf16* __restrict__ VSBT, bf16* QY, int b, int h, int qb, int lane) {
    const int r32 = lane & 31, hi = lane >> 5; const int bh = b * 16 + h;
    const int t0 = qb * 32; const size_t rb = (size_t)b * SEQ; const int tq = t0 + r32;
    bf16x8 qf[4];
    { const bf16* qp = QY + (rb + t0 + r32) * 1024 + h * 64 + 8 * hi;
#pragma unroll
      for (int d0 = 0; d0 < 4; ++d0) qf[d0] = *(const bf16x8*)(qp + 16 * d0); }
    f32x16 o0 = {}, o1 = {};
    float carry = 1.0f;
    bf16x8 kf[2][4];
    const int koff = r32 * 16 + 8 * hi, voff = r32 * 16 + 4 * hi;
#define ATT_KLOAD(ks_) do { const bf16* b0_ = KSB + ((size_t)bh * 256 + (max((ks_), 0) >> 5)) * 2048; const bf16* b1_ = KSB + ((size_t)bh * 256 + (max((ks_) + 32, 0) >> 5)) * 2048; \
        _Pragma("unroll") for (int d0 = 0; d0 < 4; ++d0) { kf[0][d0] = *(const bf16x8*)(b0_ + d0 * 512 + koff); kf[1][d0] = *(const bf16x8*)(b1_ + d0 * 512 + koff); } } while (0)
    ATT_KLOAD(t0 - 32);
    for (int tile = 0;; ++tile) {
        const int ks = t0 + 32 - 64 * (tile + 1);
        f32x16 p0 = {}, p1 = {};
#pragma unroll
        for (int d0 = 0; d0 < 4; ++d0) { p0 = mfma32(kf[0][d0], qf[d0], p0); p1 = mfma32(kf[1][d0], qf[d0], p1); }
        bf16x8 vf[2][4];
#pragma unroll
        for (int s = 0; s < 4; ++s) { const bf16* vb_ = VSBT + ((size_t)bh * 512 + (max(ks + 16 * s, 0) >> 4)) * 1024;
#pragma unroll
            for (int db = 0; db < 2; ++db) vf[db][s] = join8(*(const u32x2*)(vb_ + db * 512 + voff), *(const u32x2*)(vb_ + db * 512 + voff + 8)); }
        ATT_KLOAD(ks - 64);
        const bool need_mask = (tile == 0) || (ks < 0);
        bf16x8 pfB0, pfB1, pfA0, pfA1;
        const float tot1 = sb_half(p1, ks + 32, tq, hi, need_mask, carry, pfB0, pfB1);
        const float tot0 = sb_half(p0, ks, tq, hi, need_mask, carry * tot1, pfA0, pfA1);
        carry *= tot1 * tot0;
        o0 = mfma32(vf[0][0], pfA0, o0); o1 = mfma32(vf[1][0], pfA0, o1); o0 = mfma32(vf[0][1], pfA1, o0); o1 = mfma32(vf[1][1], pfA1, o1);
        o0 = mfma32(vf[0][2], pfB0, o0); o1 = mfma32(vf[1][2], pfB0, o1); o0 = mfma32(vf[0][3], pfB1, o0); o1 = mfma32(vf[1][3], pfB1, o1);
        if (ks <= 0) break;
        if (__all(carry < 1.0e-37f)) break;
    }
#undef ATT_KLOAD
    bf16* op = QY + (rb + t0 + r32) * 1024 + h * 64 + 4 * hi;
#pragma unroll
    for (int g = 0; g < 4; ++g) { u32x2 w; w.x = pg8::cvt_pk_bf16(o0[4 * g], o0[4 * g + 1]); w.y = pg8::cvt_pk_bf16(o0[4 * g + 2], o0[4 * g + 3]); *(u32x2*)(op + 8 * g) = w;
        u32x2 w2; w2.x = pg8::cvt_pk_bf16(o1[4 * g], o1[4 * g + 1]); w2.y = pg8::cvt_pk_bf16(o1[4 * g + 2], o1[4 * g + 3]); *(u32x2*)(op + 32 + 8 * g) = w2; }
}
constexpr int I_GU = 32 * 16 * 32, I_DN = 32 * 16 * 16, I_MOE = I_GU + I_DN;
__device__ __forceinline__ void moe_tr_item(Frame& F, int r, LAS unsigned char* scr, int lane) {
    const Bufs& B = F.B;
    if (r < I_GU) { const int e = r >> 9, q = r & 511, kb = q >> 5, nb = q & 31; const int c0 = nb * 64; const int bj = c0 >> 10, rem = c0 & 1023, ct = rem >> 7, i0 = rem & 127;
        tr_item(B.w_gu + (size_t)e * 1024 * 2048, 2048, kb * 64, c0, FWS(bf16, WS_WGUT) + (size_t)e * 2048 * 1024, 1024, 256 * ct + 128 * bj + i0, scr, lane); return; }
    r -= I_GU;
    { const int e = r >> 8, q = r & 255, kb = q >> 4, nb = q & 15;
      tr_item(B.w_dn + (size_t)e * 1024 * 1024, 1024, kb * 64, nb * 64, FWS(bf16, WS_WDT) + (size_t)e * 1024 * 1024, 1024, nb * 64, scr, lane); }
}
__device__ __forceinline__ void attn_phase(Frame& F) {
    const int gw = F.vcu * NWAVES + F.wave, NGW = F.G * NWAVES; const int lane = lane_id();
    LAS unsigned char* scr = F.lds + RING_OFF + F.wave * 9216;
    int it = gw;
    for (int wu = gw; wu < BATCH * SBH * (SEQ / 32); wu += NGW) { const int qb = wu & 255, bh = wu >> 8;
        attn_wave_unit(FWS(bf16, WS_KSB), FWS(bf16, WS_VSBT), FWS(bf16, WS_QSB), bh >> 4, bh & 15, qb, lane);
        for (int z = 0; z < 2 && it < I_MOE; ++z, it += NGW) moe_tr_item(F, it, scr, lane); }
    for (; it < I_MOE; it += NGW) moe_tr_item(F, it, scr, lane);
}

__device__ __forceinline__ int swap23(int m) { return (m & ~12) | ((m & 4) << 1) | ((m & 8) >> 1); }
__device__ __forceinline__ void scan_phase(Frame& F) {
    if (F.vcu >= BATCH * RH * 16) return;
    const int lane = lane_id(), w = F.wave, r32 = lane & 31, hi = lane >> 5;
    const int bh = F.vcu >> 4, vs = F.vcu & 15, h = bh & 3;
    const float l2g = ret_l2g(h), cd = __builtin_amdgcn_exp2f(64.0f * l2g);
    const bf16* ktp = FDO(bf16, DO_KRT) + ((size_t)bh * 128 * 4 * 256 + (32 * w + swap23(r32))) * 16 + 8 * hi;
    const bf16* vtp = FWS(bf16, WS_VRT) + ((size_t)bh * 128 * 4 * 512 + (32 * vs + r32)) * 16 + 8 * hi;
    const bf16* qp = FWS(bf16, WS_QRS) + ((size_t)bh * 128 * 16 * 64 + (size_t)(2 * w) * 64 + r32) * 16 + 8 * hi;
    bf16* yp = FWS(bf16, WS_YINT) + ((size_t)bh * 128 * 64 + (size_t)(4 * vs + (r32 >> 3))) * 512 + (r32 & 7);
    LAS f32x4* part = (LAS f32x4*)(F.lds + RING_OFF);
    f32x16 S = {};
    bf16x8 kfA[4], vfA[4], qfA[2][2], kfB[4], vfB[4], qfB[2][2];
#define SCAN_LOAD(kf, vf, qf, c) do { _Pragma("unroll") for (int s = 0; s < 4; ++s) { kf[s] = *(const bf16x8*)(ktp + (size_t)((c) * 4 + s) * 4096); vf[s] = *(const bf16x8*)(vtp + (size_t)((c) * 4 + s) * 8192); } \
        _Pragma("unroll") for (int ib = 0; ib < 2; ++ib) _Pragma("unroll") for (int s = 0; s < 2; ++s) qf[ib][s] = *(const bf16x8*)(qp + (size_t)(c) * 16384 + s * 1024 + ib * 512); } while (0)
#define SCAN_STEP(kf, vf, qf, c) do { \
        const bf16x8 sb0 = pack_frag(S, 0), sb1 = pack_frag(S, 8); \
        f32x16 y0 = {}, y1 = {}; \
        y0 = mfma32(qf[0][0], sb0, y0); y0 = mfma32(qf[0][1], sb1, y0); \
        y1 = mfma32(qf[1][0], sb0, y1); y1 = mfma32(qf[1][1], sb1, y1); \
        LAS f32x4* pb = part + ((c) & 1) * 4096 + (w * 8) * 64 + lane; \
        _Pragma("unroll") for (int q = 0; q < 4; ++q) { pb[q * 64] = (f32x4){y0[4 * q], y0[4 * q + 1], y0[4 * q + 2], y0[4 * q + 3]}; pb[(4 + q) * 64] = (f32x4){y1[4 * q], y1[4 * q + 1], y1[4 * q + 2], y1[4 * q + 3]}; } \
        _Pragma("unroll") for (int r = 0; r < 16; ++r) S[r] *= cd; \
        _Pragma("unroll") for (int s = 0; s < 4; ++s) S = mfma32(kf[s], vf[s], S); \
        { const int cn_ = ((c) + 2 < NCHUNK) ? (c) + 2 : NCHUNK - 1; SCAN_LOAD(kf, vf, qf, cn_); }     \
        LDS_WAIT(); __builtin_amdgcn_s_barrier(); asm volatile("" ::: "memory"); \
        const LAS f32x4* rbp = part + ((c) & 1) * 4096 + w * 64 + lane;         \
        f32x4 acc = rbp[0]; \
        _Pragma("unroll") for (int w2 = 1; w2 < 8; ++w2) acc += rbp[w2 * 8 * 64]; \
        _Pragma("unroll") for (int k = 0; k < 4; ++k) { const int idx = 4 * w + k, ib = idx >> 4, r = idx & 15; const int i = 32 * ib + crow(r, hi); \
            yp[(size_t)(c) * 32768 + i * 8] = f2bf(acc[k] * __builtin_amdgcn_exp2f((float)(i + 1) * l2g)); } } while (0)
    SCAN_LOAD(kfA, vfA, qfA, 0); SCAN_LOAD(kfB, vfB, qfB, 1);
    for (int c = 0; c < NCHUNK; c += 2) { SCAN_STEP(kfA, vfA, qfA, c); SCAN_STEP(kfB, vfB, qfB, c + 1); }
#undef SCAN_STEP
#undef SCAN_LOAD
    LDS_WAIT(); __syncthreads();
}

__device__ __forceinline__ void intra_phase(Frame& F) {
    const int lane = lane_id(), w = F.wave, r32 = lane & 31, hi = lane >> 5;
    LAS float* part = (LAS float*)(F.lds + RING_OFF);
    LAS u32x4* pfl = (LAS u32x4*)(F.lds + RING_OFF + 16384);
    LAS float* red = (LAS float*)(F.lds + RING_OFF + 24576);
    LAS unsigned char* stg = F.lds + RING_OFF + 32768 + w * 9216;
    const int tl = w & 3, jb = tl >> 1, ibt = tl & 1, kh = w >> 2;
    for (int un = F.vcu * 8; un < F.vcu * 8 + 8 && un < BATCH * RH * NCHUNK; ++un) {
        const int c = un & 127, h = (un >> 7) & 3, b = un >> 9, bh = b * 4 + h;
        const size_t tok0 = (size_t)b * SEQ + c * 64; const float l2g = ret_l2g(h);
        bf16x8 kfr[8], qfr[8];
        { const bf16* kp = FWS(bf16, WS_KR) + (tok0 + 32 * jb + r32) * 1024 + h * 256 + 128 * kh + 8 * hi;
          const bf16* qp = FWS(bf16, WS_QRS) + (((size_t)bh * 128 + c) * 16 + 8 * kh) * 1024 + (32 * ibt + r32) * 16 + 8 * hi;
#pragma unroll
          for (int s = 0; s < 8; ++s) { kfr[s] = *(const bf16x8*)(kp + 16 * s); qfr[s] = *(const bf16x8*)(qp + s * 1024); } }
        bf16x8 vfr[2][4];
        { const bf16* vp = FWS(bf16, WS_VRT) + (((size_t)bh * 128 + c) * 4 * 512 + 64 * w + r32) * 16 + 4 * hi;
#pragma unroll
          for (int vb = 0; vb < 2; ++vb)
#pragma unroll
              for (int ks = 0; ks < 4; ++ks) { const bf16* p = vp + (size_t)ks * 8192 + vb * 512; vfr[vb][ks] = join8(*(const u32x2*)(p), *(const u32x2*)(p + 8)); } }
        const size_t tbase = ((((size_t)bh * 128 + c) * 64 + 8 * w) * 64 + r32) * 8 + 4 * hi;
        const bf16* yrow = FWS(bf16, WS_YINT) + tbase; const bf16* srow = FWS(bf16, WS_SG) + tbase;
        u32x2 yv[2][2][4];
#pragma unroll
        for (int ib = 0; ib < 2; ++ib)
#pragma unroll
            for (int vb = 0; vb < 2; ++vb)
#pragma unroll
                for (int g = 0; g < 4; ++g) yv[ib][vb][g] = *(const u32x2*)(yrow + (size_t)(4 * vb + g) * 512 + ib * 256);
        f32x16 X = {};
#pragma unroll
        for (int s = 0; s < 8; ++s) X = mfma32(kfr[s], qfr[s], X);
        u32x2 sv[2][2][4];
#pragma unroll
        for (int ib = 0; ib < 2; ++ib)
#pragma unroll
            for (int vb = 0; vb < 2; ++vb)
#pragma unroll
                for (int g = 0; g < 4; ++g) sv[ib][vb][g] = *(const u32x2*)(srow + (size_t)(4 * vb + g) * 512 + ib * 256);
        if (kh == 1) {
#pragma unroll
            for (int r = 0; r < 16; ++r) part[(tl * 16 + r) * 64 + lane] = X[r]; }
        LDS_WAIT(); __builtin_amdgcn_s_barrier(); asm volatile("" ::: "memory");
        if (kh == 0) {
#pragma unroll
            for (int r = 0; r < 16; ++r) { const int j = 32 * jb + crow(r, hi), i = 32 * ibt + r32;
                X[r] = (X[r] + part[(tl * 16 + r) * 64 + lane]) * __builtin_amdgcn_exp2f((float)((j <= i ? i - j : j - i) - 63 + j) * l2g); }
            pfl[(ibt * 4 + 2 * jb) * 64 + lane] = __builtin_bit_cast(u32x4, pack_frag(X, 0)); pfl[(ibt * 4 + 2 * jb + 1) * 64 + lane] = __builtin_bit_cast(u32x4, pack_frag(X, 8)); }
        LDS_WAIT(); __builtin_amdgcn_s_barrier(); asm volatile("" ::: "memory");
        f32x16 Y[2][2] = {};
#pragma unroll
        for (int ks = 0; ks < 4; ++ks) { const bf16x8 p0 = __builtin_bit_cast(bf16x8, pfl[(0 * 4 + ks) * 64 + lane]), p1 = __builtin_bit_cast(bf16x8, pfl[(1 * 4 + ks) * 64 + lane]);
#pragma unroll
            for (int vb = 0; vb < 2; ++vb) { Y[vb][0] = mfma32(vfr[vb][ks], p0, Y[vb][0]); Y[vb][1] = mfma32(vfr[vb][ks], p1, Y[vb][1]); } }
        float s1[2] = {0.f, 0.f}, s2[2] = {0.f, 0.f};
#pragma unroll
        for (int ib = 0; ib < 2; ++ib)
#pragma unroll
            for (int vb = 0; vb < 2; ++vb)
#pragma unroll
                for (int g = 0; g < 4; ++g) { const u32x2 wv = yv[ib][vb][g];
                    Y[vb][ib][4 * g] += __uint_as_float(wv.x << 16); Y[vb][ib][4 * g + 1] += __uint_as_float(wv.x & 0xffff0000u); Y[vb][ib][4 * g + 2] += __uint_as_float(wv.y << 16); Y[vb][ib][4 * g + 3] += __uint_as_float(wv.y & 0xffff0000u);
#pragma unroll
                    for (int e = 0; e < 4; ++e) { const float y = Y[vb][ib][4 * g + e]; s1[ib] += y; s2[ib] += y * y; } }
#pragma unroll
        for (int ib = 0; ib < 2; ++ib) { float h1, h2; const float l1 = swap_lo(s1[ib], h1), l2 = swap_lo(s2[ib], h2);
            if (hi == 0) { red[(w * 64 + 32 * ib + r32) * 2] = l1 + h1; red[(w * 64 + 32 * ib + r32) * 2 + 1] = l2 + h2; } }
        LDS_WAIT(); __builtin_amdgcn_s_barrier(); asm volatile("" ::: "memory");
#pragma unroll
        for (int ib = 0; ib < 2; ++ib) { float t1 = 0.f, t2 = 0.f;
#pragma unroll
            for (int w2 = 0; w2 < 8; ++w2) { t1 += red[(w2 * 64 + 32 * ib + r32) * 2]; t2 += red[(w2 * 64 + 32 * ib + r32) * 2 + 1]; }
            const float mean = t1 * (1.0f / 512.0f), var = fmaxf(t2 * (1.0f / 512.0f) - mean * mean, 0.0f), rstd = __builtin_amdgcn_rsqf(var + LN_EPS);
#pragma unroll
            for (int vb = 0; vb < 2; ++vb)
#pragma unroll
                for (int g = 0; g < 4; ++g) { const u32x2 sw = sv[ib][vb][g];
                    const float g0 = __uint_as_float(sw.x << 16), g1 = __uint_as_float(sw.x & 0xffff0000u), g2 = __uint_as_float(sw.y << 16), g3 = __uint_as_float(sw.y & 0xffff0000u);
                    u32x2 ov; ov.x = pg8::cvt_pk_bf16(g0 * (Y[vb][ib][4 * g] - mean) * rstd, g1 * (Y[vb][ib][4 * g + 1] - mean) * rstd);
                    ov.y = pg8::cvt_pk_bf16(g2 * (Y[vb][ib][4 * g + 2] - mean) * rstd, g3 * (Y[vb][ib][4 * g + 3] - mean) * rstd);
                    *(LAS u32x2*)(stg + (32 * ib + r32) * 144 + (32 * vb + 8 * g + 4 * hi) * 2) = ov; } }
        LDS_WAIT(); asm volatile("" ::: "memory");
        { bf16* rp = FDO(bf16, DO_R) + (tok0 + (lane >> 3)) * 2048 + h * 512 + 64 * w + 8 * (lane & 7);
#pragma unroll
          for (int k = 0; k < 8; ++k) { const u32x4 v = *(const LAS u32x4*)(stg + (8 * k + (lane >> 3)) * 144 + (lane & 7) * 16); *(u32x4*)(rp + (size_t)(8 * k) * 2048) = v; } }
        LDS_WAIT(); asm volatile("" ::: "memory");
    }
    LDS_WAIT(); __syncthreads();
}

__device__ __forceinline__ void ln1_router_phase(Frame& F) {
    const Bufs& B = F.B;
    const int lane = lane_id(), w = F.wave, r32 = lane & 31, hi = lane >> 5; const int tid_ = w * 64 + lane;
    LAS unsigned char* xt = F.lds + RING_OFF;
    LAS f32x4* pl = (LAS f32x4*)(F.lds + RING_OFF + 66048);
    LAS int* selE = (LAS int*)(F.lds + RING_OFF + 98816);
    LAS float* selW = (LAS float*)(F.lds + RING_OFF + 98816 + 2048);
    volatile LAS unsigned* hist = F.LC + 96; volatile LAS unsigned* basew = F.LC + 128;
    if (tid_ < 32) hist[tid_] = 0u;
    f32x4 gv[4], bv[4];
#pragma unroll
    for (int j = 0; j < 4; ++j) { gv[j] = *(const f32x4*)(B.ln1_g + 4 * lane + 256 * j); bv[j] = *(const f32x4*)(B.ln1_b + 4 * lane + 256 * j); }
    const int wgrow0 = F.vcu * 128;
    f32x4 vn[4][4];
#define LN_LOAD(blk_) do { _Pragma("unroll") for (int rr = 0; rr < 4; ++rr) { const float* p_ = B.out + (size_t)(wgrow0 + 32 * (blk_) + 4 * w + rr) * 1024 + 4 * lane; \
        _Pragma("unroll") for (int j = 0; j < 4; ++j) vn[rr][j] = *(const f32x4*)(p_ + 256 * j); } } while (0)
    LN_LOAD(0);
    for (int blk = 0; blk < 4; ++blk) {
        const int row0 = wgrow0 + 32 * blk;
        f32x4 vc[4][4];
#pragma unroll
        for (int rr = 0; rr < 4; ++rr)
#pragma unroll
            for (int j = 0; j < 4; ++j) vc[rr][j] = vn[rr][j];
        { const int nb = blk < 3 ? blk + 1 : 3; LN_LOAD(nb); }
#pragma unroll
        for (int rr = 0; rr < 4; ++rr) { const int lr = 4 * w + rr; bf16* xb = FWS(bf16, WS_X1B) + (size_t)(row0 + lr) * 1024 + 4 * lane;
            f32x4 v[4]; float s = 0.f;
#pragma unroll
            for (int j = 0; j < 4; ++j) { v[j] = vc[rr][j]; s += (v[j][0] + v[j][1]) + (v[j][2] + v[j][3]); }
            const float mean = wave_sum(s) * (1.f / 1024.f); float s2 = 0.f;
#pragma unroll
            for (int j = 0; j < 4; ++j) { v[j] = v[j] - mean; s2 += (v[j][0] * v[j][0] + v[j][1] * v[j][1]) + (v[j][2] * v[j][2] + v[j][3] * v[j][3]); }
            const float rstd = rsqrtf(wave_sum(s2) * (1.f / 1024.f) + LN_EPS);
#pragma unroll
            for (int j = 0; j < 4; ++j) { const f32x4 y = v[j] * rstd * gv[j] + bv[j];
                u32x2 o; o.x = pg8::cvt_pk_bf16(y[0], y[1]); o.y = pg8::cvt_pk_bf16(y[2], y[3]); *(u32x2*)(xb + 256 * j) = o;
                *(LAS u32x2*)(xt + lr * 2064 + (4 * lane + 256 * j) * 2) = o; } }
        LDS_WAIT(); __builtin_amdgcn_s_barrier(); asm volatile("" ::: "memory");
        f32x16 acc = {};
        { const bf16* ap = FWS(bf16, WS_WRT) + (size_t)r32 * 1024 + 128 * w + 8 * hi; const LAS unsigned char* bp = xt + r32 * 2064 + (128 * w + 8 * hi) * 2;
#pragma unroll
          for (int s = 0; s < 8; ++s) acc = mfma32(*(const bf16x8*)(ap + 16 * s), *(const LAS bf16x8*)(bp + 32 * s), acc); }
#pragma unroll
        for (int q = 0; q < 4; ++q) pl[(w * 4 + q) * 64 + lane] = (f32x4){acc[4 * q], acc[4 * q + 1], acc[4 * q + 2], acc[4 * q + 3]};
        LDS_WAIT(); __builtin_amdgcn_s_barrier(); asm volatile("" ::: "memory");
        const bool fin = (w == (blk & 7));
        f32x4 t[4];
        if (fin) {
#pragma unroll
            for (int q = 0; q < 4; ++q) { t[q] = pl[q * 64 + lane];
#pragma unroll
                for (int w2 = 1; w2 < 8; ++w2) t[q] += pl[(w2 * 4 + q) * 64 + lane]; } }
        LDS_WAIT(); __builtin_amdgcn_s_barrier(); asm volatile("" ::: "memory");
        if (fin) {
            float lo[16], hv[16];
#pragma unroll
            for (int r = 0; r < 16; ++r) { const float x = t[r >> 2][r & 3] + B.b_router[crow(r, hi)]; float h_; lo[r] = swap_lo(x, h_); hv[r] = h_; }
            int se[4]; float sv[4];
#pragma unroll
            for (int kk = 0; kk < 4; ++kk) { float best = -INFINITY; int bi = 0;
#pragma unroll
                for (int g = 0; g < 4; ++g) {
#pragma unroll
                    for (int e = 0; e < 4; ++e) { if (lo[4 * g + e] > best) { best = lo[4 * g + e]; bi = 8 * g + e; } }
#pragma unroll
                    for (int e = 0; e < 4; ++e) { if (hv[4 * g + e] > best) { best = hv[4 * g + e]; bi = 8 * g + 4 + e; } } }
                se[kk] = bi; sv[kk] = best;
#pragma unroll
                for (int r = 0; r < 16; ++r) { if (bi == crow(r, 0)) lo[r] = -INFINITY; if (bi == crow(r, 1)) hv[r] = -INFINITY; } }
            const float e1 = __expf(sv[1] - sv[0]), e2 = __expf(sv[2] - sv[0]), e3 = __expf(sv[3] - sv[0]); const float inv = 1.f / (1.f + e1 + e2 + e3);
            if (hi == 0) { const int tl = 32 * blk + r32;
                selE[tl * 4 + 0] = se[0]; selE[tl * 4 + 1] = se[1]; selE[tl * 4 + 2] = se[2]; selE[tl * 4 + 3] = se[3];
                selW[tl * 4 + 0] = inv; selW[tl * 4 + 1] = e1 * inv; selW[tl * 4 + 2] = e2 * inv; selW[tl * 4 + 3] = e3 * inv; } }
    }
#undef LN_LOAD
    LDS_WAIT(); __syncthreads();
    const int myE = selE[tid_]; const float myW = selW[tid_];
    const unsigned rk = __hip_atomic_fetch_add((LAS unsigned*)hist + myE, 1u, __ATOMIC_RELAXED, __HIP_MEMORY_SCOPE_WORKGROUP);
    LDS_WAIT(); __syncthreads();
    if (tid_ < 32) basew[tid_] = __hip_atomic_fetch_add(F.ctl + CW_CNT + 64 * tid_, hist[tid_], RLX_AGENT);
    LDS_WAIT(); __syncthreads();
    { const unsigned pos = basew[myE] + rk; const int tk = (wgrow0 + (tid_ >> 2)) * 4 + (tid_ & 3);
      FWS(int, WS_ROWTK)[(size_t)myE * CAP + pos] = tk; FWS(float, WS_ROWW)[(size_t)myE * CAP + pos] = myW; }
}

template <bool GU> struct MoeOrder {
    const char* A; const char* W; volatile LAS int* ts; volatile LAS unsigned* cntl; const LAS unsigned* tab; int c;
    __device__ bool next(int i, pg8::Unit& u) const {
        const int x = c & 7, k = c >> 3, q = 8 * i + x;
        const int rt = GU ? (4 * q + (k >> 3)) : (8 * q + (k >> 2));
        if (rt >= ts[NEXP]) return false;
        int e = 0;
        for (int j = 1; j < NEXP; ++j) e += (rt >= ts[j]) ? 1 : 0;
        u.pn = GU ? (k & 7) : (k & 3); u.e = e; u.idx = i; u.rbase = rt * 256; u.pm = (rt - ts[e]) * 256;
        const int left = (int)cntl[e] - u.pm; u.nrows = left < 256 ? left : 256; return true;
    }
    __device__ __forceinline__ const char* a_ptr(const pg8::Unit& u) const { return GU ? A : A + (size_t)u.rbase * 1024 * 2; }
    __device__ __forceinline__ const char* b_ptr(const pg8::Unit& u) const { return W + ((size_t)u.e * (GU ? 2048 : 1024) + (size_t)u.pn * 256) * 1024 * 2; }
    __device__ __forceinline__ unsigned a_off(const pg8::Unit& u, int row) const { return tab[u.idx * 256 + row]; }
    __device__ __forceinline__ void a_ready(const pg8::Unit&) const {}
    __device__ __forceinline__ void done(const pg8::Unit&) const {}
};
__device__ __forceinline__ void moe_setup(Frame& F) {
    const int tid_ = F.wave * 64 + lane_id();
    volatile LAS int* ts = (volatile LAS int*)(F.LC + 16); volatile LAS unsigned* cntl = F.LC + 64;
    if (tid_ < 32) cntl[tid_] = __hip_atomic_load(F.ctl + CW_CNT + 64 * tid_, RLX_AGENT);
    LDS_WAIT(); __syncthreads();
    if (tid_ == 0) { int acc = 0; for (int e = 0; e < NEXP; ++e) { ts[e] = acc; acc += (int)((cntl[e] + 255u) >> 8); } ts[NEXP] = acc; }
    LDS_WAIT(); __syncthreads();
}

__device__ __forceinline__ void final_phase(Frame& F) {
    const Bufs& B = F.B; const int lane = lane_id();
    const int gw = F.vcu * NWAVES + F.wave, NGW = F.G * NWAVES;
    f32x4 gv[4], bv[4];
#pragma unroll
    for (int j = 0; j < 4; ++j) { gv[j] = *(const f32x4*)(B.ln2_g + 4 * lane + 256 * j); bv[j] = *(const f32x4*)(B.ln2_b + 4 * lane + 256 * j); }
    for (int row = gw; row < NTOK; row += NGW) { float* p = B.out + (size_t)row * 1024 + 4 * lane; const bf16* orow = FWS(bf16, WS_OUTR) + (size_t)row * 4096 + 4 * lane;
        const bf16* xrow = FWS(bf16, WS_X1B) + (size_t)row * 1024 + 4 * lane;
        f32x4 v[4]; float s = 0.f;
#pragma unroll
        for (int j = 0; j < 4; ++j) { { const u32x2 xv = *(const u32x2*)(xrow + 256 * j);
                v[j] = (f32x4){__uint_as_float(xv.x << 16), __uint_as_float(xv.x & 0xffff0000u), __uint_as_float(xv.y << 16), __uint_as_float(xv.y & 0xffff0000u)} * DN_ALPHA; }
#pragma unroll
            for (int kk = 0; kk < 4; ++kk) { const u32x2 wv = *(const u32x2*)(orow + kk * 1024 + 256 * j);
                v[j][0] += __uint_as_float(wv.x << 16); v[j][1] += __uint_as_float(wv.x & 0xffff0000u); v[j][2] += __uint_as_float(wv.y << 16); v[j][3] += __uint_as_float(wv.y & 0xffff0000u); }
            s += (v[j][0] + v[j][1]) + (v[j][2] + v[j][3]); }
        const float mean = wave_sum(s) * (1.f / 1024.f); float s2 = 0.f;
#pragma unroll
        for (int j = 0; j < 4; ++j) { v[j] = v[j] - mean; s2 += (v[j][0] * v[j][0] + v[j][1] * v[j][1]) + (v[j][2] * v[j][2] + v[j][3] * v[j][3]); }
        const float rstd = rsqrtf(wave_sum(s2) * (1.f / 1024.f) + LN_EPS);
#pragma unroll
        for (int j = 0; j < 4; ++j) *(f32x4*)(p + 256 * j) = v[j] * rstd * gv[j] + bv[j]; }
}

constexpr int NPHASE = 11;
struct MArgs { Bufs B; int ph_lo, ph_hi; };
__global__ void __launch_bounds__(NWAVES * 64, 2) mega_fwd(MArgs args) {
    extern __shared__ __attribute__((aligned(16))) unsigned char lds[];
    Frame F;
    F.lds = (LAS unsigned char*)lds; F.LC = (volatile LAS unsigned*)(F.lds + LDSCTL_OFF);
    F.wave = __builtin_amdgcn_readfirstlane((int)threadIdx.x >> 6);
    F.G = gridDim.x; { const int bx = blockIdx.x; F.vcu = (F.G % 8 == 0) ? (bx % 8) * (F.G / 8) + bx / 8 : bx; }
    F.B = args.B; F.ctl = (unsigned*)(args.B.ws + WS_CTL);
    for (int u = threadIdx.x; u < 256; u += NWAVES * 64) F.LC[u] = 0u;
    __syncthreads();
    const int lo = args.ph_lo, hi = args.ph_hi;
    const bool multi = (hi - lo) > 1;
    XcdBarrier bar; bar.bar = F.ctl + CW_BAR; bar.x = 0; bar.st = nullptr;
    if (multi) bar = xcd_barrier_post(F.ctl + CW_BAR, F.LC);
#ifndef PH_COMPILE
#define PH_COMPILE 0x7FF
#endif
#define IN(k) ((((PH_COMPILE) >> (k)) & 1) && lo <= (k) && (k) < hi)
#define SEAM(k) do { if (IN(k) && IN((k) + 1)) xcd_barrier(bar); } while (0)
    LAS unsigned char* ring = F.lds + RING_OFF;
    const int c = (int)blockIdx.x;
    if (IN(0)) { p0_prologue(F); } SEAM(0);
    if (IN(1)) {
        { pg8::StaticOrder S; S.init(FDO(bf16, DO_XB), FWS(bf16, WS_WINT), NTOK, 2048, 1024, F.G, c);
          pg8::EpiQK E{FWS(bf16, WS_QSB), FWS(bf16, WS_KSB)};
          pg8::gemm_phase<pg8::EpiQK, pg8::StaticOrder, true, false>(ring, 1024, S, E, F.wave); }
        { pg8::StaticOrder S; S.init(FDO(bf16, DO_XB), FWS(bf16, WS_WINT) + (size_t)2048 * 1024, NTOK, 2048, 1024, F.G, c);
          pg8::EpiRot E{FWS(bf16, WS_QR), FWS(bf16, WS_KR), FDO(bf16, DO_KRT), FWS(bf16, WS_QRS), FWS(float, WS_COS), FWS(float, WS_SIN)};
          pg8::gemm_phase<pg8::EpiRot, pg8::StaticOrder, true, false>(ring, 1024, S, E, F.wave); }
        { pg8::StaticOrder S; S.init(FDO(bf16, DO_XB), FWS(bf16, WS_WINT) + (size_t)4096 * 1024, NTOK, 4096, 1024, F.G, c);
          pg8::EpiGate E{F.B.ws};
          pg8::gemm_phase<pg8::EpiGate, pg8::StaticOrder, true, false>(ring, 1024, S, E, F.wave); }
        { pg8::StaticOrder S; S.init(FWS(bf16, WS_WVT), FDO(bf16, DO_XB), 3072, NTOK, 1024, F.G, c);
          pg8::EpiVT E{FWS(bf16, WS_VSBT), FWS(bf16, WS_VRT)};
          pg8::gemm_phase<pg8::EpiVT, pg8::StaticOrder, true, false>(ring, 1024, S, E, F.wave); }
    } SEAM(1);
    if (IN(2)) { attn_phase(F); } SEAM(2);
    if (IN(3)) { scan_phase(F); } SEAM(3);
    if (IN(4)) { intra_phase(F); } SEAM(4);
    if (IN(5)) {
        { pg8::StaticOrder S; S.init(FWS(bf16, WS_QSB), FWS(bf16, WS_WBSBT), NTOK, 1024, 1024, F.G, c);
          pg8::EpiBranch<0> E{FWS(bf16, WS_GSB), nullptr, FWS(bf16, WS_M1)};
          pg8::gemm_phase<pg8::EpiBranch<0>, pg8::StaticOrder, true, false>(ring, 1024, S, E, F.wave); }
        { pg8::StaticOrder S; S.init(FDO(bf16, DO_R), FWS(bf16, WS_WBRETT), NTOK, 1024, 2048, F.G, c);
          pg8::EpiBranch<1> E{FWS(bf16, WS_GRET), FWS(bf16, WS_M1), FWS(bf16, WS_MG)};
          pg8::gemm_phase<pg8::EpiBranch<1>, pg8::StaticOrder, true, false>(ring, 2048, S, E, F.wave); }
    } SEAM(5);
    if (IN(6)) { pg8::StaticOrder S; S.init(FWS(bf16, WS_MG), FWS(bf16, WS_WOUTT), NTOK, 1024, 1024, F.G, c);
        pg8::EpiPre E{F.B.x, F.B.out};
        pg8::gemm_phase<pg8::EpiPre, pg8::StaticOrder, true, false>(ring, 1024, S, E, F.wave); } SEAM(6);
    if (IN(7)) { ln1_router_phase(F); } SEAM(7);
    if (IN(8)) { moe_setup(F);
        MoeOrder<true> S{(const char*)FWS(bf16, WS_X1B), (const char*)FWS(bf16, WS_WGUT), (volatile LAS int*)(F.LC + 16), F.LC + 64, (const LAS unsigned*)(F.lds + LDS_TAB_OFF), c};
        { pg8::Unit u; LAS unsigned* tab = (LAS unsigned*)(F.lds + LDS_TAB_OFF);
          const int tid_ = F.wave * 64 + lane_id();
          for (int i = 0; i < 24 && S.next(i, u); ++i) { if (tid_ < 256) { const int rr = tid_; unsigned off = 0u;
                  if (rr < u.nrows) off = (unsigned)(FWS(int, WS_ROWTK)[(size_t)u.e * CAP + u.pm + rr] >> 2) * 2048u;
                  tab[i * 256 + rr] = off; } }
          LDS_WAIT(); __syncthreads(); }
        pg8::EpiGateUp E{F.B.b_gu, FWS(bf16, WS_ACT)};
        pg8::gemm_phase<pg8::EpiGateUp, MoeOrder<true>, true, true>(ring, 1024, S, E, F.wave); } SEAM(8);
    if (IN(9)) { moe_setup(F);
        MoeOrder<false> S{(const char*)FWS(bf16, WS_ACT), (const char*)FWS(bf16, WS_WDT), (volatile LAS int*)(F.LC + 16), F.LC + 64, (const LAS unsigned*)(F.lds + LDS_TAB_OFF), c};
        pg8::EpiDown E{F.B.b_dn, FWS(int, WS_ROWTK), FWS(float, WS_ROWW), FWS(bf16, WS_OUTR)};
        pg8::gemm_phase<pg8::EpiDown, MoeOrder<false>, true, false>(ring, 1024, S, E, F.wave); } SEAM(9);
    if (IN(10)) { final_phase(F); }
#undef IN
#undef SEAM
}
#ifndef OPT_MASK
#define OPT_MASK 0x7FF
#endif
#ifndef ONE_LAUNCH
#define ONE_LAUNCH 1
#endif
template <int NB, class AF, class BF, class EF> static void launch_ngemm(hipStream_t s, int M, int N, int K, const AF& af, const BF& bf, const EF& ef) {
    GArgs<AF, BF, EF> ga; memset(&ga, 0, sizeof(ga)); ga.af = af; ga.bf = bf; ga.ef = ef; ga.M = M; ga.N = N; ga.K = K; ga.pad = 0;
    ngemm<NB, AF, BF, EF><<<dim3(N / 64, M / 64), 256, 0, s>>>(ga);
}
static void launch_tr(hipStream_t s, int grid, const float* src, int lds, int c0, int width, int K, bf16* dst, int r0) {
    TrArgs a; memset(&a, 0, sizeof(a)); a.src = src; a.dst = dst; a.lds = lds; a.c0 = c0; a.width = width; a.K = K; a.r0 = r0; a.pad = 0;
    n_tr<<<grid, 256, 0, s>>>(a);
}
static AF_rows mk_rows(const void* p, int ld) { AF_rows a; memset(&a, 0, sizeof(a)); a.A = (const bf16*)p; a.ld = ld; a.pad = 0; return a; }
static BF_wt mk_wt(const void* p, int K) { BF_wt a; memset(&a, 0, sizeof(a)); a.W = (const bf16*)p; a.K = K; a.pad = 0; return a; }
static void run_naive(const Bufs& B, hipStream_t s, int stage) {
    unsigned char* ws = B.ws;
    switch (stage) {
    case 0: {
        n_xb<<<2048, 256, 0, s>>>(B);
        bf16* wint = (bf16*)(ws + WS_WINT); bf16* wvt = (bf16*)(ws + WS_WVT);
        launch_tr(s, 1024, B.w_in, INW, 0, 2048, 1024, wint, 0);
        launch_tr(s, 1024, B.w_in, INW, 2048, 1024, 1024, wvt, 0);
        launch_tr(s, 1024, B.w_in, INW, 3072, 2048, 1024, wint, 2048);
        launch_tr(s, 1024, B.w_in, INW, 5120, 2048, 1024, wvt, 1024);
        launch_tr(s, 1024, B.w_in, INW, 7168, 4096, 1024, wint, 4096);
        launch_tr(s, 1024, B.w_bsb, 1024, 0, 1024, 1024, (bf16*)(ws + WS_WBSBT), 0);
        launch_tr(s, 1024, B.w_bret, 1024, 0, 1024, 2048, (bf16*)(ws + WS_WBRETT), 0);
        launch_tr(s, 1024, B.w_out, 1024, 0, 1024, 1024, (bf16*)(ws + WS_WOUTT), 0);
        launch_tr(s, 64, B.w_router, 32, 0, 32, 1024, (bf16*)(ws + WS_WRT), 0);
        { Tr2Args a; memset(&a, 0, sizeof(a)); a.src = B.w_gu; a.dst = (bf16*)(ws + WS_WGUT); n_tr_gu<<<4096, 256, 0, s>>>(a); }
        { Tr2Args a; memset(&a, 0, sizeof(a)); a.src = B.w_dn; a.dst = (bf16*)(ws + WS_WDT); n_tr_dn<<<4096, 256, 0, s>>>(a); }
        n_rope<<<1024, 256, 0, s>>>(B);
    } break;
    case 1: {
        BF_inproj bf; memset(&bf, 0, sizeof(bf)); bf.wint = (const bf16*)(ws + WS_WINT); bf.wvt = (const bf16*)(ws + WS_WVT); EF_inproj ef{B};
        launch_ngemm<1>(s, NTOK, INW, 1024, mk_rows((unsigned char*)B.out + DO_XB, 1024), bf, ef);
        n_rotary<<<4096, 256, 0, s>>>(B);
    } break;
    case 2: n_attn<<<BATCH * SBH * SEQ / 64, 64, 0, s>>>(B);
        if (OPT_MASK & 1) { { Tr2Args a; memset(&a, 0, sizeof(a)); a.src = B.w_gu; a.dst = (bf16*)(ws + WS_WGUT); n_tr_gu<<<4096, 256, 0, s>>>(a); }
                            { Tr2Args a; memset(&a, 0, sizeof(a)); a.src = B.w_dn; a.dst = (bf16*)(ws + WS_WDT); n_tr_dn<<<4096, 256, 0, s>>>(a); } }
        break;
    case 3: n_scan<<<BATCH * RH * RDV, 64, 0, s>>>(B); break;
    case 4: n_intra<<<BATCH * RH * NCHUNK, 256, 0, s>>>(B); break;
    case 5: {
        { EF_m1 ef{B}; launch_ngemm<1>(s, NTOK, 1024, 1024, mk_rows(ws + WS_QSB, 1024), mk_wt(ws + WS_WBSBT, 1024), ef); }
        { EF_mg ef{B}; launch_ngemm<1>(s, NTOK, 1024, 2048, mk_rows((unsigned char*)B.out + DO_R, 2048), mk_wt(ws + WS_WBRETT, 2048), ef); }
    } break;
    case 6: { EF_pre ef{B}; launch_ngemm<1>(s, NTOK, 1024, 1024, mk_rows(ws + WS_MG, 1024), mk_wt(ws + WS_WOUTT, 1024), ef); } break;
    case 7: n_ln1<<<NTOK / 4, 256, 0, s>>>(B); n_router<<<NTOK / 64, 64, 0, s>>>(B); break;
    case 8: { n_tstart<<<1, 64, 0, s>>>(B); n_rowinfo<<<544, 256, 0, s>>>(B); AF_gather af{B}; BF_gu bf{B}; EF_gu ef{B}; launch_ngemm<2>(s, MAXROWS, 1024, 1024, af, bf, ef); } break;
    case 9: { n_tstart<<<1, 64, 0, s>>>(B); n_rowinfo<<<544, 256, 0, s>>>(B); AF_act af{B}; BF_dn bf{B}; EF_dn ef{B}; launch_ngemm<1>(s, MAXROWS, 1024, 1024, af, bf, ef); } break;
    case 10: n_final<<<NTOK / 4, 256, 0, s>>>(B); break;
    }
}
static void run_mega(const Bufs& B, hipStream_t s, int lo, int hi) {
    MArgs a; memset(&a, 0, sizeof(a)); a.B = B; a.ph_lo = lo; a.ph_hi = hi;
    hipLaunchKernelGGL(mega_fwd, dim3(256), dim3(NWAVES * 64), LDS_BYTES, s, a);
}

extern "C" void kernel_launch(void* const* d_in, const int* in_sizes, int n_in, void* d_out, int out_size, void* d_ws, size_t ws_size, hipStream_t stream) {
    if (n_in != 15 || out_size != NTOK * DM || ws_size < WS_END) { fprintf(stderr, "kernel_launch: unexpected shapes (n_in %d out %d ws %zu)\n", n_in, out_size, ws_size); return; }
    static int inited = 0;
    if (!inited) { inited = 1;
        if (hipFuncSetAttribute((const void*)mega_fwd, hipFuncAttributeMaxDynamicSharedMemorySize, LDS_BYTES) != hipSuccess) fprintf(stderr, "kernel_launch: hipFuncSetAttribute failed\n");
        int dev = 0, cus = 0; (void)hipGetDevice(&dev); (void)hipDeviceGetAttribute(&cus, hipDeviceAttributeMultiprocessorCount, dev);
        if (cus != 256) fprintf(stderr, "kernel_launch: built for 256 CUs, device has %d\n", cus);
        (void)hipGetLastError(); }
    Bufs B; memset(&B, 0, sizeof(B));
    B.x = (const float*)d_in[0]; B.w_in = (const float*)d_in[1]; B.w_bsb = (const float*)d_in[2]; B.w_bret = (const float*)d_in[3]; B.w_out = (const float*)d_in[4];
    B.ln1_g = (const float*)d_in[5]; B.ln1_b = (const float*)d_in[6]; B.w_router = (const float*)d_in[7]; B.b_router = (const float*)d_in[8];
    B.w_gu = (const float*)d_in[9]; B.b_gu = (const float*)d_in[10]; B.w_dn = (const float*)d_in[11]; B.b_dn = (const float*)d_in[12]; B.ln2_g = (const float*)d_in[13]; B.ln2_b = (const float*)d_in[14];
    B.out = (float*)d_out; B.ws = (unsigned char*)d_ws;
    (void)hipMemsetAsync((char*)d_ws + WS_CTL, 0, CTL_ZERO_BYTES, stream);
    if ((OPT_MASK & 0x7FF) == 0x7FF && ONE_LAUNCH) { run_mega(B, stream, 0, NPHASE); return; }
    for (int st = 0; st < NPHASE; ++st) { if ((OPT_MASK >> st) & 1) run_mega(B, stream, st, st + 1); else run_naive(B, stream, st);
#ifdef PROBE_DUP
        if (st == PROBE_DUP) {
            if (st == 2) { run_mega(B, stream, 1, 2); run_mega(B, stream, 2, 3); }
            else if (st == 4) { run_mega(B, stream, 3, 4); run_mega(B, stream, 4, 5); }
            else if (st == 7) { (void)hipMemsetAsync((char*)d_ws + WS_CTL, 0, CTL_ZERO_BYTES, stream); run_mega(B, stream, 6, 7); run_mega(B, stream, 7, 8); }
            else if (st == 10) { (void)hipMemsetAsync((char*)d_ws + WS_CTL, 0, CTL_ZERO_BYTES, stream); run_mega(B, stream, 6, 7); run_mega(B, stream, 7, 8); run_mega(B, stream, 10, 11); }
            else run_mega(B, stream, st, st + 1);
        }
#endif
    }
}
```

```cpp
#include <hip/hip_runtime.h>
#include <cstdio>
#include <cstdint>
#include <cstring>

constexpr int BATCH = 4, SEQ = 8192, DM = 1024, NTOK = BATCH * SEQ;
constexpr int SBH = 16, SBD = 64;
constexpr int RH = 4, RDK = 256, RDV = 512, RQK = RH * RDK  , RV = RH * RDV  ;
constexpr int CHUNK = 64, NCHUNK = SEQ / CHUNK;
constexpr int INW = 11264;
constexpr int NEXP = 32, TOPK = 4, DFF = 1024;
constexpr int CAP = NTOK;
constexpr int MAXROWS = NTOK * TOPK + NEXP * 256;
constexpr float LN_EPS = 1e-5f;
constexpr float DN_ALPHA = 1.18920711500272106672f;
constexpr float LOG2E = 1.4426950408889634f;
constexpr float SB_C2 = 0.125f * LOG2E;

typedef unsigned short bf16;
typedef float f32x4 __attribute__((ext_vector_type(4)));
typedef float f32x16 __attribute__((ext_vector_type(16)));
typedef short bf16x8 __attribute__((ext_vector_type(8)));
typedef short bf16x4 __attribute__((ext_vector_type(4)));
typedef unsigned u32x4 __attribute__((ext_vector_type(4)));
typedef unsigned u32x2 __attribute__((ext_vector_type(2)));

__host__ __device__ __forceinline__ float bf2f(bf16 v) { unsigned u = (unsigned)v << 16; return __builtin_bit_cast(float, u); }
__host__ __device__ __forceinline__ bf16 f2bf(float f) { unsigned u = __builtin_bit_cast(unsigned, f); return (bf16)((u + 0x7fffu + ((u >> 16) & 1u)) >> 16); }
__device__ __forceinline__ unsigned pk2(float lo, float hi) { return (unsigned)f2bf(lo) | ((unsigned)f2bf(hi) << 16); }

constexpr size_t MiB = 1u << 20;
constexpr size_t WS_CTL = 0, CTL_ZERO_BYTES = 1 * MiB;
constexpr size_t WS_COS = 1 * MiB, WS_SIN = 5 * MiB;
constexpr size_t WS_WRT = 9 * MiB;
constexpr size_t WS_TSTART = 9 * MiB + 512 * 1024;
constexpr size_t WS_WINT = 10 * MiB;
constexpr size_t WS_WVT = 26 * MiB;
constexpr size_t WS_WBSBT = 32 * MiB, WS_WBRETT = 34 * MiB, WS_WOUTT = 38 * MiB;
constexpr size_t WS_WGUT = 40 * MiB;
constexpr size_t WS_WDT = 168 * MiB;
constexpr size_t WS_QSB = 232 * MiB;
constexpr size_t WS_KSB = 296 * MiB;
constexpr size_t WS_VSBT = 360 * MiB;
constexpr size_t WS_YINT = 296 * MiB;
constexpr size_t WS_QR = 424 * MiB, WS_KR = 488 * MiB;
constexpr size_t WS_VRT = 552 * MiB;
constexpr size_t WS_SG = 680 * MiB;
constexpr size_t WS_GSB = 808 * MiB, WS_GRET = 872 * MiB;
constexpr size_t WS_SELE = 936 * MiB, WS_SELW = 937 * MiB;
constexpr size_t WS_ROWTK = 940 * MiB, WS_ROWW = 944 * MiB;
constexpr size_t WS_RINFO = 948 * MiB;
constexpr size_t WS_M1 = 424 * MiB, WS_MG = 488 * MiB;
constexpr size_t WS_X1B = 552 * MiB;
constexpr size_t WS_ACT = 616 * MiB;
constexpr size_t WS_OUTR = 232 * MiB;
constexpr size_t WS_END = 1024 * MiB;
static_assert(WS_ACT + (size_t)MAXROWS * 1024 * 2 <= WS_SELE, "ACT fits");
static_assert(WS_OUTR + (size_t)NTOK * 4 * 1024 * 2 <= WS_MG, "OUTR fits below MG");
constexpr size_t DO_XB = 0, DO_KRT = 64 * MiB;

__host__ __device__ __forceinline__ size_t krt_idx(int bh, int t, int d) { return ((((size_t)bh * 128 + (t >> 6)) * 4 + ((t >> 4) & 3)) * 256 + d) * 16 + (t & 15); }
__host__ __device__ __forceinline__ size_t vrt_idx(int bh, int t, int v) { return ((((size_t)bh * 128 + (t >> 6)) * 4 + ((t >> 4) & 3)) * 512 + v) * 16 + (t & 15); }
__host__ __device__ __forceinline__ size_t qrs_idx(int bh, int t, int d) { return ((((size_t)bh * 128 + (t >> 6)) * 16 + (d >> 4)) * 64 + (t & 63)) * 16 + (d & 15); }
__host__ __device__ __forceinline__ size_t yt_idx(int bh, int t, int v) { return ((((size_t)bh * 128 + (t >> 6)) * 64 + (v >> 3)) * 64 + (t & 63)) * 8 + (v & 7); }
__host__ __device__ __forceinline__ size_t ksb_idx(int bh, int t, int d) { return ((((size_t)bh * 256 + (t >> 5)) * 4 + (d >> 4)) * 32 + (t & 31)) * 16 + (d & 15); }
__host__ __device__ __forceinline__ size_t vsb_idx(int bh, int t, int d) { return (((size_t)bh * 512 + (t >> 4)) * 64 + d) * 16 + (t & 15); }
constexpr size_t WS_QRS = 952 * MiB;
constexpr size_t DO_R = 0;
static_assert(WS_QRS + 64 * MiB <= WS_END, "QRS fits");

constexpr int CW_TMO = 0, CW_CODE = 1;
constexpr int CW_BAR = 4096;
constexpr int CW_CNT = 16384;

struct Bufs {
    const float *x, *w_in, *w_bsb, *w_bret, *w_out, *ln1_g, *ln1_b, *w_router, *b_router, *w_gu, *b_gu, *w_dn, *b_dn, *ln2_g, *ln2_b;
    float* out; unsigned char* ws;
};
#define WSP(T, off) ((T*)(B.ws + (off)))
#define DOP(T, off) ((T*)((unsigned char*)B.out + (off)))

__global__ void n_xb(Bufs B) {
    const size_t n = (size_t)NTOK * DM; bf16* xb = DOP(bf16, DO_XB);
    for (size_t i = (size_t)blockIdx.x * blockDim.x + threadIdx.x; i < n; i += (size_t)gridDim.x * blockDim.x) xb[i] = f2bf(B.x[i]);
}
struct TrArgs { const float* src; bf16* dst; int lds, c0, width, K, r0, pad; };
__global__ void n_tr(TrArgs a) {
    const float* src = a.src; bf16* dst = a.dst; const int lds = a.lds, c0 = a.c0, width = a.width, K = a.K, r0 = a.r0;
    const size_t n = (size_t)width * K;
    for (size_t i = (size_t)blockIdx.x * blockDim.x + threadIdx.x; i < n; i += (size_t)gridDim.x * blockDim.x) {
        const int k = (int)(i % K), c = (int)(i / K); dst[(size_t)(r0 + c) * K + k] = f2bf(src[(size_t)k * lds + c0 + c]); }
}
struct Tr2Args { const float* src; bf16* dst; };
__global__ void n_tr_gu(Tr2Args a) { const float* src = a.src; bf16* dst = a.dst;
    const size_t n = (size_t)NEXP * 2048 * 1024;
    for (size_t i = (size_t)blockIdx.x * blockDim.x + threadIdx.x; i < n; i += (size_t)gridDim.x * blockDim.x) {
        const int k = (int)(i % 1024); const int r = (int)((i / 1024) % 2048); const int e = (int)(i / (1024 * 2048));
        const int ct = r >> 8, bj = (r >> 7) & 1, ii = r & 127; const int c = bj * 1024 + 128 * ct + ii;
        dst[i] = f2bf(src[((size_t)e * 1024 + k) * 2048 + c]); }
}
__global__ void n_tr_dn(Tr2Args a) { const float* src = a.src; bf16* dst = a.dst;
    const size_t n = (size_t)NEXP * 1024 * 1024;
    for (size_t i = (size_t)blockIdx.x * blockDim.x + threadIdx.x; i < n; i += (size_t)gridDim.x * blockDim.x) {
        const int ff = (int)(i % 1024); const int d = (int)((i / 1024) % 1024); const int e = (int)(i / (1024 * 1024));
        dst[i] = f2bf(src[((size_t)e * 1024 + ff) * 1024 + d]); }
}
__device__ __forceinline__ float rope_inv_freq(int j) { return powf(10000.0f, -(float)j / 128.0f); }
__global__ void n_rope(Bufs B) {
    float* c = WSP(float, WS_COS); float* s = WSP(float, WS_SIN);
    for (int i = blockIdx.x * blockDim.x + threadIdx.x; i < SEQ * 128; i += gridDim.x * blockDim.x) {
        const int pos = i >> 7, j = i & 127; const float ang = (float)pos * rope_inv_freq(j);
        c[i] = (float)cos((double)ang); s[i] = (float)sin((double)ang); }
}

template <class AF, class BF, class EF> struct GArgs { AF af; BF bf; EF ef; int M, N, K, pad; };
template <int NB, class AF, class BF, class EF>
__global__ void __launch_bounds__(256) ngemm(GArgs<AF, BF, EF> ga) {
    const AF& af = ga.af; const BF& bf = ga.bf; const EF& ef = ga.ef; const int K = ga.K;
    __shared__ float As[16][65], Bs[NB][16][65];
    const int tx = threadIdx.x & 15, ty = threadIdx.x >> 4;
    const int m0 = blockIdx.y * 64, n0 = blockIdx.x * 64;
    if (!af.active(m0)) return;
    float acc[NB][4][4];
#pragma unroll
    for (int b = 0; b < NB; ++b)
#pragma unroll
        for (int i = 0; i < 4; ++i)
#pragma unroll
            for (int j = 0; j < 4; ++j) acc[b][i][j] = 0.f;
    for (int k0 = 0; k0 < K; k0 += 16) {
#pragma unroll
        for (int i = 0; i < 4; ++i) { const int idx = threadIdx.x + 256 * i; const int kk = idx & 15, mm = idx >> 4; As[kk][mm] = af(m0 + mm, k0 + kk); }
#pragma unroll
        for (int b = 0; b < NB; ++b)
#pragma unroll
            for (int i = 0; i < 4; ++i) { const int idx = threadIdx.x + 256 * i; const int kk = idx & 15, nn = idx >> 4; Bs[b][kk][nn] = bf(m0, k0 + kk, n0 + nn, b); }
        __syncthreads();
#pragma unroll
        for (int kk = 0; kk < 16; ++kk) {
            float a[4];
#pragma unroll
            for (int i = 0; i < 4; ++i) a[i] = As[kk][ty * 4 + i];
#pragma unroll
            for (int b = 0; b < NB; ++b) {
                float bb[4];
#pragma unroll
                for (int j = 0; j < 4; ++j) bb[j] = Bs[b][kk][tx * 4 + j];
#pragma unroll
                for (int i = 0; i < 4; ++i)
#pragma unroll
                    for (int j = 0; j < 4; ++j) acc[b][i][j] += a[i] * bb[j];
            }
        }
        __syncthreads();
    }
#pragma unroll
    for (int i = 0; i < 4; ++i)
#pragma unroll
        for (int j = 0; j < 4; ++j) {
            float v[NB];
#pragma unroll
            for (int b = 0; b < NB; ++b) v[b] = acc[b][i][j];
            ef(m0 + ty * 4 + i, n0 + tx * 4 + j, v);
        }
}

__device__ __forceinline__ float sigmoidf_(float x) { return 1.0f / (1.0f + __expf(-x)); }
__device__ __forceinline__ float ret_log2gamma(int h) { return log2f(1.0f - exp2f(-5.0f - (float)h)); }

struct AF_rows { const bf16* A; int ld, pad; __device__ bool active(int) const { return true; } __device__ float operator()(int m, int k) const { return bf2f(A[(size_t)m * ld + k]); } };
struct BF_inproj { const bf16 *wint, *wvt;
    __device__ float operator()(int, int k, int n, int) const {
        const bf16* row;
        if (n < 2048) row = wint + (size_t)n * 1024;
        else if (n < 3072) row = wvt + (size_t)(n - 2048) * 1024;
        else if (n < 5120) row = wint + (size_t)(2048 + n - 3072) * 1024;
        else if (n < 7168) row = wvt + (size_t)(1024 + n - 5120) * 1024;
        else row = wint + (size_t)(4096 + n - 7168) * 1024;
        return bf2f(row[k]); } };
struct EF_inproj { Bufs B;
    __device__ void operator()(int m, int n, const float (&v)[1]) const {
        const float a = v[0];
        if (n < 1024) WSP(bf16, WS_QSB)[(size_t)m * 1024 + n] = f2bf(a * SB_C2);
        else if (n < 2048) { const int f = n - 1024; WSP(bf16, WS_KSB)[ksb_idx((m >> 13) * 16 + (f >> 6), m & (SEQ - 1), f & 63)] = f2bf(a); }
        else if (n < 3072) { const int f = n - 2048; WSP(bf16, WS_VSBT)[vsb_idx((m >> 13) * 16 + (f >> 6), m & (SEQ - 1), f & 63)] = f2bf(a); }
        else if (n < 4096) WSP(bf16, WS_QR)[(size_t)m * 1024 + n - 3072] = f2bf(a);
        else if (n < 5120) WSP(bf16, WS_KR)[(size_t)m * 1024 + n - 4096] = f2bf(a);
        else if (n < 7168) { const int f = n - 5120, h = f >> 9; const float dec = exp2f((float)(63 - (m & 63)) * ret_log2gamma(h));
            WSP(bf16, WS_VRT)[vrt_idx((m >> 13) * 4 + h, m & (SEQ - 1), f & 511)] = f2bf(a * dec); }
        else if (n < 9216) { const int f = n - 7168; WSP(bf16, WS_SG)[yt_idx((m >> 13) * 4 + (f >> 9), m & (SEQ - 1), f & 511)] = f2bf(a * sigmoidf_(a)); }
        else if (n < 10240) WSP(bf16, WS_GSB)[(size_t)m * 1024 + n - 9216] = f2bf(sigmoidf_(a));
        else WSP(bf16, WS_GRET)[(size_t)m * 1024 + n - 10240] = f2bf(sigmoidf_(a)); } };
__global__ void n_rotary(Bufs B) {
    bf16* qr = WSP(bf16, WS_QR); bf16* kr = WSP(bf16, WS_KR); bf16* krt = DOP(bf16, DO_KRT);
    const float* ct = WSP(float, WS_COS); const float* st = WSP(float, WS_SIN);
    const size_t n = (size_t)NTOK * RH * 128;
    for (size_t i = (size_t)blockIdx.x * blockDim.x + threadIdx.x; i < n; i += (size_t)gridDim.x * blockDim.x) {
        const int j = (int)(i & 127), h = (int)((i >> 7) & 3); const int m = (int)(i >> 9); const int pos = m & (SEQ - 1);
        const float c = ct[pos * 128 + j], s = st[pos * 128 + j];
        const size_t o1 = (size_t)m * 1024 + h * 256 + j, o2 = o1 + 128;
        const int bh = (m >> 13) * 4 + h;
        { const float x1 = bf2f(qr[o1]), x2 = bf2f(qr[o2]); const bf16 r1 = f2bf((x1 * c - x2 * s) * 0.0625f), r2 = f2bf((x1 * s + x2 * c) * 0.0625f); qr[o1] = r1; qr[o2] = r2;
          WSP(bf16, WS_QRS)[qrs_idx(bh, pos, j)] = r1; WSP(bf16, WS_QRS)[qrs_idx(bh, pos, j + 128)] = r2; }
        { const float x1 = bf2f(kr[o1]), x2 = bf2f(kr[o2]); const bf16 r1 = f2bf(x1 * c - x2 * s), r2 = f2bf(x1 * s + x2 * c); kr[o1] = r1; kr[o2] = r2;
          krt[krt_idx(bh, pos, j)] = r1; krt[krt_idx(bh, pos, j + 128)] = r2; }
    }
}

__global__ void __launch_bounds__(64) n_attn(Bufs B) {
    const int gid = blockIdx.x * 64 + threadIdx.x;
    const int t = gid & (SEQ - 1), bh = gid >> 13, h = bh & 15, b = bh >> 4;
    bf16* q = WSP(bf16, WS_QSB); const bf16* k = WSP(bf16, WS_KSB); const bf16* vt = WSP(bf16, WS_VSBT);
    const size_t rb = (size_t)b * SEQ;
    float qv[64], o[64];
#pragma unroll
    for (int d = 0; d < 64; ++d) { qv[d] = bf2f(q[(rb + t) * 1024 + h * 64 + d]); o[d] = 0.f; }
    float later = 0.f;
    for (int s = t - 1; s >= 0; --s) {
        float z2 = 0.f;
#pragma unroll
        for (int d = 0; d < 64; ++d) z2 += qv[d] * bf2f(k[ksb_idx(bh, s, d)]);
        const float z = z2 * 0.6931471805599453f;
        const float sp = fmaxf(z, 0.f) + log1pf(__expf(-fabsf(z)));
        const float a = __expf((z - sp) + later);
        later -= sp;
        if (a > 0.f) {
#pragma unroll
            for (int d = 0; d < 64; ++d) o[d] += a * bf2f(vt[vsb_idx(bh, s, d)]);
        }
    }
#pragma unroll
    for (int d = 0; d < 64; ++d) q[(rb + t) * 1024 + h * 64 + d] = f2bf(o[d]);
}

__global__ void __launch_bounds__(64) n_scan(Bufs B) {
    const int gid = blockIdx.x, v = gid & 511, h = (gid >> 9) & 3, b = gid >> 11, lane = threadIdx.x;
    const bf16* qr = WSP(bf16, WS_QR); const bf16* krt = DOP(bf16, DO_KRT); const bf16* vrt = WSP(bf16, WS_VRT); bf16* yint = WSP(bf16, WS_YINT);
    const float l2g = ret_log2gamma(h), cd = exp2f(64.f * l2g);
    float st[4] = {0.f, 0.f, 0.f, 0.f};
    for (int c = 0; c < NCHUNK; ++c) {
        const size_t tok0 = (size_t)b * SEQ + c * 64;
        for (int i = 0; i < 64; ++i) {
            const bf16* qp = qr + (tok0 + i) * 1024 + h * 256 + 4 * lane;
            float p = bf2f(qp[0]) * st[0] + bf2f(qp[1]) * st[1] + bf2f(qp[2]) * st[2] + bf2f(qp[3]) * st[3];
#pragma unroll
            for (int o = 1; o < 64; o <<= 1) p += __shfl_xor(p, o);
            if (lane == 0) yint[yt_idx(b * 4 + h, c * 64 + i, v)] = f2bf(p * exp2f((float)(i + 1) * l2g));
        }
        float ns[4] = {st[0] * cd, st[1] * cd, st[2] * cd, st[3] * cd};
        for (int j = 0; j < 64; ++j) {
            const float vv = bf2f(vrt[vrt_idx(b * 4 + h, c * 64 + j, v)]);
#pragma unroll
            for (int e = 0; e < 4; ++e) ns[e] += bf2f(krt[krt_idx(b * 4 + h, c * 64 + j, 4 * lane + e)]) * vv;
        }
#pragma unroll
        for (int e = 0; e < 4; ++e) st[e] = ns[e];
    }
}

__global__ void __launch_bounds__(256) n_intra(Bufs B) {
    __shared__ float P[64][65]; __shared__ float Y[8][512]; __shared__ float stat[8][2];
    const int gid = blockIdx.x, c = gid & 127, h = (gid >> 7) & 3, b = gid >> 9, tid = threadIdx.x;
    const bf16* qr = WSP(bf16, WS_QR); const bf16* kr = WSP(bf16, WS_KR); const bf16* vrt = WSP(bf16, WS_VRT); const bf16* sg = WSP(bf16, WS_SG); const bf16* yr = WSP(bf16, WS_YINT); bf16* rout = DOP(bf16, DO_R);
    const size_t tok0 = (size_t)b * SEQ + c * 64; const float l2g = ret_log2gamma(h);
    for (int e = tid; e < 4096; e += 256) { const int i = e >> 6, j = e & 63; float s = 0.f;
        const bf16* qp = qr + (tok0 + i) * 1024 + h * 256; const bf16* kp = kr + (tok0 + j) * 1024 + h * 256;
        for (int d = 0; d < 256; ++d) s += bf2f(qp[d]) * bf2f(kp[d]);
        const int ad = i > j ? i - j : j - i; P[i][j] = s * exp2f((float)(ad - 63 + j) * l2g); }
    __syncthreads();
    for (int i0 = 0; i0 < 64; i0 += 8) {
        for (int vv = tid; vv < 512; vv += 256) {
            float acc[8] = {0.f, 0.f, 0.f, 0.f, 0.f, 0.f, 0.f, 0.f};
            for (int j = 0; j < 64; ++j) { const float x = bf2f(vrt[vrt_idx(b * 4 + h, c * 64 + j, vv)]);
#pragma unroll
                for (int r = 0; r < 8; ++r) acc[r] += P[i0 + r][j] * x; }
#pragma unroll
            for (int r = 0; r < 8; ++r) Y[r][vv] = acc[r] + bf2f(yr[yt_idx(b * 4 + h, c * 64 + i0 + r, vv)]);
        }
        __syncthreads();
        { const int w = tid >> 6, lane = tid & 63;
          for (int r = w; r < 8; r += 4) { float s = 0.f, s2 = 0.f;
              for (int vv = lane; vv < 512; vv += 64) { const float x = Y[r][vv]; s += x; }
#pragma unroll
              for (int o = 1; o < 64; o <<= 1) s += __shfl_xor(s, o);
              const float mean = s * (1.f / 512.f);
              for (int vv = lane; vv < 512; vv += 64) { const float x = Y[r][vv] - mean; s2 += x * x; }
#pragma unroll
              for (int o = 1; o < 64; o <<= 1) s2 += __shfl_xor(s2, o);
              if (lane == 0) { stat[r][0] = mean; stat[r][1] = rsqrtf(s2 * (1.f / 512.f) + LN_EPS); } } }
        __syncthreads();
        for (int e = tid; e < 8 * 512; e += 256) { const int r = e >> 9, vv = e & 511; const size_t o = (tok0 + i0 + r) * 2048 + h * 512 + vv;
            rout[o] = f2bf(bf2f(sg[yt_idx(b * 4 + h, c * 64 + i0 + r, vv)]) * (Y[r][vv] - stat[r][0]) * stat[r][1]); }
        __syncthreads();
    }
}

struct BF_wt { const bf16* W; int K, pad; __device__ float operator()(int, int k, int n, int) const { return bf2f(W[(size_t)n * K + k]); } };
struct EF_m1 { Bufs B; __device__ void operator()(int m, int n, const float (&v)[1]) const { const size_t o = (size_t)m * 1024 + n; WSP(bf16, WS_M1)[o] = f2bf(bf2f(WSP(bf16, WS_GSB)[o]) * v[0]); } };
struct EF_mg { Bufs B; __device__ void operator()(int m, int n, const float (&v)[1]) const { const size_t o = (size_t)m * 1024 + n; WSP(bf16, WS_MG)[o] = f2bf(bf2f(WSP(bf16, WS_M1)[o]) + bf2f(WSP(bf16, WS_GRET)[o]) * v[0]); } };
struct EF_pre { Bufs B; __device__ void operator()(int m, int n, const float (&v)[1]) const { const size_t o = (size_t)m * 1024 + n; B.out[o] = DN_ALPHA * B.x[o] + v[0]; } };

__device__ __forceinline__ float wave_sum(float v) {
#pragma unroll
    for (int o = 1; o < 64; o <<= 1) v += __shfl_xor(v, o);
    return v;
}
__global__ void __launch_bounds__(256) n_ln1(Bufs B) {
    const int row = blockIdx.x * 4 + (threadIdx.x >> 6), lane = threadIdx.x & 63;
    float* p = B.out + (size_t)row * 1024; bf16* xb = WSP(bf16, WS_X1B) + (size_t)row * 1024;
    float v[16]; float s = 0.f;
#pragma unroll
    for (int j = 0; j < 16; ++j) { v[j] = p[lane + 64 * j]; s += v[j]; }
    const float mean = wave_sum(s) * (1.f / 1024.f); float s2 = 0.f;
#pragma unroll
    for (int j = 0; j < 16; ++j) { v[j] -= mean; s2 += v[j] * v[j]; }
    const float rstd = rsqrtf(wave_sum(s2) * (1.f / 1024.f) + LN_EPS);
#pragma unroll
    for (int j = 0; j < 16; ++j) { const int c = lane + 64 * j; const float y = v[j] * rstd * B.ln1_g[c] + B.ln1_b[c]; p[c] = y; xb[c] = f2bf(y); }
}
__global__ void __launch_bounds__(64) n_router(Bufs B) {
    const int tok = blockIdx.x * 64 + threadIdx.x;
    const bf16* xb = WSP(bf16, WS_X1B) + (size_t)tok * 1024; const bf16* wr = WSP(bf16, WS_WRT);
    float lg[32];
#pragma unroll
    for (int e = 0; e < 32; ++e) lg[e] = 0.f;
    for (int k = 0; k < 1024; ++k) { const float xv = bf2f(xb[k]);
#pragma unroll
        for (int e = 0; e < 32; ++e) lg[e] += xv * bf2f(wr[e * 1024 + k]); }
#pragma unroll
    for (int e = 0; e < 32; ++e) lg[e] += B.b_router[e];
    int se[4]; float sv[4];
#pragma unroll
    for (int kk = 0; kk < 4; ++kk) { float best = -INFINITY; int bi = 0;
#pragma unroll
        for (int e = 0; e < 32; ++e) { if (lg[e] > best) { best = lg[e]; bi = e; } }
        se[kk] = bi; sv[kk] = best;
#pragma unroll
        for (int e = 0; e < 32; ++e) if (e == bi) lg[e] = -INFINITY; }
    const float e1 = __expf(sv[1] - sv[0]), e2 = __expf(sv[2] - sv[0]), e3 = __expf(sv[3] - sv[0]); const float inv = 1.f / (1.f + e1 + e2 + e3);
    const float w[4] = {inv, e1 * inv, e2 * inv, e3 * inv};
    unsigned* cnt = WSP(unsigned, WS_CTL) + CW_CNT;
#pragma unroll
    for (int kk = 0; kk < 4; ++kk) { WSP(int, WS_SELE)[tok * 4 + kk] = se[kk]; WSP(float, WS_SELW)[tok * 4 + kk] = w[kk];
        const unsigned pos = atomicAdd(cnt + 64 * se[kk], 1u);
        WSP(int, WS_ROWTK)[(size_t)se[kk] * CAP + pos] = tok * 4 + kk; WSP(float, WS_ROWW)[(size_t)se[kk] * CAP + pos] = w[kk]; }
}
__global__ void n_tstart(Bufs B) {
    if (threadIdx.x == 0 && blockIdx.x == 0) { int* ts = WSP(int, WS_TSTART); const unsigned* cnt = WSP(unsigned, WS_CTL) + CW_CNT; int acc = 0;
        for (int e = 0; e < NEXP; ++e) { ts[e] = acc; acc += (int)((cnt[64 * e] + 255u) >> 8); } ts[NEXP] = acc; }
}
struct MoeRow { int e, valid, tk; float w; };
__global__ void n_rowinfo(Bufs B) {
    const int* ts = WSP(int, WS_TSTART); const unsigned* cnt = WSP(unsigned, WS_CTL) + CW_CNT; MoeRow* ri = WSP(MoeRow, WS_RINFO);
    for (int m = blockIdx.x * blockDim.x + threadIdx.x; m < MAXROWS; m += gridDim.x * blockDim.x) {
        MoeRow r; const int rt = m >> 8; int e = 0;
        while (e < NEXP - 1 && rt >= ts[e + 1]) ++e;
        const int pos = m - 256 * ts[e];
        r.e = e; r.valid = (rt < ts[NEXP]) && (pos < (int)cnt[64 * e]);
        r.tk = r.valid ? WSP(int, WS_ROWTK)[(size_t)e * CAP + pos] : 0; r.w = r.valid ? WSP(float, WS_ROWW)[(size_t)e * CAP + pos] : 0.f; ri[m] = r; }
}
struct AF_gather { Bufs B; __device__ bool active(int m0) const { return (m0 >> 8) < WSP(int, WS_TSTART)[NEXP]; }
    __device__ float operator()(int m, int k) const { const int tk = WSP(MoeRow, WS_RINFO)[m].tk; return bf2f(WSP(bf16, WS_X1B)[(size_t)(tk >> 2) * 1024 + k]); } };
struct BF_gu { Bufs B; __device__ float operator()(int m0, int k, int n, int which) const { const int e = WSP(MoeRow, WS_RINFO)[m0].e;
        const int ct = n >> 7, i = n & 127; return bf2f(WSP(bf16, WS_WGUT)[((size_t)e * 2048 + 256 * ct + 128 * which + i) * 1024 + k]); } };
__device__ __forceinline__ float moe_act(float g, float u) {
    g = fminf(g, 7.0f); u = fminf(fmaxf(u, -7.0f), 7.0f); const float glu = g * (1.0f / (1.0f + __expf(-1.702f * g))); return (u + 1.0f) * glu; }
struct EF_gu { Bufs B; __device__ void operator()(int m, int n, const float (&v)[2]) const { const MoeRow r = WSP(MoeRow, WS_RINFO)[m]; if (!r.valid) return;
        const float g = v[0] + B.b_gu[r.e * 2048 + n], u = v[1] + B.b_gu[r.e * 2048 + 1024 + n]; WSP(bf16, WS_ACT)[(size_t)m * 1024 + n] = f2bf(moe_act(g, u)); } };
struct AF_act { Bufs B; __device__ bool active(int m0) const { return (m0 >> 8) < WSP(int, WS_TSTART)[NEXP]; }
    __device__ float operator()(int m, int k) const { return WSP(MoeRow, WS_RINFO)[m].valid ? bf2f(WSP(bf16, WS_ACT)[(size_t)m * 1024 + k]) : 0.f; } };
struct BF_dn { Bufs B; __device__ float operator()(int m0, int k, int n, int) const { const int e = WSP(MoeRow, WS_RINFO)[m0].e; return bf2f(WSP(bf16, WS_WDT)[((size_t)e * 1024 + n) * 1024 + k]); } };
struct EF_dn { Bufs B; __device__ void operator()(int m, int n, const float (&v)[1]) const { const MoeRow r = WSP(MoeRow, WS_RINFO)[m]; if (!r.valid) return;
        WSP(bf16, WS_OUTR)[(size_t)r.tk * 1024 + n] = f2bf((v[0] + B.b_dn[r.e * 1024 + n]) * r.w); } };
__global__ void __launch_bounds__(256) n_final(Bufs B) {
    const int row = blockIdx.x * 4 + (threadIdx.x >> 6), lane = threadIdx.x & 63;
    float* p = B.out + (size_t)row * 1024; const bf16* orow = WSP(bf16, WS_OUTR) + (size_t)row * 4 * 1024;
    float v[16]; float s = 0.f;
#pragma unroll
    for (int j = 0; j < 16; ++j) { const int c = lane + 64 * j; float a = DN_ALPHA * bf2f(WSP(bf16, WS_X1B)[(size_t)row * 1024 + c]);
#pragma unroll
        for (int kk = 0; kk < 4; ++kk) a += bf2f(orow[kk * 1024 + c]);
        v[j] = a; s += a; }
    const float mean = wave_sum(s) * (1.f / 1024.f); float s2 = 0.f;
#pragma unroll
    for (int j = 0; j < 16; ++j) { v[j] -= mean; s2 += v[j] * v[j]; }
    const float rstd = rsqrtf(wave_sum(s2) * (1.f / 1024.f) + LN_EPS);
#pragma unroll
    for (int j = 0; j < 16; ++j) { const int c = lane + 64 * j; p[c] = v[j] * rstd * B.ln2_g[c] + B.ln2_b[c]; }
}

__device__ __forceinline__ int lane_id() { int l; asm volatile("v_mbcnt_lo_u32_b32 %0, -1, 0\n\tv_mbcnt_hi_u32_b32 %0, -1, %0" : "=v"(l)); return l; }
namespace pg8 {
#define PG8_LAS __attribute__((address_space(3)))
constexpr int BM = 256, BK = 64, HALF = 128, HTB = HALF * BK * 2  , STAGE_BYTES = 8 * HTB, NXCD = 8, WGM = 8;
__host__ __device__ __forceinline__ int lds_byte(int r, int c) { const int st = (r >> 4) * 2 + (c >> 5), rr = r & 15, cc = c & 31, ob = rr * 64 + cc * 2; return st * 1024 + (ob ^ (((ob >> 9) & 1) << 5)); }
__host__ __device__ __forceinline__ void stage_rc(int b, int& R, int& C) { const int st = b / 1024, sb = b % 1024, swz = sb ^ (((sb >> 9) & 1) << 5); R = (st >> 1) * 16 + swz / 64; C = (st & 1) * 32 + (swz % 64) / 2; }
__host__ __device__ __forceinline__ int perm32(int rho) { const int n = rho >> 4, i = rho & 15; return 8 * (i >> 2) + 4 * n + (i & 3); }

struct Unit { int pm, pn, e, idx, rbase, nrows; };

struct StaticOrder {
    const char* A; const char* Bt; int nM, nN, nwg, G, c, K;
    __device__ void init(const void* A_, const void* Bt_, int M, int N, int K_, int G_, int c_) { A = (const char*)A_; Bt = (const char*)Bt_; nM = M / BM; nN = N / BM; nwg = nM * nN; G = G_; c = c_; K = K_; }
    __device__ bool next(int i, Unit& u) const {
        const long L = (long)i * G + c; if (L >= nwg) return false;
        int wgid = (int)L; { const int q = nwg / NXCD, r = nwg % NXCD, xcd = wgid % NXCD, off = wgid / NXCD; wgid = (xcd < r ? xcd * (q + 1) : r * (q + 1) + (xcd - r) * q) + off; }
        const int nig = WGM * nN, gid = wgid / nig, fm = gid * WGM, gsz = (nM - fm) < WGM ? (nM - fm) : WGM;
        u.pm = fm + ((wgid % nig) % gsz); u.pn = (wgid % nig) / gsz; u.e = 0; u.idx = i; u.rbase = u.pm * BM; u.nrows = BM; return true;
    }
    __device__ __forceinline__ const char* a_ptr(const Unit& u) const { return A + (size_t)u.pm * BM * K * 2; }
    __device__ __forceinline__ const char* b_ptr(const Unit& u) const { return Bt + (size_t)u.pn * BM * K * 2; }
    __device__ __forceinline__ unsigned a_off(const Unit&, int) const { return 0u; }
    __device__ __forceinline__ void a_ready(const Unit&) const {}
    __device__ __forceinline__ void done(const Unit&) const {}
};

__device__ __forceinline__ unsigned cvt_pk_bf16(float lo, float hi) { unsigned r; asm volatile("v_cvt_pk_bf16_f32 %0, %1, %2" : "=v"(r) : "v"(lo), "v"(hi)); return r; }

template <class Epi, class Sched, bool ALIGN_EPI, bool GATHER>
__device__ __forceinline__ void gemm_phase(PG8_LAS unsigned char* lds, const int K, const Sched& S, const Epi& E, const int wid) {
    int lane_ = lane_id(); asm volatile("" : "+v"(lane_));
    const int lane = lane_, tid = wid * 64 + lane, wr = wid >> 2, wc = wid & 3, fr = lane & 15, fq = lane >> 4;
    const int nt = K / BK;
    unsigned voffB[2]; int RA[2], CA[2];
#pragma unroll
    for (int i = 0; i < 2; ++i) { int R, C; stage_rc(tid * 16 + i * 8192, R, C); const int Rb = Epi::PERM ? ((R & ~31) + perm32(R & 31)) : R;
        RA[i] = R; CA[i] = C; voffB[i] = (unsigned)(Rb * K + C) * 2u; }
    const size_t kstep = (size_t)(BK * 2);
    const size_t hstep = (size_t)HALF * K * 2;
    const unsigned ldsw = (unsigned)wid * 1024u;
    const int aoff = lds_byte(wr * 64 + fr, fq * 8), boff = lds_byte(wc * 32 + fr, fq * 8);
#define PG8_SA(b, h) (((b) * 2 + (h)) * HTB)
#define PG8_SB(b, h) ((4 + (b) * 2 + (h)) * HTB)
#define PG8_STAGE(bufoff, gbase, voff) do { _Pragma("unroll") for (int _i = 0; _i < 2; ++_i) \
        __builtin_amdgcn_global_load_lds((const unsigned*)((const char*)(gbase) + (voff)[_i]), (PG8_LAS unsigned*)(lds + (bufoff) + ldsw + _i * 8192), 16, 0, 0); } while (0)
#define PG8_LDA(dst, b, h) do { _Pragma("unroll") for (int m = 0; m < 4; ++m) _Pragma("unroll") for (int k = 0; k < 2; ++k) dst[m][k] = *(const PG8_LAS bf16x8*)(lds + PG8_SA(b, h) + aoff + m * 2048 + k * 1024); } while (0)
#define PG8_LDB(dst, b, h) do { _Pragma("unroll") for (int n = 0; n < 2; ++n) _Pragma("unroll") for (int k = 0; k < 2; ++k) dst[n][k] = *(const PG8_LAS bf16x8*)(lds + PG8_SB(b, h) + boff + n * 2048 + k * 1024); } while (0)
#define PG8_MMA(ai, bj, At, Bt) do { __builtin_amdgcn_s_setprio(1); _Pragma("unroll") for (int m = 0; m < 4; ++m) _Pragma("unroll") for (int n = 0; n < 2; ++n) _Pragma("unroll") for (int k = 0; k < 2; ++k) \
        acc[ai][bj][m][n] = __builtin_amdgcn_mfma_f32_16x16x32_bf16(Bt[n][k], At[m][k], acc[ai][bj][m][n], 0, 0, 0); __builtin_amdgcn_s_setprio(0); } while (0)
#define PG8_WAIT_V(n) asm volatile("s_waitcnt vmcnt(" #n ")" ::: "memory")
#define PG8_WAIT_L(n) asm volatile("s_waitcnt lgkmcnt(" #n ")" ::: "memory")
#define PG8_BAR __builtin_amdgcn_s_barrier()
#define PG8_SCHED __builtin_amdgcn_sched_barrier(0)
#define PG8_OFFS(dst, u) do { _Pragma("unroll") for (int _h = 0; _h < 2; ++_h) _Pragma("unroll") for (int _i = 0; _i < 2; ++_i) \
        dst[_h][_i] = GATHER ? (S.a_off(u, _h * HALF + RA[_i]) + (unsigned)CA[_i] * 2u) : (unsigned)(((_h * HALF + RA[_i]) * K + CA[_i]) * 2); } while (0)
    Unit cur, nxt; int ui = 0;
    if (!S.next(0, cur)) return;
    f32x4 acc[2][2][4][2];
#pragma unroll
    for (int a = 0; a < 2; ++a)
#pragma unroll
        for (int b = 0; b < 2; ++b)
#pragma unroll
            for (int m = 0; m < 4; ++m)
#pragma unroll
                for (int n = 0; n < 2; ++n) acc[a][b][m][n] = (f32x4){0.f, 0.f, 0.f, 0.f};
    bf16x8 At[4][2], B0[2][2], B1[2][2];
    unsigned offA[2][2], offAn[2][2];
    PG8_OFFS(offA, cur);
    const char* cA = S.a_ptr(cur); const char* cB = S.b_ptr(cur);
    S.a_ready(cur);
    PG8_STAGE(PG8_SB(0, 0), cB, voffB); PG8_STAGE(PG8_SB(0, 1), cB + hstep, voffB); PG8_STAGE(PG8_SA(0, 0), cA, offA[0]); PG8_STAGE(PG8_SA(0, 1), cA, offA[1]);
    if (wr == 1) PG8_BAR;
    PG8_WAIT_V(2); PG8_BAR;
    PG8_STAGE(PG8_SB(1, 0), cB + kstep, voffB); PG8_STAGE(PG8_SA(1, 0), cA + kstep, offA[0]); PG8_STAGE(PG8_SB(1, 1), cB + hstep + kstep, voffB);
    PG8_WAIT_V(6); PG8_BAR;
    for (;;) {
        const bool has_next = S.next(ui + 1, nxt);
        const char* nA = has_next ? S.a_ptr(nxt) : cA; const char* nB = has_next ? S.b_ptr(nxt) : cB;
        if (GATHER && has_next) { PG8_OFFS(offAn, nxt); }
        else {
#pragma unroll
            for (int h = 0; h < 2; ++h)
#pragma unroll
                for (int i = 0; i < 2; ++i) offAn[h][i] = offA[h][i]; }
        for (int t = 0; t < nt; t += 2) {
            const bool last = (t == nt - 2);
            const char* a1 = cA + (size_t)(t + 1) * kstep;
            const char* a2 = last ? nA : cA + (size_t)(t + 2) * kstep; const char* b2 = last ? nB : cB + (size_t)(t + 2) * kstep;
            const char* a3 = a2 + kstep; const char* b3 = b2 + kstep;
            unsigned o2[2][2];
#pragma unroll
            for (int h = 0; h < 2; ++h)
#pragma unroll
                for (int i = 0; i < 2; ++i) o2[h][i] = (GATHER && last) ? offAn[h][i] : offA[h][i];
            if (last && has_next) S.a_ready(nxt);
            PG8_LDB(B0, 0, 0); PG8_LDB(B1, 0, 1); PG8_SCHED; PG8_LDA(At, 0, 0); PG8_STAGE(PG8_SA(1, 1), a1, offA[1]);
            PG8_WAIT_V(8); PG8_WAIT_L(0); PG8_BAR; PG8_MMA(0, 0, At, B0); PG8_MMA(0, 1, At, B1); PG8_BAR; PG8_SCHED;
            PG8_LDA(At, 0, 1); PG8_STAGE(PG8_SB(0, 0), b2, voffB); PG8_STAGE(PG8_SB(0, 1), b2 + hstep, voffB); PG8_STAGE(PG8_SA(0, 0), a2, o2[0]);
            PG8_WAIT_V(8); PG8_WAIT_L(0); PG8_BAR; PG8_MMA(1, 0, At, B0); PG8_MMA(1, 1, At, B1); PG8_BAR; PG8_SCHED;
            PG8_LDB(B0, 1, 0); PG8_LDB(B1, 1, 1); PG8_SCHED; PG8_LDA(At, 1, 0); PG8_STAGE(PG8_SA(0, 1), a2, o2[1]);
            PG8_WAIT_V(8); PG8_WAIT_L(0); PG8_BAR; PG8_MMA(0, 0, At, B0); PG8_MMA(0, 1, At, B1); PG8_BAR; PG8_SCHED;
            PG8_LDA(At, 1, 1); PG8_STAGE(PG8_SB(1, 0), b3, voffB); PG8_STAGE(PG8_SB(1, 1), b3 + hstep, voffB); PG8_STAGE(PG8_SA(1, 0), a3, o2[0]);
            PG8_WAIT_V(8); PG8_WAIT_L(0); PG8_BAR; PG8_MMA(1, 0, At, B0); PG8_MMA(1, 1, At, B1); PG8_BAR; PG8_SCHED;
        }
        if constexpr (ALIGN_EPI) { if (wr == 0) PG8_BAR; }
        { const int l2 = lane_id();
          E(acc, cur, wr, wc, l2 & 15, l2 >> 4); } S.done(cur);
        if (!has_next) break;
#pragma unroll
        for (int a = 0; a < 2; ++a)
#pragma unroll
            for (int b = 0; b < 2; ++b)
#pragma unroll
                for (int m = 0; m < 4; ++m)
#pragma unroll
                    for (int n = 0; n < 2; ++n) acc[a][b][m][n] = (f32x4){0.f, 0.f, 0.f, 0.f};
        cur = nxt; cA = nA; cB = nB; ++ui;
#pragma unroll
        for (int h = 0; h < 2; ++h)
#pragma unroll
            for (int i = 0; i < 2; ++i) offA[h][i] = offAn[h][i];
        if constexpr (ALIGN_EPI) { if (wr == 1) PG8_BAR; }
    }
    PG8_WAIT_V(0);
    if constexpr (!ALIGN_EPI) { if (wr == 0) PG8_BAR; }
    PG8_BAR;
#undef PG8_SA
#undef PG8_SB
#undef PG8_STAGE
#undef PG8_LDA
#undef PG8_LDB
#undef PG8_MMA
#undef PG8_WAIT_V
#undef PG8_WAIT_L
#undef PG8_BAR
#undef PG8_SCHED
#undef PG8_OFFS
}
}
namespace pg8 {
__device__ __forceinline__ float fsigmoid(float x) { return __builtin_amdgcn_rcpf(1.0f + __builtin_amdgcn_exp2f(-LOG2E * x)); }
__device__ __forceinline__ u32x4 pack8(const f32x4 a, const f32x4 b) { u32x4 w; w.x = cvt_pk_bf16(a[0], a[1]); w.y = cvt_pk_bf16(a[2], a[3]); w.z = cvt_pk_bf16(b[0], b[1]); w.w = cvt_pk_bf16(b[2], b[3]); return w; }
__device__ __forceinline__ void unpack8(const u32x4 w, f32x4& a, f32x4& b) {
    a[0] = __uint_as_float(w.x << 16); a[1] = __uint_as_float(w.x & 0xffff0000u); a[2] = __uint_as_float(w.y << 16); a[3] = __uint_as_float(w.y & 0xffff0000u);
    b[0] = __uint_as_float(w.z << 16); b[1] = __uint_as_float(w.z & 0xffff0000u); b[2] = __uint_as_float(w.w << 16); b[3] = __uint_as_float(w.w & 0xffff0000u); }

struct EpiQK {
    static constexpr bool PERM = true;
    bf16 *qsb, *ksb;
    __device__ __forceinline__ void operator()(const f32x4 (&acc)[2][2][4][2], const Unit& u, int wr, int wc, int fr, int fq) const {
        const int pn = u.pn;
        if (pn < 4) {
            const bf16* ub = qsb + ((size_t)(u.pm * BM + wr * 64)) * 1024 + pn * 256 + wc * 32; const int lo = fr * 1024 + 8 * fq;
#pragma unroll
            for (int ai = 0; ai < 2; ++ai)
#pragma unroll
                for (int m = 0; m < 4; ++m)
#pragma unroll
                    for (int bj = 0; bj < 2; ++bj) *(u32x4*)(ub + (ai * HALF + m * 16) * 1024 + bj * HALF + lo) = pack8(acc[ai][bj][m][0] * SB_C2, acc[ai][bj][m][1] * SB_C2);
        } else {
            const int t0 = (u.pm * BM) & (SEQ - 1), b = (u.pm * BM) >> 13;
            const bf16* ub = ksb + ((((size_t)(b * 16 + 4 * (pn & 3) + (wc >> 1)) * 256 + (t0 >> 5) + 2 * wr) * 4 + 2 * (wc & 1)) * 512);
            const int lo = (fq >> 1) * 512 + fr * 16 + 8 * (fq & 1);
#pragma unroll
            for (int ai = 0; ai < 2; ++ai)
#pragma unroll
                for (int m = 0; m < 4; ++m)
#pragma unroll
                    for (int bj = 0; bj < 2; ++bj) *(u32x4*)(ub + (size_t)(2 * bj) * 256 * 2048 + (4 * ai + (m >> 1)) * 2048 + (m & 1) * 256 + lo) = pack8(acc[ai][bj][m][0], acc[ai][bj][m][1]);
        }
    }
};
struct EpiRot {
    static constexpr bool PERM = true;
    bf16 *qr, *kr, *krt, *qrs; const float *cosT, *sinT;
    __device__ __forceinline__ void operator()(const f32x4 (&acc)[2][2][4][2], const Unit& u, int wr, int wc, int fr, int fq) const {
        const int pn = u.pn; const bool isK = pn >= 4; const int head = pn & 3; const float sc = isK ? 1.0f : 0.0625f;
        const int R0 = u.pm * BM, P0 = R0 & (SEQ - 1), bh = (R0 >> 13) * 4 + head;
        f32x4 c[2], sn[2], dc[2], ds[2], ec[2], es[2];
        { const int tlo = fr * 128 + 8 * fq; const float* cb = cosT + (size_t)(P0 + 64 * wr) * 128 + 32 * wc; const float* sb = sinT + (size_t)(P0 + 64 * wr) * 128 + 32 * wc;
          const float* c16 = cosT + 16 * 128 + 32 * wc; const float* s16 = sinT + 16 * 128 + 32 * wc; const float* c80 = cosT + 80 * 128 + 32 * wc; const float* s80 = sinT + 80 * 128 + 32 * wc;
#pragma unroll
          for (int n = 0; n < 2; ++n) { c[n] = *(const f32x4*)(cb + tlo + 4 * n); sn[n] = *(const f32x4*)(sb + tlo + 4 * n);
              dc[n] = *(const f32x4*)(c16 + 8 * fq + 4 * n); ds[n] = *(const f32x4*)(s16 + 8 * fq + 4 * n); ec[n] = *(const f32x4*)(c80 + 8 * fq + 4 * n); es[n] = *(const f32x4*)(s80 + 8 * fq + 4 * n); } }
        bf16* on = (isK ? kr : qr) + (size_t)(R0 + 64 * wr) * 1024 + head * 256 + 32 * wc; const int lo_n = fr * 1024 + 8 * fq;
        bf16* oq = qrs + (((size_t)bh * 128 + (P0 >> 6) + wr) * 16 + 2 * wc) * 1024; const int lo_q = (fq >> 1) * 1024 + fr * 16 + 8 * (fq & 1);
        bf16* ok = krt + (((size_t)bh * 128 + (P0 >> 6) + wr) * 4) * 4096 + 32 * wc * 16; const int lo_k = 8 * fq * 16 + fr;
#pragma unroll
        for (int ai = 0; ai < 2; ++ai)
#pragma unroll
            for (int m = 0; m < 4; ++m) {
                f32x4 o1[2], o2[2];
#pragma unroll
                for (int n = 0; n < 2; ++n) { const f32x4 x1 = acc[ai][0][m][n], x2 = acc[ai][1][m][n]; o1[n] = (x1 * c[n] - x2 * sn[n]) * sc; o2[n] = (x1 * sn[n] + x2 * c[n]) * sc; }
                if (m < 3) {
#pragma unroll
                    for (int n = 0; n < 2; ++n) { const f32x4 cc = c[n] * dc[n] - sn[n] * ds[n]; sn[n] = sn[n] * dc[n] + c[n] * ds[n]; c[n] = cc; } }
                else if (ai == 0) {
#pragma unroll
                    for (int n = 0; n < 2; ++n) { const f32x4 cc = c[n] * ec[n] - sn[n] * es[n]; sn[n] = sn[n] * ec[n] + c[n] * es[n]; c[n] = cc; } }
                const u32x4 w1 = pack8(o1[0], o1[1]), w2 = pack8(o2[0], o2[1]);
                *(u32x4*)(on + (ai * HALF + m * 16) * 1024 + lo_n) = w1; *(u32x4*)(on + (ai * HALF + m * 16) * 1024 + HALF + lo_n) = w2;
                if (isK) {
                    bf16* tp = ok + (2 * ai * 4 + m) * 4096 + lo_k;
#pragma unroll
                    for (int q = 0; q < 4; ++q) { tp[(2 * q) * 16] = (bf16)(w1[q] & 0xffffu); tp[(2 * q + 1) * 16] = (bf16)(w1[q] >> 16);
                        tp[(HALF + 2 * q) * 16] = (bf16)(w2[q] & 0xffffu); tp[(HALF + 2 * q + 1) * 16] = (bf16)(w2[q] >> 16); }
                } else {
                    *(u32x4*)(oq + (2 * ai * 16) * 1024 + m * 256 + lo_q) = w1; *(u32x4*)(oq + (2 * ai * 16 + 8) * 1024 + m * 256 + lo_q) = w2; }
                asm volatile("" ::: "memory"); }
    }
};
struct EpiGate {
    static constexpr bool PERM = true;
    unsigned char* ws;
    __device__ __forceinline__ void operator()(const f32x4 (&acc)[2][2][4][2], const Unit& u, int wr, int wc, int fr, int fq) const {
        const int pn = u.pn; const int R0 = u.pm * BM, P0 = R0 & (SEQ - 1); const bool silu = pn < 8;
        const size_t ub_s = WS_SG + 2 * ((((size_t)((R0 >> 13) * 4 + (pn >> 1)) * 128 + (P0 >> 6) + wr) * 64 + 32 * (pn & 1) + 4 * wc) * 512);
        const size_t ub_g = WS_GSB + (size_t)(pn >= 12 ? 1 : 0) * (WS_GRET - WS_GSB) + 2 * ((size_t)(R0 + 64 * wr) * 1024 + (pn & 3) * 256 + 32 * wc);
        bf16* ub = (bf16*)(ws + (silu ? ub_s : ub_g));
        const int lo = silu ? fq * 512 + fr * 8 : fr * 1024 + 8 * fq;
        const int SA = silu ? 128 * 512 : HALF * 1024, SM = silu ? 128 : 16 * 1024, SB = silu ? 16 * 512 : HALF;
#pragma unroll
        for (int ai = 0; ai < 2; ++ai)
#pragma unroll
            for (int m = 0; m < 4; ++m) {
#pragma unroll
                for (int bj = 0; bj < 2; ++bj) { f32x4 a = acc[ai][bj][m][0], b = acc[ai][bj][m][1];
#pragma unroll
                    for (int e = 0; e < 4; ++e) { const float sa = fsigmoid(a[e]), sb = fsigmoid(b[e]); a[e] = silu ? a[e] * sa : sa; b[e] = silu ? b[e] * sb : sb; }
                    *(u32x4*)(ub + ai * SA + m * SM + bj * SB + lo) = pack8(a, b);
                    asm volatile("" ::: "memory"); } }
    }
};
struct EpiVT {
    static constexpr bool PERM = true;
    bf16 *vsbt, *vrt;
    __device__ __forceinline__ void operator()(const f32x4 (&acc)[2][2][4][2], const Unit& u, int wr, int wc, int fr, int fq) const {
        const int pm = u.pm; const int C0 = u.pn * BM, T0 = C0 & (SEQ - 1), b = C0 >> 13;
        if (pm < 4) {
            bf16* ub = vsbt + ((((size_t)(b * 16 + 4 * pm + wr) * 512 + (T0 >> 4) + 2 * wc) * 64) * 16); const int lo = ((fq >> 1) * 64 + fr) * 16 + 8 * (fq & 1);
#pragma unroll
            for (int ai = 0; ai < 2; ++ai)
#pragma unroll
                for (int m = 0; m < 4; ++m)
#pragma unroll
                    for (int bj = 0; bj < 2; ++bj) *(u32x4*)(ub + ((size_t)(2 * ai) * 512 * 64 + 8 * bj * 64 + 16 * m) * 16 + lo) = pack8(acc[ai][bj][m][0], acc[ai][bj][m][1]);
        } else {
            const int h = (pm - 4) >> 1; const float l2g = __builtin_amdgcn_logf(1.0f - __builtin_amdgcn_exp2f(-5.0f - (float)h));
            float dec[8];
#pragma unroll
            for (int q = 0; q < 8; ++q) dec[q] = __builtin_amdgcn_exp2f((float)(63 - (((wc & 1) * 32 + 8 * fq + q) & 63)) * l2g);
            bf16* ub = vrt + (((((size_t)(b * 4 + h) * 128 + (T0 >> 6) + (wc >> 1)) * 4 + 2 * (wc & 1)) * 512 + 256 * ((pm - 4) & 1) + 64 * wr) * 16); const int lo = ((fq >> 1) * 512 + fr) * 16 + 8 * (fq & 1);
#pragma unroll
            for (int ai = 0; ai < 2; ++ai)
#pragma unroll
                for (int m = 0; m < 4; ++m)
#pragma unroll
                    for (int bj = 0; bj < 2; ++bj) { f32x4 a = acc[ai][bj][m][0], bb = acc[ai][bj][m][1];
#pragma unroll
                        for (int e = 0; e < 4; ++e) { a[e] *= dec[e]; bb[e] *= dec[4 + e]; }
                        *(u32x4*)(ub + ((size_t)(2 * bj) * 4 * 512 + 128 * ai + 16 * m) * 16 + lo) = pack8(a, bb); }
        }
    }
};
template <int MODE> struct EpiBranch {
    static constexpr bool PERM = true;
    const bf16* gate; const bf16* m1in; bf16* out;
    __device__ __forceinline__ void operator()(const f32x4 (&acc)[2][2][4][2], const Unit& u, int wr, int wc, int fr, int fq) const {
        const size_t uo = (size_t)(u.pm * BM + 64 * wr) * 1024 + u.pn * BM + 32 * wc; const int lo = fr * 1024 + 8 * fq;
        const bf16* gp = gate + uo; const bf16* mp = m1in + uo; bf16* op = out + uo;
#pragma unroll
        for (int ai = 0; ai < 2; ++ai)
#pragma unroll
            for (int m = 0; m < 4; ++m) {
#pragma unroll
                for (int bj = 0; bj < 2; ++bj) { const int co = (ai * HALF + m * 16) * 1024 + bj * HALF + lo; f32x4 ga, gb; unpack8(*(const u32x4*)(gp + co), ga, gb);
                    f32x4 a = acc[ai][bj][m][0] * ga, b = acc[ai][bj][m][1] * gb;
                    if (MODE == 1) { f32x4 pa, pb; unpack8(*(const u32x4*)(mp + co), pa, pb); a += pa; b += pb; }
                    *(u32x4*)(op + co) = pack8(a, b); }
                asm volatile("" ::: "memory"); }
    }
};
struct EpiPre {
    static constexpr bool PERM = false;
    const float* x; float* pre;
    __device__ __forceinline__ void operator()(const f32x4 (&acc)[2][2][4][2], const Unit& u, int wr, int wc, int fr, int fq) const {
        const size_t uo = (size_t)(u.pm * BM + 64 * wr) * 1024 + u.pn * BM + 32 * wc; const int lo = fr * 1024 + 4 * fq;
        const float* xp = x + uo; float* pp = pre + uo;
#pragma unroll
        for (int ai = 0; ai < 2; ++ai)
#pragma unroll
            for (int m = 0; m < 4; ++m) {
#pragma unroll
                for (int bj = 0; bj < 2; ++bj)
#pragma unroll
                    for (int n = 0; n < 2; ++n) { const int co = (ai * HALF + m * 16) * 1024 + bj * HALF + n * 16 + lo; *(f32x4*)(pp + co) = *(const f32x4*)(xp + co) * DN_ALPHA + acc[ai][bj][m][n]; }
                asm volatile("" ::: "memory"); }
    }
};
struct EpiGateUp {
    static constexpr bool PERM = true;
    const float* bgu; bf16* act;
    __device__ __forceinline__ void operator()(const f32x4 (&acc)[2][2][4][2], const Unit& u, int wr, int wc, int fr, int fq) const {
        const float* bp = bgu + (size_t)u.e * 2048 + u.pn * 128 + wc * 32 + 8 * fq;
        bf16* ub = act + (size_t)(u.rbase + 64 * wr) * 1024 + u.pn * 128 + wc * 32; const int lo = fr * 1024 + 8 * fq;
#pragma unroll
        for (int ai = 0; ai < 2; ++ai)
#pragma unroll
            for (int m = 0; m < 4; ++m) { const int rr = ai * HALF + wr * 64 + m * 16 + fr;
                f32x4 bg[2], bu[2];
#pragma unroll
                for (int n = 0; n < 2; ++n) { bg[n] = *(const f32x4*)(bp + 4 * n); bu[n] = *(const f32x4*)(bp + 1024 + 4 * n); }
                f32x4 o[2];
#pragma unroll
                for (int n = 0; n < 2; ++n) { const f32x4 g = acc[ai][0][m][n] + bg[n], up = acc[ai][1][m][n] + bu[n];
#pragma unroll
                    for (int e = 0; e < 4; ++e) { const float gg = fminf(g[e], 7.0f), uu = fminf(fmaxf(up[e], -7.0f), 7.0f); o[n][e] = (uu + 1.0f) * gg * fsigmoid(1.702f * gg); } }
                if (rr < u.nrows) *(u32x4*)(ub + (ai * HALF + m * 16) * 1024 + lo) = pack8(o[0], o[1]);
                asm volatile("" ::: "memory"); }
    }
};
struct EpiDown {
    static constexpr bool PERM = true;
    const float* bdn; const int* rowtk; const float* roww; bf16* outr;
    __device__ __forceinline__ void operator()(const f32x4 (&acc)[2][2][4][2], const Unit& u, int wr, int wc, int fr, int fq) const {
        const int col0 = u.pn * BM + wc * 32 + 8 * fq; const float* bp = bdn + (size_t)u.e * 1024 + col0;
        const size_t lbase = (size_t)u.e * CAP + u.pm;
#pragma unroll
        for (int ai = 0; ai < 2; ++ai)
#pragma unroll
            for (int m = 0; m < 4; ++m) { const int rr = ai * HALF + wr * 64 + m * 16 + fr;
                if (rr < u.nrows) { const int tk = rowtk[lbase + rr]; const float w = roww[lbase + rr]; bf16* rowp = outr + (size_t)tk * 1024 + col0;
#pragma unroll
                    for (int bj = 0; bj < 2; ++bj) { const f32x4 b0 = *(const f32x4*)(bp + bj * HALF), b1 = *(const f32x4*)(bp + bj * HALF + 4);
                        *(u32x4*)(rowp + bj * HALF) = pack8((acc[ai][bj][m][0] + b0) * w, (acc[ai][bj][m][1] + b1) * w); } }
                asm volatile("" ::: "memory"); }
    }
};
}
#define GAS __attribute__((address_space(1)))
#define LAS __attribute__((address_space(3)))
typedef GAS unsigned gu32;
#define RLX_AGENT __ATOMIC_RELAXED, __HIP_MEMORY_SCOPE_AGENT
constexpr int NWAVES = 8;
constexpr int RING_OFF = 0, RING_BYTES = 131072;
constexpr int LDSCTL_OFF = RING_BYTES;
constexpr int LDS_TAB_OFF = RING_BYTES + 1024;
constexpr int LDS_BYTES = LDS_TAB_OFF + 24 * 256 * 4;
static_assert(LDS_BYTES <= 163840, "LDS");

#define XB_TMO      128
#define XB_XCNT(j)  (256  + 64 * (j))
#define XB_XSUB(j)  (1280 + 64 * (j))
#define XB_XGEN(j)  (2304 + 64 * (j))
#define XB_TOP      3328
#define XB_TOPGEN   3392
#define XCD_BAR_WORDS 3456
#define XB_SPIN_CAP (1u << 18)
__device__ __forceinline__ unsigned xb_ld(unsigned* p)              { return __hip_atomic_load(p, __ATOMIC_RELAXED, __HIP_MEMORY_SCOPE_AGENT); }
__device__ __forceinline__ unsigned xb_add(unsigned* p, unsigned v) { return __hip_atomic_fetch_add(p, v, __ATOMIC_RELAXED, __HIP_MEMORY_SCOPE_AGENT); }
__device__ __forceinline__ unsigned xb_xcc_id() { return (unsigned)__builtin_amdgcn_s_getreg((3 << 11) | 20) & 0xFu; }
#define XB_SPIN(cond, bar) do { unsigned _sp = 0; while (cond) { __builtin_amdgcn_s_sleep(1); \
    if ((++_sp & 255u) == 0u) { if (xb_ld(&(bar)[XB_TMO])) break; if (_sp > XB_SPIN_CAP) { atomicAdd(&(bar)[XB_TMO], 1u); break; } } } } while (0)
struct XcdBarrier { unsigned* bar; unsigned x; volatile LAS unsigned* st; };
__device__ __forceinline__ XcdBarrier xcd_barrier_post(unsigned* bar, volatile LAS unsigned* st) {
    XcdBarrier b; b.bar = bar; b.x = xb_xcc_id(); b.st = st;
    if (threadIdx.x == 0) (void)xb_add(&bar[XB_XCNT(b.x)], 1u);
    return b;
}
__device__ __forceinline__ void xcd_barrier_complete(unsigned* bar, unsigned x, unsigned& nloc, unsigned& nx) {
    const unsigned G = gridDim.x * gridDim.y * gridDim.z;
    unsigned sum, cnt, mine, sp = 0u;
    for (;;) {
        sum = 0u; cnt = 0u; mine = 0u;
#pragma unroll
        for (unsigned j = 0; j < 16; ++j) { const unsigned c = xb_ld(&bar[XB_XCNT(j)]); sum += c; cnt += (c > 0u) ? 1u : 0u; mine = (j == x) ? c : mine; }
        if (sum == G) break;
        __builtin_amdgcn_s_sleep(1);
        if ((++sp & 255u) == 0u) { if (xb_ld(&bar[XB_TMO])) break; if (sp > XB_SPIN_CAP) { atomicAdd(&bar[XB_TMO], 1u); break; } }
    }
    nloc = mine > 0u ? mine : 1u; nx = cnt > 0u ? cnt : 1u;
}
__device__ __forceinline__ void xcd_barrier(const XcdBarrier& b) {
    asm volatile("s_waitcnt vmcnt(0)" ::: "memory");
    __syncthreads();
    if (threadIdx.x == 0) {
        unsigned* bar = b.bar;
        __builtin_amdgcn_s_waitcnt(0);
        unsigned nloc = b.st[0], nx = b.st[1];
        if (nloc == 0u) { xcd_barrier_complete(bar, b.x, nloc, nx); b.st[0] = nloc; b.st[1] = nx; }
        const unsigned old = xb_add(&bar[XB_XSUB(b.x)], 1u);
        const unsigned gen = old / nloc;
        if (old + 1u == (gen + 1u) * nloc) {
            __builtin_amdgcn_fence(__ATOMIC_RELEASE, "agent");
            asm volatile("s_waitcnt vmcnt(0)" ::: "memory");
            const unsigned og = xb_add(&bar[XB_TOP], 1u);
            const unsigned tg = og / nx;
            if (og + 1u == (tg + 1u) * nx) xb_add(&bar[XB_TOPGEN], 1u);
            else XB_SPIN(xb_ld(&bar[XB_TOPGEN]) == tg, bar);
            __builtin_amdgcn_fence(__ATOMIC_ACQUIRE, "agent");
            xb_add(&bar[XB_XGEN(b.x)], 1u);
            asm volatile("s_waitcnt vmcnt(0)" ::: "memory");
        } else {
            XB_SPIN(xb_ld(&bar[XB_XGEN(b.x)]) == gen, bar);
            __builtin_amdgcn_fence(__ATOMIC_ACQUIRE, "agent");
            asm volatile("s_waitcnt vmcnt(0)" ::: "memory");
        }
    }
    __syncthreads();
}

struct Frame {
    LAS unsigned char* lds; volatile LAS unsigned* LC;
    unsigned* ctl;
    int wave, vcu, G;
    Bufs B;
};
#define FWS(T, off) ((T*)(F.B.ws + (off)))
#define FDO(T, off) ((T*)((unsigned char*)F.B.out + (off)))
#define LDS_WAIT() asm volatile("s_waitcnt lgkmcnt(0)" ::: "memory")
#define VM_WAIT() asm volatile("s_waitcnt vmcnt(0)" ::: "memory")

__device__ __forceinline__ f32x16 mfma32(bf16x8 a, bf16x8 b, f32x16 c) { return __builtin_amdgcn_mfma_f32_32x32x16_bf16(a, b, c, 0, 0, 0); }
__device__ __forceinline__ int crow(int r, int hi) { return (r & 3) + 8 * (r >> 2) + 4 * hi; }
__device__ __forceinline__ float swap_lo(float x, float& hi_out) { auto rr = __builtin_amdgcn_permlane32_swap(__float_as_uint(x), __float_as_uint(x), false, false); hi_out = __uint_as_float(rr[1]); return __uint_as_float(rr[0]); }
__device__ __forceinline__ bf16x8 pack_frag(const f32x16& v, int base) {
    u32x4 w; w.x = pg8::cvt_pk_bf16(v[base + 0], v[base + 1]); w.y = pg8::cvt_pk_bf16(v[base + 2], v[base + 3]); w.z = pg8::cvt_pk_bf16(v[base + 4], v[base + 5]); w.w = pg8::cvt_pk_bf16(v[base + 6], v[base + 7]);
    return __builtin_bit_cast(bf16x8, w); }
__device__ __forceinline__ bf16x8 join8(u32x2 a, u32x2 b) { u32x4 w; w.x = a.x; w.y = a.y; w.z = b.x; w.w = b.y; return __builtin_bit_cast(bf16x8, w); }
__device__ __forceinline__ float ret_l2g(int h) { return __builtin_amdgcn_logf(1.0f - __builtin_amdgcn_exp2f(-5.0f - (float)h)); }

__device__ __forceinline__ void tr_item(const float* src, int lds_, int k0, int c0, bf16* dst, int K, int r0, LAS unsigned char* scr, int lane) {
    const int kr = lane >> 4, nq = lane & 15;
    f32x4 v[4][4];
#pragma unroll
    for (int gI = 0; gI < 4; ++gI)
#pragma unroll
        for (int i = 0; i < 4; ++i) v[gI][i] = *(const f32x4*)(src + (size_t)(k0 + 16 * gI + 4 * kr + i) * lds_ + c0 + 4 * nq);
#pragma unroll
    for (int gI = 0; gI < 4; ++gI)
#pragma unroll
        for (int e = 0; e < 4; ++e) { u32x2 w; w.x = pk2(v[gI][0][e], v[gI][1][e]); w.y = pk2(v[gI][2][e], v[gI][3][e]);
            *(LAS u32x2*)(scr + (4 * nq + e) * 144 + 32 * gI + 8 * kr) = w; }
    LDS_WAIT(); asm volatile("" ::: "memory");
#pragma unroll
    for (int it = 0; it < 8; ++it) { const int n = it * 8 + (lane >> 3), ch = lane & 7;
        const u32x4 w = *(const LAS u32x4*)(scr + n * 144 + ch * 16);
        *(u32x4*)(dst + (size_t)(r0 + n) * K + k0 + 8 * ch) = w; }
    LDS_WAIT(); asm volatile("" ::: "memory");
}
__device__ __forceinline__ void p0_prologue(Frame& F) {
    const Bufs& B = F.B; const int lane_ = lane_id(), tid_ = F.wave * 64 + lane_;
    const int gw = F.vcu * NWAVES + F.wave, NGW = F.G * NWAVES;
    { const f32x4* xs = (const f32x4*)B.x; u32x4* xd = FDO(u32x4, DO_XB); const size_t n8 = (size_t)NTOK * DM / 8;
      for (size_t i = (size_t)blockIdx.x * 512 + tid_; i < n8; i += (size_t)F.G * 512) { const f32x4 a = xs[2 * i], b = xs[2 * i + 1];
          u32x4 w; w.x = pk2(a[0], a[1]); w.y = pk2(a[2], a[3]); w.z = pk2(b[0], b[1]); w.w = pk2(b[2], b[3]); xd[i] = w; } }
    LAS unsigned char* scr = F.lds + RING_OFF + F.wave * 9216;
    constexpr int I_IN = 16 * (INW / 64)  , I_BSB = 256, I_BRET = 32 * 16, I_OUT = 256;
    constexpr int NITEMS = I_IN + I_BSB + I_BRET + I_OUT;
    for (int it = gw; it < NITEMS; it += NGW) {
        int r = it;
        if (r < I_IN) { const int kb = r / (INW / 64), nb = r % (INW / 64); const int c0 = nb * 64; bf16* dst; int r0;
            if (c0 < 2048) { dst = FWS(bf16, WS_WINT); r0 = c0; } else if (c0 < 3072) { dst = FWS(bf16, WS_WVT); r0 = c0 - 2048; }
            else if (c0 < 5120) { dst = FWS(bf16, WS_WINT); r0 = 2048 + c0 - 3072; } else if (c0 < 7168) { dst = FWS(bf16, WS_WVT); r0 = 1024 + c0 - 5120; }
            else { dst = FWS(bf16, WS_WINT); r0 = 4096 + c0 - 7168; }
            tr_item(B.w_in, INW, kb * 64, c0, dst, 1024, r0, scr, lane_); continue; } r -= I_IN;
        if (r < I_BSB) { tr_item(B.w_bsb, 1024, (r >> 4) * 64, (r & 15) * 64, FWS(bf16, WS_WBSBT), 1024, (r & 15) * 64, scr, lane_); continue; } r -= I_BSB;
        if (r < I_BRET) { tr_item(B.w_bret, 1024, (r >> 4) * 64, (r & 15) * 64, FWS(bf16, WS_WBRETT), 2048, (r & 15) * 64, scr, lane_); continue; } r -= I_BRET;
        tr_item(B.w_out, 1024, (r >> 4) * 64, (r & 15) * 64, FWS(bf16, WS_WOUTT), 1024, (r & 15) * 64, scr, lane_);
    }
    { float* ct = FWS(float, WS_COS); float* st = FWS(float, WS_SIN);
      for (int i = blockIdx.x * 512 + tid_; i < SEQ * 128; i += F.G * 512) { const int pos = i >> 7, j = i & 127; const float ang = (float)pos * rope_inv_freq(j);
          ct[i] = (float)cos((double)ang); st[i] = (float)sin((double)ang); } }
    { bf16* wrt = FWS(bf16, WS_WRT);
      for (int i = blockIdx.x * 512 + tid_; i < 32 * 1024; i += F.G * 512) { const int k = i & 1023, e = i >> 10; wrt[i] = f2bf(B.w_router[k * 32 + e]); } }
}
__device__ __forceinline__ float sb_half(f32x16& p, int kbase, int tq, int hi, bool need_mask, float cin, bf16x8& f0, bf16x8& f1) {
    f32x16 u;
#pragma unroll
    for (int r = 0; r < 16; ++r) { const float e = __builtin_amdgcn_exp2f(fminf(p[r], 100.0f)); u[r] = __builtin_amdgcn_rcpf(1.0f + e); p[r] = e * u[r]; }
    if (need_mask) {
#pragma unroll
        for (int r = 0; r < 16; ++r) { const int s_ = kbase + crow(r, hi); const bool v = (s_ >= 0) && (s_ < tq); u[r] = v ? u[r] : 1.0f; p[r] = v ? p[r] : 0.0f; } }
    float T[4], Rh[4];
#pragma unroll
    for (int g = 0; g < 4; ++g) { const float R = (u[4 * g] * u[4 * g + 1]) * (u[4 * g + 2] * u[4 * g + 3]); float rh; const float rl = swap_lo(R, rh); Rh[g] = rh; T[g] = rl * rh; }
    float X[4]; X[3] = 1.0f;
#pragma unroll
    for (int g = 2; g >= 0; --g) X[g] = X[g + 1] * T[g + 1];
#pragma unroll
    for (int g = 0; g < 4; ++g) { const float ec = X[g] * (hi == 0 ? Rh[g] : 1.0f) * cin;
        const float w2 = u[4 * g + 3], w1 = w2 * u[4 * g + 2], w0 = w1 * u[4 * g + 1];
        p[4 * g + 3] *= ec; p[4 * g + 2] *= w2 * ec; p[4 * g + 1] *= w1 * ec; p[4 * g] *= w0 * ec; }
    f0 = pack_frag(p, 0); f1 = pack_frag(p, 8);
    return X[0] * T[0];
}
__device__ __forceinline__ void attn_wave_unit(const bf16* __restrict__ KSB, const bf16* __restrict__ VSBT, bf16* QY, int b, int h, int qb, int lane) {
    const int r32 = lane & 31, hi = lane >> 5; const int bh = b * 16 + h;
    const int t0 = qb * 32; const size_t rb = (size_t)b * SEQ; const int tq = t0 + r32;
    bf16x8 qf[4];
    { const bf16* qp = QY + (rb + t0 + r32) * 1024 + h * 64 + 8 * hi;
#pragma unroll
      for (int d0 = 0; d0 < 4; ++d0) qf[d0] = *(const bf16x8*)(qp + 16 * d0); }
    f32x16 o0 = {}, o1 = {};
    float carry = 1.0f;
    bf16x8 kf[2][4];
    const int koff = r32 * 16 + 8 * hi, voff = r32 * 16 + 4 * hi;
#define ATT_KLOAD(ks_) do { const bf16* b0_ = KSB + ((size_t)bh * 256 + (max((ks_), 0) >> 5)) * 2048; const bf16* b1_ = KSB + ((size_t)bh * 256 + (max((ks_) + 32, 0) >> 5)) * 2048; \
        _Pragma("unroll") for (int d0 = 0; d0 < 4; ++d0) { kf[0][d0] = *(const bf16x8*)(b0_ + d0 * 512 + koff); kf[1][d0] = *(const bf16x8*)(b1_ + d0 * 512 + koff); } } while (0)
    ATT_KLOAD(t0 - 32);
    for (int tile = 0;; ++tile) {
        const int ks = t0 + 32 - 64 * (tile + 1);
        f32x16 p0 = {}, p1 = {};
#pragma unroll
        for (int d0 = 0; d0 < 4; ++d0) { p0 = mfma32(kf[0][d0], qf[d0], p0); p1 = mfma32(kf[1][d0], qf[d0], p1); }
        bf16x8 vf[2][4];
#pragma unroll
        for (int s = 0; s < 4; ++s) { const bf16* vb_ = VSBT + ((size_t)bh * 512 + (max(ks + 16 * s, 0) >> 4)) * 1024;
#pragma unroll
            for (int db = 0; db < 2; ++db) vf[db][s] = join8(*(const u32x2*)(vb_ + db * 512 + voff), *(const u32x2*)(vb_ + db * 512 + voff + 8)); }
        ATT_KLOAD(ks - 64);
        const bool need_mask = (tile == 0) || (ks < 0);
        bf16x8 pfB0, pfB1, pfA0, pfA1;
        const float tot1 = sb_half(p1, ks + 32, tq, hi, need_mask, carry, pfB0, pfB1);
        const float tot0 = sb_half(p0, ks, tq, hi, need_mask, carry * tot1, pfA0, pfA1);
        carry *= tot1 * tot0;
        o0 = mfma32(vf[0][0], pfA0, o0); o1 = mfma32(vf[1][0], pfA0, o1); o0 = mfma32(vf[0][1], pfA1, o0); o1 = mfma32(vf[1][1], pfA1, o1);
        o0 = mfma32(vf[0][2], pfB0, o0); o1 = mfma32(vf[1][2], pfB0, o1); o0 = mfma32(vf[0][3], pfB1, o0); o1 = mfma32(vf[1][3], pfB1, o1);
        if (ks <= 0) break;
        if (__all(carry < 1.0e-37f)) break;
    }
#undef ATT_KLOAD
    bf16* op = QY + (rb + t0 + r32) * 1024 + h * 64 + 4 * hi;
#pragma unroll
    for (int g = 0; g < 4; ++g) { u32x2 w; w.x = pg8::cvt_pk_bf16(o0[4 * g], o0[4 * g + 1]); w.y = pg8::cvt_pk_bf16(o0[4 * g + 2], o0[4 * g + 3]); *(u32x2*)(op + 8 * g) = w;
        u32x2 w2; w2.x = pg8::cvt_pk_bf16(o1[4 * g], o1[4 * g + 1]); w2.y = pg8::cvt_pk_bf16(o1[4 * g + 2], o1[4 * g + 3]); *(u32x2*)(op + 32 + 8 * g) = w2; }
}
constexpr int I_GU = 32 * 16 * 32, I_DN = 32 * 16 * 16, I_MOE = I_GU + I_DN;
__device__ __forceinline__ void moe_tr_item(Frame& F, int r, LAS unsigned char* scr, int lane) {
    const Bufs& B = F.B;
    if (r < I_GU) { const int e = r >> 9, q = r & 511, kb = q >> 5, nb = q & 31; const int c0 = nb * 64; const int bj = c0 >> 10, rem = c0 & 1023, ct = rem >> 7, i0 = rem & 127;
        tr_item(B.w_gu + (size_t)e * 1024 * 2048, 2048, kb * 64, c0, FWS(bf16, WS_WGUT) + (size_t)e * 2048 * 1024, 1024, 256 * ct + 128 * bj + i0, scr, lane); return; }
    r -= I_GU;
    { const int e = r >> 8, q = r & 255, kb = q >> 4, nb = q & 15;
      tr_item(B.w_dn + (size_t)e * 1024 * 1024, 1024, kb * 64, nb * 64, FWS(bf16, WS_WDT) + (size_t)e * 1024 * 1024, 1024, nb * 64, scr, lane); }
}
__device__ __forceinline__ void attn_phase(Frame& F) {
    const int gw = F.vcu * NWAVES + F.wave, NGW = F.G * NWAVES; const int lane = lane_id();
    LAS unsigned char* scr = F.lds + RING_OFF + F.wave * 9216;
    int it = gw;
    for (int wu = gw; wu < BATCH * SBH * (SEQ / 32); wu += NGW) { const int qb = wu & 255, bh = wu >> 8;
        attn_wave_unit(FWS(bf16, WS_KSB), FWS(bf16, WS_VSBT), FWS(bf16, WS_QSB), bh >> 4, bh & 15, qb, lane);
        for (int z = 0; z < 2 && it < I_MOE; ++z, it += NGW) moe_tr_item(F, it, scr, lane); }
    for (; it < I_MOE; it += NGW) moe_tr_item(F, it, scr, lane);
}

__device__ __forceinline__ int swap23(int m) { return (m & ~12) | ((m & 4) << 1) | ((m & 8) >> 1); }
__device__ __forceinline__ void scan_phase(Frame& F) {
    if (F.vcu >= BATCH * RH * 16) return;
    const int lane = lane_id(), w = F.wave, r32 = lane & 31, hi = lane >> 5;
    const int bh = F.vcu >> 4, vs = F.vcu & 15, h = bh & 3;
    const float l2g = ret_l2g(h), cd = __builtin_amdgcn_exp2f(64.0f * l2g);
    const bf16* ktp = FDO(bf16, DO_KRT) + ((size_t)bh * 128 * 4 * 256 + (32 * w + swap23(r32))) * 16 + 8 * hi;
    const bf16* vtp = FWS(bf16, WS_VRT) + ((size_t)bh * 128 * 4 * 512 + (32 * vs + r32)) * 16 + 8 * hi;
    const bf16* qp = FWS(bf16, WS_QRS) + ((size_t)bh * 128 * 16 * 64 + (size_t)(2 * w) * 64 + r32) * 16 + 8 * hi;
    bf16* yp = FWS(bf16, WS_YINT) + ((size_t)bh * 128 * 64 + (size_t)(4 * vs + (r32 >> 3))) * 512 + (r32 & 7);
    LAS f32x4* part = (LAS f32x4*)(F.lds + RING_OFF);
    f32x16 S = {};
    bf16x8 kfA[4], vfA[4], qfA[2][2], kfB[4], vfB[4], qfB[2][2], kfC[4], vfC[4], qfC[2][2];
#define SCAN_LOAD(kf, vf, qf, c) do { _Pragma("unroll") for (int s = 0; s < 4; ++s) { kf[s] = *(const bf16x8*)(ktp + (size_t)((c) * 4 + s) * 4096); vf[s] = *(const bf16x8*)(vtp + (size_t)((c) * 4 + s) * 8192); } \
        _Pragma("unroll") for (int ib = 0; ib < 2; ++ib) _Pragma("unroll") for (int s = 0; s < 2; ++s) qf[ib][s] = *(const bf16x8*)(qp + (size_t)(c) * 16384 + s * 1024 + ib * 512); } while (0)
#define SCAN_STEP(kf, vf, qf, kfn, vfn, qfn, c) do { \
        { const int cn_ = ((c) + 2 < NCHUNK) ? (c) + 2 : NCHUNK - 1; SCAN_LOAD(kfn, vfn, qfn, cn_); }     \
        const bf16x8 sb0 = pack_frag(S, 0), sb1 = pack_frag(S, 8); \
        f32x16 y0 = {}, y1 = {}; \
        y0 = mfma32(qf[0][0], sb0, y0); y0 = mfma32(qf[0][1], sb1, y0); \
        y1 = mfma32(qf[1][0], sb0, y1); y1 = mfma32(qf[1][1], sb1, y1); \
        LAS f32x4* pb = part + ((c) & 1) * 4096 + (w * 8) * 64 + lane; \
        _Pragma("unroll") for (int q = 0; q < 4; ++q) { pb[q * 64] = (f32x4){y0[4 * q], y0[4 * q + 1], y0[4 * q + 2], y0[4 * q + 3]}; pb[(4 + q) * 64] = (f32x4){y1[4 * q], y1[4 * q + 1], y1[4 * q + 2], y1[4 * q + 3]}; } \
        _Pragma("unroll") for (int r = 0; r < 16; ++r) S[r] *= cd; \
        _Pragma("unroll") for (int s = 0; s < 4; ++s) S = mfma32(kf[s], vf[s], S); \
        LDS_WAIT(); __builtin_amdgcn_s_barrier(); asm volatile("" ::: "memory"); \
        const LAS f32x4* rbp = part + ((c) & 1) * 4096 + w * 64 + lane;         \
        f32x4 acc = rbp[0]; \
        _Pragma("unroll") for (int w2 = 1; w2 < 8; ++w2) acc += rbp[w2 * 8 * 64]; \
        _Pragma("unroll") for (int k = 0; k < 4; ++k) { const int idx = 4 * w + k, ib = idx >> 4, r = idx & 15; const int i = 32 * ib + crow(r, hi); \
            yp[(size_t)(c) * 32768 + i * 8] = f2bf(acc[k] * __builtin_amdgcn_exp2f((float)(i + 1) * l2g)); } } while (0)
    SCAN_LOAD(kfA, vfA, qfA, 0); SCAN_LOAD(kfB, vfB, qfB, 1);
    int c = 0;
    for (; c + 3 <= NCHUNK; c += 3) { SCAN_STEP(kfA, vfA, qfA, kfC, vfC, qfC, c); SCAN_STEP(kfB, vfB, qfB, kfA, vfA, qfA, c + 1); SCAN_STEP(kfC, vfC, qfC, kfB, vfB, qfB, c + 2); }
    SCAN_STEP(kfA, vfA, qfA, kfC, vfC, qfC, c); SCAN_STEP(kfB, vfB, qfB, kfA, vfA, qfA, c + 1);
    static_assert(NCHUNK % 3 == 2, "scan tail");
#undef SCAN_STEP
#undef SCAN_LOAD
    LDS_WAIT(); __syncthreads();
}

__device__ __forceinline__ void intra_phase(Frame& F) {
    const int lane = lane_id(), w = F.wave, r32 = lane & 31, hi = lane >> 5;
    LAS float* part = (LAS float*)(F.lds + RING_OFF);
    LAS u32x4* pfl = (LAS u32x4*)(F.lds + RING_OFF + 16384);
    LAS float* red = (LAS float*)(F.lds + RING_OFF + 24576);
    LAS unsigned char* stg = F.lds + RING_OFF + 32768 + w * 9216;
    const int tl = w & 3, jb = tl >> 1, ibt = tl & 1, kh = w >> 2;
    for (int un = F.vcu * 8; un < F.vcu * 8 + 8 && un < BATCH * RH * NCHUNK; ++un) {
        const int c = un & 127, h = (un >> 7) & 3, b = un >> 9, bh = b * 4 + h;
        const size_t tok0 = (size_t)b * SEQ + c * 64; const float l2g = ret_l2g(h);
        bf16x8 kfr[8], qfr[8];
        { const bf16* kp = FWS(bf16, WS_KR) + (tok0 + 32 * jb + r32) * 1024 + h * 256 + 128 * kh + 8 * hi;
          const bf16* qp = FWS(bf16, WS_QRS) + (((size_t)bh * 128 + c) * 16 + 8 * kh) * 1024 + (32 * ibt + r32) * 16 + 8 * hi;
#pragma unroll
          for (int s = 0; s < 8; ++s) { kfr[s] = *(const bf16x8*)(kp + 16 * s); qfr[s] = *(const bf16x8*)(qp + s * 1024); } }
        bf16x8 vfr[2][4];
        { const bf16* vp = FWS(bf16, WS_VRT) + (((size_t)bh * 128 + c) * 4 * 512 + 64 * w + r32) * 16 + 4 * hi;
#pragma unroll
          for (int vb = 0; vb < 2; ++vb)
#pragma unroll
              for (int ks = 0; ks < 4; ++ks) { const bf16* p = vp + (size_t)ks * 8192 + vb * 512; vfr[vb][ks] = join8(*(const u32x2*)(p), *(const u32x2*)(p + 8)); } }
        const size_t tbase = ((((size_t)bh * 128 + c) * 64 + 8 * w) * 64 + r32) * 8 + 4 * hi;
        const bf16* yrow = FWS(bf16, WS_YINT) + tbase; const bf16* srow = FWS(bf16, WS_SG) + tbase;
        u32x2 yv[2][2][4];
#pragma unroll
        for (int ib = 0; ib < 2; ++ib)
#pragma unroll
            for (int vb = 0; vb < 2; ++vb)
#pragma unroll
                for (int g = 0; g < 4; ++g) yv[ib][vb][g] = *(const u32x2*)(yrow + (size_t)(4 * vb + g) * 512 + ib * 256);
        f32x16 X = {};
#pragma unroll
        for (int s = 0; s < 8; ++s) X = mfma32(kfr[s], qfr[s], X);
        u32x2 sv[2][2][4];
#pragma unroll
        for (int ib = 0; ib < 2; ++ib)
#pragma unroll
            for (int vb = 0; vb < 2; ++vb)
#pragma unroll
                for (int g = 0; g < 4; ++g) sv[ib][vb][g] = *(const u32x2*)(srow + (size_t)(4 * vb + g) * 512 + ib * 256);
        if (kh == 1) {
#pragma unroll
            for (int r = 0; r < 16; ++r) part[(tl * 16 + r) * 64 + lane] = X[r]; }
        LDS_WAIT(); __builtin_amdgcn_s_barrier(); asm volatile("" ::: "memory");
        if (kh == 0) {
#pragma unroll
            for (int r = 0; r < 16; ++r) { const int j = 32 * jb + crow(r, hi), i = 32 * ibt + r32;
                X[r] = (X[r] + part[(tl * 16 + r) * 64 + lane]) * __builtin_amdgcn_exp2f((float)((j <= i ? i - j : j - i) - 63 + j) * l2g); }
            pfl[(ibt * 4 + 2 * jb) * 64 + lane] = __builtin_bit_cast(u32x4, pack_frag(X, 0)); pfl[(ibt * 4 + 2 * jb + 1) * 64 + lane] = __builtin_bit_cast(u32x4, pack_frag(X, 8)); }
        LDS_WAIT(); __builtin_amdgcn_s_barrier(); asm volatile("" ::: "memory");
        f32x16 Y[2][2] = {};
#pragma unroll
        for (int ks = 0; ks < 4; ++ks) { const bf16x8 p0 = __builtin_bit_cast(bf16x8, pfl[(0 * 4 + ks) * 64 + lane]), p1 = __builtin_bit_cast(bf16x8, pfl[(1 * 4 + ks) * 64 + lane]);
#pragma unroll
            for (int vb = 0; vb < 2; ++vb) { Y[vb][0] = mfma32(vfr[vb][ks], p0, Y[vb][0]); Y[vb][1] = mfma32(vfr[vb][ks], p1, Y[vb][1]); } }
        float s1[2] = {0.f, 0.f}, s2[2] = {0.f, 0.f};
#pragma unroll
        for (int ib = 0; ib < 2; ++ib)
#pragma unroll
            for (int vb = 0; vb < 2; ++vb)
#pragma unroll
                for (int g = 0; g < 4; ++g) { const u32x2 wv = yv[ib][vb][g];
                    Y[vb][ib][4 * g] += __uint_as_float(wv.x << 16); Y[vb][ib][4 * g + 1] += __uint_as_float(wv.x & 0xffff0000u); Y[vb][ib][4 * g + 2] += __uint_as_float(wv.y << 16); Y[vb][ib][4 * g + 3] += __uint_as_float(wv.y & 0xffff0000u);
#pragma unroll
                    for (int e = 0; e < 4; ++e) { const float y = Y[vb][ib][4 * g + e]; s1[ib] += y; s2[ib] += y * y; } }
#pragma unroll
        for (int ib = 0; ib < 2; ++ib) { float h1, h2; const float l1 = swap_lo(s1[ib], h1), l2 = swap_lo(s2[ib], h2);
            if (hi == 0) { red[(w * 64 + 32 * ib + r32) * 2] = l1 + h1; red[(w * 64 + 32 * ib + r32) * 2 + 1] = l2 + h2; } }
        LDS_WAIT(); __builtin_amdgcn_s_barrier(); asm volatile("" ::: "memory");
#pragma unroll
        for (int ib = 0; ib < 2; ++ib) { float t1 = 0.f, t2 = 0.f;
#pragma unroll
            for (int w2 = 0; w2 < 8; ++w2) { t1 += red[(w2 * 64 + 32 * ib + r32) * 2]; t2 += red[(w2 * 64 + 32 * ib + r32) * 2 + 1]; }
            const float mean = t1 * (1.0f / 512.0f), var = fmaxf(t2 * (1.0f / 512.0f) - mean * mean, 0.0f), rstd = __builtin_amdgcn_rsqf(var + LN_EPS);
#pragma unroll
            for (int vb = 0; vb < 2; ++vb)
#pragma unroll
                for (int g = 0; g < 4; ++g) { const u32x2 sw = sv[ib][vb][g];
                    const float g0 = __uint_as_float(sw.x << 16), g1 = __uint_as_float(sw.x & 0xffff0000u), g2 = __uint_as_float(sw.y << 16), g3 = __uint_as_float(sw.y & 0xffff0000u);
                    u32x2 ov; ov.x = pg8::cvt_pk_bf16(g0 * (Y[vb][ib][4 * g] - mean) * rstd, g1 * (Y[vb][ib][4 * g + 1] - mean) * rstd);
                    ov.y = pg8::cvt_pk_bf16(g2 * (Y[vb][ib][4 * g + 2] - mean) * rstd, g3 * (Y[vb][ib][4 * g + 3] - mean) * rstd);
                    *(LAS u32x2*)(stg + (32 * ib + r32) * 144 + (32 * vb + 8 * g + 4 * hi) * 2) = ov; } }
        LDS_WAIT(); asm volatile("" ::: "memory");
        { bf16* rp = FDO(bf16, DO_R) + (tok0 + (lane >> 3)) * 2048 + h * 512 + 64 * w + 8 * (lane & 7);
#pragma unroll
          for (int k = 0; k < 8; ++k) { const u32x4 v = *(const LAS u32x4*)(stg + (8 * k + (lane >> 3)) * 144 + (lane & 7) * 16); *(u32x4*)(rp + (size_t)(8 * k) * 2048) = v; } }
        LDS_WAIT(); asm volatile("" ::: "memory");
    }
    LDS_WAIT(); __syncthreads();
}

__device__ __forceinline__ void ln1_router_phase(Frame& F) {
    const Bufs& B = F.B;
    const int lane = lane_id(), w = F.wave, r32 = lane & 31, hi = lane >> 5; const int tid_ = w * 64 + lane;
    LAS unsigned char* xt = F.lds + RING_OFF;
    LAS f32x4* pl = (LAS f32x4*)(F.lds + RING_OFF + 66048);
    LAS int* selE = (LAS int*)(F.lds + RING_OFF + 98816);
    LAS float* selW = (LAS float*)(F.lds + RING_OFF + 98816 + 2048);
    volatile LAS unsigned* hist = F.LC + 96; volatile LAS unsigned* basew = F.LC + 128;
    if (tid_ < 32) hist[tid_] = 0u;
    f32x4 gv[4], bv[4];
#pragma unroll
    for (int j = 0; j < 4; ++j) { gv[j] = *(const f32x4*)(B.ln1_g + 4 * lane + 256 * j); bv[j] = *(const f32x4*)(B.ln1_b + 4 * lane + 256 * j); }
    const int wgrow0 = F.vcu * 128;
    f32x4 vn[4][4];
#define LN_LOAD(blk_) do { _Pragma("unroll") for (int rr = 0; rr < 4; ++rr) { const float* p_ = B.out + (size_t)(wgrow0 + 32 * (blk_) + 4 * w + rr) * 1024 + 4 * lane; \
        _Pragma("unroll") for (int j = 0; j < 4; ++j) vn[rr][j] = *(const f32x4*)(p_ + 256 * j); } } while (0)
    LN_LOAD(0);
    for (int blk = 0; blk < 4; ++blk) {
        const int row0 = wgrow0 + 32 * blk;
        f32x4 vc[4][4];
#pragma unroll
        for (int rr = 0; rr < 4; ++rr)
#pragma unroll
            for (int j = 0; j < 4; ++j) vc[rr][j] = vn[rr][j];
        { const int nb = blk < 3 ? blk + 1 : 3; LN_LOAD(nb); }
#pragma unroll
        for (int rr = 0; rr < 4; ++rr) { const int lr = 4 * w + rr; bf16* xb = FWS(bf16, WS_X1B) + (size_t)(row0 + lr) * 1024 + 4 * lane;
            f32x4 v[4]; float s = 0.f;
#pragma unroll
            for (int j = 0; j < 4; ++j) { v[j] = vc[rr][j]; s += (v[j][0] + v[j][1]) + (v[j][2] + v[j][3]); }
            const float mean = wave_sum(s) * (1.f / 1024.f); float s2 = 0.f;
#pragma unroll
            for (int j = 0; j < 4; ++j) { v[j] = v[j] - mean; s2 += (v[j][0] * v[j][0] + v[j][1] * v[j][1]) + (v[j][2] * v[j][2] + v[j][3] * v[j][3]); }
            const float rstd = rsqrtf(wave_sum(s2) * (1.f / 1024.f) + LN_EPS);
#pragma unroll
            for (int j = 0; j < 4; ++j) { const f32x4 y = v[j] * rstd * gv[j] + bv[j];
                u32x2 o; o.x = pg8::cvt_pk_bf16(y[0], y[1]); o.y = pg8::cvt_pk_bf16(y[2], y[3]); *(u32x2*)(xb + 256 * j) = o;
                *(LAS u32x2*)(xt + lr * 2064 + (4 * lane + 256 * j) * 2) = o; } }
        LDS_WAIT(); __builtin_amdgcn_s_barrier(); asm volatile("" ::: "memory");
        f32x16 acc = {};
        { const bf16* ap = FWS(bf16, WS_WRT) + (size_t)r32 * 1024 + 128 * w + 8 * hi; const LAS unsigned char* bp = xt + r32 * 2064 + (128 * w + 8 * hi) * 2;
#pragma unroll
          for (int s = 0; s < 8; ++s) acc = mfma32(*(const bf16x8*)(ap + 16 * s), *(const LAS bf16x8*)(bp + 32 * s), acc); }
#pragma unroll
        for (int q = 0; q < 4; ++q) pl[(w * 4 + q) * 64 + lane] = (f32x4){acc[4 * q], acc[4 * q + 1], acc[4 * q + 2], acc[4 * q + 3]};
        LDS_WAIT(); __builtin_amdgcn_s_barrier(); asm volatile("" ::: "memory");
        const bool fin = (w == (blk & 7));
        f32x4 t[4];
        if (fin) {
#pragma unroll
            for (int q = 0; q < 4; ++q) { t[q] = pl[q * 64 + lane];
#pragma unroll
                for (int w2 = 1; w2 < 8; ++w2) t[q] += pl[(w2 * 4 + q) * 64 + lane]; } }
        LDS_WAIT(); __builtin_amdgcn_s_barrier(); asm volatile("" ::: "memory");
        if (fin) {
            float lo[16], hv[16];
#pragma unroll
            for (int r = 0; r < 16; ++r) { const float x = t[r >> 2][r & 3] + B.b_router[crow(r, hi)]; float h_; lo[r] = swap_lo(x, h_); hv[r] = h_; }
            int se[4]; float sv[4];
#pragma unroll
            for (int kk = 0; kk < 4; ++kk) { float best = -INFINITY; int bi = 0;
#pragma unroll
                for (int g = 0; g < 4; ++g) {
#pragma unroll
                    for (int e = 0; e < 4; ++e) { if (lo[4 * g + e] > best) { best = lo[4 * g + e]; bi = 8 * g + e; } }
#pragma unroll
                    for (int e = 0; e < 4; ++e) { if (hv[4 * g + e] > best) { best = hv[4 * g + e]; bi = 8 * g + 4 + e; } } }
                se[kk] = bi; sv[kk] = best;
#pragma unroll
                for (int r = 0; r < 16; ++r) { if (bi == crow(r, 0)) lo[r] = -INFINITY; if (bi == crow(r, 1)) hv[r] = -INFINITY; } }
            const float e1 = __expf(sv[1] - sv[0]), e2 = __expf(sv[2] - sv[0]), e3 = __expf(sv[3] - sv[0]); const float inv = 1.f / (1.f + e1 + e2 + e3);
            if (hi == 0) { const int tl = 32 * blk + r32;
                selE[tl * 4 + 0] = se[0]; selE[tl * 4 + 1] = se[1]; selE[tl * 4 + 2] = se[2]; selE[tl * 4 + 3] = se[3];
                selW[tl * 4 + 0] = inv; selW[tl * 4 + 1] = e1 * inv; selW[tl * 4 + 2] = e2 * inv; selW[tl * 4 + 3] = e3 * inv; } }
    }
#undef LN_LOAD
    LDS_WAIT(); __syncthreads();
    const int myE = selE[tid_]; const float myW = selW[tid_];
    const unsigned rk = __hip_atomic_fetch_add((LAS unsigned*)hist + myE, 1u, __ATOMIC_RELAXED, __HIP_MEMORY_SCOPE_WORKGROUP);
    LDS_WAIT(); __syncthreads();
    if (tid_ < 32) basew[tid_] = __hip_atomic_fetch_add(F.ctl + CW_CNT + 64 * tid_, hist[tid_], RLX_AGENT);
    LDS_WAIT(); __syncthreads();
    { const unsigned pos = basew[myE] + rk; const int tk = (wgrow0 + (tid_ >> 2)) * 4 + (tid_ & 3);
      FWS(int, WS_ROWTK)[(size_t)myE * CAP + pos] = tk; FWS(float, WS_ROWW)[(size_t)myE * CAP + pos] = myW; }
}

template <bool GU> struct MoeOrder {
    const char* A; const char* W; volatile LAS int* ts; volatile LAS unsigned* cntl; const LAS unsigned* tab; int c;
    __device__ bool next(int i, pg8::Unit& u) const {
        const int x = c & 7, k = c >> 3, q = 8 * i + x;
        const int rt = GU ? (4 * q + (k >> 3)) : (8 * q + (k >> 2));
        if (rt >= ts[NEXP]) return false;
        int e = 0;
        for (int j = 1; j < NEXP; ++j) e += (rt >= ts[j]) ? 1 : 0;
        u.pn = GU ? (k & 7) : (k & 3); u.e = e; u.idx = i; u.rbase = rt * 256; u.pm = (rt - ts[e]) * 256;
        const int left = (int)cntl[e] - u.pm; u.nrows = left < 256 ? left : 256; return true;
    }
    __device__ __forceinline__ const char* a_ptr(const pg8::Unit& u) const { return GU ? A : A + (size_t)u.rbase * 1024 * 2; }
    __device__ __forceinline__ const char* b_ptr(const pg8::Unit& u) const { return W + ((size_t)u.e * (GU ? 2048 : 1024) + (size_t)u.pn * 256) * 1024 * 2; }
    __device__ __forceinline__ unsigned a_off(const pg8::Unit& u, int row) const { return tab[u.idx * 256 + row]; }
    __device__ __forceinline__ void a_ready(const pg8::Unit&) const {}
    __device__ __forceinline__ void done(const pg8::Unit&) const {}
};
__device__ __forceinline__ void moe_setup(Frame& F) {
    const int tid_ = F.wave * 64 + lane_id();
    volatile LAS int* ts = (volatile LAS int*)(F.LC + 16); volatile LAS unsigned* cntl = F.LC + 64;
    if (tid_ < 32) cntl[tid_] = __hip_atomic_load(F.ctl + CW_CNT + 64 * tid_, RLX_AGENT);
    LDS_WAIT(); __syncthreads();
    if (tid_ == 0) { int acc = 0; for (int e = 0; e < NEXP; ++e) { ts[e] = acc; acc += (int)((cntl[e] + 255u) >> 8); } ts[NEXP] = acc; }
    LDS_WAIT(); __syncthreads();
}

__device__ __forceinline__ void final_phase(Frame& F) {
    const Bufs& B = F.B; const int lane = lane_id();
    const int gw = F.vcu * NWAVES + F.wave, NGW = F.G * NWAVES;
    f32x4 gv[4], bv[4];
#pragma unroll
    for (int j = 0; j < 4; ++j) { gv[j] = *(const f32x4*)(B.ln2_g + 4 * lane + 256 * j); bv[j] = *(const f32x4*)(B.ln2_b + 4 * lane + 256 * j); }
    for (int row = gw; row < NTOK; row += NGW) { float* p = B.out + (size_t)row * 1024 + 4 * lane; const bf16* orow = FWS(bf16, WS_OUTR) + (size_t)row * 4096 + 4 * lane;
        const bf16* xrow = FWS(bf16, WS_X1B) + (size_t)row * 1024 + 4 * lane;
        f32x4 v[4]; float s = 0.f;
#pragma unroll
        for (int j = 0; j < 4; ++j) { { const u32x2 xv = *(const u32x2*)(xrow + 256 * j);
                v[j] = (f32x4){__uint_as_float(xv.x << 16), __uint_as_float(xv.x & 0xffff0000u), __uint_as_float(xv.y << 16), __uint_as_float(xv.y & 0xffff0000u)} * DN_ALPHA; }
#pragma unroll
            for (int kk = 0; kk < 4; ++kk) { const u32x2 wv = *(const u32x2*)(orow + kk * 1024 + 256 * j);
                v[j][0] += __uint_as_float(wv.x << 16); v[j][1] += __uint_as_float(wv.x & 0xffff0000u); v[j][2] += __uint_as_float(wv.y << 16); v[j][3] += __uint_as_float(wv.y & 0xffff0000u); }
            s += (v[j][0] + v[j][1]) + (v[j][2] + v[j][3]); }
        const float mean = wave_sum(s) * (1.f / 1024.f); float s2 = 0.f;
#pragma unroll
        for (int j = 0; j < 4; ++j) { v[j] = v[j] - mean; s2 += (v[j][0] * v[j][0] + v[j][1] * v[j][1]) + (v[j][2] * v[j][2] + v[j][3] * v[j][3]); }
        const float rstd = rsqrtf(wave_sum(s2) * (1.f / 1024.f) + LN_EPS);
#pragma unroll
        for (int j = 0; j < 4; ++j) *(f32x4*)(p + 256 * j) = v[j] * rstd * gv[j] + bv[j]; }
}

constexpr int NPHASE = 11;
struct MArgs { Bufs B; int ph_lo, ph_hi; };
__global__ void __launch_bounds__(NWAVES * 64, 2) mega_fwd(MArgs args) {
    extern __shared__ __attribute__((aligned(16))) unsigned char lds[];
    Frame F;
    F.lds = (LAS unsigned char*)lds; F.LC = (volatile LAS unsigned*)(F.lds + LDSCTL_OFF);
    F.wave = __builtin_amdgcn_readfirstlane((int)threadIdx.x >> 6);
    F.G = gridDim.x; { const int bx = blockIdx.x; F.vcu = (F.G % 8 == 0) ? (bx % 8) * (F.G / 8) + bx / 8 : bx; }
    F.B = args.B; F.ctl = (unsigned*)(args.B.ws + WS_CTL);
    for (int u = threadIdx.x; u < 256; u += NWAVES * 64) F.LC[u] = 0u;
    __syncthreads();
    const int lo = args.ph_lo, hi = args.ph_hi;
    const bool multi = (hi - lo) > 1;
    XcdBarrier bar; bar.bar = F.ctl + CW_BAR; bar.x = 0; bar.st = nullptr;
    if (multi) bar = xcd_barrier_post(F.ctl + CW_BAR, F.LC);
#ifndef PH_COMPILE
#define PH_COMPILE 0x7FF
#endif
#define IN(k) ((((PH_COMPILE) >> (k)) & 1) && lo <= (k) && (k) < hi)
#define SEAM(k) do { if (IN(k) && IN((k) + 1)) xcd_barrier(bar); } while (0)
    LAS unsigned char* ring = F.lds + RING_OFF;
    const int c = (int)blockIdx.x;
    if (IN(0)) { p0_prologue(F); } SEAM(0);
    if (IN(1)) {
        { pg8::StaticOrder S; S.init(FDO(bf16, DO_XB), FWS(bf16, WS_WINT), NTOK, 2048, 1024, F.G, c);
          pg8::EpiQK E{FWS(bf16, WS_QSB), FWS(bf16, WS_KSB)};
          pg8::gemm_phase<pg8::EpiQK, pg8::StaticOrder, true, false>(ring, 1024, S, E, F.wave); }
        { pg8::StaticOrder S; S.init(FDO(bf16, DO_XB), FWS(bf16, WS_WINT) + (size_t)2048 * 1024, NTOK, 2048, 1024, F.G, c);
          pg8::EpiRot E{FWS(bf16, WS_QR), FWS(bf16, WS_KR), FDO(bf16, DO_KRT), FWS(bf16, WS_QRS), FWS(float, WS_COS), FWS(float, WS_SIN)};
          pg8::gemm_phase<pg8::EpiRot, pg8::StaticOrder, true, false>(ring, 1024, S, E, F.wave); }
        { pg8::StaticOrder S; S.init(FDO(bf16, DO_XB), FWS(bf16, WS_WINT) + (size_t)4096 * 1024, NTOK, 4096, 1024, F.G, c);
          pg8::EpiGate E{F.B.ws};
          pg8::gemm_phase<pg8::EpiGate, pg8::StaticOrder, true, false>(ring, 1024, S, E, F.wave); }
        { pg8::StaticOrder S; S.init(FWS(bf16, WS_WVT), FDO(bf16, DO_XB), 3072, NTOK, 1024, F.G, c);
          pg8::EpiVT E{FWS(bf16, WS_VSBT), FWS(bf16, WS_VRT)};
          pg8::gemm_phase<pg8::EpiVT, pg8::StaticOrder, true, false>(ring, 1024, S, E, F.wave); }
    } SEAM(1);
    if (IN(2)) { attn_phase(F); } SEAM(2);
    if (IN(3)) { scan_phase(F); } SEAM(3);
    if (IN(4)) { intra_phase(F); } SEAM(4);
    if (IN(5)) {
        { pg8::StaticOrder S; S.init(FWS(bf16, WS_QSB), FWS(bf16, WS_WBSBT), NTOK, 1024, 1024, F.G, c);
          pg8::EpiBranch<0> E{FWS(bf16, WS_GSB), nullptr, FWS(bf16, WS_M1)};
          pg8::gemm_phase<pg8::EpiBranch<0>, pg8::StaticOrder, true, false>(ring, 1024, S, E, F.wave); }
        { pg8::StaticOrder S; S.init(FDO(bf16, DO_R), FWS(bf16, WS_WBRETT), NTOK, 1024, 2048, F.G, c);
          pg8::EpiBranch<1> E{FWS(bf16, WS_GRET), FWS(bf16, WS_M1), FWS(bf16, WS_MG)};
          pg8::gemm_phase<pg8::EpiBranch<1>, pg8::StaticOrder, true, false>(ring, 2048, S, E, F.wave); }
    } SEAM(5);
    if (IN(6)) { pg8::StaticOrder S; S.init(FWS(bf16, WS_MG), FWS(bf16, WS_WOUTT), NTOK, 1024, 1024, F.G, c);
        pg8::EpiPre E{F.B.x, F.B.out};
        pg8::gemm_phase<pg8::EpiPre, pg8::StaticOrder, true, false>(ring, 1024, S, E, F.wave); } SEAM(6);
    if (IN(7)) { ln1_router_phase(F); } SEAM(7);
    if (IN(8)) { moe_setup(F);
        MoeOrder<true> S{(const char*)FWS(bf16, WS_X1B), (const char*)FWS(bf16, WS_WGUT), (volatile LAS int*)(F.LC + 16), F.LC + 64, (const LAS unsigned*)(F.lds + LDS_TAB_OFF), c};
        { pg8::Unit u; LAS unsigned* tab = (LAS unsigned*)(F.lds + LDS_TAB_OFF);
          const int tid_ = F.wave * 64 + lane_id();
          for (int i = 0; i < 24 && S.next(i, u); ++i) { if (tid_ < 256) { const int rr = tid_; unsigned off = 0u;
                  if (rr < u.nrows) off = (unsigned)(FWS(int, WS_ROWTK)[(size_t)u.e * CAP + u.pm + rr] >> 2) * 2048u;
                  tab[i * 256 + rr] = off; } }
          LDS_WAIT(); __syncthreads(); }
        pg8::EpiGateUp E{F.B.b_gu, FWS(bf16, WS_ACT)};
        pg8::gemm_phase<pg8::EpiGateUp, MoeOrder<true>, true, true>(ring, 1024, S, E, F.wave); } SEAM(8);
    if (IN(9)) { moe_setup(F);
        MoeOrder<false> S{(const char*)FWS(bf16, WS_ACT), (const char*)FWS(bf16, WS_WDT), (volatile LAS int*)(F.LC + 16), F.LC + 64, (const LAS unsigned*)(F.lds + LDS_TAB_OFF), c};
        pg8::EpiDown E{F.B.b_dn, FWS(int, WS_ROWTK), FWS(float, WS_ROWW), FWS(bf16, WS_OUTR)};
        pg8::gemm_phase<pg8::EpiDown, MoeOrder<false>, true, false>(ring, 1024, S, E, F.wave); } SEAM(9);
    if (IN(10)) { final_phase(F); }
#undef IN
#undef SEAM
}
#ifndef OPT_MASK
#define OPT_MASK 0x7FF
#endif
#ifndef ONE_LAUNCH
#define ONE_LAUNCH 1
#endif
template <int NB, class AF, class BF, class EF> static void launch_ngemm(hipStream_t s, int M, int N, int K, const AF& af, const BF& bf, const EF& ef) {
    GArgs<AF, BF, EF> ga; memset(&ga, 0, sizeof(ga)); ga.af = af; ga.bf = bf; ga.ef = ef; ga.M = M; ga.N = N; ga.K = K; ga.pad = 0;
    ngemm<NB, AF, BF, EF><<<dim3(N / 64, M / 64), 256, 0, s>>>(ga);
}
static void launch_tr(hipStream_t s, int grid, const float* src, int lds, int c0, int width, int K, bf16* dst, int r0) {
    TrArgs a; memset(&a, 0, sizeof(a)); a.src = src; a.dst = dst; a.lds = lds; a.c0 = c0; a.width = width; a.K = K; a.r0 = r0; a.pad = 0;
    n_tr<<<grid, 256, 0, s>>>(a);
}
static AF_rows mk_rows(const void* p, int ld) { AF_rows a; memset(&a, 0, sizeof(a)); a.A = (const bf16*)p; a.ld = ld; a.pad = 0; return a; }
static BF_wt mk_wt(const void* p, int K) { BF_wt a; memset(&a, 0, sizeof(a)); a.W = (const bf16*)p; a.K = K; a.pad = 0; return a; }
static void run_naive(const Bufs& B, hipStream_t s, int stage) {
    unsigned char* ws = B.ws;
    switch (stage) {
    case 0: {
        n_xb<<<2048, 256, 0, s>>>(B);
        bf16* wint = (bf16*)(ws + WS_WINT); bf16* wvt = (bf16*)(ws + WS_WVT);
        launch_tr(s, 1024, B.w_in, INW, 0, 2048, 1024, wint, 0);
        launch_tr(s, 1024, B.w_in, INW, 2048, 1024, 1024, wvt, 0);
        launch_tr(s, 1024, B.w_in, INW, 3072, 2048, 1024, wint, 2048);
        launch_tr(s, 1024, B.w_in, INW, 5120, 2048, 1024, wvt, 1024);
        launch_tr(s, 1024, B.w_in, INW, 7168, 4096, 1024, wint, 4096);
        launch_tr(s, 1024, B.w_bsb, 1024, 0, 1024, 1024, (bf16*)(ws + WS_WBSBT), 0);
        launch_tr(s, 1024, B.w_bret, 1024, 0, 1024, 2048, (bf16*)(ws + WS_WBRETT), 0);
        launch_tr(s, 1024, B.w_out, 1024, 0, 1024, 1024, (bf16*)(ws + WS_WOUTT), 0);
        launch_tr(s, 64, B.w_router, 32, 0, 32, 1024, (bf16*)(ws + WS_WRT), 0);
        { Tr2Args a; memset(&a, 0, sizeof(a)); a.src = B.w_gu; a.dst = (bf16*)(ws + WS_WGUT); n_tr_gu<<<4096, 256, 0, s>>>(a); }
        { Tr2Args a; memset(&a, 0, sizeof(a)); a.src = B.w_dn; a.dst = (bf16*)(ws + WS_WDT); n_tr_dn<<<4096, 256, 0, s>>>(a); }
        n_rope<<<1024, 256, 0, s>>>(B);
    } break;
    case 1: {
        BF_inproj bf; memset(&bf, 0, sizeof(bf)); bf.wint = (const bf16*)(ws + WS_WINT); bf.wvt = (const bf16*)(ws + WS_WVT); EF_inproj ef{B};
        launch_ngemm<1>(s, NTOK, INW, 1024, mk_rows((unsigned char*)B.out + DO_XB, 1024), bf, ef);
        n_rotary<<<4096, 256, 0, s>>>(B);
    } break;
    case 2: n_attn<<<BATCH * SBH * SEQ / 64, 64, 0, s>>>(B);
        if (OPT_MASK & 1) { { Tr2Args a; memset(&a, 0, sizeof(a)); a.src = B.w_gu; a.dst = (bf16*)(ws + WS_WGUT); n_tr_gu<<<4096, 256, 0, s>>>(a); }
                            { Tr2Args a; memset(&a, 0, sizeof(a)); a.src = B.w_dn; a.dst = (bf16*)(ws + WS_WDT); n_tr_dn<<<4096, 256, 0, s>>>(a); } }
        break;
    case 3: n_scan<<<BATCH * RH * RDV, 64, 0, s>>>(B); break;
    case 4: n_intra<<<BATCH * RH * NCHUNK, 256, 0, s>>>(B); break;
    case 5: {
        { EF_m1 ef{B}; launch_ngemm<1>(s, NTOK, 1024, 1024, mk_rows(ws + WS_QSB, 1024), mk_wt(ws + WS_WBSBT, 1024), ef); }
        { EF_mg ef{B}; launch_ngemm<1>(s, NTOK, 1024, 2048, mk_rows((unsigned char*)B.out + DO_R, 2048), mk_wt(ws + WS_WBRETT, 2048), ef); }
    } break;
    case 6: { EF_pre ef{B}; launch_ngemm<1>(s, NTOK, 1024, 1024, mk_rows(ws + WS_MG, 1024), mk_wt(ws + WS_WOUTT, 1024), ef); } break;
    case 7: n_ln1<<<NTOK / 4, 256, 0, s>>>(B); n_router<<<NTOK / 64, 64, 0, s>>>(B); break;
    case 8: { n_tstart<<<1, 64, 0, s>>>(B); n_rowinfo<<<544, 256, 0, s>>>(B); AF_gather af{B}; BF_gu bf{B}; EF_gu ef{B}; launch_ngemm<2>(s, MAXROWS, 1024, 1024, af, bf, ef); } break;
    case 9: { n_tstart<<<1, 64, 0, s>>>(B); n_rowinfo<<<544, 256, 0, s>>>(B); AF_act af{B}; BF_dn bf{B}; EF_dn ef{B}; launch_ngemm<1>(s, MAXROWS, 1024, 1024, af, bf, ef); } break;
    case 10: n_final<<<NTOK / 4, 256, 0, s>>>(B); break;
    }
}
static void run_mega(const Bufs& B, hipStream_t s, int lo, int hi) {
    MArgs a; memset(&a, 0, sizeof(a)); a.B = B; a.ph_lo = lo; a.ph_hi = hi;
    hipLaunchKernelGGL(mega_fwd, dim3(256), dim3(NWAVES * 64), LDS_BYTES, s, a);
}

extern "C" void kernel_launch(void* const* d_in, const int* in_sizes, int n_in, void* d_out, int out_size, void* d_ws, size_t ws_size, hipStream_t stream) {
    if (n_in != 15 || out_size != NTOK * DM || ws_size < WS_END) { fprintf(stderr, "kernel_launch: unexpected shapes (n_in %d out %d ws %zu)\n", n_in, out_size, ws_size); return; }
    static int inited = 0;
    if (!inited) { inited = 1;
        if (hipFuncSetAttribute((const void*)mega_fwd, hipFuncAttributeMaxDynamicSharedMemorySize, LDS_BYTES) != hipSuccess) fprintf(stderr, "kernel_launch: hipFuncSetAttribute failed\n");
        int dev = 0, cus = 0; (void)hipGetDevice(&dev); (void)hipDeviceGetAttribute(&cus, hipDeviceAttributeMultiprocessorCount, dev);
        if (cus != 256) fprintf(stderr, "kernel_launch: built for 256 CUs, device has %d\n", cus);
        (void)hipGetLastError(); }
    Bufs B; memset(&B, 0, sizeof(B));
    B.x = (const float*)d_in[0]; B.w_in = (const float*)d_in[1]; B.w_bsb = (const float*)d_in[2]; B.w_bret = (const float*)d_in[3]; B.w_out = (const float*)d_in[4];
    B.ln1_g = (const float*)d_in[5]; B.ln1_b = (const float*)d_in[6]; B.w_router = (const float*)d_in[7]; B.b_router = (const float*)d_in[8];
    B.w_gu = (const float*)d_in[9]; B.b_gu = (const float*)d_in[10]; B.w_dn = (const float*)d_in[11]; B.b_dn = (const float*)d_in[12]; B.ln2_g = (const float*)d_in[13]; B.ln2_b = (const float*)d_in[14];
    B.out = (float*)d_out; B.ws = (unsigned char*)d_ws;
    (void)hipMemsetAsync((char*)d_ws + WS_CTL, 0, CTL_ZERO_BYTES, stream);
    if ((OPT_MASK & 0x7FF) == 0x7FF && ONE_LAUNCH) { run_mega(B, stream, 0, NPHASE); return; }
    for (int st = 0; st < NPHASE; ++st) { if ((OPT_MASK >> st) & 1) run_mega(B, stream, st, st + 1); else run_naive(B, stream, st);
#ifdef PROBE_DUP
        if (st == PROBE_DUP) {
            if (st == 2) { run_mega(B, stream, 1, 2); run_mega(B, stream, 2, 3); }
            else if (st == 4) { run_mega(B, stream, 3, 4); run_mega(B, stream, 4, 5); }
            else if (st == 7) { (void)hipMemsetAsync((char*)d_ws + WS_CTL, 0, CTL_ZERO_BYTES, stream); run_mega(B, stream, 6, 7); run_mega(B, stream, 7, 8); }
            else if (st == 10) { (void)hipMemsetAsync((char*)d_ws + WS_CTL, 0, CTL_ZERO_BYTES, stream); run_mega(B, stream, 6, 7); run_mega(B, stream, 7, 8); run_mega(B, stream, 10, 11); }
            else run_mega(B, stream, st, st + 1);
        }
#endif
    }
}
```

```cpp
#include <hip/hip_runtime.h>
#include <cstdio>
#include <cstdint>
#include <cstring>

constexpr int BATCH = 4, SEQ = 8192, DM = 1024, NTOK = BATCH * SEQ;
constexpr int SBH = 16, SBD = 64;
constexpr int RH = 4, RDK = 256, RDV = 512, RQK = RH * RDK  , RV = RH * RDV  ;
constexpr int CHUNK = 64, NCHUNK = SEQ / CHUNK;
constexpr int INW = 11264;
constexpr int NEXP = 32, TOPK = 4, DFF = 1024;
constexpr int CAP = NTOK;
constexpr int MAXROWS = NTOK * TOPK + NEXP * 256;
constexpr float LN_EPS = 1e-5f;
constexpr float DN_ALPHA = 1.18920711500272106672f;
constexpr float LOG2E = 1.4426950408889634f;
constexpr float SB_C2 = 0.125f * LOG2E;

typedef unsigned short bf16;
typedef float f32x4 __attribute__((ext_vector_type(4)));
typedef float f32x16 __attribute__((ext_vector_type(16)));
typedef short bf16x8 __attribute__((ext_vector_type(8)));
typedef short bf16x4 __attribute__((ext_vector_type(4)));
typedef unsigned u32x4 __attribute__((ext_vector_type(4)));
typedef unsigned u32x2 __attribute__((ext_vector_type(2)));

__host__ __device__ __forceinline__ float bf2f(bf16 v) { unsigned u = (unsigned)v << 16; return __builtin_bit_cast(float, u); }
__host__ __device__ __forceinline__ bf16 f2bf(float f) { unsigned u = __builtin_bit_cast(unsigned, f); return (bf16)((u + 0x7fffu + ((u >> 16) & 1u)) >> 16); }
__device__ __forceinline__ unsigned pk2(float lo, float hi) { return (unsigned)f2bf(lo) | ((unsigned)f2bf(hi) << 16); }

#ifndef MOE_FP8
#define MOE_FP8 1
#endif
constexpr float MOE_WSCALE = 64.0f, MOE_DESCALE = MOE_FP8 ? 1.0f / 64.0f : 1.0f;
__device__ __forceinline__ unsigned pk4_fp8(float a, float b, float c, float d) { int w = 0; w = __builtin_amdgcn_cvt_pk_fp8_f32(a, b, w, false); w = __builtin_amdgcn_cvt_pk_fp8_f32(c, d, w, true); return (unsigned)w; }

constexpr size_t MiB = 1u << 20;
constexpr size_t WS_CTL = 0, CTL_ZERO_BYTES = 1 * MiB;
constexpr size_t WS_COS = 1 * MiB, WS_SIN = 5 * MiB;
constexpr size_t WS_WRT = 9 * MiB;
constexpr size_t WS_TSTART = 9 * MiB + 512 * 1024;
constexpr size_t WS_WINT = 10 * MiB;
constexpr size_t WS_WVT = 26 * MiB;
constexpr size_t WS_WBSBT = 32 * MiB, WS_WBRETT = 34 * MiB, WS_WOUTT = 38 * MiB;
constexpr size_t WS_WGUT = 40 * MiB;
constexpr size_t WS_WDT = 168 * MiB;
constexpr size_t WS_QSB = 232 * MiB;
constexpr size_t WS_KSB = 296 * MiB;
constexpr size_t WS_VSBT = 360 * MiB;
constexpr size_t WS_YINT = 296 * MiB;
constexpr size_t WS_QR = 424 * MiB, WS_KR = 488 * MiB;
constexpr size_t WS_VRT = 552 * MiB;
constexpr size_t WS_SG = 680 * MiB;
constexpr size_t WS_GSB = 808 * MiB, WS_GRET = 872 * MiB;
constexpr size_t WS_SELE = 936 * MiB, WS_SELW = 937 * MiB;
constexpr size_t WS_ROWTK = 940 * MiB, WS_ROWW = 944 * MiB;
constexpr size_t WS_RINFO = 948 * MiB;
constexpr size_t WS_M1 = 424 * MiB, WS_MG = 488 * MiB;
constexpr size_t WS_X1B = 552 * MiB;
constexpr size_t WS_ACT = 616 * MiB;
constexpr size_t WS_OUTR = 232 * MiB;
constexpr size_t WS_END = 1024 * MiB;
static_assert(WS_ACT + (size_t)MAXROWS * 1024 * 2 <= WS_SELE, "ACT fits");
static_assert(WS_OUTR + (size_t)NTOK * 4 * 1024 * 2 <= WS_MG, "OUTR fits below MG");
constexpr size_t DO_XB = 0, DO_KRT = 64 * MiB;

__host__ __device__ __forceinline__ size_t krt_idx(int bh, int t, int d) { return ((((size_t)bh * 128 + (t >> 6)) * 4 + ((t >> 4) & 3)) * 256 + d) * 16 + (t & 15); }
__host__ __device__ __forceinline__ size_t vrt_idx(int bh, int t, int v) { return ((((size_t)bh * 128 + (t >> 6)) * 4 + ((t >> 4) & 3)) * 512 + v) * 16 + (t & 15); }
__host__ __device__ __forceinline__ size_t qrs_idx(int bh, int t, int d) { return ((((size_t)bh * 128 + (t >> 6)) * 16 + (d >> 4)) * 64 + (t & 63)) * 16 + (d & 15); }
__host__ __device__ __forceinline__ size_t yt_idx(int bh, int t, int v) { return ((((size_t)bh * 128 + (t >> 6)) * 64 + (v >> 3)) * 64 + (t & 63)) * 8 + (v & 7); }
__host__ __device__ __forceinline__ size_t ksb_idx(int bh, int t, int d) { return ((((size_t)bh * 256 + (t >> 5)) * 4 + (d >> 4)) * 32 + (t & 31)) * 16 + (d & 15); }
__host__ __device__ __forceinline__ size_t vsb_idx(int bh, int t, int d) { return (((size_t)bh * 512 + (t >> 4)) * 64 + d) * 16 + (t & 15); }
constexpr size_t WS_X1B8 = 888 * MiB;
constexpr size_t WS_QRS = 952 * MiB;
constexpr size_t DO_R = 0;
static_assert(WS_QRS + 64 * MiB <= WS_END, "QRS fits");

constexpr int CW_TMO = 0, CW_CODE = 1;
constexpr int CW_BAR = 4096;
constexpr int CW_CNT = 16384;

struct Bufs {
    const float *x, *w_in, *w_bsb, *w_bret, *w_out, *ln1_g, *ln1_b, *w_router, *b_router, *w_gu, *b_gu, *w_dn, *b_dn, *ln2_g, *ln2_b;
    float* out; unsigned char* ws;
};
#define WSP(T, off) ((T*)(B.ws + (off)))
#define DOP(T, off) ((T*)((unsigned char*)B.out + (off)))

__global__ void n_xb(Bufs B) {
    const size_t n = (size_t)NTOK * DM; bf16* xb = DOP(bf16, DO_XB);
    for (size_t i = (size_t)blockIdx.x * blockDim.x + threadIdx.x; i < n; i += (size_t)gridDim.x * blockDim.x) xb[i] = f2bf(B.x[i]);
}
struct TrArgs { const float* src; bf16* dst; int lds, c0, width, K, r0, pad; };
__global__ void n_tr(TrArgs a) {
    const float* src = a.src; bf16* dst = a.dst; const int lds = a.lds, c0 = a.c0, width = a.width, K = a.K, r0 = a.r0;
    const size_t n = (size_t)width * K;
    for (size_t i = (size_t)blockIdx.x * blockDim.x + threadIdx.x; i < n; i += (size_t)gridDim.x * blockDim.x) {
        const int k = (int)(i % K), c = (int)(i / K); dst[(size_t)(r0 + c) * K + k] = f2bf(src[(size_t)k * lds + c0 + c]); }
}
struct Tr2Args { const float* src; bf16* dst; };
__global__ void n_tr_gu(Tr2Args a) { const float* src = a.src; bf16* dst = a.dst;
    const size_t n = (size_t)NEXP * 2048 * 1024;
    for (size_t i = (size_t)blockIdx.x * blockDim.x + threadIdx.x; i < n; i += (size_t)gridDim.x * blockDim.x) {
        const int k = (int)(i % 1024); const int r = (int)((i / 1024) % 2048); const int e = (int)(i / (1024 * 2048));
        const int ct = r >> 8, bj = (r >> 7) & 1, ii = r & 127; const int c = bj * 1024 + 128 * ct + ii;
        dst[i] = f2bf(src[((size_t)e * 1024 + k) * 2048 + c]); }
}
__global__ void n_tr_dn(Tr2Args a) { const float* src = a.src; bf16* dst = a.dst;
    const size_t n = (size_t)NEXP * 1024 * 1024;
    for (size_t i = (size_t)blockIdx.x * blockDim.x + threadIdx.x; i < n; i += (size_t)gridDim.x * blockDim.x) {
        const int ff = (int)(i % 1024); const int d = (int)((i / 1024) % 1024); const int e = (int)(i / (1024 * 1024));
        dst[i] = f2bf(src[((size_t)e * 1024 + ff) * 1024 + d]); }
}
__device__ __forceinline__ float rope_inv_freq(int j) { return powf(10000.0f, -(float)j / 128.0f); }
__global__ void n_rope(Bufs B) {
    float* c = WSP(float, WS_COS); float* s = WSP(float, WS_SIN);
    for (int i = blockIdx.x * blockDim.x + threadIdx.x; i < SEQ * 128; i += gridDim.x * blockDim.x) {
        const int pos = i >> 7, j = i & 127; const float ang = (float)pos * rope_inv_freq(j);
        c[i] = (float)cos((double)ang); s[i] = (float)sin((double)ang); }
}

template <class AF, class BF, class EF> struct GArgs { AF af; BF bf; EF ef; int M, N, K, pad; };
template <int NB, class AF, class BF, class EF>
__global__ void __launch_bounds__(256) ngemm(GArgs<AF, BF, EF> ga) {
    const AF& af = ga.af; const BF& bf = ga.bf; const EF& ef = ga.ef; const int K = ga.K;
    __shared__ float As[16][65], Bs[NB][16][65];
    const int tx = threadIdx.x & 15, ty = threadIdx.x >> 4;
    const int m0 = blockIdx.y * 64, n0 = blockIdx.x * 64;
    if (!af.active(m0)) return;
    float acc[NB][4][4];
#pragma unroll
    for (int b = 0; b < NB; ++b)
#pragma unroll
        for (int i = 0; i < 4; ++i)
#pragma unroll
            for (int j = 0; j < 4; ++j) acc[b][i][j] = 0.f;
    for (int k0 = 0; k0 < K; k0 += 16) {
#pragma unroll
        for (int i = 0; i < 4; ++i) { const int idx = threadIdx.x + 256 * i; const int kk = idx & 15, mm = idx >> 4; As[kk][mm] = af(m0 + mm, k0 + kk); }
#pragma unroll
        for (int b = 0; b < NB; ++b)
#pragma unroll
            for (int i = 0; i < 4; ++i) { const int idx = threadIdx.x + 256 * i; const int kk = idx & 15, nn = idx >> 4; Bs[b][kk][nn] = bf(m0, k0 + kk, n0 + nn, b); }
        __syncthreads();
#pragma unroll
        for (int kk = 0; kk < 16; ++kk) {
            float a[4];
#pragma unroll
            for (int i = 0; i < 4; ++i) a[i] = As[kk][ty * 4 + i];
#pragma unroll
            for (int b = 0; b < NB; ++b) {
                float bb[4];
#pragma unroll
                for (int j = 0; j < 4; ++j) bb[j] = Bs[b][kk][tx * 4 + j];
#pragma unroll
                for (int i = 0; i < 4; ++i)
#pragma unroll
                    for (int j = 0; j < 4; ++j) acc[b][i][j] += a[i] * bb[j];
            }
        }
        __syncthreads();
    }
#pragma unroll
    for (int i = 0; i < 4; ++i)
#pragma unroll
        for (int j = 0; j < 4; ++j) {
            float v[NB];
#pragma unroll
            for (int b = 0; b < NB; ++b) v[b] = acc[b][i][j];
            ef(m0 + ty * 4 + i, n0 + tx * 4 + j, v);
        }
}

__device__ __forceinline__ float sigmoidf_(float x) { return 1.0f / (1.0f + __expf(-x)); }
__device__ __forceinline__ float ret_log2gamma(int h) { return log2f(1.0f - exp2f(-5.0f - (float)h)); }

struct AF_rows { const bf16* A; int ld, pad; __device__ bool active(int) const { return true; } __device__ float operator()(int m, int k) const { return bf2f(A[(size_t)m * ld + k]); } };
struct BF_inproj { const bf16 *wint, *wvt;
    __device__ float operator()(int, int k, int n, int) const {
        const bf16* row;
        if (n < 2048) row = wint + (size_t)n * 1024;
        else if (n < 3072) row = wvt + (size_t)(n - 2048) * 1024;
        else if (n < 5120) row = wint + (size_t)(2048 + n - 3072) * 1024;
        else if (n < 7168) row = wvt + (size_t)(1024 + n - 5120) * 1024;
        else row = wint + (size_t)(4096 + n - 7168) * 1024;
        return bf2f(row[k]); } };
struct EF_inproj { Bufs B;
    __device__ void operator()(int m, int n, const float (&v)[1]) const {
        const float a = v[0];
        if (n < 1024) WSP(bf16, WS_QSB)[(size_t)m * 1024 + n] = f2bf(a * SB_C2);
        else if (n < 2048) { const int f = n - 1024; WSP(bf16, WS_KSB)[ksb_idx((m >> 13) * 16 + (f >> 6), m & (SEQ - 1), f & 63)] = f2bf(a); }
        else if (n < 3072) { const int f = n - 2048; WSP(bf16, WS_VSBT)[vsb_idx((m >> 13) * 16 + (f >> 6), m & (SEQ - 1), f & 63)] = f2bf(a); }
        else if (n < 4096) WSP(bf16, WS_QR)[(size_t)m * 1024 + n - 3072] = f2bf(a);
        else if (n < 5120) WSP(bf16, WS_KR)[(size_t)m * 1024 + n - 4096] = f2bf(a);
        else if (n < 7168) { const int f = n - 5120, h = f >> 9; const float dec = exp2f((float)(63 - (m & 63)) * ret_log2gamma(h));
            WSP(bf16, WS_VRT)[vrt_idx((m >> 13) * 4 + h, m & (SEQ - 1), f & 511)] = f2bf(a * dec); }
        else if (n < 9216) { const int f = n - 7168; WSP(bf16, WS_SG)[yt_idx((m >> 13) * 4 + (f >> 9), m & (SEQ - 1), f & 511)] = f2bf(a * sigmoidf_(a)); }
        else if (n < 10240) WSP(bf16, WS_GSB)[(size_t)m * 1024 + n - 9216] = f2bf(sigmoidf_(a));
        else WSP(bf16, WS_GRET)[(size_t)m * 1024 + n - 10240] = f2bf(sigmoidf_(a)); } };
__global__ void n_rotary(Bufs B) {
    bf16* qr = WSP(bf16, WS_QR); bf16* kr = WSP(bf16, WS_KR); bf16* krt = DOP(bf16, DO_KRT);
    const float* ct = WSP(float, WS_COS); const float* st = WSP(float, WS_SIN);
    const size_t n = (size_t)NTOK * RH * 128;
    for (size_t i = (size_t)blockIdx.x * blockDim.x + threadIdx.x; i < n; i += (size_t)gridDim.x * blockDim.x) {
        const int j = (int)(i & 127), h = (int)((i >> 7) & 3); const int m = (int)(i >> 9); const int pos = m & (SEQ - 1);
        const float c = ct[pos * 128 + j], s = st[pos * 128 + j];
        const size_t o1 = (size_t)m * 1024 + h * 256 + j, o2 = o1 + 128;
        const int bh = (m >> 13) * 4 + h;
        { const float x1 = bf2f(qr[o1]), x2 = bf2f(qr[o2]); const bf16 r1 = f2bf((x1 * c - x2 * s) * 0.0625f), r2 = f2bf((x1 * s + x2 * c) * 0.0625f); qr[o1] = r1; qr[o2] = r2;
          WSP(bf16, WS_QRS)[qrs_idx(bh, pos, j)] = r1; WSP(bf16, WS_QRS)[qrs_idx(bh, pos, j + 128)] = r2; }
        { const float x1 = bf2f(kr[o1]), x2 = bf2f(kr[o2]); const bf16 r1 = f2bf(x1 * c - x2 * s), r2 = f2bf(x1 * s + x2 * c); kr[o1] = r1; kr[o2] = r2;
          krt[krt_idx(bh, pos, j)] = r1; krt[krt_idx(bh, pos, j + 128)] = r2; }
    }
}

__global__ void __launch_bounds__(64) n_attn(Bufs B) {
    const int gid = blockIdx.x * 64 + threadIdx.x;
    const int t = gid & (SEQ - 1), bh = gid >> 13, h = bh & 15, b = bh >> 4;
    bf16* q = WSP(bf16, WS_QSB); const bf16* k = WSP(bf16, WS_KSB); const bf16* vt = WSP(bf16, WS_VSBT);
    const size_t rb = (size_t)b * SEQ;
    float qv[64], o[64];
#pragma unroll
    for (int d = 0; d < 64; ++d) { qv[d] = bf2f(q[(rb + t) * 1024 + h * 64 + d]); o[d] = 0.f; }
    float later = 0.f;
    for (int s = t - 1; s >= 0; --s) {
        float z2 = 0.f;
#pragma unroll
        for (int d = 0; d < 64; ++d) z2 += qv[d] * bf2f(k[ksb_idx(bh, s, d)]);
        const float z = z2 * 0.6931471805599453f;
        const float sp = fmaxf(z, 0.f) + log1pf(__expf(-fabsf(z)));
        const float a = __expf((z - sp) + later);
        later -= sp;
        if (a > 0.f) {
#pragma unroll
            for (int d = 0; d < 64; ++d) o[d] += a * bf2f(vt[vsb_idx(bh, s, d)]);
        }
    }
#pragma unroll
    for (int d = 0; d < 64; ++d) q[(rb + t) * 1024 + h * 64 + d] = f2bf(o[d]);
}

__global__ void __launch_bounds__(64) n_scan(Bufs B) {
    const int gid = blockIdx.x, v = gid & 511, h = (gid >> 9) & 3, b = gid >> 11, lane = threadIdx.x;
    const bf16* qr = WSP(bf16, WS_QR); const bf16* krt = DOP(bf16, DO_KRT); const bf16* vrt = WSP(bf16, WS_VRT); bf16* yint = WSP(bf16, WS_YINT);
    const float l2g = ret_log2gamma(h), cd = exp2f(64.f * l2g);
    float st[4] = {0.f, 0.f, 0.f, 0.f};
    for (int c = 0; c < NCHUNK; ++c) {
        const size_t tok0 = (size_t)b * SEQ + c * 64;
        for (int i = 0; i < 64; ++i) {
            const bf16* qp = qr + (tok0 + i) * 1024 + h * 256 + 4 * lane;
            float p = bf2f(qp[0]) * st[0] + bf2f(qp[1]) * st[1] + bf2f(qp[2]) * st[2] + bf2f(qp[3]) * st[3];
#pragma unroll
            for (int o = 1; o < 64; o <<= 1) p += __shfl_xor(p, o);
            if (lane == 0) yint[yt_idx(b * 4 + h, c * 64 + i, v)] = f2bf(p * exp2f((float)(i + 1) * l2g));
        }
        float ns[4] = {st[0] * cd, st[1] * cd, st[2] * cd, st[3] * cd};
        for (int j = 0; j < 64; ++j) {
            const float vv = bf2f(vrt[vrt_idx(b * 4 + h, c * 64 + j, v)]);
#pragma unroll
            for (int e = 0; e < 4; ++e) ns[e] += bf2f(krt[krt_idx(b * 4 + h, c * 64 + j, 4 * lane + e)]) * vv;
        }
#pragma unroll
        for (int e = 0; e < 4; ++e) st[e] = ns[e];
    }
}

__global__ void __launch_bounds__(256) n_intra(Bufs B) {
    __shared__ float P[64][65]; __shared__ float Y[8][512]; __shared__ float stat[8][2];
    const int gid = blockIdx.x, c = gid & 127, h = (gid >> 7) & 3, b = gid >> 9, tid = threadIdx.x;
    const bf16* qr = WSP(bf16, WS_QR); const bf16* kr = WSP(bf16, WS_KR); const bf16* vrt = WSP(bf16, WS_VRT); const bf16* sg = WSP(bf16, WS_SG); const bf16* yr = WSP(bf16, WS_YINT); bf16* rout = DOP(bf16, DO_R);
    const size_t tok0 = (size_t)b * SEQ + c * 64; const float l2g = ret_log2gamma(h);
    for (int e = tid; e < 4096; e += 256) { const int i = e >> 6, j = e & 63; float s = 0.f;
        const bf16* qp = qr + (tok0 + i) * 1024 + h * 256; const bf16* kp = kr + (tok0 + j) * 1024 + h * 256;
        for (int d = 0; d < 256; ++d) s += bf2f(qp[d]) * bf2f(kp[d]);
        const int ad = i > j ? i - j : j - i; P[i][j] = s * exp2f((float)(ad - 63 + j) * l2g); }
    __syncthreads();
    for (int i0 = 0; i0 < 64; i0 += 8) {
        for (int vv = tid; vv < 512; vv += 256) {
            float acc[8] = {0.f, 0.f, 0.f, 0.f, 0.f, 0.f, 0.f, 0.f};
            for (int j = 0; j < 64; ++j) { const float x = bf2f(vrt[vrt_idx(b * 4 + h, c * 64 + j, vv)]);
#pragma unroll
                for (int r = 0; r < 8; ++r) acc[r] += P[i0 + r][j] * x; }
#pragma unroll
            for (int r = 0; r < 8; ++r) Y[r][vv] = acc[r] + bf2f(yr[yt_idx(b * 4 + h, c * 64 + i0 + r, vv)]);
        }
        __syncthreads();
        { const int w = tid >> 6, lane = tid & 63;
          for (int r = w; r < 8; r += 4) { float s = 0.f, s2 = 0.f;
              for (int vv = lane; vv < 512; vv += 64) { const float x = Y[r][vv]; s += x; }
#pragma unroll
              for (int o = 1; o < 64; o <<= 1) s += __shfl_xor(s, o);
              const float mean = s * (1.f / 512.f);
              for (int vv = lane; vv < 512; vv += 64) { const float x = Y[r][vv] - mean; s2 += x * x; }
#pragma unroll
              for (int o = 1; o < 64; o <<= 1) s2 += __shfl_xor(s2, o);
              if (lane == 0) { stat[r][0] = mean; stat[r][1] = rsqrtf(s2 * (1.f / 512.f) + LN_EPS); } } }
        __syncthreads();
        for (int e = tid; e < 8 * 512; e += 256) { const int r = e >> 9, vv = e & 511; const size_t o = (tok0 + i0 + r) * 2048 + h * 512 + vv;
            rout[o] = f2bf(bf2f(sg[yt_idx(b * 4 + h, c * 64 + i0 + r, vv)]) * (Y[r][vv] - stat[r][0]) * stat[r][1]); }
        __syncthreads();
    }
}

struct BF_wt { const bf16* W; int K, pad; __device__ float operator()(int, int k, int n, int) const { return bf2f(W[(size_t)n * K + k]); } };
struct EF_m1 { Bufs B; __device__ void operator()(int m, int n, const float (&v)[1]) const { const size_t o = (size_t)m * 1024 + n; WSP(bf16, WS_M1)[o] = f2bf(bf2f(WSP(bf16, WS_GSB)[o]) * v[0]); } };
struct EF_mg { Bufs B; __device__ void operator()(int m, int n, const float (&v)[1]) const { const size_t o = (size_t)m * 1024 + n; WSP(bf16, WS_MG)[o] = f2bf(bf2f(WSP(bf16, WS_M1)[o]) + bf2f(WSP(bf16, WS_GRET)[o]) * v[0]); } };
struct EF_pre { Bufs B; __device__ void operator()(int m, int n, const float (&v)[1]) const { const size_t o = (size_t)m * 1024 + n; B.out[o] = DN_ALPHA * B.x[o] + v[0]; } };

__device__ __forceinline__ float wave_sum(float v) {
#pragma unroll
    for (int o = 1; o < 64; o <<= 1) v += __shfl_xor(v, o);
    return v;
}
__global__ void __launch_bounds__(256) n_ln1(Bufs B) {
    const int row = blockIdx.x * 4 + (threadIdx.x >> 6), lane = threadIdx.x & 63;
    float* p = B.out + (size_t)row * 1024; bf16* xb = WSP(bf16, WS_X1B) + (size_t)row * 1024;
    float v[16]; float s = 0.f;
#pragma unroll
    for (int j = 0; j < 16; ++j) { v[j] = p[lane + 64 * j]; s += v[j]; }
    const float mean = wave_sum(s) * (1.f / 1024.f); float s2 = 0.f;
#pragma unroll
    for (int j = 0; j < 16; ++j) { v[j] -= mean; s2 += v[j] * v[j]; }
    const float rstd = rsqrtf(wave_sum(s2) * (1.f / 1024.f) + LN_EPS);
#pragma unroll
    for (int j = 0; j < 16; ++j) { const int c = lane + 64 * j; const float y = v[j] * rstd * B.ln1_g[c] + B.ln1_b[c]; p[c] = y; xb[c] = f2bf(y); }
}
__global__ void __launch_bounds__(64) n_router(Bufs B) {
    const int tok = blockIdx.x * 64 + threadIdx.x;
    const bf16* xb = WSP(bf16, WS_X1B) + (size_t)tok * 1024; const bf16* wr = WSP(bf16, WS_WRT);
    float lg[32];
#pragma unroll
    for (int e = 0; e < 32; ++e) lg[e] = 0.f;
    for (int k = 0; k < 1024; ++k) { const float xv = bf2f(xb[k]);
#pragma unroll
        for (int e = 0; e < 32; ++e) lg[e] += xv * bf2f(wr[e * 1024 + k]); }
#pragma unroll
    for (int e = 0; e < 32; ++e) lg[e] += B.b_router[e];
    int se[4]; float sv[4];
#pragma unroll
    for (int kk = 0; kk < 4; ++kk) { float best = -INFINITY; int bi = 0;
#pragma unroll
        for (int e = 0; e < 32; ++e) { if (lg[e] > best) { best = lg[e]; bi = e; } }
        se[kk] = bi; sv[kk] = best;
#pragma unroll
        for (int e = 0; e < 32; ++e) if (e == bi) lg[e] = -INFINITY; }
    const float e1 = __expf(sv[1] - sv[0]), e2 = __expf(sv[2] - sv[0]), e3 = __expf(sv[3] - sv[0]); const float inv = 1.f / (1.f + e1 + e2 + e3);
    const float w[4] = {inv, e1 * inv, e2 * inv, e3 * inv};
    unsigned* cnt = WSP(unsigned, WS_CTL) + CW_CNT;
#pragma unroll
    for (int kk = 0; kk < 4; ++kk) { WSP(int, WS_SELE)[tok * 4 + kk] = se[kk]; WSP(float, WS_SELW)[tok * 4 + kk] = w[kk];
        const unsigned pos = atomicAdd(cnt + 64 * se[kk], 1u);
        WSP(int, WS_ROWTK)[(size_t)se[kk] * CAP + pos] = tok * 4 + kk; WSP(float, WS_ROWW)[(size_t)se[kk] * CAP + pos] = w[kk]; }
}
__global__ void n_tstart(Bufs B) {
    if (threadIdx.x == 0 && blockIdx.x == 0) { int* ts = WSP(int, WS_TSTART); const unsigned* cnt = WSP(unsigned, WS_CTL) + CW_CNT; int acc = 0;
        for (int e = 0; e < NEXP; ++e) { ts[e] = acc; acc += (int)((cnt[64 * e] + 255u) >> 8); } ts[NEXP] = acc; }
}
struct MoeRow { int e, valid, tk; float w; };
__global__ void n_rowinfo(Bufs B) {
    const int* ts = WSP(int, WS_TSTART); const unsigned* cnt = WSP(unsigned, WS_CTL) + CW_CNT; MoeRow* ri = WSP(MoeRow, WS_RINFO);
    for (int m = blockIdx.x * blockDim.x + threadIdx.x; m < MAXROWS; m += gridDim.x * blockDim.x) {
        MoeRow r; const int rt = m >> 8; int e = 0;
        while (e < NEXP - 1 && rt >= ts[e + 1]) ++e;
        const int pos = m - 256 * ts[e];
        r.e = e; r.valid = (rt < ts[NEXP]) && (pos < (int)cnt[64 * e]);
        r.tk = r.valid ? WSP(int, WS_ROWTK)[(size_t)e * CAP + pos] : 0; r.w = r.valid ? WSP(float, WS_ROWW)[(size_t)e * CAP + pos] : 0.f; ri[m] = r; }
}
struct AF_gather { Bufs B; __device__ bool active(int m0) const { return (m0 >> 8) < WSP(int, WS_TSTART)[NEXP]; }
    __device__ float operator()(int m, int k) const { const int tk = WSP(MoeRow, WS_RINFO)[m].tk; return bf2f(WSP(bf16, WS_X1B)[(size_t)(tk >> 2) * 1024 + k]); } };
struct BF_gu { Bufs B; __device__ float operator()(int m0, int k, int n, int which) const { const int e = WSP(MoeRow, WS_RINFO)[m0].e;
        const int ct = n >> 7, i = n & 127; return bf2f(WSP(bf16, WS_WGUT)[((size_t)e * 2048 + 256 * ct + 128 * which + i) * 1024 + k]); } };
__device__ __forceinline__ float moe_act(float g, float u) {
    g = fminf(g, 7.0f); u = fminf(fmaxf(u, -7.0f), 7.0f); const float glu = g * (1.0f / (1.0f + __expf(-1.702f * g))); return (u + 1.0f) * glu; }
struct EF_gu { Bufs B; __device__ void operator()(int m, int n, const float (&v)[2]) const { const MoeRow r = WSP(MoeRow, WS_RINFO)[m]; if (!r.valid) return;
        const float g = v[0] + B.b_gu[r.e * 2048 + n], u = v[1] + B.b_gu[r.e * 2048 + 1024 + n]; WSP(bf16, WS_ACT)[(size_t)m * 1024 + n] = f2bf(moe_act(g, u)); } };
struct AF_act { Bufs B; __device__ bool active(int m0) const { return (m0 >> 8) < WSP(int, WS_TSTART)[NEXP]; }
    __device__ float operator()(int m, int k) const { return WSP(MoeRow, WS_RINFO)[m].valid ? bf2f(WSP(bf16, WS_ACT)[(size_t)m * 1024 + k]) : 0.f; } };
struct BF_dn { Bufs B; __device__ float operator()(int m0, int k, int n, int) const { const int e = WSP(MoeRow, WS_RINFO)[m0].e; return bf2f(WSP(bf16, WS_WDT)[((size_t)e * 1024 + n) * 1024 + k]); } };
struct EF_dn { Bufs B; __device__ void operator()(int m, int n, const float (&v)[1]) const { const MoeRow r = WSP(MoeRow, WS_RINFO)[m]; if (!r.valid) return;
        WSP(bf16, WS_OUTR)[(size_t)r.tk * 1024 + n] = f2bf((v[0] + B.b_dn[r.e * 1024 + n]) * r.w); } };
__global__ void __launch_bounds__(256) n_final(Bufs B) {
    const int row = blockIdx.x * 4 + (threadIdx.x >> 6), lane = threadIdx.x & 63;
    float* p = B.out + (size_t)row * 1024; const bf16* orow = WSP(bf16, WS_OUTR) + (size_t)row * 4 * 1024;
    float v[16]; float s = 0.f;
#pragma unroll
    for (int j = 0; j < 16; ++j) { const int c = lane + 64 * j; float a = DN_ALPHA * bf2f(WSP(bf16, WS_X1B)[(size_t)row * 1024 + c]);
#pragma unroll
        for (int kk = 0; kk < 4; ++kk) a += bf2f(orow[kk * 1024 + c]);
        v[j] = a; s += a; }
    const float mean = wave_sum(s) * (1.f / 1024.f); float s2 = 0.f;
#pragma unroll
    for (int j = 0; j < 16; ++j) { v[j] -= mean; s2 += v[j] * v[j]; }
    const float rstd = rsqrtf(wave_sum(s2) * (1.f / 1024.f) + LN_EPS);
#pragma unroll
    for (int j = 0; j < 16; ++j) { const int c = lane + 64 * j; p[c] = v[j] * rstd * B.ln2_g[c] + B.ln2_b[c]; }
}

__device__ __forceinline__ int lane_id() { int l; asm volatile("v_mbcnt_lo_u32_b32 %0, -1, 0\n\tv_mbcnt_hi_u32_b32 %0, -1, %0" : "=v"(l)); return l; }
namespace pg8 {
#define PG8_LAS __attribute__((address_space(3)))
constexpr int BM = 256, BK = 64, HALF = 128, HTB = HALF * BK * 2  , STAGE_BYTES = 8 * HTB, NXCD = 8, WGM = 8;
__host__ __device__ __forceinline__ int lds_byte(int r, int c) { const int st = (r >> 4) * 2 + (c >> 5), rr = r & 15, cc = c & 31, ob = rr * 64 + cc * 2; return st * 1024 + (ob ^ (((ob >> 9) & 1) << 5)); }
__host__ __device__ __forceinline__ void stage_rc(int b, int& R, int& C) { const int st = b / 1024, sb = b % 1024, swz = sb ^ (((sb >> 9) & 1) << 5); R = (st >> 1) * 16 + swz / 64; C = (st & 1) * 32 + (swz % 64) / 2; }
__host__ __device__ __forceinline__ int perm32(int rho) { const int n = rho >> 4, i = rho & 15; return 8 * (i >> 2) + 4 * n + (i & 3); }

typedef int v8i_t __attribute__((ext_vector_type(8)));
typedef int v4i_t __attribute__((ext_vector_type(4)));
struct Unit { int pm, pn, e, idx, rbase, nrows; };

struct StaticOrder {
    const char* A; const char* Bt; int nM, nN, nwg, G, c, K;
    __device__ void init(const void* A_, const void* Bt_, int M, int N, int K_, int G_, int c_) { A = (const char*)A_; Bt = (const char*)Bt_; nM = M / BM; nN = N / BM; nwg = nM * nN; G = G_; c = c_; K = K_; }
    __device__ bool next(int i, Unit& u) const {
        const long L = (long)i * G + c; if (L >= nwg) return false;
        int wgid = (int)L; { const int q = nwg / NXCD, r = nwg % NXCD, xcd = wgid % NXCD, off = wgid / NXCD; wgid = (xcd < r ? xcd * (q + 1) : r * (q + 1) + (xcd - r) * q) + off; }
        const int nig = WGM * nN, gid = wgid / nig, fm = gid * WGM, gsz = (nM - fm) < WGM ? (nM - fm) : WGM;
        u.pm = fm + ((wgid % nig) % gsz); u.pn = (wgid % nig) / gsz; u.e = 0; u.idx = i; u.rbase = u.pm * BM; u.nrows = BM; return true;
    }
    __device__ __forceinline__ const char* a_ptr(const Unit& u) const { return A + (size_t)u.pm * BM * K * 2; }
    __device__ __forceinline__ const char* b_ptr(const Unit& u) const { return Bt + (size_t)u.pn * BM * K * 2; }
    __device__ __forceinline__ unsigned a_off(const Unit&, int) const { return 0u; }
    __device__ __forceinline__ void a_ready(const Unit&) const {}
    __device__ __forceinline__ void done(const Unit&) const {}
};

__device__ __forceinline__ unsigned cvt_pk_bf16(float lo, float hi) { unsigned r; asm volatile("v_cvt_pk_bf16_f32 %0, %1, %2" : "=v"(r) : "v"(lo), "v"(hi)); return r; }

__device__ __forceinline__ void mfma8_inplace(f32x4& acc, const v8i_t& w8, const v8i_t& a8, int sc_w, int sc_a) {
    asm volatile("v_mfma_scale_f32_16x16x128_f8f6f4 %0, %1, %2, %0, %3, %4 op_sel_hi:[0,0,0]" : "+v"(acc) : "v"(w8), "v"(a8), "v"(sc_w), "v"(sc_a)); }
template <class Epi, class Sched, bool ALIGN_EPI, bool GATHER, bool FP8 = false>
__device__ __forceinline__ void gemm_phase(PG8_LAS unsigned char* lds, const int K, const Sched& S, const Epi& E, const int wid) {
    int lane_ = lane_id(); asm volatile("" : "+v"(lane_));
    const int lane = lane_, tid = wid * 64 + lane, wr = wid >> 2, wc = wid & 3, fr = lane & 15, fq = lane >> 4;
    constexpr int EB = FP8 ? 1 : 2;
    const int nt = K * EB / 128;
    unsigned voffB[2];
#pragma unroll
    for (int i = 0; i < 2; ++i) { int R, C; stage_rc(tid * 16 + i * 8192, R, C); const int Rb = Epi::PERM ? ((R & ~31) + perm32(R & 31)) : R;
        voffB[i] = (unsigned)(Rb * K * EB + C * 2); }
    const size_t kstep = (size_t)(BK * 2);
    const size_t hstep = (size_t)HALF * K * EB;
    const unsigned ldsw = (unsigned)wid * 1024u;
    const int aoff = lds_byte(wr * 64 + fr, fq * 8), boff = lds_byte(wc * 32 + fr, fq * 8);
#define PG8_SA(b, h) (((b) * 2 + (h)) * HTB)
#define PG8_SB(b, h) ((4 + (b) * 2 + (h)) * HTB)
#define PG8_STAGE(bufoff, gbase, voff) do { _Pragma("unroll") for (int _i = 0; _i < 2; ++_i) \
        __builtin_amdgcn_global_load_lds((const unsigned*)((const char*)(gbase) + (voff)[_i]), (PG8_LAS unsigned*)(lds + (bufoff) + ldsw + _i * 8192), 16, 0, 0); } while (0)
#define PG8_LD8(base) __builtin_shufflevector(*(const PG8_LAS v4i_t*)(lds + (base)), *(const PG8_LAS v4i_t*)(lds + (base) + 1024), 0, 1, 2, 3, 4, 5, 6, 7)
#define PG8_LDA(dst, b, h) do { _Pragma("unroll") for (int m = 0; m < 4; ++m) { if constexpr (FP8) dst##8[m] = PG8_LD8(PG8_SA(b, h) + aoff + m * 2048); else { _Pragma("unroll") for (int k = 0; k < 2; ++k) dst[m][k] = *(const PG8_LAS bf16x8*)(lds + PG8_SA(b, h) + aoff + m * 2048 + k * 1024); } } } while (0)
#define PG8_LDB(dst, b, h) do { _Pragma("unroll") for (int n = 0; n < 2; ++n) { if constexpr (FP8) dst##8[n] = PG8_LD8(PG8_SB(b, h) + boff + n * 2048); else { _Pragma("unroll") for (int k = 0; k < 2; ++k) dst[n][k] = *(const PG8_LAS bf16x8*)(lds + PG8_SB(b, h) + boff + n * 2048 + k * 1024); } } } while (0)
#define PG8_MMA(ai, bj, At, Bt) do { __builtin_amdgcn_s_setprio(1); _Pragma("unroll") for (int m = 0; m < 4; ++m) _Pragma("unroll") for (int n = 0; n < 2; ++n) { \
        if constexpr (FP8) mfma8_inplace(acc[ai][bj][m][n], Bt##8[n], At##8[m], sc_w, sc_a); \
        else { _Pragma("unroll") for (int k = 0; k < 2; ++k) acc[ai][bj][m][n] = __builtin_amdgcn_mfma_f32_16x16x32_bf16(Bt[n][k], At[m][k], acc[ai][bj][m][n], 0, 0, 0); } } \
        __builtin_amdgcn_s_setprio(0); } while (0)
#define PG8_WAIT_V(n) asm volatile("s_waitcnt vmcnt(" #n ")" ::: "memory")
#define PG8_WAIT_L(n) asm volatile("s_waitcnt lgkmcnt(" #n ")" ::: "memory")
#define PG8_BAR __builtin_amdgcn_s_barrier()
#define PG8_SCHED __builtin_amdgcn_sched_barrier(0)
#define PG8_OFFS(dst, u) do { const int _t = wid * 64 + lane_id(); _Pragma("unroll") for (int _i = 0; _i < 2; ++_i) { int _R, _C; stage_rc(_t * 16 + _i * 8192, _R, _C); \
        _Pragma("unroll") for (int _h = 0; _h < 2; ++_h) dst[_h][_i] = GATHER ? (S.a_off(u, _h * HALF + _R) + (unsigned)_C * 2u) : (unsigned)((_h * HALF + _R) * K * EB + _C * 2); } } while (0)
    Unit cur, nxt; int ui = 0;
    if (!S.next(0, cur)) return;
    f32x4 acc[2][2][4][2];
#pragma unroll
    for (int a = 0; a < 2; ++a)
#pragma unroll
        for (int b = 0; b < 2; ++b)
#pragma unroll
            for (int m = 0; m < 4; ++m)
#pragma unroll
                for (int n = 0; n < 2; ++n) acc[a][b][m][n] = (f32x4){0.f, 0.f, 0.f, 0.f};
    const int sc_w = 0x7F7F7F7F, sc_a = sc_w;
    bf16x8 At[4][2], B0[2][2], B1[2][2]; v8i_t At8[4], B08[2], B18[2];
    unsigned offA[2][2];
    PG8_OFFS(offA, cur);
    const char* cA = S.a_ptr(cur); const char* cB = S.b_ptr(cur);
    S.a_ready(cur);
    PG8_STAGE(PG8_SB(0, 0), cB, voffB); PG8_STAGE(PG8_SB(0, 1), cB + hstep, voffB); PG8_STAGE(PG8_SA(0, 0), cA, offA[0]); PG8_STAGE(PG8_SA(0, 1), cA, offA[1]);
    if (wr == 1) PG8_BAR;
    PG8_WAIT_V(2); PG8_BAR;
    PG8_STAGE(PG8_SB(1, 0), cB + kstep, voffB); PG8_STAGE(PG8_SA(1, 0), cA + kstep, offA[0]); PG8_STAGE(PG8_SB(1, 1), cB + hstep + kstep, voffB);
    PG8_WAIT_V(6); PG8_BAR;
    for (;;) {
        const bool has_next = S.next(ui + 1, nxt);
        const char* nA = has_next ? S.a_ptr(nxt) : cA; const char* nB = has_next ? S.b_ptr(nxt) : cB;
        for (int t = 0; t < nt; t += 2) {
            const bool last = (t == nt - 2);
            const char* a1 = cA + (size_t)(t + 1) * kstep;
            const char* a2 = last ? nA : cA + (size_t)(t + 2) * kstep; const char* b2 = last ? nB : cB + (size_t)(t + 2) * kstep;
            const char* a3 = a2 + kstep; const char* b3 = b2 + kstep;
            unsigned o2[2][2];
            if (GATHER && last && has_next) { PG8_OFFS(o2, nxt); }
            else {
#pragma unroll
                for (int h = 0; h < 2; ++h)
#pragma unroll
                    for (int i = 0; i < 2; ++i) o2[h][i] = offA[h][i]; }
            if (last && has_next) S.a_ready(nxt);
            PG8_LDB(B0, 0, 0); PG8_LDB(B1, 0, 1); PG8_SCHED; PG8_LDA(At, 0, 0); PG8_STAGE(PG8_SA(1, 1), a1, offA[1]);
            PG8_WAIT_V(8); PG8_WAIT_L(0); PG8_BAR; PG8_MMA(0, 0, At, B0); PG8_MMA(0, 1, At, B1); PG8_BAR; PG8_SCHED;
            PG8_LDA(At, 0, 1); PG8_STAGE(PG8_SB(0, 0), b2, voffB); PG8_STAGE(PG8_SB(0, 1), b2 + hstep, voffB); PG8_STAGE(PG8_SA(0, 0), a2, o2[0]);
            PG8_WAIT_V(8); PG8_WAIT_L(0); PG8_BAR; PG8_MMA(1, 0, At, B0); PG8_MMA(1, 1, At, B1); PG8_BAR; PG8_SCHED;
            PG8_LDB(B0, 1, 0); PG8_LDB(B1, 1, 1); PG8_SCHED; PG8_LDA(At, 1, 0); PG8_STAGE(PG8_SA(0, 1), a2, o2[1]);
            PG8_WAIT_V(8); PG8_WAIT_L(0); PG8_BAR; PG8_MMA(0, 0, At, B0); PG8_MMA(0, 1, At, B1); PG8_BAR; PG8_SCHED;
            PG8_LDA(At, 1, 1); PG8_STAGE(PG8_SB(1, 0), b3, voffB); PG8_STAGE(PG8_SB(1, 1), b3 + hstep, voffB); PG8_STAGE(PG8_SA(1, 0), a3, o2[0]);
            PG8_WAIT_V(8); PG8_WAIT_L(0); PG8_BAR; PG8_MMA(1, 0, At, B0); PG8_MMA(1, 1, At, B1); PG8_BAR; PG8_SCHED;
        }
        if constexpr (ALIGN_EPI) { if (wr == 0) PG8_BAR; }
        if constexpr (FP8) asm volatile("s_nop 15\n\ts_nop 15" ::: "memory");
        { const int l2 = lane_id();
          E(acc, cur, wr, wc, l2 & 15, l2 >> 4); } S.done(cur);
        if (!has_next) break;
#pragma unroll
        for (int a = 0; a < 2; ++a)
#pragma unroll
            for (int b = 0; b < 2; ++b)
#pragma unroll
                for (int m = 0; m < 4; ++m)
#pragma unroll
                    for (int n = 0; n < 2; ++n) acc[a][b][m][n] = (f32x4){0.f, 0.f, 0.f, 0.f};
        cur = nxt; cA = nA; cB = nB; ++ui;
        if (GATHER) { PG8_OFFS(offA, cur); }
        if constexpr (ALIGN_EPI) { if (wr == 1) PG8_BAR; }
    }
    PG8_WAIT_V(0);
    if constexpr (!ALIGN_EPI) { if (wr == 0) PG8_BAR; }
    PG8_BAR;
#undef PG8_SA
#undef PG8_SB
#undef PG8_STAGE
#undef PG8_LDA
#undef PG8_LD8
#undef PG8_LDB
#undef PG8_MMA
#undef PG8_WAIT_V
#undef PG8_WAIT_L
#undef PG8_BAR
#undef PG8_SCHED
#undef PG8_OFFS
}
}
namespace pg8 {
__device__ __forceinline__ float fsigmoid(float x) { return __builtin_amdgcn_rcpf(1.0f + __builtin_amdgcn_exp2f(-LOG2E * x)); }
__device__ __forceinline__ u32x4 pack8(const f32x4 a, const f32x4 b) { u32x4 w; w.x = cvt_pk_bf16(a[0], a[1]); w.y = cvt_pk_bf16(a[2], a[3]); w.z = cvt_pk_bf16(b[0], b[1]); w.w = cvt_pk_bf16(b[2], b[3]); return w; }
__device__ __forceinline__ void unpack8(const u32x4 w, f32x4& a, f32x4& b) {
    a[0] = __uint_as_float(w.x << 16); a[1] = __uint_as_float(w.x & 0xffff0000u); a[2] = __uint_as_float(w.y << 16); a[3] = __uint_as_float(w.y & 0xffff0000u);
    b[0] = __uint_as_float(w.z << 16); b[1] = __uint_as_float(w.z & 0xffff0000u); b[2] = __uint_as_float(w.w << 16); b[3] = __uint_as_float(w.w & 0xffff0000u); }

struct EpiQK {
    static constexpr bool PERM = true;
    bf16 *qsb, *ksb;
    __device__ __forceinline__ void operator()(const f32x4 (&acc)[2][2][4][2], const Unit& u, int wr, int wc, int fr, int fq) const {
        const int pn = u.pn;
        if (pn < 4) {
            const bf16* ub = qsb + ((size_t)(u.pm * BM + wr * 64)) * 1024 + pn * 256 + wc * 32; const int lo = fr * 1024 + 8 * fq;
#pragma unroll
            for (int ai = 0; ai < 2; ++ai)
#pragma unroll
                for (int m = 0; m < 4; ++m)
#pragma unroll
                    for (int bj = 0; bj < 2; ++bj) *(u32x4*)(ub + (ai * HALF + m * 16) * 1024 + bj * HALF + lo) = pack8(acc[ai][bj][m][0] * SB_C2, acc[ai][bj][m][1] * SB_C2);
        } else {
            const int t0 = (u.pm * BM) & (SEQ - 1), b = (u.pm * BM) >> 13;
            const bf16* ub = ksb + ((((size_t)(b * 16 + 4 * (pn & 3) + (wc >> 1)) * 256 + (t0 >> 5) + 2 * wr) * 4 + 2 * (wc & 1)) * 512);
            const int lo = (fq >> 1) * 512 + fr * 16 + 8 * (fq & 1);
#pragma unroll
            for (int ai = 0; ai < 2; ++ai)
#pragma unroll
                for (int m = 0; m < 4; ++m)
#pragma unroll
                    for (int bj = 0; bj < 2; ++bj) *(u32x4*)(ub + (size_t)(2 * bj) * 256 * 2048 + (4 * ai + (m >> 1)) * 2048 + (m & 1) * 256 + lo) = pack8(acc[ai][bj][m][0], acc[ai][bj][m][1]);
        }
    }
};
struct EpiRot {
    static constexpr bool PERM = true;
    bf16 *qr, *kr, *krt, *qrs; const float *cosT, *sinT;
    __device__ __forceinline__ void operator()(const f32x4 (&acc)[2][2][4][2], const Unit& u, int wr, int wc, int fr, int fq) const {
        const int pn = u.pn; const bool isK = pn >= 4; const int head = pn & 3; const float sc = isK ? 1.0f : 0.0625f;
        const int R0 = u.pm * BM, P0 = R0 & (SEQ - 1), bh = (R0 >> 13) * 4 + head;
        f32x4 c[2], sn[2], dc[2], ds[2], ec[2], es[2];
        { const int tlo = fr * 128 + 8 * fq; const float* cb = cosT + (size_t)(P0 + 64 * wr) * 128 + 32 * wc; const float* sb = sinT + (size_t)(P0 + 64 * wr) * 128 + 32 * wc;
          const float* c16 = cosT + 16 * 128 + 32 * wc; const float* s16 = sinT + 16 * 128 + 32 * wc; const float* c80 = cosT + 80 * 128 + 32 * wc; const float* s80 = sinT + 80 * 128 + 32 * wc;
#pragma unroll
          for (int n = 0; n < 2; ++n) { c[n] = *(const f32x4*)(cb + tlo + 4 * n); sn[n] = *(const f32x4*)(sb + tlo + 4 * n);
              dc[n] = *(const f32x4*)(c16 + 8 * fq + 4 * n); ds[n] = *(const f32x4*)(s16 + 8 * fq + 4 * n); ec[n] = *(const f32x4*)(c80 + 8 * fq + 4 * n); es[n] = *(const f32x4*)(s80 + 8 * fq + 4 * n); } }
        bf16* on = (isK ? kr : qr) + (size_t)(R0 + 64 * wr) * 1024 + head * 256 + 32 * wc; const int lo_n = fr * 1024 + 8 * fq;
        bf16* oq = qrs + (((size_t)bh * 128 + (P0 >> 6) + wr) * 16 + 2 * wc) * 1024; const int lo_q = (fq >> 1) * 1024 + fr * 16 + 8 * (fq & 1);
        bf16* ok = krt + (((size_t)bh * 128 + (P0 >> 6) + wr) * 4) * 4096 + 32 * wc * 16; const int lo_k = 8 * fq * 16 + fr;
#pragma unroll
        for (int ai = 0; ai < 2; ++ai)
#pragma unroll
            for (int m = 0; m < 4; ++m) {
                f32x4 o1[2], o2[2];
#pragma unroll
                for (int n = 0; n < 2; ++n) { const f32x4 x1 = acc[ai][0][m][n], x2 = acc[ai][1][m][n]; o1[n] = (x1 * c[n] - x2 * sn[n]) * sc; o2[n] = (x1 * sn[n] + x2 * c[n]) * sc; }
                if (m < 3) {
#pragma unroll
                    for (int n = 0; n < 2; ++n) { const f32x4 cc = c[n] * dc[n] - sn[n] * ds[n]; sn[n] = sn[n] * dc[n] + c[n] * ds[n]; c[n] = cc; } }
                else if (ai == 0) {
#pragma unroll
                    for (int n = 0; n < 2; ++n) { const f32x4 cc = c[n] * ec[n] - sn[n] * es[n]; sn[n] = sn[n] * ec[n] + c[n] * es[n]; c[n] = cc; } }
                const u32x4 w1 = pack8(o1[0], o1[1]), w2 = pack8(o2[0], o2[1]);
                *(u32x4*)(on + (ai * HALF + m * 16) * 1024 + lo_n) = w1; *(u32x4*)(on + (ai * HALF + m * 16) * 1024 + HALF + lo_n) = w2;
                if (isK) {
                    bf16* tp = ok + (2 * ai * 4 + m) * 4096 + lo_k;
#pragma unroll
                    for (int q = 0; q < 4; ++q) { tp[(2 * q) * 16] = (bf16)(w1[q] & 0xffffu); tp[(2 * q + 1) * 16] = (bf16)(w1[q] >> 16);
                        tp[(HALF + 2 * q) * 16] = (bf16)(w2[q] & 0xffffu); tp[(HALF + 2 * q + 1) * 16] = (bf16)(w2[q] >> 16); }
                } else {
                    *(u32x4*)(oq + (2 * ai * 16) * 1024 + m * 256 + lo_q) = w1; *(u32x4*)(oq + (2 * ai * 16 + 8) * 1024 + m * 256 + lo_q) = w2; }
                asm volatile("" ::: "memory"); }
    }
};
struct EpiGate {
    static constexpr bool PERM = true;
    unsigned char* ws;
    __device__ __forceinline__ void operator()(const f32x4 (&acc)[2][2][4][2], const Unit& u, int wr, int wc, int fr, int fq) const {
        const int pn = u.pn; const int R0 = u.pm * BM, P0 = R0 & (SEQ - 1); const bool silu = pn < 8;
        const size_t ub_s = WS_SG + 2 * ((((size_t)((R0 >> 13) * 4 + (pn >> 1)) * 128 + (P0 >> 6) + wr) * 64 + 32 * (pn & 1) + 4 * wc) * 512);
        const size_t ub_g = WS_GSB + (size_t)(pn >= 12 ? 1 : 0) * (WS_GRET - WS_GSB) + 2 * ((size_t)(R0 + 64 * wr) * 1024 + (pn & 3) * 256 + 32 * wc);
        bf16* ub = (bf16*)(ws + (silu ? ub_s : ub_g));
        const int lo = silu ? fq * 512 + fr * 8 : fr * 1024 + 8 * fq;
        const int SA = silu ? 128 * 512 : HALF * 1024, SM = silu ? 128 : 16 * 1024, SB = silu ? 16 * 512 : HALF;
#pragma unroll
        for (int ai = 0; ai < 2; ++ai)
#pragma unroll
            for (int m = 0; m < 4; ++m) {
#pragma unroll
                for (int bj = 0; bj < 2; ++bj) { f32x4 a = acc[ai][bj][m][0], b = acc[ai][bj][m][1];
#pragma unroll
                    for (int e = 0; e < 4; ++e) { const float sa = fsigmoid(a[e]), sb = fsigmoid(b[e]); a[e] = silu ? a[e] * sa : sa; b[e] = silu ? b[e] * sb : sb; }
                    *(u32x4*)(ub + ai * SA + m * SM + bj * SB + lo) = pack8(a, b);
                    asm volatile("" ::: "memory"); } }
    }
};
struct EpiVT {
    static constexpr bool PERM = true;
    bf16 *vsbt, *vrt;
    __device__ __forceinline__ void operator()(const f32x4 (&acc)[2][2][4][2], const Unit& u, int wr, int wc, int fr, int fq) const {
        const int pm = u.pm; const int C0 = u.pn * BM, T0 = C0 & (SEQ - 1), b = C0 >> 13;
        if (pm < 4) {
            bf16* ub = vsbt + ((((size_t)(b * 16 + 4 * pm + wr) * 512 + (T0 >> 4) + 2 * wc) * 64) * 16); const int lo = ((fq >> 1) * 64 + fr) * 16 + 8 * (fq & 1);
#pragma unroll
            for (int ai = 0; ai < 2; ++ai)
#pragma unroll
                for (int m = 0; m < 4; ++m)
#pragma unroll
                    for (int bj = 0; bj < 2; ++bj) *(u32x4*)(ub + ((size_t)(2 * ai) * 512 * 64 + 8 * bj * 64 + 16 * m) * 16 + lo) = pack8(acc[ai][bj][m][0], acc[ai][bj][m][1]);
        } else {
            const int h = (pm - 4) >> 1; const float l2g = __builtin_amdgcn_logf(1.0f - __builtin_amdgcn_exp2f(-5.0f - (float)h));
            float dec[8];
#pragma unroll
            for (int q = 0; q < 8; ++q) dec[q] = __builtin_amdgcn_exp2f((float)(63 - (((wc & 1) * 32 + 8 * fq + q) & 63)) * l2g);
            bf16* ub = vrt + (((((size_t)(b * 4 + h) * 128 + (T0 >> 6) + (wc >> 1)) * 4 + 2 * (wc & 1)) * 512 + 256 * ((pm - 4) & 1) + 64 * wr) * 16); const int lo = ((fq >> 1) * 512 + fr) * 16 + 8 * (fq & 1);
#pragma unroll
            for (int ai = 0; ai < 2; ++ai)
#pragma unroll
                for (int m = 0; m < 4; ++m)
#pragma unroll
                    for (int bj = 0; bj < 2; ++bj) { f32x4 a = acc[ai][bj][m][0], bb = acc[ai][bj][m][1];
#pragma unroll
                        for (int e = 0; e < 4; ++e) { a[e] *= dec[e]; bb[e] *= dec[4 + e]; }
                        *(u32x4*)(ub + ((size_t)(2 * bj) * 4 * 512 + 128 * ai + 16 * m) * 16 + lo) = pack8(a, bb); }
        }
    }
};
template <int MODE> struct EpiBranch {
    static constexpr bool PERM = true;
    const bf16* gate; const bf16* m1in; bf16* out;
    __device__ __forceinline__ void operator()(const f32x4 (&acc)[2][2][4][2], const Unit& u, int wr, int wc, int fr, int fq) const {
        const size_t uo = (size_t)(u.pm * BM + 64 * wr) * 1024 + u.pn * BM + 32 * wc; const int lo = fr * 1024 + 8 * fq;
        const bf16* gp = gate + uo; const bf16* mp = m1in + uo; bf16* op = out + uo;
#pragma unroll
        for (int ai = 0; ai < 2; ++ai)
#pragma unroll
            for (int m = 0; m < 4; ++m) {
#pragma unroll
                for (int bj = 0; bj < 2; ++bj) { const int co = (ai * HALF + m * 16) * 1024 + bj * HALF + lo; f32x4 ga, gb; unpack8(*(const u32x4*)(gp + co), ga, gb);
                    f32x4 a = acc[ai][bj][m][0] * ga, b = acc[ai][bj][m][1] * gb;
                    if (MODE == 1) { f32x4 pa, pb; unpack8(*(const u32x4*)(mp + co), pa, pb); a += pa; b += pb; }
                    *(u32x4*)(op + co) = pack8(a, b); }
                asm volatile("" ::: "memory"); }
    }
};
struct EpiPre {
    static constexpr bool PERM = false;
    const float* x; float* pre;
    __device__ __forceinline__ void operator()(const f32x4 (&acc)[2][2][4][2], const Unit& u, int wr, int wc, int fr, int fq) const {
        const size_t uo = (size_t)(u.pm * BM + 64 * wr) * 1024 + u.pn * BM + 32 * wc; const int lo = fr * 1024 + 4 * fq;
        const float* xp = x + uo; float* pp = pre + uo;
#pragma unroll
        for (int ai = 0; ai < 2; ++ai)
#pragma unroll
            for (int m = 0; m < 4; ++m) {
#pragma unroll
                for (int bj = 0; bj < 2; ++bj)
#pragma unroll
                    for (int n = 0; n < 2; ++n) { const int co = (ai * HALF + m * 16) * 1024 + bj * HALF + n * 16 + lo; *(f32x4*)(pp + co) = *(const f32x4*)(xp + co) * DN_ALPHA + acc[ai][bj][m][n]; }
                asm volatile("" ::: "memory"); }
    }
};
struct EpiGateUp {
    static constexpr bool PERM = true;
    const float* bgu; bf16* act;
    __device__ __forceinline__ void operator()(const f32x4 (&acc)[2][2][4][2], const Unit& u, int wr, int wc, int fr, int fq) const {
        const float* bp = bgu + (size_t)u.e * 2048 + u.pn * 128 + wc * 32 + 8 * fq;
        bf16* ub = act + (size_t)(u.rbase + 64 * wr) * 1024 + u.pn * 128 + wc * 32; const int lo = fr * 1024 + 8 * fq;
#pragma unroll
        for (int ai = 0; ai < 2; ++ai)
#pragma unroll
            for (int m = 0; m < 4; ++m) { const int rr = ai * HALF + wr * 64 + m * 16 + fr;
                f32x4 bg[2], bu[2];
#pragma unroll
                for (int n = 0; n < 2; ++n) { bg[n] = *(const f32x4*)(bp + 4 * n); bu[n] = *(const f32x4*)(bp + 1024 + 4 * n); }
                f32x4 o[2];
#pragma unroll
                for (int n = 0; n < 2; ++n) { const f32x4 g = acc[ai][0][m][n] * MOE_DESCALE + bg[n], up = acc[ai][1][m][n] * MOE_DESCALE + bu[n];
#pragma unroll
                    for (int e = 0; e < 4; ++e) { const float gg = fminf(g[e], 7.0f), uu = __builtin_amdgcn_fmed3f(up[e], -7.0f, 7.0f);
                        o[n][e] = (uu + 1.0f) * gg * __builtin_amdgcn_rcpf(1.0f + __builtin_amdgcn_exp2f((-1.702f * LOG2E) * gg)); } }
                if (rr < u.nrows) {
#if MOE_FP8
                    u32x2 w8; w8.x = pk4_fp8(o[0][0], o[0][1], o[0][2], o[0][3]); w8.y = pk4_fp8(o[1][0], o[1][1], o[1][2], o[1][3]);
                    *(u32x2*)((unsigned char*)act + (size_t)(u.rbase + 64 * wr) * 1024 + u.pn * 128 + wc * 32 + (ai * HALF + m * 16) * 1024 + lo) = w8;
#else
                    *(u32x4*)(ub + (ai * HALF + m * 16) * 1024 + lo) = pack8(o[0], o[1]);
#endif
                }
                asm volatile("" ::: "memory"); }
    }
};
struct EpiDown {
    static constexpr bool PERM = true;
    const float* bdn; const int* rowtk; const float* roww; bf16* outr;
    __device__ __forceinline__ void operator()(const f32x4 (&acc)[2][2][4][2], const Unit& u, int wr, int wc, int fr, int fq) const {
        const int col0 = u.pn * BM + wc * 32 + 8 * fq; const float* bp = bdn + (size_t)u.e * 1024 + col0;
        const size_t lbase = (size_t)u.e * CAP + u.pm;
#pragma unroll
        for (int ai = 0; ai < 2; ++ai)
#pragma unroll
            for (int m = 0; m < 4; ++m) { const int rr = ai * HALF + wr * 64 + m * 16 + fr;
                if (rr < u.nrows) { const int tk = rowtk[lbase + rr]; const float w = roww[lbase + rr]; bf16* rowp = outr + (size_t)tk * 1024 + col0;
#pragma unroll
                    for (int bj = 0; bj < 2; ++bj) { const f32x4 b0 = *(const f32x4*)(bp + bj * HALF), b1 = *(const f32x4*)(bp + bj * HALF + 4);
                        *(u32x4*)(rowp + bj * HALF) = pack8((acc[ai][bj][m][0] * MOE_DESCALE + b0) * w, (acc[ai][bj][m][1] * MOE_DESCALE + b1) * w); } }
                asm volatile("" ::: "memory"); }
    }
};
}
#define GAS __attribute__((address_space(1)))
#define LAS __attribute__((address_space(3)))
typedef GAS unsigned gu32;
#define RLX_AGENT __ATOMIC_RELAXED, __HIP_MEMORY_SCOPE_AGENT
constexpr int NWAVES = 8;
constexpr int RING_OFF = 0, RING_BYTES = 131072;
constexpr int LDSCTL_OFF = RING_BYTES;
constexpr int LDS_TAB_OFF = RING_BYTES + 1024;
constexpr int LDS_BYTES = LDS_TAB_OFF + 24 * 256 * 4;
static_assert(LDS_BYTES <= 163840, "LDS");

#define XB_TMO      128
#define XB_XCNT(j)  (256  + 64 * (j))
#define XB_XSUB(j)  (1280 + 64 * (j))
#define XB_XGEN(j)  (2304 + 64 * (j))
#define XB_TOP      3328
#define XB_TOPGEN   3392
#define XCD_BAR_WORDS 3456
#define XB_SPIN_CAP (1u << 18)
__device__ __forceinline__ unsigned xb_ld(unsigned* p)              { return __hip_atomic_load(p, __ATOMIC_RELAXED, __HIP_MEMORY_SCOPE_AGENT); }
__device__ __forceinline__ unsigned xb_add(unsigned* p, unsigned v) { return __hip_atomic_fetch_add(p, v, __ATOMIC_RELAXED, __HIP_MEMORY_SCOPE_AGENT); }
__device__ __forceinline__ unsigned xb_xcc_id() { return (unsigned)__builtin_amdgcn_s_getreg((3 << 11) | 20) & 0xFu; }
#define XB_SPIN(cond, bar) do { unsigned _sp = 0; while (cond) { __builtin_amdgcn_s_sleep(1); \
    if ((++_sp & 255u) == 0u) { if (xb_ld(&(bar)[XB_TMO])) break; if (_sp > XB_SPIN_CAP) { atomicAdd(&(bar)[XB_TMO], 1u); break; } } } } while (0)
struct XcdBarrier { unsigned* bar; unsigned x; volatile LAS unsigned* st; };
__device__ __forceinline__ XcdBarrier xcd_barrier_post(unsigned* bar, volatile LAS unsigned* st) {
    XcdBarrier b; b.bar = bar; b.x = xb_xcc_id(); b.st = st;
    if (threadIdx.x == 0) (void)xb_add(&bar[XB_XCNT(b.x)], 1u);
    return b;
}
__device__ __forceinline__ void xcd_barrier_complete(unsigned* bar, unsigned x, unsigned& nloc, unsigned& nx) {
    const unsigned G = gridDim.x * gridDim.y * gridDim.z;
    unsigned sum, cnt, mine, sp = 0u;
    for (;;) {
        sum = 0u; cnt = 0u; mine = 0u;
#pragma unroll
        for (unsigned j = 0; j < 16; ++j) { const unsigned c = xb_ld(&bar[XB_XCNT(j)]); sum += c; cnt += (c > 0u) ? 1u : 0u; mine = (j == x) ? c : mine; }
        if (sum == G) break;
        __builtin_amdgcn_s_sleep(1);
        if ((++sp & 255u) == 0u) { if (xb_ld(&bar[XB_TMO])) break; if (sp > XB_SPIN_CAP) { atomicAdd(&bar[XB_TMO], 1u); break; } }
    }
    nloc = mine > 0u ? mine : 1u; nx = cnt > 0u ? cnt : 1u;
}
__device__ __forceinline__ void xcd_barrier(const XcdBarrier& b) {
    asm volatile("s_waitcnt vmcnt(0)" ::: "memory");
    __syncthreads();
    if (threadIdx.x == 0) {
        unsigned* bar = b.bar;
        __builtin_amdgcn_s_waitcnt(0);
        unsigned nloc = b.st[0], nx = b.st[1];
        if (nloc == 0u) { xcd_barrier_complete(bar, b.x, nloc, nx); b.st[0] = nloc; b.st[1] = nx; }
        const unsigned old = xb_add(&bar[XB_XSUB(b.x)], 1u);
        const unsigned gen = old / nloc;
        if (old + 1u == (gen + 1u) * nloc) {
            __builtin_amdgcn_fence(__ATOMIC_RELEASE, "agent");
            asm volatile("s_waitcnt vmcnt(0)" ::: "memory");
            const unsigned og = xb_add(&bar[XB_TOP], 1u);
            const unsigned tg = og / nx;
            if (og + 1u == (tg + 1u) * nx) xb_add(&bar[XB_TOPGEN], 1u);
            else XB_SPIN(xb_ld(&bar[XB_TOPGEN]) == tg, bar);
            __builtin_amdgcn_fence(__ATOMIC_ACQUIRE, "agent");
            xb_add(&bar[XB_XGEN(b.x)], 1u);
            asm volatile("s_waitcnt vmcnt(0)" ::: "memory");
        } else {
            XB_SPIN(xb_ld(&bar[XB_XGEN(b.x)]) == gen, bar);
            __builtin_amdgcn_fence(__ATOMIC_ACQUIRE, "agent");
            asm volatile("s_waitcnt vmcnt(0)" ::: "memory");
        }
    }
    __syncthreads();
}

struct Frame {
    LAS unsigned char* lds; volatile LAS unsigned* LC;
    unsigned* ctl;
    int wave, vcu, G;
    Bufs B;
};
#define FWS(T, off) ((T*)(F.B.ws + (off)))
#define FDO(T, off) ((T*)((unsigned char*)F.B.out + (off)))
#define LDS_WAIT() asm volatile("s_waitcnt lgkmcnt(0)" ::: "memory")
#define VM_WAIT() asm volatile("s_waitcnt vmcnt(0)" ::: "memory")

__device__ __forceinline__ f32x16 mfma32(bf16x8 a, bf16x8 b, f32x16 c) { return __builtin_amdgcn_mfma_f32_32x32x16_bf16(a, b, c, 0, 0, 0); }
__device__ __forceinline__ int crow(int r, int hi) { return (r & 3) + 8 * (r >> 2) + 4 * hi; }
__device__ __forceinline__ float swap_lo(float x, float& hi_out) { auto rr = __builtin_amdgcn_permlane32_swap(__float_as_uint(x), __float_as_uint(x), false, false); hi_out = __uint_as_float(rr[1]); return __uint_as_float(rr[0]); }
__device__ __forceinline__ bf16x8 pack_frag(const f32x16& v, int base) {
    u32x4 w; w.x = pg8::cvt_pk_bf16(v[base + 0], v[base + 1]); w.y = pg8::cvt_pk_bf16(v[base + 2], v[base + 3]); w.z = pg8::cvt_pk_bf16(v[base + 4], v[base + 5]); w.w = pg8::cvt_pk_bf16(v[base + 6], v[base + 7]);
    return __builtin_bit_cast(bf16x8, w); }
__device__ __forceinline__ bf16x8 join8(u32x2 a, u32x2 b) { u32x4 w; w.x = a.x; w.y = a.y; w.z = b.x; w.w = b.y; return __builtin_bit_cast(bf16x8, w); }
__device__ __forceinline__ float ret_l2g(int h) { return __builtin_amdgcn_logf(1.0f - __builtin_amdgcn_exp2f(-5.0f - (float)h)); }

__device__ __forceinline__ void tr_item(const float* src, int lds_, int k0, int c0, bf16* dst, int K, int r0, LAS unsigned char* scr, int lane) {
    const int kr = lane >> 4, nq = lane & 15;
    f32x4 v[4][4];
#pragma unroll
    for (int gI = 0; gI < 4; ++gI)
#pragma unroll
        for (int i = 0; i < 4; ++i) v[gI][i] = *(const f32x4*)(src + (size_t)(k0 + 16 * gI + 4 * kr + i) * lds_ + c0 + 4 * nq);
#pragma unroll
    for (int gI = 0; gI < 4; ++gI)
#pragma unroll
        for (int e = 0; e < 4; ++e) { u32x2 w; w.x = pk2(v[gI][0][e], v[gI][1][e]); w.y = pk2(v[gI][2][e], v[gI][3][e]);
            *(LAS u32x2*)(scr + (4 * nq + e) * 144 + 32 * gI + 8 * kr) = w; }
    LDS_WAIT(); asm volatile("" ::: "memory");
#pragma unroll
    for (int it = 0; it < 8; ++it) { const int n = it * 8 + (lane >> 3), ch = lane & 7;
        const u32x4 w = *(const LAS u32x4*)(scr + n * 144 + ch * 16);
        *(u32x4*)(dst + (size_t)(r0 + n) * K + k0 + 8 * ch) = w; }
    LDS_WAIT(); asm volatile("" ::: "memory");
}
__device__ __forceinline__ void p0_prologue(Frame& F) {
    const Bufs& B = F.B; const int lane_ = lane_id(), tid_ = F.wave * 64 + lane_;
    const int gw = F.vcu * NWAVES + F.wave, NGW = F.G * NWAVES;
    { const f32x4* xs = (const f32x4*)B.x; u32x4* xd = FDO(u32x4, DO_XB); const size_t n8 = (size_t)NTOK * DM / 8;
      for (size_t i = (size_t)blockIdx.x * 512 + tid_; i < n8; i += (size_t)F.G * 512) { const f32x4 a = xs[2 * i], b = xs[2 * i + 1];
          u32x4 w; w.x = pk2(a[0], a[1]); w.y = pk2(a[2], a[3]); w.z = pk2(b[0], b[1]); w.w = pk2(b[2], b[3]); xd[i] = w; } }
    LAS unsigned char* scr = F.lds + RING_OFF + F.wave * 9216;
    constexpr int I_IN = 16 * (INW / 64)  , I_BSB = 256, I_BRET = 32 * 16, I_OUT = 256;
    constexpr int NITEMS = I_IN + I_BSB + I_BRET + I_OUT;
    for (int it = gw; it < NITEMS; it += NGW) {
        int r = it;
        if (r < I_IN) { const int kb = r / (INW / 64), nb = r % (INW / 64); const int c0 = nb * 64; bf16* dst; int r0;
            if (c0 < 2048) { dst = FWS(bf16, WS_WINT); r0 = c0; } else if (c0 < 3072) { dst = FWS(bf16, WS_WVT); r0 = c0 - 2048; }
            else if (c0 < 5120) { dst = FWS(bf16, WS_WINT); r0 = 2048 + c0 - 3072; } else if (c0 < 7168) { dst = FWS(bf16, WS_WVT); r0 = 1024 + c0 - 5120; }
            else { dst = FWS(bf16, WS_WINT); r0 = 4096 + c0 - 7168; }
            tr_item(B.w_in, INW, kb * 64, c0, dst, 1024, r0, scr, lane_); continue; } r -= I_IN;
        if (r < I_BSB) { tr_item(B.w_bsb, 1024, (r >> 4) * 64, (r & 15) * 64, FWS(bf16, WS_WBSBT), 1024, (r & 15) * 64, scr, lane_); continue; } r -= I_BSB;
        if (r < I_BRET) { tr_item(B.w_bret, 1024, (r >> 4) * 64, (r & 15) * 64, FWS(bf16, WS_WBRETT), 2048, (r & 15) * 64, scr, lane_); continue; } r -= I_BRET;
        tr_item(B.w_out, 1024, (r >> 4) * 64, (r & 15) * 64, FWS(bf16, WS_WOUTT), 1024, (r & 15) * 64, scr, lane_);
    }
    { float* ct = FWS(float, WS_COS); float* st = FWS(float, WS_SIN);
      for (int i = blockIdx.x * 512 + tid_; i < SEQ * 128; i += F.G * 512) { const int pos = i >> 7, j = i & 127; const float ang = (float)pos * rope_inv_freq(j);
          ct[i] = (float)cos((double)ang); st[i] = (float)sin((double)ang); } }
    { bf16* wrt = FWS(bf16, WS_WRT);
      for (int i = blockIdx.x * 512 + tid_; i < 32 * 1024; i += F.G * 512) { const int k = i & 1023, e = i >> 10; wrt[i] = f2bf(B.w_router[k * 32 + e]); } }
}
__device__ __forceinline__ float sb_half(f32x16& p, int kbase, int tq, int hi, bool need_mask, float cin, bf16x8& f0, bf16x8& f1) {
    f32x16 u;
#pragma unroll
    for (int r = 0; r < 16; ++r) { const float e = __builtin_amdgcn_exp2f(fminf(p[r], 100.0f)); u[r] = __builtin_amdgcn_rcpf(1.0f + e); p[r] = e * u[r]; }
    if (need_mask) {
#pragma unroll
        for (int r = 0; r < 16; ++r) { const int s_ = kbase + crow(r, hi); const bool v = (s_ >= 0) && (s_ < tq); u[r] = v ? u[r] : 1.0f; p[r] = v ? p[r] : 0.0f; } }
    float T[4], Rh[4];
#pragma unroll
    for (int g = 0; g < 4; ++g) { const float R = (u[4 * g] * u[4 * g + 1]) * (u[4 * g + 2] * u[4 * g + 3]); float rh; const float rl = swap_lo(R, rh); Rh[g] = rh; T[g] = rl * rh; }
    float X[4]; X[3] = 1.0f;
#pragma unroll
    for (int g = 2; g >= 0; --g) X[g] = X[g + 1] * T[g + 1];
#pragma unroll
    for (int g = 0; g < 4; ++g) { const float ec = X[g] * (hi == 0 ? Rh[g] : 1.0f) * cin;
        const float w2 = u[4 * g + 3], w1 = w2 * u[4 * g + 2], w0 = w1 * u[4 * g + 1];
        p[4 * g + 3] *= ec; p[4 * g + 2] *= w2 * ec; p[4 * g + 1] *= w1 * ec; p[4 * g] *= w0 * ec; }
    f0 = pack_frag(p, 0); f1 = pack_frag(p, 8);
    return X[0] * T[0];
}
__device__ __forceinline__ void attn_wave_unit(const bf16* __restrict__ KSB, const bf16* __restrict__ VSBT, bf16* QY, int b, int h, int qb, int lane) {
    const int r32 = lane & 31, hi = lane >> 5; const int bh = b * 16 + h;
    const int t0 = qb * 32; const size_t rb = (size_t)b * SEQ; const int tq = t0 + r32;
    bf16x8 qf[4];
    { const bf16* qp = QY + (rb + t0 + r32) * 1024 + h * 64 + 8 * hi;
#pragma unroll
      for (int d0 = 0; d0 < 4; ++d0) qf[d0] = *(const bf16x8*)(qp + 16 * d0); }
    f32x16 o0 = {}, o1 = {};
    float carry = 1.0f;
    bf16x8 kf[2][4];
    const int koff = r32 * 16 + 8 * hi, voff = r32 * 16 + 4 * hi;
#define ATT_KLOAD(ks_) do { const bf16* b0_ = KSB + ((size_t)bh * 256 + (max((ks_), 0) >> 5)) * 2048; const bf16* b1_ = KSB + ((size_t)bh * 256 + (max((ks_) + 32, 0) >> 5)) * 2048; \
        _Pragma("unroll") for (int d0 = 0; d0 < 4; ++d0) { kf[0][d0] = *(const bf16x8*)(b0_ + d0 * 512 + koff); kf[1][d0] = *(const bf16x8*)(b1_ + d0 * 512 + koff); } } while (0)
    ATT_KLOAD(t0 - 32);
    for (int tile = 0;; ++tile) {
        const int ks = t0 + 32 - 64 * (tile + 1);
        f32x16 p0 = {}, p1 = {};
#pragma unroll
        for (int d0 = 0; d0 < 4; ++d0) { p0 = mfma32(kf[0][d0], qf[d0], p0); p1 = mfma32(kf[1][d0], qf[d0], p1); }
        bf16x8 vf[2][4];
#pragma unroll
        for (int s = 0; s < 4; ++s) { const bf16* vb_ = VSBT + ((size_t)bh * 512 + (max(ks + 16 * s, 0) >> 4)) * 1024;
#pragma unroll
            for (int db = 0; db < 2; ++db) vf[db][s] = join8(*(const u32x2*)(vb_ + db * 512 + voff), *(const u32x2*)(vb_ + db * 512 + voff + 8)); }
        ATT_KLOAD(ks - 64);
        const bool need_mask = (tile == 0) || (ks < 0);
        bf16x8 pfB0, pfB1, pfA0, pfA1;
        const float tot1 = sb_half(p1, ks + 32, tq, hi, need_mask, carry, pfB0, pfB1);
        const float tot0 = sb_half(p0, ks, tq, hi, need_mask, carry * tot1, pfA0, pfA1);
        carry *= tot1 * tot0;
        o0 = mfma32(vf[0][0], pfA0, o0); o1 = mfma32(vf[1][0], pfA0, o1); o0 = mfma32(vf[0][1], pfA1, o0); o1 = mfma32(vf[1][1], pfA1, o1);
        o0 = mfma32(vf[0][2], pfB0, o0); o1 = mfma32(vf[1][2], pfB0, o1); o0 = mfma32(vf[0][3], pfB1, o0); o1 = mfma32(vf[1][3], pfB1, o1);
        if (ks <= 0) break;
        if (__all(carry < 1.0e-37f)) break;
    }
#undef ATT_KLOAD
    bf16* op = QY + (rb + t0 + r32) * 1024 + h * 64 + 4 * hi;
#pragma unroll
    for (int g = 0; g < 4; ++g) { u32x2 w; w.x = pg8::cvt_pk_bf16(o0[4 * g], o0[4 * g + 1]); w.y = pg8::cvt_pk_bf16(o0[4 * g + 2], o0[4 * g + 3]); *(u32x2*)(op + 8 * g) = w;
        u32x2 w2; w2.x = pg8::cvt_pk_bf16(o1[4 * g], o1[4 * g + 1]); w2.y = pg8::cvt_pk_bf16(o1[4 * g + 2], o1[4 * g + 3]); *(u32x2*)(op + 32 + 8 * g) = w2; }
}
constexpr int I_GU = 32 * 16 * 32, I_DN = 32 * 16 * 16, I_MOE = I_GU + I_DN;
__device__ __forceinline__ void tr_item_fp8(const float* src, int lds_, int k0, int c0, unsigned char* dst, int K, int r0, LAS unsigned char* scr, int lane) {
    const int kr = lane >> 4, nq = lane & 15;
    f32x4 v[4][4];
#pragma unroll
    for (int gI = 0; gI < 4; ++gI)
#pragma unroll
        for (int i = 0; i < 4; ++i) v[gI][i] = *(const f32x4*)(src + (size_t)(k0 + 16 * gI + 4 * kr + i) * lds_ + c0 + 4 * nq) * MOE_WSCALE;
#pragma unroll
    for (int gI = 0; gI < 4; ++gI)
#pragma unroll
        for (int e = 0; e < 4; ++e) *(LAS unsigned*)(scr + (4 * nq + e) * 80 + 16 * gI + 4 * kr) = pk4_fp8(v[gI][0][e], v[gI][1][e], v[gI][2][e], v[gI][3][e]);
    LDS_WAIT(); asm volatile("" ::: "memory");
#pragma unroll
    for (int it = 0; it < 4; ++it) { const int n = it * 16 + (lane >> 2), ch = lane & 3;
        const u32x4 w = *(const LAS u32x4*)(scr + n * 80 + ch * 16);
        *(u32x4*)(dst + (size_t)(r0 + n) * K + k0 + 16 * ch) = w; }
    LDS_WAIT(); asm volatile("" ::: "memory");
}
__device__ __forceinline__ void moe_tr_item(Frame& F, int r, LAS unsigned char* scr, int lane) {
    const Bufs& B = F.B;
    if (r < I_GU) { const int e = r >> 9, q = r & 511, kb = q >> 5, nb = q & 31; const int c0 = nb * 64; const int bj = c0 >> 10, rem = c0 & 1023, ct = rem >> 7, i0 = rem & 127;
#if MOE_FP8
        tr_item_fp8(B.w_gu + (size_t)e * 1024 * 2048, 2048, kb * 64, c0, F.B.ws + WS_WGUT + (size_t)e * 2048 * 1024, 1024, 256 * ct + 128 * bj + i0, scr, lane); return; }
#else
        tr_item(B.w_gu + (size_t)e * 1024 * 2048, 2048, kb * 64, c0, FWS(bf16, WS_WGUT) + (size_t)e * 2048 * 1024, 1024, 256 * ct + 128 * bj + i0, scr, lane); return; }
#endif
    r -= I_GU;
    { const int e = r >> 8, q = r & 255, kb = q >> 4, nb = q & 15;
#if MOE_FP8
      tr_item_fp8(B.w_dn + (size_t)e * 1024 * 1024, 1024, kb * 64, nb * 64, F.B.ws + WS_WDT + (size_t)e * 1024 * 1024, 1024, nb * 64, scr, lane); }
#else
      tr_item(B.w_dn + (size_t)e * 1024 * 1024, 1024, kb * 64, nb * 64, FWS(bf16, WS_WDT) + (size_t)e * 1024 * 1024, 1024, nb * 64, scr, lane); }
#endif
}
__device__ __forceinline__ void attn_phase(Frame& F) {
    const int gw = F.vcu * NWAVES + F.wave, NGW = F.G * NWAVES; const int lane = lane_id();
    LAS unsigned char* scr = F.lds + RING_OFF + F.wave * 9216;
    int it = gw;
    for (int wu = gw; wu < BATCH * SBH * (SEQ / 32); wu += NGW) { const int qb = wu & 255, bh = wu >> 8;
        attn_wave_unit(FWS(bf16, WS_KSB), FWS(bf16, WS_VSBT), FWS(bf16, WS_QSB), bh >> 4, bh & 15, qb, lane);
        for (int z = 0; z < 2 && it < I_MOE; ++z, it += NGW) moe_tr_item(F, it, scr, lane); }
    for (; it < I_MOE; it += NGW) moe_tr_item(F, it, scr, lane);
}

__device__ __forceinline__ int swap23(int m) { return (m & ~12) | ((m & 4) << 1) | ((m & 8) >> 1); }
__device__ __forceinline__ void scan_phase(Frame& F) {
    if (F.vcu >= BATCH * RH * 16) return;
    const int lane = lane_id(), w = F.wave, r32 = lane & 31, hi = lane >> 5;
    const int bh = F.vcu >> 4, vs = F.vcu & 15, h = bh & 3;
    const float l2g = ret_l2g(h), cd = __builtin_amdgcn_exp2f(64.0f * l2g);
    const bf16* ktp = FDO(bf16, DO_KRT) + ((size_t)bh * 128 * 4 * 256 + (32 * w + swap23(r32))) * 16 + 8 * hi;
    const bf16* vtp = FWS(bf16, WS_VRT) + ((size_t)bh * 128 * 4 * 512 + (32 * vs + r32)) * 16 + 8 * hi;
    const bf16* qp = FWS(bf16, WS_QRS) + ((size_t)bh * 128 * 16 * 64 + (size_t)(2 * w) * 64 + r32) * 16 + 8 * hi;
    bf16* yp = FWS(bf16, WS_YINT) + ((size_t)bh * 128 * 64 + (size_t)(4 * vs + (r32 >> 3))) * 512 + (r32 & 7);
    LAS f32x4* part = (LAS f32x4*)(F.lds + RING_OFF);
    f32x16 S = {};
    bf16x8 kfA[4], vfA[4], qfA[2][2], kfB[4], vfB[4], qfB[2][2], kfC[4], vfC[4], qfC[2][2];
#define SCAN_LOAD(kf, vf, qf, c) do { _Pragma("unroll") for (int s = 0; s < 4; ++s) { kf[s] = *(const bf16x8*)(ktp + (size_t)((c) * 4 + s) * 4096); vf[s] = *(const bf16x8*)(vtp + (size_t)((c) * 4 + s) * 8192); } \
        _Pragma("unroll") for (int ib = 0; ib < 2; ++ib) _Pragma("unroll") for (int s = 0; s < 2; ++s) qf[ib][s] = *(const bf16x8*)(qp + (size_t)(c) * 16384 + s * 1024 + ib * 512); } while (0)
#define SCAN_STEP(kf, vf, qf, kfn, vfn, qfn, c) do { \
        { const int cn_ = ((c) + 2 < NCHUNK) ? (c) + 2 : NCHUNK - 1; SCAN_LOAD(kfn, vfn, qfn, cn_); }     \
        const bf16x8 sb0 = pack_frag(S, 0), sb1 = pack_frag(S, 8); \
        f32x16 y0 = {}, y1 = {}; \
        y0 = mfma32(qf[0][0], sb0, y0); y0 = mfma32(qf[0][1], sb1, y0); \
        y1 = mfma32(qf[1][0], sb0, y1); y1 = mfma32(qf[1][1], sb1, y1); \
        LAS f32x4* pb = part + ((c) & 1) * 4096 + (w * 8) * 64 + lane; \
        _Pragma("unroll") for (int q = 0; q < 4; ++q) { pb[q * 64] = (f32x4){y0[4 * q], y0[4 * q + 1], y0[4 * q + 2], y0[4 * q + 3]}; pb[(4 + q) * 64] = (f32x4){y1[4 * q], y1[4 * q + 1], y1[4 * q + 2], y1[4 * q + 3]}; } \
        _Pragma("unroll") for (int r = 0; r < 16; ++r) S[r] *= cd; \
        _Pragma("unroll") for (int s = 0; s < 4; ++s) S = mfma32(kf[s], vf[s], S); \
        LDS_WAIT(); __builtin_amdgcn_s_barrier(); asm volatile("" ::: "memory"); \
        const LAS f32x4* rbp = part + ((c) & 1) * 4096 + w * 64 + lane;         \
        f32x4 acc = rbp[0]; \
        _Pragma("unroll") for (int w2 = 1; w2 < 8; ++w2) acc += rbp[w2 * 8 * 64]; \
        _Pragma("unroll") for (int k = 0; k < 4; ++k) { const int idx = 4 * w + k, ib = idx >> 4, r = idx & 15; const int i = 32 * ib + crow(r, hi); \
            yp[(size_t)(c) * 32768 + i * 8] = f2bf(acc[k] * __builtin_amdgcn_exp2f((float)(i + 1) * l2g)); } } while (0)
    SCAN_LOAD(kfA, vfA, qfA, 0); SCAN_LOAD(kfB, vfB, qfB, 1);
    int c = 0;
    for (; c + 3 <= NCHUNK; c += 3) { SCAN_STEP(kfA, vfA, qfA, kfC, vfC, qfC, c); SCAN_STEP(kfB, vfB, qfB, kfA, vfA, qfA, c + 1); SCAN_STEP(kfC, vfC, qfC, kfB, vfB, qfB, c + 2); }
    SCAN_STEP(kfA, vfA, qfA, kfC, vfC, qfC, c); SCAN_STEP(kfB, vfB, qfB, kfA, vfA, qfA, c + 1);
    static_assert(NCHUNK % 3 == 2, "scan tail");
#undef SCAN_STEP
#undef SCAN_LOAD
    LDS_WAIT(); __syncthreads();
}

__device__ __forceinline__ void intra_phase(Frame& F) {
    const int lane = lane_id(), w = F.wave, r32 = lane & 31, hi = lane >> 5;
    LAS float* part = (LAS float*)(F.lds + RING_OFF);
    LAS u32x4* pfl = (LAS u32x4*)(F.lds + RING_OFF + 16384);
    LAS float* red = (LAS float*)(F.lds + RING_OFF + 24576);
    LAS unsigned char* stg = F.lds + RING_OFF + 32768 + w * 9216;
    const int tl = w & 3, jb = tl >> 1, ibt = tl & 1, kh = w >> 2;
    for (int un = F.vcu * 8; un < F.vcu * 8 + 8 && un < BATCH * RH * NCHUNK; ++un) {
        const int c = un & 127, h = (un >> 7) & 3, b = un >> 9, bh = b * 4 + h;
        const size_t tok0 = (size_t)b * SEQ + c * 64; const float l2g = ret_l2g(h);
        bf16x8 kfr[8], qfr[8];
        { const bf16* kp = FWS(bf16, WS_KR) + (tok0 + 32 * jb + r32) * 1024 + h * 256 + 128 * kh + 8 * hi;
          const bf16* qp = FWS(bf16, WS_QRS) + (((size_t)bh * 128 + c) * 16 + 8 * kh) * 1024 + (32 * ibt + r32) * 16 + 8 * hi;
#pragma unroll
          for (int s = 0; s < 8; ++s) { kfr[s] = *(const bf16x8*)(kp + 16 * s); qfr[s] = *(const bf16x8*)(qp + s * 1024); } }
        bf16x8 vfr[2][4];
        { const bf16* vp = FWS(bf16, WS_VRT) + (((size_t)bh * 128 + c) * 4 * 512 + 64 * w + r32) * 16 + 4 * hi;
#pragma unroll
          for (int vb = 0; vb < 2; ++vb)
#pragma unroll
              for (int ks = 0; ks < 4; ++ks) { const bf16* p = vp + (size_t)ks * 8192 + vb * 512; vfr[vb][ks] = join8(*(const u32x2*)(p), *(const u32x2*)(p + 8)); } }
        const size_t tbase = ((((size_t)bh * 128 + c) * 64 + 8 * w) * 64 + r32) * 8 + 4 * hi;
        const bf16* yrow = FWS(bf16, WS_YINT) + tbase; const bf16* srow = FWS(bf16, WS_SG) + tbase;
        u32x2 yv[2][2][4];
#pragma unroll
        for (int ib = 0; ib < 2; ++ib)
#pragma unroll
            for (int vb = 0; vb < 2; ++vb)
#pragma unroll
                for (int g = 0; g < 4; ++g) yv[ib][vb][g] = *(const u32x2*)(yrow + (size_t)(4 * vb + g) * 512 + ib * 256);
        f32x16 X = {};
#pragma unroll
        for (int s = 0; s < 8; ++s) X = mfma32(kfr[s], qfr[s], X);
        u32x2 sv[2][2][4];
#pragma unroll
        for (int ib = 0; ib < 2; ++ib)
#pragma unroll
            for (int vb = 0; vb < 2; ++vb)
#pragma unroll
                for (int g = 0; g < 4; ++g) sv[ib][vb][g] = *(const u32x2*)(srow + (size_t)(4 * vb + g) * 512 + ib * 256);
        if (kh == 1) {
#pragma unroll
            for (int r = 0; r < 16; ++r) part[(tl * 16 + r) * 64 + lane] = X[r]; }
        LDS_WAIT(); __builtin_amdgcn_s_barrier(); asm volatile("" ::: "memory");
        if (kh == 0) {
#pragma unroll
            for (int r = 0; r < 16; ++r) { const int j = 32 * jb + crow(r, hi), i = 32 * ibt + r32;
                X[r] = (X[r] + part[(tl * 16 + r) * 64 + lane]) * __builtin_amdgcn_exp2f((float)((j <= i ? i - j : j - i) - 63 + j) * l2g); }
            pfl[(ibt * 4 + 2 * jb) * 64 + lane] = __builtin_bit_cast(u32x4, pack_frag(X, 0)); pfl[(ibt * 4 + 2 * jb + 1) * 64 + lane] = __builtin_bit_cast(u32x4, pack_frag(X, 8)); }
        LDS_WAIT(); __builtin_amdgcn_s_barrier(); asm volatile("" ::: "memory");
        f32x16 Y[2][2] = {};
#pragma unroll
        for (int ks = 0; ks < 4; ++ks) { const bf16x8 p0 = __builtin_bit_cast(bf16x8, pfl[(0 * 4 + ks) * 64 + lane]), p1 = __builtin_bit_cast(bf16x8, pfl[(1 * 4 + ks) * 64 + lane]);
#pragma unroll
            for (int vb = 0; vb < 2; ++vb) { Y[vb][0] = mfma32(vfr[vb][ks], p0, Y[vb][0]); Y[vb][1] = mfma32(vfr[vb][ks], p1, Y[vb][1]); } }
        float s1[2] = {0.f, 0.f}, s2[2] = {0.f, 0.f};
#pragma unroll
        for (int ib = 0; ib < 2; ++ib)
#pragma unroll
            for (int vb = 0; vb < 2; ++vb)
#pragma unroll
                for (int g = 0; g < 4; ++g) { const u32x2 wv = yv[ib][vb][g];
                    Y[vb][ib][4 * g] += __uint_as_float(wv.x << 16); Y[vb][ib][4 * g + 1] += __uint_as_float(wv.x & 0xffff0000u); Y[vb][ib][4 * g + 2] += __uint_as_float(wv.y << 16); Y[vb][ib][4 * g + 3] += __uint_as_float(wv.y & 0xffff0000u);
#pragma unroll
                    for (int e = 0; e < 4; ++e) { const float y = Y[vb][ib][4 * g + e]; s1[ib] += y; s2[ib] += y * y; } }
#pragma unroll
        for (int ib = 0; ib < 2; ++ib) { float h1, h2; const float l1 = swap_lo(s1[ib], h1), l2 = swap_lo(s2[ib], h2);
            if (hi == 0) { red[(w * 64 + 32 * ib + r32) * 2] = l1 + h1; red[(w * 64 + 32 * ib + r32) * 2 + 1] = l2 + h2; } }
        LDS_WAIT(); __builtin_amdgcn_s_barrier(); asm volatile("" ::: "memory");
#pragma unroll
        for (int ib = 0; ib < 2; ++ib) { float t1 = 0.f, t2 = 0.f;
#pragma unroll
            for (int w2 = 0; w2 < 8; ++w2) { t1 += red[(w2 * 64 + 32 * ib + r32) * 2]; t2 += red[(w2 * 64 + 32 * ib + r32) * 2 + 1]; }
            const float mean = t1 * (1.0f / 512.0f), var = fmaxf(t2 * (1.0f / 512.0f) - mean * mean, 0.0f), rstd = __builtin_amdgcn_rsqf(var + LN_EPS);
#pragma unroll
            for (int vb = 0; vb < 2; ++vb)
#pragma unroll
                for (int g = 0; g < 4; ++g) { const u32x2 sw = sv[ib][vb][g];
                    const float g0 = __uint_as_float(sw.x << 16), g1 = __uint_as_float(sw.x & 0xffff0000u), g2 = __uint_as_float(sw.y << 16), g3 = __uint_as_float(sw.y & 0xffff0000u);
                    u32x2 ov; ov.x = pg8::cvt_pk_bf16(g0 * (Y[vb][ib][4 * g] - mean) * rstd, g1 * (Y[vb][ib][4 * g + 1] - mean) * rstd);
                    ov.y = pg8::cvt_pk_bf16(g2 * (Y[vb][ib][4 * g + 2] - mean) * rstd, g3 * (Y[vb][ib][4 * g + 3] - mean) * rstd);
                    *(LAS u32x2*)(stg + (32 * ib + r32) * 144 + (32 * vb + 8 * g + 4 * hi) * 2) = ov; } }
        LDS_WAIT(); asm volatile("" ::: "memory");
        { bf16* rp = FDO(bf16, DO_R) + (tok0 + (lane >> 3)) * 2048 + h * 512 + 64 * w + 8 * (lane & 7);
#pragma unroll
          for (int k = 0; k < 8; ++k) { const u32x4 v = *(const LAS u32x4*)(stg + (8 * k + (lane >> 3)) * 144 + (lane & 7) * 16); *(u32x4*)(rp + (size_t)(8 * k) * 2048) = v; } }
        LDS_WAIT(); asm volatile("" ::: "memory");
    }
    LDS_WAIT(); __syncthreads();
}

__device__ __forceinline__ void ln1_router_phase(Frame& F) {
    const Bufs& B = F.B;
    const int lane = lane_id(), w = F.wave, r32 = lane & 31, hi = lane >> 5; const int tid_ = w * 64 + lane;
    LAS unsigned char* xt = F.lds + RING_OFF;
    LAS f32x4* pl = (LAS f32x4*)(F.lds + RING_OFF + 66048);
    LAS int* selE = (LAS int*)(F.lds + RING_OFF + 98816);
    LAS float* selW = (LAS float*)(F.lds + RING_OFF + 98816 + 2048);
    volatile LAS unsigned* hist = F.LC + 96; volatile LAS unsigned* basew = F.LC + 128;
    if (tid_ < 32) hist[tid_] = 0u;
    f32x4 gv[4], bv[4];
#pragma unroll
    for (int j = 0; j < 4; ++j) { gv[j] = *(const f32x4*)(B.ln1_g + 4 * lane + 256 * j); bv[j] = *(const f32x4*)(B.ln1_b + 4 * lane + 256 * j); }
    const int wgrow0 = F.vcu * 128;
    f32x4 vn[4][4];
#define LN_LOAD(blk_) do { _Pragma("unroll") for (int rr = 0; rr < 4; ++rr) { const float* p_ = B.out + (size_t)(wgrow0 + 32 * (blk_) + 4 * w + rr) * 1024 + 4 * lane; \
        _Pragma("unroll") for (int j = 0; j < 4; ++j) vn[rr][j] = *(const f32x4*)(p_ + 256 * j); } } while (0)
    LN_LOAD(0);
    for (int blk = 0; blk < 4; ++blk) {
        const int row0 = wgrow0 + 32 * blk;
        f32x4 vc[4][4];
#pragma unroll
        for (int rr = 0; rr < 4; ++rr)
#pragma unroll
            for (int j = 0; j < 4; ++j) vc[rr][j] = vn[rr][j];
        { const int nb = blk < 3 ? blk + 1 : 3; LN_LOAD(nb); }
#pragma unroll
        for (int rr = 0; rr < 4; ++rr) { const int lr = 4 * w + rr; bf16* xb = FWS(bf16, WS_X1B) + (size_t)(row0 + lr) * 1024 + 4 * lane;
            f32x4 v[4]; float s = 0.f;
#pragma unroll
            for (int j = 0; j < 4; ++j) { v[j] = vc[rr][j]; s += (v[j][0] + v[j][1]) + (v[j][2] + v[j][3]); }
            const float mean = wave_sum(s) * (1.f / 1024.f); float s2 = 0.f;
#pragma unroll
            for (int j = 0; j < 4; ++j) { v[j] = v[j] - mean; s2 += (v[j][0] * v[j][0] + v[j][1] * v[j][1]) + (v[j][2] * v[j][2] + v[j][3] * v[j][3]); }
            const float rstd = rsqrtf(wave_sum(s2) * (1.f / 1024.f) + LN_EPS);
#pragma unroll
            for (int j = 0; j < 4; ++j) { const f32x4 y = v[j] * rstd * gv[j] + bv[j];
                u32x2 o; o.x = pg8::cvt_pk_bf16(y[0], y[1]); o.y = pg8::cvt_pk_bf16(y[2], y[3]); *(u32x2*)(xb + 256 * j) = o;
#if MOE_FP8
                *(unsigned*)(F.B.ws + WS_X1B8 + (size_t)(row0 + lr) * 1024 + 4 * lane + 256 * j) = pk4_fp8(y[0], y[1], y[2], y[3]);
#endif
                *(LAS u32x2*)(xt + lr * 2064 + (4 * lane + 256 * j) * 2) = o; } }
        LDS_WAIT(); __builtin_amdgcn_s_barrier(); asm volatile("" ::: "memory");
        f32x16 acc = {};
        { const bf16* ap = FWS(bf16, WS_WRT) + (size_t)r32 * 1024 + 128 * w + 8 * hi; const LAS unsigned char* bp = xt + r32 * 2064 + (128 * w + 8 * hi) * 2;
#pragma unroll
          for (int s = 0; s < 8; ++s) acc = mfma32(*(const bf16x8*)(ap + 16 * s), *(const LAS bf16x8*)(bp + 32 * s), acc); }
#pragma unroll
        for (int q = 0; q < 4; ++q) pl[(w * 4 + q) * 64 + lane] = (f32x4){acc[4 * q], acc[4 * q + 1], acc[4 * q + 2], acc[4 * q + 3]};
        LDS_WAIT(); __builtin_amdgcn_s_barrier(); asm volatile("" ::: "memory");
        const bool fin = (w == (blk & 7));
        f32x4 t[4];
        if (fin) {
#pragma unroll
            for (int q = 0; q < 4; ++q) { t[q] = pl[q * 64 + lane];
#pragma unroll
                for (int w2 = 1; w2 < 8; ++w2) t[q] += pl[(w2 * 4 + q) * 64 + lane]; } }
        LDS_WAIT(); __builtin_amdgcn_s_barrier(); asm volatile("" ::: "memory");
        if (fin) {
            float lo[16], hv[16];
#pragma unroll
            for (int r = 0; r < 16; ++r) { const float x = t[r >> 2][r & 3] + B.b_router[crow(r, hi)]; float h_; lo[r] = swap_lo(x, h_); hv[r] = h_; }
            int se[4]; float sv[4];
#pragma unroll
            for (int kk = 0; kk < 4; ++kk) { float best = -INFINITY; int bi = 0;
#pragma unroll
                for (int g = 0; g < 4; ++g) {
#pragma unroll
                    for (int e = 0; e < 4; ++e) { if (lo[4 * g + e] > best) { best = lo[4 * g + e]; bi = 8 * g + e; } }
#pragma unroll
                    for (int e = 0; e < 4; ++e) { if (hv[4 * g + e] > best) { best = hv[4 * g + e]; bi = 8 * g + 4 + e; } } }
                se[kk] = bi; sv[kk] = best;
#pragma unroll
                for (int r = 0; r < 16; ++r) { if (bi == crow(r, 0)) lo[r] = -INFINITY; if (bi == crow(r, 1)) hv[r] = -INFINITY; } }
            const float e1 = __expf(sv[1] - sv[0]), e2 = __expf(sv[2] - sv[0]), e3 = __expf(sv[3] - sv[0]); const float inv = 1.f / (1.f + e1 + e2 + e3);
            if (hi == 0) { const int tl = 32 * blk + r32;
                selE[tl * 4 + 0] = se[0]; selE[tl * 4 + 1] = se[1]; selE[tl * 4 + 2] = se[2]; selE[tl * 4 + 3] = se[3];
                selW[tl * 4 + 0] = inv; selW[tl * 4 + 1] = e1 * inv; selW[tl * 4 + 2] = e2 * inv; selW[tl * 4 + 3] = e3 * inv; } }
    }
#undef LN_LOAD
    LDS_WAIT(); __syncthreads();
    const int myE = selE[tid_]; const float myW = selW[tid_];
    const unsigned rk = __hip_atomic_fetch_add((LAS unsigned*)hist + myE, 1u, __ATOMIC_RELAXED, __HIP_MEMORY_SCOPE_WORKGROUP);
    LDS_WAIT(); __syncthreads();
    if (tid_ < 32) basew[tid_] = __hip_atomic_fetch_add(F.ctl + CW_CNT + 64 * tid_, hist[tid_], RLX_AGENT);
    LDS_WAIT(); __syncthreads();
    { const unsigned pos = basew[myE] + rk; const int tk = (wgrow0 + (tid_ >> 2)) * 4 + (tid_ & 3);
      FWS(int, WS_ROWTK)[(size_t)myE * CAP + pos] = tk; FWS(float, WS_ROWW)[(size_t)myE * CAP + pos] = myW; }
}

template <bool GU> struct MoeOrder {
    const char* A; const char* W; volatile LAS int* ts; volatile LAS unsigned* cntl; const LAS unsigned* tab; int c;
    __device__ bool next(int i, pg8::Unit& u) const {
        const int x = c & 7, k = c >> 3, q = 8 * i + x;
        const int rt = GU ? (4 * q + (k >> 3)) : (8 * q + (k >> 2));
        if (rt >= ts[NEXP]) return false;
        int e = 0;
        for (int j = 1; j < NEXP; ++j) e += (rt >= ts[j]) ? 1 : 0;
        u.pn = GU ? (k & 7) : (k & 3); u.e = e; u.idx = i; u.rbase = rt * 256; u.pm = (rt - ts[e]) * 256;
        const int left = (int)cntl[e] - u.pm; u.nrows = left < 256 ? left : 256; return true;
    }
    static constexpr int EBm = MOE_FP8 ? 1 : 2;
    __device__ __forceinline__ const char* a_ptr(const pg8::Unit& u) const { return GU ? A : A + (size_t)u.rbase * 1024 * EBm; }
    __device__ __forceinline__ const char* b_ptr(const pg8::Unit& u) const { return W + ((size_t)u.e * (GU ? 2048 : 1024) + (size_t)u.pn * 256) * 1024 * EBm; }
    __device__ __forceinline__ unsigned a_off(const pg8::Unit& u, int row) const { return tab[u.idx * 256 + row]; }
    __device__ __forceinline__ void a_ready(const pg8::Unit&) const {}
    __device__ __forceinline__ void done(const pg8::Unit&) const {}
};
__device__ __forceinline__ void moe_setup(Frame& F) {
    const int tid_ = F.wave * 64 + lane_id();
    volatile LAS int* ts = (volatile LAS int*)(F.LC + 16); volatile LAS unsigned* cntl = F.LC + 64;
    if (tid_ < 32) cntl[tid_] = __hip_atomic_load(F.ctl + CW_CNT + 64 * tid_, RLX_AGENT);
    LDS_WAIT(); __syncthreads();
    if (tid_ == 0) { int acc = 0; for (int e = 0; e < NEXP; ++e) { ts[e] = acc; acc += (int)((cntl[e] + 255u) >> 8); } ts[NEXP] = acc; }
    LDS_WAIT(); __syncthreads();
}

__device__ __forceinline__ void final_phase(Frame& F) {
    const Bufs& B = F.B; const int lane = lane_id();
    const int gw = F.vcu * NWAVES + F.wave, NGW = F.G * NWAVES;
    f32x4 gv[4], bv[4];
#pragma unroll
    for (int j = 0; j < 4; ++j) { gv[j] = *(const f32x4*)(B.ln2_g + 4 * lane + 256 * j); bv[j] = *(const f32x4*)(B.ln2_b + 4 * lane + 256 * j); }
    for (int row = gw; row < NTOK; row += NGW) { float* p = B.out + (size_t)row * 1024 + 4 * lane; const bf16* orow = FWS(bf16, WS_OUTR) + (size_t)row * 4096 + 4 * lane;
        const bf16* xrow = FWS(bf16, WS_X1B) + (size_t)row * 1024 + 4 * lane;
        f32x4 v[4]; float s = 0.f;
#pragma unroll
        for (int j = 0; j < 4; ++j) { { const u32x2 xv = *(const u32x2*)(xrow + 256 * j);
                v[j] = (f32x4){__uint_as_float(xv.x << 16), __uint_as_float(xv.x & 0xffff0000u), __uint_as_float(xv.y << 16), __uint_as_float(xv.y & 0xffff0000u)} * DN_ALPHA; }
#pragma unroll
            for (int kk = 0; kk < 4; ++kk) { const u32x2 wv = *(const u32x2*)(orow + kk * 1024 + 256 * j);
                v[j][0] += __uint_as_float(wv.x << 16); v[j][1] += __uint_as_float(wv.x & 0xffff0000u); v[j][2] += __uint_as_float(wv.y << 16); v[j][3] += __uint_as_float(wv.y & 0xffff0000u); }
            s += (v[j][0] + v[j][1]) + (v[j][2] + v[j][3]); }
        const float mean = wave_sum(s) * (1.f / 1024.f); float s2 = 0.f;
#pragma unroll
        for (int j = 0; j < 4; ++j) { v[j] = v[j] - mean; s2 += (v[j][0] * v[j][0] + v[j][1] * v[j][1]) + (v[j][2] * v[j][2] + v[j][3] * v[j][3]); }
        const float rstd = rsqrtf(wave_sum(s2) * (1.f / 1024.f) + LN_EPS);
#pragma unroll
        for (int j = 0; j < 4; ++j) *(f32x4*)(p + 256 * j) = v[j] * rstd * gv[j] + bv[j]; }
}

constexpr int NPHASE = 11;
struct MArgs { Bufs B; int ph_lo, ph_hi; };
__global__ void __launch_bounds__(NWAVES * 64, 2) mega_fwd(MArgs args) {
    extern __shared__ __attribute__((aligned(16))) unsigned char lds[];
    Frame F;
    F.lds = (LAS unsigned char*)lds; F.LC = (volatile LAS unsigned*)(F.lds + LDSCTL_OFF);
    F.wave = __builtin_amdgcn_readfirstlane((int)threadIdx.x >> 6);
    F.G = gridDim.x; { const int bx = blockIdx.x; F.vcu = (F.G % 8 == 0) ? (bx % 8) * (F.G / 8) + bx / 8 : bx; }
#define REFRESH() do { const __attribute__((address_space(4))) MArgs* kp_ = (const __attribute__((address_space(4))) MArgs*)__builtin_amdgcn_kernarg_segment_ptr(); asm volatile("" : "+s"(kp_)); \
        F.B.x = kp_->B.x; F.B.w_in = kp_->B.w_in; F.B.w_bsb = kp_->B.w_bsb; F.B.w_bret = kp_->B.w_bret; F.B.w_out = kp_->B.w_out; F.B.ln1_g = kp_->B.ln1_g; F.B.ln1_b = kp_->B.ln1_b; \
        F.B.w_router = kp_->B.w_router; F.B.b_router = kp_->B.b_router; F.B.w_gu = kp_->B.w_gu; F.B.b_gu = kp_->B.b_gu; F.B.w_dn = kp_->B.w_dn; F.B.b_dn = kp_->B.b_dn; \
        F.B.ln2_g = kp_->B.ln2_g; F.B.ln2_b = kp_->B.ln2_b; F.B.out = kp_->B.out; F.B.ws = kp_->B.ws; F.ctl = (unsigned*)(F.B.ws + WS_CTL); } while (0)
    REFRESH();
    for (int u = threadIdx.x; u < 256; u += NWAVES * 64) F.LC[u] = 0u;
    __syncthreads();
    const int lo = args.ph_lo, hi = args.ph_hi;
    const bool multi = (hi - lo) > 1;
    if (multi) (void)xcd_barrier_post(F.ctl + CW_BAR, F.LC);
#ifndef PH_COMPILE
#define PH_COMPILE 0x7FF
#endif
#define IN(k) ((((PH_COMPILE) >> (k)) & 1) && lo <= (k) && (k) < hi)
#define SEAM(k) do { if (IN(k) && IN((k) + 1)) { REFRESH(); XcdBarrier bar_; bar_.bar = F.ctl + CW_BAR; bar_.x = xb_xcc_id(); bar_.st = F.LC; xcd_barrier(bar_); } } while (0)
    LAS unsigned char* ring = F.lds + RING_OFF;
    const int c = (int)blockIdx.x;
    if (IN(0)) { REFRESH(); p0_prologue(F); } SEAM(0);
    if (IN(1)) { REFRESH();
        { pg8::StaticOrder S; S.init(FDO(bf16, DO_XB), FWS(bf16, WS_WINT), NTOK, 2048, 1024, F.G, c);
          pg8::EpiQK E{FWS(bf16, WS_QSB), FWS(bf16, WS_KSB)};
          pg8::gemm_phase<pg8::EpiQK, pg8::StaticOrder, true, false>(ring, 1024, S, E, F.wave); }
        { pg8::StaticOrder S; S.init(FDO(bf16, DO_XB), FWS(bf16, WS_WINT) + (size_t)2048 * 1024, NTOK, 2048, 1024, F.G, c);
          pg8::EpiRot E{FWS(bf16, WS_QR), FWS(bf16, WS_KR), FDO(bf16, DO_KRT), FWS(bf16, WS_QRS), FWS(float, WS_COS), FWS(float, WS_SIN)};
          pg8::gemm_phase<pg8::EpiRot, pg8::StaticOrder, true, false>(ring, 1024, S, E, F.wave); }
        { pg8::StaticOrder S; S.init(FDO(bf16, DO_XB), FWS(bf16, WS_WINT) + (size_t)4096 * 1024, NTOK, 4096, 1024, F.G, c);
          pg8::EpiGate E{F.B.ws};
          pg8::gemm_phase<pg8::EpiGate, pg8::StaticOrder, true, false>(ring, 1024, S, E, F.wave); }
        { pg8::StaticOrder S; S.init(FWS(bf16, WS_WVT), FDO(bf16, DO_XB), 3072, NTOK, 1024, F.G, c);
          pg8::EpiVT E{FWS(bf16, WS_VSBT), FWS(bf16, WS_VRT)};
          pg8::gemm_phase<pg8::EpiVT, pg8::StaticOrder, true, false>(ring, 1024, S, E, F.wave); }
    } SEAM(1);
    if (IN(2)) { REFRESH(); attn_phase(F); } SEAM(2);
    if (IN(3)) { REFRESH(); scan_phase(F); } SEAM(3);
    if (IN(4)) { REFRESH(); intra_phase(F); } SEAM(4);
    if (IN(5)) { REFRESH();
        { pg8::StaticOrder S; S.init(FWS(bf16, WS_QSB), FWS(bf16, WS_WBSBT), NTOK, 1024, 1024, F.G, c);
          pg8::EpiBranch<0> E{FWS(bf16, WS_GSB), nullptr, FWS(bf16, WS_M1)};
          pg8::gemm_phase<pg8::EpiBranch<0>, pg8::StaticOrder, true, false>(ring, 1024, S, E, F.wave); }
        { pg8::StaticOrder S; S.init(FDO(bf16, DO_R), FWS(bf16, WS_WBRETT), NTOK, 1024, 2048, F.G, c);
          pg8::EpiBranch<1> E{FWS(bf16, WS_GRET), FWS(bf16, WS_M1), FWS(bf16, WS_MG)};
          pg8::gemm_phase<pg8::EpiBranch<1>, pg8::StaticOrder, true, false>(ring, 2048, S, E, F.wave); }
    } SEAM(5);
    if (IN(6)) { REFRESH(); pg8::StaticOrder S; S.init(FWS(bf16, WS_MG), FWS(bf16, WS_WOUTT), NTOK, 1024, 1024, F.G, c);
        pg8::EpiPre E{F.B.x, F.B.out};
        pg8::gemm_phase<pg8::EpiPre, pg8::StaticOrder, true, false>(ring, 1024, S, E, F.wave); } SEAM(6);
    if (IN(7)) { REFRESH(); ln1_router_phase(F); } SEAM(7);
    if (IN(8)) { REFRESH(); moe_setup(F);
        MoeOrder<true> S{(const char*)(MOE_FP8 ? F.B.ws + WS_X1B8 : F.B.ws + WS_X1B), (const char*)FWS(bf16, WS_WGUT), (volatile LAS int*)(F.LC + 16), F.LC + 64, (const LAS unsigned*)(F.lds + LDS_TAB_OFF), c};
        { pg8::Unit u; LAS unsigned* tab = (LAS unsigned*)(F.lds + LDS_TAB_OFF);
          const int tid_ = F.wave * 64 + lane_id();
          for (int i = 0; i < 24 && S.next(i, u); ++i) { if (tid_ < 256) { const int rr = tid_; unsigned off = 0u;
                  if (rr < u.nrows) off = (unsigned)(FWS(int, WS_ROWTK)[(size_t)u.e * CAP + u.pm + rr] >> 2) * (MOE_FP8 ? 1024u : 2048u);
                  tab[i * 256 + rr] = off; } }
          LDS_WAIT(); __syncthreads(); }
        pg8::EpiGateUp E{F.B.b_gu, FWS(bf16, WS_ACT)};
        pg8::gemm_phase<pg8::EpiGateUp, MoeOrder<true>, true, true, MOE_FP8 != 0>(ring, 1024, S, E, F.wave); } SEAM(8);
    if (IN(9)) { REFRESH(); moe_setup(F);
        MoeOrder<false> S{(const char*)FWS(bf16, WS_ACT), (const char*)FWS(bf16, WS_WDT), (volatile LAS int*)(F.LC + 16), F.LC + 64, (const LAS unsigned*)(F.lds + LDS_TAB_OFF), c};
        pg8::EpiDown E{F.B.b_dn, FWS(int, WS_ROWTK), FWS(float, WS_ROWW), FWS(bf16, WS_OUTR)};
        pg8::gemm_phase<pg8::EpiDown, MoeOrder<false>, true, false, MOE_FP8 != 0>(ring, 1024, S, E, F.wave); } SEAM(9);
    if (IN(10)) { REFRESH(); final_phase(F); }
#undef IN
#undef SEAM
}
#ifndef OPT_MASK
#define OPT_MASK 0x7FF
#endif
#ifndef ONE_LAUNCH
#define ONE_LAUNCH 1
#endif
template <int NB, class AF, class BF, class EF> static void launch_ngemm(hipStream_t s, int M, int N, int K, const AF& af, const BF& bf, const EF& ef) {
    GArgs<AF, BF, EF> ga; memset(&ga, 0, sizeof(ga)); ga.af = af; ga.bf = bf; ga.ef = ef; ga.M = M; ga.N = N; ga.K = K; ga.pad = 0;
    ngemm<NB, AF, BF, EF><<<dim3(N / 64, M / 64), 256, 0, s>>>(ga);
}
static void launch_tr(hipStream_t s, int grid, const float* src, int lds, int c0, int width, int K, bf16* dst, int r0) {
    TrArgs a; memset(&a, 0, sizeof(a)); a.src = src; a.dst = dst; a.lds = lds; a.c0 = c0; a.width = width; a.K = K; a.r0 = r0; a.pad = 0;
    n_tr<<<grid, 256, 0, s>>>(a);
}
static AF_rows mk_rows(const void* p, int ld) { AF_rows a; memset(&a, 0, sizeof(a)); a.A = (const bf16*)p; a.ld = ld; a.pad = 0; return a; }
static BF_wt mk_wt(const void* p, int K) { BF_wt a; memset(&a, 0, sizeof(a)); a.W = (const bf16*)p; a.K = K; a.pad = 0; return a; }
static void run_naive(const Bufs& B, hipStream_t s, int stage) {
    unsigned char* ws = B.ws;
    switch (stage) {
    case 0: {
        n_xb<<<2048, 256, 0, s>>>(B);
        bf16* wint = (bf16*)(ws + WS_WINT); bf16* wvt = (bf16*)(ws + WS_WVT);
        launch_tr(s, 1024, B.w_in, INW, 0, 2048, 1024, wint, 0);
        launch_tr(s, 1024, B.w_in, INW, 2048, 1024, 1024, wvt, 0);
        launch_tr(s, 1024, B.w_in, INW, 3072, 2048, 1024, wint, 2048);
        launch_tr(s, 1024, B.w_in, INW, 5120, 2048, 1024, wvt, 1024);
        launch_tr(s, 1024, B.w_in, INW, 7168, 4096, 1024, wint, 4096);
        launch_tr(s, 1024, B.w_bsb, 1024, 0, 1024, 1024, (bf16*)(ws + WS_WBSBT), 0);
        launch_tr(s, 1024, B.w_bret, 1024, 0, 1024, 2048, (bf16*)(ws + WS_WBRETT), 0);
        launch_tr(s, 1024, B.w_out, 1024, 0, 1024, 1024, (bf16*)(ws + WS_WOUTT), 0);
        launch_tr(s, 64, B.w_router, 32, 0, 32, 1024, (bf16*)(ws + WS_WRT), 0);
        { Tr2Args a; memset(&a, 0, sizeof(a)); a.src = B.w_gu; a.dst = (bf16*)(ws + WS_WGUT); n_tr_gu<<<4096, 256, 0, s>>>(a); }
        { Tr2Args a; memset(&a, 0, sizeof(a)); a.src = B.w_dn; a.dst = (bf16*)(ws + WS_WDT); n_tr_dn<<<4096, 256, 0, s>>>(a); }
        n_rope<<<1024, 256, 0, s>>>(B);
    } break;
    case 1: {
        BF_inproj bf; memset(&bf, 0, sizeof(bf)); bf.wint = (const bf16*)(ws + WS_WINT); bf.wvt = (const bf16*)(ws + WS_WVT); EF_inproj ef{B};
        launch_ngemm<1>(s, NTOK, INW, 1024, mk_rows((unsigned char*)B.out + DO_XB, 1024), bf, ef);
        n_rotary<<<4096, 256, 0, s>>>(B);
    } break;
    case 2: n_attn<<<BATCH * SBH * SEQ / 64, 64, 0, s>>>(B);
        if (OPT_MASK & 1) { { Tr2Args a; memset(&a, 0, sizeof(a)); a.src = B.w_gu; a.dst = (bf16*)(ws + WS_WGUT); n_tr_gu<<<4096, 256, 0, s>>>(a); }
                            { Tr2Args a; memset(&a, 0, sizeof(a)); a.src = B.w_dn; a.dst = (bf16*)(ws + WS_WDT); n_tr_dn<<<4096, 256, 0, s>>>(a); } }
        break;
    case 3: n_scan<<<BATCH * RH * RDV, 64, 0, s>>>(B); break;
    case 4: n_intra<<<BATCH * RH * NCHUNK, 256, 0, s>>>(B); break;
    case 5: {
        { EF_m1 ef{B}; launch_ngemm<1>(s, NTOK, 1024, 1024, mk_rows(ws + WS_QSB, 1024), mk_wt(ws + WS_WBSBT, 1024), ef); }
        { EF_mg ef{B}; launch_ngemm<1>(s, NTOK, 1024, 2048, mk_rows((unsigned char*)B.out + DO_R, 2048), mk_wt(ws + WS_WBRETT, 2048), ef); }
    } break;
    case 6: { EF_pre ef{B}; launch_ngemm<1>(s, NTOK, 1024, 1024, mk_rows(ws + WS_MG, 1024), mk_wt(ws + WS_WOUTT, 1024), ef); } break;
    case 7: n_ln1<<<NTOK / 4, 256, 0, s>>>(B); n_router<<<NTOK / 64, 64, 0, s>>>(B); break;
    case 8: { n_tstart<<<1, 64, 0, s>>>(B); n_rowinfo<<<544, 256, 0, s>>>(B); AF_gather af{B}; BF_gu bf{B}; EF_gu ef{B}; launch_ngemm<2>(s, MAXROWS, 1024, 1024, af, bf, ef); } break;
    case 9: { n_tstart<<<1, 64, 0, s>>>(B); n_rowinfo<<<544, 256, 0, s>>>(B); AF_act af{B}; BF_dn bf{B}; EF_dn ef{B}; launch_ngemm<1>(s, MAXROWS, 1024, 1024, af, bf, ef); } break;
    case 10: n_final<<<NTOK / 4, 256, 0, s>>>(B); break;
    }
}
static void run_mega(const Bufs& B, hipStream_t s, int lo, int hi) {
    MArgs a; memset(&a, 0, sizeof(a)); a.B = B; a.ph_lo = lo; a.ph_hi = hi;
    hipLaunchKernelGGL(mega_fwd, dim3(256), dim3(NWAVES * 64), LDS_BYTES, s, a);
}

extern "C" void kernel_launch(void* const* d_in, const int* in_sizes, int n_in, void* d_out, int out_size, void* d_ws, size_t ws_size, hipStream_t stream) {
    if (n_in != 15 || out_size != NTOK * DM || ws_size < WS_END) { fprintf(stderr, "kernel_launch: unexpected shapes (n_in %d out %d ws %zu)\n", n_in, out_size, ws_size); return; }
    static int inited = 0;
    if (!inited) { inited = 1;
        if (hipFuncSetAttribute((const void*)mega_fwd, hipFuncAttributeMaxDynamicSharedMemorySize, LDS_BYTES) != hipSuccess) fprintf(stderr, "kernel_launch: hipFuncSetAttribute failed\n");
        int dev = 0, cus = 0; (void)hipGetDevice(&dev); (void)hipDeviceGetAttribute(&cus, hipDeviceAttributeMultiprocessorCount, dev);
        if (cus != 256) fprintf(stderr, "kernel_launch: built for 256 CUs, device has %d\n", cus);
        (void)hipGetLastError(); }
    Bufs B; memset(&B, 0, sizeof(B));
    B.x = (const float*)d_in[0]; B.w_in = (const float*)d_in[1]; B.w_bsb = (const float*)d_in[2]; B.w_bret = (const float*)d_in[3]; B.w_out = (const float*)d_in[4];
    B.ln1_g = (const float*)d_in[5]; B.ln1_b = (const float*)d_in[6]; B.w_router = (const float*)d_in[7]; B.b_router = (const float*)d_in[8];
    B.w_gu = (const float*)d_in[9]; B.b_gu = (const float*)d_in[10]; B.w_dn = (const float*)d_in[11]; B.b_dn = (const float*)d_in[12]; B.ln2_g = (const float*)d_in[13]; B.ln2_b = (const float*)d_in[14];
    B.out = (float*)d_out; B.ws = (unsigned char*)d_ws;
    (void)hipMemsetAsync((char*)d_ws + WS_CTL, 0, CTL_ZERO_BYTES, stream);
    if ((OPT_MASK & 0x7FF) == 0x7FF && ONE_LAUNCH) { run_mega(B, stream, 0, NPHASE); return; }
    for (int st = 0; st < NPHASE; ++st) { if ((OPT_MASK >> st) & 1) run_mega(B, stream, st, st + 1); else run_naive(B, stream, st);
#ifdef PROBE_DUP
        if (st == PROBE_DUP) {
            if (st == 2) { run_mega(B, stream, 1, 2); run_mega(B, stream, 2, 3); }
            else if (st == 4) { run_mega(B, stream, 3, 4); run_mega(B, stream, 4, 5); }
            else if (st == 7) { (void)hipMemsetAsync((char*)d_ws + WS_CTL, 0, CTL_ZERO_BYTES, stream); run_mega(B, stream, 6, 7); run_mega(B, stream, 7, 8); }
            else if (st == 10) { (void)hipMemsetAsync((char*)d_ws + WS_CTL, 0, CTL_ZERO_BYTES, stream); run_mega(B, stream, 6, 7); run_mega(B, stream, 7, 8); run_mega(B, stream, 10, 11); }
            else {
#ifndef PROBE_REP
#define PROBE_REP 1
#endif
                for (int rep = 0; rep < PROBE_REP; ++rep) run_mega(B, stream, st, st + 1); }
        }
#endif
    }
}
```

```cpp
#include <hip/hip_runtime.h>
#include <cstdio>
#include <cstdint>
#include <cstring>

constexpr int BATCH = 4, SEQ = 8192, DM = 1024, NTOK = BATCH * SEQ;
constexpr int SBH = 16, SBD = 64;
constexpr int RH = 4, RDK = 256, RDV = 512, RQK = RH * RDK  , RV = RH * RDV  ;
constexpr int CHUNK = 64, NCHUNK = SEQ / CHUNK;
constexpr int INW = 11264;
constexpr int NEXP = 32, TOPK = 4, DFF = 1024;
constexpr int CAP = NTOK;
constexpr int MAXROWS = NTOK * TOPK + NEXP * 256;
constexpr float LN_EPS = 1e-5f;
constexpr float DN_ALPHA = 1.18920711500272106672f;
constexpr float LOG2E = 1.4426950408889634f;
constexpr float SB_C2 = 0.125f * LOG2E;

typedef unsigned short bf16;
typedef float f32x4 __attribute__((ext_vector_type(4)));
typedef float f32x16 __attribute__((ext_vector_type(16)));
typedef short bf16x8 __attribute__((ext_vector_type(8)));
typedef short bf16x4 __attribute__((ext_vector_type(4)));
typedef unsigned u32x4 __attribute__((ext_vector_type(4)));
typedef unsigned u32x2 __attribute__((ext_vector_type(2)));

__host__ __device__ __forceinline__ float bf2f(bf16 v) { unsigned u = (unsigned)v << 16; return __builtin_bit_cast(float, u); }
__host__ __device__ __forceinline__ bf16 f2bf(float f) { unsigned u = __builtin_bit_cast(unsigned, f); return (bf16)((u + 0x7fffu + ((u >> 16) & 1u)) >> 16); }
__device__ __forceinline__ unsigned pk2(float lo, float hi) { return (unsigned)f2bf(lo) | ((unsigned)f2bf(hi) << 16); }

#ifndef MOE_FP8
#define MOE_FP8 1
#endif
#ifndef INPROJ_FP8
#define INPROJ_FP8 1
#endif
constexpr float IN_WSCALE = 32.0f, IN_DS = INPROJ_FP8 ? 1.0f / 32.0f : 1.0f;
constexpr float MOE_WSCALE = 64.0f, MOE_DESCALE = MOE_FP8 ? 1.0f / 64.0f : 1.0f;
__device__ __forceinline__ unsigned pk4_fp8(float a, float b, float c, float d) { int w = 0; w = __builtin_amdgcn_cvt_pk_fp8_f32(a, b, w, false); w = __builtin_amdgcn_cvt_pk_fp8_f32(c, d, w, true); return (unsigned)w; }

constexpr size_t MiB = 1u << 20;
constexpr size_t WS_CTL = 0, CTL_ZERO_BYTES = 1 * MiB;
constexpr size_t WS_COS = 1 * MiB, WS_SIN = 5 * MiB;
constexpr size_t WS_WRT = 9 * MiB;
constexpr size_t WS_TSTART = 9 * MiB + 512 * 1024;
constexpr size_t WS_WINT = 10 * MiB;
constexpr size_t WS_WVT = 26 * MiB;
constexpr size_t WS_WBSBT = 32 * MiB, WS_WBRETT = 34 * MiB, WS_WOUTT = 38 * MiB;
constexpr size_t WS_WGUT = 40 * MiB;
constexpr size_t WS_WDT = 168 * MiB;
constexpr size_t WS_QSB = 232 * MiB;
constexpr size_t WS_KSB = 296 * MiB;
constexpr size_t WS_VSBT = 360 * MiB;
constexpr size_t WS_YINT = 296 * MiB;
constexpr size_t WS_QR = 424 * MiB, WS_KR = 488 * MiB;
constexpr size_t WS_VRT = 552 * MiB;
constexpr size_t WS_SG = 680 * MiB;
constexpr size_t WS_GSB = 808 * MiB, WS_GRET = 872 * MiB;
constexpr size_t WS_SELE = 936 * MiB, WS_SELW = 937 * MiB;
constexpr size_t WS_ROWTK = 940 * MiB, WS_ROWW = 944 * MiB;
constexpr size_t WS_RINFO = 948 * MiB;
constexpr size_t WS_M1 = 424 * MiB, WS_MG = 488 * MiB;
constexpr size_t WS_X1B = 552 * MiB;
constexpr size_t WS_ACT = 616 * MiB;
constexpr size_t WS_OUTR = 232 * MiB;
constexpr size_t WS_END = 1024 * MiB;
static_assert(WS_ACT + (size_t)MAXROWS * 1024 * 2 <= WS_SELE, "ACT fits");
static_assert(WS_OUTR + (size_t)NTOK * 4 * 1024 * 2 <= WS_MG, "OUTR fits below MG");
constexpr size_t DO_XB = 0, DO_KRT = 64 * MiB;

__host__ __device__ __forceinline__ size_t krt_idx(int bh, int t, int d) { return ((((size_t)bh * 128 + (t >> 6)) * 4 + ((t >> 4) & 3)) * 256 + d) * 16 + (t & 15); }
__host__ __device__ __forceinline__ size_t vrt_idx(int bh, int t, int v) { return ((((size_t)bh * 128 + (t >> 6)) * 4 + ((t >> 4) & 3)) * 512 + v) * 16 + (t & 15); }
__host__ __device__ __forceinline__ size_t qrs_idx(int bh, int t, int d) { return ((((size_t)bh * 128 + (t >> 6)) * 16 + (d >> 4)) * 64 + (t & 63)) * 16 + (d & 15); }
__host__ __device__ __forceinline__ size_t yt_idx(int bh, int t, int v) { return ((((size_t)bh * 128 + (t >> 6)) * 64 + (v >> 3)) * 64 + (t & 63)) * 8 + (v & 7); }
__host__ __device__ __forceinline__ size_t ksb_idx(int bh, int t, int d) { return ((((size_t)bh * 256 + (t >> 5)) * 4 + (d >> 4)) * 32 + (t & 31)) * 16 + (d & 15); }
__host__ __device__ __forceinline__ size_t vsb_idx(int bh, int t, int d) { return (((size_t)bh * 512 + (t >> 4)) * 64 + d) * 16 + (t & 15); }
constexpr size_t WS_X1B8 = 888 * MiB;
constexpr size_t WS_QRS = 952 * MiB;
constexpr size_t DO_R = 0;
static_assert(WS_QRS + 64 * MiB <= WS_END, "QRS fits");

constexpr int CW_TMO = 0, CW_CODE = 1;
constexpr int CW_BAR = 4096;
constexpr int CW_CNT = 16384;

struct Bufs {
    const float *x, *w_in, *w_bsb, *w_bret, *w_out, *ln1_g, *ln1_b, *w_router, *b_router, *w_gu, *b_gu, *w_dn, *b_dn, *ln2_g, *ln2_b;
    float* out; unsigned char* ws;
};
#define WSP(T, off) ((T*)(B.ws + (off)))
#define DOP(T, off) ((T*)((unsigned char*)B.out + (off)))

__global__ void n_xb(Bufs B) {
    const size_t n = (size_t)NTOK * DM; bf16* xb = DOP(bf16, DO_XB);
    for (size_t i = (size_t)blockIdx.x * blockDim.x + threadIdx.x; i < n; i += (size_t)gridDim.x * blockDim.x) xb[i] = f2bf(B.x[i]);
}
struct TrArgs { const float* src; bf16* dst; int lds, c0, width, K, r0, pad; };
__global__ void n_tr(TrArgs a) {
    const float* src = a.src; bf16* dst = a.dst; const int lds = a.lds, c0 = a.c0, width = a.width, K = a.K, r0 = a.r0;
    const size_t n = (size_t)width * K;
    for (size_t i = (size_t)blockIdx.x * blockDim.x + threadIdx.x; i < n; i += (size_t)gridDim.x * blockDim.x) {
        const int k = (int)(i % K), c = (int)(i / K); dst[(size_t)(r0 + c) * K + k] = f2bf(src[(size_t)k * lds + c0 + c]); }
}
struct Tr2Args { const float* src; bf16* dst; };
__global__ void n_tr_gu(Tr2Args a) { const float* src = a.src; bf16* dst = a.dst;
    const size_t n = (size_t)NEXP * 2048 * 1024;
    for (size_t i = (size_t)blockIdx.x * blockDim.x + threadIdx.x; i < n; i += (size_t)gridDim.x * blockDim.x) {
        const int k = (int)(i % 1024); const int r = (int)((i / 1024) % 2048); const int e = (int)(i / (1024 * 2048));
        const int ct = r >> 8, bj = (r >> 7) & 1, ii = r & 127; const int c = bj * 1024 + 128 * ct + ii;
        dst[i] = f2bf(src[((size_t)e * 1024 + k) * 2048 + c]); }
}
__global__ void n_tr_dn(Tr2Args a) { const float* src = a.src; bf16* dst = a.dst;
    const size_t n = (size_t)NEXP * 1024 * 1024;
    for (size_t i = (size_t)blockIdx.x * blockDim.x + threadIdx.x; i < n; i += (size_t)gridDim.x * blockDim.x) {
        const int ff = (int)(i % 1024); const int d = (int)((i / 1024) % 1024); const int e = (int)(i / (1024 * 1024));
        dst[i] = f2bf(src[((size_t)e * 1024 + ff) * 1024 + d]); }
}
__device__ __forceinline__ float rope_inv_freq(int j) { return powf(10000.0f, -(float)j / 128.0f); }
__global__ void n_rope(Bufs B) {
    float* c = WSP(float, WS_COS); float* s = WSP(float, WS_SIN);
    for (int i = blockIdx.x * blockDim.x + threadIdx.x; i < SEQ * 128; i += gridDim.x * blockDim.x) {
        const int pos = i >> 7, j = i & 127; const float ang = (float)pos * rope_inv_freq(j);
        c[i] = (float)cos((double)ang); s[i] = (float)sin((double)ang); }
}

template <class AF, class BF, class EF> struct GArgs { AF af; BF bf; EF ef; int M, N, K, pad; };
template <int NB, class AF, class BF, class EF>
__global__ void __launch_bounds__(256) ngemm(GArgs<AF, BF, EF> ga) {
    const AF& af = ga.af; const BF& bf = ga.bf; const EF& ef = ga.ef; const int K = ga.K;
    __shared__ float As[16][65], Bs[NB][16][65];
    const int tx = threadIdx.x & 15, ty = threadIdx.x >> 4;
    const int m0 = blockIdx.y * 64, n0 = blockIdx.x * 64;
    if (!af.active(m0)) return;
    float acc[NB][4][4];
#pragma unroll
    for (int b = 0; b < NB; ++b)
#pragma unroll
        for (int i = 0; i < 4; ++i)
#pragma unroll
            for (int j = 0; j < 4; ++j) acc[b][i][j] = 0.f;
    for (int k0 = 0; k0 < K; k0 += 16) {
#pragma unroll
        for (int i = 0; i < 4; ++i) { const int idx = threadIdx.x + 256 * i; const int kk = idx & 15, mm = idx >> 4; As[kk][mm] = af(m0 + mm, k0 + kk); }
#pragma unroll
        for (int b = 0; b < NB; ++b)
#pragma unroll
            for (int i = 0; i < 4; ++i) { const int idx = threadIdx.x + 256 * i; const int kk = idx & 15, nn = idx >> 4; Bs[b][kk][nn] = bf(m0, k0 + kk, n0 + nn, b); }
        __syncthreads();
#pragma unroll
        for (int kk = 0; kk < 16; ++kk) {
            float a[4];
#pragma unroll
            for (int i = 0; i < 4; ++i) a[i] = As[kk][ty * 4 + i];
#pragma unroll
            for (int b = 0; b < NB; ++b) {
                float bb[4];
#pragma unroll
                for (int j = 0; j < 4; ++j) bb[j] = Bs[b][kk][tx * 4 + j];
#pragma unroll
                for (int i = 0; i < 4; ++i)
#pragma unroll
                    for (int j = 0; j < 4; ++j) acc[b][i][j] += a[i] * bb[j];
            }
        }
        __syncthreads();
    }
#pragma unroll
    for (int i = 0; i < 4; ++i)
#pragma unroll
        for (int j = 0; j < 4; ++j) {
            float v[NB];
#pragma unroll
            for (int b = 0; b < NB; ++b) v[b] = acc[b][i][j];
            ef(m0 + ty * 4 + i, n0 + tx * 4 + j, v);
        }
}

__device__ __forceinline__ float sigmoidf_(float x) { return 1.0f / (1.0f + __expf(-x)); }
__device__ __forceinline__ float ret_log2gamma(int h) { return log2f(1.0f - exp2f(-5.0f - (float)h)); }

struct AF_rows { const bf16* A; int ld, pad; __device__ bool active(int) const { return true; } __device__ float operator()(int m, int k) const { return bf2f(A[(size_t)m * ld + k]); } };
struct BF_inproj { const bf16 *wint, *wvt;
    __device__ float operator()(int, int k, int n, int) const {
        const bf16* row;
        if (n < 2048) row = wint + (size_t)n * 1024;
        else if (n < 3072) row = wvt + (size_t)(n - 2048) * 1024;
        else if (n < 5120) row = wint + (size_t)(2048 + n - 3072) * 1024;
        else if (n < 7168) row = wvt + (size_t)(1024 + n - 5120) * 1024;
        else row = wint + (size_t)(4096 + n - 7168) * 1024;
        return bf2f(row[k]); } };
struct EF_inproj { Bufs B;
    __device__ void operator()(int m, int n, const float (&v)[1]) const {
        const float a = v[0];
        if (n < 1024) WSP(bf16, WS_QSB)[(size_t)m * 1024 + n] = f2bf(a * SB_C2);
        else if (n < 2048) { const int f = n - 1024; WSP(bf16, WS_KSB)[ksb_idx((m >> 13) * 16 + (f >> 6), m & (SEQ - 1), f & 63)] = f2bf(a); }
        else if (n < 3072) { const int f = n - 2048; WSP(bf16, WS_VSBT)[vsb_idx((m >> 13) * 16 + (f >> 6), m & (SEQ - 1), f & 63)] = f2bf(a); }
        else if (n < 4096) WSP(bf16, WS_QR)[(size_t)m * 1024 + n - 3072] = f2bf(a);
        else if (n < 5120) WSP(bf16, WS_KR)[(size_t)m * 1024 + n - 4096] = f2bf(a);
        else if (n < 7168) { const int f = n - 5120, h = f >> 9; const float dec = exp2f((float)(63 - (m & 63)) * ret_log2gamma(h));
            WSP(bf16, WS_VRT)[vrt_idx((m >> 13) * 4 + h, m & (SEQ - 1), f & 511)] = f2bf(a * dec); }
        else if (n < 9216) { const int f = n - 7168; WSP(bf16, WS_SG)[yt_idx((m >> 13) * 4 + (f >> 9), m & (SEQ - 1), f & 511)] = f2bf(a * sigmoidf_(a)); }
        else if (n < 10240) WSP(bf16, WS_GSB)[(size_t)m * 1024 + n - 9216] = f2bf(sigmoidf_(a));
        else WSP(bf16, WS_GRET)[(size_t)m * 1024 + n - 10240] = f2bf(sigmoidf_(a)); } };
__global__ void n_rotary(Bufs B) {
    bf16* qr = WSP(bf16, WS_QR); bf16* kr = WSP(bf16, WS_KR); bf16* krt = DOP(bf16, DO_KRT);
    const float* ct = WSP(float, WS_COS); const float* st = WSP(float, WS_SIN);
    const size_t n = (size_t)NTOK * RH * 128;
    for (size_t i = (size_t)blockIdx.x * blockDim.x + threadIdx.x; i < n; i += (size_t)gridDim.x * blockDim.x) {
        const int j = (int)(i & 127), h = (int)((i >> 7) & 3); const int m = (int)(i >> 9); const int pos = m & (SEQ - 1);
        const float c = ct[pos * 128 + j], s = st[pos * 128 + j];
        const size_t o1 = (size_t)m * 1024 + h * 256 + j, o2 = o1 + 128;
        const int bh = (m >> 13) * 4 + h;
        { const float x1 = bf2f(qr[o1]), x2 = bf2f(qr[o2]); const bf16 r1 = f2bf((x1 * c - x2 * s) * 0.0625f), r2 = f2bf((x1 * s + x2 * c) * 0.0625f); qr[o1] = r1; qr[o2] = r2;
          WSP(bf16, WS_QRS)[qrs_idx(bh, pos, j)] = r1; WSP(bf16, WS_QRS)[qrs_idx(bh, pos, j + 128)] = r2; }
        { const float x1 = bf2f(kr[o1]), x2 = bf2f(kr[o2]); const bf16 r1 = f2bf(x1 * c - x2 * s), r2 = f2bf(x1 * s + x2 * c); kr[o1] = r1; kr[o2] = r2;
          krt[krt_idx(bh, pos, j)] = r1; krt[krt_idx(bh, pos, j + 128)] = r2; }
    }
}

__global__ void __launch_bounds__(64) n_attn(Bufs B) {
    const int gid = blockIdx.x * 64 + threadIdx.x;
    const int t = gid & (SEQ - 1), bh = gid >> 13, h = bh & 15, b = bh >> 4;
    bf16* q = WSP(bf16, WS_QSB); const bf16* k = WSP(bf16, WS_KSB); const bf16* vt = WSP(bf16, WS_VSBT);
    const size_t rb = (size_t)b * SEQ;
    float qv[64], o[64];
#pragma unroll
    for (int d = 0; d < 64; ++d) { qv[d] = bf2f(q[(rb + t) * 1024 + h * 64 + d]); o[d] = 0.f; }
    float later = 0.f;
    for (int s = t - 1; s >= 0; --s) {
        float z2 = 0.f;
#pragma unroll
        for (int d = 0; d < 64; ++d) z2 += qv[d] * bf2f(k[ksb_idx(bh, s, d)]);
        const float z = z2 * 0.6931471805599453f;
        const float sp = fmaxf(z, 0.f) + log1pf(__expf(-fabsf(z)));
        const float a = __expf((z - sp) + later);
        later -= sp;
        if (a > 0.f) {
#pragma unroll
            for (int d = 0; d < 64; ++d) o[d] += a * bf2f(vt[vsb_idx(bh, s, d)]);
        }
    }
#pragma unroll
    for (int d = 0; d < 64; ++d) q[(rb + t) * 1024 + h * 64 + d] = f2bf(o[d]);
}

__global__ void __launch_bounds__(64) n_scan(Bufs B) {
    const int gid = blockIdx.x, v = gid & 511, h = (gid >> 9) & 3, b = gid >> 11, lane = threadIdx.x;
    const bf16* qr = WSP(bf16, WS_QR); const bf16* krt = DOP(bf16, DO_KRT); const bf16* vrt = WSP(bf16, WS_VRT); bf16* yint = WSP(bf16, WS_YINT);
    const float l2g = ret_log2gamma(h), cd = exp2f(64.f * l2g);
    float st[4] = {0.f, 0.f, 0.f, 0.f};
    for (int c = 0; c < NCHUNK; ++c) {
        const size_t tok0 = (size_t)b * SEQ + c * 64;
        for (int i = 0; i < 64; ++i) {
            const bf16* qp = qr + (tok0 + i) * 1024 + h * 256 + 4 * lane;
            float p = bf2f(qp[0]) * st[0] + bf2f(qp[1]) * st[1] + bf2f(qp[2]) * st[2] + bf2f(qp[3]) * st[3];
#pragma unroll
            for (int o = 1; o < 64; o <<= 1) p += __shfl_xor(p, o);
            if (lane == 0) yint[yt_idx(b * 4 + h, c * 64 + i, v)] = f2bf(p * exp2f((float)(i + 1) * l2g));
        }
        float ns[4] = {st[0] * cd, st[1] * cd, st[2] * cd, st[3] * cd};
        for (int j = 0; j < 64; ++j) {
            const float vv = bf2f(vrt[vrt_idx(b * 4 + h, c * 64 + j, v)]);
#pragma unroll
            for (int e = 0; e < 4; ++e) ns[e] += bf2f(krt[krt_idx(b * 4 + h, c * 64 + j, 4 * lane + e)]) * vv;
        }
#pragma unroll
        for (int e = 0; e < 4; ++e) st[e] = ns[e];
    }
}

__global__ void __launch_bounds__(256) n_intra(Bufs B) {
    __shared__ float P[64][65]; __shared__ float Y[8][512]; __shared__ float stat[8][2];
    const int gid = blockIdx.x, c = gid & 127, h = (gid >> 7) & 3, b = gid >> 9, tid = threadIdx.x;
    const bf16* qr = WSP(bf16, WS_QR); const bf16* kr = WSP(bf16, WS_KR); const bf16* vrt = WSP(bf16, WS_VRT); const bf16* sg = WSP(bf16, WS_SG); const bf16* yr = WSP(bf16, WS_YINT); bf16* rout = DOP(bf16, DO_R);
    const size_t tok0 = (size_t)b * SEQ + c * 64; const float l2g = ret_log2gamma(h);
    for (int e = tid; e < 4096; e += 256) { const int i = e >> 6, j = e & 63; float s = 0.f;
        const bf16* qp = qr + (tok0 + i) * 1024 + h * 256; const bf16* kp = kr + (tok0 + j) * 1024 + h * 256;
        for (int d = 0; d < 256; ++d) s += bf2f(qp[d]) * bf2f(kp[d]);
        const int ad = i > j ? i - j : j - i; P[i][j] = s * exp2f((float)(ad - 63 + j) * l2g); }
    __syncthreads();
    for (int i0 = 0; i0 < 64; i0 += 8) {
        for (int vv = tid; vv < 512; vv += 256) {
            float acc[8] = {0.f, 0.f, 0.f, 0.f, 0.f, 0.f, 0.f, 0.f};
            for (int j = 0; j < 64; ++j) { const float x = bf2f(vrt[vrt_idx(b * 4 + h, c * 64 + j, vv)]);
#pragma unroll
                for (int r = 0; r < 8; ++r) acc[r] += P[i0 + r][j] * x; }
#pragma unroll
            for (int r = 0; r < 8; ++r) Y[r][vv] = acc[r] + bf2f(yr[yt_idx(b * 4 + h, c * 64 + i0 + r, vv)]);
        }
        __syncthreads();
        { const int w = tid >> 6, lane = tid & 63;
          for (int r = w; r < 8; r += 4) { float s = 0.f, s2 = 0.f;
              for (int vv = lane; vv < 512; vv += 64) { const float x = Y[r][vv]; s += x; }
#pragma unroll
              for (int o = 1; o < 64; o <<= 1) s += __shfl_xor(s, o);
              const float mean = s * (1.f / 512.f);
              for (int vv = lane; vv < 512; vv += 64) { const float x = Y[r][vv] - mean; s2 += x * x; }
#pragma unroll
              for (int o = 1; o < 64; o <<= 1) s2 += __shfl_xor(s2, o);
              if (lane == 0) { stat[r][0] = mean; stat[r][1] = rsqrtf(s2 * (1.f / 512.f) + LN_EPS); } } }
        __syncthreads();
        for (int e = tid; e < 8 * 512; e += 256) { const int r = e >> 9, vv = e & 511; const size_t o = (tok0 + i0 + r) * 2048 + h * 512 + vv;
            rout[o] = f2bf(bf2f(sg[yt_idx(b * 4 + h, c * 64 + i0 + r, vv)]) * (Y[r][vv] - stat[r][0]) * stat[r][1]); }
        __syncthreads();
    }
}

struct BF_wt { const bf16* W; int K, pad; __device__ float operator()(int, int k, int n, int) const { return bf2f(W[(size_t)n * K + k]); } };
struct EF_m1 { Bufs B; __device__ void operator()(int m, int n, const float (&v)[1]) const { const size_t o = (size_t)m * 1024 + n; WSP(bf16, WS_M1)[o] = f2bf(bf2f(WSP(bf16, WS_GSB)[o]) * v[0]); } };
struct EF_mg { Bufs B; __device__ void operator()(int m, int n, const float (&v)[1]) const { const size_t o = (size_t)m * 1024 + n; WSP(bf16, WS_MG)[o] = f2bf(bf2f(WSP(bf16, WS_M1)[o]) + bf2f(WSP(bf16, WS_GRET)[o]) * v[0]); } };
struct EF_pre { Bufs B; __device__ void operator()(int m, int n, const float (&v)[1]) const { const size_t o = (size_t)m * 1024 + n; B.out[o] = DN_ALPHA * B.x[o] + v[0]; } };

__device__ __forceinline__ float wave_sum(float v) {
#pragma unroll
    for (int o = 1; o < 64; o <<= 1) v += __shfl_xor(v, o);
    return v;
}
__global__ void __launch_bounds__(256) n_ln1(Bufs B) {
    const int row = blockIdx.x * 4 + (threadIdx.x >> 6), lane = threadIdx.x & 63;
    float* p = B.out + (size_t)row * 1024; bf16* xb = WSP(bf16, WS_X1B) + (size_t)row * 1024;
    float v[16]; float s = 0.f;
#pragma unroll
    for (int j = 0; j < 16; ++j) { v[j] = p[lane + 64 * j]; s += v[j]; }
    const float mean = wave_sum(s) * (1.f / 1024.f); float s2 = 0.f;
#pragma unroll
    for (int j = 0; j < 16; ++j) { v[j] -= mean; s2 += v[j] * v[j]; }
    const float rstd = rsqrtf(wave_sum(s2) * (1.f / 1024.f) + LN_EPS);
#pragma unroll
    for (int j = 0; j < 16; ++j) { const int c = lane + 64 * j; const float y = v[j] * rstd * B.ln1_g[c] + B.ln1_b[c]; p[c] = y; xb[c] = f2bf(y); }
}
__global__ void __launch_bounds__(64) n_router(Bufs B) {
    const int tok = blockIdx.x * 64 + threadIdx.x;
    const bf16* xb = WSP(bf16, WS_X1B) + (size_t)tok * 1024; const bf16* wr = WSP(bf16, WS_WRT);
    float lg[32];
#pragma unroll
    for (int e = 0; e < 32; ++e) lg[e] = 0.f;
    for (int k = 0; k < 1024; ++k) { const float xv = bf2f(xb[k]);
#pragma unroll
        for (int e = 0; e < 32; ++e) lg[e] += xv * bf2f(wr[e * 1024 + k]); }
#pragma unroll
    for (int e = 0; e < 32; ++e) lg[e] += B.b_router[e];
    int se[4]; float sv[4];
#pragma unroll
    for (int kk = 0; kk < 4; ++kk) { float best = -INFINITY; int bi = 0;
#pragma unroll
        for (int e = 0; e < 32; ++e) { if (lg[e] > best) { best = lg[e]; bi = e; } }
        se[kk] = bi; sv[kk] = best;
#pragma unroll
        for (int e = 0; e < 32; ++e) if (e == bi) lg[e] = -INFINITY; }
    const float e1 = __expf(sv[1] - sv[0]), e2 = __expf(sv[2] - sv[0]), e3 = __expf(sv[3] - sv[0]); const float inv = 1.f / (1.f + e1 + e2 + e3);
    const float w[4] = {inv, e1 * inv, e2 * inv, e3 * inv};
    unsigned* cnt = WSP(unsigned, WS_CTL) + CW_CNT;
#pragma unroll
    for (int kk = 0; kk < 4; ++kk) { WSP(int, WS_SELE)[tok * 4 + kk] = se[kk]; WSP(float, WS_SELW)[tok * 4 + kk] = w[kk];
        const unsigned pos = atomicAdd(cnt + 64 * se[kk], 1u);
        WSP(int, WS_ROWTK)[(size_t)se[kk] * CAP + pos] = tok * 4 + kk; WSP(float, WS_ROWW)[(size_t)se[kk] * CAP + pos] = w[kk]; }
}
__global__ void n_tstart(Bufs B) {
    if (threadIdx.x == 0 && blockIdx.x == 0) { int* ts = WSP(int, WS_TSTART); const unsigned* cnt = WSP(unsigned, WS_CTL) + CW_CNT; int acc = 0;
        for (int e = 0; e < NEXP; ++e) { ts[e] = acc; acc += (int)((cnt[64 * e] + 255u) >> 8); } ts[NEXP] = acc; }
}
struct MoeRow { int e, valid, tk; float w; };
__global__ void n_rowinfo(Bufs B) {
    const int* ts = WSP(int, WS_TSTART); const unsigned* cnt = WSP(unsigned, WS_CTL) + CW_CNT; MoeRow* ri = WSP(MoeRow, WS_RINFO);
    for (int m = blockIdx.x * blockDim.x + threadIdx.x; m < MAXROWS; m += gridDim.x * blockDim.x) {
        MoeRow r; const int rt = m >> 8; int e = 0;
        while (e < NEXP - 1 && rt >= ts[e + 1]) ++e;
        const int pos = m - 256 * ts[e];
        r.e = e; r.valid = (rt < ts[NEXP]) && (pos < (int)cnt[64 * e]);
        r.tk = r.valid ? WSP(int, WS_ROWTK)[(size_t)e * CAP + pos] : 0; r.w = r.valid ? WSP(float, WS_ROWW)[(size_t)e * CAP + pos] : 0.f; ri[m] = r; }
}
struct AF_gather { Bufs B; __device__ bool active(int m0) const { return (m0 >> 8) < WSP(int, WS_TSTART)[NEXP]; }
    __device__ float operator()(int m, int k) const { const int tk = WSP(MoeRow, WS_RINFO)[m].tk; return bf2f(WSP(bf16, WS_X1B)[(size_t)(tk >> 2) * 1024 + k]); } };
struct BF_gu { Bufs B; __device__ float operator()(int m0, int k, int n, int which) const { const int e = WSP(MoeRow, WS_RINFO)[m0].e;
        const int ct = n >> 7, i = n & 127; return bf2f(WSP(bf16, WS_WGUT)[((size_t)e * 2048 + 256 * ct + 128 * which + i) * 1024 + k]); } };
__device__ __forceinline__ float moe_act(float g, float u) {
    g = fminf(g, 7.0f); u = fminf(fmaxf(u, -7.0f), 7.0f); const float glu = g * (1.0f / (1.0f + __expf(-1.702f * g))); return (u + 1.0f) * glu; }
struct EF_gu { Bufs B; __device__ void operator()(int m, int n, const float (&v)[2]) const { const MoeRow r = WSP(MoeRow, WS_RINFO)[m]; if (!r.valid) return;
        const float g = v[0] + B.b_gu[r.e * 2048 + n], u = v[1] + B.b_gu[r.e * 2048 + 1024 + n]; WSP(bf16, WS_ACT)[(size_t)m * 1024 + n] = f2bf(moe_act(g, u)); } };
struct AF_act { Bufs B; __device__ bool active(int m0) const { return (m0 >> 8) < WSP(int, WS_TSTART)[NEXP]; }
    __device__ float operator()(int m, int k) const { return WSP(MoeRow, WS_RINFO)[m].valid ? bf2f(WSP(bf16, WS_ACT)[(size_t)m * 1024 + k]) : 0.f; } };
struct BF_dn { Bufs B; __device__ float operator()(int m0, int k, int n, int) const { const int e = WSP(MoeRow, WS_RINFO)[m0].e; return bf2f(WSP(bf16, WS_WDT)[((size_t)e * 1024 + n) * 1024 + k]); } };
struct EF_dn { Bufs B; __device__ void operator()(int m, int n, const float (&v)[1]) const { const MoeRow r = WSP(MoeRow, WS_RINFO)[m]; if (!r.valid) return;
        WSP(bf16, WS_OUTR)[(size_t)r.tk * 1024 + n] = f2bf((v[0] + B.b_dn[r.e * 1024 + n]) * r.w); } };
__global__ void __launch_bounds__(256) n_final(Bufs B) {
    const int row = blockIdx.x * 4 + (threadIdx.x >> 6), lane = threadIdx.x & 63;
    float* p = B.out + (size_t)row * 1024; const bf16* orow = WSP(bf16, WS_OUTR) + (size_t)row * 4 * 1024;
    float v[16]; float s = 0.f;
#pragma unroll
    for (int j = 0; j < 16; ++j) { const int c = lane + 64 * j; float a = DN_ALPHA * bf2f(WSP(bf16, WS_X1B)[(size_t)row * 1024 + c]);
#pragma unroll
        for (int kk = 0; kk < 4; ++kk) a += bf2f(orow[kk * 1024 + c]);
        v[j] = a; s += a; }
    const float mean = wave_sum(s) * (1.f / 1024.f); float s2 = 0.f;
#pragma unroll
    for (int j = 0; j < 16; ++j) { v[j] -= mean; s2 += v[j] * v[j]; }
    const float rstd = rsqrtf(wave_sum(s2) * (1.f / 1024.f) + LN_EPS);
#pragma unroll
    for (int j = 0; j < 16; ++j) { const int c = lane + 64 * j; p[c] = v[j] * rstd * B.ln2_g[c] + B.ln2_b[c]; }
}

__device__ __forceinline__ int lane_id() { int l; asm volatile("v_mbcnt_lo_u32_b32 %0, -1, 0\n\tv_mbcnt_hi_u32_b32 %0, -1, %0" : "=v"(l)); return l; }
namespace pg8 {
#define PG8_LAS __attribute__((address_space(3)))
constexpr int BM = 256, BK = 64, HALF = 128, HTB = HALF * BK * 2  , STAGE_BYTES = 8 * HTB, NXCD = 8, WGM = 8;
__host__ __device__ __forceinline__ int lds_byte(int r, int c) { const int st = (r >> 4) * 2 + (c >> 5), rr = r & 15, cc = c & 31, ob = rr * 64 + cc * 2; return st * 1024 + (ob ^ (((ob >> 9) & 1) << 5)); }
__host__ __device__ __forceinline__ void stage_rc(int b, int& R, int& C) { const int st = b / 1024, sb = b % 1024, swz = sb ^ (((sb >> 9) & 1) << 5); R = (st >> 1) * 16 + swz / 64; C = (st & 1) * 32 + (swz % 64) / 2; }
__host__ __device__ __forceinline__ int perm32(int rho) { const int n = rho >> 4, i = rho & 15; return 8 * (i >> 2) + 4 * n + (i & 3); }

typedef int v8i_t __attribute__((ext_vector_type(8)));
typedef int v4i_t __attribute__((ext_vector_type(4)));
struct Unit { int pm, pn, e, idx, rbase, nrows; };

struct StaticOrder {
    const char* A; const char* Bt; int nM, nN, nwg, G, c, rb;
    __device__ void init(const void* A_, const void* Bt_, int M, int N, int K_, int G_, int c_, int eb = 2) { A = (const char*)A_; Bt = (const char*)Bt_; nM = M / BM; nN = N / BM; nwg = nM * nN; G = G_; c = c_; rb = K_ * eb; }
    __device__ bool next(int i, Unit& u) const {
        const long L = (long)i * G + c; if (L >= nwg) return false;
        int wgid = (int)L; { const int q = nwg / NXCD, r = nwg % NXCD, xcd = wgid % NXCD, off = wgid / NXCD; wgid = (xcd < r ? xcd * (q + 1) : r * (q + 1) + (xcd - r) * q) + off; }
        const int nig = WGM * nN, gid = wgid / nig, fm = gid * WGM, gsz = (nM - fm) < WGM ? (nM - fm) : WGM;
        u.pm = fm + ((wgid % nig) % gsz); u.pn = (wgid % nig) / gsz; u.e = 0; u.idx = i; u.rbase = u.pm * BM; u.nrows = BM; return true;
    }
    __device__ __forceinline__ const char* a_ptr(const Unit& u) const { return A + (size_t)u.pm * BM * rb; }
    __device__ __forceinline__ const char* b_ptr(const Unit& u) const { return Bt + (size_t)u.pn * BM * rb; }
    __device__ __forceinline__ unsigned a_off(const Unit&, int) const { return 0u; }
    __device__ __forceinline__ void a_ready(const Unit&) const {}
    __device__ __forceinline__ void done(const Unit&) const {}
};

__device__ __forceinline__ unsigned cvt_pk_bf16(float lo, float hi) { unsigned r; asm volatile("v_cvt_pk_bf16_f32 %0, %1, %2" : "=v"(r) : "v"(lo), "v"(hi)); return r; }

__device__ __forceinline__ void mfma8_inplace(f32x4& acc, const v8i_t& w8, const v8i_t& a8, int sc_w, int sc_a) {
    asm volatile("v_mfma_scale_f32_16x16x128_f8f6f4 %0, %1, %2, %0, %3, %4 op_sel_hi:[0,0,0]" : "+v"(acc) : "v"(w8), "v"(a8), "v"(sc_w), "v"(sc_a)); }
template <class Epi, class Sched, bool ALIGN_EPI, bool GATHER, bool FP8 = false>
__device__ __forceinline__ void gemm_phase(PG8_LAS unsigned char* lds, const int K, const Sched& S, const Epi& E, const int wid) {
    int lane_ = lane_id(); asm volatile("" : "+v"(lane_));
    const int lane = lane_, tid = wid * 64 + lane, wr = wid >> 2, wc = wid & 3, fr = lane & 15, fq = lane >> 4;
    constexpr int EB = FP8 ? 1 : 2;
    const int nt = K * EB / 128;
    unsigned voffB[2];
#pragma unroll
    for (int i = 0; i < 2; ++i) { int R, C; stage_rc(tid * 16 + i * 8192, R, C); const int Rb = Epi::PERM ? ((R & ~31) + perm32(R & 31)) : R;
        voffB[i] = (unsigned)(Rb * K * EB + C * 2); }
    const size_t kstep = (size_t)(BK * 2);
    const size_t hstep = (size_t)HALF * K * EB;
    const unsigned ldsw = (unsigned)wid * 1024u;
    const int aoff = lds_byte(wr * 64 + fr, fq * 8), boff = lds_byte(wc * 32 + fr, fq * 8);
#define PG8_SA(b, h) (((b) * 2 + (h)) * HTB)
#define PG8_SB(b, h) ((4 + (b) * 2 + (h)) * HTB)
#define PG8_STAGE(bufoff, gbase, voff) do { _Pragma("unroll") for (int _i = 0; _i < 2; ++_i) \
        __builtin_amdgcn_global_load_lds((const unsigned*)((const char*)(gbase) + (voff)[_i]), (PG8_LAS unsigned*)(lds + (bufoff) + ldsw + _i * 8192), 16, 0, 0); } while (0)
#define PG8_LD8(base) __builtin_shufflevector(*(const PG8_LAS v4i_t*)(lds + (base)), *(const PG8_LAS v4i_t*)(lds + (base) + 1024), 0, 1, 2, 3, 4, 5, 6, 7)
#define PG8_LDA(dst, b, h) do { _Pragma("unroll") for (int m = 0; m < 4; ++m) { if constexpr (FP8) dst##8[m] = PG8_LD8(PG8_SA(b, h) + aoff + m * 2048); else { _Pragma("unroll") for (int k = 0; k < 2; ++k) dst[m][k] = *(const PG8_LAS bf16x8*)(lds + PG8_SA(b, h) + aoff + m * 2048 + k * 1024); } } } while (0)
#define PG8_LDB(dst, b, h) do { _Pragma("unroll") for (int n = 0; n < 2; ++n) { if constexpr (FP8) dst##8[n] = PG8_LD8(PG8_SB(b, h) + boff + n * 2048); else { _Pragma("unroll") for (int k = 0; k < 2; ++k) dst[n][k] = *(const PG8_LAS bf16x8*)(lds + PG8_SB(b, h) + boff + n * 2048 + k * 1024); } } } while (0)
#define PG8_MMA(ai, bj, At, Bt) do { __builtin_amdgcn_s_setprio(1); _Pragma("unroll") for (int m = 0; m < 4; ++m) _Pragma("unroll") for (int n = 0; n < 2; ++n) { \
        if constexpr (FP8) mfma8_inplace(acc[ai][bj][m][n], Bt##8[n], At##8[m], sc_w, sc_a); \
        else { _Pragma("unroll") for (int k = 0; k < 2; ++k) acc[ai][bj][m][n] = __builtin_amdgcn_mfma_f32_16x16x32_bf16(Bt[n][k], At[m][k], acc[ai][bj][m][n], 0, 0, 0); } } \
        __builtin_amdgcn_s_setprio(0); } while (0)
#define PG8_WAIT_V(n) asm volatile("s_waitcnt vmcnt(" #n ")" ::: "memory")
#define PG8_WAIT_L(n) asm volatile("s_waitcnt lgkmcnt(" #n ")" ::: "memory")
#define PG8_BAR __builtin_amdgcn_s_barrier()
#define PG8_SCHED __builtin_amdgcn_sched_barrier(0)
#define PG8_OFFS(dst, u) do { const int _t = wid * 64 + lane_id(); _Pragma("unroll") for (int _i = 0; _i < 2; ++_i) { int _R, _C; stage_rc(_t * 16 + _i * 8192, _R, _C); \
        _Pragma("unroll") for (int _h = 0; _h < 2; ++_h) dst[_h][_i] = GATHER ? (S.a_off(u, _h * HALF + _R) + (unsigned)_C * 2u) : (unsigned)((_h * HALF + _R) * K * EB + _C * 2); } } while (0)
    Unit cur, nxt; int ui = 0;
    if (!S.next(0, cur)) return;
    f32x4 acc[2][2][4][2];
#pragma unroll
    for (int a = 0; a < 2; ++a)
#pragma unroll
        for (int b = 0; b < 2; ++b)
#pragma unroll
            for (int m = 0; m < 4; ++m)
#pragma unroll
                for (int n = 0; n < 2; ++n) acc[a][b][m][n] = (f32x4){0.f, 0.f, 0.f, 0.f};
    const int sc_w = 0x7F7F7F7F, sc_a = sc_w;
    bf16x8 At[4][2], B0[2][2], B1[2][2]; v8i_t At8[4], B08[2], B18[2];
    unsigned offA[2][2];
    PG8_OFFS(offA, cur);
    const char* cA = S.a_ptr(cur); const char* cB = S.b_ptr(cur);
    S.a_ready(cur);
    PG8_STAGE(PG8_SB(0, 0), cB, voffB); PG8_STAGE(PG8_SB(0, 1), cB + hstep, voffB); PG8_STAGE(PG8_SA(0, 0), cA, offA[0]); PG8_STAGE(PG8_SA(0, 1), cA, offA[1]);
    if (wr == 1) PG8_BAR;
    PG8_WAIT_V(2); PG8_BAR;
    PG8_STAGE(PG8_SB(1, 0), cB + kstep, voffB); PG8_STAGE(PG8_SA(1, 0), cA + kstep, offA[0]); PG8_STAGE(PG8_SB(1, 1), cB + hstep + kstep, voffB);
    PG8_WAIT_V(6); PG8_BAR;
    for (;;) {
        const bool has_next = S.next(ui + 1, nxt);
        const char* nA = has_next ? S.a_ptr(nxt) : cA; const char* nB = has_next ? S.b_ptr(nxt) : cB;
        for (int t = 0; t < nt; t += 2) {
            const bool last = (t == nt - 2);
            const char* a1 = cA + (size_t)(t + 1) * kstep;
            const char* a2 = last ? nA : cA + (size_t)(t + 2) * kstep; const char* b2 = last ? nB : cB + (size_t)(t + 2) * kstep;
            const char* a3 = a2 + kstep; const char* b3 = b2 + kstep;
            unsigned o2[2][2];
            if (GATHER && last && has_next) { PG8_OFFS(o2, nxt); }
            else {
#pragma unroll
                for (int h = 0; h < 2; ++h)
#pragma unroll
                    for (int i = 0; i < 2; ++i) o2[h][i] = offA[h][i]; }
            if (last && has_next) S.a_ready(nxt);
            PG8_LDB(B0, 0, 0); PG8_LDB(B1, 0, 1); PG8_SCHED; PG8_LDA(At, 0, 0); PG8_STAGE(PG8_SA(1, 1), a1, offA[1]);
            PG8_WAIT_V(8); PG8_WAIT_L(0); PG8_BAR; PG8_MMA(0, 0, At, B0); PG8_MMA(0, 1, At, B1); PG8_BAR; PG8_SCHED;
            PG8_LDA(At, 0, 1); PG8_STAGE(PG8_SB(0, 0), b2, voffB); PG8_STAGE(PG8_SB(0, 1), b2 + hstep, voffB); PG8_STAGE(PG8_SA(0, 0), a2, o2[0]);
            PG8_WAIT_V(8); PG8_WAIT_L(0); PG8_BAR; PG8_MMA(1, 0, At, B0); PG8_MMA(1, 1, At, B1); PG8_BAR; PG8_SCHED;
            PG8_LDB(B0, 1, 0); PG8_LDB(B1, 1, 1); PG8_SCHED; PG8_LDA(At, 1, 0); PG8_STAGE(PG8_SA(0, 1), a2, o2[1]);
            PG8_WAIT_V(8); PG8_WAIT_L(0); PG8_BAR; PG8_MMA(0, 0, At, B0); PG8_MMA(0, 1, At, B1); PG8_BAR; PG8_SCHED;
            PG8_LDA(At, 1, 1); PG8_STAGE(PG8_SB(1, 0), b3, voffB); PG8_STAGE(PG8_SB(1, 1), b3 + hstep, voffB); PG8_STAGE(PG8_SA(1, 0), a3, o2[0]);
            PG8_WAIT_V(8); PG8_WAIT_L(0); PG8_BAR; PG8_MMA(1, 0, At, B0); PG8_MMA(1, 1, At, B1); PG8_BAR; PG8_SCHED;
        }
        if constexpr (ALIGN_EPI) { if (wr == 0) PG8_BAR; }
        if constexpr (FP8) asm volatile("s_nop 15\n\ts_nop 15" ::: "memory");
        { const int l2 = lane_id();
          E(acc, cur, wr, wc, l2 & 15, l2 >> 4); } S.done(cur);
        if (!has_next) break;
#pragma unroll
        for (int a = 0; a < 2; ++a)
#pragma unroll
            for (int b = 0; b < 2; ++b)
#pragma unroll
                for (int m = 0; m < 4; ++m)
#pragma unroll
                    for (int n = 0; n < 2; ++n) acc[a][b][m][n] = (f32x4){0.f, 0.f, 0.f, 0.f};
        cur = nxt; cA = nA; cB = nB; ++ui;
        if (GATHER) { PG8_OFFS(offA, cur); }
        if constexpr (ALIGN_EPI) { if (wr == 1) PG8_BAR; }
    }
    PG8_WAIT_V(0);
    if constexpr (!ALIGN_EPI) { if (wr == 0) PG8_BAR; }
    PG8_BAR;
#undef PG8_SA
#undef PG8_SB
#undef PG8_STAGE
#undef PG8_LDA
#undef PG8_LD8
#undef PG8_LDB
#undef PG8_MMA
#undef PG8_WAIT_V
#undef PG8_WAIT_L
#undef PG8_BAR
#undef PG8_SCHED
#undef PG8_OFFS
}
}
namespace pg8 {
__device__ __forceinline__ float fsigmoid(float x) { return __builtin_amdgcn_rcpf(1.0f + __builtin_amdgcn_exp2f(-LOG2E * x)); }
__device__ __forceinline__ u32x4 pack8(const f32x4 a, const f32x4 b) { u32x4 w; w.x = cvt_pk_bf16(a[0], a[1]); w.y = cvt_pk_bf16(a[2], a[3]); w.z = cvt_pk_bf16(b[0], b[1]); w.w = cvt_pk_bf16(b[2], b[3]); return w; }
__device__ __forceinline__ void unpack8(const u32x4 w, f32x4& a, f32x4& b) {
    a[0] = __uint_as_float(w.x << 16); a[1] = __uint_as_float(w.x & 0xffff0000u); a[2] = __uint_as_float(w.y << 16); a[3] = __uint_as_float(w.y & 0xffff0000u);
    b[0] = __uint_as_float(w.z << 16); b[1] = __uint_as_float(w.z & 0xffff0000u); b[2] = __uint_as_float(w.w << 16); b[3] = __uint_as_float(w.w & 0xffff0000u); }

struct EpiQK {
    static constexpr bool PERM = true;
    bf16 *qsb, *ksb;
    __device__ __forceinline__ void operator()(const f32x4 (&acc)[2][2][4][2], const Unit& u, int wr, int wc, int fr, int fq) const {
        const int pn = u.pn;
        if (pn < 4) {
            const bf16* ub = qsb + ((size_t)(u.pm * BM + wr * 64)) * 1024 + pn * 256 + wc * 32; const int lo = fr * 1024 + 8 * fq;
#pragma unroll
            for (int ai = 0; ai < 2; ++ai)
#pragma unroll
                for (int m = 0; m < 4; ++m)
#pragma unroll
                    for (int bj = 0; bj < 2; ++bj) *(u32x4*)(ub + (ai * HALF + m * 16) * 1024 + bj * HALF + lo) = pack8(acc[ai][bj][m][0] * (SB_C2 * IN_DS), acc[ai][bj][m][1] * (SB_C2 * IN_DS));
        } else {
            const int t0 = (u.pm * BM) & (SEQ - 1), b = (u.pm * BM) >> 13;
            const bf16* ub = ksb + ((((size_t)(b * 16 + 4 * (pn & 3) + (wc >> 1)) * 256 + (t0 >> 5) + 2 * wr) * 4 + 2 * (wc & 1)) * 512);
            const int lo = (fq >> 1) * 512 + fr * 16 + 8 * (fq & 1);
#pragma unroll
            for (int ai = 0; ai < 2; ++ai)
#pragma unroll
                for (int m = 0; m < 4; ++m)
#pragma unroll
                    for (int bj = 0; bj < 2; ++bj) *(u32x4*)(ub + (size_t)(2 * bj) * 256 * 2048 + (4 * ai + (m >> 1)) * 2048 + (m & 1) * 256 + lo) = pack8(acc[ai][bj][m][0] * IN_DS, acc[ai][bj][m][1] * IN_DS);
        }
    }
};
struct EpiRot {
    static constexpr bool PERM = true;
    bf16 *qr, *kr, *krt, *qrs; const float *cosT, *sinT;
    __device__ __forceinline__ void operator()(const f32x4 (&acc)[2][2][4][2], const Unit& u, int wr, int wc, int fr, int fq) const {
        const int pn = u.pn; const bool isK = pn >= 4; const int head = pn & 3; const float sc = (isK ? 1.0f : 0.0625f) * IN_DS;
        const int R0 = u.pm * BM, P0 = R0 & (SEQ - 1), bh = (R0 >> 13) * 4 + head;
        f32x4 c[2], sn[2], dc[2], ds[2], ec[2], es[2];
        { const int tlo = fr * 128 + 8 * fq; const float* cb = cosT + (size_t)(P0 + 64 * wr) * 128 + 32 * wc; const float* sb = sinT + (size_t)(P0 + 64 * wr) * 128 + 32 * wc;
          const float* c16 = cosT + 16 * 128 + 32 * wc; const float* s16 = sinT + 16 * 128 + 32 * wc; const float* c80 = cosT + 80 * 128 + 32 * wc; const float* s80 = sinT + 80 * 128 + 32 * wc;
#pragma unroll
          for (int n = 0; n < 2; ++n) { c[n] = *(const f32x4*)(cb + tlo + 4 * n); sn[n] = *(const f32x4*)(sb + tlo + 4 * n);
              dc[n] = *(const f32x4*)(c16 + 8 * fq + 4 * n); ds[n] = *(const f32x4*)(s16 + 8 * fq + 4 * n); ec[n] = *(const f32x4*)(c80 + 8 * fq + 4 * n); es[n] = *(const f32x4*)(s80 + 8 * fq + 4 * n); } }
        bf16* on = (isK ? kr : qr) + (size_t)(R0 + 64 * wr) * 1024 + head * 256 + 32 * wc; const int lo_n = fr * 1024 + 8 * fq;
        bf16* oq = qrs + (((size_t)bh * 128 + (P0 >> 6) + wr) * 16 + 2 * wc) * 1024; const int lo_q = (fq >> 1) * 1024 + fr * 16 + 8 * (fq & 1);
        bf16* ok = krt + (((size_t)bh * 128 + (P0 >> 6) + wr) * 4) * 4096 + 32 * wc * 16; const int lo_k = 8 * fq * 16 + fr;
#pragma unroll
        for (int ai = 0; ai < 2; ++ai)
#pragma unroll
            for (int m = 0; m < 4; ++m) {
                f32x4 o1[2], o2[2];
#pragma unroll
                for (int n = 0; n < 2; ++n) { const f32x4 x1 = acc[ai][0][m][n], x2 = acc[ai][1][m][n]; o1[n] = (x1 * c[n] - x2 * sn[n]) * sc; o2[n] = (x1 * sn[n] + x2 * c[n]) * sc; }
                if (m < 3) {
#pragma unroll
                    for (int n = 0; n < 2; ++n) { const f32x4 cc = c[n] * dc[n] - sn[n] * ds[n]; sn[n] = sn[n] * dc[n] + c[n] * ds[n]; c[n] = cc; } }
                else if (ai == 0) {
#pragma unroll
                    for (int n = 0; n < 2; ++n) { const f32x4 cc = c[n] * ec[n] - sn[n] * es[n]; sn[n] = sn[n] * ec[n] + c[n] * es[n]; c[n] = cc; } }
                const u32x4 w1 = pack8(o1[0], o1[1]), w2 = pack8(o2[0], o2[1]);
                *(u32x4*)(on + (ai * HALF + m * 16) * 1024 + lo_n) = w1; *(u32x4*)(on + (ai * HALF + m * 16) * 1024 + HALF + lo_n) = w2;
                if (isK) {
                    bf16* tp = ok + (2 * ai * 4 + m) * 4096 + lo_k;
#pragma unroll
                    for (int q = 0; q < 4; ++q) { tp[(2 * q) * 16] = (bf16)(w1[q] & 0xffffu); tp[(2 * q + 1) * 16] = (bf16)(w1[q] >> 16);
                        tp[(HALF + 2 * q) * 16] = (bf16)(w2[q] & 0xffffu); tp[(HALF + 2 * q + 1) * 16] = (bf16)(w2[q] >> 16); }
                } else {
                    *(u32x4*)(oq + (2 * ai * 16) * 1024 + m * 256 + lo_q) = w1; *(u32x4*)(oq + (2 * ai * 16 + 8) * 1024 + m * 256 + lo_q) = w2; }
                asm volatile("" ::: "memory"); }
    }
};
struct EpiGate {
    static constexpr bool PERM = true;
    unsigned char* ws;
    __device__ __forceinline__ void operator()(const f32x4 (&acc)[2][2][4][2], const Unit& u, int wr, int wc, int fr, int fq) const {
        const int pn = u.pn; const int R0 = u.pm * BM, P0 = R0 & (SEQ - 1); const bool silu = pn < 8;
        const size_t ub_s = WS_SG + 2 * ((((size_t)((R0 >> 13) * 4 + (pn >> 1)) * 128 + (P0 >> 6) + wr) * 64 + 32 * (pn & 1) + 4 * wc) * 512);
        const size_t ub_g = WS_GSB + (size_t)(pn >= 12 ? 1 : 0) * (WS_GRET - WS_GSB) + 2 * ((size_t)(R0 + 64 * wr) * 1024 + (pn & 3) * 256 + 32 * wc);
        bf16* ub = (bf16*)(ws + (silu ? ub_s : ub_g));
        const int lo = silu ? fq * 512 + fr * 8 : fr * 1024 + 8 * fq;
        const int SA = silu ? 128 * 512 : HALF * 1024, SM = silu ? 128 : 16 * 1024, SB = silu ? 16 * 512 : HALF;
#pragma unroll
        for (int ai = 0; ai < 2; ++ai)
#pragma unroll
            for (int m = 0; m < 4; ++m) {
#pragma unroll
                for (int bj = 0; bj < 2; ++bj) { f32x4 a = acc[ai][bj][m][0] * IN_DS, b = acc[ai][bj][m][1] * IN_DS;
#pragma unroll
                    for (int e = 0; e < 4; ++e) { const float sa = fsigmoid(a[e]), sb = fsigmoid(b[e]); a[e] = silu ? a[e] * sa : sa; b[e] = silu ? b[e] * sb : sb; }
                    *(u32x4*)(ub + ai * SA + m * SM + bj * SB + lo) = pack8(a, b);
                    asm volatile("" ::: "memory"); } }
    }
};
struct EpiVT {
    static constexpr bool PERM = true;
    bf16 *vsbt, *vrt;
    __device__ __forceinline__ void operator()(const f32x4 (&acc)[2][2][4][2], const Unit& u, int wr, int wc, int fr, int fq) const {
        const int pm = u.pm; const int C0 = u.pn * BM, T0 = C0 & (SEQ - 1), b = C0 >> 13;
        if (pm < 4) {
            bf16* ub = vsbt + ((((size_t)(b * 16 + 4 * pm + wr) * 512 + (T0 >> 4) + 2 * wc) * 64) * 16); const int lo = ((fq >> 1) * 64 + fr) * 16 + 8 * (fq & 1);
#pragma unroll
            for (int ai = 0; ai < 2; ++ai)
#pragma unroll
                for (int m = 0; m < 4; ++m)
#pragma unroll
                    for (int bj = 0; bj < 2; ++bj) *(u32x4*)(ub + ((size_t)(2 * ai) * 512 * 64 + 8 * bj * 64 + 16 * m) * 16 + lo) = pack8(acc[ai][bj][m][0] * IN_DS, acc[ai][bj][m][1] * IN_DS);
        } else {
            const int h = (pm - 4) >> 1; const float l2g = __builtin_amdgcn_logf(1.0f - __builtin_amdgcn_exp2f(-5.0f - (float)h));
            float dec[8];
#pragma unroll
            for (int q = 0; q < 8; ++q) dec[q] = __builtin_amdgcn_exp2f((float)(63 - (((wc & 1) * 32 + 8 * fq + q) & 63)) * l2g) * IN_DS;
            bf16* ub = vrt + (((((size_t)(b * 4 + h) * 128 + (T0 >> 6) + (wc >> 1)) * 4 + 2 * (wc & 1)) * 512 + 256 * ((pm - 4) & 1) + 64 * wr) * 16); const int lo = ((fq >> 1) * 512 + fr) * 16 + 8 * (fq & 1);
#pragma unroll
            for (int ai = 0; ai < 2; ++ai)
#pragma unroll
                for (int m = 0; m < 4; ++m)
#pragma unroll
                    for (int bj = 0; bj < 2; ++bj) { f32x4 a = acc[ai][bj][m][0], bb = acc[ai][bj][m][1];
#pragma unroll
                        for (int e = 0; e < 4; ++e) { a[e] *= dec[e]; bb[e] *= dec[4 + e]; }
                        *(u32x4*)(ub + ((size_t)(2 * bj) * 4 * 512 + 128 * ai + 16 * m) * 16 + lo) = pack8(a, bb); }
        }
    }
};
template <int MODE> struct EpiBranch {
    static constexpr bool PERM = true;
    const bf16* gate; const bf16* m1in; bf16* out;
    __device__ __forceinline__ void operator()(const f32x4 (&acc)[2][2][4][2], const Unit& u, int wr, int wc, int fr, int fq) const {
        const size_t uo = (size_t)(u.pm * BM + 64 * wr) * 1024 + u.pn * BM + 32 * wc; const int lo = fr * 1024 + 8 * fq;
        const bf16* gp = gate + uo; const bf16* mp = m1in + uo; bf16* op = out + uo;
#pragma unroll
        for (int ai = 0; ai < 2; ++ai)
#pragma unroll
            for (int m = 0; m < 4; ++m) {
#pragma unroll
                for (int bj = 0; bj < 2; ++bj) { const int co = (ai * HALF + m * 16) * 1024 + bj * HALF + lo; f32x4 ga, gb; unpack8(*(const u32x4*)(gp + co), ga, gb);
                    f32x4 a = acc[ai][bj][m][0] * ga, b = acc[ai][bj][m][1] * gb;
                    if (MODE == 1) { f32x4 pa, pb; unpack8(*(const u32x4*)(mp + co), pa, pb); a += pa; b += pb; }
                    *(u32x4*)(op + co) = pack8(a, b); }
                asm volatile("" ::: "memory"); }
    }
};
struct EpiPre {
    static constexpr bool PERM = false;
    const float* x; float* pre;
    __device__ __forceinline__ void operator()(const f32x4 (&acc)[2][2][4][2], const Unit& u, int wr, int wc, int fr, int fq) const {
        const size_t uo = (size_t)(u.pm * BM + 64 * wr) * 1024 + u.pn * BM + 32 * wc; const int lo = fr * 1024 + 4 * fq;
        const float* xp = x + uo; float* pp = pre + uo;
#pragma unroll
        for (int ai = 0; ai < 2; ++ai)
#pragma unroll
            for (int m = 0; m < 4; ++m) {
#pragma unroll
                for (int bj = 0; bj < 2; ++bj)
#pragma unroll
                    for (int n = 0; n < 2; ++n) { const int co = (ai * HALF + m * 16) * 1024 + bj * HALF + n * 16 + lo; *(f32x4*)(pp + co) = *(const f32x4*)(xp + co) * DN_ALPHA + acc[ai][bj][m][n]; }
                asm volatile("" ::: "memory"); }
    }
};
struct EpiGateUp {
    static constexpr bool PERM = true;
    const float* bgu; bf16* act;
    __device__ __forceinline__ void operator()(const f32x4 (&acc)[2][2][4][2], const Unit& u, int wr, int wc, int fr, int fq) const {
        const float* bp = bgu + (size_t)u.e * 2048 + u.pn * 128 + wc * 32 + 8 * fq;
        bf16* ub = act + (size_t)(u.rbase + 64 * wr) * 1024 + u.pn * 128 + wc * 32; const int lo = fr * 1024 + 8 * fq;
#pragma unroll
        for (int ai = 0; ai < 2; ++ai)
#pragma unroll
            for (int m = 0; m < 4; ++m) { const int rr = ai * HALF + wr * 64 + m * 16 + fr;
                f32x4 bg[2], bu[2];
#pragma unroll
                for (int n = 0; n < 2; ++n) { bg[n] = *(const f32x4*)(bp + 4 * n); bu[n] = *(const f32x4*)(bp + 1024 + 4 * n); }
                f32x4 o[2];
#pragma unroll
                for (int n = 0; n < 2; ++n) { const f32x4 g = acc[ai][0][m][n] * MOE_DESCALE + bg[n], up = acc[ai][1][m][n] * MOE_DESCALE + bu[n];
#pragma unroll
                    for (int e = 0; e < 4; ++e) { const float gg = fminf(g[e], 7.0f), uu = __builtin_amdgcn_fmed3f(up[e], -7.0f, 7.0f);
                        o[n][e] = (uu + 1.0f) * gg * __builtin_amdgcn_rcpf(1.0f + __builtin_amdgcn_exp2f((-1.702f * LOG2E) * gg)); } }
                if (rr < u.nrows) {
#if MOE_FP8
                    u32x2 w8; w8.x = pk4_fp8(o[0][0], o[0][1], o[0][2], o[0][3]); w8.y = pk4_fp8(o[1][0], o[1][1], o[1][2], o[1][3]);
                    *(u32x2*)((unsigned char*)act + (size_t)(u.rbase + 64 * wr) * 1024 + u.pn * 128 + wc * 32 + (ai * HALF + m * 16) * 1024 + lo) = w8;
#else
                    *(u32x4*)(ub + (ai * HALF + m * 16) * 1024 + lo) = pack8(o[0], o[1]);
#endif
                }
                asm volatile("" ::: "memory"); }
    }
};
struct EpiDown {
    static constexpr bool PERM = true;
    const float* bdn; const int* rowtk; const float* roww; bf16* outr;
    __device__ __forceinline__ void operator()(const f32x4 (&acc)[2][2][4][2], const Unit& u, int wr, int wc, int fr, int fq) const {
        const int col0 = u.pn * BM + wc * 32 + 8 * fq; const float* bp = bdn + (size_t)u.e * 1024 + col0;
        const size_t lbase = (size_t)u.e * CAP + u.pm;
#pragma unroll
        for (int ai = 0; ai < 2; ++ai)
#pragma unroll
            for (int m = 0; m < 4; ++m) { const int rr = ai * HALF + wr * 64 + m * 16 + fr;
                if (rr < u.nrows) { const int tk = rowtk[lbase + rr]; const float w = roww[lbase + rr]; bf16* rowp = outr + (size_t)tk * 1024 + col0;
#pragma unroll
                    for (int bj = 0; bj < 2; ++bj) { const f32x4 b0 = *(const f32x4*)(bp + bj * HALF), b1 = *(const f32x4*)(bp + bj * HALF + 4);
                        *(u32x4*)(rowp + bj * HALF) = pack8((acc[ai][bj][m][0] * MOE_DESCALE + b0) * w, (acc[ai][bj][m][1] * MOE_DESCALE + b1) * w); } }
                asm volatile("" ::: "memory"); }
    }
};
}
#define GAS __attribute__((address_space(1)))
#define LAS __attribute__((address_space(3)))
typedef GAS unsigned gu32;
#define RLX_AGENT __ATOMIC_RELAXED, __HIP_MEMORY_SCOPE_AGENT
constexpr int NWAVES = 8;
constexpr int RING_OFF = 0, RING_BYTES = 131072;
constexpr int LDSCTL_OFF = RING_BYTES;
constexpr int LDS_TAB_OFF = RING_BYTES + 1024;
constexpr int LDS_BYTES = LDS_TAB_OFF + 24 * 256 * 4;
static_assert(LDS_BYTES <= 163840, "LDS");

#define XB_TMO      128
#define XB_XCNT(j)  (256  + 64 * (j))
#define XB_XSUB(j)  (1280 + 64 * (j))
#define XB_XGEN(j)  (2304 + 64 * (j))
#define XB_TOP      3328
#define XB_TOPGEN   3392
#define XCD_BAR_WORDS 3456
#define XB_SPIN_CAP (1u << 18)
__device__ __forceinline__ unsigned xb_ld(unsigned* p)              { return __hip_atomic_load(p, __ATOMIC_RELAXED, __HIP_MEMORY_SCOPE_AGENT); }
__device__ __forceinline__ unsigned xb_add(unsigned* p, unsigned v) { return __hip_atomic_fetch_add(p, v, __ATOMIC_RELAXED, __HIP_MEMORY_SCOPE_AGENT); }
__device__ __forceinline__ unsigned xb_xcc_id() { return (unsigned)__builtin_amdgcn_s_getreg((3 << 11) | 20) & 0xFu; }
#define XB_SPIN(cond, bar) do { unsigned _sp = 0; while (cond) { __builtin_amdgcn_s_sleep(1); \
    if ((++_sp & 255u) == 0u) { if (xb_ld(&(bar)[XB_TMO])) break; if (_sp > XB_SPIN_CAP) { atomicAdd(&(bar)[XB_TMO], 1u); break; } } } } while (0)
struct XcdBarrier { unsigned* bar; unsigned x; volatile LAS unsigned* st; };
__device__ __forceinline__ XcdBarrier xcd_barrier_post(unsigned* bar, volatile LAS unsigned* st) {
    XcdBarrier b; b.bar = bar; b.x = xb_xcc_id(); b.st = st;
    if (threadIdx.x == 0) (void)xb_add(&bar[XB_XCNT(b.x)], 1u);
    return b;
}
__device__ __forceinline__ void xcd_barrier_complete(unsigned* bar, unsigned x, unsigned& nloc, unsigned& nx) {
    const unsigned G = gridDim.x * gridDim.y * gridDim.z;
    unsigned sum, cnt, mine, sp = 0u;
    for (;;) {
        sum = 0u; cnt = 0u; mine = 0u;
#pragma unroll
        for (unsigned j = 0; j < 16; ++j) { const unsigned c = xb_ld(&bar[XB_XCNT(j)]); sum += c; cnt += (c > 0u) ? 1u : 0u; mine = (j == x) ? c : mine; }
        if (sum == G) break;
        __builtin_amdgcn_s_sleep(1);
        if ((++sp & 255u) == 0u) { if (xb_ld(&bar[XB_TMO])) break; if (sp > XB_SPIN_CAP) { atomicAdd(&bar[XB_TMO], 1u); break; } }
    }
    nloc = mine > 0u ? mine : 1u; nx = cnt > 0u ? cnt : 1u;
}
__device__ __forceinline__ void xcd_barrier(const XcdBarrier& b) {
    asm volatile("s_waitcnt vmcnt(0)" ::: "memory");
    __syncthreads();
    if (threadIdx.x == 0) {
        unsigned* bar = b.bar;
        __builtin_amdgcn_s_waitcnt(0);
        unsigned nloc = b.st[0], nx = b.st[1];
        if (nloc == 0u) { xcd_barrier_complete(bar, b.x, nloc, nx); b.st[0] = nloc; b.st[1] = nx; }
        const unsigned old = xb_add(&bar[XB_XSUB(b.x)], 1u);
        const unsigned gen = old / nloc;
        if (old + 1u == (gen + 1u) * nloc) {
            __builtin_amdgcn_fence(__ATOMIC_RELEASE, "agent");
            asm volatile("s_waitcnt vmcnt(0)" ::: "memory");
            const unsigned og = xb_add(&bar[XB_TOP], 1u);
            const unsigned tg = og / nx;
            if (og + 1u == (tg + 1u) * nx) xb_add(&bar[XB_TOPGEN], 1u);
            else XB_SPIN(xb_ld(&bar[XB_TOPGEN]) == tg, bar);
            __builtin_amdgcn_fence(__ATOMIC_ACQUIRE, "agent");
            xb_add(&bar[XB_XGEN(b.x)], 1u);
            asm volatile("s_waitcnt vmcnt(0)" ::: "memory");
        } else {
            XB_SPIN(xb_ld(&bar[XB_XGEN(b.x)]) == gen, bar);
            __builtin_amdgcn_fence(__ATOMIC_ACQUIRE, "agent");
            asm volatile("s_waitcnt vmcnt(0)" ::: "memory");
        }
    }
    __syncthreads();
}

struct Frame {
    LAS unsigned char* lds; volatile LAS unsigned* LC;
    unsigned* ctl;
    int wave, vcu, G;
    Bufs B;
};
#define FWS(T, off) ((T*)(F.B.ws + (off)))
#define FDO(T, off) ((T*)((unsigned char*)F.B.out + (off)))
#define LDS_WAIT() asm volatile("s_waitcnt lgkmcnt(0)" ::: "memory")
#define VM_WAIT() asm volatile("s_waitcnt vmcnt(0)" ::: "memory")

__device__ __forceinline__ f32x16 mfma32(bf16x8 a, bf16x8 b, f32x16 c) { return __builtin_amdgcn_mfma_f32_32x32x16_bf16(a, b, c, 0, 0, 0); }
__device__ __forceinline__ int crow(int r, int hi) { return (r & 3) + 8 * (r >> 2) + 4 * hi; }
__device__ __forceinline__ float swap_lo(float x, float& hi_out) { auto rr = __builtin_amdgcn_permlane32_swap(__float_as_uint(x), __float_as_uint(x), false, false); hi_out = __uint_as_float(rr[1]); return __uint_as_float(rr[0]); }
__device__ __forceinline__ bf16x8 pack_frag(const f32x16& v, int base) {
    u32x4 w; w.x = pg8::cvt_pk_bf16(v[base + 0], v[base + 1]); w.y = pg8::cvt_pk_bf16(v[base + 2], v[base + 3]); w.z = pg8::cvt_pk_bf16(v[base + 4], v[base + 5]); w.w = pg8::cvt_pk_bf16(v[base + 6], v[base + 7]);
    return __builtin_bit_cast(bf16x8, w); }
__device__ __forceinline__ bf16x8 join8(u32x2 a, u32x2 b) { u32x4 w; w.x = a.x; w.y = a.y; w.z = b.x; w.w = b.y; return __builtin_bit_cast(bf16x8, w); }
__device__ __forceinline__ float ret_l2g(int h) { return __builtin_amdgcn_logf(1.0f - __builtin_amdgcn_exp2f(-5.0f - (float)h)); }

__device__ __forceinline__ void tr_item(const float* src, int lds_, int k0, int c0, bf16* dst, int K, int r0, LAS unsigned char* scr, int lane) {
    const int kr = lane >> 4, nq = lane & 15;
    f32x4 v[4][4];
#pragma unroll
    for (int gI = 0; gI < 4; ++gI)
#pragma unroll
        for (int i = 0; i < 4; ++i) v[gI][i] = *(const f32x4*)(src + (size_t)(k0 + 16 * gI + 4 * kr + i) * lds_ + c0 + 4 * nq);
#pragma unroll
    for (int gI = 0; gI < 4; ++gI)
#pragma unroll
        for (int e = 0; e < 4; ++e) { u32x2 w; w.x = pk2(v[gI][0][e], v[gI][1][e]); w.y = pk2(v[gI][2][e], v[gI][3][e]);
            *(LAS u32x2*)(scr + (4 * nq + e) * 144 + 32 * gI + 8 * kr) = w; }
    LDS_WAIT(); asm volatile("" ::: "memory");
#pragma unroll
    for (int it = 0; it < 8; ++it) { const int n = it * 8 + (lane >> 3), ch = lane & 7;
        const u32x4 w = *(const LAS u32x4*)(scr + n * 144 + ch * 16);
        *(u32x4*)(dst + (size_t)(r0 + n) * K + k0 + 8 * ch) = w; }
    LDS_WAIT(); asm volatile("" ::: "memory");
}
__device__ __forceinline__ void tr_item_fp8(const float* src, int lds_, int k0, int c0, unsigned char* dst, int K, int r0, LAS unsigned char* scr, int lane, const float wscale) {
    const int kr = lane >> 4, nq = lane & 15;
    f32x4 v[4][4];
#pragma unroll
    for (int gI = 0; gI < 4; ++gI)
#pragma unroll
        for (int i = 0; i < 4; ++i) v[gI][i] = *(const f32x4*)(src + (size_t)(k0 + 16 * gI + 4 * kr + i) * lds_ + c0 + 4 * nq) * wscale;
#pragma unroll
    for (int gI = 0; gI < 4; ++gI)
#pragma unroll
        for (int e = 0; e < 4; ++e) *(LAS unsigned*)(scr + (4 * nq + e) * 80 + 16 * gI + 4 * kr) = pk4_fp8(v[gI][0][e], v[gI][1][e], v[gI][2][e], v[gI][3][e]);
    LDS_WAIT(); asm volatile("" ::: "memory");
#pragma unroll
    for (int it = 0; it < 4; ++it) { const int n = it * 16 + (lane >> 2), ch = lane & 3;
        const u32x4 w = *(const LAS u32x4*)(scr + n * 80 + ch * 16);
        *(u32x4*)(dst + (size_t)(r0 + n) * K + k0 + 16 * ch) = w; }
    LDS_WAIT(); asm volatile("" ::: "memory");
}
__device__ __forceinline__ void p0_prologue(Frame& F) {
    const Bufs& B = F.B; const int lane_ = lane_id(), tid_ = F.wave * 64 + lane_;
    const int gw = F.vcu * NWAVES + F.wave, NGW = F.G * NWAVES;
    { const f32x4* xs = (const f32x4*)B.x; const size_t n8 = (size_t)NTOK * DM / 8;
#if INPROJ_FP8
      u32x2* xd = FDO(u32x2, DO_XB);
      for (size_t i = (size_t)blockIdx.x * 512 + tid_; i < n8; i += (size_t)F.G * 512) { const f32x4 a = xs[2 * i], b = xs[2 * i + 1];
          u32x2 w; w.x = pk4_fp8(a[0], a[1], a[2], a[3]); w.y = pk4_fp8(b[0], b[1], b[2], b[3]); xd[i] = w; }
#else
      u32x4* xd = FDO(u32x4, DO_XB);
      for (size_t i = (size_t)blockIdx.x * 512 + tid_; i < n8; i += (size_t)F.G * 512) { const f32x4 a = xs[2 * i], b = xs[2 * i + 1];
          u32x4 w; w.x = pk2(a[0], a[1]); w.y = pk2(a[2], a[3]); w.z = pk2(b[0], b[1]); w.w = pk2(b[2], b[3]); xd[i] = w; }
#endif
    }
    LAS unsigned char* scr = F.lds + RING_OFF + F.wave * 9216;
    constexpr int I_IN = 16 * (INW / 64)  , I_BSB = 256, I_BRET = 32 * 16, I_OUT = 256;
    constexpr int NITEMS = I_IN + I_BSB + I_BRET + I_OUT;
    for (int it = gw; it < NITEMS; it += NGW) {
        int r = it;
        if (r < I_IN) { const int kb = r / (INW / 64), nb = r % (INW / 64); const int c0 = nb * 64; bf16* dst; int r0;
            if (c0 < 2048) { dst = FWS(bf16, WS_WINT); r0 = c0; } else if (c0 < 3072) { dst = FWS(bf16, WS_WVT); r0 = c0 - 2048; }
            else if (c0 < 5120) { dst = FWS(bf16, WS_WINT); r0 = 2048 + c0 - 3072; } else if (c0 < 7168) { dst = FWS(bf16, WS_WVT); r0 = 1024 + c0 - 5120; }
            else { dst = FWS(bf16, WS_WINT); r0 = 4096 + c0 - 7168; }
#if INPROJ_FP8
            tr_item_fp8(B.w_in, INW, kb * 64, c0, (unsigned char*)dst, 1024, r0, scr, lane_, IN_WSCALE); continue; } r -= I_IN;
#else
            tr_item(B.w_in, INW, kb * 64, c0, dst, 1024, r0, scr, lane_); continue; } r -= I_IN;
#endif
        if (r < I_BSB) { tr_item(B.w_bsb, 1024, (r >> 4) * 64, (r & 15) * 64, FWS(bf16, WS_WBSBT), 1024, (r & 15) * 64, scr, lane_); continue; } r -= I_BSB;
        if (r < I_BRET) { tr_item(B.w_bret, 1024, (r >> 4) * 64, (r & 15) * 64, FWS(bf16, WS_WBRETT), 2048, (r & 15) * 64, scr, lane_); continue; } r -= I_BRET;
        tr_item(B.w_out, 1024, (r >> 4) * 64, (r & 15) * 64, FWS(bf16, WS_WOUTT), 1024, (r & 15) * 64, scr, lane_);
    }
    { float* ct = FWS(float, WS_COS); float* st = FWS(float, WS_SIN);
      for (int i = blockIdx.x * 512 + tid_; i < SEQ * 128; i += F.G * 512) { const int pos = i >> 7, j = i & 127; const float ang = (float)pos * rope_inv_freq(j);
          ct[i] = (float)cos((double)ang); st[i] = (float)sin((double)ang); } }
    { bf16* wrt = FWS(bf16, WS_WRT);
      for (int i = blockIdx.x * 512 + tid_; i < 32 * 1024; i += F.G * 512) { const int k = i & 1023, e = i >> 10; wrt[i] = f2bf(B.w_router[k * 32 + e]); } }
}
__device__ __forceinline__ float sb_half(f32x16& p, int kbase, int tq, int hi, bool need_mask, float cin, bf16x8& f0, bf16x8& f1) {
    f32x16 u;
#pragma unroll
    for (int r = 0; r < 16; ++r) { const float e = __builtin_amdgcn_exp2f(fminf(p[r], 100.0f)); u[r] = __builtin_amdgcn_rcpf(1.0f + e); p[r] = e * u[r]; }
    if (need_mask) {
#pragma unroll
        for (int r = 0; r < 16; ++r) { const int s_ = kbase + crow(r, hi); const bool v = (s_ >= 0) && (s_ < tq); u[r] = v ? u[r] : 1.0f; p[r] = v ? p[r] : 0.0f; } }
    float T[4], Rh[4];
#pragma unroll
    for (int g = 0; g < 4; ++g) { const float R = (u[4 * g] * u[4 * g + 1]) * (u[4 * g + 2] * u[4 * g + 3]); float rh; const float rl = swap_lo(R, rh); Rh[g] = rh; T[g] = rl * rh; }
    float X[4]; X[3] = 1.0f;
#pragma unroll
    for (int g = 2; g >= 0; --g) X[g] = X[g + 1] * T[g + 1];
#pragma unroll
    for (int g = 0; g < 4; ++g) { const float ec = X[g] * (hi == 0 ? Rh[g] : 1.0f) * cin;
        const float w2 = u[4 * g + 3], w1 = w2 * u[4 * g + 2], w0 = w1 * u[4 * g + 1];
        p[4 * g + 3] *= ec; p[4 * g + 2] *= w2 * ec; p[4 * g + 1] *= w1 * ec; p[4 * g] *= w0 * ec; }
    f0 = pack_frag(p, 0); f1 = pack_frag(p, 8);
    return X[0] * T[0];
}
__device__ __forceinline__ void attn_wave_unit(const bf16* __restrict__ KSB, const bf16* __restrict__ VSBT, bf16* QY, int b, int h, int qb, int lane) {
    const int r32 = lane & 31, hi = lane >> 5; const int bh = b * 16 + h;
    const int t0 = qb * 32; const size_t rb = (size_t)b * SEQ; const int tq = t0 + r32;
    bf16x8 qf[4];
    { const bf16* qp = QY + (rb + t0 + r32) * 1024 + h * 64 + 8 * hi;
#pragma unroll
      for (int d0 = 0; d0 < 4; ++d0) qf[d0] = *(const bf16x8*)(qp + 16 * d0); }
    f32x16 o0 = {}, o1 = {};
    float carry = 1.0f;
    bf16x8 kf[2][4];
    const int koff = r32 * 16 + 8 * hi, voff = r32 * 16 + 4 * hi;
#define ATT_KLOAD(ks_) do { const bf16* b0_ = KSB + ((size_t)bh * 256 + (max((ks_), 0) >> 5)) * 2048; const bf16* b1_ = KSB + ((size_t)bh * 256 + (max((ks_) + 32, 0) >> 5)) * 2048; \
        _Pragma("unroll") for (int d0 = 0; d0 < 4; ++d0) { kf[0][d0] = *(const bf16x8*)(b0_ + d0 * 512 + koff); kf[1][d0] = *(const bf16x8*)(b1_ + d0 * 512 + koff); } } while (0)
    ATT_KLOAD(t0 - 32);
    for (int tile = 0;; ++tile) {
        const int ks = t0 + 32 - 64 * (tile + 1);
        f32x16 p0 = {}, p1 = {};
#pragma unroll
        for (int d0 = 0; d0 < 4; ++d0) { p0 = mfma32(kf[0][d0], qf[d0], p0); p1 = mfma32(kf[1][d0], qf[d0], p1); }
        bf16x8 vf[2][4];
#pragma unroll
        for (int s = 0; s < 4; ++s) { const bf16* vb_ = VSBT + ((size_t)bh * 512 + (max(ks + 16 * s, 0) >> 4)) * 1024;
#pragma unroll
            for (int db = 0; db < 2; ++db) vf[db][s] = join8(*(const u32x2*)(vb_ + db * 512 + voff), *(const u32x2*)(vb_ + db * 512 + voff + 8)); }
        ATT_KLOAD(ks - 64);
        const bool need_mask = (tile == 0) || (ks < 0);
        bf16x8 pfB0, pfB1, pfA0, pfA1;
        const float tot1 = sb_half(p1, ks + 32, tq, hi, need_mask, carry, pfB0, pfB1);
        const float tot0 = sb_half(p0, ks, tq, hi, need_mask, carry * tot1, pfA0, pfA1);
        carry *= tot1 * tot0;
        o0 = mfma32(vf[0][0], pfA0, o0); o1 = mfma32(vf[1][0], pfA0, o1); o0 = mfma32(vf[0][1], pfA1, o0); o1 = mfma32(vf[1][1], pfA1, o1);
        o0 = mfma32(vf[0][2], pfB0, o0); o1 = mfma32(vf[1][2], pfB0, o1); o0 = mfma32(vf[0][3], pfB1, o0); o1 = mfma32(vf[1][3], pfB1, o1);
        if (ks <= 0) break;
        if (__all(carry < 1.0e-37f)) break;
    }
#undef ATT_KLOAD
    bf16* op = QY + (rb + t0 + r32) * 1024 + h * 64 + 4 * hi;
#pragma unroll
    for (int g = 0; g < 4; ++g) { u32x2 w; w.x = pg8::cvt_pk_bf16(o0[4 * g], o0[4 * g + 1]); w.y = pg8::cvt_pk_bf16(o0[4 * g + 2], o0[4 * g + 3]); *(u32x2*)(op + 8 * g) = w;
        u32x2 w2; w2.x = pg8::cvt_pk_bf16(o1[4 * g], o1[4 * g + 1]); w2.y = pg8::cvt_pk_bf16(o1[4 * g + 2], o1[4 * g + 3]); *(u32x2*)(op + 32 + 8 * g) = w2; }
}
constexpr int I_GU = 32 * 16 * 32, I_DN = 32 * 16 * 16, I_MOE = I_GU + I_DN;
__device__ __forceinline__ void moe_tr_item(Frame& F, int r, LAS unsigned char* scr, int lane) {
    const Bufs& B = F.B;
    if (r < I_GU) { const int e = r >> 9, q = r & 511, kb = q >> 5, nb = q & 31; const int c0 = nb * 64; const int bj = c0 >> 10, rem = c0 & 1023, ct = rem >> 7, i0 = rem & 127;
#if MOE_FP8
        tr_item_fp8(B.w_gu + (size_t)e * 1024 * 2048, 2048, kb * 64, c0, F.B.ws + WS_WGUT + (size_t)e * 2048 * 1024, 1024, 256 * ct + 128 * bj + i0, scr, lane, MOE_WSCALE); return; }
#else
        tr_item(B.w_gu + (size_t)e * 1024 * 2048, 2048, kb * 64, c0, FWS(bf16, WS_WGUT) + (size_t)e * 2048 * 1024, 1024, 256 * ct + 128 * bj + i0, scr, lane); return; }
#endif
    r -= I_GU;
    { const int e = r >> 8, q = r & 255, kb = q >> 4, nb = q & 15;
#if MOE_FP8
      tr_item_fp8(B.w_dn + (size_t)e * 1024 * 1024, 1024, kb * 64, nb * 64, F.B.ws + WS_WDT + (size_t)e * 1024 * 1024, 1024, nb * 64, scr, lane, MOE_WSCALE); }
#else
      tr_item(B.w_dn + (size_t)e * 1024 * 1024, 1024, kb * 64, nb * 64, FWS(bf16, WS_WDT) + (size_t)e * 1024 * 1024, 1024, nb * 64, scr, lane); }
#endif
}
__device__ __forceinline__ void attn_phase(Frame& F) {
    const int gw = F.vcu * NWAVES + F.wave, NGW = F.G * NWAVES; const int lane = lane_id();
    LAS unsigned char* scr = F.lds + RING_OFF + F.wave * 9216;
    int it = gw;
    for (int wu = gw; wu < BATCH * SBH * (SEQ / 32); wu += NGW) { const int qb = wu & 255, bh = wu >> 8;
        attn_wave_unit(FWS(bf16, WS_KSB), FWS(bf16, WS_VSBT), FWS(bf16, WS_QSB), bh >> 4, bh & 15, qb, lane);
        for (int z = 0; z < 2 && it < I_MOE; ++z, it += NGW) moe_tr_item(F, it, scr, lane); }
    for (; it < I_MOE; it += NGW) moe_tr_item(F, it, scr, lane);
}

__device__ __forceinline__ int swap23(int m) { return (m & ~12) | ((m & 4) << 1) | ((m & 8) >> 1); }
__device__ __forceinline__ void scan_phase(Frame& F) {
    if (F.vcu >= BATCH * RH * 16) return;
    const int lane = lane_id(), w = F.wave, r32 = lane & 31, hi = lane >> 5;
    const int bh = F.vcu >> 4, vs = F.vcu & 15, h = bh & 3;
    const float l2g = ret_l2g(h), cd = __builtin_amdgcn_exp2f(64.0f * l2g);
    const bf16* ktp = FDO(bf16, DO_KRT) + ((size_t)bh * 128 * 4 * 256 + (32 * w + swap23(r32))) * 16 + 8 * hi;
    const bf16* vtp = FWS(bf16, WS_VRT) + ((size_t)bh * 128 * 4 * 512 + (32 * vs + r32)) * 16 + 8 * hi;
    const bf16* qp = FWS(bf16, WS_QRS) + ((size_t)bh * 128 * 16 * 64 + (size_t)(2 * w) * 64 + r32) * 16 + 8 * hi;
    bf16* yp = FWS(bf16, WS_YINT) + ((size_t)bh * 128 * 64 + (size_t)(4 * vs + (r32 >> 3))) * 512 + (r32 & 7);
    LAS f32x4* part = (LAS f32x4*)(F.lds + RING_OFF);
    f32x16 S = {};
    bf16x8 kfA[4], vfA[4], qfA[2][2], kfB[4], vfB[4], qfB[2][2], kfC[4], vfC[4], qfC[2][2];
#define SCAN_LOAD(kf, vf, qf, c) do { _Pragma("unroll") for (int s = 0; s < 4; ++s) { kf[s] = *(const bf16x8*)(ktp + (size_t)((c) * 4 + s) * 4096); vf[s] = *(const bf16x8*)(vtp + (size_t)((c) * 4 + s) * 8192); } \
        _Pragma("unroll") for (int ib = 0; ib < 2; ++ib) _Pragma("unroll") for (int s = 0; s < 2; ++s) qf[ib][s] = *(const bf16x8*)(qp + (size_t)(c) * 16384 + s * 1024 + ib * 512); } while (0)
#define SCAN_STEP(kf, vf, qf, kfn, vfn, qfn, c) do { \
        { const int cn_ = ((c) + 2 < NCHUNK) ? (c) + 2 : NCHUNK - 1; SCAN_LOAD(kfn, vfn, qfn, cn_); }     \
        const bf16x8 sb0 = pack_frag(S, 0), sb1 = pack_frag(S, 8); \
        f32x16 y0 = {}, y1 = {}; \
        y0 = mfma32(qf[0][0], sb0, y0); y0 = mfma32(qf[0][1], sb1, y0); \
        y1 = mfma32(qf[1][0], sb0, y1); y1 = mfma32(qf[1][1], sb1, y1); \
        LAS f32x4* pb = part + ((c) & 1) * 4096 + (w * 8) * 64 + lane; \
        _Pragma("unroll") for (int q = 0; q < 4; ++q) { pb[q * 64] = (f32x4){y0[4 * q], y0[4 * q + 1], y0[4 * q + 2], y0[4 * q + 3]}; pb[(4 + q) * 64] = (f32x4){y1[4 * q], y1[4 * q + 1], y1[4 * q + 2], y1[4 * q + 3]}; } \
        _Pragma("unroll") for (int r = 0; r < 16; ++r) S[r] *= cd; \
        _Pragma("unroll") for (int s = 0; s < 4; ++s) S = mfma32(kf[s], vf[s], S); \
        LDS_WAIT(); __builtin_amdgcn_s_barrier(); asm volatile("" ::: "memory"); \
        const LAS f32x4* rbp = part + ((c) & 1) * 4096 + w * 64 + lane;         \
        f32x4 acc = rbp[0]; \
        _Pragma("unroll") for (int w2 = 1; w2 < 8; ++w2) acc += rbp[w2 * 8 * 64]; \
        _Pragma("unroll") for (int k = 0; k < 4; ++k) { const int idx = 4 * w + k, ib = idx >> 4, r = idx & 15; const int i = 32 * ib + crow(r, hi); \
            yp[(size_t)(c) * 32768 + i * 8] = f2bf(acc[k] * __builtin_amdgcn_exp2f((float)(i + 1) * l2g)); } } while (0)
    SCAN_LOAD(kfA, vfA, qfA, 0); SCAN_LOAD(kfB, vfB, qfB, 1);
    int c = 0;
    for (; c + 3 <= NCHUNK; c += 3) { SCAN_STEP(kfA, vfA, qfA, kfC, vfC, qfC, c); SCAN_STEP(kfB, vfB, qfB, kfA, vfA, qfA, c + 1); SCAN_STEP(kfC, vfC, qfC, kfB, vfB, qfB, c + 2); }
    SCAN_STEP(kfA, vfA, qfA, kfC, vfC, qfC, c); SCAN_STEP(kfB, vfB, qfB, kfA, vfA, qfA, c + 1);
    static_assert(NCHUNK % 3 == 2, "scan tail");
#undef SCAN_STEP
#undef SCAN_LOAD
    LDS_WAIT(); __syncthreads();
}

__device__ __forceinline__ void intra_phase(Frame& F) {
    const int lane = lane_id(), w = F.wave, r32 = lane & 31, hi = lane >> 5;
    LAS float* part = (LAS float*)(F.lds + RING_OFF);
    LAS u32x4* pfl = (LAS u32x4*)(F.lds + RING_OFF + 16384);
    LAS float* red = (LAS float*)(F.lds + RING_OFF + 24576);
    LAS unsigned char* stg = F.lds + RING_OFF + 32768 + w * 9216;
    const int tl = w & 3, jb = tl >> 1, ibt = tl & 1, kh = w >> 2;
    for (int un = F.vcu * 8; un < F.vcu * 8 + 8 && un < BATCH * RH * NCHUNK; ++un) {
        const int c = un & 127, h = (un >> 7) & 3, b = un >> 9, bh = b * 4 + h;
        const size_t tok0 = (size_t)b * SEQ + c * 64; const float l2g = ret_l2g(h);
        bf16x8 kfr[8], qfr[8];
        { const bf16* kp = FWS(bf16, WS_KR) + (tok0 + 32 * jb + r32) * 1024 + h * 256 + 128 * kh + 8 * hi;
          const bf16* qp = FWS(bf16, WS_QRS) + (((size_t)bh * 128 + c) * 16 + 8 * kh) * 1024 + (32 * ibt + r32) * 16 + 8 * hi;
#pragma unroll
          for (int s = 0; s < 8; ++s) { kfr[s] = *(const bf16x8*)(kp + 16 * s); qfr[s] = *(const bf16x8*)(qp + s * 1024); } }
        bf16x8 vfr[2][4];
        { const bf16* vp = FWS(bf16, WS_VRT) + (((size_t)bh * 128 + c) * 4 * 512 + 64 * w + r32) * 16 + 4 * hi;
#pragma unroll
          for (int vb = 0; vb < 2; ++vb)
#pragma unroll
              for (int ks = 0; ks < 4; ++ks) { const bf16* p = vp + (size_t)ks * 8192 + vb * 512; vfr[vb][ks] = join8(*(const u32x2*)(p), *(const u32x2*)(p + 8)); } }
        const size_t tbase = ((((size_t)bh * 128 + c) * 64 + 8 * w) * 64 + r32) * 8 + 4 * hi;
        const bf16* yrow = FWS(bf16, WS_YINT) + tbase; const bf16* srow = FWS(bf16, WS_SG) + tbase;
        u32x2 yv[2][2][4];
#pragma unroll
        for (int ib = 0; ib < 2; ++ib)
#pragma unroll
            for (int vb = 0; vb < 2; ++vb)
#pragma unroll
                for (int g = 0; g < 4; ++g) yv[ib][vb][g] = *(const u32x2*)(yrow + (size_t)(4 * vb + g) * 512 + ib * 256);
        f32x16 X = {};
#pragma unroll
        for (int s = 0; s < 8; ++s) X = mfma32(kfr[s], qfr[s], X);
        u32x2 sv[2][2][4];
#pragma unroll
        for (int ib = 0; ib < 2; ++ib)
#pragma unroll
            for (int vb = 0; vb < 2; ++vb)
#pragma unroll
                for (int g = 0; g < 4; ++g) sv[ib][vb][g] = *(const u32x2*)(srow + (size_t)(4 * vb + g) * 512 + ib * 256);
        if (kh == 1) {
#pragma unroll
            for (int r = 0; r < 16; ++r) part[(tl * 16 + r) * 64 + lane] = X[r]; }
        LDS_WAIT(); __builtin_amdgcn_s_barrier(); asm volatile("" ::: "memory");
        if (kh == 0) {
#pragma unroll
            for (int r = 0; r < 16; ++r) { const int j = 32 * jb + crow(r, hi), i = 32 * ibt + r32;
                X[r] = (X[r] + part[(tl * 16 + r) * 64 + lane]) * __builtin_amdgcn_exp2f((float)((j <= i ? i - j : j - i) - 63 + j) * l2g); }
            pfl[(ibt * 4 + 2 * jb) * 64 + lane] = __builtin_bit_cast(u32x4, pack_frag(X, 0)); pfl[(ibt * 4 + 2 * jb + 1) * 64 + lane] = __builtin_bit_cast(u32x4, pack_frag(X, 8)); }
        LDS_WAIT(); __builtin_amdgcn_s_barrier(); asm volatile("" ::: "memory");
        f32x16 Y[2][2] = {};
#pragma unroll
        for (int ks = 0; ks < 4; ++ks) { const bf16x8 p0 = __builtin_bit_cast(bf16x8, pfl[(0 * 4 + ks) * 64 + lane]), p1 = __builtin_bit_cast(bf16x8, pfl[(1 * 4 + ks) * 64 + lane]);
#pragma unroll
            for (int vb = 0; vb < 2; ++vb) { Y[vb][0] = mfma32(vfr[vb][ks], p0, Y[vb][0]); Y[vb][1] = mfma32(vfr[vb][ks], p1, Y[vb][1]); } }
        float s1[2] = {0.f, 0.f}, s2[2] = {0.f, 0.f};
#pragma unroll
        for (int ib = 0; ib < 2; ++ib)
#pragma unroll
            for (int vb = 0; vb < 2; ++vb)
#pragma unroll
                for (int g = 0; g < 4; ++g) { const u32x2 wv = yv[ib][vb][g];
                    Y[vb][ib][4 * g] += __uint_as_float(wv.x << 16); Y[vb][ib][4 * g + 1] += __uint_as_float(wv.x & 0xffff0000u); Y[vb][ib][4 * g + 2] += __uint_as_float(wv.y << 16); Y[vb][ib][4 * g + 3] += __uint_as_float(wv.y & 0xffff0000u);
#pragma unroll
                    for (int e = 0; e < 4; ++e) { const float y = Y[vb][ib][4 * g + e]; s1[ib] += y; s2[ib] += y * y; } }
#pragma unroll
        for (int ib = 0; ib < 2; ++ib) { float h1, h2; const float l1 = swap_lo(s1[ib], h1), l2 = swap_lo(s2[ib], h2);
            if (hi == 0) { red[(w * 64 + 32 * ib + r32) * 2] = l1 + h1; red[(w * 64 + 32 * ib + r32) * 2 + 1] = l2 + h2; } }
        LDS_WAIT(); __builtin_amdgcn_s_barrier(); asm volatile("" ::: "memory");
#pragma unroll
        for (int ib = 0; ib < 2; ++ib) { float t1 = 0.f, t2 = 0.f;
#pragma unroll
            for (int w2 = 0; w2 < 8; ++w2) { t1 += red[(w2 * 64 + 32 * ib + r32) * 2]; t2 += red[(w2 * 64 + 32 * ib + r32) * 2 + 1]; }
            const float mean = t1 * (1.0f / 512.0f), var = fmaxf(t2 * (1.0f / 512.0f) - mean * mean, 0.0f), rstd = __builtin_amdgcn_rsqf(var + LN_EPS);
#pragma unroll
            for (int vb = 0; vb < 2; ++vb)
#pragma unroll
                for (int g = 0; g < 4; ++g) { const u32x2 sw = sv[ib][vb][g];
                    const float g0 = __uint_as_float(sw.x << 16), g1 = __uint_as_float(sw.x & 0xffff0000u), g2 = __uint_as_float(sw.y << 16), g3 = __uint_as_float(sw.y & 0xffff0000u);
                    u32x2 ov; ov.x = pg8::cvt_pk_bf16(g0 * (Y[vb][ib][4 * g] - mean) * rstd, g1 * (Y[vb][ib][4 * g + 1] - mean) * rstd);
                    ov.y = pg8::cvt_pk_bf16(g2 * (Y[vb][ib][4 * g + 2] - mean) * rstd, g3 * (Y[vb][ib][4 * g + 3] - mean) * rstd);
                    *(LAS u32x2*)(stg + (32 * ib + r32) * 144 + (32 * vb + 8 * g + 4 * hi) * 2) = ov; } }
        LDS_WAIT(); asm volatile("" ::: "memory");
        { bf16* rp = FDO(bf16, DO_R) + (tok0 + (lane >> 3)) * 2048 + h * 512 + 64 * w + 8 * (lane & 7);
#pragma unroll
          for (int k = 0; k < 8; ++k) { const u32x4 v = *(const LAS u32x4*)(stg + (8 * k + (lane >> 3)) * 144 + (lane & 7) * 16); *(u32x4*)(rp + (size_t)(8 * k) * 2048) = v; } }
        LDS_WAIT(); asm volatile("" ::: "memory");
    }
    LDS_WAIT(); __syncthreads();
}

__device__ __forceinline__ void ln1_router_phase(Frame& F) {
    const Bufs& B = F.B;
    const int lane = lane_id(), w = F.wave, r32 = lane & 31, hi = lane >> 5; const int tid_ = w * 64 + lane;
    LAS unsigned char* xt = F.lds + RING_OFF;
    LAS f32x4* pl = (LAS f32x4*)(F.lds + RING_OFF + 66048);
    LAS int* selE = (LAS int*)(F.lds + RING_OFF + 98816);
    LAS float* selW = (LAS float*)(F.lds + RING_OFF + 98816 + 2048);
    volatile LAS unsigned* hist = F.LC + 96; volatile LAS unsigned* basew = F.LC + 128;
    if (tid_ < 32) hist[tid_] = 0u;
    f32x4 gv[4], bv[4];
#pragma unroll
    for (int j = 0; j < 4; ++j) { gv[j] = *(const f32x4*)(B.ln1_g + 4 * lane + 256 * j); bv[j] = *(const f32x4*)(B.ln1_b + 4 * lane + 256 * j); }
    const int wgrow0 = F.vcu * 128;
    f32x4 vn[4][4];
#define LN_LOAD(blk_) do { _Pragma("unroll") for (int rr = 0; rr < 4; ++rr) { const float* p_ = B.out + (size_t)(wgrow0 + 32 * (blk_) + 4 * w + rr) * 1024 + 4 * lane; \
        _Pragma("unroll") for (int j = 0; j < 4; ++j) vn[rr][j] = *(const f32x4*)(p_ + 256 * j); } } while (0)
    LN_LOAD(0);
    for (int blk = 0; blk < 4; ++blk) {
        const int row0 = wgrow0 + 32 * blk;
        f32x4 vc[4][4];
#pragma unroll
        for (int rr = 0; rr < 4; ++rr)
#pragma unroll
            for (int j = 0; j < 4; ++j) vc[rr][j] = vn[rr][j];
        { const int nb = blk < 3 ? blk + 1 : 3; LN_LOAD(nb); }
#pragma unroll
        for (int rr = 0; rr < 4; ++rr) { const int lr = 4 * w + rr; bf16* xb = FWS(bf16, WS_X1B) + (size_t)(row0 + lr) * 1024 + 4 * lane;
            f32x4 v[4]; float s = 0.f;
#pragma unroll
            for (int j = 0; j < 4; ++j) { v[j] = vc[rr][j]; s += (v[j][0] + v[j][1]) + (v[j][2] + v[j][3]); }
            const float mean = wave_sum(s) * (1.f / 1024.f); float s2 = 0.f;
#pragma unroll
            for (int j = 0; j < 4; ++j) { v[j] = v[j] - mean; s2 += (v[j][0] * v[j][0] + v[j][1] * v[j][1]) + (v[j][2] * v[j][2] + v[j][3] * v[j][3]); }
            const float rstd = rsqrtf(wave_sum(s2) * (1.f / 1024.f) + LN_EPS);
#pragma unroll
            for (int j = 0; j < 4; ++j) { const f32x4 y = v[j] * rstd * gv[j] + bv[j];
                u32x2 o; o.x = pg8::cvt_pk_bf16(y[0], y[1]); o.y = pg8::cvt_pk_bf16(y[2], y[3]); *(u32x2*)(xb + 256 * j) = o;
#if MOE_FP8
                *(unsigned*)(F.B.ws + WS_X1B8 + (size_t)(row0 + lr) * 1024 + 4 * lane + 256 * j) = pk4_fp8(y[0], y[1], y[2], y[3]);
#endif
                *(LAS u32x2*)(xt + lr * 2064 + (4 * lane + 256 * j) * 2) = o; } }
        LDS_WAIT(); __builtin_amdgcn_s_barrier(); asm volatile("" ::: "memory");
        f32x16 acc = {};
        { const bf16* ap = FWS(bf16, WS_WRT) + (size_t)r32 * 1024 + 128 * w + 8 * hi; const LAS unsigned char* bp = xt + r32 * 2064 + (128 * w + 8 * hi) * 2;
#pragma unroll
          for (int s = 0; s < 8; ++s) acc = mfma32(*(const bf16x8*)(ap + 16 * s), *(const LAS bf16x8*)(bp + 32 * s), acc); }
#pragma unroll
        for (int q = 0; q < 4; ++q) pl[(w * 4 + q) * 64 + lane] = (f32x4){acc[4 * q], acc[4 * q + 1], acc[4 * q + 2], acc[4 * q + 3]};
        LDS_WAIT(); __builtin_amdgcn_s_barrier(); asm volatile("" ::: "memory");
        const bool fin = (w == (blk & 7));
        f32x4 t[4];
        if (fin) {
#pragma unroll
            for (int q = 0; q < 4; ++q) { t[q] = pl[q * 64 + lane];
#pragma unroll
                for (int w2 = 1; w2 < 8; ++w2) t[q] += pl[(w2 * 4 + q) * 64 + lane]; } }
        LDS_WAIT(); __builtin_amdgcn_s_barrier(); asm volatile("" ::: "memory");
        if (fin) {
            float lo[16], hv[16];
#pragma unroll
            for (int r = 0; r < 16; ++r) { const float x = t[r >> 2][r & 3] + B.b_router[crow(r, hi)]; float h_; lo[r] = swap_lo(x, h_); hv[r] = h_; }
            int se[4]; float sv[4];
#pragma unroll
            for (int kk = 0; kk < 4; ++kk) { float best = -INFINITY; int bi = 0;
#pragma unroll
                for (int g = 0; g < 4; ++g) {
#pragma unroll
                    for (int e = 0; e < 4; ++e) { if (lo[4 * g + e] > best) { best = lo[4 * g + e]; bi = 8 * g + e; } }
#pragma unroll
                    for (int e = 0; e < 4; ++e) { if (hv[4 * g + e] > best) { best = hv[4 * g + e]; bi = 8 * g + 4 + e; } } }
                se[kk] = bi; sv[kk] = best;
#pragma unroll
                for (int r = 0; r < 16; ++r) { if (bi == crow(r, 0)) lo[r] = -INFINITY; if (bi == crow(r, 1)) hv[r] = -INFINITY; } }
            const float e1 = __expf(sv[1] - sv[0]), e2 = __expf(sv[2] - sv[0]), e3 = __expf(sv[3] - sv[0]); const float inv = 1.f / (1.f + e1 + e2 + e3);
            if (hi == 0) { const int tl = 32 * blk + r32;
                selE[tl * 4 + 0] = se[0]; selE[tl * 4 + 1] = se[1]; selE[tl * 4 + 2] = se[2]; selE[tl * 4 + 3] = se[3];
                selW[tl * 4 + 0] = inv; selW[tl * 4 + 1] = e1 * inv; selW[tl * 4 + 2] = e2 * inv; selW[tl * 4 + 3] = e3 * inv; } }
    }
#undef LN_LOAD
    LDS_WAIT(); __syncthreads();
    const int myE = selE[tid_]; const float myW = selW[tid_];
    const unsigned rk = __hip_atomic_fetch_add((LAS unsigned*)hist + myE, 1u, __ATOMIC_RELAXED, __HIP_MEMORY_SCOPE_WORKGROUP);
    LDS_WAIT(); __syncthreads();
    if (tid_ < 32) basew[tid_] = __hip_atomic_fetch_add(F.ctl + CW_CNT + 64 * tid_, hist[tid_], RLX_AGENT);
    LDS_WAIT(); __syncthreads();
    { const unsigned pos = basew[myE] + rk; const int tk = (wgrow0 + (tid_ >> 2)) * 4 + (tid_ & 3);
      FWS(int, WS_ROWTK)[(size_t)myE * CAP + pos] = tk; FWS(float, WS_ROWW)[(size_t)myE * CAP + pos] = myW; }
}

template <bool GU> struct MoeOrder {
    const char* A; const char* W; volatile LAS int* ts; volatile LAS unsigned* cntl; const LAS unsigned* tab; int c;
    __device__ bool next(int i, pg8::Unit& u) const {
        const int x = c & 7, k = c >> 3, q = 8 * i + x;
        const int rt = GU ? (4 * q + (k >> 3)) : (8 * q + (k >> 2));
        if (rt >= ts[NEXP]) return false;
        int e = 0;
        for (int j = 1; j < NEXP; ++j) e += (rt >= ts[j]) ? 1 : 0;
        u.pn = GU ? (k & 7) : (k & 3); u.e = e; u.idx = i; u.rbase = rt * 256; u.pm = (rt - ts[e]) * 256;
        const int left = (int)cntl[e] - u.pm; u.nrows = left < 256 ? left : 256; return true;
    }
    static constexpr int EBm = MOE_FP8 ? 1 : 2;
    __device__ __forceinline__ const char* a_ptr(const pg8::Unit& u) const { return GU ? A : A + (size_t)u.rbase * 1024 * EBm; }
    __device__ __forceinline__ const char* b_ptr(const pg8::Unit& u) const { return W + ((size_t)u.e * (GU ? 2048 : 1024) + (size_t)u.pn * 256) * 1024 * EBm; }
    __device__ __forceinline__ unsigned a_off(const pg8::Unit& u, int row) const { return tab[u.idx * 256 + row]; }
    __device__ __forceinline__ void a_ready(const pg8::Unit&) const {}
    __device__ __forceinline__ void done(const pg8::Unit&) const {}
};
__device__ __forceinline__ void moe_setup(Frame& F) {
    const int tid_ = F.wave * 64 + lane_id();
    volatile LAS int* ts = (volatile LAS int*)(F.LC + 16); volatile LAS unsigned* cntl = F.LC + 64;
    if (tid_ < 32) cntl[tid_] = __hip_atomic_load(F.ctl + CW_CNT + 64 * tid_, RLX_AGENT);
    LDS_WAIT(); __syncthreads();
    if (tid_ == 0) { int acc = 0; for (int e = 0; e < NEXP; ++e) { ts[e] = acc; acc += (int)((cntl[e] + 255u) >> 8); } ts[NEXP] = acc; }
    LDS_WAIT(); __syncthreads();
}

__device__ __forceinline__ void final_phase(Frame& F) {
    const Bufs& B = F.B; const int lane = lane_id();
    const int gw = F.vcu * NWAVES + F.wave, NGW = F.G * NWAVES;
    f32x4 gv[4], bv[4];
#pragma unroll
    for (int j = 0; j < 4; ++j) { gv[j] = *(const f32x4*)(B.ln2_g + 4 * lane + 256 * j); bv[j] = *(const f32x4*)(B.ln2_b + 4 * lane + 256 * j); }
    for (int row = gw; row < NTOK; row += NGW) { float* p = B.out + (size_t)row * 1024 + 4 * lane; const bf16* orow = FWS(bf16, WS_OUTR) + (size_t)row * 4096 + 4 * lane;
        const bf16* xrow = FWS(bf16, WS_X1B) + (size_t)row * 1024 + 4 * lane;
        f32x4 v[4]; float s = 0.f;
#pragma unroll
        for (int j = 0; j < 4; ++j) { { const u32x2 xv = *(const u32x2*)(xrow + 256 * j);
                v[j] = (f32x4){__uint_as_float(xv.x << 16), __uint_as_float(xv.x & 0xffff0000u), __uint_as_float(xv.y << 16), __uint_as_float(xv.y & 0xffff0000u)} * DN_ALPHA; }
#pragma unroll
            for (int kk = 0; kk < 4; ++kk) { const u32x2 wv = *(const u32x2*)(orow + kk * 1024 + 256 * j);
                v[j][0] += __uint_as_float(wv.x << 16); v[j][1] += __uint_as_float(wv.x & 0xffff0000u); v[j][2] += __uint_as_float(wv.y << 16); v[j][3] += __uint_as_float(wv.y & 0xffff0000u); }
            s += (v[j][0] + v[j][1]) + (v[j][2] + v[j][3]); }
        const float mean = wave_sum(s) * (1.f / 1024.f); float s2 = 0.f;
#pragma unroll
        for (int j = 0; j < 4; ++j) { v[j] = v[j] - mean; s2 += (v[j][0] * v[j][0] + v[j][1] * v[j][1]) + (v[j][2] * v[j][2] + v[j][3] * v[j][3]); }
        const float rstd = rsqrtf(wave_sum(s2) * (1.f / 1024.f) + LN_EPS);
#pragma unroll
        for (int j = 0; j < 4; ++j) *(f32x4*)(p + 256 * j) = v[j] * rstd * gv[j] + bv[j]; }
}

constexpr int NPHASE = 11;
struct MArgs { Bufs B; int ph_lo, ph_hi; };
__global__ void __launch_bounds__(NWAVES * 64, 2) mega_fwd(MArgs args) {
    extern __shared__ __attribute__((aligned(16))) unsigned char lds[];
    Frame F;
    F.lds = (LAS unsigned char*)lds; F.LC = (volatile LAS unsigned*)(F.lds + LDSCTL_OFF);
    F.wave = __builtin_amdgcn_readfirstlane((int)threadIdx.x >> 6);
    F.G = gridDim.x; { const int bx = blockIdx.x; F.vcu = (F.G % 8 == 0) ? (bx % 8) * (F.G / 8) + bx / 8 : bx; }
#define REFRESH() do { const __attribute__((address_space(4))) MArgs* kp_ = (const __attribute__((address_space(4))) MArgs*)__builtin_amdgcn_kernarg_segment_ptr(); asm volatile("" : "+s"(kp_)); \
        F.B.x = kp_->B.x; F.B.w_in = kp_->B.w_in; F.B.w_bsb = kp_->B.w_bsb; F.B.w_bret = kp_->B.w_bret; F.B.w_out = kp_->B.w_out; F.B.ln1_g = kp_->B.ln1_g; F.B.ln1_b = kp_->B.ln1_b; \
        F.B.w_router = kp_->B.w_router; F.B.b_router = kp_->B.b_router; F.B.w_gu = kp_->B.w_gu; F.B.b_gu = kp_->B.b_gu; F.B.w_dn = kp_->B.w_dn; F.B.b_dn = kp_->B.b_dn; \
        F.B.ln2_g = kp_->B.ln2_g; F.B.ln2_b = kp_->B.ln2_b; F.B.out = kp_->B.out; F.B.ws = kp_->B.ws; F.ctl = (unsigned*)(F.B.ws + WS_CTL); } while (0)
    REFRESH();
    for (int u = threadIdx.x; u < 256; u += NWAVES * 64) F.LC[u] = 0u;
    __syncthreads();
    const int lo = args.ph_lo, hi = args.ph_hi;
    const bool multi = (hi - lo) > 1;
    if (multi) (void)xcd_barrier_post(F.ctl + CW_BAR, F.LC);
#ifndef PH_COMPILE
#define PH_COMPILE 0x7FF
#endif
#define IN(k) ((((PH_COMPILE) >> (k)) & 1) && lo <= (k) && (k) < hi)
#define SEAM(k) do { if (IN(k) && IN((k) + 1)) { REFRESH(); XcdBarrier bar_; bar_.bar = F.ctl + CW_BAR; bar_.x = xb_xcc_id(); bar_.st = F.LC; xcd_barrier(bar_); } } while (0)
    LAS unsigned char* ring = F.lds + RING_OFF;
    const int c = (int)blockIdx.x;
    if (IN(0)) { REFRESH(); p0_prologue(F); } SEAM(0);
    if (IN(1)) { REFRESH();
        constexpr int IEB = INPROJ_FP8 ? 1 : 2; constexpr bool IF8 = INPROJ_FP8 != 0;
        { pg8::StaticOrder S; S.init(FDO(char, DO_XB), F.B.ws + WS_WINT, NTOK, 2048, 1024, F.G, c, IEB);
          pg8::EpiQK E{FWS(bf16, WS_QSB), FWS(bf16, WS_KSB)};
          pg8::gemm_phase<pg8::EpiQK, pg8::StaticOrder, true, false, IF8>(ring, 1024, S, E, F.wave); }
        { pg8::StaticOrder S; S.init(FDO(char, DO_XB), F.B.ws + WS_WINT + (size_t)2048 * 1024 * IEB, NTOK, 2048, 1024, F.G, c, IEB);
          pg8::EpiRot E{FWS(bf16, WS_QR), FWS(bf16, WS_KR), FDO(bf16, DO_KRT), FWS(bf16, WS_QRS), FWS(float, WS_COS), FWS(float, WS_SIN)};
          pg8::gemm_phase<pg8::EpiRot, pg8::StaticOrder, true, false, IF8>(ring, 1024, S, E, F.wave); }
        { pg8::StaticOrder S; S.init(FDO(char, DO_XB), F.B.ws + WS_WINT + (size_t)4096 * 1024 * IEB, NTOK, 4096, 1024, F.G, c, IEB);
          pg8::EpiGate E{F.B.ws};
          pg8::gemm_phase<pg8::EpiGate, pg8::StaticOrder, true, false, IF8>(ring, 1024, S, E, F.wave); }
        { pg8::StaticOrder S; S.init(F.B.ws + WS_WVT, FDO(char, DO_XB), 3072, NTOK, 1024, F.G, c, IEB);
          pg8::EpiVT E{FWS(bf16, WS_VSBT), FWS(bf16, WS_VRT)};
          pg8::gemm_phase<pg8::EpiVT, pg8::StaticOrder, true, false, IF8>(ring, 1024, S, E, F.wave); }
    } SEAM(1);
    if (IN(2)) { REFRESH(); attn_phase(F); } SEAM(2);
    if (IN(3)) { REFRESH(); scan_phase(F); } SEAM(3);
    if (IN(4)) { REFRESH(); intra_phase(F); } SEAM(4);
    if (IN(5)) { REFRESH();
        { pg8::StaticOrder S; S.init(FWS(bf16, WS_QSB), FWS(bf16, WS_WBSBT), NTOK, 1024, 1024, F.G, c);
          pg8::EpiBranch<0> E{FWS(bf16, WS_GSB), nullptr, FWS(bf16, WS_M1)};
          pg8::gemm_phase<pg8::EpiBranch<0>, pg8::StaticOrder, true, false>(ring, 1024, S, E, F.wave); }
        { pg8::StaticOrder S; S.init(FDO(bf16, DO_R), FWS(bf16, WS_WBRETT), NTOK, 1024, 2048, F.G, c);
          pg8::EpiBranch<1> E{FWS(bf16, WS_GRET), FWS(bf16, WS_M1), FWS(bf16, WS_MG)};
          pg8::gemm_phase<pg8::EpiBranch<1>, pg8::StaticOrder, true, false>(ring, 2048, S, E, F.wave); }
    } SEAM(5);
    if (IN(6)) { REFRESH(); pg8::StaticOrder S; S.init(FWS(bf16, WS_MG), FWS(bf16, WS_WOUTT), NTOK, 1024, 1024, F.G, c);
        pg8::EpiPre E{F.B.x, F.B.out};
        pg8::gemm_phase<pg8::EpiPre, pg8::StaticOrder, true, false>(ring, 1024, S, E, F.wave); } SEAM(6);
    if (IN(7)) { REFRESH(); ln1_router_phase(F); } SEAM(7);
    if (IN(8)) { REFRESH(); moe_setup(F);
        MoeOrder<true> S{(const char*)(MOE_FP8 ? F.B.ws + WS_X1B8 : F.B.ws + WS_X1B), (const char*)FWS(bf16, WS_WGUT), (volatile LAS int*)(F.LC + 16), F.LC + 64, (const LAS unsigned*)(F.lds + LDS_TAB_OFF), c};
        { pg8::Unit u; LAS unsigned* tab = (LAS unsigned*)(F.lds + LDS_TAB_OFF);
          const int tid_ = F.wave * 64 + lane_id();
          for (int i = 0; i < 24 && S.next(i, u); ++i) { if (tid_ < 256) { const int rr = tid_; unsigned off = 0u;
                  if (rr < u.nrows) off = (unsigned)(FWS(int, WS_ROWTK)[(size_t)u.e * CAP + u.pm + rr] >> 2) * (MOE_FP8 ? 1024u : 2048u);
                  tab[i * 256 + rr] = off; } }
          LDS_WAIT(); __syncthreads(); }
        pg8::EpiGateUp E{F.B.b_gu, FWS(bf16, WS_ACT)};
        pg8::gemm_phase<pg8::EpiGateUp, MoeOrder<true>, true, true, MOE_FP8 != 0>(ring, 1024, S, E, F.wave); } SEAM(8);
    if (IN(9)) { REFRESH(); moe_setup(F);
        MoeOrder<false> S{(const char*)FWS(bf16, WS_ACT), (const char*)FWS(bf16, WS_WDT), (volatile LAS int*)(F.LC + 16), F.LC + 64, (const LAS unsigned*)(F.lds + LDS_TAB_OFF), c};
        pg8::EpiDown E{F.B.b_dn, FWS(int, WS_ROWTK), FWS(float, WS_ROWW), FWS(bf16, WS_OUTR)};
        pg8::gemm_phase<pg8::EpiDown, MoeOrder<false>, true, false, MOE_FP8 != 0>(ring, 1024, S, E, F.wave); } SEAM(9);
    if (IN(10)) { REFRESH(); final_phase(F); }
#undef IN
#undef SEAM
}
#ifndef OPT_MASK
#define OPT_MASK 0x7FF
#endif
#ifndef ONE_LAUNCH
#define ONE_LAUNCH 1
#endif
template <int NB, class AF, class BF, class EF> static void launch_ngemm(hipStream_t s, int M, int N, int K, const AF& af, const BF& bf, const EF& ef) {
    GArgs<AF, BF, EF> ga; memset(&ga, 0, sizeof(ga)); ga.af = af; ga.bf = bf; ga.ef = ef; ga.M = M; ga.N = N; ga.K = K; ga.pad = 0;
    ngemm<NB, AF, BF, EF><<<dim3(N / 64, M / 64), 256, 0, s>>>(ga);
}
static void launch_tr(hipStream_t s, int grid, const float* src, int lds, int c0, int width, int K, bf16* dst, int r0) {
    TrArgs a; memset(&a, 0, sizeof(a)); a.src = src; a.dst = dst; a.lds = lds; a.c0 = c0; a.width = width; a.K = K; a.r0 = r0; a.pad = 0;
    n_tr<<<grid, 256, 0, s>>>(a);
}
static AF_rows mk_rows(const void* p, int ld) { AF_rows a; memset(&a, 0, sizeof(a)); a.A = (const bf16*)p; a.ld = ld; a.pad = 0; return a; }
static BF_wt mk_wt(const void* p, int K) { BF_wt a; memset(&a, 0, sizeof(a)); a.W = (const bf16*)p; a.K = K; a.pad = 0; return a; }
static void run_naive(const Bufs& B, hipStream_t s, int stage) {
    unsigned char* ws = B.ws;
    switch (stage) {
    case 0: {
        n_xb<<<2048, 256, 0, s>>>(B);
        bf16* wint = (bf16*)(ws + WS_WINT); bf16* wvt = (bf16*)(ws + WS_WVT);
        launch_tr(s, 1024, B.w_in, INW, 0, 2048, 1024, wint, 0);
        launch_tr(s, 1024, B.w_in, INW, 2048, 1024, 1024, wvt, 0);
        launch_tr(s, 1024, B.w_in, INW, 3072, 2048, 1024, wint, 2048);
        launch_tr(s, 1024, B.w_in, INW, 5120, 2048, 1024, wvt, 1024);
        launch_tr(s, 1024, B.w_in, INW, 7168, 4096, 1024, wint, 4096);
        launch_tr(s, 1024, B.w_bsb, 1024, 0, 1024, 1024, (bf16*)(ws + WS_WBSBT), 0);
        launch_tr(s, 1024, B.w_bret, 1024, 0, 1024, 2048, (bf16*)(ws + WS_WBRETT), 0);
        launch_tr(s, 1024, B.w_out, 1024, 0, 1024, 1024, (bf16*)(ws + WS_WOUTT), 0);
        launch_tr(s, 64, B.w_router, 32, 0, 32, 1024, (bf16*)(ws + WS_WRT), 0);
        { Tr2Args a; memset(&a, 0, sizeof(a)); a.src = B.w_gu; a.dst = (bf16*)(ws + WS_WGUT); n_tr_gu<<<4096, 256, 0, s>>>(a); }
        { Tr2Args a; memset(&a, 0, sizeof(a)); a.src = B.w_dn; a.dst = (bf16*)(ws + WS_WDT); n_tr_dn<<<4096, 256, 0, s>>>(a); }
        n_rope<<<1024, 256, 0, s>>>(B);
    } break;
    case 1: {
        BF_inproj bf; memset(&bf, 0, sizeof(bf)); bf.wint = (const bf16*)(ws + WS_WINT); bf.wvt = (const bf16*)(ws + WS_WVT); EF_inproj ef{B};
        launch_ngemm<1>(s, NTOK, INW, 1024, mk_rows((unsigned char*)B.out + DO_XB, 1024), bf, ef);
        n_rotary<<<4096, 256, 0, s>>>(B);
    } break;
    case 2: n_attn<<<BATCH * SBH * SEQ / 64, 64, 0, s>>>(B);
        if (OPT_MASK & 1) { { Tr2Args a; memset(&a, 0, sizeof(a)); a.src = B.w_gu; a.dst = (bf16*)(ws + WS_WGUT); n_tr_gu<<<4096, 256, 0, s>>>(a); }
                            { Tr2Args a; memset(&a, 0, sizeof(a)); a.src = B.w_dn; a.dst = (bf16*)(ws + WS_WDT); n_tr_dn<<<4096, 256, 0, s>>>(a); } }
        break;
    case 3: n_scan<<<BATCH * RH * RDV, 64, 0, s>>>(B); break;
    case 4: n_intra<<<BATCH * RH * NCHUNK, 256, 0, s>>>(B); break;
    case 5: {
        { EF_m1 ef{B}; launch_ngemm<1>(s, NTOK, 1024, 1024, mk_rows(ws + WS_QSB, 1024), mk_wt(ws + WS_WBSBT, 1024), ef); }
        { EF_mg ef{B}; launch_ngemm<1>(s, NTOK, 1024, 2048, mk_rows((unsigned char*)B.out + DO_R, 2048), mk_wt(ws + WS_WBRETT, 2048), ef); }
    } break;
    case 6: { EF_pre ef{B}; launch_ngemm<1>(s, NTOK, 1024, 1024, mk_rows(ws + WS_MG, 1024), mk_wt(ws + WS_WOUTT, 1024), ef); } break;
    case 7: n_ln1<<<NTOK / 4, 256, 0, s>>>(B); n_router<<<NTOK / 64, 64, 0, s>>>(B); break;
    case 8: { n_tstart<<<1, 64, 0, s>>>(B); n_rowinfo<<<544, 256, 0, s>>>(B); AF_gather af{B}; BF_gu bf{B}; EF_gu ef{B}; launch_ngemm<2>(s, MAXROWS, 1024, 1024, af, bf, ef); } break;
    case 9: { n_tstart<<<1, 64, 0, s>>>(B); n_rowinfo<<<544, 256, 0, s>>>(B); AF_act af{B}; BF_dn bf{B}; EF_dn ef{B}; launch_ngemm<1>(s, MAXROWS, 1024, 1024, af, bf, ef); } break;
    case 10: n_final<<<NTOK / 4, 256, 0, s>>>(B); break;
    }
}
static void run_mega(const Bufs& B, hipStream_t s, int lo, int hi) {
    MArgs a; memset(&a, 0, sizeof(a)); a.B = B; a.ph_lo = lo; a.ph_hi = hi;
    hipLaunchKernelGGL(mega_fwd, dim3(256), dim3(NWAVES * 64), LDS_BYTES, s, a);
}

extern "C" void kernel_launch(void* const* d_in, const int* in_sizes, int n_in, void* d_out, int out_size, void* d_ws, size_t ws_size, hipStream_t stream) {
    if (n_in != 15 || out_size != NTOK * DM || ws_size < WS_END) { fprintf(stderr, "kernel_launch: unexpected shapes (n_in %d out %d ws %zu)\n", n_in, out_size, ws_size); return; }
    static int inited = 0;
    if (!inited) { inited = 1;
        if (hipFuncSetAttribute((const void*)mega_fwd, hipFuncAttributeMaxDynamicSharedMemorySize, LDS_BYTES) != hipSuccess) fprintf(stderr, "kernel_launch: hipFuncSetAttribute failed\n");
        int dev = 0, cus = 0; (void)hipGetDevice(&dev); (void)hipDeviceGetAttribute(&cus, hipDeviceAttributeMultiprocessorCount, dev);
        if (cus != 256) fprintf(stderr, "kernel_launch: built for 256 CUs, device has %d\n", cus);
        (void)hipGetLastError(); }
    Bufs B; memset(&B, 0, sizeof(B));
    B.x = (const float*)d_in[0]; B.w_in = (const float*)d_in[1]; B.w_bsb = (const float*)d_in[2]; B.w_bret = (const float*)d_in[3]; B.w_out = (const float*)d_in[4];
    B.ln1_g = (const float*)d_in[5]; B.ln1_b = (const float*)d_in[6]; B.w_router = (const float*)d_in[7]; B.b_router = (const float*)d_in[8];
    B.w_gu = (const float*)d_in[9]; B.b_gu = (const float*)d_in[10]; B.w_dn = (const float*)d_in[11]; B.b_dn = (const float*)d_in[12]; B.ln2_g = (const float*)d_in[13]; B.ln2_b = (const float*)d_in[14];
    B.out = (float*)d_out; B.ws = (unsigned char*)d_ws;
    (void)hipMemsetAsync((char*)d_ws + WS_CTL, 0, CTL_ZERO_BYTES, stream);
    if ((OPT_MASK & 0x7FF) == 0x7FF && ONE_LAUNCH) { run_mega(B, stream, 0, NPHASE); return; }
    for (int st = 0; st < NPHASE; ++st) { if ((OPT_MASK >> st) & 1) run_mega(B, stream, st, st + 1); else run_naive(B, stream, st);
#ifdef PROBE_DUP
        if (st == PROBE_DUP) {
            if (st == 2) { run_mega(B, stream, 1, 2); run_mega(B, stream, 2, 3); }
            else if (st == 4) { run_mega(B, stream, 3, 4); run_mega(B, stream, 4, 5); }
            else if (st == 7) { (void)hipMemsetAsync((char*)d_ws + WS_CTL, 0, CTL_ZERO_BYTES, stream); run_mega(B, stream, 6, 7); run_mega(B, stream, 7, 8); }
            else if (st == 10) { (void)hipMemsetAsync((char*)d_ws + WS_CTL, 0, CTL_ZERO_BYTES, stream); run_mega(B, stream, 6, 7); run_mega(B, stream, 7, 8); run_mega(B, stream, 10, 11); }
            else {
#ifndef PROBE_REP
#define PROBE_REP 1
#endif
                for (int rep = 0; rep < PROBE_REP; ++rep) run_mega(B, stream, st, st + 1); }
        }
#endif
    }
}
```

```cpp
#include <hip/hip_runtime.h>
#include <cstdio>
#include <cstdint>
#include <cstring>

constexpr int BATCH = 4, SEQ = 8192, DM = 1024, NTOK = BATCH * SEQ;
constexpr int SBH = 16, SBD = 64;
constexpr int RH = 4, RDK = 256, RDV = 512, RQK = RH * RDK  , RV = RH * RDV  ;
constexpr int CHUNK = 64, NCHUNK = SEQ / CHUNK;
constexpr int INW = 11264;
constexpr int NEXP = 32, TOPK = 4, DFF = 1024;
constexpr int CAP = NTOK;
constexpr int MAXROWS = NTOK * TOPK + NEXP * 256;
constexpr float LN_EPS = 1e-5f;
constexpr float DN_ALPHA = 1.18920711500272106672f;
constexpr float LOG2E = 1.4426950408889634f;
constexpr float SB_C2 = 0.125f * LOG2E;

typedef unsigned short bf16;
typedef float f32x4 __attribute__((ext_vector_type(4)));
typedef float f32x16 __attribute__((ext_vector_type(16)));
typedef short bf16x8 __attribute__((ext_vector_type(8)));
typedef short bf16x4 __attribute__((ext_vector_type(4)));
typedef unsigned u32x4 __attribute__((ext_vector_type(4)));
typedef unsigned u32x2 __attribute__((ext_vector_type(2)));

__host__ __device__ __forceinline__ float bf2f(bf16 v) { unsigned u = (unsigned)v << 16; return __builtin_bit_cast(float, u); }
__host__ __device__ __forceinline__ bf16 f2bf(float f) { unsigned u = __builtin_bit_cast(unsigned, f); return (bf16)((u + 0x7fffu + ((u >> 16) & 1u)) >> 16); }
__device__ __forceinline__ unsigned pk2(float lo, float hi) { return (unsigned)f2bf(lo) | ((unsigned)f2bf(hi) << 16); }

constexpr size_t MiB_ = 1u << 20;
#ifndef MOE_FP8
#define MOE_FP8 1
#endif
#ifndef INPROJ_FP8
#define INPROJ_FP8 1
#endif
#ifndef ROT_BF16
#define ROT_BF16 0
#endif
constexpr size_t WS_XB8 = 104 * MiB_, WS_WROT = 136 * MiB_;
constexpr float IN_WSCALE = 32.0f, IN_DS = INPROJ_FP8 ? 1.0f / 32.0f : 1.0f;
constexpr float MOE_WSCALE = 64.0f, MOE_DESCALE = MOE_FP8 ? 1.0f / 64.0f : 1.0f;
__device__ __forceinline__ unsigned pk4_fp8(float a, float b, float c, float d) { int w = 0; w = __builtin_amdgcn_cvt_pk_fp8_f32(a, b, w, false); w = __builtin_amdgcn_cvt_pk_fp8_f32(c, d, w, true); return (unsigned)w; }

constexpr size_t MiB = 1u << 20;
constexpr size_t WS_CTL = 0, CTL_ZERO_BYTES = 1 * MiB;
constexpr size_t WS_COS = 1 * MiB, WS_SIN = 5 * MiB;
constexpr size_t WS_WRT = 9 * MiB;
constexpr size_t WS_TSTART = 9 * MiB + 512 * 1024;
constexpr size_t WS_WINT = 10 * MiB;
constexpr size_t WS_WVT = 26 * MiB;
constexpr size_t WS_WBSBT = 32 * MiB, WS_WBRETT = 34 * MiB, WS_WOUTT = 38 * MiB;
constexpr size_t WS_WGUT = 40 * MiB;
constexpr size_t WS_WDT = 168 * MiB;
constexpr size_t WS_QSB = 232 * MiB;
constexpr size_t WS_KSB = 296 * MiB;
constexpr size_t WS_VSBT = 360 * MiB;
constexpr size_t WS_YINT = 296 * MiB;
constexpr size_t WS_QR = 424 * MiB, WS_KR = 488 * MiB;
constexpr size_t WS_VRT = 552 * MiB;
constexpr size_t WS_SG = 680 * MiB;
constexpr size_t WS_GSB = 808 * MiB, WS_GRET = 872 * MiB;
constexpr size_t WS_SELE = 936 * MiB, WS_SELW = 937 * MiB;
constexpr size_t WS_ROWTK = 940 * MiB, WS_ROWW = 944 * MiB;
constexpr size_t WS_RINFO = 948 * MiB;
constexpr size_t WS_M1 = 424 * MiB, WS_MG = 488 * MiB;
constexpr size_t WS_X1B = 552 * MiB;
constexpr size_t WS_ACT = 616 * MiB;
constexpr size_t WS_OUTR = 232 * MiB;
constexpr size_t WS_END = 1024 * MiB;
static_assert(WS_ACT + (size_t)MAXROWS * 1024 * 2 <= WS_SELE, "ACT fits");
static_assert(WS_OUTR + (size_t)NTOK * 4 * 1024 * 2 <= WS_MG, "OUTR fits below MG");
constexpr size_t DO_XB = 0, DO_KRT = 64 * MiB;

__host__ __device__ __forceinline__ size_t krt_idx(int bh, int t, int d) { return ((((size_t)bh * 128 + (t >> 6)) * 4 + ((t >> 4) & 3)) * 256 + d) * 16 + (t & 15); }
__host__ __device__ __forceinline__ size_t vrt_idx(int bh, int t, int v) { return ((((size_t)bh * 128 + (t >> 6)) * 4 + ((t >> 4) & 3)) * 512 + v) * 16 + (t & 15); }
__host__ __device__ __forceinline__ size_t qrs_idx(int bh, int t, int d) { return ((((size_t)bh * 128 + (t >> 6)) * 16 + (d >> 4)) * 64 + (t & 63)) * 16 + (d & 15); }
__host__ __device__ __forceinline__ size_t yt_idx(int bh, int t, int v) { return ((((size_t)bh * 128 + (t >> 6)) * 64 + (v >> 3)) * 64 + (t & 63)) * 8 + (v & 7); }
__host__ __device__ __forceinline__ size_t ksb_idx(int bh, int t, int d) { return ((((size_t)bh * 256 + (t >> 5)) * 4 + (d >> 4)) * 32 + (t & 31)) * 16 + (d & 15); }
__host__ __device__ __forceinline__ size_t vsb_idx(int bh, int t, int d) { return (((size_t)bh * 512 + (t >> 4)) * 64 + d) * 16 + (t & 15); }
constexpr size_t WS_X1B8 = 888 * MiB;
constexpr size_t WS_QRS = 952 * MiB;
constexpr size_t DO_R = 0;
static_assert(WS_QRS + 64 * MiB <= WS_END, "QRS fits");

constexpr int CW_TMO = 0, CW_CODE = 1;
constexpr int CW_BAR = 4096;
constexpr int CW_CNT = 16384;

struct Bufs {
    const float *x, *w_in, *w_bsb, *w_bret, *w_out, *ln1_g, *ln1_b, *w_router, *b_router, *w_gu, *b_gu, *w_dn, *b_dn, *ln2_g, *ln2_b;
    float* out; unsigned char* ws;
};
struct MArgs { Bufs B; int ph_lo, ph_hi; };
#define KARG_LDS_WORD 250
__device__ __forceinline__ const __attribute__((address_space(4))) struct MArgs* karg_ptr() {
    extern __shared__ __attribute__((aligned(16))) unsigned char lds_karg_[];
    const volatile __attribute__((address_space(3))) unsigned* p = (const volatile __attribute__((address_space(3))) unsigned*)((__attribute__((address_space(3))) unsigned char*)lds_karg_ + 131072) + KARG_LDS_WORD;
    const unsigned lo = __builtin_amdgcn_readfirstlane(p[0]), hi = __builtin_amdgcn_readfirstlane(p[1]);
    return (const __attribute__((address_space(4))) struct MArgs*)(((unsigned long long)hi << 32) | lo);
}
#define KARG() (karg_ptr())
#define WSP(T, off) ((T*)(B.ws + (off)))
#define DOP(T, off) ((T*)((unsigned char*)B.out + (off)))

__global__ void n_xb(Bufs B) {
    const size_t n = (size_t)NTOK * DM; bf16* xb = DOP(bf16, DO_XB);
    for (size_t i = (size_t)blockIdx.x * blockDim.x + threadIdx.x; i < n; i += (size_t)gridDim.x * blockDim.x) xb[i] = f2bf(B.x[i]);
}
struct TrArgs { const float* src; bf16* dst; int lds, c0, width, K, r0, pad; };
__global__ void n_tr(TrArgs a) {
    const float* src = a.src; bf16* dst = a.dst; const int lds = a.lds, c0 = a.c0, width = a.width, K = a.K, r0 = a.r0;
    const size_t n = (size_t)width * K;
    for (size_t i = (size_t)blockIdx.x * blockDim.x + threadIdx.x; i < n; i += (size_t)gridDim.x * blockDim.x) {
        const int k = (int)(i % K), c = (int)(i / K); dst[(size_t)(r0 + c) * K + k] = f2bf(src[(size_t)k * lds + c0 + c]); }
}
struct Tr2Args { const float* src; bf16* dst; };
__global__ void n_tr_gu(Tr2Args a) { const float* src = a.src; bf16* dst = a.dst;
    const size_t n = (size_t)NEXP * 2048 * 1024;
    for (size_t i = (size_t)blockIdx.x * blockDim.x + threadIdx.x; i < n; i += (size_t)gridDim.x * blockDim.x) {
        const int k = (int)(i % 1024); const int r = (int)((i / 1024) % 2048); const int e = (int)(i / (1024 * 2048));
        const int ct = r >> 8, bj = (r >> 7) & 1, ii = r & 127; const int c = bj * 1024 + 128 * ct + ii;
        dst[i] = f2bf(src[((size_t)e * 1024 + k) * 2048 + c]); }
}
__global__ void n_tr_dn(Tr2Args a) { const float* src = a.src; bf16* dst = a.dst;
    const size_t n = (size_t)NEXP * 1024 * 1024;
    for (size_t i = (size_t)blockIdx.x * blockDim.x + threadIdx.x; i < n; i += (size_t)gridDim.x * blockDim.x) {
        const int ff = (int)(i % 1024); const int d = (int)((i / 1024) % 1024); const int e = (int)(i / (1024 * 1024));
        dst[i] = f2bf(src[((size_t)e * 1024 + ff) * 1024 + d]); }
}
__device__ __forceinline__ float rope_inv_freq(int j) { return powf(10000.0f, -(float)j / 128.0f); }
__global__ void n_rope(Bufs B) {
    float* c = WSP(float, WS_COS); float* s = WSP(float, WS_SIN);
    for (int i = blockIdx.x * blockDim.x + threadIdx.x; i < SEQ * 128; i += gridDim.x * blockDim.x) {
        const int pos = i >> 7, j = i & 127; const float ang = (float)pos * rope_inv_freq(j);
        c[i] = (float)cos((double)ang); s[i] = (float)sin((double)ang); }
}

template <class AF, class BF, class EF> struct GArgs { AF af; BF bf; EF ef; int M, N, K, pad; };
template <int NB, class AF, class BF, class EF>
__global__ void __launch_bounds__(256) ngemm(GArgs<AF, BF, EF> ga) {
    const AF& af = ga.af; const BF& bf = ga.bf; const EF& ef = ga.ef; const int K = ga.K;
    __shared__ float As[16][65], Bs[NB][16][65];
    const int tx = threadIdx.x & 15, ty = threadIdx.x >> 4;
    const int m0 = blockIdx.y * 64, n0 = blockIdx.x * 64;
    if (!af.active(m0)) return;
    float acc[NB][4][4];
#pragma unroll
    for (int b = 0; b < NB; ++b)
#pragma unroll
        for (int i = 0; i < 4; ++i)
#pragma unroll
            for (int j = 0; j < 4; ++j) acc[b][i][j] = 0.f;
    for (int k0 = 0; k0 < K; k0 += 16) {
#pragma unroll
        for (int i = 0; i < 4; ++i) { const int idx = threadIdx.x + 256 * i; const int kk = idx & 15, mm = idx >> 4; As[kk][mm] = af(m0 + mm, k0 + kk); }
#pragma unroll
        for (int b = 0; b < NB; ++b)
#pragma unroll
            for (int i = 0; i < 4; ++i) { const int idx = threadIdx.x + 256 * i; const int kk = idx & 15, nn = idx >> 4; Bs[b][kk][nn] = bf(m0, k0 + kk, n0 + nn, b); }
        __syncthreads();
#pragma unroll
        for (int kk = 0; kk < 16; ++kk) {
            float a[4];
#pragma unroll
            for (int i = 0; i < 4; ++i) a[i] = As[kk][ty * 4 + i];
#pragma unroll
            for (int b = 0; b < NB; ++b) {
                float bb[4];
#pragma unroll
                for (int j = 0; j < 4; ++j) bb[j] = Bs[b][kk][tx * 4 + j];
#pragma unroll
                for (int i = 0; i < 4; ++i)
#pragma unroll
                    for (int j = 0; j < 4; ++j) acc[b][i][j] += a[i] * bb[j];
            }
        }
        __syncthreads();
    }
#pragma unroll
    for (int i = 0; i < 4; ++i)
#pragma unroll
        for (int j = 0; j < 4; ++j) {
            float v[NB];
#pragma unroll
            for (int b = 0; b < NB; ++b) v[b] = acc[b][i][j];
            ef(m0 + ty * 4 + i, n0 + tx * 4 + j, v);
        }
}

__device__ __forceinline__ float sigmoidf_(float x) { return 1.0f / (1.0f + __expf(-x)); }
__device__ __forceinline__ float ret_log2gamma(int h) { return log2f(1.0f - exp2f(-5.0f - (float)h)); }

struct AF_rows { const bf16* A; int ld, pad; __device__ bool active(int) const { return true; } __device__ float operator()(int m, int k) const { return bf2f(A[(size_t)m * ld + k]); } };
struct BF_inproj { const bf16 *wint, *wvt;
    __device__ float operator()(int, int k, int n, int) const {
        const bf16* row;
        if (n < 2048) row = wint + (size_t)n * 1024;
        else if (n < 3072) row = wvt + (size_t)(n - 2048) * 1024;
        else if (n < 5120) row = wint + (size_t)(2048 + n - 3072) * 1024;
        else if (n < 7168) row = wvt + (size_t)(1024 + n - 5120) * 1024;
        else row = wint + (size_t)(4096 + n - 7168) * 1024;
        return bf2f(row[k]); } };
struct EF_inproj { Bufs B;
    __device__ void operator()(int m, int n, const float (&v)[1]) const {
        const float a = v[0];
        if (n < 1024) WSP(bf16, WS_QSB)[(size_t)m * 1024 + n] = f2bf(a * SB_C2);
        else if (n < 2048) { const int f = n - 1024; WSP(bf16, WS_KSB)[ksb_idx((m >> 13) * 16 + (f >> 6), m & (SEQ - 1), f & 63)] = f2bf(a); }
        else if (n < 3072) { const int f = n - 2048; WSP(bf16, WS_VSBT)[vsb_idx((m >> 13) * 16 + (f >> 6), m & (SEQ - 1), f & 63)] = f2bf(a); }
        else if (n < 4096) WSP(bf16, WS_QR)[(size_t)m * 1024 + n - 3072] = f2bf(a);
        else if (n < 5120) WSP(bf16, WS_KR)[(size_t)m * 1024 + n - 4096] = f2bf(a);
        else if (n < 7168) { const int f = n - 5120, h = f >> 9; const float dec = exp2f((float)(63 - (m & 63)) * ret_log2gamma(h));
            WSP(bf16, WS_VRT)[vrt_idx((m >> 13) * 4 + h, m & (SEQ - 1), f & 511)] = f2bf(a * dec); }
        else if (n < 9216) { const int f = n - 7168; WSP(bf16, WS_SG)[yt_idx((m >> 13) * 4 + (f >> 9), m & (SEQ - 1), f & 511)] = f2bf(a * sigmoidf_(a)); }
        else if (n < 10240) WSP(bf16, WS_GSB)[(size_t)m * 1024 + n - 9216] = f2bf(sigmoidf_(a));
        else WSP(bf16, WS_GRET)[(size_t)m * 1024 + n - 10240] = f2bf(sigmoidf_(a)); } };
__global__ void n_rotary(Bufs B) {
    bf16* qr = WSP(bf16, WS_QR); bf16* kr = WSP(bf16, WS_KR); bf16* krt = DOP(bf16, DO_KRT);
    const float* ct = WSP(float, WS_COS); const float* st = WSP(float, WS_SIN);
    const size_t n = (size_t)NTOK * RH * 128;
    for (size_t i = (size_t)blockIdx.x * blockDim.x + threadIdx.x; i < n; i += (size_t)gridDim.x * blockDim.x) {
        const int j = (int)(i & 127), h = (int)((i >> 7) & 3); const int m = (int)(i >> 9); const int pos = m & (SEQ - 1);
        const float c = ct[pos * 128 + j], s = st[pos * 128 + j];
        const size_t o1 = (size_t)m * 1024 + h * 256 + j, o2 = o1 + 128;
        const int bh = (m >> 13) * 4 + h;
        { const float x1 = bf2f(qr[o1]), x2 = bf2f(qr[o2]); const bf16 r1 = f2bf((x1 * c - x2 * s) * 0.0625f), r2 = f2bf((x1 * s + x2 * c) * 0.0625f); qr[o1] = r1; qr[o2] = r2;
          WSP(bf16, WS_QRS)[qrs_idx(bh, pos, j)] = r1; WSP(bf16, WS_QRS)[qrs_idx(bh, pos, j + 128)] = r2; }
        { const float x1 = bf2f(kr[o1]), x2 = bf2f(kr[o2]); const bf16 r1 = f2bf(x1 * c - x2 * s), r2 = f2bf(x1 * s + x2 * c); kr[o1] = r1; kr[o2] = r2;
          krt[krt_idx(bh, pos, j)] = r1; krt[krt_idx(bh, pos, j + 128)] = r2; }
    }
}

__global__ void __launch_bounds__(64) n_attn(Bufs B) {
    const int gid = blockIdx.x * 64 + threadIdx.x;
    const int t = gid & (SEQ - 1), bh = gid >> 13, h = bh & 15, b = bh >> 4;
    bf16* q = WSP(bf16, WS_QSB); const bf16* k = WSP(bf16, WS_KSB); const bf16* vt = WSP(bf16, WS_VSBT);
    const size_t rb = (size_t)b * SEQ;
    float qv[64], o[64];
#pragma unroll
    for (int d = 0; d < 64; ++d) { qv[d] = bf2f(q[(rb + t) * 1024 + h * 64 + d]); o[d] = 0.f; }
    float later = 0.f;
    for (int s = t - 1; s >= 0; --s) {
        float z2 = 0.f;
#pragma unroll
        for (int d = 0; d < 64; ++d) z2 += qv[d] * bf2f(k[ksb_idx(bh, s, d)]);
        const float z = z2 * 0.6931471805599453f;
        const float sp = fmaxf(z, 0.f) + log1pf(__expf(-fabsf(z)));
        const float a = __expf((z - sp) + later);
        later -= sp;
        if (a > 0.f) {
#pragma unroll
            for (int d = 0; d < 64; ++d) o[d] += a * bf2f(vt[vsb_idx(bh, s, d)]);
        }
    }
#pragma unroll
    for (int d = 0; d < 64; ++d) q[(rb + t) * 1024 + h * 64 + d] = f2bf(o[d]);
}

__global__ void __launch_bounds__(64) n_scan(Bufs B) {
    const int gid = blockIdx.x, v = gid & 511, h = (gid >> 9) & 3, b = gid >> 11, lane = threadIdx.x;
    const bf16* qr = WSP(bf16, WS_QR); const bf16* krt = DOP(bf16, DO_KRT); const bf16* vrt = WSP(bf16, WS_VRT); bf16* yint = WSP(bf16, WS_YINT);
    const float l2g = ret_log2gamma(h), cd = exp2f(64.f * l2g);
    float st[4] = {0.f, 0.f, 0.f, 0.f};
    for (int c = 0; c < NCHUNK; ++c) {
        const size_t tok0 = (size_t)b * SEQ + c * 64;
        for (int i = 0; i < 64; ++i) {
            const bf16* qp = qr + (tok0 + i) * 1024 + h * 256 + 4 * lane;
            float p = bf2f(qp[0]) * st[0] + bf2f(qp[1]) * st[1] + bf2f(qp[2]) * st[2] + bf2f(qp[3]) * st[3];
#pragma unroll
            for (int o = 1; o < 64; o <<= 1) p += __shfl_xor(p, o);
            if (lane == 0) yint[yt_idx(b * 4 + h, c * 64 + i, v)] = f2bf(p * exp2f((float)(i + 1) * l2g));
        }
        float ns[4] = {st[0] * cd, st[1] * cd, st[2] * cd, st[3] * cd};
        for (int j = 0; j < 64; ++j) {
            const float vv = bf2f(vrt[vrt_idx(b * 4 + h, c * 64 + j, v)]);
#pragma unroll
            for (int e = 0; e < 4; ++e) ns[e] += bf2f(krt[krt_idx(b * 4 + h, c * 64 + j, 4 * lane + e)]) * vv;
        }
#pragma unroll
        for (int e = 0; e < 4; ++e) st[e] = ns[e];
    }
}

__global__ void __launch_bounds__(256) n_intra(Bufs B) {
    __shared__ float P[64][65]; __shared__ float Y[8][512]; __shared__ float stat[8][2];
    const int gid = blockIdx.x, c = gid & 127, h = (gid >> 7) & 3, b = gid >> 9, tid = threadIdx.x;
    const bf16* qr = WSP(bf16, WS_QR); const bf16* kr = WSP(bf16, WS_KR); const bf16* vrt = WSP(bf16, WS_VRT); const bf16* sg = WSP(bf16, WS_SG); const bf16* yr = WSP(bf16, WS_YINT); bf16* rout = DOP(bf16, DO_R);
    const size_t tok0 = (size_t)b * SEQ + c * 64; const float l2g = ret_log2gamma(h);
    for (int e = tid; e < 4096; e += 256) { const int i = e >> 6, j = e & 63; float s = 0.f;
        const bf16* qp = qr + (tok0 + i) * 1024 + h * 256; const bf16* kp = kr + (tok0 + j) * 1024 + h * 256;
        for (int d = 0; d < 256; ++d) s += bf2f(qp[d]) * bf2f(kp[d]);
        const int ad = i > j ? i - j : j - i; P[i][j] = s * exp2f((float)(ad - 63 + j) * l2g); }
    __syncthreads();
    for (int i0 = 0; i0 < 64; i0 += 8) {
        for (int vv = tid; vv < 512; vv += 256) {
            float acc[8] = {0.f, 0.f, 0.f, 0.f, 0.f, 0.f, 0.f, 0.f};
            for (int j = 0; j < 64; ++j) { const float x = bf2f(vrt[vrt_idx(b * 4 + h, c * 64 + j, vv)]);
#pragma unroll
                for (int r = 0; r < 8; ++r) acc[r] += P[i0 + r][j] * x; }
#pragma unroll
            for (int r = 0; r < 8; ++r) Y[r][vv] = acc[r] + bf2f(yr[yt_idx(b * 4 + h, c * 64 + i0 + r, vv)]);
        }
        __syncthreads();
        { const int w = tid >> 6, lane = tid & 63;
          for (int r = w; r < 8; r += 4) { float s = 0.f, s2 = 0.f;
              for (int vv = lane; vv < 512; vv += 64) { const float x = Y[r][vv]; s += x; }
#pragma unroll
              for (int o = 1; o < 64; o <<= 1) s += __shfl_xor(s, o);
              const float mean = s * (1.f / 512.f);
              for (int vv = lane; vv < 512; vv += 64) { const float x = Y[r][vv] - mean; s2 += x * x; }
#pragma unroll
              for (int o = 1; o < 64; o <<= 1) s2 += __shfl_xor(s2, o);
              if (lane == 0) { stat[r][0] = mean; stat[r][1] = rsqrtf(s2 * (1.f / 512.f) + LN_EPS); } } }
        __syncthreads();
        for (int e = tid; e < 8 * 512; e += 256) { const int r = e >> 9, vv = e & 511; const size_t o = (tok0 + i0 + r) * 2048 + h * 512 + vv;
            rout[o] = f2bf(bf2f(sg[yt_idx(b * 4 + h, c * 64 + i0 + r, vv)]) * (Y[r][vv] - stat[r][0]) * stat[r][1]); }
        __syncthreads();
    }
}

struct BF_wt { const bf16* W; int K, pad; __device__ float operator()(int, int k, int n, int) const { return bf2f(W[(size_t)n * K + k]); } };
struct EF_m1 { Bufs B; __device__ void operator()(int m, int n, const float (&v)[1]) const { const size_t o = (size_t)m * 1024 + n; WSP(bf16, WS_M1)[o] = f2bf(bf2f(WSP(bf16, WS_GSB)[o]) * v[0]); } };
struct EF_mg { Bufs B; __device__ void operator()(int m, int n, const float (&v)[1]) const { const size_t o = (size_t)m * 1024 + n; WSP(bf16, WS_MG)[o] = f2bf(bf2f(WSP(bf16, WS_M1)[o]) + bf2f(WSP(bf16, WS_GRET)[o]) * v[0]); } };
struct EF_pre { Bufs B; __device__ void operator()(int m, int n, const float (&v)[1]) const { const size_t o = (size_t)m * 1024 + n; B.out[o] = DN_ALPHA * B.x[o] + v[0]; } };

__device__ __forceinline__ float wave_sum(float v) {
#pragma unroll
    for (int o = 1; o < 64; o <<= 1) v += __shfl_xor(v, o);
    return v;
}
__global__ void __launch_bounds__(256) n_ln1(Bufs B) {
    const int row = blockIdx.x * 4 + (threadIdx.x >> 6), lane = threadIdx.x & 63;
    float* p = B.out + (size_t)row * 1024; bf16* xb = WSP(bf16, WS_X1B) + (size_t)row * 1024;
    float v[16]; float s = 0.f;
#pragma unroll
    for (int j = 0; j < 16; ++j) { v[j] = p[lane + 64 * j]; s += v[j]; }
    const float mean = wave_sum(s) * (1.f / 1024.f); float s2 = 0.f;
#pragma unroll
    for (int j = 0; j < 16; ++j) { v[j] -= mean; s2 += v[j] * v[j]; }
    const float rstd = rsqrtf(wave_sum(s2) * (1.f / 1024.f) + LN_EPS);
#pragma unroll
    for (int j = 0; j < 16; ++j) { const int c = lane + 64 * j; const float y = v[j] * rstd * B.ln1_g[c] + B.ln1_b[c]; p[c] = y; xb[c] = f2bf(y); }
}
__global__ void __launch_bounds__(64) n_router(Bufs B) {
    const int tok = blockIdx.x * 64 + threadIdx.x;
    const bf16* xb = WSP(bf16, WS_X1B) + (size_t)tok * 1024; const bf16* wr = WSP(bf16, WS_WRT);
    float lg[32];
#pragma unroll
    for (int e = 0; e < 32; ++e) lg[e] = 0.f;
    for (int k = 0; k < 1024; ++k) { const float xv = bf2f(xb[k]);
#pragma unroll
        for (int e = 0; e < 32; ++e) lg[e] += xv * bf2f(wr[e * 1024 + k]); }
#pragma unroll
    for (int e = 0; e < 32; ++e) lg[e] += B.b_router[e];
    int se[4]; float sv[4];
#pragma unroll
    for (int kk = 0; kk < 4; ++kk) { float best = -INFINITY; int bi = 0;
#pragma unroll
        for (int e = 0; e < 32; ++e) { if (lg[e] > best) { best = lg[e]; bi = e; } }
        se[kk] = bi; sv[kk] = best;
#pragma unroll
        for (int e = 0; e < 32; ++e) if (e == bi) lg[e] = -INFINITY; }
    const float e1 = __expf(sv[1] - sv[0]), e2 = __expf(sv[2] - sv[0]), e3 = __expf(sv[3] - sv[0]); const float inv = 1.f / (1.f + e1 + e2 + e3);
    const float w[4] = {inv, e1 * inv, e2 * inv, e3 * inv};
    unsigned* cnt = WSP(unsigned, WS_CTL) + CW_CNT;
#pragma unroll
    for (int kk = 0; kk < 4; ++kk) { WSP(int, WS_SELE)[tok * 4 + kk] = se[kk]; WSP(float, WS_SELW)[tok * 4 + kk] = w[kk];
        const unsigned pos = atomicAdd(cnt + 64 * se[kk], 1u);
        WSP(int, WS_ROWTK)[(size_t)se[kk] * CAP + pos] = tok * 4 + kk; WSP(float, WS_ROWW)[(size_t)se[kk] * CAP + pos] = w[kk]; }
}
__global__ void n_tstart(Bufs B) {
    if (threadIdx.x == 0 && blockIdx.x == 0) { int* ts = WSP(int, WS_TSTART); const unsigned* cnt = WSP(unsigned, WS_CTL) + CW_CNT; int acc = 0;
        for (int e = 0; e < NEXP; ++e) { ts[e] = acc; acc += (int)((cnt[64 * e] + 255u) >> 8); } ts[NEXP] = acc; }
}
struct MoeRow { int e, valid, tk; float w; };
__global__ void n_rowinfo(Bufs B) {
    const int* ts = WSP(int, WS_TSTART); const unsigned* cnt = WSP(unsigned, WS_CTL) + CW_CNT; MoeRow* ri = WSP(MoeRow, WS_RINFO);
    for (int m = blockIdx.x * blockDim.x + threadIdx.x; m < MAXROWS; m += gridDim.x * blockDim.x) {
        MoeRow r; const int rt = m >> 8; int e = 0;
        while (e < NEXP - 1 && rt >= ts[e + 1]) ++e;
        const int pos = m - 256 * ts[e];
        r.e = e; r.valid = (rt < ts[NEXP]) && (pos < (int)cnt[64 * e]);
        r.tk = r.valid ? WSP(int, WS_ROWTK)[(size_t)e * CAP + pos] : 0; r.w = r.valid ? WSP(float, WS_ROWW)[(size_t)e * CAP + pos] : 0.f; ri[m] = r; }
}
struct AF_gather { Bufs B; __device__ bool active(int m0) const { return (m0 >> 8) < WSP(int, WS_TSTART)[NEXP]; }
    __device__ float operator()(int m, int k) const { const int tk = WSP(MoeRow, WS_RINFO)[m].tk; return bf2f(WSP(bf16, WS_X1B)[(size_t)(tk >> 2) * 1024 + k]); } };
struct BF_gu { Bufs B; __device__ float operator()(int m0, int k, int n, int which) const { const int e = WSP(MoeRow, WS_RINFO)[m0].e;
        const int ct = n >> 7, i = n & 127; return bf2f(WSP(bf16, WS_WGUT)[((size_t)e * 2048 + 256 * ct + 128 * which + i) * 1024 + k]); } };
__device__ __forceinline__ float moe_act(float g, float u) {
    g = fminf(g, 7.0f); u = fminf(fmaxf(u, -7.0f), 7.0f); const float glu = g * (1.0f / (1.0f + __expf(-1.702f * g))); return (u + 1.0f) * glu; }
struct EF_gu { Bufs B; __device__ void operator()(int m, int n, const float (&v)[2]) const { const MoeRow r = WSP(MoeRow, WS_RINFO)[m]; if (!r.valid) return;
        const float g = v[0] + B.b_gu[r.e * 2048 + n], u = v[1] + B.b_gu[r.e * 2048 + 1024 + n]; WSP(bf16, WS_ACT)[(size_t)m * 1024 + n] = f2bf(moe_act(g, u)); } };
struct AF_act { Bufs B; __device__ bool active(int m0) const { return (m0 >> 8) < WSP(int, WS_TSTART)[NEXP]; }
    __device__ float operator()(int m, int k) const { return WSP(MoeRow, WS_RINFO)[m].valid ? bf2f(WSP(bf16, WS_ACT)[(size_t)m * 1024 + k]) : 0.f; } };
struct BF_dn { Bufs B; __device__ float operator()(int m0, int k, int n, int) const { const int e = WSP(MoeRow, WS_RINFO)[m0].e; return bf2f(WSP(bf16, WS_WDT)[((size_t)e * 1024 + n) * 1024 + k]); } };
struct EF_dn { Bufs B; __device__ void operator()(int m, int n, const float (&v)[1]) const { const MoeRow r = WSP(MoeRow, WS_RINFO)[m]; if (!r.valid) return;
        WSP(bf16, WS_OUTR)[(size_t)r.tk * 1024 + n] = f2bf((v[0] + B.b_dn[r.e * 1024 + n]) * r.w); } };
__global__ void __launch_bounds__(256) n_final(Bufs B) {
    const int row = blockIdx.x * 4 + (threadIdx.x >> 6), lane = threadIdx.x & 63;
    float* p = B.out + (size_t)row * 1024; const bf16* orow = WSP(bf16, WS_OUTR) + (size_t)row * 4 * 1024;
    float v[16]; float s = 0.f;
#pragma unroll
    for (int j = 0; j < 16; ++j) { const int c = lane + 64 * j; float a = DN_ALPHA * bf2f(WSP(bf16, WS_X1B)[(size_t)row * 1024 + c]);
#pragma unroll
        for (int kk = 0; kk < 4; ++kk) a += bf2f(orow[kk * 1024 + c]);
        v[j] = a; s += a; }
    const float mean = wave_sum(s) * (1.f / 1024.f); float s2 = 0.f;
#pragma unroll
    for (int j = 0; j < 16; ++j) { v[j] -= mean; s2 += v[j] * v[j]; }
    const float rstd = rsqrtf(wave_sum(s2) * (1.f / 1024.f) + LN_EPS);
#pragma unroll
    for (int j = 0; j < 16; ++j) { const int c = lane + 64 * j; p[c] = v[j] * rstd * B.ln2_g[c] + B.ln2_b[c]; }
}

__device__ __forceinline__ int lane_id() { int l; asm volatile("v_mbcnt_lo_u32_b32 %0, -1, 0\n\tv_mbcnt_hi_u32_b32 %0, -1, %0" : "=v"(l)); return l; }
namespace pg8 {
#define PG8_LAS __attribute__((address_space(3)))
constexpr int BM = 256, BK = 64, HALF = 128, HTB = HALF * BK * 2  , STAGE_BYTES = 8 * HTB, NXCD = 8, WGM = 8;
__host__ __device__ __forceinline__ int lds_byte(int r, int c) { const int st = (r >> 4) * 2 + (c >> 5), rr = r & 15, cc = c & 31, ob = rr * 64 + cc * 2; return st * 1024 + (ob ^ (((ob >> 9) & 1) << 5)); }
__host__ __device__ __forceinline__ void stage_rc(int b, int& R, int& C) { const int st = b / 1024, sb = b % 1024, swz = sb ^ (((sb >> 9) & 1) << 5); R = (st >> 1) * 16 + swz / 64; C = (st & 1) * 32 + (swz % 64) / 2; }
__host__ __device__ __forceinline__ int perm32(int rho) { const int n = rho >> 4, i = rho & 15; return 8 * (i >> 2) + 4 * n + (i & 3); }

typedef int v8i_t __attribute__((ext_vector_type(8)));
typedef int v4i_t __attribute__((ext_vector_type(4)));
struct Unit { int pm, pn, e, idx, rbase, nrows; };

struct StaticOrder {
    const char* A; const char* Bt; int nM, nN, nwg, G, c, rb;
    __device__ void init(const void* A_, const void* Bt_, int M, int N, int K_, int G_, int c_, int eb = 2) { A = (const char*)A_; Bt = (const char*)Bt_; nM = M / BM; nN = N / BM; nwg = nM * nN; G = G_; c = c_; rb = K_ * eb; }
    __device__ bool next(int i, Unit& u) const {
        const long L = (long)i * G + c; if (L >= nwg) return false;
        int wgid = (int)L; { const int q = nwg / NXCD, r = nwg % NXCD, xcd = wgid % NXCD, off = wgid / NXCD; wgid = (xcd < r ? xcd * (q + 1) : r * (q + 1) + (xcd - r) * q) + off; }
        const int nig = WGM * nN, gid = wgid / nig, fm = gid * WGM, gsz = (nM - fm) < WGM ? (nM - fm) : WGM;
        u.pm = fm + ((wgid % nig) % gsz); u.pn = (wgid % nig) / gsz; u.e = 0; u.idx = i; u.rbase = u.pm * BM; u.nrows = BM; return true;
    }
    __device__ __forceinline__ const char* a_ptr(const Unit& u) const { return A + (size_t)u.pm * BM * rb; }
    __device__ __forceinline__ const char* b_ptr(const Unit& u) const { return Bt + (size_t)u.pn * BM * rb; }
    __device__ __forceinline__ unsigned a_off(const Unit&, int) const { return 0u; }
    __device__ __forceinline__ void a_ready(const Unit&) const {}
    __device__ __forceinline__ void done(const Unit&) const {}
};

__device__ __forceinline__ unsigned cvt_pk_bf16(float lo, float hi) { unsigned r; asm volatile("v_cvt_pk_bf16_f32 %0, %1, %2" : "=v"(r) : "v"(lo), "v"(hi)); return r; }

__device__ __forceinline__ void mfma8_inplace(f32x4& acc, const v8i_t& w8, const v8i_t& a8, int sc_w, int sc_a) {
    asm volatile("v_mfma_scale_f32_16x16x128_f8f6f4 %0, %1, %2, %0, %3, %4 op_sel_hi:[0,0,0]" : "+v"(acc) : "v"(w8), "v"(a8), "v"(sc_w), "v"(sc_a)); }
__device__ __forceinline__ void mfma8_first(f32x4& acc, const v8i_t& w8, const v8i_t& a8, int sc_w, int sc_a) {
    asm volatile("v_mfma_scale_f32_16x16x128_f8f6f4 %0, %1, %2, 0, %3, %4 op_sel_hi:[0,0,0]" : "=&v"(acc) : "v"(w8), "v"(a8), "v"(sc_w), "v"(sc_a)); }
template <class Epi, class Sched, bool ALIGN_EPI, bool GATHER, bool FP8 = false>
__device__ __forceinline__ void gemm_phase(PG8_LAS unsigned char* lds, const int K, const Sched& S, const Epi& E, const int wid) {
    int lane_ = lane_id(); asm volatile("" : "+v"(lane_));
    const int lane = lane_, tid = wid * 64 + lane, wr = wid >> 2, wc = wid & 3, fr = lane & 15, fq = lane >> 4;
    constexpr int EB = FP8 ? 1 : 2;
    const int nt = K * EB / 128;
    unsigned voffB[2];
#pragma unroll
    for (int i = 0; i < 2; ++i) { int R, C; stage_rc(tid * 16 + i * 8192, R, C); const int Rb = Epi::PERM ? ((R & ~31) + perm32(R & 31)) : R;
        voffB[i] = (unsigned)(Rb * K * EB + C * 2); }
    const size_t kstep = (size_t)(BK * 2);
    const size_t hstep = (size_t)HALF * K * EB;
    const unsigned ldsw = (unsigned)wid * 1024u;
    const int aoff = lds_byte(wr * 64 + fr, fq * 8), boff = lds_byte(wc * 32 + fr, fq * 8);
#define PG8_SA(b, h) (((b) * 2 + (h)) * HTB)
#define PG8_SB(b, h) ((4 + (b) * 2 + (h)) * HTB)
#define PG8_STAGE(bufoff, gbase, voff) do { _Pragma("unroll") for (int _i = 0; _i < 2; ++_i) \
        __builtin_amdgcn_global_load_lds((const unsigned*)((const char*)(gbase) + (voff)[_i]), (PG8_LAS unsigned*)(lds + (bufoff) + ldsw + _i * 8192), 16, 0, 0); } while (0)
#define PG8_LD8(base) __builtin_shufflevector(*(const PG8_LAS v4i_t*)(lds + (base)), *(const PG8_LAS v4i_t*)(lds + (base) + 1024), 0, 1, 2, 3, 4, 5, 6, 7)
#define PG8_LDA(dst, b, h) do { _Pragma("unroll") for (int m = 0; m < 4; ++m) { if constexpr (FP8) dst##8[m] = PG8_LD8(PG8_SA(b, h) + aoff + m * 2048); else { _Pragma("unroll") for (int k = 0; k < 2; ++k) dst[m][k] = *(const PG8_LAS bf16x8*)(lds + PG8_SA(b, h) + aoff + m * 2048 + k * 1024); } } } while (0)
#define PG8_LDB(dst, b, h) do { _Pragma("unroll") for (int n = 0; n < 2; ++n) { if constexpr (FP8) dst##8[n] = PG8_LD8(PG8_SB(b, h) + boff + n * 2048); else { _Pragma("unroll") for (int k = 0; k < 2; ++k) dst[n][k] = *(const PG8_LAS bf16x8*)(lds + PG8_SB(b, h) + boff + n * 2048 + k * 1024); } } } while (0)
#define PG8_MMA(ai, bj, At, Bt) do { __builtin_amdgcn_s_setprio(1); _Pragma("unroll") for (int m = 0; m < 4; ++m) _Pragma("unroll") for (int n = 0; n < 2; ++n) { \
        if constexpr (FP8) mfma8_inplace(acc[ai][bj][m][n], Bt##8[n], At##8[m], sc_w, sc_a); \
        else { _Pragma("unroll") for (int k = 0; k < 2; ++k) acc[ai][bj][m][n] = __builtin_amdgcn_mfma_f32_16x16x32_bf16(Bt[n][k], At[m][k], acc[ai][bj][m][n], 0, 0, 0); } } \
        __builtin_amdgcn_s_setprio(0); } while (0)
#define PG8_MMA_Z(ai, bj, At, Bt) do { __builtin_amdgcn_s_setprio(1); _Pragma("unroll") for (int m = 0; m < 4; ++m) _Pragma("unroll") for (int n = 0; n < 2; ++n) { \
        if constexpr (FP8) mfma8_first(acc[ai][bj][m][n], Bt##8[n], At##8[m], sc_w, sc_a); \
        else { acc[ai][bj][m][n] = __builtin_amdgcn_mfma_f32_16x16x32_bf16(Bt[n][0], At[m][0], (f32x4){0.f, 0.f, 0.f, 0.f}, 0, 0, 0); \
               acc[ai][bj][m][n] = __builtin_amdgcn_mfma_f32_16x16x32_bf16(Bt[n][1], At[m][1], acc[ai][bj][m][n], 0, 0, 0); } } \
        __builtin_amdgcn_s_setprio(0); } while (0)
#define PG8_WAIT_V(n) asm volatile("s_waitcnt vmcnt(" #n ")" ::: "memory")
#define PG8_WAIT_L(n) asm volatile("s_waitcnt lgkmcnt(" #n ")" ::: "memory")
#define PG8_BAR __builtin_amdgcn_s_barrier()
#define PG8_SCHED __builtin_amdgcn_sched_barrier(0)
#define PG8_OFFS(dst, u) do { const int _t = wid * 64 + lane_id(); _Pragma("unroll") for (int _i = 0; _i < 2; ++_i) { int _R, _C; stage_rc(_t * 16 + _i * 8192, _R, _C); \
        _Pragma("unroll") for (int _h = 0; _h < 2; ++_h) dst[_h][_i] = GATHER ? (S.a_off(u, _h * HALF + _R) + (unsigned)_C * 2u) : (unsigned)((_h * HALF + _R) * K * EB + _C * 2); } } while (0)
    Unit cur, nxt; int ui = 0;
    if (!S.next(0, cur)) return;
    f32x4 acc[2][2][4][2];
    const int sc_w = 0x7F7F7F7F, sc_a = sc_w;
    bf16x8 At[4][2], B0[2][2], B1[2][2]; v8i_t At8[4], B08[2], B18[2];
    unsigned offA[2][2];
    PG8_OFFS(offA, cur);
    const char* cA = S.a_ptr(cur); const char* cB = S.b_ptr(cur);
    S.a_ready(cur);
    constexpr bool DEFER = Epi::NST > 0;
    PG8_STAGE(PG8_SB(0, 0), cB, voffB); PG8_STAGE(PG8_SB(0, 1), cB + hstep, voffB); PG8_STAGE(PG8_SA(0, 0), cA, offA[0]); PG8_STAGE(PG8_SA(0, 1), cA, offA[1]);
    if constexpr (DEFER) {
        PG8_STAGE(PG8_SB(1, 0), cB + kstep, voffB); PG8_STAGE(PG8_SA(1, 0), cA + kstep, offA[0]); PG8_STAGE(PG8_SB(1, 1), cB + hstep + kstep, voffB); PG8_STAGE(PG8_SA(1, 1), cA + kstep, offA[1]);
        PG8_WAIT_V(0);
        if (wr == 1) PG8_BAR;
        PG8_BAR;
    } else {
        if (wr == 1) PG8_BAR;
        PG8_WAIT_V(2); PG8_BAR;
        PG8_STAGE(PG8_SB(1, 0), cB + kstep, voffB); PG8_STAGE(PG8_SA(1, 0), cA + kstep, offA[0]); PG8_STAGE(PG8_SB(1, 1), cB + hstep + kstep, voffB);
        PG8_WAIT_V(6); PG8_BAR; }
    constexpr int WF = 8 + Epi::NST;
#define PG8_WAIT_F() do { if (DEFER && t == 0) asm volatile("s_waitcnt vmcnt(%0)" :: "n"(WF) : "memory"); else PG8_WAIT_V(8); } while (0)
    for (;;) {
        const bool has_next = S.next(ui + 1, nxt);
        const char* nA = has_next ? S.a_ptr(nxt) : cA; const char* nB = has_next ? S.b_ptr(nxt) : cB;
        unsigned o2[2][2];
        for (int t = 0; t < nt; t += 2) {
            const bool last = (t == nt - 2);
            const char* a1 = cA + (size_t)(t + 1) * kstep;
            const char* a2 = last ? nA : cA + (size_t)(t + 2) * kstep; const char* b2 = last ? nB : cB + (size_t)(t + 2) * kstep;
            const char* a3 = a2 + kstep; const char* b3 = b2 + kstep;
            if (GATHER && last && has_next) { PG8_OFFS(o2, nxt); }
            else {
#pragma unroll
                for (int h = 0; h < 2; ++h)
#pragma unroll
                    for (int i = 0; i < 2; ++i) o2[h][i] = offA[h][i]; }
            if (last && has_next) S.a_ready(nxt);
            PG8_LDB(B0, 0, 0); PG8_LDB(B1, 0, 1); PG8_SCHED; PG8_LDA(At, 0, 0); if (!DEFER || t != 0) PG8_STAGE(PG8_SA(1, 1), a1, offA[1]);
            PG8_WAIT_F(); PG8_WAIT_L(0); PG8_BAR; if (t == 0) { PG8_MMA_Z(0, 0, At, B0); PG8_MMA_Z(0, 1, At, B1); } else { PG8_MMA(0, 0, At, B0); PG8_MMA(0, 1, At, B1); } PG8_BAR; PG8_SCHED;
            PG8_LDA(At, 0, 1); PG8_STAGE(PG8_SB(0, 0), b2, voffB); PG8_STAGE(PG8_SB(0, 1), b2 + hstep, voffB); PG8_STAGE(PG8_SA(0, 0), a2, o2[0]);
            PG8_WAIT_F(); PG8_WAIT_L(0); PG8_BAR; if (t == 0) { PG8_MMA_Z(1, 0, At, B0); PG8_MMA_Z(1, 1, At, B1); } else { PG8_MMA(1, 0, At, B0); PG8_MMA(1, 1, At, B1); } PG8_BAR; PG8_SCHED;
            PG8_LDB(B0, 1, 0); PG8_LDB(B1, 1, 1); PG8_SCHED; PG8_LDA(At, 1, 0); PG8_STAGE(PG8_SA(0, 1), a2, o2[1]);
            PG8_WAIT_F(); PG8_WAIT_L(0); PG8_BAR; PG8_MMA(0, 0, At, B0); PG8_MMA(0, 1, At, B1); PG8_BAR; PG8_SCHED;
            PG8_LDA(At, 1, 1); PG8_STAGE(PG8_SB(1, 0), b3, voffB); PG8_STAGE(PG8_SB(1, 1), b3 + hstep, voffB); PG8_STAGE(PG8_SA(1, 0), a3, o2[0]);
            PG8_WAIT_V(8); PG8_WAIT_L(0); PG8_BAR; PG8_MMA(1, 0, At, B0); PG8_MMA(1, 1, At, B1); PG8_BAR; PG8_SCHED;
        }
        if constexpr (DEFER) { if constexpr (GATHER) { PG8_STAGE(PG8_SA(1, 1), nA + kstep, o2[1]); } else { PG8_STAGE(PG8_SA(1, 1), nA + kstep, offA[1]); }
            asm volatile("" ::: "memory"); PG8_SCHED; }
        if constexpr (ALIGN_EPI) { if (wr == 0) PG8_BAR; }
        if constexpr (FP8) asm volatile("s_nop 15\n\ts_nop 15" ::: "memory");
        { const int l2 = lane_id();
          E(acc, cur, wr, wc, l2 & 15, l2 >> 4); } S.done(cur);
        if (!has_next) break;
        cur = nxt; cA = nA; cB = nB; ++ui;
        if (GATHER) { PG8_OFFS(offA, cur); }
        if constexpr (ALIGN_EPI) { if (wr == 1) PG8_BAR; }
    }
    PG8_WAIT_V(0);
    if constexpr (!ALIGN_EPI) { if (wr == 0) PG8_BAR; }
    PG8_BAR;
#undef PG8_SA
#undef PG8_SB
#undef PG8_STAGE
#undef PG8_LDA
#undef PG8_LD8
#undef PG8_LDB
#undef PG8_MMA
#undef PG8_MMA_Z
#undef PG8_WAIT_V
#undef PG8_WAIT_L
#undef PG8_WAIT_F
#undef PG8_BAR
#undef PG8_SCHED
#undef PG8_OFFS
}
}

namespace pg8 {
#ifndef EPI_NT
#define EPI_NT 1
#endif
__device__ __forceinline__ void st16(const void* p_, const u32x4 v) {
#if EPI_NT
    __builtin_nontemporal_store(v, (u32x4*)p_);
#else
    *(u32x4*)p_ = v;
#endif
}
}
namespace pg8 {
__device__ __forceinline__ float fsigmoid(float x) { return __builtin_amdgcn_rcpf(1.0f + __builtin_amdgcn_exp2f(-LOG2E * x)); }
__device__ __forceinline__ u32x4 pack8(const f32x4 a, const f32x4 b) { u32x4 w; w.x = cvt_pk_bf16(a[0], a[1]); w.y = cvt_pk_bf16(a[2], a[3]); w.z = cvt_pk_bf16(b[0], b[1]); w.w = cvt_pk_bf16(b[2], b[3]); return w; }
__device__ __forceinline__ void unpack8(const u32x4 w, f32x4& a, f32x4& b) {
    a[0] = __uint_as_float(w.x << 16); a[1] = __uint_as_float(w.x & 0xffff0000u); a[2] = __uint_as_float(w.y << 16); a[3] = __uint_as_float(w.y & 0xffff0000u);
    b[0] = __uint_as_float(w.z << 16); b[1] = __uint_as_float(w.z & 0xffff0000u); b[2] = __uint_as_float(w.w << 16); b[3] = __uint_as_float(w.w & 0xffff0000u); }

struct EpiQK {
    static constexpr bool PERM = true; static constexpr int NST = 16;
    bf16 *qsb, *ksb;
    __device__ __forceinline__ void operator()(const f32x4 (&acc)[2][2][4][2], const Unit& u, int wr, int wc, int fr, int fq) const {
        const int pn = u.pn;
        if (pn < 4) {
            const bf16* ub = qsb + ((size_t)(u.pm * BM + wr * 64)) * 1024 + pn * 256 + wc * 32; const int lo = fr * 1024 + 8 * fq;
#pragma unroll
            for (int ai = 0; ai < 2; ++ai)
#pragma unroll
                for (int m = 0; m < 4; ++m)
#pragma unroll
                    for (int bj = 0; bj < 2; ++bj) st16(ub + (ai * HALF + m * 16) * 1024 + bj * HALF + lo, pack8(acc[ai][bj][m][0] * (SB_C2 * IN_DS), acc[ai][bj][m][1] * (SB_C2 * IN_DS)));
        } else {
            const int t0 = (u.pm * BM) & (SEQ - 1), b = (u.pm * BM) >> 13;
            const bf16* ub = ksb + ((((size_t)(b * 16 + 4 * (pn & 3) + (wc >> 1)) * 256 + (t0 >> 5) + 2 * wr) * 4 + 2 * (wc & 1)) * 512);
            const int lo = (fq >> 1) * 512 + fr * 16 + 8 * (fq & 1);
#pragma unroll
            for (int ai = 0; ai < 2; ++ai)
#pragma unroll
                for (int m = 0; m < 4; ++m)
#pragma unroll
                    for (int bj = 0; bj < 2; ++bj) st16(ub + (size_t)(2 * bj) * 256 * 2048 + (4 * ai + (m >> 1)) * 2048 + (m & 1) * 256 + lo, pack8(acc[ai][bj][m][0] * IN_DS, acc[ai][bj][m][1] * IN_DS));
        }
    }
};
struct EpiRot {
    static constexpr bool PERM = true; static constexpr int NST = 16;
    bf16 *qr, *kr, *krt, *qrs; const float *cosT, *sinT; float ds_;
    __device__ __forceinline__ void operator()(const f32x4 (&acc)[2][2][4][2], const Unit& u, int wr, int wc, int fr, int fq) const {
        const int pn = u.pn; const bool isK = pn >= 4; const int head = pn & 3; const float sc = (isK ? 1.0f : 0.0625f) * ds_;
        const int R0 = u.pm * BM, P0 = R0 & (SEQ - 1), bh = (R0 >> 13) * 4 + head;
        f32x4 c[2], sn[2], dc[2], ds[2], ec[2], es[2];
        { const int tlo = fr * 128 + 8 * fq; const float* cb = cosT + (size_t)(P0 + 64 * wr) * 128 + 32 * wc; const float* sb = sinT + (size_t)(P0 + 64 * wr) * 128 + 32 * wc;
          const float* c16 = cosT + 16 * 128 + 32 * wc; const float* s16 = sinT + 16 * 128 + 32 * wc; const float* c80 = cosT + 80 * 128 + 32 * wc; const float* s80 = sinT + 80 * 128 + 32 * wc;
#pragma unroll
          for (int n = 0; n < 2; ++n) { c[n] = *(const f32x4*)(cb + tlo + 4 * n); sn[n] = *(const f32x4*)(sb + tlo + 4 * n);
              dc[n] = *(const f32x4*)(c16 + 8 * fq + 4 * n); ds[n] = *(const f32x4*)(s16 + 8 * fq + 4 * n); ec[n] = *(const f32x4*)(c80 + 8 * fq + 4 * n); es[n] = *(const f32x4*)(s80 + 8 * fq + 4 * n); } }
        bf16* on = (isK ? kr : qr) + (size_t)(R0 + 64 * wr) * 1024 + head * 256 + 32 * wc; const int lo_n = fr * 1024 + 8 * fq;
        bf16* oq = qrs + (((size_t)bh * 128 + (P0 >> 6) + wr) * 16 + 2 * wc) * 1024; const int lo_q = (fq >> 1) * 1024 + fr * 16 + 8 * (fq & 1);
        bf16* ok = krt + (((size_t)bh * 128 + (P0 >> 6) + wr) * 4) * 4096 + 32 * wc * 16; const int lo_k = 8 * fq * 16 + fr;
#pragma unroll
        for (int ai = 0; ai < 2; ++ai)
#pragma unroll
            for (int m = 0; m < 4; ++m) {
                f32x4 o1[2], o2[2];
#pragma unroll
                for (int n = 0; n < 2; ++n) { const f32x4 x1 = acc[ai][0][m][n], x2 = acc[ai][1][m][n]; o1[n] = (x1 * c[n] - x2 * sn[n]) * sc; o2[n] = (x1 * sn[n] + x2 * c[n]) * sc; }
                if (m < 3) {
#pragma unroll
                    for (int n = 0; n < 2; ++n) { const f32x4 cc = c[n] * dc[n] - sn[n] * ds[n]; sn[n] = sn[n] * dc[n] + c[n] * ds[n]; c[n] = cc; } }
                else if (ai == 0) {
#pragma unroll
                    for (int n = 0; n < 2; ++n) { const f32x4 cc = c[n] * ec[n] - sn[n] * es[n]; sn[n] = sn[n] * ec[n] + c[n] * es[n]; c[n] = cc; } }
                const u32x4 w1 = pack8(o1[0], o1[1]), w2 = pack8(o2[0], o2[1]);
                if (isK) { st16(on + (ai * HALF + m * 16) * 1024 + lo_n, w1); st16(on + (ai * HALF + m * 16) * 1024 + HALF + lo_n, w2); }
                if (isK) {
                    bf16* tp = ok + (2 * ai * 4 + m) * 4096 + lo_k;
#pragma unroll
                    for (int q = 0; q < 4; ++q) { tp[(2 * q) * 16] = (bf16)(w1[q] & 0xffffu); tp[(2 * q + 1) * 16] = (bf16)(w1[q] >> 16);
                        tp[(HALF + 2 * q) * 16] = (bf16)(w2[q] & 0xffffu); tp[(HALF + 2 * q + 1) * 16] = (bf16)(w2[q] >> 16); }
                } else {
                    st16(oq + (2 * ai * 16) * 1024 + m * 256 + lo_q, w1); st16(oq + (2 * ai * 16 + 8) * 1024 + m * 256 + lo_q, w2); }
                asm volatile("" ::: "memory"); }
    }
};
struct EpiGate {
    static constexpr bool PERM = true; static constexpr int NST = 16;
    unsigned char* ws;
    __device__ __forceinline__ void operator()(const f32x4 (&acc)[2][2][4][2], const Unit& u, int wr, int wc, int fr, int fq) const {
        const int pn = u.pn; const int R0 = u.pm * BM, P0 = R0 & (SEQ - 1); const bool silu = pn < 8;
        const size_t ub_s = WS_SG + 2 * ((((size_t)((R0 >> 13) * 4 + (pn >> 1)) * 128 + (P0 >> 6) + wr) * 64 + 32 * (pn & 1) + 4 * wc) * 512);
        const size_t ub_g = WS_GSB + (size_t)(pn >= 12 ? 1 : 0) * (WS_GRET - WS_GSB) + 2 * ((size_t)(R0 + 64 * wr) * 1024 + (pn & 3) * 256 + 32 * wc);
        bf16* ub = (bf16*)(ws + (silu ? ub_s : ub_g));
        const int lo = silu ? fq * 512 + fr * 8 : fr * 1024 + 8 * fq;
        const int SA = silu ? 128 * 512 : HALF * 1024, SM = silu ? 128 : 16 * 1024, SB = silu ? 16 * 512 : HALF;
#pragma unroll
        for (int ai = 0; ai < 2; ++ai)
#pragma unroll
            for (int m = 0; m < 4; ++m) {
#pragma unroll
                for (int bj = 0; bj < 2; ++bj) { f32x4 a = acc[ai][bj][m][0] * IN_DS, b = acc[ai][bj][m][1] * IN_DS;
#pragma unroll
                    for (int e = 0; e < 4; ++e) { const float sa = fsigmoid(a[e]), sb = fsigmoid(b[e]); a[e] = silu ? a[e] * sa : sa; b[e] = silu ? b[e] * sb : sb; }
                    st16(ub + ai * SA + m * SM + bj * SB + lo, pack8(a, b));
                    asm volatile("" ::: "memory"); } }
    }
};
struct EpiVT {
    static constexpr bool PERM = true; static constexpr int NST = 16;
    bf16 *vsbt, *vrt;
    __device__ __forceinline__ void operator()(const f32x4 (&acc)[2][2][4][2], const Unit& u, int wr, int wc, int fr, int fq) const {
        const int pm = u.pm; const int C0 = u.pn * BM, T0 = C0 & (SEQ - 1), b = C0 >> 13;
        if (pm < 4) {
            bf16* ub = vsbt + ((((size_t)(b * 16 + 4 * pm + wr) * 512 + (T0 >> 4) + 2 * wc) * 64) * 16); const int lo = ((fq >> 1) * 64 + fr) * 16 + 8 * (fq & 1);
#pragma unroll
            for (int ai = 0; ai < 2; ++ai)
#pragma unroll
                for (int m = 0; m < 4; ++m)
#pragma unroll
                    for (int bj = 0; bj < 2; ++bj) st16(ub + ((size_t)(2 * ai) * 512 * 64 + 8 * bj * 64 + 16 * m) * 16 + lo, pack8(acc[ai][bj][m][0] * IN_DS, acc[ai][bj][m][1] * IN_DS));
        } else {
            const int h = (pm - 4) >> 1; const float l2g = __builtin_amdgcn_logf(1.0f - __builtin_amdgcn_exp2f(-5.0f - (float)h));
            float dec[8];
#pragma unroll
            for (int q = 0; q < 8; ++q) dec[q] = __builtin_amdgcn_exp2f((float)(63 - (((wc & 1) * 32 + 8 * fq + q) & 63)) * l2g) * IN_DS;
            bf16* ub = vrt + (((((size_t)(b * 4 + h) * 128 + (T0 >> 6) + (wc >> 1)) * 4 + 2 * (wc & 1)) * 512 + 256 * ((pm - 4) & 1) + 64 * wr) * 16); const int lo = ((fq >> 1) * 512 + fr) * 16 + 8 * (fq & 1);
#pragma unroll
            for (int ai = 0; ai < 2; ++ai)
#pragma unroll
                for (int m = 0; m < 4; ++m)
#pragma unroll
                    for (int bj = 0; bj < 2; ++bj) { f32x4 a = acc[ai][bj][m][0], bb = acc[ai][bj][m][1];
#pragma unroll
                        for (int e = 0; e < 4; ++e) { a[e] *= dec[e]; bb[e] *= dec[4 + e]; }
                        st16(ub + ((size_t)(2 * bj) * 4 * 512 + 128 * ai + 16 * m) * 16 + lo, pack8(a, bb)); }
        }
    }
};
template <int MODE> struct EpiBranch {
    static constexpr bool PERM = true; static constexpr int NST = 16;
    const bf16* gate; const bf16* m1in; bf16* out;
    __device__ __forceinline__ void operator()(const f32x4 (&acc)[2][2][4][2], const Unit& u, int wr, int wc, int fr, int fq) const {
        const size_t uo = (size_t)(u.pm * BM + 64 * wr) * 1024 + u.pn * BM + 32 * wc; const int lo = fr * 1024 + 8 * fq;
        const bf16* gp = gate + uo; const bf16* mp = m1in + uo; bf16* op = out + uo;
#pragma unroll
        for (int ai = 0; ai < 2; ++ai) {
            u32x4 gv[4][2], mv[4][2];
#pragma unroll
            for (int m = 0; m < 4; ++m)
#pragma unroll
                for (int bj = 0; bj < 2; ++bj) { const int co = (ai * HALF + m * 16) * 1024 + bj * HALF + lo; gv[m][bj] = *(const u32x4*)(gp + co); if (MODE == 1) mv[m][bj] = *(const u32x4*)(mp + co); }
#pragma unroll
            for (int m = 0; m < 4; ++m)
#pragma unroll
                for (int bj = 0; bj < 2; ++bj) { const int co = (ai * HALF + m * 16) * 1024 + bj * HALF + lo; f32x4 ga, gb; unpack8(gv[m][bj], ga, gb);
                    f32x4 a = acc[ai][bj][m][0] * ga, b = acc[ai][bj][m][1] * gb;
                    if (MODE == 1) { f32x4 pa, pb; unpack8(mv[m][bj], pa, pb); a += pa; b += pb; }
                    st16(op + co, pack8(a, b)); }
            asm volatile("" ::: "memory"); }
    }
};
struct EpiPre {
    static constexpr bool PERM = true; static constexpr int NST = 16;
    const float* x; bf16* pre;
    __device__ __forceinline__ void operator()(const f32x4 (&acc)[2][2][4][2], const Unit& u, int wr, int wc, int fr, int fq) const {
        const size_t uo = (size_t)(u.pm * BM + 64 * wr) * 1024 + u.pn * BM + 32 * wc; const int lo = fr * 1024 + 8 * fq;
        const float* xp = x + uo; bf16* pp = pre + uo;
#pragma unroll
        for (int ai = 0; ai < 2; ++ai) {
            f32x4 xv[4][2][2];
#pragma unroll
            for (int m = 0; m < 4; ++m)
#pragma unroll
                for (int bj = 0; bj < 2; ++bj)
#pragma unroll
                    for (int n = 0; n < 2; ++n) xv[m][bj][n] = *(const f32x4*)(xp + (ai * HALF + m * 16) * 1024 + bj * HALF + 4 * n + lo);
#pragma unroll
            for (int m = 0; m < 4; ++m)
#pragma unroll
                for (int bj = 0; bj < 2; ++bj) st16(pp + (ai * HALF + m * 16) * 1024 + bj * HALF + lo, pack8(xv[m][bj][0] * DN_ALPHA + acc[ai][bj][m][0], xv[m][bj][1] * DN_ALPHA + acc[ai][bj][m][1]));
            asm volatile("" ::: "memory"); }
    }
};
struct EpiGateUp {
    static constexpr bool PERM = true; static constexpr int NST = 8;
    int dummy_;
    __device__ __forceinline__ void operator()(const f32x4 (&acc)[2][2][4][2], const Unit& u, int wr, int wc, int fr, int fq) const {
        const float* bgu = KARG()->B.b_gu; bf16* act = (bf16*)(KARG()->B.ws + WS_ACT);
        const float* bp = bgu + (size_t)u.e * 2048 + u.pn * 128 + wc * 32 + 8 * fq;
        f32x4 bg[2], bu[2];
#pragma unroll
        for (int n = 0; n < 2; ++n) { bg[n] = *(const f32x4*)(bp + 4 * n); bu[n] = *(const f32x4*)(bp + 1024 + 4 * n); }
        const int lo = fr * 1024 + 8 * fq;
#pragma unroll
        for (int ai = 0; ai < 2; ++ai)
#pragma unroll
            for (int m = 0; m < 4; ++m) { const int rr = ai * HALF + wr * 64 + m * 16 + fr;
                f32x4 o[2];
#pragma unroll
                for (int n = 0; n < 2; ++n) { const f32x4 g = acc[ai][0][m][n] * MOE_DESCALE + bg[n], up = acc[ai][1][m][n] * MOE_DESCALE + bu[n];
#pragma unroll
                    for (int e = 0; e < 4; ++e) { const float gg = fminf(g[e], 7.0f), uu = __builtin_amdgcn_fmed3f(up[e], -7.0f, 7.0f);
                        o[n][e] = (uu + 1.0f) * gg * __builtin_amdgcn_rcpf(1.0f + __builtin_amdgcn_exp2f((-1.702f * LOG2E) * gg)); } }
                {
#if MOE_FP8
                    u32x2 w8; w8.x = pk4_fp8(o[0][0], o[0][1], o[0][2], o[0][3]); w8.y = pk4_fp8(o[1][0], o[1][1], o[1][2], o[1][3]);
                    *(u32x2*)((unsigned char*)act + (size_t)(u.rbase + 64 * wr) * 1024 + u.pn * 128 + wc * 32 + (ai * HALF + m * 16) * 1024 + lo) = w8;
#else
                    st16(act + (size_t)(u.rbase + 64 * wr) * 1024 + u.pn * 128 + wc * 32 + (ai * HALF + m * 16) * 1024 + lo, pack8(o[0], o[1]));
#endif
                } }
    }
};
struct EpiDown {
    static constexpr bool PERM = true; static constexpr int NST = 16;
    int dummy_;
    __device__ __forceinline__ void operator()(const f32x4 (&acc)[2][2][4][2], const Unit& u, int wr, int wc, int fr, int fq) const {
        unsigned char* ws_ = KARG()->B.ws; const float* bdn = KARG()->B.b_dn;
        const unsigned colb = (unsigned)(u.pn * BM + wc * 32 + 8 * fq) * 2u;
        const unsigned char* bp = (const unsigned char*)(bdn + (size_t)u.e * 1024);
        const unsigned lb = (unsigned)(u.e * CAP + u.pm + wr * 64 + fr) * 4u;
        const unsigned char* rowtk = ws_ + WS_ROWTK; const unsigned char* roww = ws_ + WS_ROWW; unsigned char* outr = ws_ + WS_OUTR;
        constexpr unsigned TRASH = (unsigned)(WS_RINFO - WS_OUTR);
        unsigned ro[2][4]; float w[2][4]; f32x4 bv[2][2];
#pragma unroll
        for (int ai = 0; ai < 2; ++ai)
#pragma unroll
            for (int m = 0; m < 4; ++m) { const int rr = ai * HALF + wr * 64 + m * 16 + fr; const bool v = rr < u.nrows;
                const unsigned lo_ = lb + (unsigned)(ai * HALF + m * 16) * 4u;
                const int tkv = *(const int*)(rowtk + lo_); w[ai][m] = *(const float*)(roww + lo_);
                ro[ai][m] = (v ? (unsigned)tkv * 2048u : TRASH) + colb; }
#pragma unroll
        for (int bj = 0; bj < 2; ++bj)
#pragma unroll
            for (int n = 0; n < 2; ++n) bv[bj][n] = *(const f32x4*)(bp + colb * 2u + (unsigned)(bj * HALF + 4 * n) * 4u);
#pragma unroll
        for (int ai = 0; ai < 2; ++ai)
#pragma unroll
            for (int m = 0; m < 4; ++m) { const float ww = w[ai][m];
#pragma unroll
                for (int bj = 0; bj < 2; ++bj) st16(outr + ro[ai][m] + (unsigned)(bj * HALF * 2), pack8((acc[ai][bj][m][0] * MOE_DESCALE + bv[bj][0]) * ww, (acc[ai][bj][m][1] * MOE_DESCALE + bv[bj][1]) * ww)); }
    }
};
}
#define GAS __attribute__((address_space(1)))
#define LAS __attribute__((address_space(3)))
typedef GAS unsigned gu32;
#define RLX_AGENT __ATOMIC_RELAXED, __HIP_MEMORY_SCOPE_AGENT
constexpr int NWAVES = 8;
constexpr int RING_OFF = 0, RING_BYTES = 131072;
constexpr int LDSCTL_OFF = RING_BYTES;
constexpr int LDS_TAB_OFF = RING_BYTES + 1024;
constexpr int LDS_BYTES = LDS_TAB_OFF + 24 * 256 * 4;
static_assert(LDS_BYTES <= 163840, "LDS");

#define XB_TMO      128
#define XB_XCNT(j)  (256  + 64 * (j))
#define XB_XSUB(j)  (1280 + 64 * (j))
#define XB_XGEN(j)  (2304 + 64 * (j))
#define XB_TOP      3328
#define XB_TOPGEN   3392
#define XCD_BAR_WORDS 3456
#define XB_SPIN_CAP (1u << 18)
__device__ __forceinline__ unsigned xb_ld(unsigned* p)              { return __hip_atomic_load(p, __ATOMIC_RELAXED, __HIP_MEMORY_SCOPE_AGENT); }
__device__ __forceinline__ unsigned xb_add(unsigned* p, unsigned v) { return __hip_atomic_fetch_add(p, v, __ATOMIC_RELAXED, __HIP_MEMORY_SCOPE_AGENT); }
__device__ __forceinline__ unsigned xb_xcc_id() { return (unsigned)__builtin_amdgcn_s_getreg((3 << 11) | 20) & 0xFu; }
#define XB_SPIN(cond, bar) do { unsigned _sp = 0; while (cond) { __builtin_amdgcn_s_sleep(1); \
    if ((++_sp & 255u) == 0u) { if (xb_ld(&(bar)[XB_TMO])) break; if (_sp > XB_SPIN_CAP) { atomicAdd(&(bar)[XB_TMO], 1u); break; } } } } while (0)
struct XcdBarrier { unsigned* bar; unsigned x; volatile LAS unsigned* st; };
__device__ __forceinline__ XcdBarrier xcd_barrier_post(unsigned* bar, volatile LAS unsigned* st) {
    XcdBarrier b; b.bar = bar; b.x = xb_xcc_id(); b.st = st;
    if (threadIdx.x == 0) (void)xb_add(&bar[XB_XCNT(b.x)], 1u);
    return b;
}
__device__ __forceinline__ void xcd_barrier_complete(unsigned* bar, unsigned x, unsigned& nloc, unsigned& nx) {
    const unsigned G = gridDim.x * gridDim.y * gridDim.z;
    unsigned sum, cnt, mine, sp = 0u;
    for (;;) {
        sum = 0u; cnt = 0u; mine = 0u;
#pragma unroll
        for (unsigned j = 0; j < 16; ++j) { const unsigned c = xb_ld(&bar[XB_XCNT(j)]); sum += c; cnt += (c > 0u) ? 1u : 0u; mine = (j == x) ? c : mine; }
        if (sum == G) break;
        __builtin_amdgcn_s_sleep(1);
        if ((++sp & 255u) == 0u) { if (xb_ld(&bar[XB_TMO])) break; if (sp > XB_SPIN_CAP) { atomicAdd(&bar[XB_TMO], 1u); break; } }
    }
    nloc = mine > 0u ? mine : 1u; nx = cnt > 0u ? cnt : 1u;
}
__device__ __forceinline__ void xcd_barrier(const XcdBarrier& b) {
    asm volatile("s_waitcnt vmcnt(0)" ::: "memory");
    __syncthreads();
    if (threadIdx.x == 0) {
        unsigned* bar = b.bar;
        __builtin_amdgcn_s_waitcnt(0);
        unsigned nloc = b.st[0], nx = b.st[1];
        if (nloc == 0u) { xcd_barrier_complete(bar, b.x, nloc, nx); b.st[0] = nloc; b.st[1] = nx; }
        const unsigned old = xb_add(&bar[XB_XSUB(b.x)], 1u);
        const unsigned gen = old / nloc;
        if (old + 1u == (gen + 1u) * nloc) {
            __builtin_amdgcn_fence(__ATOMIC_RELEASE, "agent");
            asm volatile("s_waitcnt vmcnt(0)" ::: "memory");
            const unsigned og = xb_add(&bar[XB_TOP], 1u);
            const unsigned tg = og / nx;
            if (og + 1u == (tg + 1u) * nx) xb_add(&bar[XB_TOPGEN], 1u);
            else XB_SPIN(xb_ld(&bar[XB_TOPGEN]) == tg, bar);
            __builtin_amdgcn_fence(__ATOMIC_ACQUIRE, "agent");
            xb_add(&bar[XB_XGEN(b.x)], 1u);
            asm volatile("s_waitcnt vmcnt(0)" ::: "memory");
        } else {
            XB_SPIN(xb_ld(&bar[XB_XGEN(b.x)]) == gen, bar);
            __builtin_amdgcn_fence(__ATOMIC_ACQUIRE, "agent");
            asm volatile("s_waitcnt vmcnt(0)" ::: "memory");
        }
    }
    __syncthreads();
}

struct Frame {
    LAS unsigned char* lds; volatile LAS unsigned* LC;
    unsigned* ctl;
    int wave, vcu, G;
    Bufs B;
};
#define FWS(T, off) ((T*)(F.B.ws + (off)))
#define FDO(T, off) ((T*)((unsigned char*)F.B.out + (off)))
#define LDS_WAIT() asm volatile("s_waitcnt lgkmcnt(0)" ::: "memory")
#define VM_WAIT() asm volatile("s_waitcnt vmcnt(0)" ::: "memory")

__device__ __forceinline__ f32x16 mfma32(bf16x8 a, bf16x8 b, f32x16 c) { return __builtin_amdgcn_mfma_f32_32x32x16_bf16(a, b, c, 0, 0, 0); }
__device__ __forceinline__ int crow(int r, int hi) { return (r & 3) + 8 * (r >> 2) + 4 * hi; }
__device__ __forceinline__ float swap_lo(float x, float& hi_out) { auto rr = __builtin_amdgcn_permlane32_swap(__float_as_uint(x), __float_as_uint(x), false, false); hi_out = __uint_as_float(rr[1]); return __uint_as_float(rr[0]); }
__device__ __forceinline__ bf16x8 pack_frag(const f32x16& v, int base) {
    u32x4 w; w.x = pg8::cvt_pk_bf16(v[base + 0], v[base + 1]); w.y = pg8::cvt_pk_bf16(v[base + 2], v[base + 3]); w.z = pg8::cvt_pk_bf16(v[base + 4], v[base + 5]); w.w = pg8::cvt_pk_bf16(v[base + 6], v[base + 7]);
    return __builtin_bit_cast(bf16x8, w); }
__device__ __forceinline__ bf16x8 join8(u32x2 a, u32x2 b) { u32x4 w; w.x = a.x; w.y = a.y; w.z = b.x; w.w = b.y; return __builtin_bit_cast(bf16x8, w); }
__device__ __forceinline__ float ret_l2g(int h) { return __builtin_amdgcn_logf(1.0f - __builtin_amdgcn_exp2f(-5.0f - (float)h)); }

__device__ __forceinline__ void tr_item(const float* src, int lds_, int k0, int c0, bf16* dst, int K, int r0, LAS unsigned char* scr, int lane) {
    const int kr = lane >> 4, nq = lane & 15;
    f32x4 v[4][4];
#pragma unroll
    for (int gI = 0; gI < 4; ++gI)
#pragma unroll
        for (int i = 0; i < 4; ++i) v[gI][i] = *(const f32x4*)(src + (size_t)(k0 + 16 * gI + 4 * kr + i) * lds_ + c0 + 4 * nq);
#pragma unroll
    for (int gI = 0; gI < 4; ++gI)
#pragma unroll
        for (int e = 0; e < 4; ++e) { u32x2 w; w.x = pk2(v[gI][0][e], v[gI][1][e]); w.y = pk2(v[gI][2][e], v[gI][3][e]);
            *(LAS u32x2*)(scr + (4 * nq + e) * 144 + 32 * gI + 8 * kr) = w; }
    LDS_WAIT(); asm volatile("" ::: "memory");
#pragma unroll
    for (int it = 0; it < 8; ++it) { const int n = it * 8 + (lane >> 3), ch = lane & 7;
        const u32x4 w = *(const LAS u32x4*)(scr + n * 144 + ch * 16);
        *(u32x4*)(dst + (size_t)(r0 + n) * K + k0 + 8 * ch) = w; }
    LDS_WAIT(); asm volatile("" ::: "memory");
}
__device__ __forceinline__ void tr_item_fp8(const float* src, int lds_, int k0, int c0, unsigned char* dst, int K, int r0, LAS unsigned char* scr, int lane, const float wscale) {
    const int kr = lane >> 4, nq = lane & 15;
    f32x4 v[4][4];
#pragma unroll
    for (int gI = 0; gI < 4; ++gI)
#pragma unroll
        for (int i = 0; i < 4; ++i) v[gI][i] = *(const f32x4*)(src + (size_t)(k0 + 16 * gI + 4 * kr + i) * lds_ + c0 + 4 * nq) * wscale;
#pragma unroll
    for (int gI = 0; gI < 4; ++gI)
#pragma unroll
        for (int e = 0; e < 4; ++e) *(LAS unsigned*)(scr + (4 * nq + e) * 80 + 16 * gI + 4 * kr) = pk4_fp8(v[gI][0][e], v[gI][1][e], v[gI][2][e], v[gI][3][e]);
    LDS_WAIT(); asm volatile("" ::: "memory");
#pragma unroll
    for (int it = 0; it < 4; ++it) { const int n = it * 16 + (lane >> 2), ch = lane & 3;
        const u32x4 w = *(const LAS u32x4*)(scr + n * 80 + ch * 16);
        *(u32x4*)(dst + (size_t)(r0 + n) * K + k0 + 16 * ch) = w; }
    LDS_WAIT(); asm volatile("" ::: "memory");
}
__device__ __forceinline__ void p0_prologue(Frame& F) {
    const Bufs& B = F.B; const int lane_ = lane_id(), tid_ = F.wave * 64 + lane_;
    const int gw = F.vcu * NWAVES + F.wave, NGW = F.G * NWAVES;
    { const f32x4* xs = (const f32x4*)B.x; const size_t n8 = (size_t)NTOK * DM / 8;
#if INPROJ_FP8
      u32x2* xd = (u32x2*)(F.B.ws + WS_XB8);
#if ROT_BF16
      u32x4* xd16 = FDO(u32x4, DO_XB);
#endif
      for (size_t i = (size_t)blockIdx.x * 512 + tid_; i < n8; i += (size_t)F.G * 512) { const f32x4 a = xs[2 * i], b = xs[2 * i + 1];
          u32x2 w; w.x = pk4_fp8(a[0], a[1], a[2], a[3]); w.y = pk4_fp8(b[0], b[1], b[2], b[3]); xd[i] = w;
#if ROT_BF16
          u32x4 w16; w16.x = pk2(a[0], a[1]); w16.y = pk2(a[2], a[3]); w16.z = pk2(b[0], b[1]); w16.w = pk2(b[2], b[3]); xd16[i] = w16;
#endif
      }
#else
      u32x4* xd = FDO(u32x4, DO_XB);
      for (size_t i = (size_t)blockIdx.x * 512 + tid_; i < n8; i += (size_t)F.G * 512) { const f32x4 a = xs[2 * i], b = xs[2 * i + 1];
          u32x4 w; w.x = pk2(a[0], a[1]); w.y = pk2(a[2], a[3]); w.z = pk2(b[0], b[1]); w.w = pk2(b[2], b[3]); xd[i] = w; }
#endif
    }
    LAS unsigned char* scr = F.lds + RING_OFF + F.wave * 9216;
    constexpr int I_IN = 16 * (INW / 64)  , I_BSB = 256, I_BRET = 32 * 16, I_OUT = 256;
    constexpr int NITEMS = I_IN + I_BSB + I_BRET + I_OUT;
    for (int it = gw; it < NITEMS; it += NGW) {
        int r = it;
        if (r < I_IN) { const int kb = r / (INW / 64), nb = r % (INW / 64); const int c0 = nb * 64; bf16* dst; int r0;
            if (c0 < 2048) { dst = FWS(bf16, WS_WINT); r0 = c0; } else if (c0 < 3072) { dst = FWS(bf16, WS_WVT); r0 = c0 - 2048; }
            else if (c0 < 5120) { dst = FWS(bf16, WS_WINT); r0 = 2048 + c0 - 3072; } else if (c0 < 7168) { dst = FWS(bf16, WS_WVT); r0 = 1024 + c0 - 5120; }
            else { dst = FWS(bf16, WS_WINT); r0 = 4096 + c0 - 7168; }
#if INPROJ_FP8
            if (ROT_BF16 && c0 >= 3072 && c0 < 5120) tr_item(B.w_in, INW, kb * 64, c0, (bf16*)(F.B.ws + WS_WROT), 1024, c0 - 3072, scr, lane_);
            else tr_item_fp8(B.w_in, INW, kb * 64, c0, (unsigned char*)dst, 1024, r0, scr, lane_, IN_WSCALE);
            continue; } r -= I_IN;
#else
            tr_item(B.w_in, INW, kb * 64, c0, dst, 1024, r0, scr, lane_); continue; } r -= I_IN;
#endif
        if (r < I_BSB) { tr_item(B.w_bsb, 1024, (r >> 4) * 64, (r & 15) * 64, FWS(bf16, WS_WBSBT), 1024, (r & 15) * 64, scr, lane_); continue; } r -= I_BSB;
        if (r < I_BRET) { tr_item(B.w_bret, 1024, (r >> 4) * 64, (r & 15) * 64, FWS(bf16, WS_WBRETT), 2048, (r & 15) * 64, scr, lane_); continue; } r -= I_BRET;
        tr_item(B.w_out, 1024, (r >> 4) * 64, (r & 15) * 64, FWS(bf16, WS_WOUTT), 1024, (r & 15) * 64, scr, lane_);
    }
    { float* ct = FWS(float, WS_COS); float* st = FWS(float, WS_SIN);
      for (int i = blockIdx.x * 512 + tid_; i < SEQ * 128; i += F.G * 512) { const int pos = i >> 7, j = i & 127; const float ang = (float)pos * rope_inv_freq(j);
          ct[i] = (float)cos((double)ang); st[i] = (float)sin((double)ang); } }
    { bf16* wrt = FWS(bf16, WS_WRT);
      for (int i = blockIdx.x * 512 + tid_; i < 32 * 1024; i += F.G * 512) { const int k = i & 1023, e = i >> 10; wrt[i] = f2bf(B.w_router[k * 32 + e]); } }
}
__device__ __forceinline__ float sb_half(f32x16& p, int kbase, int tq, int hi, bool need_mask, float cin, bf16x8& f0, bf16x8& f1) {
    f32x16 u;
#pragma unroll
    for (int r = 0; r < 16; ++r) { const float e = __builtin_amdgcn_exp2f(fminf(p[r], 100.0f)); u[r] = __builtin_amdgcn_rcpf(1.0f + e); p[r] = e * u[r]; }
    if (need_mask) {
#pragma unroll
        for (int r = 0; r < 16; ++r) { const int s_ = kbase + crow(r, hi); const bool v = (s_ >= 0) && (s_ < tq); u[r] = v ? u[r] : 1.0f; p[r] = v ? p[r] : 0.0f; } }
    float T[4], Rh[4];
#pragma unroll
    for (int g = 0; g < 4; ++g) { const float R = (u[4 * g] * u[4 * g + 1]) * (u[4 * g + 2] * u[4 * g + 3]); float rh; const float rl = swap_lo(R, rh); Rh[g] = rh; T[g] = rl * rh; }
    float X[4]; X[3] = 1.0f;
#pragma unroll
    for (int g = 2; g >= 0; --g) X[g] = X[g + 1] * T[g + 1];
#pragma unroll
    for (int g = 0; g < 4; ++g) { const float ec = X[g] * (hi == 0 ? Rh[g] : 1.0f) * cin;
        const float w2 = u[4 * g + 3], w1 = w2 * u[4 * g + 2], w0 = w1 * u[4 * g + 1];
        p[4 * g + 3] *= ec; p[4 * g + 2] *= w2 * ec; p[4 * g + 1] *= w1 * ec; p[4 * g] *= w0 * ec; }
    f0 = pack_frag(p, 0); f1 = pack_frag(p, 8);
    return X[0] * T[0];
}
__device__ __forceinline__ void attn_wave_unit(const bf16* __restrict__ KSB, const bf16* __restrict__ VSBT, bf16* QY, int b, int h, int qb, int lane) {
    const int r32 = lane & 31, hi = lane >> 5; const int bh = b * 16 + h;
    const int t0 = qb * 32; const size_t rb = (size_t)b * SEQ; const int tq = t0 + r32;
    bf16x8 qf[4];
    { const bf16* qp = QY + (rb + t0 + r32) * 1024 + h * 64 + 8 * hi;
#pragma unroll
      for (int d0 = 0; d0 < 4; ++d0) qf[d0] = *(const bf16x8*)(qp + 16 * d0); }
    f32x16 o0 = {}, o1 = {};
    float carry = 1.0f;
    bf16x8 kf[2][4];
    const int koff = r32 * 16 + 8 * hi, voff = r32 * 16 + 4 * hi;
#define ATT_KLOAD(ks_) do { const bf16* b0_ = KSB + ((size_t)bh * 256 + (max((ks_), 0) >> 5)) * 2048; const bf16* b1_ = KSB + ((size_t)bh * 256 + (max((ks_) + 32, 0) >> 5)) * 2048; \
        _Pragma("unroll") for (int d0 = 0; d0 < 4; ++d0) { kf[0][d0] = *(const bf16x8*)(b0_ + d0 * 512 + koff); kf[1][d0] = *(const bf16x8*)(b1_ + d0 * 512 + koff); } } while (0)
    ATT_KLOAD(t0 - 32);
    for (int tile = 0;; ++tile) {
        const int ks = t0 + 32 - 64 * (tile + 1);
        f32x16 p0 = {}, p1 = {};
#pragma unroll
        for (int d0 = 0; d0 < 4; ++d0) { p0 = mfma32(kf[0][d0], qf[d0], p0); p1 = mfma32(kf[1][d0], qf[d0], p1); }
        bf16x8 vf[2][4];
#pragma unroll
        for (int s = 0; s < 4; ++s) { const bf16* vb_ = VSBT + ((size_t)bh * 512 + (max(ks + 16 * s, 0) >> 4)) * 1024;
#pragma unroll
            for (int db = 0; db < 2; ++db) vf[db][s] = join8(*(const u32x2*)(vb_ + db * 512 + voff), *(const u32x2*)(vb_ + db * 512 + voff + 8)); }
        ATT_KLOAD(ks - 64);
        const bool need_mask = (tile == 0) || (ks < 0);
        bf16x8 pfB0, pfB1, pfA0, pfA1;
        const float tot1 = sb_half(p1, ks + 32, tq, hi, need_mask, carry, pfB0, pfB1);
        const float tot0 = sb_half(p0, ks, tq, hi, need_mask, carry * tot1, pfA0, pfA1);
        carry *= tot1 * tot0;
        o0 = mfma32(vf[0][0], pfA0, o0); o1 = mfma32(vf[1][0], pfA0, o1); o0 = mfma32(vf[0][1], pfA1, o0); o1 = mfma32(vf[1][1], pfA1, o1);
        o0 = mfma32(vf[0][2], pfB0, o0); o1 = mfma32(vf[1][2], pfB0, o1); o0 = mfma32(vf[0][3], pfB1, o0); o1 = mfma32(vf[1][3], pfB1, o1);
        if (ks <= 0) break;
        if (__all(carry < 1.0e-37f)) break;
    }
#undef ATT_KLOAD
    bf16* op = QY + (rb + t0 + r32) * 1024 + h * 64 + 4 * hi;
    asm volatile("s_nop 15" ::: "memory");
#pragma unroll
    for (int g = 0; g < 4; ++g) { u32x2 w; w.x = pg8::cvt_pk_bf16(o0[4 * g], o0[4 * g + 1]); w.y = pg8::cvt_pk_bf16(o0[4 * g + 2], o0[4 * g + 3]); *(u32x2*)(op + 8 * g) = w;
        u32x2 w2; w2.x = pg8::cvt_pk_bf16(o1[4 * g], o1[4 * g + 1]); w2.y = pg8::cvt_pk_bf16(o1[4 * g + 2], o1[4 * g + 3]); *(u32x2*)(op + 32 + 8 * g) = w2; }
}
constexpr int I_GU = 32 * 16 * 32, I_DN = 32 * 16 * 16, I_MOE = I_GU + I_DN;
__device__ __forceinline__ void moe_tr_item(Frame& F, int r, LAS unsigned char* scr, int lane) {
    const Bufs& B = F.B;
    if (r < I_GU) { const int e = r >> 9, q = r & 511, kb = q >> 5, nb = q & 31; const int c0 = nb * 64; const int bj = c0 >> 10, rem = c0 & 1023, ct = rem >> 7, i0 = rem & 127;
#if MOE_FP8
        tr_item_fp8(B.w_gu + (size_t)e * 1024 * 2048, 2048, kb * 64, c0, F.B.ws + WS_WGUT + (size_t)e * 2048 * 1024, 1024, 256 * ct + 128 * bj + i0, scr, lane, MOE_WSCALE); return; }
#else
        tr_item(B.w_gu + (size_t)e * 1024 * 2048, 2048, kb * 64, c0, FWS(bf16, WS_WGUT) + (size_t)e * 2048 * 1024, 1024, 256 * ct + 128 * bj + i0, scr, lane); return; }
#endif
    r -= I_GU;
    { const int e = r >> 8, q = r & 255, kb = q >> 4, nb = q & 15;
#if MOE_FP8
      tr_item_fp8(B.w_dn + (size_t)e * 1024 * 1024, 1024, kb * 64, nb * 64, F.B.ws + WS_WDT + (size_t)e * 1024 * 1024, 1024, nb * 64, scr, lane, MOE_WSCALE); }
#else
      tr_item(B.w_dn + (size_t)e * 1024 * 1024, 1024, kb * 64, nb * 64, FWS(bf16, WS_WDT) + (size_t)e * 1024 * 1024, 1024, nb * 64, scr, lane); }
#endif
}
__device__ __forceinline__ void attn_phase(Frame& F) {
    const int lane = lane_id();
    LAS unsigned char* scr = F.lds + RING_OFF + F.wave * 9216;
    const int half = F.wave >> 2, gw4 = F.vcu * 4 + (F.wave & 3), NG4 = F.G * 4;
    if (half == 0) {
        for (int wu = gw4; wu < BATCH * SBH * (SEQ / 32); wu += NG4) { const int qb = wu & 255, bh = wu >> 8;
            attn_wave_unit(FWS(bf16, WS_KSB), FWS(bf16, WS_VSBT), FWS(bf16, WS_QSB), bh >> 4, bh & 15, qb, lane); }
    } else {
        for (int it = gw4; it < I_MOE; it += NG4) moe_tr_item(F, it, scr, lane);
    }
}

__device__ __forceinline__ int swap23(int m) { return (m & ~12) | ((m & 4) << 1) | ((m & 8) >> 1); }
__device__ __forceinline__ void scan_phase(Frame& F) {
    if (F.vcu >= BATCH * RH * 16) return;
    const int lane = lane_id(), w = F.wave, r32 = lane & 31, hi = lane >> 5;
    const int bh = F.vcu >> 4, vs = F.vcu & 15, h = bh & 3;
    const float l2g = ret_l2g(h), cd = __builtin_amdgcn_exp2f(64.0f * l2g);
    const bf16* ktp = FDO(bf16, DO_KRT) + ((size_t)bh * 128 * 4 * 256 + (32 * w + swap23(r32))) * 16 + 8 * hi;
    const bf16* vtp = FWS(bf16, WS_VRT) + ((size_t)bh * 128 * 4 * 512 + (32 * vs + r32)) * 16 + 8 * hi;
    const bf16* qp = FWS(bf16, WS_QRS) + ((size_t)bh * 128 * 16 * 64 + (size_t)(2 * w) * 64 + r32) * 16 + 8 * hi;
    bf16* yst = FWS(bf16, WS_YINT) + ((size_t)bh * 128 * 64 + (size_t)(4 * vs + (w & 3))) * 512 + lane * 8;
    LAS unsigned char* stg = F.lds + LDS_TAB_OFF;
    LAS f32x4* part = (LAS f32x4*)(F.lds + RING_OFF);
    f32x16 S = {};
    bf16x8 kfA[4], vfA[4], qfA[2][2], kfB[4], vfB[4], qfB[2][2], kfC[4], vfC[4], qfC[2][2];
#define SCAN_LOAD(kf, vf, qf, c) do { _Pragma("unroll") for (int s = 0; s < 4; ++s) { kf[s] = *(const bf16x8*)(ktp + (size_t)((c) * 4 + s) * 4096); vf[s] = *(const bf16x8*)(vtp + (size_t)((c) * 4 + s) * 8192); } \
        _Pragma("unroll") for (int ib = 0; ib < 2; ++ib) _Pragma("unroll") for (int s = 0; s < 2; ++s) qf[ib][s] = *(const bf16x8*)(qp + (size_t)(c) * 16384 + s * 1024 + ib * 512); } while (0)
#define SCAN_STEP(kf, vf, qf, kfn, vfn, qfn, c) do { \
        { const int cn_ = ((c) + 2 < NCHUNK) ? (c) + 2 : NCHUNK - 1; SCAN_LOAD(kfn, vfn, qfn, cn_); }     \
        const bf16x8 sb0 = pack_frag(S, 0), sb1 = pack_frag(S, 8); \
        f32x16 y0 = {}, y1 = {}; \
        y0 = mfma32(qf[0][0], sb0, y0); y0 = mfma32(qf[0][1], sb1, y0); \
        y1 = mfma32(qf[1][0], sb0, y1); y1 = mfma32(qf[1][1], sb1, y1); \
        LAS f32x4* pb = part + ((c) & 1) * 4096 + (w * 8) * 64 + lane; \
        _Pragma("unroll") for (int q = 0; q < 4; ++q) { pb[q * 64] = (f32x4){y0[4 * q], y0[4 * q + 1], y0[4 * q + 2], y0[4 * q + 3]}; pb[(4 + q) * 64] = (f32x4){y1[4 * q], y1[4 * q + 1], y1[4 * q + 2], y1[4 * q + 3]}; } \
        _Pragma("unroll") for (int r = 0; r < 16; ++r) S[r] *= cd; \
        _Pragma("unroll") for (int s = 0; s < 4; ++s) S = mfma32(kf[s], vf[s], S); \
        LDS_WAIT(); __builtin_amdgcn_s_barrier(); asm volatile("" ::: "memory"); \
        const LAS f32x4* rbp = part + ((c) & 1) * 4096 + w * 64 + lane;         \
        f32x4 acc = rbp[0]; \
        _Pragma("unroll") for (int w2 = 1; w2 < 8; ++w2) acc += rbp[w2 * 8 * 64]; \
        if ((c) > 0 && w < 4) *(u32x4*)(yst + (size_t)((c) - 1) * 32768) = *(const LAS u32x4*)(stg + (((c) - 1) & 1) * 4096 + w * 1024 + lane * 16);     \
        _Pragma("unroll") for (int k = 0; k < 4; ++k) { const int idx = 4 * w + k, ib = idx >> 4, r = idx & 15; const int i = 32 * ib + crow(r, hi); \
            *(LAS bf16*)(stg + ((c) & 1) * 4096 + (r32 >> 3) * 1024 + i * 16 + (r32 & 7) * 2) = f2bf(acc[k] * __builtin_amdgcn_exp2f((float)(i + 1) * l2g)); } } while (0)
    SCAN_LOAD(kfA, vfA, qfA, 0); SCAN_LOAD(kfB, vfB, qfB, 1);
    int c = 0;
    for (; c + 3 <= NCHUNK; c += 3) { SCAN_STEP(kfA, vfA, qfA, kfC, vfC, qfC, c); SCAN_STEP(kfB, vfB, qfB, kfA, vfA, qfA, c + 1); SCAN_STEP(kfC, vfC, qfC, kfB, vfB, qfB, c + 2); }
    SCAN_STEP(kfA, vfA, qfA, kfC, vfC, qfC, c); SCAN_STEP(kfB, vfB, qfB, kfA, vfA, qfA, c + 1);
    LDS_WAIT(); __syncthreads();
    if (w < 4) *(u32x4*)(yst + (size_t)(NCHUNK - 1) * 32768) = *(const LAS u32x4*)(stg + ((NCHUNK - 1) & 1) * 4096 + w * 1024 + lane * 16);
    static_assert(NCHUNK % 3 == 2, "scan tail");
#undef SCAN_STEP
#undef SCAN_LOAD
    LDS_WAIT(); __syncthreads();
}

__device__ __forceinline__ void intra_phase(Frame& F) {
    const int lane = lane_id(), w = F.wave, r32 = lane & 31, hi = lane >> 5;
    LAS float* part = (LAS float*)(F.lds + RING_OFF);
    LAS u32x4* pfl = (LAS u32x4*)(F.lds + RING_OFF + 16384);
    LAS float* red = (LAS float*)(F.lds + RING_OFF + 24576);
    LAS unsigned char* stg = F.lds + RING_OFF + 32768 + w * 9216;
    const int tl = w & 3, jb = tl >> 1, ibt = tl & 1, kh = w >> 2;
    const int un0 = F.vcu * 8; if (un0 >= BATCH * RH * NCHUNK) return;
    const int c0 = un0 & 127, h = (un0 >> 7) & 3, b = un0 >> 9, bh = b * 4 + h; const float l2g = ret_l2g(h);
    const bf16* kp0 = FWS(bf16, WS_KR) + ((size_t)b * SEQ + 32 * jb + r32) * 1024 + h * 256 + 128 * kh + 8 * hi;
    const bf16* qp0 = FWS(bf16, WS_QRS) + ((size_t)bh * 128 * 16 + 8 * kh) * 1024 + (32 * ibt + r32) * 16 + 8 * hi;
    const bf16* vp0 = FWS(bf16, WS_VRT) + ((size_t)bh * 128 * 4 * 512 + 64 * w + r32) * 16 + 4 * hi;
    const size_t tb0 = (((size_t)bh * 128 * 64 + 8 * w) * 64 + r32) * 8 + 4 * hi;
    const bf16* yp0 = FWS(bf16, WS_YINT) + tb0; const bf16* sp0 = FWS(bf16, WS_SG) + tb0;
    bf16x8 kfr[8], qfr[8], vfr[2][4]; u32x2 yv[2][2][4], sv[2][2][4];
#define IL_KQ(c) do { _Pragma("unroll") for (int s = 0; s < 8; ++s) { kfr[s] = *(const bf16x8*)(kp0 + (size_t)(c) * 65536 + 16 * s); qfr[s] = *(const bf16x8*)(qp0 + (size_t)(c) * 16384 + s * 1024); } } while (0)
#define IL_V(c) do { _Pragma("unroll") for (int vb = 0; vb < 2; ++vb) _Pragma("unroll") for (int ks = 0; ks < 4; ++ks) { const bf16* p = vp0 + (size_t)(c) * 32768 + (size_t)ks * 8192 + vb * 512; vfr[vb][ks] = join8(*(const u32x2*)(p), *(const u32x2*)(p + 8)); } } while (0)
#define IL_T(dst, base, c) do { _Pragma("unroll") for (int ib = 0; ib < 2; ++ib) _Pragma("unroll") for (int vb = 0; vb < 2; ++vb) _Pragma("unroll") for (int g = 0; g < 4; ++g) \
        dst[ib][vb][g] = *(const u32x2*)(base + (size_t)(c) * 32768 + (size_t)(4 * vb + g) * 512 + ib * 256); } while (0)
    IL_KQ(c0); IL_V(c0); IL_T(yv, yp0, c0);
    for (int k = 0; k < 8; ++k) {
        const int c = c0 + k; const bool more = k < 7;
        const size_t tok0 = (size_t)b * SEQ + c * 64;
        f32x16 X = {};
#pragma unroll
        for (int s = 0; s < 8; ++s) X = mfma32(kfr[s], qfr[s], X);
        { const int cn = more ? c + 1 : c; IL_KQ(cn); }
        if (kh == 1) {
#pragma unroll
            for (int r = 0; r < 16; ++r) part[(tl * 16 + r) * 64 + lane] = X[r]; }
        LDS_WAIT(); __builtin_amdgcn_s_barrier(); asm volatile("" ::: "memory");
        if (kh == 0) {
#pragma unroll
            for (int r = 0; r < 16; ++r) { const int j = 32 * jb + crow(r, hi), i = 32 * ibt + r32;
                X[r] = (X[r] + part[(tl * 16 + r) * 64 + lane]) * __builtin_amdgcn_exp2f((float)((j <= i ? i - j : j - i) - 63 + j) * l2g); }
            pfl[(ibt * 4 + 2 * jb) * 64 + lane] = __builtin_bit_cast(u32x4, pack_frag(X, 0)); pfl[(ibt * 4 + 2 * jb + 1) * 64 + lane] = __builtin_bit_cast(u32x4, pack_frag(X, 8)); }
        LDS_WAIT(); __builtin_amdgcn_s_barrier(); asm volatile("" ::: "memory");
        f32x16 Y[2][2] = {};
#pragma unroll
        for (int ks = 0; ks < 4; ++ks) { const bf16x8 p0 = __builtin_bit_cast(bf16x8, pfl[(0 * 4 + ks) * 64 + lane]), p1 = __builtin_bit_cast(bf16x8, pfl[(1 * 4 + ks) * 64 + lane]);
#pragma unroll
            for (int vb = 0; vb < 2; ++vb) { Y[vb][0] = mfma32(vfr[vb][ks], p0, Y[vb][0]); Y[vb][1] = mfma32(vfr[vb][ks], p1, Y[vb][1]); } }
        IL_T(sv, sp0, c);
        float s1[2] = {0.f, 0.f}, s2[2] = {0.f, 0.f};
#pragma unroll
        for (int ib = 0; ib < 2; ++ib)
#pragma unroll
            for (int vb = 0; vb < 2; ++vb)
#pragma unroll
                for (int g = 0; g < 4; ++g) { const u32x2 wv = yv[ib][vb][g];
                    Y[vb][ib][4 * g] += __uint_as_float(wv.x << 16); Y[vb][ib][4 * g + 1] += __uint_as_float(wv.x & 0xffff0000u); Y[vb][ib][4 * g + 2] += __uint_as_float(wv.y << 16); Y[vb][ib][4 * g + 3] += __uint_as_float(wv.y & 0xffff0000u);
#pragma unroll
                    for (int e = 0; e < 4; ++e) { const float y = Y[vb][ib][4 * g + e]; s1[ib] += y; s2[ib] += y * y; } }
#pragma unroll
        for (int ib = 0; ib < 2; ++ib) { float h1, h2; const float l1 = swap_lo(s1[ib], h1), l2 = swap_lo(s2[ib], h2);
            if (hi == 0) { red[(w * 64 + 32 * ib + r32) * 2] = l1 + h1; red[(w * 64 + 32 * ib + r32) * 2 + 1] = l2 + h2; } }
        LDS_WAIT(); __builtin_amdgcn_s_barrier(); asm volatile("" ::: "memory");
#pragma unroll
        for (int ib = 0; ib < 2; ++ib) { float t1 = 0.f, t2 = 0.f;
#pragma unroll
            for (int w2 = 0; w2 < 8; ++w2) { t1 += red[(w2 * 64 + 32 * ib + r32) * 2]; t2 += red[(w2 * 64 + 32 * ib + r32) * 2 + 1]; }
            const float mean = t1 * (1.0f / 512.0f), var = fmaxf(t2 * (1.0f / 512.0f) - mean * mean, 0.0f), rstd = __builtin_amdgcn_rsqf(var + LN_EPS);
#pragma unroll
            for (int vb = 0; vb < 2; ++vb)
#pragma unroll
                for (int g = 0; g < 4; ++g) { const u32x2 sw = sv[ib][vb][g];
                    const float g0 = __uint_as_float(sw.x << 16), g1 = __uint_as_float(sw.x & 0xffff0000u), g2 = __uint_as_float(sw.y << 16), g3 = __uint_as_float(sw.y & 0xffff0000u);
                    u32x2 ov; ov.x = pg8::cvt_pk_bf16(g0 * (Y[vb][ib][4 * g] - mean) * rstd, g1 * (Y[vb][ib][4 * g + 1] - mean) * rstd);
                    ov.y = pg8::cvt_pk_bf16(g2 * (Y[vb][ib][4 * g + 2] - mean) * rstd, g3 * (Y[vb][ib][4 * g + 3] - mean) * rstd);
                    *(LAS u32x2*)(stg + (32 * ib + r32) * 144 + (32 * vb + 8 * g + 4 * hi) * 2) = ov; } }
        { const int cn = more ? c + 1 : c; IL_V(cn); IL_T(yv, yp0, cn); }
        LDS_WAIT(); asm volatile("" ::: "memory");
        { bf16* rp = FDO(bf16, DO_R) + (tok0 + (lane >> 3)) * 2048 + h * 512 + 64 * w + 8 * (lane & 7);
#pragma unroll
          for (int kk = 0; kk < 8; ++kk) { const u32x4 v = *(const LAS u32x4*)(stg + (8 * kk + (lane >> 3)) * 144 + (lane & 7) * 16); *(u32x4*)(rp + (size_t)(8 * kk) * 2048) = v; } }
        LDS_WAIT(); asm volatile("" ::: "memory");
    }
#undef IL_KQ
#undef IL_V
#undef IL_T
    LDS_WAIT(); __syncthreads();
}

__device__ __forceinline__ void ln1_router_phase(Frame& F) {
    const Bufs& B = F.B;
    const int lane = lane_id(), w = F.wave, n = lane & 15, kq = lane >> 4; const int tid_ = w * 64 + lane;
    LAS unsigned char* wl = F.lds + RING_OFF;
    LAS float* gl = (LAS float*)(F.lds + RING_OFF + 66048);
    LAS float* bl = gl + 1024;
    LAS int* selE = (LAS int*)(F.lds + RING_OFF + 98816);
    LAS float* selW = (LAS float*)(F.lds + RING_OFF + 98816 + 2048);
    volatile LAS unsigned* hist = F.LC + 96; volatile LAS unsigned* basew = F.LC + 128;
    if (tid_ < 32) hist[tid_] = 0u;
    const int wgrow0 = F.vcu * 128;
    const int row = wgrow0 + 16 * w + n;
    u32x4 v[32];
    { const unsigned char* prow = (const unsigned char*)B.out + (size_t)row * 2048 + kq * 16;
#pragma unroll
      for (int s = 0; s < 32; ++s) v[s] = *(const u32x4*)(prow + 64 * s); }
    { const u32x4* src = FWS(u32x4, WS_WRT);
      for (int i = tid_; i < 4096; i += 512) { const int e = i >> 7, c = i & 127; *(LAS u32x4*)(wl + e * 2064 + c * 16) = src[i]; }
      if (tid_ < 256) *(LAS f32x4*)(gl + 4 * tid_) = *(const f32x4*)(B.ln1_g + 4 * tid_); else *(LAS f32x4*)(bl + 4 * (tid_ - 256)) = *(const f32x4*)(B.ln1_b + 4 * (tid_ - 256)); }
    LDS_WAIT(); __syncthreads();
    float s1 = 0.f;
#pragma unroll
    for (int s = 0; s < 32; ++s)
#pragma unroll
        for (int q = 0; q < 4; ++q) s1 += __uint_as_float(v[s][q] << 16) + __uint_as_float(v[s][q] & 0xffff0000u);
    s1 += __shfl_xor(s1, 16); s1 += __shfl_xor(s1, 32);
#define P7_LAUNDER() do { _Pragma("unroll") for (int s = 0; s < 32; ++s) asm volatile("" : "+v"(v[s])); } while (0)
    P7_LAUNDER();
    const float mean = s1 * (1.f / 1024.f); float s2 = 0.f;
#pragma unroll
    for (int s = 0; s < 32; ++s)
#pragma unroll
        for (int q = 0; q < 4; ++q) { const float d0 = __uint_as_float(v[s][q] << 16) - mean, d1 = __uint_as_float(v[s][q] & 0xffff0000u) - mean; s2 += d0 * d0 + d1 * d1; }
    s2 += __shfl_xor(s2, 16); s2 += __shfl_xor(s2, 32);
    P7_LAUNDER();
#undef P7_LAUNDER
    const float rstd = rsqrtf(s2 * (1.f / 1024.f) + LN_EPS);
    f32x4 acc0 = {0.f, 0.f, 0.f, 0.f}, acc1 = {0.f, 0.f, 0.f, 0.f};
    { unsigned char* xb = F.B.ws + WS_X1B + (size_t)row * 2048 + kq * 16;
#if MOE_FP8
      unsigned char* x8 = F.B.ws + WS_X1B8 + (size_t)row * 1024 + kq * 8;
#endif
      const LAS unsigned char* wa = wl + n * 2064 + kq * 16;
#pragma unroll
      for (int s = 0; s < 32; ++s) { const int k0 = 32 * s + 8 * kq;
          const f32x4 g0 = *(const LAS f32x4*)(gl + k0), g1 = *(const LAS f32x4*)(gl + k0 + 4), b0 = *(const LAS f32x4*)(bl + k0), b1 = *(const LAS f32x4*)(bl + k0 + 4);
          f32x4 y0, y1;
          y0[0] = (__uint_as_float(v[s][0] << 16) - mean) * rstd * g0[0] + b0[0]; y0[1] = (__uint_as_float(v[s][0] & 0xffff0000u) - mean) * rstd * g0[1] + b0[1];
          y0[2] = (__uint_as_float(v[s][1] << 16) - mean) * rstd * g0[2] + b0[2]; y0[3] = (__uint_as_float(v[s][1] & 0xffff0000u) - mean) * rstd * g0[3] + b0[3];
          y1[0] = (__uint_as_float(v[s][2] << 16) - mean) * rstd * g1[0] + b1[0]; y1[1] = (__uint_as_float(v[s][2] & 0xffff0000u) - mean) * rstd * g1[1] + b1[1];
          y1[2] = (__uint_as_float(v[s][3] << 16) - mean) * rstd * g1[2] + b1[2]; y1[3] = (__uint_as_float(v[s][3] & 0xffff0000u) - mean) * rstd * g1[3] + b1[3];
          const u32x4 o = pg8::pack8(y0, y1);
          *(u32x4*)(xb + 64 * s) = o;
#if MOE_FP8
          { u32x2 o8; o8.x = pk4_fp8(y0[0], y0[1], y0[2], y0[3]); o8.y = pk4_fp8(y1[0], y1[1], y1[2], y1[3]); *(u32x2*)(x8 + 32 * s) = o8; }
#endif
          const bf16x8 bf = __builtin_bit_cast(bf16x8, o);
          acc0 = __builtin_amdgcn_mfma_f32_16x16x32_bf16(*(const LAS bf16x8*)(wa + 64 * s), bf, acc0, 0, 0, 0);
          acc1 = __builtin_amdgcn_mfma_f32_16x16x32_bf16(*(const LAS bf16x8*)(wa + 16 * 2064 + 64 * s), bf, acc1, 0, 0, 0);
          asm volatile("" ::: "memory"); } }
    { float lg[8];
#pragma unroll
      for (int i = 0; i < 4; ++i) { lg[i] = acc0[i] + B.b_router[4 * kq + i]; lg[4 + i] = acc1[i] + B.b_router[16 + 4 * kq + i]; }
      int se[4]; float sv[4];
#pragma unroll
      for (int kk = 0; kk < 4; ++kk) { float best = -INFINITY; int bi = 0;
#pragma unroll
          for (int i = 0; i < 8; ++i) { const int e = (i < 4 ? 0 : 12) + 4 * kq + i; if (lg[i] > best) { best = lg[i]; bi = e; } }
#pragma unroll
          for (int off = 16; off <= 32; off <<= 1) { const float pv = __shfl_xor(best, off); const int pi = __shfl_xor(bi, off); if (pv > best || (pv == best && pi < bi)) { best = pv; bi = pi; } }
          se[kk] = bi; sv[kk] = best;
#pragma unroll
          for (int i = 0; i < 8; ++i) { const int e = (i < 4 ? 0 : 12) + 4 * kq + i; if (e == bi) lg[i] = -INFINITY; } }
      const float e1 = __expf(sv[1] - sv[0]), e2 = __expf(sv[2] - sv[0]), e3 = __expf(sv[3] - sv[0]); const float inv = 1.f / (1.f + e1 + e2 + e3);
      if (kq == 0) { const int tl = 16 * w + n;
          selE[tl * 4 + 0] = se[0]; selE[tl * 4 + 1] = se[1]; selE[tl * 4 + 2] = se[2]; selE[tl * 4 + 3] = se[3];
          selW[tl * 4 + 0] = inv; selW[tl * 4 + 1] = e1 * inv; selW[tl * 4 + 2] = e2 * inv; selW[tl * 4 + 3] = e3 * inv; } }
    LDS_WAIT(); __syncthreads();
    const int myE = selE[tid_]; const float myW = selW[tid_];
    const unsigned rk = __hip_atomic_fetch_add((LAS unsigned*)hist + myE, 1u, __ATOMIC_RELAXED, __HIP_MEMORY_SCOPE_WORKGROUP);
    LDS_WAIT(); __syncthreads();
    if (tid_ < 32) basew[tid_] = __hip_atomic_fetch_add(F.ctl + CW_CNT + 64 * tid_, hist[tid_], RLX_AGENT);
    LDS_WAIT(); __syncthreads();
    { const unsigned pos = basew[myE] + rk; const int tk = (wgrow0 + (tid_ >> 2)) * 4 + (tid_ & 3);
      FWS(int, WS_ROWTK)[(size_t)myE * CAP + pos] = tk; FWS(float, WS_ROWW)[(size_t)myE * CAP + pos] = myW; }
}

template <bool GU> struct MoeOrder {
    volatile LAS int* ts; volatile LAS unsigned* cntl; const LAS unsigned* tab; int c;
    static constexpr int UT_WORD = 96;
    __device__ bool search(int i, pg8::Unit& u) const {
        const int x = c & 7, k = c >> 3, q = 8 * i + x;
        const int rt = GU ? (4 * q + (k >> 3)) : (8 * q + (k >> 2));
        if (rt >= ts[NEXP]) return false;
        int e = 0;
        for (int j = 1; j < NEXP; ++j) e += (rt >= ts[j]) ? 1 : 0;
        u.pn = GU ? (k & 7) : (k & 3); u.e = e; u.idx = i; u.rbase = rt * 256; u.pm = (rt - ts[e]) * 256;
        const int left = (int)cntl[e] - u.pm; u.nrows = left < 256 ? left : 256; return true;
    }
    __device__ void build(int tid) const {
        if (tid < 24) { pg8::Unit u; const bool ok = search(tid, u); volatile LAS int* ut = (volatile LAS int*)(cntl - 64 + UT_WORD) + 4 * tid;
            ut[0] = ok ? u.e : -1; ut[1] = ok ? u.rbase : 0; ut[2] = ok ? u.pm : 0; ut[3] = ok ? u.nrows : 0; }
    }
    __device__ bool next(int i, pg8::Unit& u) const {
        if (i >= 24) return false;
        const volatile LAS int* ut = (const volatile LAS int*)(cntl - 64 + UT_WORD) + 4 * i;
        const int e = ut[0]; if (e < 0) return false;
        const int k = c >> 3; u.pn = GU ? (k & 7) : (k & 3); u.e = e; u.idx = i; u.rbase = ut[1]; u.pm = ut[2]; u.nrows = ut[3]; return true;
    }
    static constexpr int EBm = MOE_FP8 ? 1 : 2;
    __device__ __forceinline__ const char* a_ptr(const pg8::Unit& u) const { const char* ws_ = (const char*)KARG()->B.ws; return GU ? ws_ + (MOE_FP8 ? WS_X1B8 : WS_X1B) : ws_ + WS_ACT + (size_t)u.rbase * 1024 * EBm; }
    __device__ __forceinline__ const char* b_ptr(const pg8::Unit& u) const { const char* ws_ = (const char*)KARG()->B.ws; return ws_ + (GU ? WS_WGUT : WS_WDT) + ((size_t)u.e * (GU ? 2048 : 1024) + (size_t)u.pn * 256) * 1024 * EBm; }
    __device__ __forceinline__ unsigned a_off(const pg8::Unit& u, int row) const { return tab[u.idx * 256 + row]; }
    __device__ __forceinline__ void a_ready(const pg8::Unit&) const {}
    __device__ __forceinline__ void done(const pg8::Unit&) const {}
};
__device__ __forceinline__ void moe_setup(Frame& F) {
    const int tid_ = F.wave * 64 + lane_id();
    volatile LAS int* ts = (volatile LAS int*)(F.LC + 16); volatile LAS unsigned* cntl = F.LC + 64;
    if (tid_ < 32) cntl[tid_] = __hip_atomic_load(F.ctl + CW_CNT + 64 * tid_, RLX_AGENT);
    LDS_WAIT(); __syncthreads();
    if (tid_ <= NEXP) { const LAS unsigned* cn = (const LAS unsigned*)cntl; int acc = 0;
#pragma unroll
        for (int e = 0; e < NEXP; ++e) acc += (e < tid_) ? (int)((cn[e] + 255u) >> 8) : 0;
        ts[tid_] = acc; }
    LDS_WAIT(); __syncthreads();
}

__device__ __forceinline__ void final_phase(Frame& F) {
    const Bufs& B = F.B; const int lane = lane_id();
    const int gw = F.vcu * NWAVES + F.wave, NGW = F.G * NWAVES;
    f32x4 gv[4], bv[4];
#pragma unroll
    for (int j = 0; j < 4; ++j) { gv[j] = *(const f32x4*)(B.ln2_g + 4 * lane + 256 * j); bv[j] = *(const f32x4*)(B.ln2_b + 4 * lane + 256 * j); }
    for (int row = gw; row < NTOK; row += NGW) { float* p = B.out + (size_t)row * 1024 + 4 * lane; const bf16* orow = FWS(bf16, WS_OUTR) + (size_t)row * 4096 + 4 * lane;
        const bf16* xrow = FWS(bf16, WS_X1B) + (size_t)row * 1024 + 4 * lane;
        f32x4 v[4]; float s = 0.f;
#pragma unroll
        for (int j = 0; j < 4; ++j) { { const u32x2 xv = *(const u32x2*)(xrow + 256 * j);
                v[j] = (f32x4){__uint_as_float(xv.x << 16), __uint_as_float(xv.x & 0xffff0000u), __uint_as_float(xv.y << 16), __uint_as_float(xv.y & 0xffff0000u)} * DN_ALPHA; }
#pragma unroll
            for (int kk = 0; kk < 4; ++kk) { const u32x2 wv = *(const u32x2*)(orow + kk * 1024 + 256 * j);
                v[j][0] += __uint_as_float(wv.x << 16); v[j][1] += __uint_as_float(wv.x & 0xffff0000u); v[j][2] += __uint_as_float(wv.y << 16); v[j][3] += __uint_as_float(wv.y & 0xffff0000u); }
            s += (v[j][0] + v[j][1]) + (v[j][2] + v[j][3]); }
        const float mean = wave_sum(s) * (1.f / 1024.f); float s2 = 0.f;
#pragma unroll
        for (int j = 0; j < 4; ++j) { v[j] = v[j] - mean; s2 += (v[j][0] * v[j][0] + v[j][1] * v[j][1]) + (v[j][2] * v[j][2] + v[j][3] * v[j][3]); }
        const float rstd = rsqrtf(wave_sum(s2) * (1.f / 1024.f) + LN_EPS);
#pragma unroll
        for (int j = 0; j < 4; ++j) *(f32x4*)(p + 256 * j) = v[j] * rstd * gv[j] + bv[j]; }
}

__device__ __forceinline__ void stagger(const Frame& F, int quarter_ticks  ) {
    const unsigned long long t0 = __builtin_amdgcn_s_memrealtime(); const unsigned long long dt = (unsigned long long)((F.vcu & 3) * quarter_ticks);
    while (__builtin_amdgcn_s_memrealtime() - t0 < dt) __builtin_amdgcn_s_sleep(8);
}
#ifndef STAGGER
#define STAGGER 0
#endif
constexpr int NPHASE = 11;
__global__ void __launch_bounds__(NWAVES * 64, 2) mega_fwd(MArgs args) {
    extern __shared__ __attribute__((aligned(16))) unsigned char lds[];
    Frame F;
    F.lds = (LAS unsigned char*)lds; F.LC = (volatile LAS unsigned*)(F.lds + LDSCTL_OFF);
    F.wave = __builtin_amdgcn_readfirstlane((int)threadIdx.x >> 6);
    F.G = gridDim.x; { const int bx = blockIdx.x; F.vcu = (F.G % 8 == 0) ? (bx % 8) * (F.G / 8) + bx / 8 : bx; }
#define REFRESH() do { const __attribute__((address_space(4))) MArgs* kp_ = KARG(); \
        F.B.x = kp_->B.x; F.B.w_in = kp_->B.w_in; F.B.w_bsb = kp_->B.w_bsb; F.B.w_bret = kp_->B.w_bret; F.B.w_out = kp_->B.w_out; F.B.ln1_g = kp_->B.ln1_g; F.B.ln1_b = kp_->B.ln1_b; \
        F.B.w_router = kp_->B.w_router; F.B.b_router = kp_->B.b_router; F.B.w_gu = kp_->B.w_gu; F.B.b_gu = kp_->B.b_gu; F.B.w_dn = kp_->B.w_dn; F.B.b_dn = kp_->B.b_dn; \
        F.B.ln2_g = kp_->B.ln2_g; F.B.ln2_b = kp_->B.ln2_b; F.B.out = kp_->B.out; F.B.ws = kp_->B.ws; F.ctl = (unsigned*)(F.B.ws + WS_CTL); } while (0)
    F.B = args.B; F.ctl = (unsigned*)(args.B.ws + WS_CTL);
    for (int u = threadIdx.x; u < 256; u += NWAVES * 64) F.LC[u] = 0u;
    __syncthreads();
    if (threadIdx.x == 0) { const unsigned long long kp = (unsigned long long)__builtin_amdgcn_kernarg_segment_ptr(); F.LC[KARG_LDS_WORD] = (unsigned)kp; F.LC[KARG_LDS_WORD + 1] = (unsigned)(kp >> 32); }
    __syncthreads();
    const int lo = args.ph_lo, hi = args.ph_hi;
    const bool multi = (hi - lo) > 1;
    if (multi) (void)xcd_barrier_post(F.ctl + CW_BAR, F.LC);
#ifndef PH_COMPILE
#define PH_COMPILE 0x7FF
#endif
#define IN(k) ((((PH_COMPILE) >> (k)) & 1) && (KARG()->ph_lo & 0xff) <= (k) && (k) < KARG()->ph_hi)
#define SEAM(k) do { if (IN(k) && IN((k) + 1)) { REFRESH(); XcdBarrier bar_; bar_.bar = F.ctl + CW_BAR; bar_.x = xb_xcc_id(); bar_.st = F.LC; xcd_barrier(bar_); } } while (0)
    LAS unsigned char* ring = F.lds + RING_OFF;
    const int c = (int)blockIdx.x;
    if (IN(0)) { REFRESH(); p0_prologue(F); } SEAM(0);
    if (IN(1)) { REFRESH(); if (STAGGER) stagger(F, 500);
        constexpr int IEB = INPROJ_FP8 ? 1 : 2; constexpr bool IF8 = INPROJ_FP8 != 0;
        constexpr bool RB = IF8 && ROT_BF16;
        const char* xa = IF8 ? (const char*)(F.B.ws + WS_XB8) : (const char*)FDO(char, DO_XB);
        { pg8::StaticOrder S; S.init(xa, F.B.ws + WS_WINT, NTOK, 2048, 1024, F.G, c, IEB);
          pg8::EpiQK E{FWS(bf16, WS_QSB), FWS(bf16, WS_KSB)};
          pg8::gemm_phase<pg8::EpiQK, pg8::StaticOrder, true, false, IF8>(ring, 1024, S, E, F.wave); }
        { pg8::StaticOrder S;
          if (RB) S.init(FDO(char, DO_XB), F.B.ws + WS_WROT, NTOK, 2048, 1024, F.G, c, 2); else S.init(xa, F.B.ws + WS_WINT + (size_t)2048 * 1024 * IEB, NTOK, 2048, 1024, F.G, c, IEB);
          pg8::EpiRot E{FWS(bf16, WS_QR), FWS(bf16, WS_KR), FDO(bf16, DO_KRT), FWS(bf16, WS_QRS), FWS(float, WS_COS), FWS(float, WS_SIN), RB ? 1.0f : IN_DS};
          pg8::gemm_phase<pg8::EpiRot, pg8::StaticOrder, true, false, IF8 && !RB>(ring, 1024, S, E, F.wave); }
        { pg8::StaticOrder S; S.init(xa, F.B.ws + WS_WINT + (size_t)4096 * 1024 * IEB, NTOK, 4096, 1024, F.G, c, IEB);
          pg8::EpiGate E{F.B.ws};
          pg8::gemm_phase<pg8::EpiGate, pg8::StaticOrder, true, false, IF8>(ring, 1024, S, E, F.wave); }
        { pg8::StaticOrder S; S.init(F.B.ws + WS_WVT, xa, 3072, NTOK, 1024, F.G, c, IEB);
          pg8::EpiVT E{FWS(bf16, WS_VSBT), FWS(bf16, WS_VRT)};
          pg8::gemm_phase<pg8::EpiVT, pg8::StaticOrder, true, false, IF8>(ring, 1024, S, E, F.wave); }
    } SEAM(1);
    if (IN(2)) { REFRESH(); attn_phase(F); } SEAM(2);
    if (IN(3)) { REFRESH(); scan_phase(F); } SEAM(3);
    if (IN(4)) { REFRESH(); intra_phase(F); } SEAM(4);
    if (IN(5)) { REFRESH(); if (STAGGER) stagger(F, 700);
        { pg8::StaticOrder S; S.init(FWS(bf16, WS_QSB), FWS(bf16, WS_WBSBT), NTOK, 1024, 1024, F.G, c);
          pg8::EpiBranch<0> E{FWS(bf16, WS_GSB), nullptr, FWS(bf16, WS_M1)};
          pg8::gemm_phase<pg8::EpiBranch<0>, pg8::StaticOrder, true, false>(ring, 1024, S, E, F.wave); }
        { pg8::StaticOrder S; S.init(FDO(bf16, DO_R), FWS(bf16, WS_WBRETT), NTOK, 1024, 2048, F.G, c);
          pg8::EpiBranch<1> E{FWS(bf16, WS_GRET), FWS(bf16, WS_M1), FWS(bf16, WS_MG)};
          pg8::gemm_phase<pg8::EpiBranch<1>, pg8::StaticOrder, true, false>(ring, 2048, S, E, F.wave); }
    } SEAM(5);
    if (IN(6)) { REFRESH(); if (STAGGER) stagger(F, 700); pg8::StaticOrder S; S.init(FWS(bf16, WS_MG), FWS(bf16, WS_WOUTT), NTOK, 1024, 1024, F.G, c);
        pg8::EpiPre E{F.B.x, (bf16*)F.B.out};
        pg8::gemm_phase<pg8::EpiPre, pg8::StaticOrder, true, false>(ring, 1024, S, E, F.wave); } SEAM(6);
    if (IN(7)) { REFRESH(); ln1_router_phase(F); } SEAM(7);
    if (IN(8)) { REFRESH(); if (STAGGER) stagger(F, 500); moe_setup(F);
        MoeOrder<true> S{(volatile LAS int*)(F.LC + 16), F.LC + 64, (const LAS unsigned*)(F.lds + LDS_TAB_OFF), c};
        S.build(F.wave * 64 + lane_id()); LDS_WAIT(); __syncthreads();
        { pg8::Unit u; LAS unsigned* tab = (LAS unsigned*)(F.lds + LDS_TAB_OFF);
          const int tid_ = F.wave * 64 + lane_id();
          (void)u; const int half_ = tid_ >> 8, rr = tid_ & 255; const LAS int* ut = (const LAS int*)(F.LC + MoeOrder<true>::UT_WORD); const int* rowtk = FWS(int, WS_ROWTK);
          int tkv[12]; bool vld[12];
#pragma unroll
          for (int j = 0; j < 12; ++j) { const int i = 2 * j + half_; const int e = ut[4 * i], pm = ut[4 * i + 2], nr = ut[4 * i + 3]; vld[j] = (e >= 0) && (rr < nr);
              tkv[j] = rowtk[vld[j] ? (size_t)e * CAP + pm + rr : (size_t)0]; }
#pragma unroll
          for (int j = 0; j < 12; ++j) tab[(2 * j + half_) * 256 + rr] = vld[j] ? (unsigned)(tkv[j] >> 2) * (MOE_FP8 ? 1024u : 2048u) : 0u;
          LDS_WAIT(); __syncthreads(); }
        pg8::EpiGateUp E{0};
        pg8::gemm_phase<pg8::EpiGateUp, MoeOrder<true>, true, true, MOE_FP8 != 0>(ring, 1024, S, E, F.wave); } SEAM(8);
    if (IN(9)) { REFRESH(); if (STAGGER) stagger(F, 500); moe_setup(F);
        MoeOrder<false> S{(volatile LAS int*)(F.LC + 16), F.LC + 64, (const LAS unsigned*)(F.lds + LDS_TAB_OFF), c};
        S.build(F.wave * 64 + lane_id()); LDS_WAIT(); __syncthreads();
        pg8::EpiDown E{0};
        pg8::gemm_phase<pg8::EpiDown, MoeOrder<false>, true, false, MOE_FP8 != 0>(ring, 1024, S, E, F.wave); } SEAM(9);
    if (IN(10)) { REFRESH(); final_phase(F); }
#undef IN
#undef SEAM
}
#ifndef OPT_MASK
#define OPT_MASK 0x7FF
#endif
#ifndef ONE_LAUNCH
#define ONE_LAUNCH 1
#endif
template <int NB, class AF, class BF, class EF> static void launch_ngemm(hipStream_t s, int M, int N, int K, const AF& af, const BF& bf, const EF& ef) {
    GArgs<AF, BF, EF> ga; memset(&ga, 0, sizeof(ga)); ga.af = af; ga.bf = bf; ga.ef = ef; ga.M = M; ga.N = N; ga.K = K; ga.pad = 0;
    ngemm<NB, AF, BF, EF><<<dim3(N / 64, M / 64), 256, 0, s>>>(ga);
}
static void launch_tr(hipStream_t s, int grid, const float* src, int lds, int c0, int width, int K, bf16* dst, int r0) {
    TrArgs a; memset(&a, 0, sizeof(a)); a.src = src; a.dst = dst; a.lds = lds; a.c0 = c0; a.width = width; a.K = K; a.r0 = r0; a.pad = 0;
    n_tr<<<grid, 256, 0, s>>>(a);
}
static AF_rows mk_rows(const void* p, int ld) { AF_rows a; memset(&a, 0, sizeof(a)); a.A = (const bf16*)p; a.ld = ld; a.pad = 0; return a; }
static BF_wt mk_wt(const void* p, int K) { BF_wt a; memset(&a, 0, sizeof(a)); a.W = (const bf16*)p; a.K = K; a.pad = 0; return a; }
static void run_naive(const Bufs& B, hipStream_t s, int stage) {
    unsigned char* ws = B.ws;
    switch (stage) {
    case 0: {
        n_xb<<<2048, 256, 0, s>>>(B);
        bf16* wint = (bf16*)(ws + WS_WINT); bf16* wvt = (bf16*)(ws + WS_WVT);
        launch_tr(s, 1024, B.w_in, INW, 0, 2048, 1024, wint, 0);
        launch_tr(s, 1024, B.w_in, INW, 2048, 1024, 1024, wvt, 0);
        launch_tr(s, 1024, B.w_in, INW, 3072, 2048, 1024, wint, 2048);
        launch_tr(s, 1024, B.w_in, INW, 5120, 2048, 1024, wvt, 1024);
        launch_tr(s, 1024, B.w_in, INW, 7168, 4096, 1024, wint, 4096);
        launch_tr(s, 1024, B.w_bsb, 1024, 0, 1024, 1024, (bf16*)(ws + WS_WBSBT), 0);
        launch_tr(s, 1024, B.w_bret, 1024, 0, 1024, 2048, (bf16*)(ws + WS_WBRETT), 0);
        launch_tr(s, 1024, B.w_out, 1024, 0, 1024, 1024, (bf16*)(ws + WS_WOUTT), 0);
        launch_tr(s, 64, B.w_router, 32, 0, 32, 1024, (bf16*)(ws + WS_WRT), 0);
        { Tr2Args a; memset(&a, 0, sizeof(a)); a.src = B.w_gu; a.dst = (bf16*)(ws + WS_WGUT); n_tr_gu<<<4096, 256, 0, s>>>(a); }
        { Tr2Args a; memset(&a, 0, sizeof(a)); a.src = B.w_dn; a.dst = (bf16*)(ws + WS_WDT); n_tr_dn<<<4096, 256, 0, s>>>(a); }
        n_rope<<<1024, 256, 0, s>>>(B);
    } break;
    case 1: {
        BF_inproj bf; memset(&bf, 0, sizeof(bf)); bf.wint = (const bf16*)(ws + WS_WINT); bf.wvt = (const bf16*)(ws + WS_WVT); EF_inproj ef{B};
        launch_ngemm<1>(s, NTOK, INW, 1024, mk_rows((unsigned char*)B.out + DO_XB, 1024), bf, ef);
        n_rotary<<<4096, 256, 0, s>>>(B);
    } break;
    case 2: n_attn<<<BATCH * SBH * SEQ / 64, 64, 0, s>>>(B);
        if (OPT_MASK & 1) { { Tr2Args a; memset(&a, 0, sizeof(a)); a.src = B.w_gu; a.dst = (bf16*)(ws + WS_WGUT); n_tr_gu<<<4096, 256, 0, s>>>(a); }
                            { Tr2Args a; memset(&a, 0, sizeof(a)); a.src = B.w_dn; a.dst = (bf16*)(ws + WS_WDT); n_tr_dn<<<4096, 256, 0, s>>>(a); } }
        break;
    case 3: n_scan<<<BATCH * RH * RDV, 64, 0, s>>>(B); break;
    case 4: n_intra<<<BATCH * RH * NCHUNK, 256, 0, s>>>(B); break;
    case 5: {
        { EF_m1 ef{B}; launch_ngemm<1>(s, NTOK, 1024, 1024, mk_rows(ws + WS_QSB, 1024), mk_wt(ws + WS_WBSBT, 1024), ef); }
        { EF_mg ef{B}; launch_ngemm<1>(s, NTOK, 1024, 2048, mk_rows((unsigned char*)B.out + DO_R, 2048), mk_wt(ws + WS_WBRETT, 2048), ef); }
    } break;
    case 6: { EF_pre ef{B}; launch_ngemm<1>(s, NTOK, 1024, 1024, mk_rows(ws + WS_MG, 1024), mk_wt(ws + WS_WOUTT, 1024), ef); } break;
    case 7: n_ln1<<<NTOK / 4, 256, 0, s>>>(B); n_router<<<NTOK / 64, 64, 0, s>>>(B); break;
    case 8: { n_tstart<<<1, 64, 0, s>>>(B); n_rowinfo<<<544, 256, 0, s>>>(B); AF_gather af{B}; BF_gu bf{B}; EF_gu ef{B}; launch_ngemm<2>(s, MAXROWS, 1024, 1024, af, bf, ef); } break;
    case 9: { n_tstart<<<1, 64, 0, s>>>(B); n_rowinfo<<<544, 256, 0, s>>>(B); AF_act af{B}; BF_dn bf{B}; EF_dn ef{B}; launch_ngemm<1>(s, MAXROWS, 1024, 1024, af, bf, ef); } break;
    case 10: n_final<<<NTOK / 4, 256, 0, s>>>(B); break;
    }
}
static void run_mega(const Bufs& B, hipStream_t s, int lo, int hi) {
    MArgs a; memset(&a, 0, sizeof(a)); a.B = B; a.ph_lo = lo; a.ph_hi = hi;
    hipLaunchKernelGGL(mega_fwd, dim3(256), dim3(NWAVES * 64), LDS_BYTES, s, a);
}

extern "C" void kernel_launch(void* const* d_in, const int* in_sizes, int n_in, void* d_out, int out_size, void* d_ws, size_t ws_size, hipStream_t stream) {
    if (n_in != 15 || out_size != NTOK * DM || ws_size < WS_END) { fprintf(stderr, "kernel_launch: unexpected shapes (n_in %d out %d ws %zu)\n", n_in, out_size, ws_size); return; }
    static int inited = 0;
    if (!inited) { inited = 1;
        if (hipFuncSetAttribute((const void*)mega_fwd, hipFuncAttributeMaxDynamicSharedMemorySize, LDS_BYTES) != hipSuccess) fprintf(stderr, "kernel_launch: hipFuncSetAttribute failed\n");
        int dev = 0, cus = 0; (void)hipGetDevice(&dev); (void)hipDeviceGetAttribute(&cus, hipDeviceAttributeMultiprocessorCount, dev);
        if (cus != 256) fprintf(stderr, "kernel_launch: built for 256 CUs, device has %d\n", cus);
        (void)hipGetLastError(); }
    Bufs B; memset(&B, 0, sizeof(B));
    B.x = (const float*)d_in[0]; B.w_in = (const float*)d_in[1]; B.w_bsb = (const float*)d_in[2]; B.w_bret = (const float*)d_in[3]; B.w_out = (const float*)d_in[4];
    B.ln1_g = (const float*)d_in[5]; B.ln1_b = (const float*)d_in[6]; B.w_router = (const float*)d_in[7]; B.b_router = (const float*)d_in[8];
    B.w_gu = (const float*)d_in[9]; B.b_gu = (const float*)d_in[10]; B.w_dn = (const float*)d_in[11]; B.b_dn = (const float*)d_in[12]; B.ln2_g = (const float*)d_in[13]; B.ln2_b = (const float*)d_in[14];
    B.out = (float*)d_out; B.ws = (unsigned char*)d_ws;
    (void)hipMemsetAsync((char*)d_ws + WS_CTL, 0, CTL_ZERO_BYTES, stream);
    if ((OPT_MASK & 0x7FF) == 0x7FF && ONE_LAUNCH) { run_mega(B, stream, 0, NPHASE); return; }
    for (int st = 0; st < NPHASE; ++st) { if ((OPT_MASK >> st) & 1) run_mega(B, stream, st, st + 1); else run_naive(B, stream, st);
#ifdef PROBE_DUP
        if (st == PROBE_DUP) {
            if (st == 2) { run_mega(B, stream, 1, 2); run_mega(B, stream, 2, 3); }
            else if (st == 4) { run_mega(B, stream, 3, 4); run_mega(B, stream, 4, 5); }
            else if (st == 7) { (void)hipMemsetAsync((char*)d_ws + WS_CTL, 0, CTL_ZERO_BYTES, stream); run_mega(B, stream, 6, 7); run_mega(B, stream, 7, 8); }
            else if (st == 10) { (void)hipMemsetAsync((char*)d_ws + WS_CTL, 0, CTL_ZERO_BYTES, stream); run_mega(B, stream, 6, 7); run_mega(B, stream, 7, 8); run_mega(B, stream, 10, 11); }
            else {
#ifndef PROBE_REP
#define PROBE_REP 1
#endif
                for (int rep = 0; rep < PROBE_REP; ++rep) run_mega(B, stream, st, st + 1); }
        }
#endif
    }
}
```

```cpp
#include <hip/hip_runtime.h>
#include <cstdio>
#include <cstdint>
#include <cstring>

constexpr int BATCH = 4, SEQ = 8192, DM = 1024, NTOK = BATCH * SEQ;
constexpr int SBH = 16, SBD = 64;
constexpr int RH = 4, RDK = 256, RDV = 512, RQK = RH * RDK  , RV = RH * RDV  ;
constexpr int CHUNK = 64, NCHUNK = SEQ / CHUNK;
constexpr int INW = 11264;
constexpr int NEXP = 32, TOPK = 4, DFF = 1024;
constexpr int CAP = NTOK;
constexpr int MAXROWS = NTOK * TOPK + NEXP * 256;
constexpr float LN_EPS = 1e-5f;
constexpr float DN_ALPHA = 1.18920711500272106672f;
constexpr float LOG2E = 1.4426950408889634f;
constexpr float SB_C2 = 0.125f * LOG2E;

typedef unsigned short bf16;
typedef float f32x4 __attribute__((ext_vector_type(4)));
typedef float f32x16 __attribute__((ext_vector_type(16)));
typedef short bf16x8 __attribute__((ext_vector_type(8)));
typedef short bf16x4 __attribute__((ext_vector_type(4)));
typedef unsigned u32x4 __attribute__((ext_vector_type(4)));
typedef unsigned u32x2 __attribute__((ext_vector_type(2)));

__host__ __device__ __forceinline__ float bf2f(bf16 v) { unsigned u = (unsigned)v << 16; return __builtin_bit_cast(float, u); }
__host__ __device__ __forceinline__ bf16 f2bf(float f) { unsigned u = __builtin_bit_cast(unsigned, f); return (bf16)((u + 0x7fffu + ((u >> 16) & 1u)) >> 16); }
__device__ __forceinline__ unsigned pk2(float lo, float hi) { return (unsigned)f2bf(lo) | ((unsigned)f2bf(hi) << 16); }

constexpr size_t MiB_ = 1u << 20;
#ifndef MOE_FP8
#define MOE_FP8 1
#endif
#ifndef INPROJ_FP8
#define INPROJ_FP8 1
#endif
#ifndef ROT_BF16
#define ROT_BF16 0
#endif
constexpr size_t WS_XB8 = 104 * MiB_, WS_WROT = 136 * MiB_;
constexpr float IN_WSCALE = 32.0f, IN_DS = INPROJ_FP8 ? 1.0f / 32.0f : 1.0f;
constexpr float MOE_WSCALE = 64.0f, MOE_DESCALE = MOE_FP8 ? 1.0f / 64.0f : 1.0f;
__device__ __forceinline__ unsigned pk4_fp8(float a, float b, float c, float d) { int w = 0; w = __builtin_amdgcn_cvt_pk_fp8_f32(a, b, w, false); w = __builtin_amdgcn_cvt_pk_fp8_f32(c, d, w, true); return (unsigned)w; }

constexpr size_t MiB = 1u << 20;
constexpr size_t WS_CTL = 0, CTL_ZERO_BYTES = 1 * MiB;
constexpr size_t WS_COS = 1 * MiB, WS_SIN = 5 * MiB;
constexpr size_t WS_WRT = 9 * MiB;
constexpr size_t WS_TSTART = 9 * MiB + 512 * 1024;
constexpr size_t WS_WINT = 10 * MiB;
constexpr size_t WS_WVT = 26 * MiB;
constexpr size_t WS_WBSBT = 32 * MiB, WS_WBRETT = 34 * MiB, WS_WOUTT = 38 * MiB;
constexpr size_t WS_WGUT = 40 * MiB;
constexpr size_t WS_WDT = 168 * MiB;
constexpr size_t WS_QSB = 232 * MiB;
constexpr size_t WS_KSB = 296 * MiB;
constexpr size_t WS_VSBT = 360 * MiB;
constexpr size_t WS_YINT = 296 * MiB;
constexpr size_t WS_QR = 424 * MiB, WS_KR = 488 * MiB;
constexpr size_t WS_VRT = 552 * MiB;
constexpr size_t WS_SG = 680 * MiB;
constexpr size_t WS_GSB = 808 * MiB, WS_GRET = 872 * MiB;
constexpr size_t WS_SELE = 936 * MiB, WS_SELW = 937 * MiB;
constexpr size_t WS_ROWTK = 940 * MiB, WS_ROWW = 944 * MiB;
constexpr size_t WS_RINFO = 948 * MiB;
constexpr size_t WS_M1 = 424 * MiB, WS_MG = 488 * MiB;
constexpr size_t WS_X1B = 552 * MiB;
constexpr size_t WS_ACT = 616 * MiB;
constexpr size_t WS_OUTR = 232 * MiB;
constexpr size_t WS_END = 1024 * MiB;
static_assert(WS_ACT + (size_t)MAXROWS * 1024 * 2 <= WS_SELE, "ACT fits");
static_assert(WS_OUTR + (size_t)NTOK * 4 * 1024 * 2 <= WS_MG, "OUTR fits below MG");
constexpr size_t DO_XB = 0, DO_KRT = 64 * MiB;

__host__ __device__ __forceinline__ size_t krt_idx(int bh, int t, int d) { return ((((size_t)bh * 128 + (t >> 6)) * 4 + ((t >> 4) & 3)) * 256 + d) * 16 + (t & 15); }
__host__ __device__ __forceinline__ size_t vrt_idx(int bh, int t, int v) { return ((((size_t)bh * 128 + (t >> 6)) * 4 + ((t >> 4) & 3)) * 512 + v) * 16 + (t & 15); }
__host__ __device__ __forceinline__ size_t qrs_idx(int bh, int t, int d) { return ((((size_t)bh * 128 + (t >> 6)) * 16 + (d >> 4)) * 64 + (t & 63)) * 16 + (d & 15); }
__host__ __device__ __forceinline__ size_t yt_idx(int bh, int t, int v) { return ((((size_t)bh * 128 + (t >> 6)) * 64 + (v >> 3)) * 64 + (t & 63)) * 8 + (v & 7); }
__host__ __device__ __forceinline__ size_t ksb_idx(int bh, int t, int d) { return ((((size_t)bh * 256 + (t >> 5)) * 4 + (d >> 4)) * 32 + (t & 31)) * 16 + (d & 15); }
__host__ __device__ __forceinline__ size_t vsb_idx(int bh, int t, int d) { return (((size_t)bh * 512 + (t >> 4)) * 64 + d) * 16 + (t & 15); }
constexpr size_t WS_X1B8 = 888 * MiB;
constexpr size_t WS_QRS = 952 * MiB;
constexpr size_t DO_R = 0;
static_assert(WS_QRS + 64 * MiB <= WS_END, "QRS fits");

constexpr int CW_TMO = 0, CW_CODE = 1;
constexpr int CW_BAR = 4096;
constexpr int CW_CNT = 16384;

struct Bufs {
    const float *x, *w_in, *w_bsb, *w_bret, *w_out, *ln1_g, *ln1_b, *w_router, *b_router, *w_gu, *b_gu, *w_dn, *b_dn, *ln2_g, *ln2_b;
    float* out; unsigned char* ws;
};
struct MArgs { Bufs B; int ph_lo, ph_hi; };
#define KARG_LDS_WORD 250
__device__ __forceinline__ const __attribute__((address_space(4))) struct MArgs* karg_ptr() {
    extern __shared__ __attribute__((aligned(16))) unsigned char lds_karg_[];
    const volatile __attribute__((address_space(3))) unsigned* p = (const volatile __attribute__((address_space(3))) unsigned*)((__attribute__((address_space(3))) unsigned char*)lds_karg_ + 131072) + KARG_LDS_WORD;
    const unsigned lo = __builtin_amdgcn_readfirstlane(p[0]), hi = __builtin_amdgcn_readfirstlane(p[1]);
    return (const __attribute__((address_space(4))) struct MArgs*)(((unsigned long long)hi << 32) | lo);
}
#define KARG() (karg_ptr())
#define WSP(T, off) ((T*)(B.ws + (off)))
#define DOP(T, off) ((T*)((unsigned char*)B.out + (off)))

__global__ void n_xb(Bufs B) {
    const size_t n = (size_t)NTOK * DM; bf16* xb = DOP(bf16, DO_XB);
    for (size_t i = (size_t)blockIdx.x * blockDim.x + threadIdx.x; i < n; i += (size_t)gridDim.x * blockDim.x) xb[i] = f2bf(B.x[i]);
}
struct TrArgs { const float* src; bf16* dst; int lds, c0, width, K, r0, pad; };
__global__ void n_tr(TrArgs a) {
    const float* src = a.src; bf16* dst = a.dst; const int lds = a.lds, c0 = a.c0, width = a.width, K = a.K, r0 = a.r0;
    const size_t n = (size_t)width * K;
    for (size_t i = (size_t)blockIdx.x * blockDim.x + threadIdx.x; i < n; i += (size_t)gridDim.x * blockDim.x) {
        const int k = (int)(i % K), c = (int)(i / K); dst[(size_t)(r0 + c) * K + k] = f2bf(src[(size_t)k * lds + c0 + c]); }
}
struct Tr2Args { const float* src; bf16* dst; };
__global__ void n_tr_gu(Tr2Args a) { const float* src = a.src; bf16* dst = a.dst;
    const size_t n = (size_t)NEXP * 2048 * 1024;
    for (size_t i = (size_t)blockIdx.x * blockDim.x + threadIdx.x; i < n; i += (size_t)gridDim.x * blockDim.x) {
        const int k = (int)(i % 1024); const int r = (int)((i / 1024) % 2048); const int e = (int)(i / (1024 * 2048));
        const int ct = r >> 8, bj = (r >> 7) & 1, ii = r & 127; const int c = bj * 1024 + 128 * ct + ii;
        dst[i] = f2bf(src[((size_t)e * 1024 + k) * 2048 + c]); }
}
__global__ void n_tr_dn(Tr2Args a) { const float* src = a.src; bf16* dst = a.dst;
    const size_t n = (size_t)NEXP * 1024 * 1024;
    for (size_t i = (size_t)blockIdx.x * blockDim.x + threadIdx.x; i < n; i += (size_t)gridDim.x * blockDim.x) {
        const int ff = (int)(i % 1024); const int d = (int)((i / 1024) % 1024); const int e = (int)(i / (1024 * 1024));
        dst[i] = f2bf(src[((size_t)e * 1024 + ff) * 1024 + d]); }
}
__device__ __forceinline__ float rope_inv_freq(int j) { return powf(10000.0f, -(float)j / 128.0f); }
__global__ void n_rope(Bufs B) {
    float* c = WSP(float, WS_COS); float* s = WSP(float, WS_SIN);
    for (int i = blockIdx.x * blockDim.x + threadIdx.x; i < SEQ * 128; i += gridDim.x * blockDim.x) {
        const int pos = i >> 7, j = i & 127; const float ang = (float)pos * rope_inv_freq(j);
        c[i] = (float)cos((double)ang); s[i] = (float)sin((double)ang); }
}

template <class AF, class BF, class EF> struct GArgs { AF af; BF bf; EF ef; int M, N, K, pad; };
template <int NB, class AF, class BF, class EF>
__global__ void __launch_bounds__(256) ngemm(GArgs<AF, BF, EF> ga) {
    const AF& af = ga.af; const BF& bf = ga.bf; const EF& ef = ga.ef; const int K = ga.K;
    __shared__ float As[16][65], Bs[NB][16][65];
    const int tx = threadIdx.x & 15, ty = threadIdx.x >> 4;
    const int m0 = blockIdx.y * 64, n0 = blockIdx.x * 64;
    if (!af.active(m0)) return;
    float acc[NB][4][4];
#pragma unroll
    for (int b = 0; b < NB; ++b)
#pragma unroll
        for (int i = 0; i < 4; ++i)
#pragma unroll
            for (int j = 0; j < 4; ++j) acc[b][i][j] = 0.f;
    for (int k0 = 0; k0 < K; k0 += 16) {
#pragma unroll
        for (int i = 0; i < 4; ++i) { const int idx = threadIdx.x + 256 * i; const int kk = idx & 15, mm = idx >> 4; As[kk][mm] = af(m0 + mm, k0 + kk); }
#pragma unroll
        for (int b = 0; b < NB; ++b)
#pragma unroll
            for (int i = 0; i < 4; ++i) { const int idx = threadIdx.x + 256 * i; const int kk = idx & 15, nn = idx >> 4; Bs[b][kk][nn] = bf(m0, k0 + kk, n0 + nn, b); }
        __syncthreads();
#pragma unroll
        for (int kk = 0; kk < 16; ++kk) {
            float a[4];
#pragma unroll
            for (int i = 0; i < 4; ++i) a[i] = As[kk][ty * 4 + i];
#pragma unroll
            for (int b = 0; b < NB; ++b) {
                float bb[4];
#pragma unroll
                for (int j = 0; j < 4; ++j) bb[j] = Bs[b][kk][tx * 4 + j];
#pragma unroll
                for (int i = 0; i < 4; ++i)
#pragma unroll
                    for (int j = 0; j < 4; ++j) acc[b][i][j] += a[i] * bb[j];
            }
        }
        __syncthreads();
    }
#pragma unroll
    for (int i = 0; i < 4; ++i)
#pragma unroll
        for (int j = 0; j < 4; ++j) {
            float v[NB];
#pragma unroll
            for (int b = 0; b < NB; ++b) v[b] = acc[b][i][j];
            ef(m0 + ty * 4 + i, n0 + tx * 4 + j, v);
        }
}

__device__ __forceinline__ float sigmoidf_(float x) { return 1.0f / (1.0f + __expf(-x)); }
__device__ __forceinline__ float ret_log2gamma(int h) { return log2f(1.0f - exp2f(-5.0f - (float)h)); }

struct AF_rows { const bf16* A; int ld, pad; __device__ bool active(int) const { return true; } __device__ float operator()(int m, int k) const { return bf2f(A[(size_t)m * ld + k]); } };
struct BF_inproj { const bf16 *wint, *wvt;
    __device__ float operator()(int, int k, int n, int) const {
        const bf16* row;
        if (n < 2048) row = wint + (size_t)n * 1024;
        else if (n < 3072) row = wvt + (size_t)(n - 2048) * 1024;
        else if (n < 5120) row = wint + (size_t)(2048 + n - 3072) * 1024;
        else if (n < 7168) row = wvt + (size_t)(1024 + n - 5120) * 1024;
        else row = wint + (size_t)(4096 + n - 7168) * 1024;
        return bf2f(row[k]); } };
struct EF_inproj { Bufs B;
    __device__ void operator()(int m, int n, const float (&v)[1]) const {
        const float a = v[0];
        if (n < 1024) WSP(bf16, WS_QSB)[(size_t)m * 1024 + n] = f2bf(a * SB_C2);
        else if (n < 2048) { const int f = n - 1024; WSP(bf16, WS_KSB)[ksb_idx((m >> 13) * 16 + (f >> 6), m & (SEQ - 1), f & 63)] = f2bf(a); }
        else if (n < 3072) { const int f = n - 2048; WSP(bf16, WS_VSBT)[vsb_idx((m >> 13) * 16 + (f >> 6), m & (SEQ - 1), f & 63)] = f2bf(a); }
        else if (n < 4096) WSP(bf16, WS_QR)[(size_t)m * 1024 + n - 3072] = f2bf(a);
        else if (n < 5120) WSP(bf16, WS_KR)[(size_t)m * 1024 + n - 4096] = f2bf(a);
        else if (n < 7168) { const int f = n - 5120, h = f >> 9; const float dec = exp2f((float)(63 - (m & 63)) * ret_log2gamma(h));
            WSP(bf16, WS_VRT)[vrt_idx((m >> 13) * 4 + h, m & (SEQ - 1), f & 511)] = f2bf(a * dec); }
        else if (n < 9216) { const int f = n - 7168; WSP(bf16, WS_SG)[yt_idx((m >> 13) * 4 + (f >> 9), m & (SEQ - 1), f & 511)] = f2bf(a * sigmoidf_(a)); }
        else if (n < 10240) WSP(bf16, WS_GSB)[(size_t)m * 1024 + n - 9216] = f2bf(sigmoidf_(a));
        else WSP(bf16, WS_GRET)[(size_t)m * 1024 + n - 10240] = f2bf(sigmoidf_(a)); } };
__global__ void n_rotary(Bufs B) {
    bf16* qr = WSP(bf16, WS_QR); bf16* kr = WSP(bf16, WS_KR); bf16* krt = DOP(bf16, DO_KRT);
    const float* ct = WSP(float, WS_COS); const float* st = WSP(float, WS_SIN);
    const size_t n = (size_t)NTOK * RH * 128;
    for (size_t i = (size_t)blockIdx.x * blockDim.x + threadIdx.x; i < n; i += (size_t)gridDim.x * blockDim.x) {
        const int j = (int)(i & 127), h = (int)((i >> 7) & 3); const int m = (int)(i >> 9); const int pos = m & (SEQ - 1);
        const float c = ct[pos * 128 + j], s = st[pos * 128 + j];
        const size_t o1 = (size_t)m * 1024 + h * 256 + j, o2 = o1 + 128;
        const int bh = (m >> 13) * 4 + h;
        { const float x1 = bf2f(qr[o1]), x2 = bf2f(qr[o2]); const bf16 r1 = f2bf((x1 * c - x2 * s) * 0.0625f), r2 = f2bf((x1 * s + x2 * c) * 0.0625f); qr[o1] = r1; qr[o2] = r2;
          WSP(bf16, WS_QRS)[qrs_idx(bh, pos, j)] = r1; WSP(bf16, WS_QRS)[qrs_idx(bh, pos, j + 128)] = r2; }
        { const float x1 = bf2f(kr[o1]), x2 = bf2f(kr[o2]); const bf16 r1 = f2bf(x1 * c - x2 * s), r2 = f2bf(x1 * s + x2 * c); kr[o1] = r1; kr[o2] = r2;
          krt[krt_idx(bh, pos, j)] = r1; krt[krt_idx(bh, pos, j + 128)] = r2; }
    }
}

__global__ void __launch_bounds__(64) n_attn(Bufs B) {
    const int gid = blockIdx.x * 64 + threadIdx.x;
    const int t = gid & (SEQ - 1), bh = gid >> 13, h = bh & 15, b = bh >> 4;
    bf16* q = WSP(bf16, WS_QSB); const bf16* k = WSP(bf16, WS_KSB); const bf16* vt = WSP(bf16, WS_VSBT);
    const size_t rb = (size_t)b * SEQ;
    float qv[64], o[64];
#pragma unroll
    for (int d = 0; d < 64; ++d) { qv[d] = bf2f(q[(rb + t) * 1024 + h * 64 + d]); o[d] = 0.f; }
    float later = 0.f;
    for (int s = t - 1; s >= 0; --s) {
        float z2 = 0.f;
#pragma unroll
        for (int d = 0; d < 64; ++d) z2 += qv[d] * bf2f(k[ksb_idx(bh, s, d)]);
        const float z = z2 * 0.6931471805599453f;
        const float sp = fmaxf(z, 0.f) + log1pf(__expf(-fabsf(z)));
        const float a = __expf((z - sp) + later);
        later -= sp;
        if (a > 0.f) {
#pragma unroll
            for (int d = 0; d < 64; ++d) o[d] += a * bf2f(vt[vsb_idx(bh, s, d)]);
        }
    }
#pragma unroll
    for (int d = 0; d < 64; ++d) q[(rb + t) * 1024 + h * 64 + d] = f2bf(o[d]);
}

__global__ void __launch_bounds__(64) n_scan(Bufs B) {
    const int gid = blockIdx.x, v = gid & 511, h = (gid >> 9) & 3, b = gid >> 11, lane = threadIdx.x;
    const bf16* qr = WSP(bf16, WS_QR); const bf16* krt = DOP(bf16, DO_KRT); const bf16* vrt = WSP(bf16, WS_VRT); bf16* yint = WSP(bf16, WS_YINT);
    const float l2g = ret_log2gamma(h), cd = exp2f(64.f * l2g);
    float st[4] = {0.f, 0.f, 0.f, 0.f};
    for (int c = 0; c < NCHUNK; ++c) {
        const size_t tok0 = (size_t)b * SEQ + c * 64;
        for (int i = 0; i < 64; ++i) {
            const bf16* qp = qr + (tok0 + i) * 1024 + h * 256 + 4 * lane;
            float p = bf2f(qp[0]) * st[0] + bf2f(qp[1]) * st[1] + bf2f(qp[2]) * st[2] + bf2f(qp[3]) * st[3];
#pragma unroll
            for (int o = 1; o < 64; o <<= 1) p += __shfl_xor(p, o);
            if (lane == 0) yint[yt_idx(b * 4 + h, c * 64 + i, v)] = f2bf(p * exp2f((float)(i + 1) * l2g));
        }
        float ns[4] = {st[0] * cd, st[1] * cd, st[2] * cd, st[3] * cd};
        for (int j = 0; j < 64; ++j) {
            const float vv = bf2f(vrt[vrt_idx(b * 4 + h, c * 64 + j, v)]);
#pragma unroll
            for (int e = 0; e < 4; ++e) ns[e] += bf2f(krt[krt_idx(b * 4 + h, c * 64 + j, 4 * lane + e)]) * vv;
        }
#pragma unroll
        for (int e = 0; e < 4; ++e) st[e] = ns[e];
    }
}

__global__ void __launch_bounds__(256) n_intra(Bufs B) {
    __shared__ float P[64][65]; __shared__ float Y[8][512]; __shared__ float stat[8][2];
    const int gid = blockIdx.x, c = gid & 127, h = (gid >> 7) & 3, b = gid >> 9, tid = threadIdx.x;
    const bf16* qr = WSP(bf16, WS_QR); const bf16* kr = WSP(bf16, WS_KR); const bf16* vrt = WSP(bf16, WS_VRT); const bf16* sg = WSP(bf16, WS_SG); const bf16* yr = WSP(bf16, WS_YINT); bf16* rout = DOP(bf16, DO_R);
    const size_t tok0 = (size_t)b * SEQ + c * 64; const float l2g = ret_log2gamma(h);
    for (int e = tid; e < 4096; e += 256) { const int i = e >> 6, j = e & 63; float s = 0.f;
        const bf16* qp = qr + (tok0 + i) * 1024 + h * 256; const bf16* kp = kr + (tok0 + j) * 1024 + h * 256;
        for (int d = 0; d < 256; ++d) s += bf2f(qp[d]) * bf2f(kp[d]);
        const int ad = i > j ? i - j : j - i; P[i][j] = s * exp2f((float)(ad - 63 + j) * l2g); }
    __syncthreads();
    for (int i0 = 0; i0 < 64; i0 += 8) {
        for (int vv = tid; vv < 512; vv += 256) {
            float acc[8] = {0.f, 0.f, 0.f, 0.f, 0.f, 0.f, 0.f, 0.f};
            for (int j = 0; j < 64; ++j) { const float x = bf2f(vrt[vrt_idx(b * 4 + h, c * 64 + j, vv)]);
#pragma unroll
                for (int r = 0; r < 8; ++r) acc[r] += P[i0 + r][j] * x; }
#pragma unroll
            for (int r = 0; r < 8; ++r) Y[r][vv] = acc[r] + bf2f(yr[yt_idx(b * 4 + h, c * 64 + i0 + r, vv)]);
        }
        __syncthreads();
        { const int w = tid >> 6, lane = tid & 63;
          for (int r = w; r < 8; r += 4) { float s = 0.f, s2 = 0.f;
              for (int vv = lane; vv < 512; vv += 64) { const float x = Y[r][vv]; s += x; }
#pragma unroll
              for (int o = 1; o < 64; o <<= 1) s += __shfl_xor(s, o);
              const float mean = s * (1.f / 512.f);
              for (int vv = lane; vv < 512; vv += 64) { const float x = Y[r][vv] - mean; s2 += x * x; }
#pragma unroll
              for (int o = 1; o < 64; o <<= 1) s2 += __shfl_xor(s2, o);
              if (lane == 0) { stat[r][0] = mean; stat[r][1] = rsqrtf(s2 * (1.f / 512.f) + LN_EPS); } } }
        __syncthreads();
        for (int e = tid; e < 8 * 512; e += 256) { const int r = e >> 9, vv = e & 511; const size_t o = (tok0 + i0 + r) * 2048 + h * 512 + vv;
            rout[o] = f2bf(bf2f(sg[yt_idx(b * 4 + h, c * 64 + i0 + r, vv)]) * (Y[r][vv] - stat[r][0]) * stat[r][1]); }
        __syncthreads();
    }
}

struct BF_wt { const bf16* W; int K, pad; __device__ float operator()(int, int k, int n, int) const { return bf2f(W[(size_t)n * K + k]); } };
struct EF_m1 { Bufs B; __device__ void operator()(int m, int n, const float (&v)[1]) const { const size_t o = (size_t)m * 1024 + n; WSP(bf16, WS_M1)[o] = f2bf(bf2f(WSP(bf16, WS_GSB)[o]) * v[0]); } };
struct EF_mg { Bufs B; __device__ void operator()(int m, int n, const float (&v)[1]) const { const size_t o = (size_t)m * 1024 + n; WSP(bf16, WS_MG)[o] = f2bf(bf2f(WSP(bf16, WS_M1)[o]) + bf2f(WSP(bf16, WS_GRET)[o]) * v[0]); } };
struct EF_pre { Bufs B; __device__ void operator()(int m, int n, const float (&v)[1]) const { const size_t o = (size_t)m * 1024 + n; B.out[o] = DN_ALPHA * B.x[o] + v[0]; } };

__device__ __forceinline__ float wave_sum(float v) {
#pragma unroll
    for (int o = 1; o < 64; o <<= 1) v += __shfl_xor(v, o);
    return v;
}
__global__ void __launch_bounds__(256) n_ln1(Bufs B) {
    const int row = blockIdx.x * 4 + (threadIdx.x >> 6), lane = threadIdx.x & 63;
    float* p = B.out + (size_t)row * 1024; bf16* xb = WSP(bf16, WS_X1B) + (size_t)row * 1024;
    float v[16]; float s = 0.f;
#pragma unroll
    for (int j = 0; j < 16; ++j) { v[j] = p[lane + 64 * j]; s += v[j]; }
    const float mean = wave_sum(s) * (1.f / 1024.f); float s2 = 0.f;
#pragma unroll
    for (int j = 0; j < 16; ++j) { v[j] -= mean; s2 += v[j] * v[j]; }
    const float rstd = rsqrtf(wave_sum(s2) * (1.f / 1024.f) + LN_EPS);
#pragma unroll
    for (int j = 0; j < 16; ++j) { const int c = lane + 64 * j; const float y = v[j] * rstd * B.ln1_g[c] + B.ln1_b[c]; p[c] = y; xb[c] = f2bf(y); }
}
__global__ void __launch_bounds__(64) n_router(Bufs B) {
    const int tok = blockIdx.x * 64 + threadIdx.x;
    const bf16* xb = WSP(bf16, WS_X1B) + (size_t)tok * 1024; const bf16* wr = WSP(bf16, WS_WRT);
    float lg[32];
#pragma unroll
    for (int e = 0; e < 32; ++e) lg[e] = 0.f;
    for (int k = 0; k < 1024; ++k) { const float xv = bf2f(xb[k]);
#pragma unroll
        for (int e = 0; e < 32; ++e) lg[e] += xv * bf2f(wr[e * 1024 + k]); }
#pragma unroll
    for (int e = 0; e < 32; ++e) lg[e] += B.b_router[e];
    int se[4]; float sv[4];
#pragma unroll
    for (int kk = 0; kk < 4; ++kk) { float best = -INFINITY; int bi = 0;
#pragma unroll
        for (int e = 0; e < 32; ++e) { if (lg[e] > best) { best = lg[e]; bi = e; } }
        se[kk] = bi; sv[kk] = best;
#pragma unroll
        for (int e = 0; e < 32; ++e) if (e == bi) lg[e] = -INFINITY; }
    const float e1 = __expf(sv[1] - sv[0]), e2 = __expf(sv[2] - sv[0]), e3 = __expf(sv[3] - sv[0]); const float inv = 1.f / (1.f + e1 + e2 + e3);
    const float w[4] = {inv, e1 * inv, e2 * inv, e3 * inv};
    unsigned* cnt = WSP(unsigned, WS_CTL) + CW_CNT;
#pragma unroll
    for (int kk = 0; kk < 4; ++kk) { WSP(int, WS_SELE)[tok * 4 + kk] = se[kk]; WSP(float, WS_SELW)[tok * 4 + kk] = w[kk];
        const unsigned pos = atomicAdd(cnt + 64 * se[kk], 1u);
        WSP(int, WS_ROWTK)[(size_t)se[kk] * CAP + pos] = tok * 4 + kk; WSP(float, WS_ROWW)[(size_t)se[kk] * CAP + pos] = w[kk]; }
}
__global__ void n_tstart(Bufs B) {
    if (threadIdx.x == 0 && blockIdx.x == 0) { int* ts = WSP(int, WS_TSTART); const unsigned* cnt = WSP(unsigned, WS_CTL) + CW_CNT; int acc = 0;
        for (int e = 0; e < NEXP; ++e) { ts[e] = acc; acc += (int)((cnt[64 * e] + 255u) >> 8); } ts[NEXP] = acc; }
}
struct MoeRow { int e, valid, tk; float w; };
__global__ void n_rowinfo(Bufs B) {
    const int* ts = WSP(int, WS_TSTART); const unsigned* cnt = WSP(unsigned, WS_CTL) + CW_CNT; MoeRow* ri = WSP(MoeRow, WS_RINFO);
    for (int m = blockIdx.x * blockDim.x + threadIdx.x; m < MAXROWS; m += gridDim.x * blockDim.x) {
        MoeRow r; const int rt = m >> 8; int e = 0;
        while (e < NEXP - 1 && rt >= ts[e + 1]) ++e;
        const int pos = m - 256 * ts[e];
        r.e = e; r.valid = (rt < ts[NEXP]) && (pos < (int)cnt[64 * e]);
        r.tk = r.valid ? WSP(int, WS_ROWTK)[(size_t)e * CAP + pos] : 0; r.w = r.valid ? WSP(float, WS_ROWW)[(size_t)e * CAP + pos] : 0.f; ri[m] = r; }
}
struct AF_gather { Bufs B; __device__ bool active(int m0) const { return (m0 >> 8) < WSP(int, WS_TSTART)[NEXP]; }
    __device__ float operator()(int m, int k) const { const int tk = WSP(MoeRow, WS_RINFO)[m].tk; return bf2f(WSP(bf16, WS_X1B)[(size_t)(tk >> 2) * 1024 + k]); } };
struct BF_gu { Bufs B; __device__ float operator()(int m0, int k, int n, int which) const { const int e = WSP(MoeRow, WS_RINFO)[m0].e;
        const int ct = n >> 7, i = n & 127; return bf2f(WSP(bf16, WS_WGUT)[((size_t)e * 2048 + 256 * ct + 128 * which + i) * 1024 + k]); } };
__device__ __forceinline__ float moe_act(float g, float u) {
    g = fminf(g, 7.0f); u = fminf(fmaxf(u, -7.0f), 7.0f); const float glu = g * (1.0f / (1.0f + __expf(-1.702f * g))); return (u + 1.0f) * glu; }
struct EF_gu { Bufs B; __device__ void operator()(int m, int n, const float (&v)[2]) const { const MoeRow r = WSP(MoeRow, WS_RINFO)[m]; if (!r.valid) return;
        const float g = v[0] + B.b_gu[r.e * 2048 + n], u = v[1] + B.b_gu[r.e * 2048 + 1024 + n]; WSP(bf16, WS_ACT)[(size_t)m * 1024 + n] = f2bf(moe_act(g, u)); } };
struct AF_act { Bufs B; __device__ bool active(int m0) const { return (m0 >> 8) < WSP(int, WS_TSTART)[NEXP]; }
    __device__ float operator()(int m, int k) const { return WSP(MoeRow, WS_RINFO)[m].valid ? bf2f(WSP(bf16, WS_ACT)[(size_t)m * 1024 + k]) : 0.f; } };
struct BF_dn { Bufs B; __device__ float operator()(int m0, int k, int n, int) const { const int e = WSP(MoeRow, WS_RINFO)[m0].e; return bf2f(WSP(bf16, WS_WDT)[((size_t)e * 1024 + n) * 1024 + k]); } };
struct EF_dn { Bufs B; __device__ void operator()(int m, int n, const float (&v)[1]) const { const MoeRow r = WSP(MoeRow, WS_RINFO)[m]; if (!r.valid) return;
        WSP(bf16, WS_OUTR)[(size_t)r.tk * 1024 + n] = f2bf((v[0] + B.b_dn[r.e * 1024 + n]) * r.w); } };
__global__ void __launch_bounds__(256) n_final(Bufs B) {
    const int row = blockIdx.x * 4 + (threadIdx.x >> 6), lane = threadIdx.x & 63;
    float* p = B.out + (size_t)row * 1024; const bf16* orow = WSP(bf16, WS_OUTR) + (size_t)row * 4 * 1024;
    float v[16]; float s = 0.f;
#pragma unroll
    for (int j = 0; j < 16; ++j) { const int c = lane + 64 * j; float a = DN_ALPHA * bf2f(WSP(bf16, WS_X1B)[(size_t)row * 1024 + c]);
#pragma unroll
        for (int kk = 0; kk < 4; ++kk) a += bf2f(orow[kk * 1024 + c]);
        v[j] = a; s += a; }
    const float mean = wave_sum(s) * (1.f / 1024.f); float s2 = 0.f;
#pragma unroll
    for (int j = 0; j < 16; ++j) { v[j] -= mean; s2 += v[j] * v[j]; }
    const float rstd = rsqrtf(wave_sum(s2) * (1.f / 1024.f) + LN_EPS);
#pragma unroll
    for (int j = 0; j < 16; ++j) { const int c = lane + 64 * j; p[c] = v[j] * rstd * B.ln2_g[c] + B.ln2_b[c]; }
}

__device__ __forceinline__ int lane_id() { int l; asm volatile("v_mbcnt_lo_u32_b32 %0, -1, 0\n\tv_mbcnt_hi_u32_b32 %0, -1, %0" : "=v"(l)); return l; }
namespace pg8 {
#define PG8_LAS __attribute__((address_space(3)))
constexpr int BM = 256, BK = 64, HALF = 128, HTB = HALF * BK * 2  , STAGE_BYTES = 8 * HTB, NXCD = 8, WGM = 8;
__host__ __device__ __forceinline__ int lds_byte(int r, int c) { const int st = (r >> 4) * 2 + (c >> 5), rr = r & 15, cc = c & 31, ob = rr * 64 + cc * 2; return st * 1024 + (ob ^ (((ob >> 9) & 1) << 5)); }
__host__ __device__ __forceinline__ void stage_rc(int b, int& R, int& C) { const int st = b / 1024, sb = b % 1024, swz = sb ^ (((sb >> 9) & 1) << 5); R = (st >> 1) * 16 + swz / 64; C = (st & 1) * 32 + (swz % 64) / 2; }
__host__ __device__ __forceinline__ int perm32(int rho) { const int n = rho >> 4, i = rho & 15; return 8 * (i >> 2) + 4 * n + (i & 3); }

typedef int v8i_t __attribute__((ext_vector_type(8)));
typedef int v4i_t __attribute__((ext_vector_type(4)));
struct Unit { int pm, pn, e, idx, rbase, nrows; };

struct StaticOrder {
    const char* A; const char* Bt; int nM, nN, nwg, G, c, rb;
    __device__ void init(const void* A_, const void* Bt_, int M, int N, int K_, int G_, int c_, int eb = 2) { A = (const char*)A_; Bt = (const char*)Bt_; nM = M / BM; nN = N / BM; nwg = nM * nN; G = G_; c = c_; rb = K_ * eb; }
    __device__ bool next(int i, Unit& u) const {
        const long L = (long)i * G + c; if (L >= nwg) return false;
        int wgid = (int)L; { const int q = nwg / NXCD, r = nwg % NXCD, xcd = wgid % NXCD, off = wgid / NXCD; wgid = (xcd < r ? xcd * (q + 1) : r * (q + 1) + (xcd - r) * q) + off; }
        const int nig = WGM * nN, gid = wgid / nig, fm = gid * WGM, gsz = (nM - fm) < WGM ? (nM - fm) : WGM;
        u.pm = fm + ((wgid % nig) % gsz); u.pn = (wgid % nig) / gsz; u.e = 0; u.idx = i; u.rbase = u.pm * BM; u.nrows = BM; return true;
    }
    __device__ __forceinline__ const char* a_ptr(const Unit& u) const { return A + (size_t)u.pm * BM * rb; }
    __device__ __forceinline__ const char* b_ptr(const Unit& u) const { return Bt + (size_t)u.pn * BM * rb; }
    __device__ __forceinline__ unsigned a_off(const Unit&, int) const { return 0u; }
    __device__ __forceinline__ void a_ready(const Unit&) const {}
    __device__ __forceinline__ void done(const Unit&) const {}
};

__device__ __forceinline__ unsigned cvt_pk_bf16(float lo, float hi) { unsigned r; asm volatile("v_cvt_pk_bf16_f32 %0, %1, %2" : "=v"(r) : "v"(lo), "v"(hi)); return r; }

__device__ __forceinline__ void mfma8_inplace(f32x4& acc, const v8i_t& w8, const v8i_t& a8, int sc_w, int sc_a) {
    asm volatile("v_mfma_scale_f32_16x16x128_f8f6f4 %0, %1, %2, %0, %3, %4 op_sel_hi:[0,0,0]" : "+v"(acc) : "v"(w8), "v"(a8), "v"(sc_w), "v"(sc_a)); }
__device__ __forceinline__ void mfma8_first(f32x4& acc, const v8i_t& w8, const v8i_t& a8, int sc_w, int sc_a) {
    asm volatile("v_mfma_scale_f32_16x16x128_f8f6f4 %0, %1, %2, 0, %3, %4 op_sel_hi:[0,0,0]" : "=&v"(acc) : "v"(w8), "v"(a8), "v"(sc_w), "v"(sc_a)); }
template <class Epi, class Sched, bool ALIGN_EPI, bool GATHER, bool FP8 = false>
__device__ __forceinline__ void gemm_phase(PG8_LAS unsigned char* lds, const int K, const Sched& S, const Epi& E, const int wid) {
    int lane_ = lane_id(); asm volatile("" : "+v"(lane_));
    const int lane = lane_, tid = wid * 64 + lane, wr = wid >> 2, wc = wid & 3, fr = lane & 15, fq = lane >> 4;
    constexpr int EB = FP8 ? 1 : 2;
    const int nt = K * EB / 128;
    unsigned voffB[2];
#pragma unroll
    for (int i = 0; i < 2; ++i) { int R, C; stage_rc(tid * 16 + i * 8192, R, C); const int Rb = Epi::PERM ? ((R & ~31) + perm32(R & 31)) : R;
        voffB[i] = (unsigned)(Rb * K * EB + C * 2); }
    const size_t kstep = (size_t)(BK * 2);
    const size_t hstep = (size_t)HALF * K * EB;
    const unsigned ldsw = (unsigned)wid * 1024u;
    const int aoff = lds_byte(wr * 64 + fr, fq * 8), boff = lds_byte(wc * 32 + fr, fq * 8);
#define PG8_SA(b, h) (((b) * 2 + (h)) * HTB)
#define PG8_SB(b, h) ((4 + (b) * 2 + (h)) * HTB)
#define PG8_STAGE(bufoff, gbase, voff) do { _Pragma("unroll") for (int _i = 0; _i < 2; ++_i) \
        __builtin_amdgcn_global_load_lds((const unsigned*)((const char*)(gbase) + (voff)[_i]), (PG8_LAS unsigned*)(lds + (bufoff) + ldsw + _i * 8192), 16, 0, 0); } while (0)
#define PG8_LD8(base) __builtin_shufflevector(*(const PG8_LAS v4i_t*)(lds + (base)), *(const PG8_LAS v4i_t*)(lds + (base) + 1024), 0, 1, 2, 3, 4, 5, 6, 7)
#define PG8_LDA(dst, b, h) do { _Pragma("unroll") for (int m = 0; m < 4; ++m) { if constexpr (FP8) dst##8[m] = PG8_LD8(PG8_SA(b, h) + aoff + m * 2048); else { _Pragma("unroll") for (int k = 0; k < 2; ++k) dst[m][k] = *(const PG8_LAS bf16x8*)(lds + PG8_SA(b, h) + aoff + m * 2048 + k * 1024); } } } while (0)
#define PG8_LDB(dst, b, h) do { _Pragma("unroll") for (int n = 0; n < 2; ++n) { if constexpr (FP8) dst##8[n] = PG8_LD8(PG8_SB(b, h) + boff + n * 2048); else { _Pragma("unroll") for (int k = 0; k < 2; ++k) dst[n][k] = *(const PG8_LAS bf16x8*)(lds + PG8_SB(b, h) + boff + n * 2048 + k * 1024); } } } while (0)
#define PG8_MMA(ai, bj, At, Bt) do { __builtin_amdgcn_s_setprio(1); _Pragma("unroll") for (int m = 0; m < 4; ++m) _Pragma("unroll") for (int n = 0; n < 2; ++n) { \
        if constexpr (FP8) mfma8_inplace(acc[ai][bj][m][n], Bt##8[n], At##8[m], sc_w, sc_a); \
        else { _Pragma("unroll") for (int k = 0; k < 2; ++k) acc[ai][bj][m][n] = __builtin_amdgcn_mfma_f32_16x16x32_bf16(Bt[n][k], At[m][k], acc[ai][bj][m][n], 0, 0, 0); } } \
        __builtin_amdgcn_s_setprio(0); } while (0)
#define PG8_MMA_Z(ai, bj, At, Bt) do { __builtin_amdgcn_s_setprio(1); _Pragma("unroll") for (int m = 0; m < 4; ++m) _Pragma("unroll") for (int n = 0; n < 2; ++n) { \
        if constexpr (FP8) mfma8_first(acc[ai][bj][m][n], Bt##8[n], At##8[m], sc_w, sc_a); \
        else { acc[ai][bj][m][n] = __builtin_amdgcn_mfma_f32_16x16x32_bf16(Bt[n][0], At[m][0], (f32x4){0.f, 0.f, 0.f, 0.f}, 0, 0, 0); \
               acc[ai][bj][m][n] = __builtin_amdgcn_mfma_f32_16x16x32_bf16(Bt[n][1], At[m][1], acc[ai][bj][m][n], 0, 0, 0); } } \
        __builtin_amdgcn_s_setprio(0); } while (0)
#define PG8_WAIT_V(n) asm volatile("s_waitcnt vmcnt(" #n ")" ::: "memory")
#define PG8_WAIT_L(n) asm volatile("s_waitcnt lgkmcnt(" #n ")" ::: "memory")
#define PG8_BAR __builtin_amdgcn_s_barrier()
#define PG8_SCHED __builtin_amdgcn_sched_barrier(0)
#define PG8_OFFS(dst, u) do { const int _t = wid * 64 + lane_id(); _Pragma("unroll") for (int _i = 0; _i < 2; ++_i) { int _R, _C; stage_rc(_t * 16 + _i * 8192, _R, _C); \
        _Pragma("unroll") for (int _h = 0; _h < 2; ++_h) dst[_h][_i] = GATHER ? (S.a_off(u, _h * HALF + _R) + (unsigned)_C * 2u) : (unsigned)((_h * HALF + _R) * K * EB + _C * 2); } } while (0)
    Unit cur, nxt; int ui = 0;
    if (!S.next(0, cur)) return;
    f32x4 acc[2][2][4][2];
    const int sc_w = 0x7F7F7F7F, sc_a = sc_w;
    bf16x8 At[4][2], B0[2][2], B1[2][2]; v8i_t At8[4], B08[2], B18[2];
    unsigned offA[2][2];
    PG8_OFFS(offA, cur);
    const char* cA = S.a_ptr(cur); const char* cB = S.b_ptr(cur);
    S.a_ready(cur);
    PG8_STAGE(PG8_SB(0, 0), cB, voffB); PG8_STAGE(PG8_SB(0, 1), cB + hstep, voffB); PG8_STAGE(PG8_SA(0, 0), cA, offA[0]); PG8_STAGE(PG8_SA(0, 1), cA, offA[1]);
    if (wr == 1) PG8_BAR;
    PG8_WAIT_V(2); PG8_BAR;
    PG8_STAGE(PG8_SB(1, 0), cB + kstep, voffB); PG8_STAGE(PG8_SA(1, 0), cA + kstep, offA[0]); PG8_STAGE(PG8_SB(1, 1), cB + hstep + kstep, voffB);
    constexpr bool DEFER = Epi::NST > 0;
    if constexpr (DEFER) { PG8_STAGE(PG8_SA(1, 1), cA + kstep, offA[1]); PG8_WAIT_V(0); } else { PG8_WAIT_V(6); }
    PG8_BAR;
    constexpr int WF = 8 + Epi::NST;
#define PG8_WAIT_F() do { if (DEFER && t == 0) asm volatile("s_waitcnt vmcnt(%0)" :: "n"(WF) : "memory"); else PG8_WAIT_V(8); } while (0)
    for (;;) {
        const bool has_next = S.next(ui + 1, nxt);
        const char* nA = has_next ? S.a_ptr(nxt) : cA; const char* nB = has_next ? S.b_ptr(nxt) : cB;
        unsigned o2[2][2];
        for (int t = 0; t < nt; t += 2) {
            const bool last = (t == nt - 2);
            const char* a1 = cA + (size_t)(t + 1) * kstep;
            const char* a2 = last ? nA : cA + (size_t)(t + 2) * kstep; const char* b2 = last ? nB : cB + (size_t)(t + 2) * kstep;
            const char* a3 = a2 + kstep; const char* b3 = b2 + kstep;
            if (GATHER && last && has_next) { PG8_OFFS(o2, nxt); }
            else {
#pragma unroll
                for (int h = 0; h < 2; ++h)
#pragma unroll
                    for (int i = 0; i < 2; ++i) o2[h][i] = offA[h][i]; }
            if (last && has_next) S.a_ready(nxt);
            PG8_LDB(B0, 0, 0); PG8_LDB(B1, 0, 1); PG8_SCHED; PG8_LDA(At, 0, 0); if (!DEFER || t != 0) PG8_STAGE(PG8_SA(1, 1), a1, offA[1]);
            PG8_WAIT_F(); PG8_WAIT_L(0); PG8_BAR; if (t == 0) { PG8_MMA_Z(0, 0, At, B0); PG8_MMA_Z(0, 1, At, B1); } else { PG8_MMA(0, 0, At, B0); PG8_MMA(0, 1, At, B1); } PG8_BAR; PG8_SCHED;
            PG8_LDA(At, 0, 1); PG8_STAGE(PG8_SB(0, 0), b2, voffB); PG8_STAGE(PG8_SB(0, 1), b2 + hstep, voffB); PG8_STAGE(PG8_SA(0, 0), a2, o2[0]);
            PG8_WAIT_F(); PG8_WAIT_L(0); PG8_BAR; if (t == 0) { PG8_MMA_Z(1, 0, At, B0); PG8_MMA_Z(1, 1, At, B1); } else { PG8_MMA(1, 0, At, B0); PG8_MMA(1, 1, At, B1); } PG8_BAR; PG8_SCHED;
            PG8_LDB(B0, 1, 0); PG8_LDB(B1, 1, 1); PG8_SCHED; PG8_LDA(At, 1, 0); PG8_STAGE(PG8_SA(0, 1), a2, o2[1]);
            PG8_WAIT_F(); PG8_WAIT_L(0); PG8_BAR; PG8_MMA(0, 0, At, B0); PG8_MMA(0, 1, At, B1); PG8_BAR; PG8_SCHED;
            PG8_LDA(At, 1, 1); PG8_STAGE(PG8_SB(1, 0), b3, voffB); PG8_STAGE(PG8_SB(1, 1), b3 + hstep, voffB); PG8_STAGE(PG8_SA(1, 0), a3, o2[0]);
            PG8_WAIT_V(8); PG8_WAIT_L(0); PG8_BAR; PG8_MMA(1, 0, At, B0); PG8_MMA(1, 1, At, B1); PG8_BAR; PG8_SCHED;
        }
        if constexpr (DEFER) { if constexpr (GATHER) { PG8_STAGE(PG8_SA(1, 1), nA + kstep, o2[1]); } else { PG8_STAGE(PG8_SA(1, 1), nA + kstep, offA[1]); }
            asm volatile("" ::: "memory"); PG8_SCHED; }
        if constexpr (ALIGN_EPI) { if (wr == 0) PG8_BAR; }
        if constexpr (FP8) asm volatile("s_nop 15\n\ts_nop 15" ::: "memory");
        { const int l2 = lane_id();
          E(acc, cur, wr, wc, l2 & 15, l2 >> 4); } S.done(cur);
        if (!has_next) break;
        cur = nxt; cA = nA; cB = nB; ++ui;
        if (GATHER) { PG8_OFFS(offA, cur); }
        if constexpr (ALIGN_EPI) { if (wr == 1) PG8_BAR; }
    }
    PG8_WAIT_V(0);
    if constexpr (!ALIGN_EPI) { if (wr == 0) PG8_BAR; }
    PG8_BAR;
#undef PG8_SA
#undef PG8_SB
#undef PG8_STAGE
#undef PG8_LDA
#undef PG8_LD8
#undef PG8_LDB
#undef PG8_MMA
#undef PG8_MMA_Z
#undef PG8_WAIT_V
#undef PG8_WAIT_L
#undef PG8_WAIT_F
#undef PG8_BAR
#undef PG8_SCHED
#undef PG8_OFFS
}
}

namespace pg8 {
#ifndef EPI_NT
#define EPI_NT 1
#endif
__device__ __forceinline__ void st16(const void* p_, const u32x4 v) {
#if EPI_NT
    __builtin_nontemporal_store(v, (u32x4*)p_);
#else
    *(u32x4*)p_ = v;
#endif
}
}
namespace pg8 {
__device__ __forceinline__ float fsigmoid(float x) { return __builtin_amdgcn_rcpf(1.0f + __builtin_amdgcn_exp2f(-LOG2E * x)); }
__device__ __forceinline__ u32x4 pack8(const f32x4 a, const f32x4 b) { u32x4 w; w.x = cvt_pk_bf16(a[0], a[1]); w.y = cvt_pk_bf16(a[2], a[3]); w.z = cvt_pk_bf16(b[0], b[1]); w.w = cvt_pk_bf16(b[2], b[3]); return w; }
__device__ __forceinline__ void unpack8(const u32x4 w, f32x4& a, f32x4& b) {
    a[0] = __uint_as_float(w.x << 16); a[1] = __uint_as_float(w.x & 0xffff0000u); a[2] = __uint_as_float(w.y << 16); a[3] = __uint_as_float(w.y & 0xffff0000u);
    b[0] = __uint_as_float(w.z << 16); b[1] = __uint_as_float(w.z & 0xffff0000u); b[2] = __uint_as_float(w.w << 16); b[3] = __uint_as_float(w.w & 0xffff0000u); }

struct EpiQK {
    static constexpr bool PERM = true; static constexpr int NST = 16;
    bf16 *qsb, *ksb;
    __device__ __forceinline__ void operator()(const f32x4 (&acc)[2][2][4][2], const Unit& u, int wr, int wc, int fr, int fq) const {
        const int pn = u.pn;
        if (pn < 4) {
            const bf16* ub = qsb + ((size_t)(u.pm * BM + wr * 64)) * 1024 + pn * 256 + wc * 32; const int lo = fr * 1024 + 8 * fq;
#pragma unroll
            for (int ai = 0; ai < 2; ++ai)
#pragma unroll
                for (int m = 0; m < 4; ++m)
#pragma unroll
                    for (int bj = 0; bj < 2; ++bj) st16(ub + (ai * HALF + m * 16) * 1024 + bj * HALF + lo, pack8(acc[ai][bj][m][0] * (SB_C2 * IN_DS), acc[ai][bj][m][1] * (SB_C2 * IN_DS)));
        } else {
            const int t0 = (u.pm * BM) & (SEQ - 1), b = (u.pm * BM) >> 13;
            const bf16* ub = ksb + ((((size_t)(b * 16 + 4 * (pn & 3) + (wc >> 1)) * 256 + (t0 >> 5) + 2 * wr) * 4 + 2 * (wc & 1)) * 512);
            const int lo = (fq >> 1) * 512 + fr * 16 + 8 * (fq & 1);
#pragma unroll
            for (int ai = 0; ai < 2; ++ai)
#pragma unroll
                for (int m = 0; m < 4; ++m)
#pragma unroll
                    for (int bj = 0; bj < 2; ++bj) st16(ub + (size_t)(2 * bj) * 256 * 2048 + (4 * ai + (m >> 1)) * 2048 + (m & 1) * 256 + lo, pack8(acc[ai][bj][m][0] * IN_DS, acc[ai][bj][m][1] * IN_DS));
        }
    }
};
struct EpiRot {
    static constexpr bool PERM = true; static constexpr int NST = 16;
    bf16 *qr, *kr, *krt, *qrs; const float *cosT, *sinT; float ds_;
    __device__ __forceinline__ void operator()(const f32x4 (&acc)[2][2][4][2], const Unit& u, int wr, int wc, int fr, int fq) const {
        const int pn = u.pn; const bool isK = pn >= 4; const int head = pn & 3; const float sc = (isK ? 1.0f : 0.0625f) * ds_;
        const int R0 = u.pm * BM, P0 = R0 & (SEQ - 1), bh = (R0 >> 13) * 4 + head;
        f32x4 c[2], sn[2], dc[2], ds[2], ec[2], es[2];
        { const int tlo = fr * 128 + 8 * fq; const float* cb = cosT + (size_t)(P0 + 64 * wr) * 128 + 32 * wc; const float* sb = sinT + (size_t)(P0 + 64 * wr) * 128 + 32 * wc;
          const float* c16 = cosT + 16 * 128 + 32 * wc; const float* s16 = sinT + 16 * 128 + 32 * wc; const float* c80 = cosT + 80 * 128 + 32 * wc; const float* s80 = sinT + 80 * 128 + 32 * wc;
#pragma unroll
          for (int n = 0; n < 2; ++n) { c[n] = *(const f32x4*)(cb + tlo + 4 * n); sn[n] = *(const f32x4*)(sb + tlo + 4 * n);
              dc[n] = *(const f32x4*)(c16 + 8 * fq + 4 * n); ds[n] = *(const f32x4*)(s16 + 8 * fq + 4 * n); ec[n] = *(const f32x4*)(c80 + 8 * fq + 4 * n); es[n] = *(const f32x4*)(s80 + 8 * fq + 4 * n); } }
        bf16* on = (isK ? kr : qr) + (size_t)(R0 + 64 * wr) * 1024 + head * 256 + 32 * wc; const int lo_n = fr * 1024 + 8 * fq;
        bf16* oq = qrs + (((size_t)bh * 128 + (P0 >> 6) + wr) * 16 + 2 * wc) * 1024; const int lo_q = (fq >> 1) * 1024 + fr * 16 + 8 * (fq & 1);
        bf16* ok = krt + (((size_t)bh * 128 + (P0 >> 6) + wr) * 4) * 4096 + 32 * wc * 16; const int lo_k = 8 * fq * 16 + fr;
#pragma unroll
        for (int ai = 0; ai < 2; ++ai)
#pragma unroll
            for (int m = 0; m < 4; ++m) {
                f32x4 o1[2], o2[2];
#pragma unroll
                for (int n = 0; n < 2; ++n) { const f32x4 x1 = acc[ai][0][m][n], x2 = acc[ai][1][m][n]; o1[n] = (x1 * c[n] - x2 * sn[n]) * sc; o2[n] = (x1 * sn[n] + x2 * c[n]) * sc; }
                if (m < 3) {
#pragma unroll
                    for (int n = 0; n < 2; ++n) { const f32x4 cc = c[n] * dc[n] - sn[n] * ds[n]; sn[n] = sn[n] * dc[n] + c[n] * ds[n]; c[n] = cc; } }
                else if (ai == 0) {
#pragma unroll
                    for (int n = 0; n < 2; ++n) { const f32x4 cc = c[n] * ec[n] - sn[n] * es[n]; sn[n] = sn[n] * ec[n] + c[n] * es[n]; c[n] = cc; } }
                const u32x4 w1 = pack8(o1[0], o1[1]), w2 = pack8(o2[0], o2[1]);
                if (isK) { st16(on + (ai * HALF + m * 16) * 1024 + lo_n, w1); st16(on + (ai * HALF + m * 16) * 1024 + HALF + lo_n, w2); }
                if (isK) {
                    extern __shared__ __attribute__((aligned(16))) unsigned char lds_epi_[];
                    PG8_LAS unsigned char* t1 = (PG8_LAS unsigned char*)lds_epi_ + (131072 + 1024) + (wr * 4 + wc) * 2560; PG8_LAS unsigned char* t2 = t1 + 1280;
                    const int wo = 8 * fq * 40 + fr * 2, ln = fq * 16 + fr, ro = (ln >> 1) * 40 + (ln & 1) * 16;
#pragma unroll
                    for (int q = 0; q < 4; ++q) { *(PG8_LAS bf16*)(t1 + wo + (2 * q) * 40) = (bf16)(w1[q] & 0xffffu); *(PG8_LAS bf16*)(t1 + wo + (2 * q + 1) * 40) = (bf16)(w1[q] >> 16);
                        *(PG8_LAS bf16*)(t2 + wo + (2 * q) * 40) = (bf16)(w2[q] & 0xffffu); *(PG8_LAS bf16*)(t2 + wo + (2 * q + 1) * 40) = (bf16)(w2[q] >> 16); }
                    const u32x2 a1 = *(const PG8_LAS u32x2*)(t1 + ro), b1 = *(const PG8_LAS u32x2*)(t1 + ro + 8), a2 = *(const PG8_LAS u32x2*)(t2 + ro), b2 = *(const PG8_LAS u32x2*)(t2 + ro + 8);
                    bf16* blk = ok + (2 * ai * 4 + m) * 4096 + ln * 8;
                    st16(blk, (u32x4){a1.x, a1.y, b1.x, b1.y}); st16(blk + HALF * 16, (u32x4){a2.x, a2.y, b2.x, b2.y});
                } else {
                    st16(oq + (2 * ai * 16) * 1024 + m * 256 + lo_q, w1); st16(oq + (2 * ai * 16 + 8) * 1024 + m * 256 + lo_q, w2); }
                asm volatile("" ::: "memory"); }
    }
};
struct EpiGate {
    static constexpr bool PERM = true; static constexpr int NST = 16;
    unsigned char* ws;
    __device__ __forceinline__ void operator()(const f32x4 (&acc)[2][2][4][2], const Unit& u, int wr, int wc, int fr, int fq) const {
        const int pn = u.pn; const int R0 = u.pm * BM, P0 = R0 & (SEQ - 1); const bool silu = pn < 8;
        const size_t ub_s = WS_SG + 2 * ((((size_t)((R0 >> 13) * 4 + (pn >> 1)) * 128 + (P0 >> 6) + wr) * 64 + 32 * (pn & 1) + 4 * wc) * 512);
        const size_t ub_g = WS_GSB + (size_t)(pn >= 12 ? 1 : 0) * (WS_GRET - WS_GSB) + 2 * ((size_t)(R0 + 64 * wr) * 1024 + (pn & 3) * 256 + 32 * wc);
        bf16* ub = (bf16*)(ws + (silu ? ub_s : ub_g));
        const int lo = silu ? fq * 512 + fr * 8 : fr * 1024 + 8 * fq;
        const int SA = silu ? 128 * 512 : HALF * 1024, SM = silu ? 128 : 16 * 1024, SB = silu ? 16 * 512 : HALF;
#pragma unroll
        for (int ai = 0; ai < 2; ++ai)
#pragma unroll
            for (int m = 0; m < 4; ++m) {
#pragma unroll
                for (int bj = 0; bj < 2; ++bj) { f32x4 a, b;
#pragma unroll
                    for (int h = 0; h < 4; ++h) { typedef float f32x2_t __attribute__((ext_vector_type(2)));
                        const f32x4& src = acc[ai][bj][m][h >> 1]; const int e0 = 2 * (h & 1);
                        const f32x2_t x = (f32x2_t){src[e0], src[e0 + 1]} * IN_DS, z = x * (-LOG2E);
                        f32x2_t ex; ex.x = __builtin_amdgcn_exp2f(z.x); ex.y = __builtin_amdgcn_exp2f(z.y);
                        const f32x2_t dn = ex + 1.0f; f32x2_t sg; sg.x = __builtin_amdgcn_rcpf(dn.x); sg.y = __builtin_amdgcn_rcpf(dn.y);
                        const f32x2_t pr = x * sg; const float r0 = silu ? pr.x : sg.x, r1 = silu ? pr.y : sg.y;
                        if (h < 2) { a[e0] = r0; a[e0 + 1] = r1; } else { b[e0] = r0; b[e0 + 1] = r1; } }
                    st16(ub + ai * SA + m * SM + bj * SB + lo, pack8(a, b));
                    asm volatile("" ::: "memory"); } }
    }
};
struct EpiVT {
    static constexpr bool PERM = true; static constexpr int NST = 16;
    bf16 *vsbt, *vrt;
    __device__ __forceinline__ void operator()(const f32x4 (&acc)[2][2][4][2], const Unit& u, int wr, int wc, int fr, int fq) const {
        const int pm = u.pm; const int C0 = u.pn * BM, T0 = C0 & (SEQ - 1), b = C0 >> 13;
        if (pm < 4) {
            bf16* ub = vsbt + ((((size_t)(b * 16 + 4 * pm + wr) * 512 + (T0 >> 4) + 2 * wc) * 64) * 16); const int lo = ((fq >> 1) * 64 + fr) * 16 + 8 * (fq & 1);
#pragma unroll
            for (int ai = 0; ai < 2; ++ai)
#pragma unroll
                for (int m = 0; m < 4; ++m)
#pragma unroll
                    for (int bj = 0; bj < 2; ++bj) st16(ub + ((size_t)(2 * ai) * 512 * 64 + 8 * bj * 64 + 16 * m) * 16 + lo, pack8(acc[ai][bj][m][0] * IN_DS, acc[ai][bj][m][1] * IN_DS));
        } else {
            const int h = (pm - 4) >> 1; const float l2g = __builtin_amdgcn_logf(1.0f - __builtin_amdgcn_exp2f(-5.0f - (float)h));
            float dec[8];
#pragma unroll
            for (int q = 0; q < 8; ++q) dec[q] = __builtin_amdgcn_exp2f((float)(63 - (((wc & 1) * 32 + 8 * fq + q) & 63)) * l2g) * IN_DS;
            bf16* ub = vrt + (((((size_t)(b * 4 + h) * 128 + (T0 >> 6) + (wc >> 1)) * 4 + 2 * (wc & 1)) * 512 + 256 * ((pm - 4) & 1) + 64 * wr) * 16); const int lo = ((fq >> 1) * 512 + fr) * 16 + 8 * (fq & 1);
#pragma unroll
            for (int ai = 0; ai < 2; ++ai)
#pragma unroll
                for (int m = 0; m < 4; ++m)
#pragma unroll
                    for (int bj = 0; bj < 2; ++bj) { f32x4 a = acc[ai][bj][m][0], bb = acc[ai][bj][m][1];
#pragma unroll
                        for (int e = 0; e < 4; ++e) { a[e] *= dec[e]; bb[e] *= dec[4 + e]; }
                        st16(ub + ((size_t)(2 * bj) * 4 * 512 + 128 * ai + 16 * m) * 16 + lo, pack8(a, bb)); }
        }
    }
};
template <int MODE> struct EpiBranch {
    static constexpr bool PERM = true; static constexpr int NST = 16;
    const bf16* gate; const bf16* m1in; bf16* out;
    __device__ __forceinline__ void operator()(const f32x4 (&acc)[2][2][4][2], const Unit& u, int wr, int wc, int fr, int fq) const {
        const size_t uo = (size_t)(u.pm * BM + 64 * wr) * 1024 + u.pn * BM + 32 * wc; const int lo = fr * 1024 + 8 * fq;
        const bf16* gp = gate + uo; const bf16* mp = m1in + uo; bf16* op = out + uo;
#pragma unroll
        for (int ai = 0; ai < 2; ++ai) {
            u32x4 gv[4][2], mv[4][2];
#pragma unroll
            for (int m = 0; m < 4; ++m)
#pragma unroll
                for (int bj = 0; bj < 2; ++bj) { const int co = (ai * HALF + m * 16) * 1024 + bj * HALF + lo; gv[m][bj] = *(const u32x4*)(gp + co); if (MODE == 1) mv[m][bj] = *(const u32x4*)(mp + co); }
#pragma unroll
            for (int m = 0; m < 4; ++m)
#pragma unroll
                for (int bj = 0; bj < 2; ++bj) { const int co = (ai * HALF + m * 16) * 1024 + bj * HALF + lo; f32x4 ga, gb; unpack8(gv[m][bj], ga, gb);
                    f32x4 a = acc[ai][bj][m][0] * ga, b = acc[ai][bj][m][1] * gb;
                    if (MODE == 1) { f32x4 pa, pb; unpack8(mv[m][bj], pa, pb); a += pa; b += pb; }
                    *(u32x4*)(op + co) = pack8(a, b); }
            asm volatile("" ::: "memory"); }
    }
};
struct EpiPre {
    static constexpr bool PERM = true; static constexpr int NST = 16;
    const float* x; bf16* pre;
    __device__ __forceinline__ void operator()(const f32x4 (&acc)[2][2][4][2], const Unit& u, int wr, int wc, int fr, int fq) const {
        const size_t uo = (size_t)(u.pm * BM + 64 * wr) * 1024 + u.pn * BM + 32 * wc; const int lo = fr * 1024 + 8 * fq;
        const float* xp = x + uo; bf16* pp = pre + uo;
#pragma unroll
        for (int ai = 0; ai < 2; ++ai) {
            f32x4 xv[4][2][2];
#pragma unroll
            for (int m = 0; m < 4; ++m)
#pragma unroll
                for (int bj = 0; bj < 2; ++bj)
#pragma unroll
                    for (int n = 0; n < 2; ++n) xv[m][bj][n] = *(const f32x4*)(xp + (ai * HALF + m * 16) * 1024 + bj * HALF + 4 * n + lo);
#pragma unroll
            for (int m = 0; m < 4; ++m)
#pragma unroll
                for (int bj = 0; bj < 2; ++bj) *(u32x4*)(pp + (ai * HALF + m * 16) * 1024 + bj * HALF + lo) = (pack8(xv[m][bj][0] * DN_ALPHA + acc[ai][bj][m][0], xv[m][bj][1] * DN_ALPHA + acc[ai][bj][m][1]));
            asm volatile("" ::: "memory"); }
    }
};
struct EpiGateUp {
    static constexpr bool PERM = true; static constexpr int NST = 8;
    const float* bgu_; unsigned char* ws_m;
    __device__ __forceinline__ void operator()(const f32x4 (&acc)[2][2][4][2], const Unit& u, int wr, int wc, int fr, int fq) const {
        const float* bgu = bgu_; bf16* act = (bf16*)(ws_m + WS_ACT);
        const float* bp = bgu + (size_t)u.e * 2048 + u.pn * 128 + wc * 32 + 8 * fq;
        f32x4 bg[2], bu[2];
#pragma unroll
        for (int n = 0; n < 2; ++n) { bg[n] = *(const f32x4*)(bp + 4 * n); bu[n] = *(const f32x4*)(bp + 1024 + 4 * n); }
        const int lo = fr * 1024 + 8 * fq;
#pragma unroll
        for (int ai = 0; ai < 2; ++ai)
#pragma unroll
            for (int m = 0; m < 4; ++m) { const int rr = ai * HALF + wr * 64 + m * 16 + fr;
                f32x4 o[2];
#pragma unroll
                for (int n = 0; n < 2; ++n) {
#pragma unroll
                    for (int e = 0; e < 4; e += 2) {
                        typedef float f32x2_t __attribute__((ext_vector_type(2)));
                        const f32x2_t a_g = {acc[ai][0][m][n][e], acc[ai][0][m][n][e + 1]}, a_u = {acc[ai][1][m][n][e], acc[ai][1][m][n][e + 1]};
                        const f32x2_t b_g = {bg[n][e], bg[n][e + 1]}, b_u = {bu[n][e], bu[n][e + 1]};
                        const f32x2_t g2 = a_g * MOE_DESCALE + b_g, u2 = a_u * MOE_DESCALE + b_u;
                        f32x2_t gg, uu; gg.x = fminf(g2.x, 7.0f); gg.y = fminf(g2.y, 7.0f); uu.x = __builtin_amdgcn_fmed3f(u2.x, -7.0f, 7.0f); uu.y = __builtin_amdgcn_fmed3f(u2.y, -7.0f, 7.0f);
                        const f32x2_t z = gg * (-1.702f * LOG2E);
                        f32x2_t ex; ex.x = __builtin_amdgcn_exp2f(z.x); ex.y = __builtin_amdgcn_exp2f(z.y);
                        const f32x2_t dn = ex + 1.0f;
                        f32x2_t rc; rc.x = __builtin_amdgcn_rcpf(dn.x); rc.y = __builtin_amdgcn_rcpf(dn.y);
                        const f32x2_t r2 = ((uu + 1.0f) * gg) * rc;
                        o[n][e] = r2.x; o[n][e + 1] = r2.y; } }
                {
#if MOE_FP8
                    u32x2 w8; w8.x = pk4_fp8(o[0][0], o[0][1], o[0][2], o[0][3]); w8.y = pk4_fp8(o[1][0], o[1][1], o[1][2], o[1][3]);
                    *(u32x2*)((unsigned char*)act + (size_t)(u.rbase + 64 * wr) * 1024 + u.pn * 128 + wc * 32 + (ai * HALF + m * 16) * 1024 + lo) = w8;
#else
                    st16(act + (size_t)(u.rbase + 64 * wr) * 1024 + u.pn * 128 + wc * 32 + (ai * HALF + m * 16) * 1024 + lo, pack8(o[0], o[1]));
#endif
                } }
    }
};
struct EpiDown {
    static constexpr bool PERM = true; static constexpr int NST = 16;
    unsigned char* ws_m; const float* bdn_;
    __device__ __forceinline__ void operator()(const f32x4 (&acc)[2][2][4][2], const Unit& u, int wr, int wc, int fr, int fq) const {
        unsigned char* ws_ = ws_m; const float* bdn = bdn_;
        const unsigned colb = (unsigned)(u.pn * BM + wc * 32 + 8 * fq) * 2u;
        const unsigned char* bp = (const unsigned char*)(bdn + (size_t)u.e * 1024);
        const unsigned lb = (unsigned)(u.e * CAP + u.pm + wr * 64 + fr) * 4u;
        const unsigned char* rowtk = ws_ + WS_ROWTK; const unsigned char* roww = ws_ + WS_ROWW; unsigned char* outr = ws_ + WS_OUTR;
        constexpr unsigned TRASH = (unsigned)(WS_RINFO - WS_OUTR);
        unsigned ro[2][4]; float w[2][4]; f32x4 bv[2][2];
#pragma unroll
        for (int ai = 0; ai < 2; ++ai)
#pragma unroll
            for (int m = 0; m < 4; ++m) { const int rr = ai * HALF + wr * 64 + m * 16 + fr; const bool v = rr < u.nrows;
                const unsigned lo_ = lb + (unsigned)(ai * HALF + m * 16) * 4u;
                const int tkv = *(const int*)(rowtk + lo_); w[ai][m] = *(const float*)(roww + lo_);
                ro[ai][m] = (v ? (unsigned)tkv * 2048u : TRASH) + colb; }
#pragma unroll
        for (int bj = 0; bj < 2; ++bj)
#pragma unroll
            for (int n = 0; n < 2; ++n) bv[bj][n] = *(const f32x4*)(bp + colb * 2u + (unsigned)(bj * HALF + 4 * n) * 4u);
#pragma unroll
        for (int ai = 0; ai < 2; ++ai)
#pragma unroll
            for (int m = 0; m < 4; ++m) { const float ww = w[ai][m];
#pragma unroll
                for (int bj = 0; bj < 2; ++bj) st16(outr + ro[ai][m] + (unsigned)(bj * HALF * 2), pack8((acc[ai][bj][m][0] * MOE_DESCALE + bv[bj][0]) * ww, (acc[ai][bj][m][1] * MOE_DESCALE + bv[bj][1]) * ww)); }
    }
};
}
#define GAS __attribute__((address_space(1)))
#define LAS __attribute__((address_space(3)))
typedef GAS unsigned gu32;
#define RLX_AGENT __ATOMIC_RELAXED, __HIP_MEMORY_SCOPE_AGENT
constexpr int NWAVES = 8;
constexpr int RING_OFF = 0, RING_BYTES = 131072;
constexpr int LDSCTL_OFF = RING_BYTES;
constexpr int LDS_TAB_OFF = RING_BYTES + 1024;
constexpr int LDS_BYTES = LDS_TAB_OFF + 24 * 256 * 4;
static_assert(LDS_BYTES <= 163840, "LDS");

#define XB_TMO      128
#define XB_XCNT(j)  (256  + 64 * (j))
#define XB_XSUB(j)  (1280 + 64 * (j))
#define XB_XGEN(j)  (2304 + 64 * (j))
#define XB_TOP      3328
#define XB_TOPGEN   3392
#define XCD_BAR_WORDS 3456
#define XB_SPIN_CAP (1u << 18)
__device__ __forceinline__ unsigned xb_ld(unsigned* p)              { return __hip_atomic_load(p, __ATOMIC_RELAXED, __HIP_MEMORY_SCOPE_AGENT); }
__device__ __forceinline__ unsigned xb_add(unsigned* p, unsigned v) { return __hip_atomic_fetch_add(p, v, __ATOMIC_RELAXED, __HIP_MEMORY_SCOPE_AGENT); }
__device__ __forceinline__ unsigned xb_xcc_id() { return (unsigned)__builtin_amdgcn_s_getreg((3 << 11) | 20) & 0xFu; }
#define XB_SPIN(cond, bar) do { unsigned _sp = 0; while (cond) { __builtin_amdgcn_s_sleep(1); \
    if ((++_sp & 255u) == 0u) { if (xb_ld(&(bar)[XB_TMO])) break; if (_sp > XB_SPIN_CAP) { atomicAdd(&(bar)[XB_TMO], 1u); break; } } } } while (0)
struct XcdBarrier { unsigned* bar; unsigned x; volatile LAS unsigned* st; };
__device__ __forceinline__ XcdBarrier xcd_barrier_post(unsigned* bar, volatile LAS unsigned* st) {
    XcdBarrier b; b.bar = bar; b.x = xb_xcc_id(); b.st = st;
    if (threadIdx.x == 0) (void)xb_add(&bar[XB_XCNT(b.x)], 1u);
    return b;
}
__device__ __forceinline__ void xcd_barrier_complete(unsigned* bar, unsigned x, unsigned& nloc, unsigned& nx) {
    const unsigned G = gridDim.x * gridDim.y * gridDim.z;
    unsigned sum, cnt, mine, sp = 0u;
    for (;;) {
        sum = 0u; cnt = 0u; mine = 0u;
#pragma unroll
        for (unsigned j = 0; j < 16; ++j) { const unsigned c = xb_ld(&bar[XB_XCNT(j)]); sum += c; cnt += (c > 0u) ? 1u : 0u; mine = (j == x) ? c : mine; }
        if (sum == G) break;
        __builtin_amdgcn_s_sleep(1);
        if ((++sp & 255u) == 0u) { if (xb_ld(&bar[XB_TMO])) break; if (sp > XB_SPIN_CAP) { atomicAdd(&bar[XB_TMO], 1u); break; } }
    }
    nloc = mine > 0u ? mine : 1u; nx = cnt > 0u ? cnt : 1u;
}
__device__ __forceinline__ void xcd_barrier(const XcdBarrier& b) {
    asm volatile("s_waitcnt vmcnt(0)" ::: "memory");
    __syncthreads();
    if (threadIdx.x == 0) {
        unsigned* bar = b.bar;
        __builtin_amdgcn_s_waitcnt(0);
        unsigned nloc = b.st[0], nx = b.st[1];
        if (nloc == 0u) { xcd_barrier_complete(bar, b.x, nloc, nx); b.st[0] = nloc; b.st[1] = nx; }
        const unsigned old = xb_add(&bar[XB_XSUB(b.x)], 1u);
        const unsigned gen = old / nloc;
        if (old + 1u == (gen + 1u) * nloc) {
            __builtin_amdgcn_fence(__ATOMIC_RELEASE, "agent");
            asm volatile("s_waitcnt vmcnt(0)" ::: "memory");
            const unsigned og = xb_add(&bar[XB_TOP], 1u);
            const unsigned tg = og / nx;
            if (og + 1u == (tg + 1u) * nx) xb_add(&bar[XB_TOPGEN], 1u);
            else XB_SPIN(xb_ld(&bar[XB_TOPGEN]) == tg, bar);
            __builtin_amdgcn_fence(__ATOMIC_ACQUIRE, "agent");
            xb_add(&bar[XB_XGEN(b.x)], 1u);
            asm volatile("s_waitcnt vmcnt(0)" ::: "memory");
        } else {
            XB_SPIN(xb_ld(&bar[XB_XGEN(b.x)]) == gen, bar);
            __builtin_amdgcn_fence(__ATOMIC_ACQUIRE, "agent");
            asm volatile("s_waitcnt vmcnt(0)" ::: "memory");
        }
    }
    __syncthreads();
}

struct Frame {
    LAS unsigned char* lds; volatile LAS unsigned* LC;
    unsigned* ctl;
    int wave, vcu, G;
    Bufs B;
};
#define FWS(T, off) ((T*)(F.B.ws + (off)))
#define FDO(T, off) ((T*)((unsigned char*)F.B.out + (off)))
#define LDS_WAIT() asm volatile("s_waitcnt lgkmcnt(0)" ::: "memory")
#define VM_WAIT() asm volatile("s_waitcnt vmcnt(0)" ::: "memory")

__device__ __forceinline__ f32x16 mfma32(bf16x8 a, bf16x8 b, f32x16 c) { return __builtin_amdgcn_mfma_f32_32x32x16_bf16(a, b, c, 0, 0, 0); }
__device__ __forceinline__ int crow(int r, int hi) { return (r & 3) + 8 * (r >> 2) + 4 * hi; }
__device__ __forceinline__ float swap_lo(float x, float& hi_out) { auto rr = __builtin_amdgcn_permlane32_swap(__float_as_uint(x), __float_as_uint(x), false, false); hi_out = __uint_as_float(rr[1]); return __uint_as_float(rr[0]); }
__device__ __forceinline__ bf16x8 pack_frag(const f32x16& v, int base) {
    u32x4 w; w.x = pg8::cvt_pk_bf16(v[base + 0], v[base + 1]); w.y = pg8::cvt_pk_bf16(v[base + 2], v[base + 3]); w.z = pg8::cvt_pk_bf16(v[base + 4], v[base + 5]); w.w = pg8::cvt_pk_bf16(v[base + 6], v[base + 7]);
    return __builtin_bit_cast(bf16x8, w); }
__device__ __forceinline__ bf16x8 join8(u32x2 a, u32x2 b) { u32x4 w; w.x = a.x; w.y = a.y; w.z = b.x; w.w = b.y; return __builtin_bit_cast(bf16x8, w); }
__device__ __forceinline__ float ret_l2g(int h) { return __builtin_amdgcn_logf(1.0f - __builtin_amdgcn_exp2f(-5.0f - (float)h)); }

__device__ __forceinline__ void tr_item(const float* src, int lds_, int k0, int c0, bf16* dst, int K, int r0, LAS unsigned char* scr, int lane) {
    const int kr = lane >> 4, nq = lane & 15;
    f32x4 v[4][4];
#pragma unroll
    for (int gI = 0; gI < 4; ++gI)
#pragma unroll
        for (int i = 0; i < 4; ++i) v[gI][i] = *(const f32x4*)(src + (size_t)(k0 + 16 * gI + 4 * kr + i) * lds_ + c0 + 4 * nq);
#pragma unroll
    for (int gI = 0; gI < 4; ++gI)
#pragma unroll
        for (int e = 0; e < 4; ++e) { u32x2 w; w.x = pk2(v[gI][0][e], v[gI][1][e]); w.y = pk2(v[gI][2][e], v[gI][3][e]);
            *(LAS u32x2*)(scr + (4 * nq + e) * 144 + 32 * gI + 8 * kr) = w; }
    LDS_WAIT(); asm volatile("" ::: "memory");
#pragma unroll
    for (int it = 0; it < 8; ++it) { const int n = it * 8 + (lane >> 3), ch = lane & 7;
        const u32x4 w = *(const LAS u32x4*)(scr + n * 144 + ch * 16);
        *(u32x4*)(dst + (size_t)(r0 + n) * K + k0 + 8 * ch) = w; }
    LDS_WAIT(); asm volatile("" ::: "memory");
}
__device__ __forceinline__ void tr_item_fp8(const float* src, int lds_, int k0, int c0, unsigned char* dst, int K, int r0, LAS unsigned char* scr, int lane, const float wscale) {
    const int kr = lane >> 4, nq = lane & 15;
    f32x4 v[4][4];
#pragma unroll
    for (int gI = 0; gI < 4; ++gI)
#pragma unroll
        for (int i = 0; i < 4; ++i) v[gI][i] = *(const f32x4*)(src + (size_t)(k0 + 16 * gI + 4 * kr + i) * lds_ + c0 + 4 * nq) * wscale;
#pragma unroll
    for (int gI = 0; gI < 4; ++gI)
#pragma unroll
        for (int e = 0; e < 4; ++e) *(LAS unsigned*)(scr + (4 * nq + e) * 80 + 16 * gI + 4 * kr) = pk4_fp8(v[gI][0][e], v[gI][1][e], v[gI][2][e], v[gI][3][e]);
    LDS_WAIT(); asm volatile("" ::: "memory");
#pragma unroll
    for (int it = 0; it < 4; ++it) { const int n = it * 16 + (lane >> 2), ch = lane & 3;
        const u32x4 w = *(const LAS u32x4*)(scr + n * 80 + ch * 16);
        *(u32x4*)(dst + (size_t)(r0 + n) * K + k0 + 16 * ch) = w; }
    LDS_WAIT(); asm volatile("" ::: "memory");
}
__device__ __forceinline__ void p0_prologue(Frame& F) {
    const Bufs& B = F.B; const int lane_ = lane_id(), tid_ = F.wave * 64 + lane_;
    const int gw = F.vcu * NWAVES + F.wave, NGW = F.G * NWAVES;
    { const f32x4* xs = (const f32x4*)B.x; const size_t n8 = (size_t)NTOK * DM / 8;
#if INPROJ_FP8
      u32x2* xd = (u32x2*)(F.B.ws + WS_XB8);
#if ROT_BF16
      u32x4* xd16 = FDO(u32x4, DO_XB);
#endif
      for (size_t i = (size_t)blockIdx.x * 512 + tid_; i < n8; i += (size_t)F.G * 512) { const f32x4 a = xs[2 * i], b = xs[2 * i + 1];
          u32x2 w; w.x = pk4_fp8(a[0], a[1], a[2], a[3]); w.y = pk4_fp8(b[0], b[1], b[2], b[3]); xd[i] = w;
#if ROT_BF16
          u32x4 w16; w16.x = pk2(a[0], a[1]); w16.y = pk2(a[2], a[3]); w16.z = pk2(b[0], b[1]); w16.w = pk2(b[2], b[3]); xd16[i] = w16;
#endif
      }
#else
      u32x4* xd = FDO(u32x4, DO_XB);
      for (size_t i = (size_t)blockIdx.x * 512 + tid_; i < n8; i += (size_t)F.G * 512) { const f32x4 a = xs[2 * i], b = xs[2 * i + 1];
          u32x4 w; w.x = pk2(a[0], a[1]); w.y = pk2(a[2], a[3]); w.z = pk2(b[0], b[1]); w.w = pk2(b[2], b[3]); xd[i] = w; }
#endif
    }
    LAS unsigned char* scr = F.lds + RING_OFF + F.wave * 9216;
    constexpr int I_IN = 16 * (INW / 64)  , I_BSB = 256, I_BRET = 32 * 16, I_OUT = 256;
    constexpr int NITEMS = I_IN + I_BSB + I_BRET + I_OUT;
    for (int it = gw; it < NITEMS; it += NGW) {
        int r = it;
        if (r < I_IN) { const int kb = r / (INW / 64), nb = r % (INW / 64); const int c0 = nb * 64; bf16* dst; int r0;
            if (c0 < 2048) { dst = FWS(bf16, WS_WINT); r0 = c0; } else if (c0 < 3072) { dst = FWS(bf16, WS_WVT); r0 = c0 - 2048; }
            else if (c0 < 5120) { dst = FWS(bf16, WS_WINT); r0 = 2048 + c0 - 3072; } else if (c0 < 7168) { dst = FWS(bf16, WS_WVT); r0 = 1024 + c0 - 5120; }
            else { dst = FWS(bf16, WS_WINT); r0 = 4096 + c0 - 7168; }
#if INPROJ_FP8
            if (ROT_BF16 && c0 >= 3072 && c0 < 5120) tr_item(B.w_in, INW, kb * 64, c0, (bf16*)(F.B.ws + WS_WROT), 1024, c0 - 3072, scr, lane_);
            else tr_item_fp8(B.w_in, INW, kb * 64, c0, (unsigned char*)dst, 1024, r0, scr, lane_, IN_WSCALE);
            continue; } r -= I_IN;
#else
            tr_item(B.w_in, INW, kb * 64, c0, dst, 1024, r0, scr, lane_); continue; } r -= I_IN;
#endif
        if (r < I_BSB) { tr_item(B.w_bsb, 1024, (r >> 4) * 64, (r & 15) * 64, FWS(bf16, WS_WBSBT), 1024, (r & 15) * 64, scr, lane_); continue; } r -= I_BSB;
        if (r < I_BRET) { tr_item(B.w_bret, 1024, (r >> 4) * 64, (r & 15) * 64, FWS(bf16, WS_WBRETT), 2048, (r & 15) * 64, scr, lane_); continue; } r -= I_BRET;
        tr_item(B.w_out, 1024, (r >> 4) * 64, (r & 15) * 64, FWS(bf16, WS_WOUTT), 1024, (r & 15) * 64, scr, lane_);
    }
    { float* ct = FWS(float, WS_COS); float* st = FWS(float, WS_SIN);
      for (int i = blockIdx.x * 512 + tid_; i < SEQ * 128; i += F.G * 512) { const int pos = i >> 7, j = i & 127; const float ang = (float)pos * rope_inv_freq(j);
          ct[i] = (float)cos((double)ang); st[i] = (float)sin((double)ang); } }
    { bf16* wrt = FWS(bf16, WS_WRT);
      for (int i = blockIdx.x * 512 + tid_; i < 32 * 1024; i += F.G * 512) { const int k = i & 1023, e = i >> 10; wrt[i] = f2bf(B.w_router[k * 32 + e]); } }
}
__device__ __forceinline__ float sb_half(f32x16& p, int kbase, int tq, int hi, bool need_mask, float cin, bf16x8& f0, bf16x8& f1) {
    f32x16 u;
#pragma unroll
    for (int r = 0; r < 16; ++r) { const float e = __builtin_amdgcn_exp2f(fminf(p[r], 100.0f)); u[r] = __builtin_amdgcn_rcpf(1.0f + e); p[r] = e * u[r]; }
    if (need_mask) {
#pragma unroll
        for (int r = 0; r < 16; ++r) { const int s_ = kbase + crow(r, hi); const bool v = (s_ >= 0) && (s_ < tq); u[r] = v ? u[r] : 1.0f; p[r] = v ? p[r] : 0.0f; } }
    float T[4], Rh[4];
#pragma unroll
    for (int g = 0; g < 4; ++g) { const float R = (u[4 * g] * u[4 * g + 1]) * (u[4 * g + 2] * u[4 * g + 3]); float rh; const float rl = swap_lo(R, rh); Rh[g] = rh; T[g] = rl * rh; }
    float X[4]; X[3] = 1.0f;
#pragma unroll
    for (int g = 2; g >= 0; --g) X[g] = X[g + 1] * T[g + 1];
#pragma unroll
    for (int g = 0; g < 4; ++g) { const float ec = X[g] * (hi == 0 ? Rh[g] : 1.0f) * cin;
        const float w2 = u[4 * g + 3], w1 = w2 * u[4 * g + 2], w0 = w1 * u[4 * g + 1];
        p[4 * g + 3] *= ec; p[4 * g + 2] *= w2 * ec; p[4 * g + 1] *= w1 * ec; p[4 * g] *= w0 * ec; }
    f0 = pack_frag(p, 0); f1 = pack_frag(p, 8);
    return X[0] * T[0];
}
__device__ __forceinline__ void attn_wave_unit(const bf16* __restrict__ KSB, const bf16* __restrict__ VSBT, bf16* QY, int b, int h, int qb, int lane) {
    const int r32 = lane & 31, hi = lane >> 5; const int bh = b * 16 + h;
    const int t0 = qb * 32; const size_t rb = (size_t)b * SEQ; const int tq = t0 + r32;
    bf16x8 qf[4];
    { const bf16* qp = QY + (rb + t0 + r32) * 1024 + h * 64 + 8 * hi;
#pragma unroll
      for (int d0 = 0; d0 < 4; ++d0) qf[d0] = *(const bf16x8*)(qp + 16 * d0); }
    f32x16 o0 = {}, o1 = {};
    float carry = 1.0f;
    bf16x8 kf[2][4];
    const int koff = r32 * 16 + 8 * hi, voff = r32 * 16 + 4 * hi;
#define ATT_KLOAD(ks_) do { const bf16* b0_ = KSB + ((size_t)bh * 256 + (max((ks_), 0) >> 5)) * 2048; const bf16* b1_ = KSB + ((size_t)bh * 256 + (max((ks_) + 32, 0) >> 5)) * 2048; \
        _Pragma("unroll") for (int d0 = 0; d0 < 4; ++d0) { kf[0][d0] = *(const bf16x8*)(b0_ + d0 * 512 + koff); kf[1][d0] = *(const bf16x8*)(b1_ + d0 * 512 + koff); } } while (0)
    ATT_KLOAD(t0 - 32);
    for (int tile = 0;; ++tile) {
        const int ks = t0 + 32 - 64 * (tile + 1);
        f32x16 p0 = {}, p1 = {};
#pragma unroll
        for (int d0 = 0; d0 < 4; ++d0) { p0 = mfma32(kf[0][d0], qf[d0], p0); p1 = mfma32(kf[1][d0], qf[d0], p1); }
        bf16x8 vf[2][4];
#pragma unroll
        for (int s = 0; s < 4; ++s) { const bf16* vb_ = VSBT + ((size_t)bh * 512 + (max(ks + 16 * s, 0) >> 4)) * 1024;
#pragma unroll
            for (int db = 0; db < 2; ++db) vf[db][s] = join8(*(const u32x2*)(vb_ + db * 512 + voff), *(const u32x2*)(vb_ + db * 512 + voff + 8)); }
        ATT_KLOAD(ks - 64);
        const bool need_mask = (tile == 0) || (ks < 0);
        bf16x8 pfB0, pfB1, pfA0, pfA1;
        const float tot1 = sb_half(p1, ks + 32, tq, hi, need_mask, carry, pfB0, pfB1);
        const float tot0 = sb_half(p0, ks, tq, hi, need_mask, carry * tot1, pfA0, pfA1);
        carry *= tot1 * tot0;
        o0 = mfma32(vf[0][0], pfA0, o0); o1 = mfma32(vf[1][0], pfA0, o1); o0 = mfma32(vf[0][1], pfA1, o0); o1 = mfma32(vf[1][1], pfA1, o1);
        o0 = mfma32(vf[0][2], pfB0, o0); o1 = mfma32(vf[1][2], pfB0, o1); o0 = mfma32(vf[0][3], pfB1, o0); o1 = mfma32(vf[1][3], pfB1, o1);
        if (ks <= 0) break;
        if (__all(carry < 1.0e-37f)) break;
    }
#undef ATT_KLOAD
    bf16* op = QY + (rb + t0 + r32) * 1024 + h * 64 + 4 * hi;
    asm volatile("s_nop 15" ::: "memory");
#pragma unroll
    for (int g = 0; g < 4; ++g) { u32x2 w; w.x = pg8::cvt_pk_bf16(o0[4 * g], o0[4 * g + 1]); w.y = pg8::cvt_pk_bf16(o0[4 * g + 2], o0[4 * g + 3]); *(u32x2*)(op + 8 * g) = w;
        u32x2 w2; w2.x = pg8::cvt_pk_bf16(o1[4 * g], o1[4 * g + 1]); w2.y = pg8::cvt_pk_bf16(o1[4 * g + 2], o1[4 * g + 3]); *(u32x2*)(op + 32 + 8 * g) = w2; }
}
constexpr int I_GU = 32 * 16 * 32, I_DN = 32 * 16 * 16, I_MOE = I_GU + I_DN;
__device__ __forceinline__ void moe_tr_item(Frame& F, int r, LAS unsigned char* scr, int lane) {
    const Bufs& B = F.B;
    if (r < I_GU) { const int e = r >> 9, q = r & 511, kb = q >> 5, nb = q & 31; const int c0 = nb * 64; const int bj = c0 >> 10, rem = c0 & 1023, ct = rem >> 7, i0 = rem & 127;
#if MOE_FP8
        tr_item_fp8(B.w_gu + (size_t)e * 1024 * 2048, 2048, kb * 64, c0, F.B.ws + WS_WGUT + (size_t)e * 2048 * 1024, 1024, 256 * ct + 128 * bj + i0, scr, lane, MOE_WSCALE); return; }
#else
        tr_item(B.w_gu + (size_t)e * 1024 * 2048, 2048, kb * 64, c0, FWS(bf16, WS_WGUT) + (size_t)e * 2048 * 1024, 1024, 256 * ct + 128 * bj + i0, scr, lane); return; }
#endif
    r -= I_GU;
    { const int e = r >> 8, q = r & 255, kb = q >> 4, nb = q & 15;
#if MOE_FP8
      tr_item_fp8(B.w_dn + (size_t)e * 1024 * 1024, 1024, kb * 64, nb * 64, F.B.ws + WS_WDT + (size_t)e * 1024 * 1024, 1024, nb * 64, scr, lane, MOE_WSCALE); }
#else
      tr_item(B.w_dn + (size_t)e * 1024 * 1024, 1024, kb * 64, nb * 64, FWS(bf16, WS_WDT) + (size_t)e * 1024 * 1024, 1024, nb * 64, scr, lane); }
#endif
}
__device__ __forceinline__ void attn_phase(Frame& F) {
    const int lane = lane_id();
    LAS unsigned char* scr = F.lds + RING_OFF + F.wave * 9216;
    const int half = F.wave >> 2, gw4 = F.vcu * 4 + (F.wave & 3), NG4 = F.G * 4;
    if (half == 0) {
        for (int wu = gw4; wu < BATCH * SBH * (SEQ / 32); wu += NG4) { const int qb = wu & 255, bh = wu >> 8;
            attn_wave_unit(FWS(bf16, WS_KSB), FWS(bf16, WS_VSBT), FWS(bf16, WS_QSB), bh >> 4, bh & 15, qb, lane); }
    } else {
        for (int it = gw4; it < I_MOE; it += NG4) moe_tr_item(F, it, scr, lane);
    }
}

__device__ __forceinline__ int swap23(int m) { return (m & ~12) | ((m & 4) << 1) | ((m & 8) >> 1); }
__device__ __forceinline__ void scan_phase(Frame& F) {
    if (F.vcu >= BATCH * RH * 16) return;
    const int lane = lane_id(), w = F.wave, r32 = lane & 31, hi = lane >> 5;
    const int bh = F.vcu >> 4, vs = F.vcu & 15, h = bh & 3;
    const float l2g = ret_l2g(h), cd = __builtin_amdgcn_exp2f(64.0f * l2g);
    const bf16* ktp = FDO(bf16, DO_KRT) + ((size_t)bh * 128 * 4 * 256 + (32 * w + swap23(r32))) * 16 + 8 * hi;
    const bf16* vtp = FWS(bf16, WS_VRT) + ((size_t)bh * 128 * 4 * 512 + (32 * vs + r32)) * 16 + 8 * hi;
    const bf16* qp = FWS(bf16, WS_QRS) + ((size_t)bh * 128 * 16 * 64 + (size_t)(2 * w) * 64 + r32) * 16 + 8 * hi;
    bf16* yst = FWS(bf16, WS_YINT) + ((size_t)bh * 128 * 64 + (size_t)(4 * vs + (w & 3))) * 512 + lane * 8;
    LAS unsigned char* stg = F.lds + LDS_TAB_OFF;
    LAS f32x4* part = (LAS f32x4*)(F.lds + RING_OFF);
    f32x16 S = {};
    bf16x8 kfA[4], vfA[4], qfA[2][2], kfB[4], vfB[4], qfB[2][2], kfC[4], vfC[4], qfC[2][2];
#define SCAN_LOAD(kf, vf, qf, c) do { _Pragma("unroll") for (int s = 0; s < 4; ++s) { kf[s] = *(const bf16x8*)(ktp + (size_t)((c) * 4 + s) * 4096); vf[s] = *(const bf16x8*)(vtp + (size_t)((c) * 4 + s) * 8192); } \
        _Pragma("unroll") for (int ib = 0; ib < 2; ++ib) _Pragma("unroll") for (int s = 0; s < 2; ++s) qf[ib][s] = *(const bf16x8*)(qp + (size_t)(c) * 16384 + s * 1024 + ib * 512); } while (0)
#define SCAN_STEP(kf, vf, qf, kfn, vfn, qfn, c) do { \
        { const int cn_ = ((c) + 2 < NCHUNK) ? (c) + 2 : NCHUNK - 1; SCAN_LOAD(kfn, vfn, qfn, cn_); }     \
        const bf16x8 sb0 = pack_frag(S, 0), sb1 = pack_frag(S, 8); \
        f32x16 y0 = {}, y1 = {}; \
        y0 = mfma32(qf[0][0], sb0, y0); y0 = mfma32(qf[0][1], sb1, y0); \
        y1 = mfma32(qf[1][0], sb0, y1); y1 = mfma32(qf[1][1], sb1, y1); \
        LAS f32x4* pb = part + ((c) & 1) * 4096 + (w * 8) * 64 + lane; \
        _Pragma("unroll") for (int q = 0; q < 4; ++q) { pb[q * 64] = (f32x4){y0[4 * q], y0[4 * q + 1], y0[4 * q + 2], y0[4 * q + 3]}; pb[(4 + q) * 64] = (f32x4){y1[4 * q], y1[4 * q + 1], y1[4 * q + 2], y1[4 * q + 3]}; } \
        _Pragma("unroll") for (int r = 0; r < 16; ++r) S[r] *= cd; \
        _Pragma("unroll") for (int s = 0; s < 4; ++s) S = mfma32(kf[s], vf[s], S); \
        LDS_WAIT(); __builtin_amdgcn_s_barrier(); asm volatile("" ::: "memory"); \
        const LAS f32x4* rbp = part + ((c) & 1) * 4096 + w * 64 + lane;         \
        f32x4 acc = rbp[0]; \
        _Pragma("unroll") for (int w2 = 1; w2 < 8; ++w2) acc += rbp[w2 * 8 * 64]; \
        if ((c) > 0 && w < 4) *(u32x4*)(yst + (size_t)((c) - 1) * 32768) = *(const LAS u32x4*)(stg + (((c) - 1) & 1) * 4096 + w * 1024 + lane * 16);     \
        _Pragma("unroll") for (int k = 0; k < 4; ++k) { const int idx = 4 * w + k, ib = idx >> 4, r = idx & 15; const int i = 32 * ib + crow(r, hi); \
            *(LAS bf16*)(stg + ((c) & 1) * 4096 + (r32 >> 3) * 1024 + i * 16 + (r32 & 7) * 2) = f2bf(acc[k] * __builtin_amdgcn_exp2f((float)(i + 1) * l2g)); } } while (0)
    SCAN_LOAD(kfA, vfA, qfA, 0); SCAN_LOAD(kfB, vfB, qfB, 1);
    int c = 0;
    for (; c + 3 <= NCHUNK; c += 3) { SCAN_STEP(kfA, vfA, qfA, kfC, vfC, qfC, c); SCAN_STEP(kfB, vfB, qfB, kfA, vfA, qfA, c + 1); SCAN_STEP(kfC, vfC, qfC, kfB, vfB, qfB, c + 2); }
    SCAN_STEP(kfA, vfA, qfA, kfC, vfC, qfC, c); SCAN_STEP(kfB, vfB, qfB, kfA, vfA, qfA, c + 1);
    LDS_WAIT(); __syncthreads();
    if (w < 4) *(u32x4*)(yst + (size_t)(NCHUNK - 1) * 32768) = *(const LAS u32x4*)(stg + ((NCHUNK - 1) & 1) * 4096 + w * 1024 + lane * 16);
    static_assert(NCHUNK % 3 == 2, "scan tail");
#undef SCAN_STEP
#undef SCAN_LOAD
    LDS_WAIT(); __syncthreads();
}

__device__ __forceinline__ void intra_phase(Frame& F) {
    const int lane = lane_id(), w = F.wave, r32 = lane & 31, hi = lane >> 5;
    LAS float* part = (LAS float*)(F.lds + RING_OFF);
    LAS u32x4* pfl = (LAS u32x4*)(F.lds + RING_OFF + 16384);
    LAS float* red = (LAS float*)(F.lds + RING_OFF + 24576);
    LAS unsigned char* stg = F.lds + RING_OFF + 32768 + w * 9216;
    const int tl = w & 3, jb = tl >> 1, ibt = tl & 1, kh = w >> 2;
    const int un0 = F.vcu * 8; if (un0 >= BATCH * RH * NCHUNK) return;
    const int c0 = un0 & 127, h = (un0 >> 7) & 3, b = un0 >> 9, bh = b * 4 + h; const float l2g = ret_l2g(h);
    const bf16* kp0 = FWS(bf16, WS_KR) + ((size_t)b * SEQ + 32 * jb + r32) * 1024 + h * 256 + 128 * kh + 8 * hi;
    const bf16* qp0 = FWS(bf16, WS_QRS) + ((size_t)bh * 128 * 16 + 8 * kh) * 1024 + (32 * ibt + r32) * 16 + 8 * hi;
    const bf16* vp0 = FWS(bf16, WS_VRT) + ((size_t)bh * 128 * 4 * 512 + 64 * w + r32) * 16 + 4 * hi;
    const size_t tb0 = (((size_t)bh * 128 * 64 + 8 * w) * 64 + r32) * 8 + 4 * hi;
    const bf16* yp0 = FWS(bf16, WS_YINT) + tb0; const bf16* sp0 = FWS(bf16, WS_SG) + tb0;
    bf16x8 kfr[8], qfr[8], vfr[2][4]; u32x2 yv[2][2][4], sv[2][2][4];
#define IL_KQ(c) do { _Pragma("unroll") for (int s = 0; s < 8; ++s) { kfr[s] = *(const bf16x8*)(kp0 + (size_t)(c) * 65536 + 16 * s); qfr[s] = *(const bf16x8*)(qp0 + (size_t)(c) * 16384 + s * 1024); } } while (0)
#define IL_V(c) do { _Pragma("unroll") for (int vb = 0; vb < 2; ++vb) _Pragma("unroll") for (int ks = 0; ks < 4; ++ks) { const bf16* p = vp0 + (size_t)(c) * 32768 + (size_t)ks * 8192 + vb * 512; vfr[vb][ks] = join8(*(const u32x2*)(p), *(const u32x2*)(p + 8)); } } while (0)
#define IL_T(dst, base, c) do { _Pragma("unroll") for (int ib = 0; ib < 2; ++ib) _Pragma("unroll") for (int vb = 0; vb < 2; ++vb) _Pragma("unroll") for (int g = 0; g < 4; ++g) \
        dst[ib][vb][g] = *(const u32x2*)(base + (size_t)(c) * 32768 + (size_t)(4 * vb + g) * 512 + ib * 256); } while (0)
    IL_KQ(c0); IL_V(c0); IL_T(yv, yp0, c0);
    for (int k = 0; k < 8; ++k) {
        const int c = c0 + k; const bool more = k < 7;
        const size_t tok0 = (size_t)b * SEQ + c * 64;
        f32x16 X = {};
#pragma unroll
        for (int s = 0; s < 8; ++s) X = mfma32(kfr[s], qfr[s], X);
        { const int cn = more ? c + 1 : c; IL_KQ(cn); }
        if (kh == 1) {
#pragma unroll
            for (int r = 0; r < 16; ++r) part[(tl * 16 + r) * 64 + lane] = X[r]; }
        LDS_WAIT(); __builtin_amdgcn_s_barrier(); asm volatile("" ::: "memory");
        if (kh == 0) {
#pragma unroll
            for (int r = 0; r < 16; ++r) { const int j = 32 * jb + crow(r, hi), i = 32 * ibt + r32;
                X[r] = (X[r] + part[(tl * 16 + r) * 64 + lane]) * __builtin_amdgcn_exp2f((float)((j <= i ? i - j : j - i) - 63 + j) * l2g); }
            pfl[(ibt * 4 + 2 * jb) * 64 + lane] = __builtin_bit_cast(u32x4, pack_frag(X, 0)); pfl[(ibt * 4 + 2 * jb + 1) * 64 + lane] = __builtin_bit_cast(u32x4, pack_frag(X, 8)); }
        LDS_WAIT(); __builtin_amdgcn_s_barrier(); asm volatile("" ::: "memory");
        f32x16 Y[2][2] = {};
#pragma unroll
        for (int ks = 0; ks < 4; ++ks) { const bf16x8 p0 = __builtin_bit_cast(bf16x8, pfl[(0 * 4 + ks) * 64 + lane]), p1 = __builtin_bit_cast(bf16x8, pfl[(1 * 4 + ks) * 64 + lane]);
#pragma unroll
            for (int vb = 0; vb < 2; ++vb) { Y[vb][0] = mfma32(vfr[vb][ks], p0, Y[vb][0]); Y[vb][1] = mfma32(vfr[vb][ks], p1, Y[vb][1]); } }
        IL_T(sv, sp0, c);
        float s1[2] = {0.f, 0.f}, s2[2] = {0.f, 0.f};
#pragma unroll
        for (int ib = 0; ib < 2; ++ib)
#pragma unroll
            for (int vb = 0; vb < 2; ++vb)
#pragma unroll
                for (int g = 0; g < 4; ++g) { const u32x2 wv = yv[ib][vb][g];
                    Y[vb][ib][4 * g] += __uint_as_float(wv.x << 16); Y[vb][ib][4 * g + 1] += __uint_as_float(wv.x & 0xffff0000u); Y[vb][ib][4 * g + 2] += __uint_as_float(wv.y << 16); Y[vb][ib][4 * g + 3] += __uint_as_float(wv.y & 0xffff0000u);
#pragma unroll
                    for (int e = 0; e < 4; ++e) { const float y = Y[vb][ib][4 * g + e]; s1[ib] += y; s2[ib] += y * y; } }
#pragma unroll
        for (int ib = 0; ib < 2; ++ib) { float h1, h2; const float l1 = swap_lo(s1[ib], h1), l2 = swap_lo(s2[ib], h2);
            if (hi == 0) { red[(w * 64 + 32 * ib + r32) * 2] = l1 + h1; red[(w * 64 + 32 * ib + r32) * 2 + 1] = l2 + h2; } }
        LDS_WAIT(); __builtin_amdgcn_s_barrier(); asm volatile("" ::: "memory");
#pragma unroll
        for (int ib = 0; ib < 2; ++ib) { float t1 = 0.f, t2 = 0.f;
#pragma unroll
            for (int w2 = 0; w2 < 8; ++w2) { t1 += red[(w2 * 64 + 32 * ib + r32) * 2]; t2 += red[(w2 * 64 + 32 * ib + r32) * 2 + 1]; }
            const float mean = t1 * (1.0f / 512.0f), var = fmaxf(t2 * (1.0f / 512.0f) - mean * mean, 0.0f), rstd = __builtin_amdgcn_rsqf(var + LN_EPS);
#pragma unroll
            for (int vb = 0; vb < 2; ++vb)
#pragma unroll
                for (int g = 0; g < 4; ++g) { const u32x2 sw = sv[ib][vb][g];
                    const float g0 = __uint_as_float(sw.x << 16), g1 = __uint_as_float(sw.x & 0xffff0000u), g2 = __uint_as_float(sw.y << 16), g3 = __uint_as_float(sw.y & 0xffff0000u);
                    u32x2 ov; ov.x = pg8::cvt_pk_bf16(g0 * (Y[vb][ib][4 * g] - mean) * rstd, g1 * (Y[vb][ib][4 * g + 1] - mean) * rstd);
                    ov.y = pg8::cvt_pk_bf16(g2 * (Y[vb][ib][4 * g + 2] - mean) * rstd, g3 * (Y[vb][ib][4 * g + 3] - mean) * rstd);
                    *(LAS u32x2*)(stg + (32 * ib + r32) * 144 + (32 * vb + 8 * g + 4 * hi) * 2) = ov; } }
        { const int cn = more ? c + 1 : c; IL_V(cn); IL_T(yv, yp0, cn); }
        LDS_WAIT(); asm volatile("" ::: "memory");
        { bf16* rp = FDO(bf16, DO_R) + (tok0 + (lane >> 3)) * 2048 + h * 512 + 64 * w + 8 * (lane & 7);
#pragma unroll
          for (int kk = 0; kk < 8; ++kk) { const u32x4 v = *(const LAS u32x4*)(stg + (8 * kk + (lane >> 3)) * 144 + (lane & 7) * 16); *(u32x4*)(rp + (size_t)(8 * kk) * 2048) = v; } }
        LDS_WAIT(); asm volatile("" ::: "memory");
    }
#undef IL_KQ
#undef IL_V
#undef IL_T
    LDS_WAIT(); __syncthreads();
}

__device__ __forceinline__ void ln1_router_phase(Frame& F) {
    const Bufs& B = F.B;
    const int lane = lane_id(), w = F.wave, n = lane & 15, kq = lane >> 4; const int tid_ = w * 64 + lane;
    LAS unsigned char* wl = F.lds + RING_OFF;
    LAS float* gl = (LAS float*)(F.lds + RING_OFF + 66048);
    LAS float* bl = gl + 1024;
    LAS int* selE = (LAS int*)(F.lds + RING_OFF + 98816);
    LAS float* selW = (LAS float*)(F.lds + RING_OFF + 98816 + 2048);
    volatile LAS unsigned* hist = F.LC + 96; volatile LAS unsigned* basew = F.LC + 128;
    if (tid_ < 32) hist[tid_] = 0u;
    const int wgrow0 = F.vcu * 128;
    const int row = wgrow0 + 16 * w + n;
    u32x4 v[32];
    { const unsigned char* prow = (const unsigned char*)B.out + (size_t)row * 2048 + kq * 16;
#pragma unroll
      for (int s = 0; s < 32; ++s) v[s] = *(const u32x4*)(prow + 64 * s); }
    { const u32x4* src = FWS(u32x4, WS_WRT);
      for (int i = tid_; i < 4096; i += 512) { const int e = i >> 7, c = i & 127; *(LAS u32x4*)(wl + e * 2064 + c * 16) = src[i]; }
      if (tid_ < 256) *(LAS f32x4*)(gl + 4 * tid_) = *(const f32x4*)(B.ln1_g + 4 * tid_); else *(LAS f32x4*)(bl + 4 * (tid_ - 256)) = *(const f32x4*)(B.ln1_b + 4 * (tid_ - 256)); }
    LDS_WAIT(); __syncthreads();
    float s1 = 0.f;
#pragma unroll
    for (int s = 0; s < 32; ++s)
#pragma unroll
        for (int q = 0; q < 4; ++q) s1 += __uint_as_float(v[s][q] << 16) + __uint_as_float(v[s][q] & 0xffff0000u);
    s1 += __shfl_xor(s1, 16); s1 += __shfl_xor(s1, 32);
#define P7_LAUNDER() do { _Pragma("unroll") for (int s = 0; s < 32; ++s) asm volatile("" : "+v"(v[s])); } while (0)
    P7_LAUNDER();
    const float mean = s1 * (1.f / 1024.f); float s2 = 0.f;
#pragma unroll
    for (int s = 0; s < 32; ++s)
#pragma unroll
        for (int q = 0; q < 4; ++q) { const float d0 = __uint_as_float(v[s][q] << 16) - mean, d1 = __uint_as_float(v[s][q] & 0xffff0000u) - mean; s2 += d0 * d0 + d1 * d1; }
    s2 += __shfl_xor(s2, 16); s2 += __shfl_xor(s2, 32);
    P7_LAUNDER();
#undef P7_LAUNDER
    const float rstd = rsqrtf(s2 * (1.f / 1024.f) + LN_EPS);
    f32x4 acc0 = {0.f, 0.f, 0.f, 0.f}, acc1 = {0.f, 0.f, 0.f, 0.f};
    { unsigned char* xb = F.B.ws + WS_X1B + (size_t)row * 2048 + kq * 16;
#if MOE_FP8
      unsigned char* x8 = F.B.ws + WS_X1B8 + (size_t)row * 1024 + kq * 8;
#endif
      const LAS unsigned char* wa = wl + n * 2064 + kq * 16;
#pragma unroll
      for (int s = 0; s < 32; ++s) { const int k0 = 32 * s + 8 * kq;
          const f32x4 g0 = *(const LAS f32x4*)(gl + k0), g1 = *(const LAS f32x4*)(gl + k0 + 4), b0 = *(const LAS f32x4*)(bl + k0), b1 = *(const LAS f32x4*)(bl + k0 + 4);
          f32x4 y0, y1;
          y0[0] = (__uint_as_float(v[s][0] << 16) - mean) * rstd * g0[0] + b0[0]; y0[1] = (__uint_as_float(v[s][0] & 0xffff0000u) - mean) * rstd * g0[1] + b0[1];
          y0[2] = (__uint_as_float(v[s][1] << 16) - mean) * rstd * g0[2] + b0[2]; y0[3] = (__uint_as_float(v[s][1] & 0xffff0000u) - mean) * rstd * g0[3] + b0[3];
          y1[0] = (__uint_as_float(v[s][2] << 16) - mean) * rstd * g1[0] + b1[0]; y1[1] = (__uint_as_float(v[s][2] & 0xffff0000u) - mean) * rstd * g1[1] + b1[1];
          y1[2] = (__uint_as_float(v[s][3] << 16) - mean) * rstd * g1[2] + b1[2]; y1[3] = (__uint_as_float(v[s][3] & 0xffff0000u) - mean) * rstd * g1[3] + b1[3];
          const u32x4 o = pg8::pack8(y0, y1);
          *(u32x4*)(xb + 64 * s) = o;
#if MOE_FP8
          { u32x2 o8; o8.x = pk4_fp8(y0[0], y0[1], y0[2], y0[3]); o8.y = pk4_fp8(y1[0], y1[1], y1[2], y1[3]); *(u32x2*)(x8 + 32 * s) = o8; }
#endif
          const bf16x8 bf = __builtin_bit_cast(bf16x8, o);
          acc0 = __builtin_amdgcn_mfma_f32_16x16x32_bf16(*(const LAS bf16x8*)(wa + 64 * s), bf, acc0, 0, 0, 0);
          acc1 = __builtin_amdgcn_mfma_f32_16x16x32_bf16(*(const LAS bf16x8*)(wa + 16 * 2064 + 64 * s), bf, acc1, 0, 0, 0);
          asm volatile("" ::: "memory"); } }
    { float lg[8];
#pragma unroll
      for (int i = 0; i < 4; ++i) { lg[i] = acc0[i] + B.b_router[4 * kq + i]; lg[4 + i] = acc1[i] + B.b_router[16 + 4 * kq + i]; }
      int se[4]; float sv[4];
#pragma unroll
      for (int kk = 0; kk < 4; ++kk) { float best = -INFINITY; int bi = 0;
#pragma unroll
          for (int i = 0; i < 8; ++i) { const int e = (i < 4 ? 0 : 12) + 4 * kq + i; if (lg[i] > best) { best = lg[i]; bi = e; } }
#pragma unroll
          for (int off = 16; off <= 32; off <<= 1) { const float pv = __shfl_xor(best, off); const int pi = __shfl_xor(bi, off); if (pv > best || (pv == best && pi < bi)) { best = pv; bi = pi; } }
          se[kk] = bi; sv[kk] = best;
#pragma unroll
          for (int i = 0; i < 8; ++i) { const int e = (i < 4 ? 0 : 12) + 4 * kq + i; if (e == bi) lg[i] = -INFINITY; } }
      const float e1 = __expf(sv[1] - sv[0]), e2 = __expf(sv[2] - sv[0]), e3 = __expf(sv[3] - sv[0]); const float inv = 1.f / (1.f + e1 + e2 + e3);
      if (kq == 0) { const int tl = 16 * w + n;
          selE[tl * 4 + 0] = se[0]; selE[tl * 4 + 1] = se[1]; selE[tl * 4 + 2] = se[2]; selE[tl * 4 + 3] = se[3];
          selW[tl * 4 + 0] = inv; selW[tl * 4 + 1] = e1 * inv; selW[tl * 4 + 2] = e2 * inv; selW[tl * 4 + 3] = e3 * inv; } }
    LDS_WAIT(); __syncthreads();
    const int myE = selE[tid_]; const float myW = selW[tid_];
    const unsigned rk = __hip_atomic_fetch_add((LAS unsigned*)hist + myE, 1u, __ATOMIC_RELAXED, __HIP_MEMORY_SCOPE_WORKGROUP);
    LDS_WAIT(); __syncthreads();
    if (tid_ < 32) basew[tid_] = __hip_atomic_fetch_add(F.ctl + CW_CNT + 64 * tid_, hist[tid_], RLX_AGENT);
    LDS_WAIT(); __syncthreads();
    { const unsigned pos = basew[myE] + rk; const int tk = (wgrow0 + (tid_ >> 2)) * 4 + (tid_ & 3);
      FWS(int, WS_ROWTK)[(size_t)myE * CAP + pos] = tk; FWS(float, WS_ROWW)[(size_t)myE * CAP + pos] = myW; }
}

template <bool GU> struct MoeOrder {
    volatile LAS int* ts; volatile LAS unsigned* cntl; const LAS unsigned* tab; int c; const char* wsb;
    static constexpr int UT_WORD = 96;
    __device__ bool search(int i, pg8::Unit& u) const {
        const int x = c & 7, k = c >> 3, q = 8 * i + x;
        const int rt = GU ? (4 * q + (k >> 3)) : (8 * q + (k >> 2));
        if (rt >= ts[NEXP]) return false;
        int e = 0;
        for (int j = 1; j < NEXP; ++j) e += (rt >= ts[j]) ? 1 : 0;
        u.pn = GU ? (k & 7) : (k & 3); u.e = e; u.idx = i; u.rbase = rt * 256; u.pm = (rt - ts[e]) * 256;
        const int left = (int)cntl[e] - u.pm; u.nrows = left < 256 ? left : 256; return true;
    }
    __device__ void build(int tid) const {
        if (tid < 24) { pg8::Unit u; const bool ok = search(tid, u); volatile LAS int* ut = (volatile LAS int*)(cntl - 64 + UT_WORD) + 4 * tid;
            ut[0] = ok ? u.e : -1; ut[1] = ok ? u.rbase : 0; ut[2] = ok ? u.pm : 0; ut[3] = ok ? u.nrows : 0; }
    }
    __device__ bool next(int i, pg8::Unit& u) const {
        if (i >= 24) return false;
        const volatile LAS int* ut = (const volatile LAS int*)(cntl - 64 + UT_WORD) + 4 * i;
        const int e = ut[0]; if (e < 0) return false;
        const int k = c >> 3; u.pn = GU ? (k & 7) : (k & 3); u.e = e; u.idx = i; u.rbase = ut[1]; u.pm = ut[2]; u.nrows = ut[3]; return true;
    }
    static constexpr int EBm = MOE_FP8 ? 1 : 2;
    __device__ __forceinline__ const char* a_ptr(const pg8::Unit& u) const { const char* ws_ = wsb; return GU ? ws_ + (MOE_FP8 ? WS_X1B8 : WS_X1B) : ws_ + WS_ACT + (size_t)u.rbase * 1024 * EBm; }
    __device__ __forceinline__ const char* b_ptr(const pg8::Unit& u) const { const char* ws_ = wsb; return ws_ + (GU ? WS_WGUT : WS_WDT) + ((size_t)u.e * (GU ? 2048 : 1024) + (size_t)u.pn * 256) * 1024 * EBm; }
    __device__ __forceinline__ unsigned a_off(const pg8::Unit& u, int row) const { return tab[u.idx * 256 + row]; }
    __device__ __forceinline__ void a_ready(const pg8::Unit&) const {}
    __device__ __forceinline__ void done(const pg8::Unit&) const {}
};
__device__ __forceinline__ void moe_setup(Frame& F) {
    const int tid_ = F.wave * 64 + lane_id();
    volatile LAS int* ts = (volatile LAS int*)(F.LC + 16); volatile LAS unsigned* cntl = F.LC + 64;
    if (tid_ < 32) cntl[tid_] = __hip_atomic_load(F.ctl + CW_CNT + 64 * tid_, RLX_AGENT);
    LDS_WAIT(); __syncthreads();
    if (tid_ <= NEXP) { const LAS unsigned* cn = (const LAS unsigned*)cntl; int acc = 0;
#pragma unroll
        for (int e = 0; e < NEXP; ++e) acc += (e < tid_) ? (int)((cn[e] + 255u) >> 8) : 0;
        ts[tid_] = acc; }
    LDS_WAIT(); __syncthreads();
}

__device__ __forceinline__ void final_phase(Frame& F) {
    const Bufs& B = F.B; const int lane = lane_id();
    const int gw = F.vcu * NWAVES + F.wave, NGW = F.G * NWAVES;
    f32x4 gv[4], bv[4];
#pragma unroll
    for (int j = 0; j < 4; ++j) { gv[j] = *(const f32x4*)(B.ln2_g + 4 * lane + 256 * j); bv[j] = *(const f32x4*)(B.ln2_b + 4 * lane + 256 * j); }
    for (int row = gw; row < NTOK; row += NGW) { float* p = B.out + (size_t)row * 1024 + 4 * lane; const bf16* orow = FWS(bf16, WS_OUTR) + (size_t)row * 4096 + 4 * lane;
        const bf16* xrow = FWS(bf16, WS_X1B) + (size_t)row * 1024 + 4 * lane;
        f32x4 v[4]; float s = 0.f;
#pragma unroll
        for (int j = 0; j < 4; ++j) { { const u32x2 xv = *(const u32x2*)(xrow + 256 * j);
                v[j] = (f32x4){__uint_as_float(xv.x << 16), __uint_as_float(xv.x & 0xffff0000u), __uint_as_float(xv.y << 16), __uint_as_float(xv.y & 0xffff0000u)} * DN_ALPHA; }
#pragma unroll
            for (int kk = 0; kk < 4; ++kk) { const u32x2 wv = *(const u32x2*)(orow + kk * 1024 + 256 * j);
                v[j][0] += __uint_as_float(wv.x << 16); v[j][1] += __uint_as_float(wv.x & 0xffff0000u); v[j][2] += __uint_as_float(wv.y << 16); v[j][3] += __uint_as_float(wv.y & 0xffff0000u); }
            s += (v[j][0] + v[j][1]) + (v[j][2] + v[j][3]); }
        const float mean = wave_sum(s) * (1.f / 1024.f); float s2 = 0.f;
#pragma unroll
        for (int j = 0; j < 4; ++j) { v[j] = v[j] - mean; s2 += (v[j][0] * v[j][0] + v[j][1] * v[j][1]) + (v[j][2] * v[j][2] + v[j][3] * v[j][3]); }
        const float rstd = rsqrtf(wave_sum(s2) * (1.f / 1024.f) + LN_EPS);
#pragma unroll
        for (int j = 0; j < 4; ++j) *(f32x4*)(p + 256 * j) = v[j] * rstd * gv[j] + bv[j]; }
}

__device__ __forceinline__ void stagger(const Frame& F, int quarter_ticks  ) {
    const unsigned long long t0 = __builtin_amdgcn_s_memrealtime(); const unsigned long long dt = (unsigned long long)((F.vcu & 3) * quarter_ticks);
    while (__builtin_amdgcn_s_memrealtime() - t0 < dt) __builtin_amdgcn_s_sleep(8);
}
#ifndef STAGGER
#define STAGGER 0
#endif
constexpr int NPHASE = 11;
__global__ void __launch_bounds__(NWAVES * 64, 2) mega_fwd(MArgs args) {
    extern __shared__ __attribute__((aligned(16))) unsigned char lds[];
    Frame F;
    F.lds = (LAS unsigned char*)lds; F.LC = (volatile LAS unsigned*)(F.lds + LDSCTL_OFF);
    F.wave = __builtin_amdgcn_readfirstlane((int)threadIdx.x >> 6);
    F.G = gridDim.x; { const int bx = blockIdx.x; F.vcu = (F.G % 8 == 0) ? (bx % 8) * (F.G / 8) + bx / 8 : bx; }
#define REFRESH() do { const __attribute__((address_space(4))) MArgs* kp_ = KARG(); \
        F.B.x = kp_->B.x; F.B.w_in = kp_->B.w_in; F.B.w_bsb = kp_->B.w_bsb; F.B.w_bret = kp_->B.w_bret; F.B.w_out = kp_->B.w_out; F.B.ln1_g = kp_->B.ln1_g; F.B.ln1_b = kp_->B.ln1_b; \
        F.B.w_router = kp_->B.w_router; F.B.b_router = kp_->B.b_router; F.B.w_gu = kp_->B.w_gu; F.B.b_gu = kp_->B.b_gu; F.B.w_dn = kp_->B.w_dn; F.B.b_dn = kp_->B.b_dn; \
        F.B.ln2_g = kp_->B.ln2_g; F.B.ln2_b = kp_->B.ln2_b; F.B.out = kp_->B.out; F.B.ws = kp_->B.ws; F.ctl = (unsigned*)(F.B.ws + WS_CTL); } while (0)
    F.B = args.B; F.ctl = (unsigned*)(args.B.ws + WS_CTL);
    for (int u = threadIdx.x; u < 256; u += NWAVES * 64) F.LC[u] = 0u;
    __syncthreads();
    if (threadIdx.x == 0) { const unsigned long long kp = (unsigned long long)__builtin_amdgcn_kernarg_segment_ptr(); F.LC[KARG_LDS_WORD] = (unsigned)kp; F.LC[KARG_LDS_WORD + 1] = (unsigned)(kp >> 32); }
    __syncthreads();
    const int lo = args.ph_lo, hi = args.ph_hi;
    const bool multi = (hi - lo) > 1;
    if (multi) (void)xcd_barrier_post(F.ctl + CW_BAR, F.LC);
#ifndef PH_COMPILE
#define PH_COMPILE 0x7FF
#endif
#define IN(k) ((((PH_COMPILE) >> (k)) & 1) && (KARG()->ph_lo & 0xff) <= (k) && (k) < KARG()->ph_hi)
#define SEAM(k) do { if (IN(k) && IN((k) + 1)) { REFRESH(); XcdBarrier bar_; bar_.bar = F.ctl + CW_BAR; bar_.x = xb_xcc_id(); bar_.st = F.LC; xcd_barrier(bar_); } } while (0)
    LAS unsigned char* ring = F.lds + RING_OFF;
    const int c = (int)blockIdx.x;
    if (IN(0)) { REFRESH(); p0_prologue(F); } SEAM(0);
    if (IN(1)) { REFRESH(); if (STAGGER) stagger(F, 500);
        constexpr int IEB = INPROJ_FP8 ? 1 : 2; constexpr bool IF8 = INPROJ_FP8 != 0;
        constexpr bool RB = IF8 && ROT_BF16;
        const char* xa = IF8 ? (const char*)(F.B.ws + WS_XB8) : (const char*)FDO(char, DO_XB);
        { pg8::StaticOrder S; S.init(xa, F.B.ws + WS_WINT, NTOK, 2048, 1024, F.G, c, IEB);
          pg8::EpiQK E{FWS(bf16, WS_QSB), FWS(bf16, WS_KSB)};
          pg8::gemm_phase<pg8::EpiQK, pg8::StaticOrder, true, false, IF8>(ring, 1024, S, E, F.wave); }
        { pg8::StaticOrder S;
          if (RB) S.init(FDO(char, DO_XB), F.B.ws + WS_WROT, NTOK, 2048, 1024, F.G, c, 2); else S.init(xa, F.B.ws + WS_WINT + (size_t)2048 * 1024 * IEB, NTOK, 2048, 1024, F.G, c, IEB);
          pg8::EpiRot E{FWS(bf16, WS_QR), FWS(bf16, WS_KR), FDO(bf16, DO_KRT), FWS(bf16, WS_QRS), FWS(float, WS_COS), FWS(float, WS_SIN), RB ? 1.0f : IN_DS};
          pg8::gemm_phase<pg8::EpiRot, pg8::StaticOrder, true, false, IF8 && !RB>(ring, 1024, S, E, F.wave); }
        { pg8::StaticOrder S; S.init(xa, F.B.ws + WS_WINT + (size_t)4096 * 1024 * IEB, NTOK, 4096, 1024, F.G, c, IEB);
          pg8::EpiGate E{F.B.ws};
          pg8::gemm_phase<pg8::EpiGate, pg8::StaticOrder, true, false, IF8>(ring, 1024, S, E, F.wave); }
        { pg8::StaticOrder S; S.init(F.B.ws + WS_WVT, xa, 3072, NTOK, 1024, F.G, c, IEB);
          pg8::EpiVT E{FWS(bf16, WS_VSBT), FWS(bf16, WS_VRT)};
          pg8::gemm_phase<pg8::EpiVT, pg8::StaticOrder, true, false, IF8>(ring, 1024, S, E, F.wave); }
    } SEAM(1);
    if (IN(2)) { REFRESH(); attn_phase(F); } SEAM(2);
    if (IN(3)) { REFRESH(); scan_phase(F); } SEAM(3);
    if (IN(4)) { REFRESH(); intra_phase(F); } SEAM(4);
    if (IN(5)) { REFRESH(); if (STAGGER) stagger(F, 700);
        { pg8::StaticOrder S; S.init(FWS(bf16, WS_QSB), FWS(bf16, WS_WBSBT), NTOK, 1024, 1024, F.G, c);
          pg8::EpiBranch<0> E{FWS(bf16, WS_GSB), nullptr, FWS(bf16, WS_M1)};
          pg8::gemm_phase<pg8::EpiBranch<0>, pg8::StaticOrder, true, false>(ring, 1024, S, E, F.wave); }
        { pg8::StaticOrder S; S.init(FDO(bf16, DO_R), FWS(bf16, WS_WBRETT), NTOK, 1024, 2048, F.G, c);
          pg8::EpiBranch<1> E{FWS(bf16, WS_GRET), FWS(bf16, WS_M1), FWS(bf16, WS_MG)};
          pg8::gemm_phase<pg8::EpiBranch<1>, pg8::StaticOrder, true, false>(ring, 2048, S, E, F.wave); }
    } SEAM(5);
    if (IN(6)) { REFRESH(); if (STAGGER) stagger(F, 700); pg8::StaticOrder S; S.init(FWS(bf16, WS_MG), FWS(bf16, WS_WOUTT), NTOK, 1024, 1024, F.G, c);
        pg8::EpiPre E{F.B.x, (bf16*)F.B.out};
        pg8::gemm_phase<pg8::EpiPre, pg8::StaticOrder, true, false>(ring, 1024, S, E, F.wave); } SEAM(6);
    if (IN(7)) { REFRESH(); ln1_router_phase(F); } SEAM(7);
    if (IN(8)) { REFRESH(); if (STAGGER) stagger(F, 500); moe_setup(F);
        MoeOrder<true> S{(volatile LAS int*)(F.LC + 16), F.LC + 64, (const LAS unsigned*)(F.lds + LDS_TAB_OFF), c, (const char*)F.B.ws};
        S.build(F.wave * 64 + lane_id()); LDS_WAIT(); __syncthreads();
        { pg8::Unit u; LAS unsigned* tab = (LAS unsigned*)(F.lds + LDS_TAB_OFF);
          const int tid_ = F.wave * 64 + lane_id();
          (void)u; const int half_ = tid_ >> 8, rr = tid_ & 255; const LAS int* ut = (const LAS int*)(F.LC + MoeOrder<true>::UT_WORD); const int* rowtk = FWS(int, WS_ROWTK);
          int tkv[12]; bool vld[12];
#pragma unroll
          for (int j = 0; j < 12; ++j) { const int i = 2 * j + half_; const int e = ut[4 * i], pm = ut[4 * i + 2], nr = ut[4 * i + 3]; vld[j] = (e >= 0) && (rr < nr);
              tkv[j] = rowtk[vld[j] ? (size_t)e * CAP + pm + rr : (size_t)0]; }
#pragma unroll
          for (int j = 0; j < 12; ++j) tab[(2 * j + half_) * 256 + rr] = vld[j] ? (unsigned)(tkv[j] >> 2) * (MOE_FP8 ? 1024u : 2048u) : 0u;
          LDS_WAIT(); __syncthreads(); }
        pg8::EpiGateUp E{F.B.b_gu, F.B.ws};
        pg8::gemm_phase<pg8::EpiGateUp, MoeOrder<true>, true, true, MOE_FP8 != 0>(ring, 1024, S, E, F.wave); } SEAM(8);
    if (IN(9)) { REFRESH(); if (STAGGER) stagger(F, 500); moe_setup(F);
        MoeOrder<false> S{(volatile LAS int*)(F.LC + 16), F.LC + 64, (const LAS unsigned*)(F.lds + LDS_TAB_OFF), c, (const char*)F.B.ws};
        S.build(F.wave * 64 + lane_id()); LDS_WAIT(); __syncthreads();
        pg8::EpiDown E{F.B.ws, F.B.b_dn};
        pg8::gemm_phase<pg8::EpiDown, MoeOrder<false>, true, false, MOE_FP8 != 0>(ring, 1024, S, E, F.wave); } SEAM(9);
    if (IN(10)) { REFRESH(); final_phase(F); }
#undef IN
#undef SEAM
}
#ifndef OPT_MASK
#define OPT_MASK 0x7FF
#endif
#ifndef ONE_LAUNCH
#define ONE_LAUNCH 1
#endif
template <int NB, class AF, class BF, class EF> static void launch_ngemm(hipStream_t s, int M, int N, int K, const AF& af, const BF& bf, const EF& ef) {
    GArgs<AF, BF, EF> ga; memset(&ga, 0, sizeof(ga)); ga.af = af; ga.bf = bf; ga.ef = ef; ga.M = M; ga.N = N; ga.K = K; ga.pad = 0;
    ngemm<NB, AF, BF, EF><<<dim3(N / 64, M / 64), 256, 0, s>>>(ga);
}
static void launch_tr(hipStream_t s, int grid, const float* src, int lds, int c0, int width, int K, bf16* dst, int r0) {
    TrArgs a; memset(&a, 0, sizeof(a)); a.src = src; a.dst = dst; a.lds = lds; a.c0 = c0; a.width = width; a.K = K; a.r0 = r0; a.pad = 0;
    n_tr<<<grid, 256, 0, s>>>(a);
}
static AF_rows mk_rows(const void* p, int ld) { AF_rows a; memset(&a, 0, sizeof(a)); a.A = (const bf16*)p; a.ld = ld; a.pad = 0; return a; }
static BF_wt mk_wt(const void* p, int K) { BF_wt a; memset(&a, 0, sizeof(a)); a.W = (const bf16*)p; a.K = K; a.pad = 0; return a; }
static void run_naive(const Bufs& B, hipStream_t s, int stage) {
    unsigned char* ws = B.ws;
    switch (stage) {
    case 0: {
        n_xb<<<2048, 256, 0, s>>>(B);
        bf16* wint = (bf16*)(ws + WS_WINT); bf16* wvt = (bf16*)(ws + WS_WVT);
        launch_tr(s, 1024, B.w_in, INW, 0, 2048, 1024, wint, 0);
        launch_tr(s, 1024, B.w_in, INW, 2048, 1024, 1024, wvt, 0);
        launch_tr(s, 1024, B.w_in, INW, 3072, 2048, 1024, wint, 2048);
        launch_tr(s, 1024, B.w_in, INW, 5120, 2048, 1024, wvt, 1024);
        launch_tr(s, 1024, B.w_in, INW, 7168, 4096, 1024, wint, 4096);
        launch_tr(s, 1024, B.w_bsb, 1024, 0, 1024, 1024, (bf16*)(ws + WS_WBSBT), 0);
        launch_tr(s, 1024, B.w_bret, 1024, 0, 1024, 2048, (bf16*)(ws + WS_WBRETT), 0);
        launch_tr(s, 1024, B.w_out, 1024, 0, 1024, 1024, (bf16*)(ws + WS_WOUTT), 0);
        launch_tr(s, 64, B.w_router, 32, 0, 32, 1024, (bf16*)(ws + WS_WRT), 0);
        { Tr2Args a; memset(&a, 0, sizeof(a)); a.src = B.w_gu; a.dst = (bf16*)(ws + WS_WGUT); n_tr_gu<<<4096, 256, 0, s>>>(a); }
        { Tr2Args a; memset(&a, 0, sizeof(a)); a.src = B.w_dn; a.dst = (bf16*)(ws + WS_WDT); n_tr_dn<<<4096, 256, 0, s>>>(a); }
        n_rope<<<1024, 256, 0, s>>>(B);
    } break;
    case 1: {
        BF_inproj bf; memset(&bf, 0, sizeof(bf)); bf.wint = (const bf16*)(ws + WS_WINT); bf.wvt = (const bf16*)(ws + WS_WVT); EF_inproj ef{B};
        launch_ngemm<1>(s, NTOK, INW, 1024, mk_rows((unsigned char*)B.out + DO_XB, 1024), bf, ef);
        n_rotary<<<4096, 256, 0, s>>>(B);
    } break;
    case 2: n_attn<<<BATCH * SBH * SEQ / 64, 64, 0, s>>>(B);
        if (OPT_MASK & 1) { { Tr2Args a; memset(&a, 0, sizeof(a)); a.src = B.w_gu; a.dst = (bf16*)(ws + WS_WGUT); n_tr_gu<<<4096, 256, 0, s>>>(a); }
                            { Tr2Args a; memset(&a, 0, sizeof(a)); a.src = B.w_dn; a.dst = (bf16*)(ws + WS_WDT); n_tr_dn<<<4096, 256, 0, s>>>(a); } }
        break;
    case 3: n_scan<<<BATCH * RH * RDV, 64, 0, s>>>(B); break;
    case 4: n_intra<<<BATCH * RH * NCHUNK, 256, 0, s>>>(B); break;
    case 5: {
        { EF_m1 ef{B}; launch_ngemm<1>(s, NTOK, 1024, 1024, mk_rows(ws + WS_QSB, 1024), mk_wt(ws + WS_WBSBT, 1024), ef); }
        { EF_mg ef{B}; launch_ngemm<1>(s, NTOK, 1024, 2048, mk_rows((unsigned char*)B.out + DO_R, 2048), mk_wt(ws + WS_WBRETT, 2048), ef); }
    } break;
    case 6: { EF_pre ef{B}; launch_ngemm<1>(s, NTOK, 1024, 1024, mk_rows(ws + WS_MG, 1024), mk_wt(ws + WS_WOUTT, 1024), ef); } break;
    case 7: n_ln1<<<NTOK / 4, 256, 0, s>>>(B); n_router<<<NTOK / 64, 64, 0, s>>>(B); break;
    case 8: { n_tstart<<<1, 64, 0, s>>>(B); n_rowinfo<<<544, 256, 0, s>>>(B); AF_gather af{B}; BF_gu bf{B}; EF_gu ef{B}; launch_ngemm<2>(s, MAXROWS, 1024, 1024, af, bf, ef); } break;
    case 9: { n_tstart<<<1, 64, 0, s>>>(B); n_rowinfo<<<544, 256, 0, s>>>(B); AF_act af{B}; BF_dn bf{B}; EF_dn ef{B}; launch_ngemm<1>(s, MAXROWS, 1024, 1024, af, bf, ef); } break;
    case 10: n_final<<<NTOK / 4, 256, 0, s>>>(B); break;
    }
}
static void run_mega(const Bufs& B, hipStream_t s, int lo, int hi) {
    MArgs a; memset(&a, 0, sizeof(a)); a.B = B; a.ph_lo = lo; a.ph_hi = hi;
    hipLaunchKernelGGL(mega_fwd, dim3(256), dim3(NWAVES * 64), LDS_BYTES, s, a);
}

extern "C" void kernel_launch(void* const* d_in, const int* in_sizes, int n_in, void* d_out, int out_size, void* d_ws, size_t ws_size, hipStream_t stream) {
    if (n_in != 15 || out_size != NTOK * DM || ws_size < WS_END) { fprintf(stderr, "kernel_launch: unexpected shapes (n_in %d out %d ws %zu)\n", n_in, out_size, ws_size); return; }
    static int inited = 0;
    if (!inited) { inited = 1;
        if (hipFuncSetAttribute((const void*)mega_fwd, hipFuncAttributeMaxDynamicSharedMemorySize, LDS_BYTES) != hipSuccess) fprintf(stderr, "kernel_launch: hipFuncSetAttribute failed\n");
        int dev = 0, cus = 0; (void)hipGetDevice(&dev); (void)hipDeviceGetAttribute(&cus, hipDeviceAttributeMultiprocessorCount, dev);
        if (cus != 256) fprintf(stderr, "kernel_launch: built for 256 CUs, device has %d\n", cus);
        (void)hipGetLastError(); }
    Bufs B; memset(&B, 0, sizeof(B));
    B.x = (const float*)d_in[0]; B.w_in = (const float*)d_in[1]; B.w_bsb = (const float*)d_in[2]; B.w_bret = (const float*)d_in[3]; B.w_out = (const float*)d_in[4];
    B.ln1_g = (const float*)d_in[5]; B.ln1_b = (const float*)d_in[6]; B.w_router = (const float*)d_in[7]; B.b_router = (const float*)d_in[8];
    B.w_gu = (const float*)d_in[9]; B.b_gu = (const float*)d_in[10]; B.w_dn = (const float*)d_in[11]; B.b_dn = (const float*)d_in[12]; B.ln2_g = (const float*)d_in[13]; B.ln2_b = (const float*)d_in[14];
    B.out = (float*)d_out; B.ws = (unsigned char*)d_ws;
    (void)hipMemsetAsync((char*)d_ws + WS_CTL, 0, CTL_ZERO_BYTES, stream);
    if ((OPT_MASK & 0x7FF) == 0x7FF && ONE_LAUNCH) { run_mega(B, stream, 0, NPHASE); return; }
    for (int st = 0; st < NPHASE; ++st) { if ((OPT_MASK >> st) & 1) run_mega(B, stream, st, st + 1); else run_naive(B, stream, st);
#ifdef PROBE_DUP
        if (st == PROBE_DUP) {
            if (st == 2) { run_mega(B, stream, 1, 2); run_mega(B, stream, 2, 3); }
            else if (st == 4) { run_mega(B, stream, 3, 4); run_mega(B, stream, 4, 5); }
            else if (st == 7) { (void)hipMemsetAsync((char*)d_ws + WS_CTL, 0, CTL_ZERO_BYTES, stream); run_mega(B, stream, 6, 7); run_mega(B, stream, 7, 8); }
            else if (st == 10) { (void)hipMemsetAsync((char*)d_ws + WS_CTL, 0, CTL_ZERO_BYTES, stream); run_mega(B, stream, 6, 7); run_mega(B, stream, 7, 8); run_mega(B, stream, 10, 11); }
            else {
#ifndef PROBE_REP
#define PROBE_REP 1
#endif
                for (int rep = 0; rep < PROBE_REP; ++rep) run_mega(B, stream, st, st + 1); }
        }
#endif
    }
}
```
